# Optimizing an MI355X kernel written in HIP

```python
import jax, jax.numpy as jnp
from jax import lax
import numpy as np

D_MODEL = 1024
BATCH = 8
SEQ = 2048
DEPTH = 4
DEC_BATCH = 16
DEC_SEQ = 16
PAST_LEN = 1024

CHUNK = 64
SB_HEADS = 6
SB_DIM = 64
SB_WIDTH = SB_HEADS * SB_DIM
SB_BLOCK = 128
POOL_WINDOWS = (2, 4, 8, 16)
POOL_GROUPS = 4
POOL_GDIM = 64
POOL_WIDTH = POOL_GROUPS * POOL_GDIM
POOL_HIST = max(POOL_WINDOWS) - 1
GLA_HEADS = 4
GLA_DK = 96
GLA_DV = 96
GLA_KW = GLA_HEADS * GLA_DK
GLA_VW = GLA_HEADS * GLA_DV
GLA_RANK = 16
GLA_TAU = 16.0
N_BRANCH = 3
MEM_LEN = 256
X_HEADS = 4
X_DIM = D_MODEL // X_HEADS
FF = -(-8 * D_MODEL // (3 * 256)) * 256
EPS = 1e-6
IN_SPLITS = (SB_WIDTH, SB_WIDTH, SB_WIDTH, POOL_WIDTH, GLA_KW, GLA_KW, GLA_VW, GLA_VW, GLA_RANK, D_MODEL, D_MODEL, D_MODEL)
IN_WIDTH = 3 * SB_WIDTH + POOL_WIDTH + 2 * GLA_KW + 2 * GLA_VW + GLA_RANK + N_BRANCH * D_MODEL

kernel_name = 'stickbreak_pool_gla_hybrid_stream_step'


def rmsnorm(x, g):
    xf = x.astype(jnp.float32)
    y = xf * lax.rsqrt(jnp.mean(xf * xf, axis=-1, keepdims=True) + EPS)
    return (y * g.astype(jnp.float32)).astype(x.dtype)


def stick_breaking(q, k, v, q_pos, k_pos):
    z = jnp.einsum('bqhd,bkhd->bhqk', q, k).astype(jnp.float32) * (q.shape[-1] ** -0.5)
    mask = (k_pos[None, :] < q_pos[:, None])[None, None]
    log_beta = jax.nn.log_sigmoid(z)
    log_fail = jnp.where(mask, jax.nn.log_sigmoid(-z), 0.0)
    after = lax.cumsum(log_fail, axis=3, reverse=True) - log_fail
    w = jnp.where(mask, jnp.exp(log_beta + after), 0.0)
    return jnp.einsum('bhqk,bkhd->bqhd', w.astype(v.dtype), v)


def sb_prompt(q, k, v):
    B, T, H, D = q.shape
    nb = T // SB_BLOCK
    pos = jnp.arange(T)
    qb = q.reshape(B, nb, SB_BLOCK, H, D).swapaxes(0, 1)
    pb = pos.reshape(nb, SB_BLOCK)
    ob = lax.map(lambda a: stick_breaking(a[0], k, v, a[1], pos), (qb, pb))
    return ob.swapaxes(0, 1).reshape(B, T, H, D)


def pool_mix(u, hist, pos0):
    B, T, C = u.shape
    full = jnp.concatenate([hist.astype(u.dtype), u], axis=1)
    ff = full.astype(jnp.float32)
    cs = jnp.concatenate([jnp.zeros((B, 1, C), jnp.float32), jnp.cumsum(ff, axis=1)], axis=1)
    pos = pos0 + jnp.arange(T)
    P = POOL_HIST
    outs = []
    for g, w in enumerate(POOL_WINDOWS):
        sl = slice(g * POOL_GDIM, (g + 1) * POOL_GDIM)
        s = cs[:, P + 1:P + 1 + T, sl] - cs[:, P + 1 - w:P + 1 - w + T, sl]
        cnt = jnp.minimum(pos + 1, w).astype(jnp.float32)
        outs.append(s / cnt[None, :, None])
    pooled = jnp.concatenate(outs, axis=-1) - ff[:, P:]
    return pooled.astype(u.dtype), full[:, -POOL_HIST:]


def gla(q, k, v, log_a, S0, L):
    B, T, H, DK = q.shape
    DV = v.shape[-1]
    n = T // L

    def to_chunks(a):
        return a.reshape(B, n, L, H, a.shape[-1]).swapaxes(0, 1).astype(jnp.float32)

    causal = jnp.tril(jnp.ones((L, L), bool))[None, :, :, None, None]

    def step(S, inp):
        qc, kc, vc, ac = inp
        b = jnp.cumsum(ac, axis=1)
        o_inter = jnp.einsum('blhk,bhkv->blhv', qc * jnp.exp(b), S)
        rel = b[:, :, None] - b[:, None, :]
        decay = jnp.exp(jnp.where(causal, rel, -jnp.inf))
        att = jnp.einsum('bthk,bshk,btshk->bhts', qc, kc, decay)
        o_intra = jnp.einsum('bhts,bshv->bthv', att, vc)
        bL = b[:, -1]
        S_new = jnp.exp(bL)[..., None] * S + jnp.einsum('bshk,bshv->bhkv', kc * jnp.exp(bL[:, None] - b), vc)
        return S_new, o_inter + o_intra

    S, o = lax.scan(step, S0.astype(jnp.float32), (to_chunks(q), to_chunks(k), to_chunks(v), to_chunks(log_a)))
    return S, o.swapaxes(0, 1).reshape(B, T, H, DV)


def token_mixers(h, p, l, sb_past, pool_hist, S0, pos0, gla_chunk):
    B, T, _ = h.shape
    idx = np.cumsum(np.array(IN_SPLITS))[:-1].tolist()
    qa, ka, va, u, qc, kc, vc, gc, lr, ga, gb, gcg = jnp.split(h @ p['w_in'][l], idx, axis=-1)
    qa = qa.reshape(B, T, SB_HEADS, SB_DIM)
    ka = ka.reshape(B, T, SB_HEADS, SB_DIM)
    va = va.reshape(B, T, SB_HEADS, SB_DIM)
    if sb_past is None:
        oa = sb_prompt(qa, ka, va)
    else:
        K = jnp.concatenate([sb_past[0].astype(ka.dtype), ka], axis=1)
        V = jnp.concatenate([sb_past[1].astype(va.dtype), va], axis=1)
        oa = stick_breaking(qa, K, V, pos0 + jnp.arange(T), jnp.arange(K.shape[1]))
    oa = oa.reshape(B, T, SB_WIDTH)
    pooled, pool_new = pool_mix(u, pool_hist, pos0)
    ob = jnp.einsum('btgc,gcd->btgd', pooled.reshape(B, T, POOL_GROUPS, POOL_GDIM), p['w_pool'][l])
    ob = ob.reshape(B, T, POOL_WIDTH) * p['pool_scale'][l]
    log_a = jax.nn.log_sigmoid((lr @ p['w_gla_a2'][l] + p['b_gla_a'][l]).astype(jnp.float32)) / GLA_TAU
    S_new, oc = gla((qc * (GLA_DK ** -0.5)).reshape(B, T, GLA_HEADS, GLA_DK),
                    kc.reshape(B, T, GLA_HEADS, GLA_DK),
                    vc.reshape(B, T, GLA_HEADS, GLA_DV),
                    log_a.reshape(B, T, GLA_HEADS, GLA_DK), S0, gla_chunk)
    oc = rmsnorm(oc, p['gla_norm'][l].reshape(GLA_HEADS, GLA_DV)).reshape(B, T, GLA_VW)
    oc = (oc * jax.nn.silu(gc.astype(jnp.float32))).astype(h.dtype)
    merged = (jax.nn.sigmoid(ga) * (oa @ p['w_branch_a'][l])
              + jax.nn.sigmoid(gb) * (ob @ p['w_branch_b'][l])
              + jax.nn.sigmoid(gcg) * (oc @ p['w_branch_c'][l]))
    out = (merged @ p['w_mix_out'][l]).astype(h.dtype)
    return out, ka, va, pool_new, S_new


def mem_kv(mem, g, wk, wv):
    B, M, _ = mem.shape
    m = rmsnorm(mem, g)
    return (m @ wk).reshape(B, M, X_HEADS, X_DIM), (m @ wv).reshape(B, M, X_HEADS, X_DIM)


def cross_attn(h, mk, mv, wq, wo):
    B, T, _ = h.shape
    q = (h @ wq).reshape(B, T, X_HEADS, X_DIM)
    s = jnp.einsum('bthd,bmhd->bhtm', q, mk.astype(q.dtype)).astype(jnp.float32) * (X_DIM ** -0.5)
    pr = jax.nn.softmax(s, axis=-1).astype(h.dtype)
    o = jnp.einsum('bhtm,bmhd->bthd', pr, mv.astype(h.dtype)).reshape(B, T, D_MODEL)
    return o @ wo


def swiglu(h, w_in, w_out):
    g, u = jnp.split(h @ w_in, 2, axis=-1)
    return (jax.nn.silu(g) * u) @ w_out


def layer(x, p, l, sb_past, pool_hist, S0, mk, mv, pos0, gla_chunk):
    h = rmsnorm(x, p['norm_mix_pre'][l])
    mix, k_new, v_new, pool_new, S_new = token_mixers(h, p, l, sb_past, pool_hist, S0, pos0, gla_chunk)
    x = x + rmsnorm(mix, p['norm_mix_post'][l]).astype(x.dtype)
    h = rmsnorm(x, p['norm_x_pre'][l])
    x = x + rmsnorm(cross_attn(h, mk, mv, p['w_xq'][l], p['w_xo'][l]), p['norm_x_post'][l]).astype(x.dtype)
    h = rmsnorm(x, p['norm_ffn_pre'][l])
    x = x + rmsnorm(swiglu(h, p['w_ffn_in'][l], p['w_ffn_out'][l]), p['norm_ffn_post'][l]).astype(x.dtype)
    return x, k_new, v_new, pool_new, S_new


def setup_inputs(seed: int = 0) -> dict:
    key = jax.random.key(seed)
    ks = jax.random.split(key, 40)
    f32 = jnp.float32

    def nrm(k, shape, fan_in):
        return jax.random.normal(k, shape, f32) * (fan_in ** -0.5)

    def gain(k, shape):
        return 1.0 + 0.05 * jax.random.normal(k, shape, f32)

    L = DEPTH
    return {
        'x_prompt': jax.random.normal(ks[0], (BATCH, SEQ, D_MODEL), f32),
        'x_sample': jax.random.normal(ks[1], (DEC_BATCH, DEC_SEQ, D_MODEL), f32),
        'mem_prompt': jax.random.normal(ks[2], (BATCH, MEM_LEN, D_MODEL), f32),
        'cache_sb_k': jax.random.normal(ks[3], (L, DEC_BATCH, PAST_LEN, SB_HEADS, SB_DIM), f32),
        'cache_sb_v': jax.random.normal(ks[4], (L, DEC_BATCH, PAST_LEN, SB_HEADS, SB_DIM), f32),
        'state_pool': jax.random.normal(ks[5], (L, DEC_BATCH, POOL_HIST, POOL_WIDTH), f32),
        'state_gla': jax.random.normal(ks[6], (L, DEC_BATCH, GLA_HEADS, GLA_DK, GLA_DV), f32),
        'cache_mem_k': jax.random.normal(ks[7], (L, DEC_BATCH, MEM_LEN, X_HEADS, X_DIM), f32),
        'cache_mem_v': jax.random.normal(ks[8], (L, DEC_BATCH, MEM_LEN, X_HEADS, X_DIM), f32),
        'w_in': nrm(ks[9], (L, D_MODEL, IN_WIDTH), D_MODEL),
        'w_gla_a2': nrm(ks[10], (L, GLA_RANK, GLA_KW), GLA_RANK),
        'b_gla_a': 0.1 * jax.random.normal(ks[11], (L, GLA_KW), f32),
        'gla_norm': gain(ks[12], (L, GLA_VW)),
        'w_pool': nrm(ks[13], (L, POOL_GROUPS, POOL_GDIM, POOL_GDIM), POOL_GDIM),
        'pool_scale': 1.0 + 0.1 * jax.random.normal(ks[14], (L, POOL_WIDTH), f32),
        'w_branch_a': nrm(ks[15], (L, SB_WIDTH, D_MODEL), SB_WIDTH),
        'w_branch_b': nrm(ks[16], (L, POOL_WIDTH, D_MODEL), POOL_WIDTH),
        'w_branch_c': nrm(ks[17], (L, GLA_VW, D_MODEL), GLA_VW),
        'w_mix_out': nrm(ks[18], (L, D_MODEL, D_MODEL), D_MODEL),
        'mem_norm': gain(ks[19], (L, D_MODEL)),
        'w_xq': nrm(ks[20], (L, D_MODEL, D_MODEL), D_MODEL),
        'w_xk': nrm(ks[21], (L, D_MODEL, D_MODEL), D_MODEL),
        'w_xv': nrm(ks[22], (L, D_MODEL, D_MODEL), D_MODEL),
        'w_xo': nrm(ks[23], (L, D_MODEL, D_MODEL), D_MODEL),
        'w_ffn_in': nrm(ks[24], (L, D_MODEL, 2 * FF), D_MODEL),
        'w_ffn_out': nrm(ks[25], (L, FF, D_MODEL), FF),
        'norm_mix_pre': gain(ks[26], (L, D_MODEL)),
        'norm_mix_post': gain(ks[27], (L, D_MODEL)),
        'norm_x_pre': gain(ks[28], (L, D_MODEL)),
        'norm_x_post': gain(ks[29], (L, D_MODEL)),
        'norm_ffn_pre': gain(ks[30], (L, D_MODEL)),
        'norm_ffn_post': gain(ks[31], (L, D_MODEL)),
    }


def reference(x_prompt, x_sample, mem_prompt, cache_sb_k, cache_sb_v, state_pool, state_gla,
              cache_mem_k, cache_mem_v, w_in, w_gla_a2, b_gla_a, gla_norm, w_pool, pool_scale,
              w_branch_a, w_branch_b, w_branch_c, w_mix_out, mem_norm, w_xq, w_xk, w_xv, w_xo,
              w_ffn_in, w_ffn_out, norm_mix_pre, norm_mix_post, norm_x_pre, norm_x_post,
              norm_ffn_pre, norm_ffn_post):
    p = dict(w_in=w_in, w_gla_a2=w_gla_a2, b_gla_a=b_gla_a, gla_norm=gla_norm, w_pool=w_pool,
             pool_scale=pool_scale, w_branch_a=w_branch_a, w_branch_b=w_branch_b,
             w_branch_c=w_branch_c, w_mix_out=w_mix_out, w_xq=w_xq, w_xo=w_xo,
             w_ffn_in=w_ffn_in, w_ffn_out=w_ffn_out, norm_mix_pre=norm_mix_pre,
             norm_mix_post=norm_mix_post, norm_x_pre=norm_x_pre, norm_x_post=norm_x_post,
             norm_ffn_pre=norm_ffn_pre, norm_ffn_post=norm_ffn_post)
    B = x_prompt.shape[0]
    Ts = x_sample.shape[1]
    yp, ys = x_prompt, x_sample
    kp, vp, poolp, glap, mkp, mvp = [], [], [], [], [], []
    kss, vss, pools, glas = [], [], [], []
    pool_zero = jnp.zeros((B, POOL_HIST, POOL_WIDTH), x_prompt.dtype)
    gla_zero = jnp.zeros((B, GLA_HEADS, GLA_DK, GLA_DV), jnp.float32)
    for l in range(DEPTH):
        mk, mv = mem_kv(mem_prompt, mem_norm[l], w_xk[l], w_xv[l])
        yp, k_new, v_new, pool_new, S_new = layer(yp, p, l, None, pool_zero, gla_zero, mk, mv, 0, CHUNK)
        kp.append(k_new); vp.append(v_new); poolp.append(pool_new); glap.append(S_new)
        mkp.append(mk); mvp.append(mv)
        ys, k_new, v_new, pool_new, S_new = layer(ys, p, l, (cache_sb_k[l], cache_sb_v[l]), state_pool[l],
                                                 state_gla[l], cache_mem_k[l], cache_mem_v[l], PAST_LEN, Ts)
        kss.append(k_new); vss.append(v_new); pools.append(pool_new); glas.append(S_new)
    return (yp, ys,
            jnp.stack(kp), jnp.stack(vp), jnp.stack(poolp), jnp.stack(glap), jnp.stack(mkp), jnp.stack(mvp),
            jnp.stack(kss), jnp.stack(vss), jnp.stack(pools), jnp.stack(glas))
```

```cpp
#include <hip/hip_runtime.h>
#include <hip/hip_cooperative_groups.h>
#include <cstdio>
#include <cstdint>
namespace cg = cooperative_groups;

namespace pg8 {
#define PG8_LAS __attribute__((address_space(3)))
typedef unsigned short bf16_t;
typedef short bf16x8 __attribute__((ext_vector_type(8)));
typedef float f32x4 __attribute__((ext_vector_type(4)));
typedef unsigned u32x4 __attribute__((ext_vector_type(4)));
typedef unsigned u32x2 __attribute__((ext_vector_type(2)));
constexpr int BM = 256, BK = 64, HALF = 128, HTB = HALF * BK * 2  , STAGE_BYTES = 8 * HTB, NXCD = 8, WGM = 8;

__host__ __device__ __forceinline__ int lds_byte(int r, int c) { const int st = (r >> 4) * 2 + (c >> 5), rr = r & 15, cc = c & 31, ob = rr * 64 + cc * 2; return st * 1024 + (ob ^ (((ob >> 9) & 1) << 5)); }
__host__ __device__ __forceinline__ void stage_rc(int b, int& R, int& C) { const int st = b / 1024, sb = b % 1024, swz = sb ^ (((sb >> 9) & 1) << 5); R = (st >> 1) * 16 + swz / 64; C = (st & 1) * 32 + (swz % 64) / 2; }
__host__ __device__ __forceinline__ int perm32(int rho) { const int n = rho >> 4, i = rho & 15; return 8 * (i >> 2) + 4 * n + (i & 3); }

struct Unit { int pm, pn; const char* a; const char* b; };
struct Gemm { int K, lda, ldb; };

struct TileOrder {
    int nM, nN, G, c, lda, ldb; const char* A; const char* B;
    __device__ void init(const void* A_, int lda_, const void* B_, int ldb_, int, int nM_, int nN_, int G_, int c_) {
        A = (const char*)A_; B = (const char*)B_; lda = lda_; ldb = ldb_; nM = nM_; nN = nN_; G = G_; c = c_; }
    __device__ bool next(int i, Unit& u) const {
        const int nwg = nM * nN; const long L = (long)i * G + c; if (L >= nwg) return false;
        int wgid = (int)L; { const int q = nwg / NXCD, r = nwg % NXCD, xcd = wgid % NXCD, off = wgid / NXCD; wgid = (xcd < r ? xcd * (q + 1) : r * (q + 1) + (xcd - r) * q) + off; }
        const int nig = WGM * nN, gid = wgid / nig, fm = gid * WGM, gsz = (nM - fm) < WGM ? (nM - fm) : WGM;
        u.pm = fm + ((wgid % nig) % gsz); u.pn = (wgid % nig) / gsz; u.a = A + (size_t)u.pm * ((size_t)BM * 2 * lda); u.b = B + (size_t)u.pn * ((size_t)BM * 2 * ldb); return true;
    }
    __device__ __forceinline__ void a_ready(const Unit&) const {}
    __device__ __forceinline__ void done(const Unit&) const {}
};

__device__ __forceinline__ int tid_() { int t = threadIdx.x; asm volatile("" : "+v"(t)); return t; }
__device__ __forceinline__ unsigned cvt_pk_bf16(float lo, float hi) { unsigned r; asm volatile("v_cvt_pk_bf16_f32 %0, %1, %2" : "=v"(r) : "v"(lo), "v"(hi)); return r; }

template <class Epi, class Sched, bool ALIGN_EPI = false, bool SP2 = false>
__device__ __forceinline__ void gemm_phase(PG8_LAS unsigned char* lds, const Gemm g, const Sched& S, const Epi& E) {
    const int tid = pg8::tid_(), wid = __builtin_amdgcn_readfirstlane(tid >> 6), lane = tid & 63, wr = wid >> 2, wc = wid & 3, fr = lane & 15, fq = lane >> 4;
    const int K = g.K, nt = K / BK;
    unsigned voffA, voffB;
    { int R, C; stage_rc(tid * 16, R, C); const int Rb = Epi::PERM ? ((R & ~31) + perm32(R & 31)) : R;
        voffA = (unsigned)(R * g.lda + C) * 2u; voffB = (unsigned)(Rb * g.ldb + C) * 2u; }
    const size_t qstepA = (size_t)64 * g.lda * 2, qstepB = (size_t)64 * g.ldb * 2;
    const size_t kstep = (size_t)(BK * 2);
    const size_t hstepA = (size_t)HALF * g.lda * 2, hstepB = (size_t)HALF * g.ldb * 2;
    const unsigned ldsw = (unsigned)wid * 1024u;
    const int aoff = lds_byte(wr * 64 + fr, fq * 8), boff = lds_byte(wc * 32 + fr, fq * 8);
#define PG8_SA(b, h) (((b) * 2 + (h)) * HTB)
#define PG8_SB(b, h) ((4 + (b) * 2 + (h)) * HTB)
#define PG8_STAGE(bufoff, gbase, voff) do { _Pragma("unroll") for (int _i = 0; _i < 2; ++_i) { const char* sb_ = (const char*)(gbase) + (size_t)_i * q##voff; asm volatile("" : "+s"(sb_));   \
        __builtin_amdgcn_global_load_lds((const unsigned*)(sb_ + (voff)), (PG8_LAS unsigned*)(lds + (bufoff) + ldsw + _i * 8192), 16, 0, 0); } } while (0)
#define qvoffA qstepA
#define qvoffB qstepB
#define PG8_LDA(dst, b, h) do { _Pragma("unroll") for (int m = 0; m < 4; ++m) _Pragma("unroll") for (int k = 0; k < 2; ++k) dst[m][k] = *(const PG8_LAS bf16x8*)(lds + PG8_SA(b, h) + aoff + m * 2048 + k * 1024); } while (0)
#define PG8_LDB(dst, b, h) do { _Pragma("unroll") for (int n = 0; n < 2; ++n) _Pragma("unroll") for (int k = 0; k < 2; ++k) dst[n][k] = *(const PG8_LAS bf16x8*)(lds + PG8_SB(b, h) + boff + n * 2048 + k * 1024); } while (0)
#define PG8_MMA(ai, bj, At, Bt) do { __builtin_amdgcn_s_setprio(1); _Pragma("unroll") for (int m = 0; m < 4; ++m) _Pragma("unroll") for (int n = 0; n < 2; ++n) _Pragma("unroll") for (int k = 0; k < 2; ++k) \
        acc[ai][bj][m][n] = __builtin_amdgcn_mfma_f32_16x16x32_bf16(Bt[n][k], At[m][k], acc[ai][bj][m][n], 0, 0, 0); __builtin_amdgcn_s_setprio(0); } while (0)
#define PG8_WAIT_V(n) asm volatile("s_waitcnt vmcnt(" #n ")" ::: "memory")
#define PG8_WAIT_L(n) asm volatile("s_waitcnt lgkmcnt(" #n ")" ::: "memory")
#define PG8_BAR __builtin_amdgcn_s_barrier()
#define PG8_SCHED __builtin_amdgcn_sched_barrier(0)
    Unit cur, nxt; int ui = 0;
    if (!S.next(0, cur)) return;
    f32x4 acc[2][2][4][2];
#pragma unroll
    for (int a = 0; a < 2; ++a)
#pragma unroll
        for (int b = 0; b < 2; ++b)
#pragma unroll
            for (int m = 0; m < 4; ++m)
#pragma unroll
                for (int n = 0; n < 2; ++n) acc[a][b][m][n] = (f32x4){0.f, 0.f, 0.f, 0.f};
    bf16x8 At[4][2], B0[2][2], B1[2][2];
    const char* cA = cur.a; const char* cB = cur.b;
    S.a_ready(cur);
    if constexpr (SP2) {
        PG8_STAGE(PG8_SB(0, 0), cB, voffB); PG8_STAGE(PG8_SB(0, 1), cB + hstepB, voffB); PG8_STAGE(PG8_SA(0, 0), cA, voffA); PG8_STAGE(PG8_SA(0, 1), cA + hstepA, voffA);
        if (wr == 1) PG8_BAR;
        PG8_WAIT_V(2); PG8_BAR;
        PG8_STAGE(PG8_SB(1, 0), cB + kstep, voffB); PG8_STAGE(PG8_SA(1, 0), cA + kstep, voffA); PG8_STAGE(PG8_SB(1, 1), cB + hstepB + kstep, voffB);
        PG8_WAIT_V(6); PG8_BAR;
    } else {
        PG8_STAGE(PG8_SB(0, 0), cB, voffB); PG8_STAGE(PG8_SA(0, 0), cA, voffA); PG8_STAGE(PG8_SB(0, 1), cB + hstepB, voffB); PG8_STAGE(PG8_SA(0, 1), cA + hstepA, voffA);
        if (wr == 1) PG8_BAR;
        PG8_WAIT_V(4); PG8_BAR;
        PG8_STAGE(PG8_SB(1, 0), cB + kstep, voffB); PG8_STAGE(PG8_SA(1, 0), cA + kstep, voffA); PG8_STAGE(PG8_SB(1, 1), cB + hstepB + kstep, voffB);
        PG8_WAIT_V(6); PG8_BAR;
    }
    for (;;) {
        const bool has_next = S.next(ui + 1, nxt);
        const char* nA = has_next ? nxt.a : cA; const char* nB = has_next ? nxt.b : cB;
        for (int t = 0; t < nt; t += 2) {
            const bool last = (t == nt - 2);
            const char* a1 = cA + (size_t)(t + 1) * kstep;
            const char* a2 = last ? nA : cA + (size_t)(t + 2) * kstep; const char* b2 = last ? nB : cB + (size_t)(t + 2) * kstep;
            const char* a3 = a2 + kstep; const char* b3 = b2 + kstep;
            if (last && has_next) S.a_ready(nxt);
            if constexpr (SP2) {
            PG8_LDB(B0, 0, 0); PG8_LDB(B1, 0, 1); PG8_SCHED; PG8_LDA(At, 0, 0); PG8_STAGE(PG8_SA(1, 1), a1 + hstepA, voffA);
            PG8_WAIT_V(8); PG8_WAIT_L(0); PG8_BAR; PG8_MMA(0, 0, At, B0); PG8_MMA(0, 1, At, B1); PG8_BAR; PG8_SCHED;
            PG8_LDA(At, 0, 1); PG8_STAGE(PG8_SB(0, 0), b2, voffB); PG8_STAGE(PG8_SB(0, 1), b2 + hstepB, voffB); PG8_STAGE(PG8_SA(0, 0), a2, voffA);
            PG8_WAIT_V(8); PG8_WAIT_L(0); PG8_BAR; PG8_MMA(1, 0, At, B0); PG8_MMA(1, 1, At, B1); PG8_BAR; PG8_SCHED;
            PG8_LDB(B0, 1, 0); PG8_LDB(B1, 1, 1); PG8_SCHED; PG8_LDA(At, 1, 0); PG8_STAGE(PG8_SA(0, 1), a2 + hstepA, voffA);
            PG8_WAIT_V(8); PG8_WAIT_L(0); PG8_BAR; PG8_MMA(0, 0, At, B0); PG8_MMA(0, 1, At, B1); PG8_BAR; PG8_SCHED;
            PG8_LDA(At, 1, 1); PG8_STAGE(PG8_SB(1, 0), b3, voffB); PG8_STAGE(PG8_SB(1, 1), b3 + hstepB, voffB); PG8_STAGE(PG8_SA(1, 0), a3, voffA);
            PG8_WAIT_V(8); PG8_WAIT_L(0); PG8_BAR; PG8_MMA(1, 0, At, B0); PG8_MMA(1, 1, At, B1); PG8_BAR; PG8_SCHED;
            } else {
            PG8_LDB(B0, 0, 0); PG8_SCHED; PG8_LDA(At, 0, 0); PG8_STAGE(PG8_SA(1, 1), a1 + hstepA, voffA);
            PG8_WAIT_L(8); PG8_BAR; PG8_WAIT_L(0); PG8_MMA(0, 0, At, B0); PG8_BAR; PG8_SCHED;
            PG8_LDB(B1, 0, 1); PG8_STAGE(PG8_SB(0, 0), b2, voffB);
            PG8_BAR; PG8_WAIT_L(0); PG8_MMA(0, 1, At, B1); PG8_BAR;
            PG8_LDA(At, 0, 1); PG8_STAGE(PG8_SA(0, 0), a2, voffA);
            PG8_BAR; PG8_WAIT_L(0); PG8_MMA(1, 0, At, B0); PG8_BAR; PG8_SCHED;
            PG8_STAGE(PG8_SB(0, 1), b2 + hstepB, voffB);
            PG8_WAIT_V(6); PG8_BAR; PG8_MMA(1, 1, At, B1); PG8_BAR;
            PG8_LDB(B0, 1, 0); PG8_SCHED; PG8_LDA(At, 1, 0); PG8_STAGE(PG8_SA(0, 1), a2 + hstepA, voffA);
            PG8_WAIT_L(8); PG8_BAR; PG8_WAIT_L(0); PG8_MMA(0, 0, At, B0); PG8_BAR; PG8_SCHED;
            PG8_LDB(B1, 1, 1); PG8_STAGE(PG8_SB(1, 0), b3, voffB);
            PG8_BAR; PG8_WAIT_L(0); PG8_MMA(0, 1, At, B1); PG8_BAR;
            PG8_LDA(At, 1, 1); PG8_STAGE(PG8_SA(1, 0), a3, voffA);
            PG8_BAR; PG8_WAIT_L(0); PG8_MMA(1, 0, At, B0); PG8_BAR; PG8_SCHED;
            PG8_STAGE(PG8_SB(1, 1), b3 + hstepB, voffB);
            PG8_WAIT_V(6); PG8_BAR; PG8_MMA(1, 1, At, B1); PG8_BAR;
            }
        }
        if constexpr (ALIGN_EPI) { if (wr == 0) PG8_BAR; }
        if constexpr (!Epi::AFTER_DRAIN) { const int l2_ = tid_() & 63, fr2 = l2_ & 15, fq2 = l2_ >> 4;   E(acc, cur, wr, wc, fr2, fq2); S.done(cur); }
        if (!has_next) break;
#pragma unroll
        for (int a = 0; a < 2; ++a)
#pragma unroll
            for (int b = 0; b < 2; ++b)
#pragma unroll
                for (int m = 0; m < 4; ++m)
#pragma unroll
                    for (int n = 0; n < 2; ++n) acc[a][b][m][n] = (f32x4){0.f, 0.f, 0.f, 0.f};
        cur = nxt; cA = nA; cB = nB; ++ui;
        if constexpr (ALIGN_EPI) { if (wr == 1) PG8_BAR; }
    }
    PG8_WAIT_V(0);
    if constexpr (!ALIGN_EPI) { if (wr == 0) PG8_BAR; }
    PG8_BAR;
    if constexpr (Epi::AFTER_DRAIN) { E.fused(acc, cur, wr, wc, fr, fq, lds, wid, lane); S.done(cur); }
#undef PG8_SA
#undef PG8_SB
#undef PG8_STAGE
#undef qvoffA
#undef qvoffB
#undef PG8_LDA
#undef PG8_LDB
#undef PG8_MMA
#undef PG8_WAIT_V
#undef PG8_WAIT_L
#undef PG8_BAR
#undef PG8_SCHED
}
}

using pg8::bf16_t; using pg8::f32x4; using pg8::bf16x8; using pg8::u32x4; using pg8::u32x2;
#define DI __device__ __forceinline__
#define LAS __attribute__((address_space(3)))
typedef float f32x16 __attribute__((ext_vector_type(16)));
typedef short s16x4 __attribute__((ext_vector_type(4)));
typedef float f32x2_t __attribute__((ext_vector_type(2))); typedef __bf16 bf16x2_t __attribute__((ext_vector_type(2)));

constexpr int NTHR = 512, NWAVES = 8;
constexpr int D = 1024, NB = 8, SEQ = 2048, DEPTH = 4, DB = 16, DT = 16, PAST = 1024;
constexpr int MP = NB * SEQ, MS = DB * DT, MA = MP + MS;
constexpr int NIN = 6032, NINP = 6144;
constexpr int C_QA = 0, C_KA = 384, C_VA = 768, C_U = 1152, C_QC = 1408, C_KC = 1792, C_VC = 2176, C_GC = 2560, C_LR = 2944, C_GA = 2960, C_GB = 3984, C_GCG = 5008;
constexpr int FF = 2816, FF2 = 5632;
constexpr int GH = 4, GK = 96;
constexpr int NGU_P = NB * GH * 32, NGU_S = DB * GH, NGU = NGU_P + NGU_S;
constexpr float EPS = 1e-6f;

constexpr size_t O_YP = 0, O_YS = O_YP + (size_t)MP * D, O_KP = O_YS + (size_t)MS * D, O_VP = O_KP + (size_t)DEPTH * MP * 384, O_POOLP = O_VP + (size_t)DEPTH * MP * 384,
    O_GLAP = O_POOLP + (size_t)DEPTH * NB * 15 * 256, O_MKP = O_GLAP + (size_t)DEPTH * NB * GH * GK * GK, O_MVP = O_MKP + (size_t)DEPTH * NB * 256 * D,
    O_KS = O_MVP + (size_t)DEPTH * NB * 256 * D, O_VS = O_KS + (size_t)DEPTH * MS * 384, O_POOLS = O_VS + (size_t)DEPTH * MS * 384, O_GLAS = O_POOLS + (size_t)DEPTH * DB * 15 * 256,
    O_END = O_GLAS + (size_t)DEPTH * DB * GH * GK * GK;

enum { I_XP = 0, I_XS, I_MEM, I_CSK, I_CSV, I_SPOOL, I_SGLA, I_CMK, I_CMV, I_WIN, I_WA2, I_BA, I_GLAN, I_WPOOL, I_PSCALE, I_WBA, I_WBB, I_WBC, I_WMIX, I_MEMN, I_WXQ, I_WXK, I_WXV, I_WXO,
       I_WF1, I_WF2, I_NMIXPRE, I_NMIXPOST, I_NXPRE, I_NXPOST, I_NFPRE, I_NFPOST, N_IN };

constexpr size_t MiB = 1u << 20;
constexpr size_t SZ_WIN = (size_t)NINP * D * 2, SZ_WBA = (size_t)D * 384 * 2, SZ_WBB = (size_t)D * 256 * 2, SZ_WSQ = (size_t)D * D * 2, SZ_WKV = 2 * SZ_WSQ, SZ_WF1 = (size_t)FF2 * D * 2, SZ_WF2 = (size_t)D * FF * 2;
constexpr size_t WS_CTL = 0, CTL_BYTES = 1 * MiB, WS_TAB = CTL_BYTES - 4096;
constexpr size_t WS_WIN = WS_CTL + CTL_BYTES, WS_WBA = WS_WIN + 4 * SZ_WIN, WS_WBB = WS_WBA + 4 * SZ_WBA, WS_WBC = WS_WBB + 4 * SZ_WBB, WS_WMIX = WS_WBC + 4 * SZ_WBA,
    WS_WXQ = WS_WMIX + 4 * SZ_WSQ, WS_WXO = WS_WXQ + 4 * SZ_WSQ, WS_WKV = WS_WXO + 4 * SZ_WSQ, WS_WF1 = WS_WKV + 4 * SZ_WKV, WS_WF2 = WS_WF1 + 4 * SZ_WF1,
    WS_MN = WS_WF2 + 4 * SZ_WF2, WS_MKV = WS_MN + 4 * SZ_WKV, WS_MEMVT = WS_MKV + 8 * SZ_WKV, WS_PROJ = WS_MEMVT + 4 * SZ_WKV;
constexpr size_t SZ_ROWS = (size_t)MA * D * 2;
constexpr size_t SZ_PROJ = (size_t)MA * NINP * 2;
constexpr size_t WS_Q = WS_PROJ, WS_P = WS_Q + SZ_ROWS, WS_O = WS_P + SZ_ROWS, WS_ACT = WS_O + SZ_ROWS;
static_assert(WS_ACT + (size_t)MA * FF * 2 <= WS_PROJ + SZ_PROJ, "overlay fits");
constexpr size_t WS_H = WS_PROJ + SZ_PROJ, WS_MERGED = WS_H + SZ_ROWS, WS_Y = WS_MERGED + SZ_ROWS;
constexpr size_t WS_GKV = WS_H, WS_GSP = WS_GKV + 39 * MiB, WS_GDEC = WS_GSP + 37 * MiB;
static_assert((size_t)NGU * GK * GK * 4 <= 39 * MiB && (size_t)NGU_P * GK * GK * 4 <= 37 * MiB && WS_GDEC + (size_t)NGU * GK * 4 <= WS_Y + SZ_ROWS, "GLA overlay fits");
constexpr size_t WS_OA = WS_Y + SZ_ROWS, WS_POOLED = WS_OA + (size_t)MA * 384 * 2, WS_OC = WS_POOLED + (size_t)MA * 256 * 2, WS_END = WS_OC + (size_t)MA * 384 * 2;
static_assert(WS_WIN % 256 == 0 && WS_PROJ % 256 == 0 && WS_H % 256 == 0 && WS_OA % 256 == 0 && WS_POOLED % 256 == 0 && WS_OC % 256 == 0 && WS_P % 256 == 0, "alignment");

constexpr int LDS_GEMM = 131072, LDS_X = LDS_GEMM, LDS_X_BYTES = 12288, LDS_MISC = LDS_X + LDS_X_BYTES, LDS_BYTES = LDS_MISC + 256;

struct Params { const float* in[N_IN]; float* out; unsigned char* ws; int ph_lo, ph_hi; };
struct InTab { const float* const* t;
    __device__ __forceinline__ const float* operator[](int i) const { const unsigned long long v = (unsigned long long)t[i];
        const unsigned lo = __builtin_amdgcn_readfirstlane((unsigned)v), hi = __builtin_amdgcn_readfirstlane((unsigned)(v >> 32)); return (const float*)(((unsigned long long)hi << 32) | lo); } };
struct Ctx { InTab in; float* out; unsigned char* ws; };

DI float bflo(unsigned w) { return __uint_as_float(w << 16); }
DI float bfhi(unsigned w) { return __uint_as_float(w & 0xffff0000u); }
DI float bf2f(unsigned short v) { return __uint_as_float((unsigned)v << 16); }
DI unsigned pk2(float lo, float hi) { f32x2_t v = {lo, hi}; bf16x2_t b = __builtin_convertvector(v, bf16x2_t); return __builtin_bit_cast(unsigned, b); }
DI unsigned short f2bf(float f) { return (unsigned short)(pk2(f, 0.f) & 0xffffu); }
DI float wave_sum(float v) {
#pragma unroll
    for (int o = 1; o < 64; o <<= 1) v += __shfl_xor(v, o);
    return v;
}
DI float wave_max(float v) {
#pragma unroll
    for (int o = 1; o < 64; o <<= 1) v = fmaxf(v, __shfl_xor(v, o));
    return v;
}
DI float sigmoidf_(float x) { return __builtin_amdgcn_rcpf(1.f + __expf(-x)); }
DI float softplusf_(float z) { return fmaxf(z, 0.f) + __logf(1.f + __expf(-fabsf(z))); }
DI int next_work(unsigned* ctr, volatile LAS int* slot) {
    __syncthreads();
    if (pg8::tid_() == 0) *slot = (int)atomicAdd(ctr, 1u);
    __syncthreads();
    return *slot;
}

typedef const pg8::f32x4 (&AccRef)[2][2][4][2];
struct EpiBf16 {
    static constexpr bool PERM = true, AFTER_DRAIN = false;
    bf16_t* O; int ldc; int pnmask;
    DI void operator()(AccRef acc, const pg8::Unit& u, int wr, int wc, int fr, int fq) const {
#pragma unroll
        for (int ai = 0; ai < 2; ++ai)
#pragma unroll
            for (int m = 0; m < 4; ++m) {
                bf16_t* rowp = O + (size_t)(u.pm * 256 + ai * 128 + wr * 64 + m * 16 + fr) * ldc + (u.pn & pnmask) * 256 + wc * 32 + 8 * fq;
#pragma unroll
                for (int bj = 0; bj < 2; ++bj) {
                    const f32x4 v0 = acc[ai][bj][m][0], v1 = acc[ai][bj][m][1];
                    u32x4 w; w.x = pk2(v0[0], v0[1]); w.y = pk2(v0[2], v0[3]); w.z = pk2(v1[0], v1[1]); w.w = pk2(v1[2], v1[3]);
                    *(u32x4*)(rowp + bj * 128) = w;
                }
            }
    }
};
struct EpiGate {
    static constexpr bool PERM = true, AFTER_DRAIN = false;
    bf16_t* merged; const bf16_t* proj; int goff; int accum;
    DI void operator()(AccRef acc, const pg8::Unit& u, int wr, int wc, int fr, int fq) const {
#pragma unroll
        for (int ai = 0; ai < 2; ++ai)
#pragma unroll
            for (int m = 0; m < 4; ++m) {
                const int row = u.pm * 256 + ai * 128 + wr * 64 + m * 16 + fr;
                const bf16_t* gp = proj + (size_t)row * NINP + goff + u.pn * 256 + wc * 32 + 8 * fq;
                bf16_t* mp = merged + (size_t)row * D + u.pn * 256 + wc * 32 + 8 * fq;
#pragma unroll
                for (int bj = 0; bj < 2; ++bj)
#pragma unroll
                    for (int n = 0; n < 2; ++n) {
                        const u32x2 g = *(const u32x2*)(gp + bj * 128 + 4 * n);
                        u32x2 pm2 = {0u, 0u}; if (accum) pm2 = *(const u32x2*)(mp + bj * 128 + 4 * n);
                        const f32x4 v = acc[ai][bj][m][n];
                        const float r0 = sigmoidf_(bflo(g.x)) * v[0] + bflo(pm2.x), r1 = sigmoidf_(bfhi(g.x)) * v[1] + bfhi(pm2.x);
                        const float r2 = sigmoidf_(bflo(g.y)) * v[2] + bflo(pm2.y), r3 = sigmoidf_(bfhi(g.y)) * v[3] + bfhi(pm2.y);
                        u32x2 w; w.x = pk2(r0, r1); w.y = pk2(r2, r3);
                        *(u32x2*)(mp + bj * 128 + 4 * n) = w;
                        asm volatile("" ::: "memory");
                    }
            }
    }
};
struct EpiSwiglu {
    static constexpr bool PERM = true, AFTER_DRAIN = false;
    bf16_t* act;
    DI void operator()(AccRef acc, const pg8::Unit& u, int wr, int wc, int fr, int fq) const {
#pragma unroll
        for (int ai = 0; ai < 2; ++ai)
#pragma unroll
            for (int m = 0; m < 4; ++m) {
                const int row = u.pm * 256 + ai * 128 + wr * 64 + m * 16 + fr;
#pragma unroll
                for (int bj = 0; bj < 2; ++bj) {
                    const int col0 = u.pn * 256 + bj * 128 + wc * 32 + 8 * fq;
                    const f32x4 g = acc[ai][bj][m][0], up = acc[ai][bj][m][1];
                    float r[4];
#pragma unroll
                    for (int j = 0; j < 4; ++j) r[j] = g[j] * sigmoidf_(g[j]) * up[j];
                    u32x2 w; w.x = pk2(r[0], r[1]); w.y = pk2(r[2], r[3]);
                    *(u32x2*)(act + (size_t)row * FF + (col0 >> 1)) = w;
                }
            }
    }
};
struct MemKvOrder {
    int G, c; const char* A; const char* B;
    DI bool next(int i, pg8::Unit& u) const {
        const int L = i * G + c; if (L >= 256) return false;
        const int l = L >> 6, r = L & 63; u.pm = l * 8 + (r & 7); u.pn = l * 8 + (r >> 3);
        u.a = A + (size_t)u.pm * (256 * D * 2); u.b = B + (size_t)u.pn * (256 * D * 2); return true;
    }
    DI void a_ready(const pg8::Unit&) const {}
    DI void done(const pg8::Unit&) const {}
};
struct CrossOrder {
    int G, c; const char* A; const char* B; int mode;
    DI bool next(int i, pg8::Unit& u) const {
        const int L = i * G + c; if (L >= 256) return false;
        u.pm = L >> 2; u.pn = L & 3; const int b = u.pm >> 3, h = u.pn;
        u.a = A + ((size_t)u.pm * 256 * D + h * 256) * 2;
        u.b = mode == 0 ? B + ((size_t)b * 256 * 2048 + h * 256) * 2 : B + ((size_t)h * 256 * 2048 + b * 256) * 2;
        return true;
    }
    DI void a_ready(const pg8::Unit&) const {}
    DI void done(const pg8::Unit&) const {}
};
struct EpiSoftmax {
    static constexpr bool PERM = true, AFTER_DRAIN = false;
    bf16_t* P; LAS float* xs;
    DI void operator()(AccRef acc, const pg8::Unit& u, int wr, int wc, int fr, int fq) const {
        const float sc = 0.0625f * 1.4426950408889634f;
        LAS float* xm = xs; LAS float* xsum = xs + 1024;
#pragma unroll
        for (int ai = 0; ai < 2; ++ai)
#pragma unroll
            for (int m = 0; m < 4; ++m) {
                float a = -3.0e38f;
#pragma unroll
                for (int bj = 0; bj < 2; ++bj)
#pragma unroll
                    for (int n = 0; n < 2; ++n) { const f32x4 v = acc[ai][bj][m][n]; a = fmaxf(a, fmaxf(fmaxf(v[0], v[1]), fmaxf(v[2], v[3]))); }
                a = fmaxf(a, __shfl_xor(a, 16)); a = fmaxf(a, __shfl_xor(a, 32));
                if (fq == 0) xm[(ai * 128 + wr * 64 + m * 16 + fr) * 4 + wc] = a;
                asm volatile("" ::: "memory");
            }
        __syncthreads();
#pragma unroll
        for (int ai = 0; ai < 2; ++ai)
#pragma unroll
            for (int m = 0; m < 4; ++m) {
                const f32x4 t = *(LAS f32x4*)(xm + (ai * 128 + wr * 64 + m * 16 + fr) * 4); const float mx = fmaxf(fmaxf(t[0], t[1]), fmaxf(t[2], t[3])) * sc;
                float s = 0.f;
#pragma unroll
                for (int bj = 0; bj < 2; ++bj)
#pragma unroll
                    for (int n = 0; n < 2; ++n)
#pragma unroll
                        for (int j = 0; j < 4; ++j) s += __builtin_amdgcn_exp2f(acc[ai][bj][m][n][j] * sc - mx);
                s += __shfl_xor(s, 16); s += __shfl_xor(s, 32);
                if (fq == 0) xsum[(ai * 128 + wr * 64 + m * 16 + fr) * 4 + wc] = s;
                asm volatile("" ::: "memory");
            }
        __syncthreads();
#pragma unroll
        for (int ai = 0; ai < 2; ++ai)
#pragma unroll
            for (int m = 0; m < 4; ++m) {
                const f32x4 t = *(LAS f32x4*)(xm + (ai * 128 + wr * 64 + m * 16 + fr) * 4); const float mx = fmaxf(fmaxf(t[0], t[1]), fmaxf(t[2], t[3])) * sc;
                const f32x4 t2 = *(LAS f32x4*)(xsum + (ai * 128 + wr * 64 + m * 16 + fr) * 4); const float inv = __builtin_amdgcn_rcpf((t2[0] + t2[1]) + (t2[2] + t2[3]));
                bf16_t* rowp = P + (size_t)(u.pm * 256 + ai * 128 + wr * 64 + m * 16 + fr) * D + u.pn * 256 + wc * 32 + 8 * fq;
#pragma unroll
                for (int bj = 0; bj < 2; ++bj)
#pragma unroll
                    for (int n = 0; n < 2; ++n) {
                        const f32x4 v = acc[ai][bj][m][n];
                        u32x2 w; w.x = pk2(__builtin_amdgcn_exp2f(v[0] * sc - mx) * inv, __builtin_amdgcn_exp2f(v[1] * sc - mx) * inv); w.y = pk2(__builtin_amdgcn_exp2f(v[2] * sc - mx) * inv, __builtin_amdgcn_exp2f(v[3] * sc - mx) * inv);
                        *(u32x2*)(rowp + bj * 128 + 4 * n) = w;
                    }
                asm volatile("" ::: "memory");
            }
        __syncthreads();
    }
};

#define LDS_WAIT() asm volatile("s_waitcnt lgkmcnt(0)" ::: "memory")
DI void transpose_item(const float* W, int K, int N, int Npad, bf16_t* WT, int mode, LAS float* scr, int item, int lane) {
    const int nblk = Npad / 32, kb = item / nblk, nb = item % nblk, k0 = 64 * kb, n0 = 32 * nb;
    const int nn = n0 + (lane & 31); const bool ok = nn < N;
#pragma unroll 8
    for (int i = 0; i < 32; ++i) { const int kk = 2 * i + (lane >> 5); scr[kk * 33 + (lane & 31)] = ok ? W[(size_t)(k0 + kk) * N + nn] : 0.f; }
    LDS_WAIT(); asm volatile("" ::: "memory");
    const int c = lane & 7;
#pragma unroll
    for (int j = 0; j < 4; ++j) {
        const int n = (lane >> 3) + 8 * j; const LAS float* s = scr + (8 * c) * 33 + n;
        u32x4 o; o.x = pk2(s[0 * 33], s[1 * 33]); o.y = pk2(s[2 * 33], s[3 * 33]); o.z = pk2(s[4 * 33], s[5 * 33]); o.w = pk2(s[6 * 33], s[7 * 33]);
        int drow = n0 + n;
        if (mode == 1) { const int jj = drow >= FF ? drow - FF : drow, isu = drow >= FF ? 1 : 0; drow = (jj >> 2) * 8 + isu * 4 + (jj & 3); }
        *(u32x4*)(WT + (size_t)drow * K + k0 + 8 * c) = o;
    }
    LDS_WAIT(); asm volatile("" ::: "memory");
}

DI void norm_row(const float* xsrc, float* xdst, const bf16_t* y, const float* gpost, const float* gpre, bf16_t* h, int lane) {
    f32x4 v[4];
#pragma unroll
    for (int j = 0; j < 4; ++j) v[j] = *(const f32x4*)(xsrc + 4 * lane + 256 * j);
    if (y) {
        f32x4 yv[4]; float ss = 0.f;
#pragma unroll
        for (int j = 0; j < 4; ++j) { const u32x2 w = *(const u32x2*)(y + 4 * lane + 256 * j); yv[j] = (f32x4){bflo(w.x), bfhi(w.x), bflo(w.y), bfhi(w.y)}; ss += (yv[j][0] * yv[j][0] + yv[j][1] * yv[j][1]) + (yv[j][2] * yv[j][2] + yv[j][3] * yv[j][3]); }
        const float rs = rsqrtf(wave_sum(ss) * (1.f / D) + EPS);
#pragma unroll
        for (int j = 0; j < 4; ++j) { const f32x4 g = *(const f32x4*)(gpost + 4 * lane + 256 * j); v[j] = v[j] + yv[j] * rs * g; }
    }
#pragma unroll
    for (int j = 0; j < 4; ++j) *(f32x4*)(xdst + 4 * lane + 256 * j) = v[j];
    if (gpre) {
        float ss = 0.f;
#pragma unroll
        for (int j = 0; j < 4; ++j) ss += (v[j][0] * v[j][0] + v[j][1] * v[j][1]) + (v[j][2] * v[j][2] + v[j][3] * v[j][3]);
        const float rs = rsqrtf(wave_sum(ss) * (1.f / D) + EPS);
#pragma unroll
        for (int j = 0; j < 4; ++j) { const f32x4 g = *(const f32x4*)(gpre + 4 * lane + 256 * j); const f32x4 o = v[j] * rs * g; u32x2 w; w.x = pk2(o[0], o[1]); w.y = pk2(o[2], o[3]); *(u32x2*)(h + 4 * lane + 256 * j) = w; }
    }
}


DI void norm_phase(const Ctx& p, const float* gpost, const float* gpre, int G, int bx) {
    const int tid = pg8::tid_(), lane = tid & 63, wv = tid >> 6, gw = bx * NWAVES + wv, NGW = G * NWAVES;
    const bf16_t* Yb = (const bf16_t*)(p.ws + WS_Y); bf16_t* Hb = (bf16_t*)(p.ws + WS_H);
    for (int row = gw; row < MA; row += NGW) norm_row(p.out + (size_t)row * D, p.out + (size_t)row * D, Yb + (size_t)row * D, gpost, gpre, Hb + (size_t)row * D, lane);
}

DI void prologue(const Params& p, LAS unsigned char* lds) {
    const int tid = pg8::tid_(), lane = tid & 63, wv = tid >> 6;
    const int gw = blockIdx.x * NWAVES + wv, NGW = gridDim.x * NWAVES;
    LAS float* scr = (LAS float*)(lds + wv * 16384);
    unsigned char* ws = p.ws;
    constexpr int I0 = 3072, I1 = 192, I2 = 512, I3 = 2816, I4 = 1408, IPL = I0 + 2 * I1 + 5 * I2 + I3 + I4;
    for (int it = gw; it < 4 * IPL; it += NGW) {
        const int l = it / IPL; int r = it % IPL;
        if (r < I0) { transpose_item(p.in[I_WIN] + (size_t)l * D * NIN, D, NIN, NINP, (bf16_t*)(ws + WS_WIN + l * SZ_WIN), 0, scr, r, lane); continue; } r -= I0;
        if (r < I1) { transpose_item(p.in[I_WBA] + (size_t)l * 384 * D, 384, D, D, (bf16_t*)(ws + WS_WBA + l * SZ_WBA), 0, scr, r, lane); continue; } r -= I1;
        if (r < I1) { transpose_item(p.in[I_WBC] + (size_t)l * 384 * D, 384, D, D, (bf16_t*)(ws + WS_WBC + l * SZ_WBA), 0, scr, r, lane); continue; } r -= I1;
        if (r < I2) { transpose_item(p.in[I_WMIX] + (size_t)l * D * D, D, D, D, (bf16_t*)(ws + WS_WMIX + l * SZ_WSQ), 0, scr, r, lane); continue; } r -= I2;
        if (r < I2) { transpose_item(p.in[I_WXQ] + (size_t)l * D * D, D, D, D, (bf16_t*)(ws + WS_WXQ + l * SZ_WSQ), 0, scr, r, lane); continue; } r -= I2;
        if (r < I2) { transpose_item(p.in[I_WXO] + (size_t)l * D * D, D, D, D, (bf16_t*)(ws + WS_WXO + l * SZ_WSQ), 0, scr, r, lane); continue; } r -= I2;
        if (r < I2) { transpose_item(p.in[I_WXK] + (size_t)l * D * D, D, D, D, (bf16_t*)(ws + WS_WKV + l * SZ_WKV), 0, scr, r, lane); continue; } r -= I2;
        if (r < I2) { transpose_item(p.in[I_WXV] + (size_t)l * D * D, D, D, D, (bf16_t*)(ws + WS_WKV + l * SZ_WKV + SZ_WSQ), 0, scr, r, lane); continue; } r -= I2;
        if (r < I3) { transpose_item(p.in[I_WF1] + (size_t)l * D * FF2, D, FF2, FF2, (bf16_t*)(ws + WS_WF1 + l * SZ_WF1), 1, scr, r, lane); continue; } r -= I3;
        transpose_item(p.in[I_WF2] + (size_t)l * FF * D, FF, D, D, (bf16_t*)(ws + WS_WF2 + l * SZ_WF2), 0, scr, r, lane);
    }
    {
        const int gt = blockIdx.x * NTHR + tid, NT = gridDim.x * NTHR;
        for (int idx = gt; idx < 4 * 256 * 1024; idx += NT) {
            const int n = idx & 1023, k = (idx >> 10) & 255, l = idx >> 18, g = k >> 6, c = k & 63;
            const float* wp = p.in[I_WPOOL] + ((size_t)(l * 4 + g) * 64 + c) * 64; const float* sc = p.in[I_PSCALE] + l * 256 + g * 64;
            const float* wb = p.in[I_WBB] + ((size_t)l * 256 + g * 64) * D + n;
            float s = 0.f;
#pragma unroll 8
            for (int d = 0; d < 64; ++d) s += wp[d] * sc[d] * wb[(size_t)d * D];
            ((bf16_t*)(ws + WS_WBB + l * SZ_WBB))[(size_t)n * 256 + k] = f2bf(s);
        }
    }
    for (int row = gw; row < MA; row += NGW) {
        const float* src = row < MP ? p.in[I_XP] + (size_t)row * D : p.in[I_XS] + (size_t)(row - MP) * D;
        norm_row(src, p.out + (size_t)row * D, nullptr, nullptr, p.in[I_NMIXPRE], (bf16_t*)(ws + WS_H) + (size_t)row * D, lane);
    }
    for (int row = gw; row < NB * 256; row += NGW) {
        f32x4 v[4]; float ss = 0.f;
#pragma unroll
        for (int j = 0; j < 4; ++j) { v[j] = *(const f32x4*)(p.in[I_MEM] + (size_t)row * D + 4 * lane + 256 * j); ss += (v[j][0] * v[j][0] + v[j][1] * v[j][1]) + (v[j][2] * v[j][2] + v[j][3] * v[j][3]); }
        const float rs = rsqrtf(wave_sum(ss) * (1.f / D) + EPS);
        for (int l = 0; l < 4; ++l)
#pragma unroll
            for (int j = 0; j < 4; ++j) { const f32x4 g = *(const f32x4*)(p.in[I_MEMN] + l * D + 4 * lane + 256 * j); const f32x4 o = v[j] * rs * g; u32x2 w; w.x = pk2(o[0], o[1]); w.y = pk2(o[2], o[3]);
                *(u32x2*)((bf16_t*)(ws + WS_MN) + ((size_t)l * 2048 + row) * D + 4 * lane + 256 * j) = w; }
    }
}

#define MFMA32(a, b, c) __builtin_amdgcn_mfma_f32_32x32x16_bf16((a), (b), (c), 0, 0, 0)
#define MFMA16(a, b, c) __builtin_amdgcn_mfma_f32_16x16x32_bf16((a), (b), (c), 0, 0, 0)
DI void sb_prompt_unit(const Ctx& p, int b, int h, int qb, LAS unsigned char* lds) {
    const bf16_t* proj = (const bf16_t*)(p.ws + WS_PROJ);
    LAS unsigned short* KS = (LAS unsigned short*)lds;
    LAS unsigned short* VT = KS + 64 * 72;
    const int tid = pg8::tid_(), lane = tid & 63, wv = tid >> 6, hi = lane >> 5, c = lane & 31;
    const int q0 = qb * 256 + wv * 32, tq = q0 + c;
    const size_t rowbase = (size_t)b * SEQ;
    bf16x8 qf[4];
    {
        const bf16_t* qp = proj + (rowbase + tq) * NINP + C_QA + h * 64 + 8 * hi;
#pragma unroll
        for (int kk = 0; kk < 4; ++kk) qf[kk] = *(const bf16x8*)(qp + 16 * kk);
    }
    f32x16 o0, o1;
#pragma unroll
    for (int i = 0; i < 16; ++i) { o0[i] = 0.f; o1[i] = 0.f; }
    float R = 0.f;
    const bf16_t* kbase = proj + rowbase * NINP + C_KA + h * 64 + 8 * wv;
    const bf16_t* vbase = proj + rowbase * NINP + C_VA + h * 64 + 8 * wv;
    int jt = 4 * qb + 3;
    u32x4 kr = *(const u32x4*)(kbase + (size_t)(64 * jt + lane) * NINP), vr = *(const u32x4*)(vbase + (size_t)(64 * jt + lane) * NINP);
    for (; jt >= 0; --jt) {
        __syncthreads();
        *(LAS u32x4*)(KS + lane * 72 + 8 * wv) = kr;
#pragma unroll
        for (int i = 0; i < 4; ++i) { const unsigned w = vr[i]; VT[(8 * wv + 2 * i) * 72 + lane] = (unsigned short)(w & 0xffffu); VT[(8 * wv + 2 * i + 1) * 72 + lane] = (unsigned short)(w >> 16); }
        __syncthreads();
        if (jt > 0) { kr = *(const u32x4*)(kbase + (size_t)(64 * (jt - 1) + lane) * NINP); vr = *(const u32x4*)(vbase + (size_t)(64 * (jt - 1) + lane) * NINP); }
        if (64 * jt < q0 + 31) {
            f32x16 z[2];
#pragma unroll
            for (int kb = 0; kb < 2; ++kb) {
                f32x16 acc;
#pragma unroll
                for (int i = 0; i < 16; ++i) acc[i] = 0.f;
#pragma unroll
                for (int kk = 0; kk < 4; ++kk) { const bf16x8 a = *(const LAS bf16x8*)(KS + (32 * kb + c) * 72 + 16 * kk + 8 * hi); acc = MFMA32(a, qf[kk], acc); }
                z[kb] = acc;
            }
            f32x16 e[2]; float T[8];
            const int sbase = 64 * jt + 4 * hi;
#pragma unroll
            for (int kb = 0; kb < 2; ++kb)
#pragma unroll
                for (int g = 0; g < 4; ++g) {
                    float lf[4];
#pragma unroll
                    for (int j = 0; j < 4; ++j) {
                        const int r = 4 * g + j; const float zz = z[kb][r] * 0.125f; const bool valid = (sbase + 32 * kb + 8 * g + j) < tq;
                        const float sp = softplusf_(zz); lf[j] = valid ? -sp : 0.f; z[kb][r] = valid ? zz - sp : -1.0e30f;
                    }
                    e[kb][4 * g + 3] = 0.f; e[kb][4 * g + 2] = lf[3]; e[kb][4 * g + 1] = lf[3] + lf[2]; e[kb][4 * g + 0] = lf[3] + lf[2] + lf[1];
                    T[kb * 4 + g] = e[kb][4 * g + 0] + lf[0];
                }
            float Tp[8], X[8];
#pragma unroll
            for (int gi = 0; gi < 8; ++gi) Tp[gi] = __shfl_xor(T[gi], 32);
            X[7] = 0.f;
#pragma unroll
            for (int gi = 6; gi >= 0; --gi) X[gi] = X[gi + 1] + (T[gi + 1] + Tp[gi + 1]);
            const float total = X[0] + (T[0] + Tp[0]);
#pragma unroll
            for (int kb = 0; kb < 2; ++kb)
#pragma unroll
                for (int g = 0; g < 4; ++g) {
                    const int gi = kb * 4 + g; const float off = R + X[gi] + (hi == 0 ? Tp[gi] : 0.f);
#pragma unroll
                    for (int j = 0; j < 4; ++j) { const int r = 4 * g + j; z[kb][r] = __expf(z[kb][r] + off + e[kb][r]); }
                }
            R += total;
#pragma unroll
            for (int kb = 0; kb < 2; ++kb)
#pragma unroll
                for (int s2 = 0; s2 < 2; ++s2) {
                    u32x4 pw; pw.x = pk2(z[kb][8 * s2 + 0], z[kb][8 * s2 + 1]); pw.y = pk2(z[kb][8 * s2 + 2], z[kb][8 * s2 + 3]); pw.z = pk2(z[kb][8 * s2 + 4], z[kb][8 * s2 + 5]); pw.w = pk2(z[kb][8 * s2 + 6], z[kb][8 * s2 + 7]);
                    const bf16x8 pb = __builtin_bit_cast(bf16x8, pw);
                    const int ko = 32 * kb + 16 * s2 + 4 * hi;
                    { const s16x4 lo = *(const LAS s16x4*)(VT + c * 72 + ko), hh = *(const LAS s16x4*)(VT + c * 72 + ko + 8);
                      const bf16x8 va = __builtin_shufflevector(lo, hh, 0, 1, 2, 3, 4, 5, 6, 7); o0 = MFMA32(va, pb, o0); }
                    { const s16x4 lo = *(const LAS s16x4*)(VT + (c + 32) * 72 + ko), hh = *(const LAS s16x4*)(VT + (c + 32) * 72 + ko + 8);
                      const bf16x8 va = __builtin_shufflevector(lo, hh, 0, 1, 2, 3, 4, 5, 6, 7); o1 = MFMA32(va, pb, o1); }
                }
        }
    }
    bf16_t* op = (bf16_t*)(p.ws + WS_OA) + (rowbase + tq) * 384 + h * 64 + 4 * hi;
#pragma unroll
    for (int g = 0; g < 4; ++g) {
        u32x2 w; w.x = pk2(o0[4 * g], o0[4 * g + 1]); w.y = pk2(o0[4 * g + 2], o0[4 * g + 3]); *(u32x2*)(op + 8 * g) = w;
        w.x = pk2(o1[4 * g], o1[4 * g + 1]); w.y = pk2(o1[4 * g + 2], o1[4 * g + 3]); *(u32x2*)(op + 32 + 8 * g) = w;
    }
}

DI void sb_sample_unit(const Ctx& p, int l, int b, int h, LAS unsigned char* lds) {
    const bf16_t* proj = (const bf16_t*)(p.ws + WS_PROJ);
    LAS float* qs = (LAS float*)lds;
    LAS float* Z = qs + 1024;
    LAS float* RED = Z + 16 * 1056;
    const int tid = pg8::tid_(), lane = tid & 63, wv = tid >> 6;
    const size_t srow = (size_t)MP + b * 16;
    for (int i = tid; i < 1024; i += NTHR) qs[i] = bf2f(proj[(srow + (i >> 6)) * NINP + C_QA + h * 64 + (i & 63)]) * 0.125f;
    __syncthreads();
    {
        float a0[16], a1[16];
#pragma unroll
        for (int i = 0; i < 16; ++i) { a0[i] = 0.f; a1[i] = 0.f; }
        const float* k0p = p.in[I_CSK] + ((((size_t)l * DB + b) * PAST + tid) * 6 + h) * 64; const float* k1p = k0p + (size_t)512 * 6 * 64;
        for (int d4 = 0; d4 < 16; ++d4) {
            const f32x4 ka = *(const f32x4*)(k0p + 4 * d4), kb = *(const f32x4*)(k1p + 4 * d4);
#pragma unroll
            for (int i = 0; i < 16; ++i) { const f32x4 q = *(const LAS f32x4*)(qs + i * 64 + 4 * d4);
                a0[i] += (q[0] * ka[0] + q[1] * ka[1]) + (q[2] * ka[2] + q[3] * ka[3]); a1[i] += (q[0] * kb[0] + q[1] * kb[1]) + (q[2] * kb[2] + q[3] * kb[3]); }
        }
#pragma unroll
        for (int i = 0; i < 16; ++i) { Z[i * 1056 + tid] = a0[i]; Z[i * 1056 + tid + 512] = a1[i]; }
        if (tid < 256) {
            const int i = tid >> 4, j = tid & 15; const bf16_t* kp = proj + (srow + j) * NINP + C_KA + h * 64; float s = 0.f;
            for (int d = 0; d < 64; ++d) s += qs[i * 64 + d] * bf2f(kp[d]);
            Z[i * 1056 + 1024 + j] = s;
        }
    }
    __syncthreads();
    for (int qq = 0; qq < 2; ++qq) {
        const int i = 2 * wv + qq, lim = PAST + i; LAS float* zr = Z + i * 1056;
        const int st = 17 * lane, en = (st + 17 < 1040) ? st + 17 : 1040;
        float tot = 0.f;
        for (int s = st; s < en; ++s) if (s < lim) tot -= softplusf_(zr[s]);
        float incl = tot;
#pragma unroll
        for (int o = 1; o < 64; o <<= 1) { const float t = __shfl_down(incl, o); if (lane + o < 64) incl += t; }
        float run = incl - tot;
        for (int s = en - 1; s >= st; --s) {
            const float zz = zr[s]; float w = 0.f;
            if (s < lim) { const float sp = softplusf_(zz); w = __expf(zz - sp + run); run -= sp; }
            zr[s] = w;
        }
    }
    __syncthreads();
    {
        const int d = tid & 63, g = tid >> 6;
        float o[16];
#pragma unroll
        for (int i = 0; i < 16; ++i) o[i] = 0.f;
        const float* vp = p.in[I_CSV] + (((size_t)l * DB + b) * PAST * 6 + h) * 64 + d;
        for (int s = 130 * g; s < 130 * g + 130; ++s) {
            const float v = s < PAST ? vp[(size_t)s * 384] : bf2f(proj[(srow + (s - PAST)) * NINP + C_VA + h * 64 + d]);
#pragma unroll
            for (int i = 0; i < 16; ++i) o[i] += Z[i * 1056 + s] * v;
        }
#pragma unroll
        for (int i = 0; i < 16; ++i) RED[(g * 16 + i) * 64 + d] = o[i];
    }
    __syncthreads();
    for (int i = tid; i < 1024; i += NTHR) {
        const int qi = i >> 6, d = i & 63; float s = 0.f;
#pragma unroll
        for (int g = 0; g < 8; ++g) s += RED[(g * 16 + qi) * 64 + d];
        ((bf16_t*)(p.ws + WS_OA))[(srow + qi) * 384 + h * 64 + d] = f2bf(s);
    }
}

DI void pool_unit(const Ctx& p, int l, int unit) {
    const bf16_t* proj = (const bf16_t*)(p.ws + WS_PROJ); bf16_t* pooled = (bf16_t*)(p.ws + WS_POOLED);
    const int tid = pg8::tid_(), ch = tid & 255, w = 2 << (ch >> 6);
    for (int i = 0; i < 32; ++i) {
        const int row = unit * 64 + (tid >> 8) + 2 * i;
        float s = 0.f, cnt, u0;
        if (row < MP) {
            const int t = row & (SEQ - 1); const int n = (t + 1 < w) ? t + 1 : w; cnt = (float)n;
            const bf16_t* up = proj + (size_t)row * NINP + C_U + ch; u0 = bf2f(up[0]);
            for (int j = 0; j < n; ++j) s += bf2f(*(up - (size_t)j * NINP));
            if (t >= SEQ - 15) p.out[O_POOLP + ((size_t)(l * NB + (row >> 11)) * 15 + (t - (SEQ - 15))) * 256 + ch] = u0;
        } else {
            const int rs = row - MP, b = rs >> 4, t = rs & 15; cnt = (float)w;
            const bf16_t* up = proj + (size_t)row * NINP + C_U + ch; u0 = bf2f(up[0]);
            const float* hist = p.in[I_SPOOL] + ((size_t)(l * DB + b) * 15) * 256 + ch;
            for (int j = 0; j < w; ++j) { const int tt = t - j; s += tt >= 0 ? bf2f(*(up - (size_t)j * NINP)) : hist[(15 + tt) * 256]; }
            if (t >= 1) p.out[O_POOLS + ((size_t)(l * DB + b) * 15 + (t - 1)) * 256 + ch] = u0;
        }
        pooled[(size_t)row * 256 + ch] = f2bf(s / cnt - u0);
    }
}


DI void kvout_unit(const Ctx& p, int l, int unit) {
    const bf16_t* proj = (const bf16_t*)(p.ws + WS_PROJ);
    for (int i = pg8::tid_(); i < 64 * 96; i += NTHR) {
        const int r = i / 96, ch = i % 96, row = unit * 64 + r;
        const u32x4 w = *(const u32x4*)(proj + (size_t)row * NINP + C_KA + 8 * ch);
        const bool isv = ch >= 48; const int c = 8 * (isv ? ch - 48 : ch);
        float* dst = (row < MP) ? p.out + (isv ? O_VP : O_KP) + ((size_t)l * MP + row) * 384 + c : p.out + (isv ? O_VS : O_KS) + ((size_t)l * MS + (row - MP)) * 384 + c;
        *(f32x4*)dst = (f32x4){bflo(w.x), bfhi(w.x), bflo(w.y), bfhi(w.y)}; *(f32x4*)(dst + 4) = (f32x4){bflo(w.z), bfhi(w.z), bflo(w.w), bfhi(w.w)};
    }
}
DI void memout_unit(const Ctx& p, int unit) {
    const bf16_t* mkv = (const bf16_t*)(p.ws + WS_MKV);
    for (int i = pg8::tid_(); i < 16 * 256; i += NTHR) {
        const int r = i >> 8, ch = i & 255, row = unit * 16 + r, col = 8 * ch;
        const u32x4 w = *(const u32x4*)(mkv + (size_t)row * 2048 + col);
        float* dst = p.out + (col >= 1024 ? O_MVP : O_MKP) + (size_t)row * D + (col & 1023);
        *(f32x4*)dst = (f32x4){bflo(w.x), bfhi(w.x), bflo(w.y), bfhi(w.y)}; *(f32x4*)(dst + 4) = (f32x4){bflo(w.z), bfhi(w.z), bflo(w.w), bfhi(w.w)};
    }
}
DI void memvt_unit(const Ctx& p, int unit) {
    const int l = unit >> 7, nb = (unit >> 3) & 15, b = unit & 7, tid = pg8::tid_(), n = nb * 64 + (tid & 63), wv = tid >> 6;
    const bf16_t* src = (const bf16_t*)(p.ws + WS_MKV) + ((size_t)l * 2048 + b * 256) * 2048 + 1024 + n;
    bf16_t* dst = (bf16_t*)(p.ws + WS_MEMVT) + ((size_t)l * 1024 + n) * 2048 + b * 256;
    for (int c = wv; c < 32; c += 8) {
        unsigned v[8];
#pragma unroll
        for (int j = 0; j < 8; ++j) v[j] = src[(size_t)(8 * c + j) * 2048];
        u32x4 w; w.x = v[0] | (v[1] << 16); w.y = v[2] | (v[3] << 16); w.z = v[4] | (v[5] << 16); w.w = v[6] | (v[7] << 16);
        *(u32x4*)(dst + 8 * c) = w;
    }
}

DI void gla_decay(const Ctx& p, int l, int h, size_t row0, int ntok, LAS unsigned char* lds) {
    const bf16_t* proj = (const bf16_t*)(p.ws + WS_PROJ);
    LAS float* Bc = (LAS float*)lds; LAS float* LR = (LAS float*)(lds + 24576); LAS float* A2 = (LAS float*)(lds + 28672); LAS float* BIA = (LAS float*)(lds + 34816); LAS float* SEG = (LAS float*)(lds + 35200);
    const int tid = pg8::tid_();
    for (int i = tid; i < 64 * 16; i += NTHR) { const int t = i >> 4, r = i & 15; LR[i] = t < ntok ? bf2f(proj[(row0 + t) * NINP + C_LR + r]) : 0.f; }
    for (int i = tid; i < 16 * 96; i += NTHR) { const int r = i / 96, k = i % 96; A2[i] = p.in[I_WA2][((size_t)l * 16 + r) * 384 + h * 96 + k]; }
    if (tid < 96) BIA[tid] = p.in[I_BA][l * 384 + h * 96 + tid];
    __syncthreads();
    for (int i = tid; i < 64 * 96; i += NTHR) {
        const int t = i / 96, k = i % 96; float s = BIA[k];
#pragma unroll
        for (int r = 0; r < 16; ++r) s += LR[t * 16 + r] * A2[r * 96 + k];
        Bc[i] = t < ntok ? -softplusf_(-s) * (1.f / 16.f) : 0.f;
    }
    __syncthreads();
    const int k = tid % 96, seg = tid / 96;
    if (tid < 384) { float run = 0.f; for (int i = 0; i < 16; ++i) { const int idx = (16 * seg + i) * 96 + k; run += Bc[idx]; Bc[idx] = run; } SEG[seg * 96 + k] = run; }
    __syncthreads();
    if (tid < 384 && seg > 0) { float off = 0.f; for (int s2 = 0; s2 < seg; ++s2) off += SEG[s2 * 96 + k]; for (int i = 0; i < 16; ++i) Bc[(16 * seg + i) * 96 + k] += off; }
    __syncthreads();
}
DI void gla_unit_rows(int gu, size_t& row0, int& ntok, int& bh, int& h) {
    if (gu < NGU_P) { bh = gu >> 5; const int c = gu & 31, b = bh >> 2; h = bh & 3; row0 = (size_t)b * SEQ + c * 64; ntok = 64; }
    else { bh = gu - NGU_P; const int b = bh >> 2; h = bh & 3; row0 = (size_t)MP + b * 16; ntok = 16; }
}
DI void gla_stage1_unit(const Ctx& p, int l, int gu, LAS unsigned char* lds) {
    const bf16_t* proj = (const bf16_t*)(p.ws + WS_PROJ);
    size_t row0; int ntok, bh, h; gla_unit_rows(gu, row0, ntok, bh, h);
    gla_decay(p, l, h, row0, ntok, lds);
    LAS float* Bc = (LAS float*)lds;
    LAS unsigned short* KT = (LAS unsigned short*)(lds + 36864);
    LAS unsigned short* VT = KT + 96 * 72;
    const int tid = pg8::tid_(), lane = tid & 63, wv = tid >> 6, fr = lane & 15, fq = lane >> 4;
    for (int i = tid; i < 64 * 96; i += NTHR) {
        const int t = i / 96, k = i % 96; float kv = 0.f, vv = 0.f;
        if (t < ntok) { const bf16_t* rp = proj + (row0 + t) * NINP + h * 96 + k; kv = bf2f(rp[C_KC]) * __expf(Bc[(ntok - 1) * 96 + k] - Bc[t * 96 + k]); vv = bf2f(rp[C_VC]); }
        KT[k * 72 + t] = f2bf(kv); VT[k * 72 + t] = f2bf(vv);
    }
    if (tid < 96) ((float*)(p.ws + WS_GDEC))[(size_t)gu * 96 + tid] = __expf(Bc[(ntok - 1) * 96 + tid]);
    __syncthreads();
    float* KV = (float*)(p.ws + WS_GKV) + (size_t)gu * (GK * GK);
    for (int tile = wv; tile < 36; tile += 8) {
        const int ki = tile / 6, vi = tile % 6; f32x4 acc = {0.f, 0.f, 0.f, 0.f};
#pragma unroll
        for (int ks = 0; ks < 2; ++ks) { const bf16x8 a = *(const LAS bf16x8*)(KT + (16 * ki + fr) * 72 + 32 * ks + 8 * fq), bb = *(const LAS bf16x8*)(VT + (16 * vi + fr) * 72 + 32 * ks + 8 * fq); acc = MFMA16(a, bb, acc); }
#pragma unroll
        for (int j = 0; j < 4; ++j) KV[(16 * ki + 4 * fq + j) * 96 + 16 * vi + fr] = acc[j];
    }
}
DI void gla_scan(const Ctx& p, int l) {
    const int gt = blockIdx.x * NTHR + pg8::tid_(), NT = gridDim.x * NTHR;
    const float* KV = (const float*)(p.ws + WS_GKV); const float* DEC = (const float*)(p.ws + WS_GDEC); float* SP = (float*)(p.ws + WS_GSP);
    for (int e = gt; e < 32 * GK * GK; e += NT) {
        const int bh = e / (GK * GK), kv = e % (GK * GK), k = kv / GK; float S = 0.f;
#pragma unroll 4
        for (int c = 0; c < 32; ++c) { const size_t gu = (size_t)bh * 32 + c; SP[gu * (GK * GK) + kv] = S; S = DEC[gu * 96 + k] * S + KV[gu * (GK * GK) + kv]; }
        p.out[O_GLAP + ((size_t)l * 32 + bh) * (GK * GK) + kv] = S;
    }
    for (int e = gt; e < 64 * GK * GK; e += NT) {
        const int bh = e / (GK * GK), kv = e % (GK * GK), k = kv / GK; const size_t gu = (size_t)NGU_P + bh;
        const float S0 = p.in[I_SGLA][((size_t)l * 64 + bh) * (GK * GK) + kv];
        p.out[O_GLAS + ((size_t)l * 64 + bh) * (GK * GK) + kv] = DEC[gu * 96 + k] * S0 + KV[gu * (GK * GK) + kv];
    }
}
DI void gla_stage3_unit(const Ctx& p, int l, int gu, LAS unsigned char* lds) {
    const bf16_t* proj = (const bf16_t*)(p.ws + WS_PROJ);
    size_t row0; int ntok, bh, h; gla_unit_rows(gu, row0, ntok, bh, h);
    gla_decay(p, l, h, row0, ntok, lds);
    LAS float* Bc = (LAS float*)lds;
    LAS unsigned short* QP = (LAS unsigned short*)(lds + 36864);
    LAS unsigned short* KP = QP + 64 * 104;
    LAS unsigned short* VT = KP + 64 * 104;
    LAS unsigned short* ST = VT + 96 * 72;
    LAS unsigned short* ATT = ST + 96 * 104;
    const int tid = pg8::tid_(), lane = tid & 63, wv = tid >> 6, fr = lane & 15, fq = lane >> 4;
    const float* Sprev = gu < NGU_P ? (const float*)(p.ws + WS_GSP) + (size_t)gu * (GK * GK) : p.in[I_SGLA] + ((size_t)l * 64 + bh) * (GK * GK);
    for (int i = tid; i < 64 * 96; i += NTHR) {
        const int t = i / 96, k = i % 96; float qv = 0.f, kv = 0.f, vv = 0.f;
        if (t < ntok) { const bf16_t* rp = proj + (row0 + t) * NINP + h * 96 + k; const float bb = Bc[i];
            qv = bf2f(rp[C_QC]) * 0.10206207261596575f * __expf(bb); kv = bf2f(rp[C_KC]) * __expf(-bb); vv = bf2f(rp[C_VC]); }
        QP[t * 104 + k] = f2bf(qv); KP[t * 104 + k] = f2bf(kv); VT[k * 72 + t] = f2bf(vv);
    }
    for (int i = tid; i < 96 * 96; i += NTHR) { const int k = i / 96, v = i % 96; ST[v * 104 + k] = f2bf(Sprev[i]); }
    __syncthreads();
    for (int tile = 2 * wv; tile < 2 * wv + 2; ++tile) {
        const int ti = tile >> 2, si = tile & 3; f32x4 acc = {0.f, 0.f, 0.f, 0.f};
        if (si <= ti) {
#pragma unroll
            for (int ks = 0; ks < 3; ++ks) { const bf16x8 a = *(const LAS bf16x8*)(QP + (16 * ti + fr) * 104 + 32 * ks + 8 * fq), bb = *(const LAS bf16x8*)(KP + (16 * si + fr) * 104 + 32 * ks + 8 * fq); acc = MFMA16(a, bb, acc); }
        }
#pragma unroll
        for (int j = 0; j < 4; ++j) { const int t = 16 * ti + 4 * fq + j, s = 16 * si + fr; ATT[t * 72 + s] = f2bf(s <= t ? acc[j] : 0.f); }
    }
    __syncthreads();
    LAS float* OT = Bc;
    for (int tile = wv; tile < 24; tile += 8) {
        const int ti = tile / 6, vi = tile % 6; f32x4 acc = {0.f, 0.f, 0.f, 0.f};
#pragma unroll
        for (int ks = 0; ks < 2; ++ks) { const bf16x8 a = *(const LAS bf16x8*)(ATT + (16 * ti + fr) * 72 + 32 * ks + 8 * fq), bb = *(const LAS bf16x8*)(VT + (16 * vi + fr) * 72 + 32 * ks + 8 * fq); acc = MFMA16(a, bb, acc); }
#pragma unroll
        for (int ks = 0; ks < 3; ++ks) { const bf16x8 a = *(const LAS bf16x8*)(QP + (16 * ti + fr) * 104 + 32 * ks + 8 * fq), bb = *(const LAS bf16x8*)(ST + (16 * vi + fr) * 104 + 32 * ks + 8 * fq); acc = MFMA16(a, bb, acc); }
#pragma unroll
        for (int j = 0; j < 4; ++j) OT[(16 * ti + 4 * fq + j) * 96 + 16 * vi + fr] = acc[j];
    }
    __syncthreads();
    bf16_t* oc = (bf16_t*)(p.ws + WS_OC);
    for (int tt = 0; tt < 8; ++tt) {
        const int t = wv * 8 + tt; if (t >= ntok) break;
        const float a0 = OT[t * 96 + lane], a1 = lane < 32 ? OT[t * 96 + 64 + lane] : 0.f;
        const float rs = rsqrtf(wave_sum(a0 * a0 + a1 * a1) * (1.f / 96.f) + EPS);
        const bf16_t* gp = proj + (row0 + t) * NINP + C_GC + h * 96; const float* gn = p.in[I_GLAN] + l * 384 + h * 96;
        { const float g = bf2f(gp[lane]); oc[(row0 + t) * 384 + h * 96 + lane] = f2bf(a0 * rs * gn[lane] * g * sigmoidf_(g)); }
        if (lane < 32) { const float g = bf2f(gp[64 + lane]); oc[(row0 + t) * 384 + h * 96 + 64 + lane] = f2bf(a1 * rs * gn[64 + lane] * g * sigmoidf_(g)); }
    }
}

DI void cross_sample_unit(const Ctx& p, int l, int b, int h, LAS unsigned char* lds) {
    LAS float* qs = (LAS float*)lds;
    LAS float* S = qs + 16 * 256;
    LAS float* PART = S + 16 * 260;
    const bf16_t* Q = (const bf16_t*)(p.ws + WS_Q);
    const int tid = pg8::tid_(), lane = tid & 63, wv = tid >> 6;
    const size_t srow = (size_t)MP + b * 16;
    for (int i = tid; i < 16 * 256; i += NTHR) qs[i] = bf2f(Q[(srow + (i >> 8)) * D + h * 256 + (i & 255)]) * 0.0625f;
    __syncthreads();
    const int m = tid & 255, half = tid >> 8;
    {
        float acc[16];
#pragma unroll
        for (int i = 0; i < 16; ++i) acc[i] = 0.f;
        const float* kp = p.in[I_CMK] + ((((size_t)l * DB + b) * 256 + m) * 4 + h) * 256 + 128 * half;
        for (int d4 = 0; d4 < 32; ++d4) {
            const f32x4 kv = *(const f32x4*)(kp + 4 * d4);
#pragma unroll
            for (int i = 0; i < 16; ++i) { const f32x4 q = *(const LAS f32x4*)(qs + i * 256 + 128 * half + 4 * d4); acc[i] += (q[0] * kv[0] + q[1] * kv[1]) + (q[2] * kv[2] + q[3] * kv[3]); }
        }
#pragma unroll
        for (int i = 0; i < 16; ++i) PART[(half * 16 + i) * 256 + m] = acc[i];
    }
    __syncthreads();
    for (int qq = 0; qq < 2; ++qq) {
        const int i = 2 * wv + qq; float v[4], mx = -3.0e38f;
#pragma unroll
        for (int j = 0; j < 4; ++j) { v[j] = PART[i * 256 + lane + 64 * j] + PART[(16 + i) * 256 + lane + 64 * j]; mx = fmaxf(mx, v[j]); }
        mx = wave_max(mx); float sum = 0.f;
#pragma unroll
        for (int j = 0; j < 4; ++j) { v[j] = __expf(v[j] - mx); sum += v[j]; }
        sum = wave_sum(sum); const float inv = 1.f / sum;
#pragma unroll
        for (int j = 0; j < 4; ++j) S[i * 260 + lane + 64 * j] = v[j] * inv;
    }
    __syncthreads();
    {
        float acc[16];
#pragma unroll
        for (int i = 0; i < 16; ++i) acc[i] = 0.f;
        const float* vp = p.in[I_CMV] + ((((size_t)l * DB + b) * 256 + 128 * half) * 4 + h) * 256 + m;
        for (int kk = 0; kk < 128; ++kk) {
            const float v = vp[(size_t)kk * 1024];
#pragma unroll
            for (int i = 0; i < 16; ++i) acc[i] += S[i * 260 + 128 * half + kk] * v;
        }
#pragma unroll
        for (int i = 0; i < 16; ++i) PART[(half * 16 + i) * 256 + m] = acc[i];
    }
    __syncthreads();
    bf16_t* O = (bf16_t*)(p.ws + WS_O);
    for (int i = tid; i < 16 * 256; i += NTHR) { const int qi = i >> 8, d = i & 255; O[(srow + qi) * D + h * 256 + d] = f2bf(PART[qi * 256 + d] + PART[(16 + qi) * 256 + d]); }
}

constexpr int PH_PER_LAYER = 15, N_PHASES = 1 + DEPTH * PH_PER_LAYER;
#define RUN_GEMM(EpiT, E, Aptr, lda_, Bptr, ldb_, K_, pm0_, nM_, nN_) do { const pg8::Gemm g_{(K_), (lda_), (ldb_)}; pg8::TileOrder S_; S_.init((Aptr), (lda_), (Bptr), (ldb_), (pm0_), (nM_), (nN_), G, bx); \
        pg8::gemm_phase<EpiT, pg8::TileOrder, true, true>(lds, g_, S_, (E)); } while (0)

__global__ void __launch_bounds__(NTHR, 2) fwd_kernel(Params p) {
    extern __shared__ __attribute__((aligned(16))) unsigned char lds_raw[];
#define PROJ ((bf16_t*)(ws + WS_PROJ))
#define H ((bf16_t*)(ws + WS_H))
#define MERGED ((bf16_t*)(ws + WS_MERGED))
#define Y ((bf16_t*)(ws + WS_Y))
#define QB ((bf16_t*)(ws + WS_Q))
#define PB ((bf16_t*)(ws + WS_P))
#define OB ((bf16_t*)(ws + WS_O))
#define ACT ((bf16_t*)(ws + WS_ACT))

    if (p.ph_lo == 0) {
        prologue(p, (LAS unsigned char*)lds_raw);
        if (blockIdx.x == 0 && pg8::tid_() == 0) {
            const float** tab = (const float**)(p.ws + WS_TAB);
#pragma unroll
            for (int i = 0; i < N_IN; ++i) tab[i] = p.in[i];
        }
        if (p.ph_hi > 1) cg::this_grid().sync();
    }
    for (int ph = p.ph_lo > 1 ? p.ph_lo : 1; ph < p.ph_hi; ++ph) {
        unsigned ldsb = (unsigned)(size_t)(LAS unsigned char*)lds_raw; asm volatile("" : "+s"(ldsb));
        LAS unsigned char* lds = (LAS unsigned char*)(size_t)ldsb;
        volatile LAS int* slot = (volatile LAS int*)(lds + LDS_MISC);
        unsigned char* ws = p.ws; asm volatile("" : "+s"(ws));
        Ctx c; c.ws = ws; c.in.t = (const float* const*)(ws + WS_TAB); c.out = p.out;
        unsigned* ctl = (unsigned*)(ws + WS_CTL);
        int G = gridDim.x, bx = blockIdx.x; asm volatile("" : "+s"(G), "+s"(bx));
        {
            const int l = (ph - 1) / PH_PER_LAYER, st = (ph - 1) % PH_PER_LAYER;
            switch (st) {
            case 0: {
                EpiBf16 E{PROJ, NINP, 0xffff};
                RUN_GEMM(EpiBf16, E, H, D, ws + WS_WIN + l * SZ_WIN, D, D, 0, MA / 256, NINP / 256);
                if (l == 0) {
                    const pg8::Gemm g{D, D, D}; MemKvOrder S{G, bx, (const char*)(ws + WS_MN), (const char*)(ws + WS_WKV)};
                    EpiBf16 E2{(bf16_t*)(ws + WS_MKV), 2048, 7};
                    pg8::gemm_phase<EpiBf16, MemKvOrder, true, true>(lds, g, S, E2);
                }
            } break;
            case 1: {
                unsigned* ctr = ctl + 64 * ph;
                constexpr int U_SBP = 384, U_SBS = U_SBP + DB * 6, U_GLA = U_SBS + NGU, U_POOL = U_GLA + MA / 64, U_KV = U_POOL + MA / 64, U_MO = U_KV + 512, U_VT = U_MO + 512;
                const int U_ALL = l == 0 ? U_VT : U_KV;
                for (;;) {
                    const int u = next_work(ctr, slot); if (u >= U_ALL) break;
                    if (u < U_SBP) { const int qb = 7 - u / 48, bh = u % 48; sb_prompt_unit(c, bh / 6, bh % 6, qb, lds); }
                    else if (u < U_SBS) { const int v = u - U_SBP; sb_sample_unit(c, l, v / 6, v % 6, lds); }
                    else if (u < U_GLA) gla_stage1_unit(c, l, u - U_SBS, lds);
                    else if (u < U_POOL) pool_unit(c, l, u - U_GLA);
                    else if (u < U_KV) kvout_unit(c, l, u - U_POOL);
                    else if (u < U_MO) memout_unit(c, u - U_KV);
                    else memvt_unit(c, u - U_MO);
                }
            } break;
            case 2: gla_scan(c, l); break;
            case 3: {
                unsigned* ctr = ctl + 64 * ph;
                for (;;) { const int u = next_work(ctr, slot); if (u >= NGU) break; gla_stage3_unit(c, l, u, lds); }
            } break;
            case 4: {
                EpiGate E1{MERGED, PROJ, C_GA, 0}, E2{MERGED, PROJ, C_GB, 1}, E3{MERGED, PROJ, C_GCG, 1};
                RUN_GEMM(EpiGate, E1, ws + WS_OA, 384, ws + WS_WBA + l * SZ_WBA, 384, 384, 0, MA / 256, 4);
                RUN_GEMM(EpiGate, E2, ws + WS_POOLED, 256, ws + WS_WBB + l * SZ_WBB, 256, 256, 0, MA / 256, 4);
                RUN_GEMM(EpiGate, E3, ws + WS_OC, 384, ws + WS_WBC + l * SZ_WBA, 384, 384, 0, MA / 256, 4);
            } break;
            case 5: { EpiBf16 E{Y, D, 0xffff}; RUN_GEMM(EpiBf16, E, MERGED, D, ws + WS_WMIX + l * SZ_WSQ, D, D, 0, MA / 256, 4); } break;
            case 6: norm_phase(c, c.in[I_NMIXPOST] + l * D, c.in[I_NXPRE] + l * D, G, bx); break;
            case 7: { EpiBf16 E{QB, D, 0xffff}; RUN_GEMM(EpiBf16, E, H, D, ws + WS_WXQ + l * SZ_WSQ, D, D, 0, MA / 256, 4); } break;
            case 8: {
                const pg8::Gemm g{256, D, 2048}; CrossOrder S{G, bx, (const char*)QB, (const char*)(ws + WS_MKV + (size_t)l * 2 * SZ_WKV), 0};
                EpiSoftmax E{PB, (LAS float*)(lds + LDS_X)};
                pg8::gemm_phase<EpiSoftmax, CrossOrder, true, true>(lds, g, S, E);
            } break;
            case 9: {
                const pg8::Gemm g{256, D, 2048}; CrossOrder S{G, bx, (const char*)PB, (const char*)(ws + WS_MEMVT + (size_t)l * SZ_WKV), 1};
                EpiBf16 E{OB, D, 0xffff};
                pg8::gemm_phase<EpiBf16, CrossOrder, true, true>(lds, g, S, E);
                for (int u = bx; u < DB * 4; u += G) { __syncthreads(); cross_sample_unit(c, l, u >> 2, u & 3, lds); }
            } break;
            case 10: { EpiBf16 E{Y, D, 0xffff}; RUN_GEMM(EpiBf16, E, OB, D, ws + WS_WXO + l * SZ_WSQ, D, D, 0, MA / 256, 4); } break;
            case 11: norm_phase(c, c.in[I_NXPOST] + l * D, c.in[I_NFPRE] + l * D, G, bx); break;
            case 12: { EpiSwiglu E{ACT}; RUN_GEMM(EpiSwiglu, E, H, D, ws + WS_WF1 + l * SZ_WF1, D, D, 0, MA / 256, FF2 / 256); } break;
            case 13: { EpiBf16 E{Y, D, 0xffff}; RUN_GEMM(EpiBf16, E, ACT, FF, ws + WS_WF2 + l * SZ_WF2, FF, FF, 0, MA / 256, 4); } break;
            default: norm_phase(c, c.in[I_NFPOST] + l * D, l < DEPTH - 1 ? c.in[I_NMIXPRE] + (l + 1) * D : nullptr, G, bx); break;
            }
        }
        if (ph + 1 < p.ph_hi) { if ((ph - 1) % PH_PER_LAYER == 8) { __threadfence(); __syncthreads(); } else cg::this_grid().sync(); }
    }
}

extern "C" void kernel_launch(void* const* d_in, const int* in_sizes, int n_in, void* d_out, int out_size, void* d_ws, size_t ws_size, hipStream_t stream) {
    static int grid = 0;
    if (grid == 0) {
        if (n_in != N_IN || (size_t)out_size != O_END || ws_size < WS_END) { fprintf(stderr, "kernel_launch: unexpected shapes: n_in %d out %d ws %zu (need %zu)\n", n_in, out_size, ws_size, (size_t)WS_END); grid = -1; return; }
        int dev = 0, cus = 0, per_cu = 0;
        (void)hipGetDevice(&dev); (void)hipDeviceGetAttribute(&cus, hipDeviceAttributeMultiprocessorCount, dev);
        (void)hipFuncSetAttribute((const void*)fwd_kernel, hipFuncAttributeMaxDynamicSharedMemorySize, LDS_BYTES);
        if (hipOccupancyMaxActiveBlocksPerMultiprocessor(&per_cu, (const void*)fwd_kernel, NTHR, LDS_BYTES) != hipSuccess || per_cu < 1) { fprintf(stderr, "kernel_launch: occupancy query gave %d\n", per_cu); per_cu = 1; }
        (void)hipGetLastError();
        grid = cus * per_cu;
    }
    if (grid < 0) return;
    (void)hipMemsetAsync((char*)d_ws + WS_CTL, 0, CTL_BYTES, stream);
    Params p{};
    for (int i = 0; i < N_IN; ++i) p.in[i] = (const float*)d_in[i];
    p.out = (float*)d_out; p.ws = (unsigned char*)d_ws;
#ifdef MULTI_LAUNCH
    for (int ph = 0; ph < N_PHASES; ++ph) { p.ph_lo = ph; p.ph_hi = ph + 1; hipLaunchKernelGGL(fwd_kernel, dim3(grid), dim3(NTHR), LDS_BYTES, stream, p); }
#else
    p.ph_lo = 0; p.ph_hi = N_PHASES;
    void* args[] = {&p};
    const hipError_t e = hipLaunchCooperativeKernel((const void*)fwd_kernel, dim3(grid), dim3(NTHR), args, LDS_BYTES, stream);
    if (e != hipSuccess) fprintf(stderr, "kernel_launch: cooperative launch failed: %s (grid %d)\n", hipGetErrorString(e), grid);
#endif
}
```

```cpp
#include <hip/hip_runtime.h>
#include <hip/hip_cooperative_groups.h>
#include <cstdio>
#include <cstdint>
namespace cg = cooperative_groups;

namespace pg8 {
#define PG8_LAS __attribute__((address_space(3)))
typedef unsigned short bf16_t;
typedef short bf16x8 __attribute__((ext_vector_type(8)));
typedef float f32x4 __attribute__((ext_vector_type(4)));
typedef unsigned u32x4 __attribute__((ext_vector_type(4)));
typedef unsigned u32x2 __attribute__((ext_vector_type(2)));
constexpr int BM = 256, BK = 64, HALF = 128, HTB = HALF * BK * 2  , STAGE_BYTES = 8 * HTB, NXCD = 8, WGM = 8;

__host__ __device__ __forceinline__ int lds_byte(int r, int c) { const int st = (r >> 4) * 2 + (c >> 5), rr = r & 15, cc = c & 31, ob = rr * 64 + cc * 2; return st * 1024 + (ob ^ (((ob >> 9) & 1) << 5)); }
__host__ __device__ __forceinline__ void stage_rc(int b, int& R, int& C) { const int st = b / 1024, sb = b % 1024, swz = sb ^ (((sb >> 9) & 1) << 5); R = (st >> 1) * 16 + swz / 64; C = (st & 1) * 32 + (swz % 64) / 2; }
__host__ __device__ __forceinline__ int perm32(int rho) { const int n = rho >> 4, i = rho & 15; return 8 * (i >> 2) + 4 * n + (i & 3); }

struct Unit { int pm, pn; const char* a; const char* b; };
struct Gemm { int K, lda, ldb; };

struct TileOrder {
    int nM, nN, G, c, lda, ldb; const char* A; const char* B;
    __device__ void init(const void* A_, int lda_, const void* B_, int ldb_, int, int nM_, int nN_, int G_, int c_) {
        A = (const char*)A_; B = (const char*)B_; lda = lda_; ldb = ldb_; nM = nM_; nN = nN_; G = G_; c = c_; }
    __device__ bool next(int i, Unit& u) const {
        const int nwg = nM * nN; const long L = (long)i * G + c; if (L >= nwg) return false;
        int wgid = (int)L; { const int q = nwg / NXCD, r = nwg % NXCD, xcd = wgid % NXCD, off = wgid / NXCD; wgid = (xcd < r ? xcd * (q + 1) : r * (q + 1) + (xcd - r) * q) + off; }
        const int nig = WGM * nN, gid = wgid / nig, fm = gid * WGM, gsz = (nM - fm) < WGM ? (nM - fm) : WGM;
        u.pm = fm + ((wgid % nig) % gsz); u.pn = (wgid % nig) / gsz; u.a = A + (size_t)u.pm * ((size_t)BM * 2 * lda); u.b = B + (size_t)u.pn * ((size_t)BM * 2 * ldb); return true;
    }
    __device__ __forceinline__ void a_ready(const Unit&) const {}
    __device__ __forceinline__ void done(const Unit&) const {}
};

__device__ __forceinline__ int tid_() { int t = threadIdx.x; asm volatile("" : "+v"(t)); return t; }
__device__ __forceinline__ unsigned cvt_pk_bf16(float lo, float hi) { unsigned r; asm volatile("v_cvt_pk_bf16_f32 %0, %1, %2" : "=v"(r) : "v"(lo), "v"(hi)); return r; }

template <class Epi, class Sched, bool ALIGN_EPI = false, bool SP2 = false>
__device__ __forceinline__ void gemm_phase(PG8_LAS unsigned char* lds, const Gemm g, const Sched& S, const Epi& E) {
    const int tid = pg8::tid_(), wid = __builtin_amdgcn_readfirstlane(tid >> 6), lane = tid & 63, wr = wid >> 2, wc = wid & 3, fr = lane & 15, fq = lane >> 4;
    const int K = g.K, nt = K / BK;
    unsigned voffA, voffB;
    { int R, C; stage_rc(tid * 16, R, C); const int Rb = Epi::PERM ? ((R & ~31) + perm32(R & 31)) : R;
        voffA = (unsigned)(R * g.lda + C) * 2u; voffB = (unsigned)(Rb * g.ldb + C) * 2u; }
    const size_t qstepA = (size_t)64 * g.lda * 2, qstepB = (size_t)64 * g.ldb * 2;
    const size_t kstep = (size_t)(BK * 2);
    const size_t hstepA = (size_t)HALF * g.lda * 2, hstepB = (size_t)HALF * g.ldb * 2;
    const unsigned ldsw = (unsigned)wid * 1024u;
    const int aoff = lds_byte(wr * 64 + fr, fq * 8), boff = lds_byte(wc * 32 + fr, fq * 8);
#define PG8_SA(b, h) (((b) * 2 + (h)) * HTB)
#define PG8_SB(b, h) ((4 + (b) * 2 + (h)) * HTB)
#define PG8_STAGE(bufoff, gbase, voff) do { _Pragma("unroll") for (int _i = 0; _i < 2; ++_i) { const char* sb_ = (const char*)(gbase) + (size_t)_i * q##voff; asm volatile("" : "+s"(sb_));   \
        __builtin_amdgcn_global_load_lds((const unsigned*)(sb_ + (voff)), (PG8_LAS unsigned*)(lds + (bufoff) + ldsw + _i * 8192), 16, 0, 0); } } while (0)
#define qvoffA qstepA
#define qvoffB qstepB
#define PG8_LDA(dst, b, h) do { _Pragma("unroll") for (int m = 0; m < 4; ++m) _Pragma("unroll") for (int k = 0; k < 2; ++k) dst[m][k] = *(const PG8_LAS bf16x8*)(lds + PG8_SA(b, h) + aoff + m * 2048 + k * 1024); } while (0)
#define PG8_LDB(dst, b, h) do { _Pragma("unroll") for (int n = 0; n < 2; ++n) _Pragma("unroll") for (int k = 0; k < 2; ++k) dst[n][k] = *(const PG8_LAS bf16x8*)(lds + PG8_SB(b, h) + boff + n * 2048 + k * 1024); } while (0)
#define PG8_MMA(ai, bj, At, Bt) do { __builtin_amdgcn_s_setprio(1); _Pragma("unroll") for (int m = 0; m < 4; ++m) _Pragma("unroll") for (int n = 0; n < 2; ++n) _Pragma("unroll") for (int k = 0; k < 2; ++k) \
        acc[ai][bj][m][n] = __builtin_amdgcn_mfma_f32_16x16x32_bf16(Bt[n][k], At[m][k], acc[ai][bj][m][n], 0, 0, 0); __builtin_amdgcn_s_setprio(0); } while (0)
#define PG8_WAIT_V(n) asm volatile("s_waitcnt vmcnt(" #n ")" ::: "memory")
#define PG8_WAIT_L(n) asm volatile("s_waitcnt lgkmcnt(" #n ")" ::: "memory")
#define PG8_BAR __builtin_amdgcn_s_barrier()
#define PG8_SCHED __builtin_amdgcn_sched_barrier(0)
    Unit cur, nxt; int ui = 0;
    if (!S.next(0, cur)) return;
    f32x4 acc[2][2][4][2];
#pragma unroll
    for (int a = 0; a < 2; ++a)
#pragma unroll
        for (int b = 0; b < 2; ++b)
#pragma unroll
            for (int m = 0; m < 4; ++m)
#pragma unroll
                for (int n = 0; n < 2; ++n) acc[a][b][m][n] = (f32x4){0.f, 0.f, 0.f, 0.f};
    bf16x8 At[4][2], B0[2][2], B1[2][2];
    const char* cA = cur.a; const char* cB = cur.b;
    S.a_ready(cur);
    if constexpr (SP2) {
        PG8_STAGE(PG8_SB(0, 0), cB, voffB); PG8_STAGE(PG8_SB(0, 1), cB + hstepB, voffB); PG8_STAGE(PG8_SA(0, 0), cA, voffA); PG8_STAGE(PG8_SA(0, 1), cA + hstepA, voffA);
        if (wr == 1) PG8_BAR;
        PG8_WAIT_V(2); PG8_BAR;
        PG8_STAGE(PG8_SB(1, 0), cB + kstep, voffB); PG8_STAGE(PG8_SA(1, 0), cA + kstep, voffA); PG8_STAGE(PG8_SB(1, 1), cB + hstepB + kstep, voffB);
        PG8_WAIT_V(6); PG8_BAR;
    } else {
        PG8_STAGE(PG8_SB(0, 0), cB, voffB); PG8_STAGE(PG8_SA(0, 0), cA, voffA); PG8_STAGE(PG8_SB(0, 1), cB + hstepB, voffB); PG8_STAGE(PG8_SA(0, 1), cA + hstepA, voffA);
        if (wr == 1) PG8_BAR;
        PG8_WAIT_V(4); PG8_BAR;
        PG8_STAGE(PG8_SB(1, 0), cB + kstep, voffB); PG8_STAGE(PG8_SA(1, 0), cA + kstep, voffA); PG8_STAGE(PG8_SB(1, 1), cB + hstepB + kstep, voffB);
        PG8_WAIT_V(6); PG8_BAR;
    }
    for (;;) {
        const bool has_next = S.next(ui + 1, nxt);
        const char* nA = has_next ? nxt.a : cA; const char* nB = has_next ? nxt.b : cB;
        for (int t = 0; t < nt; t += 2) {
            const bool last = (t == nt - 2);
            const char* a1 = cA + (size_t)(t + 1) * kstep;
            const char* a2 = last ? nA : cA + (size_t)(t + 2) * kstep; const char* b2 = last ? nB : cB + (size_t)(t + 2) * kstep;
            const char* a3 = a2 + kstep; const char* b3 = b2 + kstep;
            if (last && has_next) S.a_ready(nxt);
            if constexpr (SP2) {
            PG8_LDB(B0, 0, 0); PG8_LDB(B1, 0, 1); PG8_SCHED; PG8_LDA(At, 0, 0); PG8_STAGE(PG8_SA(1, 1), a1 + hstepA, voffA);
            PG8_WAIT_V(8); PG8_WAIT_L(0); PG8_BAR; PG8_MMA(0, 0, At, B0); PG8_MMA(0, 1, At, B1); PG8_BAR; PG8_SCHED;
            PG8_LDA(At, 0, 1); PG8_STAGE(PG8_SB(0, 0), b2, voffB); PG8_STAGE(PG8_SB(0, 1), b2 + hstepB, voffB); PG8_STAGE(PG8_SA(0, 0), a2, voffA);
            PG8_WAIT_V(8); PG8_WAIT_L(0); PG8_BAR; PG8_MMA(1, 0, At, B0); PG8_MMA(1, 1, At, B1); PG8_BAR; PG8_SCHED;
            PG8_LDB(B0, 1, 0); PG8_LDB(B1, 1, 1); PG8_SCHED; PG8_LDA(At, 1, 0); PG8_STAGE(PG8_SA(0, 1), a2 + hstepA, voffA);
            PG8_WAIT_V(8); PG8_WAIT_L(0); PG8_BAR; PG8_MMA(0, 0, At, B0); PG8_MMA(0, 1, At, B1); PG8_BAR; PG8_SCHED;
            PG8_LDA(At, 1, 1); PG8_STAGE(PG8_SB(1, 0), b3, voffB); PG8_STAGE(PG8_SB(1, 1), b3 + hstepB, voffB); PG8_STAGE(PG8_SA(1, 0), a3, voffA);
            PG8_WAIT_V(8); PG8_WAIT_L(0); PG8_BAR; PG8_MMA(1, 0, At, B0); PG8_MMA(1, 1, At, B1); PG8_BAR; PG8_SCHED;
            } else {
            PG8_LDB(B0, 0, 0); PG8_SCHED; PG8_LDA(At, 0, 0); PG8_STAGE(PG8_SA(1, 1), a1 + hstepA, voffA);
            PG8_WAIT_L(8); PG8_BAR; PG8_WAIT_L(0); PG8_MMA(0, 0, At, B0); PG8_BAR; PG8_SCHED;
            PG8_LDB(B1, 0, 1); PG8_STAGE(PG8_SB(0, 0), b2, voffB);
            PG8_BAR; PG8_WAIT_L(0); PG8_MMA(0, 1, At, B1); PG8_BAR;
            PG8_LDA(At, 0, 1); PG8_STAGE(PG8_SA(0, 0), a2, voffA);
            PG8_BAR; PG8_WAIT_L(0); PG8_MMA(1, 0, At, B0); PG8_BAR; PG8_SCHED;
            PG8_STAGE(PG8_SB(0, 1), b2 + hstepB, voffB);
            PG8_WAIT_V(6); PG8_BAR; PG8_MMA(1, 1, At, B1); PG8_BAR;
            PG8_LDB(B0, 1, 0); PG8_SCHED; PG8_LDA(At, 1, 0); PG8_STAGE(PG8_SA(0, 1), a2 + hstepA, voffA);
            PG8_WAIT_L(8); PG8_BAR; PG8_WAIT_L(0); PG8_MMA(0, 0, At, B0); PG8_BAR; PG8_SCHED;
            PG8_LDB(B1, 1, 1); PG8_STAGE(PG8_SB(1, 0), b3, voffB);
            PG8_BAR; PG8_WAIT_L(0); PG8_MMA(0, 1, At, B1); PG8_BAR;
            PG8_LDA(At, 1, 1); PG8_STAGE(PG8_SA(1, 0), a3, voffA);
            PG8_BAR; PG8_WAIT_L(0); PG8_MMA(1, 0, At, B0); PG8_BAR; PG8_SCHED;
            PG8_STAGE(PG8_SB(1, 1), b3 + hstepB, voffB);
            PG8_WAIT_V(6); PG8_BAR; PG8_MMA(1, 1, At, B1); PG8_BAR;
            }
        }
        if constexpr (ALIGN_EPI) { if (wr == 0) PG8_BAR; }
        if constexpr (!Epi::AFTER_DRAIN) { const int l2_ = tid_() & 63, fr2 = l2_ & 15, fq2 = l2_ >> 4;   E(acc, cur, wr, wc, fr2, fq2); S.done(cur); }
        if (!has_next) break;
#pragma unroll
        for (int a = 0; a < 2; ++a)
#pragma unroll
            for (int b = 0; b < 2; ++b)
#pragma unroll
                for (int m = 0; m < 4; ++m)
#pragma unroll
                    for (int n = 0; n < 2; ++n) acc[a][b][m][n] = (f32x4){0.f, 0.f, 0.f, 0.f};
        cur = nxt; cA = nA; cB = nB; ++ui;
        if constexpr (ALIGN_EPI) { if (wr == 1) PG8_BAR; }
    }
    PG8_WAIT_V(0);
    if constexpr (!ALIGN_EPI) { if (wr == 0) PG8_BAR; }
    PG8_BAR;
    if constexpr (Epi::AFTER_DRAIN) { E.fused(acc, cur, wr, wc, fr, fq, lds, wid, lane); S.done(cur); }
#undef PG8_SA
#undef PG8_SB
#undef PG8_STAGE
#undef qvoffA
#undef qvoffB
#undef PG8_LDA
#undef PG8_LDB
#undef PG8_MMA
#undef PG8_WAIT_V
#undef PG8_WAIT_L
#undef PG8_BAR
#undef PG8_SCHED
}
}

using pg8::bf16_t; using pg8::f32x4; using pg8::bf16x8; using pg8::u32x4; using pg8::u32x2;
#define DI __device__ __forceinline__
#define LAS __attribute__((address_space(3)))
typedef float f32x16 __attribute__((ext_vector_type(16)));
typedef short s16x4 __attribute__((ext_vector_type(4)));
typedef float f32x2_t __attribute__((ext_vector_type(2))); typedef __bf16 bf16x2_t __attribute__((ext_vector_type(2)));

constexpr int NTHR = 512, NWAVES = 8;
constexpr int D = 1024, NB = 8, SEQ = 2048, DEPTH = 4, DB = 16, DT = 16, PAST = 1024;
constexpr int MP = NB * SEQ, MS = DB * DT, MA = MP + MS;
constexpr int NIN = 6032, NINP = 6144;
constexpr int C_QA = 0, C_KA = 384, C_VA = 768, C_U = 1152, C_QC = 1408, C_KC = 1792, C_VC = 2176, C_GC = 2560, C_LR = 2944, C_GA = 2960, C_GB = 3984, C_GCG = 5008;
constexpr int FF = 2816, FF2 = 5632;
constexpr int GH = 4, GK = 96;
constexpr int NGU_P = NB * GH * 32, NGU_S = DB * GH, NGU = NGU_P + NGU_S;
constexpr float EPS = 1e-6f;

constexpr size_t O_YP = 0, O_YS = O_YP + (size_t)MP * D, O_KP = O_YS + (size_t)MS * D, O_VP = O_KP + (size_t)DEPTH * MP * 384, O_POOLP = O_VP + (size_t)DEPTH * MP * 384,
    O_GLAP = O_POOLP + (size_t)DEPTH * NB * 15 * 256, O_MKP = O_GLAP + (size_t)DEPTH * NB * GH * GK * GK, O_MVP = O_MKP + (size_t)DEPTH * NB * 256 * D,
    O_KS = O_MVP + (size_t)DEPTH * NB * 256 * D, O_VS = O_KS + (size_t)DEPTH * MS * 384, O_POOLS = O_VS + (size_t)DEPTH * MS * 384, O_GLAS = O_POOLS + (size_t)DEPTH * DB * 15 * 256,
    O_END = O_GLAS + (size_t)DEPTH * DB * GH * GK * GK;

enum { I_XP = 0, I_XS, I_MEM, I_CSK, I_CSV, I_SPOOL, I_SGLA, I_CMK, I_CMV, I_WIN, I_WA2, I_BA, I_GLAN, I_WPOOL, I_PSCALE, I_WBA, I_WBB, I_WBC, I_WMIX, I_MEMN, I_WXQ, I_WXK, I_WXV, I_WXO,
       I_WF1, I_WF2, I_NMIXPRE, I_NMIXPOST, I_NXPRE, I_NXPOST, I_NFPRE, I_NFPOST, N_IN };

constexpr size_t MiB = 1u << 20;
constexpr size_t SZ_WIN = (size_t)NINP * D * 2, SZ_WBA = (size_t)D * 384 * 2, SZ_WBB = (size_t)D * 256 * 2, SZ_WSQ = (size_t)D * D * 2, SZ_WKV = 2 * SZ_WSQ, SZ_WF1 = (size_t)FF2 * D * 2, SZ_WF2 = (size_t)D * FF * 2;
constexpr size_t WS_CTL = 0, CTL_BYTES = 1 * MiB, WS_TAB = CTL_BYTES - 4096;
constexpr size_t WS_WIN = WS_CTL + CTL_BYTES, WS_WBA = WS_WIN + 4 * SZ_WIN, WS_WBB = WS_WBA + 4 * SZ_WBA, WS_WBC = WS_WBB + 4 * SZ_WBB, WS_WMIX = WS_WBC + 4 * SZ_WBA,
    WS_WXQ = WS_WMIX + 4 * SZ_WSQ, WS_WXO = WS_WXQ + 4 * SZ_WSQ, WS_WKV = WS_WXO + 4 * SZ_WSQ, WS_WF1 = WS_WKV + 4 * SZ_WKV, WS_WF2 = WS_WF1 + 4 * SZ_WF1,
    WS_MN = WS_WF2 + 4 * SZ_WF2, WS_MKV = WS_MN + 4 * SZ_WKV, WS_MEMVT = WS_MKV + 8 * SZ_WKV, WS_PROJ = WS_MEMVT + 4 * SZ_WKV;
constexpr size_t SZ_ROWS = (size_t)MA * D * 2;
constexpr size_t SZ_PROJ = (size_t)MA * NINP * 2;
constexpr size_t WS_Q = WS_PROJ, WS_P = WS_Q + SZ_ROWS, WS_O = WS_P + SZ_ROWS, WS_ACT = WS_O + SZ_ROWS;
static_assert(WS_ACT + (size_t)MA * FF * 2 <= WS_PROJ + SZ_PROJ, "overlay fits");
constexpr size_t WS_H = WS_PROJ + SZ_PROJ, WS_MERGED = WS_H + SZ_ROWS, WS_Y = WS_MERGED + SZ_ROWS;
constexpr size_t WS_GKV = WS_H, WS_GSP = WS_GKV + 39 * MiB, WS_GDEC = WS_GSP + 37 * MiB;
static_assert((size_t)NGU * GK * GK * 4 <= 39 * MiB && (size_t)NGU_P * GK * GK * 4 <= 37 * MiB && WS_GDEC + (size_t)NGU * GK * 4 <= WS_Y + SZ_ROWS, "GLA overlay fits");
constexpr size_t WS_OA = WS_Y + SZ_ROWS, WS_POOLED = WS_OA + (size_t)MA * 384 * 2, WS_OC = WS_POOLED + (size_t)MA * 256 * 2, WS_END = WS_OC + (size_t)MA * 384 * 2;
static_assert(WS_WIN % 256 == 0 && WS_PROJ % 256 == 0 && WS_H % 256 == 0 && WS_OA % 256 == 0 && WS_POOLED % 256 == 0 && WS_OC % 256 == 0 && WS_P % 256 == 0, "alignment");

constexpr int CW_BAR = 16384;
constexpr int LDS_GEMM = 131072, LDS_X = LDS_GEMM, LDS_X_BYTES = 12288, LDS_MISC = LDS_X + LDS_X_BYTES, LDS_BYTES = LDS_MISC + 256;

struct Params { const float* in[N_IN]; float* out; unsigned char* ws; int ph_lo, ph_hi; };
struct InTab { const float* const* t;
    __device__ __forceinline__ const float* operator[](int i) const { const unsigned long long v = (unsigned long long)t[i];
        const unsigned lo = __builtin_amdgcn_readfirstlane((unsigned)v), hi = __builtin_amdgcn_readfirstlane((unsigned)(v >> 32)); return (const float*)(((unsigned long long)hi << 32) | lo); } };
struct Ctx { InTab in; float* out; unsigned char* ws; };

DI float bflo(unsigned w) { return __uint_as_float(w << 16); }
DI float bfhi(unsigned w) { return __uint_as_float(w & 0xffff0000u); }
DI float bf2f(unsigned short v) { return __uint_as_float((unsigned)v << 16); }
DI unsigned pk2(float lo, float hi) { f32x2_t v = {lo, hi}; bf16x2_t b = __builtin_convertvector(v, bf16x2_t); return __builtin_bit_cast(unsigned, b); }
DI unsigned short f2bf(float f) { return (unsigned short)(pk2(f, 0.f) & 0xffffu); }
DI float wave_sum(float v) {
#pragma unroll
    for (int o = 1; o < 64; o <<= 1) v += __shfl_xor(v, o);
    return v;
}
DI float wave_max(float v) {
#pragma unroll
    for (int o = 1; o < 64; o <<= 1) v = fmaxf(v, __shfl_xor(v, o));
    return v;
}
DI float sigmoidf_(float x) { return __builtin_amdgcn_rcpf(1.f + __expf(-x)); }
DI float softplusf_(float z) { return fmaxf(z, 0.f) + __logf(1.f + __expf(-fabsf(z))); }
DI int next_work(unsigned* ctr, volatile LAS int* slot) {
    __syncthreads();
    if (pg8::tid_() == 0) *slot = (int)atomicAdd(ctr, 1u);
    __syncthreads();
    return *slot;
}

typedef const pg8::f32x4 (&AccRef)[2][2][4][2];
struct EpiBf16 {
    static constexpr bool PERM = true, AFTER_DRAIN = false;
    bf16_t* O; int ldc; int pnmask;
    DI void operator()(AccRef acc, const pg8::Unit& u, int wr, int wc, int fr, int fq) const {
#pragma unroll
        for (int ai = 0; ai < 2; ++ai)
#pragma unroll
            for (int m = 0; m < 4; ++m) {
                bf16_t* rowp = O + (size_t)(u.pm * 256 + ai * 128 + wr * 64 + m * 16 + fr) * ldc + (u.pn & pnmask) * 256 + wc * 32 + 8 * fq;
#pragma unroll
                for (int bj = 0; bj < 2; ++bj) {
                    const f32x4 v0 = acc[ai][bj][m][0], v1 = acc[ai][bj][m][1];
                    u32x4 w; w.x = pk2(v0[0], v0[1]); w.y = pk2(v0[2], v0[3]); w.z = pk2(v1[0], v1[1]); w.w = pk2(v1[2], v1[3]);
                    *(u32x4*)(rowp + bj * 128) = w;
                }
            }
    }
};
struct EpiGate {
    static constexpr bool PERM = true, AFTER_DRAIN = false;
    bf16_t* merged; const bf16_t* proj; int goff; int accum;
    DI void operator()(AccRef acc, const pg8::Unit& u, int wr, int wc, int fr, int fq) const {
#pragma unroll
        for (int ai = 0; ai < 2; ++ai)
#pragma unroll
            for (int m = 0; m < 4; ++m) {
                const int row = u.pm * 256 + ai * 128 + wr * 64 + m * 16 + fr;
                const bf16_t* gp = proj + (size_t)row * NINP + goff + u.pn * 256 + wc * 32 + 8 * fq;
                bf16_t* mp = merged + (size_t)row * D + u.pn * 256 + wc * 32 + 8 * fq;
#pragma unroll
                for (int bj = 0; bj < 2; ++bj)
#pragma unroll
                    for (int n = 0; n < 2; ++n) {
                        const u32x2 g = *(const u32x2*)(gp + bj * 128 + 4 * n);
                        u32x2 pm2 = {0u, 0u}; if (accum) pm2 = *(const u32x2*)(mp + bj * 128 + 4 * n);
                        const f32x4 v = acc[ai][bj][m][n];
                        const float r0 = sigmoidf_(bflo(g.x)) * v[0] + bflo(pm2.x), r1 = sigmoidf_(bfhi(g.x)) * v[1] + bfhi(pm2.x);
                        const float r2 = sigmoidf_(bflo(g.y)) * v[2] + bflo(pm2.y), r3 = sigmoidf_(bfhi(g.y)) * v[3] + bfhi(pm2.y);
                        u32x2 w; w.x = pk2(r0, r1); w.y = pk2(r2, r3);
                        *(u32x2*)(mp + bj * 128 + 4 * n) = w;
                        asm volatile("" ::: "memory");
                    }
            }
    }
};
struct EpiSwiglu {
    static constexpr bool PERM = true, AFTER_DRAIN = false;
    bf16_t* act;
    DI void operator()(AccRef acc, const pg8::Unit& u, int wr, int wc, int fr, int fq) const {
#pragma unroll
        for (int ai = 0; ai < 2; ++ai)
#pragma unroll
            for (int m = 0; m < 4; ++m) {
                const int row = u.pm * 256 + ai * 128 + wr * 64 + m * 16 + fr;
#pragma unroll
                for (int bj = 0; bj < 2; ++bj) {
                    const int col0 = u.pn * 256 + bj * 128 + wc * 32 + 8 * fq;
                    const f32x4 g = acc[ai][bj][m][0], up = acc[ai][bj][m][1];
                    float r[4];
#pragma unroll
                    for (int j = 0; j < 4; ++j) r[j] = g[j] * sigmoidf_(g[j]) * up[j];
                    u32x2 w; w.x = pk2(r[0], r[1]); w.y = pk2(r[2], r[3]);
                    *(u32x2*)(act + (size_t)row * FF + (col0 >> 1)) = w;
                }
            }
    }
};
struct MemKvOrder {
    int G, c; const char* A; const char* B;
    DI bool next(int i, pg8::Unit& u) const {
        const int L = i * G + c; if (L >= 256) return false;
        const int l = L >> 6, r = L & 63; u.pm = l * 8 + (r & 7); u.pn = l * 8 + (r >> 3);
        u.a = A + (size_t)u.pm * (256 * D * 2); u.b = B + (size_t)u.pn * (256 * D * 2); return true;
    }
    DI void a_ready(const pg8::Unit&) const {}
    DI void done(const pg8::Unit&) const {}
};
struct CrossOrder {
    int G, c; const char* A; const char* B; int mode;
    DI bool next(int i, pg8::Unit& u) const {
        const int L = i * G + c; if (L >= 256) return false;
        u.pm = L >> 2; u.pn = L & 3; const int b = u.pm >> 3, h = u.pn;
        u.a = A + ((size_t)u.pm * 256 * D + h * 256) * 2;
        u.b = mode == 0 ? B + ((size_t)b * 256 * 2048 + h * 256) * 2 : B + ((size_t)h * 256 * 2048 + b * 256) * 2;
        return true;
    }
    DI void a_ready(const pg8::Unit&) const {}
    DI void done(const pg8::Unit&) const {}
};
struct EpiSoftmax {
    static constexpr bool PERM = true, AFTER_DRAIN = false;
    bf16_t* P; LAS float* xs;
    DI void operator()(AccRef acc, const pg8::Unit& u, int wr, int wc, int fr, int fq) const {
        const float sc = 0.0625f * 1.4426950408889634f;
        LAS float* xm = xs; LAS float* xsum = xs + 1024;
#pragma unroll
        for (int ai = 0; ai < 2; ++ai)
#pragma unroll
            for (int m = 0; m < 4; ++m) {
                float a = -3.0e38f;
#pragma unroll
                for (int bj = 0; bj < 2; ++bj)
#pragma unroll
                    for (int n = 0; n < 2; ++n) { const f32x4 v = acc[ai][bj][m][n]; a = fmaxf(a, fmaxf(fmaxf(v[0], v[1]), fmaxf(v[2], v[3]))); }
                a = fmaxf(a, __shfl_xor(a, 16)); a = fmaxf(a, __shfl_xor(a, 32));
                if (fq == 0) xm[(ai * 128 + wr * 64 + m * 16 + fr) * 4 + wc] = a;
                asm volatile("" ::: "memory");
            }
        __syncthreads();
#pragma unroll
        for (int ai = 0; ai < 2; ++ai)
#pragma unroll
            for (int m = 0; m < 4; ++m) {
                const f32x4 t = *(LAS f32x4*)(xm + (ai * 128 + wr * 64 + m * 16 + fr) * 4); const float mx = fmaxf(fmaxf(t[0], t[1]), fmaxf(t[2], t[3])) * sc;
                float s = 0.f;
#pragma unroll
                for (int bj = 0; bj < 2; ++bj)
#pragma unroll
                    for (int n = 0; n < 2; ++n)
#pragma unroll
                        for (int j = 0; j < 4; ++j) s += __builtin_amdgcn_exp2f(acc[ai][bj][m][n][j] * sc - mx);
                s += __shfl_xor(s, 16); s += __shfl_xor(s, 32);
                if (fq == 0) xsum[(ai * 128 + wr * 64 + m * 16 + fr) * 4 + wc] = s;
                asm volatile("" ::: "memory");
            }
        __syncthreads();
#pragma unroll
        for (int ai = 0; ai < 2; ++ai)
#pragma unroll
            for (int m = 0; m < 4; ++m) {
                const f32x4 t = *(LAS f32x4*)(xm + (ai * 128 + wr * 64 + m * 16 + fr) * 4); const float mx = fmaxf(fmaxf(t[0], t[1]), fmaxf(t[2], t[3])) * sc;
                const f32x4 t2 = *(LAS f32x4*)(xsum + (ai * 128 + wr * 64 + m * 16 + fr) * 4); const float inv = __builtin_amdgcn_rcpf((t2[0] + t2[1]) + (t2[2] + t2[3]));
                bf16_t* rowp = P + (size_t)(u.pm * 256 + ai * 128 + wr * 64 + m * 16 + fr) * D + u.pn * 256 + wc * 32 + 8 * fq;
#pragma unroll
                for (int bj = 0; bj < 2; ++bj)
#pragma unroll
                    for (int n = 0; n < 2; ++n) {
                        const f32x4 v = acc[ai][bj][m][n];
                        u32x2 w; w.x = pk2(__builtin_amdgcn_exp2f(v[0] * sc - mx) * inv, __builtin_amdgcn_exp2f(v[1] * sc - mx) * inv); w.y = pk2(__builtin_amdgcn_exp2f(v[2] * sc - mx) * inv, __builtin_amdgcn_exp2f(v[3] * sc - mx) * inv);
                        *(u32x2*)(rowp + bj * 128 + 4 * n) = w;
                    }
                asm volatile("" ::: "memory");
            }
        __syncthreads();
    }
};

#define XB_TMO      128
#define XB_XCNT(j)  (256  + 64 * (j))
#define XB_XSUB(j)  (1280 + 64 * (j))
#define XB_XGEN(j)  (2304 + 64 * (j))
#define XB_TOP      3328
#define XB_TOPGEN   3392
#define XCD_BAR_WORDS 3456
#define XB_SPIN_CAP (1u << 18)

__device__ __forceinline__ unsigned xb_ld(unsigned* p)              { return __hip_atomic_load(p, __ATOMIC_RELAXED, __HIP_MEMORY_SCOPE_AGENT); }
__device__ __forceinline__ unsigned xb_add(unsigned* p, unsigned v) { return __hip_atomic_fetch_add(p, v, __ATOMIC_RELAXED, __HIP_MEMORY_SCOPE_AGENT); }
__device__ __forceinline__ unsigned xb_xcc_id() { return (unsigned)__builtin_amdgcn_s_getreg((3 << 11) | 20) & 0xFu; }
#define XB_SPIN(cond, bar) do { unsigned _sp = 0; while (cond) { __builtin_amdgcn_s_sleep(1); \
    if ((++_sp & 255u) == 0u) { if (xb_ld(&(bar)[XB_TMO])) break; if (_sp > XB_SPIN_CAP) { atomicAdd(&(bar)[XB_TMO], 1u); break; } } } } while (0)

struct XcdBarrier {
    unsigned* bar; unsigned x;
    volatile LAS unsigned* st;
};

__device__ __forceinline__ XcdBarrier xcd_barrier_post(unsigned* bar, volatile LAS unsigned* st) {
    XcdBarrier b; b.bar = bar; b.x = xb_xcc_id(); b.st = st;
    if (threadIdx.x == 0) (void)xb_add(&bar[XB_XCNT(b.x)], 1u);
    return b;
}
__device__ __forceinline__ void xcd_barrier_complete(unsigned* bar, unsigned x, unsigned& nloc, unsigned& nx) {
    const unsigned G = gridDim.x * gridDim.y * gridDim.z;
    unsigned sum, cnt, mine, sp = 0u;
    for (;;) {
        sum = 0u; cnt = 0u; mine = 0u;
#pragma unroll
        for (unsigned j = 0; j < 16; ++j) { const unsigned c = xb_ld(&bar[XB_XCNT(j)]); sum += c; cnt += (c > 0u) ? 1u : 0u; mine = (j == x) ? c : mine; }
        if (sum == G) break;
        __builtin_amdgcn_s_sleep(1);
        if ((++sp & 255u) == 0u) { if (xb_ld(&bar[XB_TMO])) break; if (sp > XB_SPIN_CAP) { atomicAdd(&bar[XB_TMO], 1u); break; } }
    }
    nloc = mine > 0u ? mine : 1u; nx = cnt > 0u ? cnt : 1u;
}

__device__ __forceinline__ void xcd_barrier(const XcdBarrier& b) {
    asm volatile("s_waitcnt vmcnt(0)" ::: "memory");
    __syncthreads();
    if (threadIdx.x == 0) {
        unsigned* bar = b.bar;
        __builtin_amdgcn_s_waitcnt(0);
        unsigned nloc = b.st[0], nx = b.st[1];
        if (nloc == 0u) { xcd_barrier_complete(bar, b.x, nloc, nx); b.st[0] = nloc; b.st[1] = nx; }
        const unsigned old = xb_add(&bar[XB_XSUB(b.x)], 1u);
        const unsigned gen = old / nloc;
        if (old + 1u == (gen + 1u) * nloc) {
            __builtin_amdgcn_fence(__ATOMIC_RELEASE, "agent");
            asm volatile("s_waitcnt vmcnt(0)" ::: "memory");
            const unsigned og = xb_add(&bar[XB_TOP], 1u);
            const unsigned tg = og / nx;
            if (og + 1u == (tg + 1u) * nx) xb_add(&bar[XB_TOPGEN], 1u);
            else XB_SPIN(xb_ld(&bar[XB_TOPGEN]) == tg, bar);
            __builtin_amdgcn_fence(__ATOMIC_ACQUIRE, "agent");
            xb_add(&bar[XB_XGEN(b.x)], 1u);
            asm volatile("s_waitcnt vmcnt(0)" ::: "memory");
        } else {
            XB_SPIN(xb_ld(&bar[XB_XGEN(b.x)]) == gen, bar);
            __builtin_amdgcn_fence(__ATOMIC_ACQUIRE, "agent");
            asm volatile("s_waitcnt vmcnt(0)" ::: "memory");
        }
    }
    __syncthreads();
}


#define LDS_WAIT() asm volatile("s_waitcnt lgkmcnt(0)" ::: "memory")
DI void transpose_item(const float* W, int K, int N, int Npad, bf16_t* WT, int mode, LAS float* scr, int item, int lane) {
    const int nblk = Npad / 32, kb = item / nblk, nb = item % nblk, k0 = 64 * kb, n0 = 32 * nb;
    const int nn = n0 + (lane & 31); const bool ok = nn < N;
#pragma unroll 8
    for (int i = 0; i < 32; ++i) { const int kk = 2 * i + (lane >> 5); scr[kk * 33 + (lane & 31)] = ok ? W[(size_t)(k0 + kk) * N + nn] : 0.f; }
    LDS_WAIT(); asm volatile("" ::: "memory");
    const int c = lane & 7;
#pragma unroll
    for (int j = 0; j < 4; ++j) {
        const int n = (lane >> 3) + 8 * j; const LAS float* s = scr + (8 * c) * 33 + n;
        u32x4 o; o.x = pk2(s[0 * 33], s[1 * 33]); o.y = pk2(s[2 * 33], s[3 * 33]); o.z = pk2(s[4 * 33], s[5 * 33]); o.w = pk2(s[6 * 33], s[7 * 33]);
        int drow = n0 + n;
        if (mode == 1) { const int jj = drow >= FF ? drow - FF : drow, isu = drow >= FF ? 1 : 0; drow = (jj >> 2) * 8 + isu * 4 + (jj & 3); }
        *(u32x4*)(WT + (size_t)drow * K + k0 + 8 * c) = o;
    }
    LDS_WAIT(); asm volatile("" ::: "memory");
}

DI void norm_row(const float* xsrc, float* xdst, const bf16_t* y, const float* gpost, const float* gpre, bf16_t* h, int lane) {
    f32x4 v[4];
#pragma unroll
    for (int j = 0; j < 4; ++j) v[j] = *(const f32x4*)(xsrc + 4 * lane + 256 * j);
    if (y) {
        f32x4 yv[4]; float ss = 0.f;
#pragma unroll
        for (int j = 0; j < 4; ++j) { const u32x2 w = *(const u32x2*)(y + 4 * lane + 256 * j); yv[j] = (f32x4){bflo(w.x), bfhi(w.x), bflo(w.y), bfhi(w.y)}; ss += (yv[j][0] * yv[j][0] + yv[j][1] * yv[j][1]) + (yv[j][2] * yv[j][2] + yv[j][3] * yv[j][3]); }
        const float rs = rsqrtf(wave_sum(ss) * (1.f / D) + EPS);
#pragma unroll
        for (int j = 0; j < 4; ++j) { const f32x4 g = *(const f32x4*)(gpost + 4 * lane + 256 * j); v[j] = v[j] + yv[j] * rs * g; }
    }
#pragma unroll
    for (int j = 0; j < 4; ++j) *(f32x4*)(xdst + 4 * lane + 256 * j) = v[j];
    if (gpre) {
        float ss = 0.f;
#pragma unroll
        for (int j = 0; j < 4; ++j) ss += (v[j][0] * v[j][0] + v[j][1] * v[j][1]) + (v[j][2] * v[j][2] + v[j][3] * v[j][3]);
        const float rs = rsqrtf(wave_sum(ss) * (1.f / D) + EPS);
#pragma unroll
        for (int j = 0; j < 4; ++j) { const f32x4 g = *(const f32x4*)(gpre + 4 * lane + 256 * j); const f32x4 o = v[j] * rs * g; u32x2 w; w.x = pk2(o[0], o[1]); w.y = pk2(o[2], o[3]); *(u32x2*)(h + 4 * lane + 256 * j) = w; }
    }
}


DI void norm_phase(const Ctx& p, const float* gpost, const float* gpre, int G, int bx) {
    const int tid = pg8::tid_(), lane = tid & 63, wv = tid >> 6, gw = bx * NWAVES + wv, NGW = G * NWAVES;
    const bf16_t* Yb = (const bf16_t*)(p.ws + WS_Y); bf16_t* Hb = (bf16_t*)(p.ws + WS_H);
    for (int row = gw; row < MA; row += NGW) norm_row(p.out + (size_t)row * D, p.out + (size_t)row * D, Yb + (size_t)row * D, gpost, gpre, Hb + (size_t)row * D, lane);
}

DI void prologue(const Params& p, LAS unsigned char* lds) {
    const int tid = pg8::tid_(), lane = tid & 63, wv = tid >> 6;
    const int gw = blockIdx.x * NWAVES + wv, NGW = gridDim.x * NWAVES;
    LAS float* scr = (LAS float*)(lds + wv * 16384);
    unsigned char* ws = p.ws;
    constexpr int I0 = 3072, I1 = 192, I2 = 512, I3 = 2816, I4 = 1408, IPL = I0 + 2 * I1 + 5 * I2 + I3 + I4;
    for (int it = gw; it < 4 * IPL; it += NGW) {
        const int l = it / IPL; int r = it % IPL;
        if (r < I0) { transpose_item(p.in[I_WIN] + (size_t)l * D * NIN, D, NIN, NINP, (bf16_t*)(ws + WS_WIN + l * SZ_WIN), 0, scr, r, lane); continue; } r -= I0;
        if (r < I1) { transpose_item(p.in[I_WBA] + (size_t)l * 384 * D, 384, D, D, (bf16_t*)(ws + WS_WBA + l * SZ_WBA), 0, scr, r, lane); continue; } r -= I1;
        if (r < I1) { transpose_item(p.in[I_WBC] + (size_t)l * 384 * D, 384, D, D, (bf16_t*)(ws + WS_WBC + l * SZ_WBA), 0, scr, r, lane); continue; } r -= I1;
        if (r < I2) { transpose_item(p.in[I_WMIX] + (size_t)l * D * D, D, D, D, (bf16_t*)(ws + WS_WMIX + l * SZ_WSQ), 0, scr, r, lane); continue; } r -= I2;
        if (r < I2) { transpose_item(p.in[I_WXQ] + (size_t)l * D * D, D, D, D, (bf16_t*)(ws + WS_WXQ + l * SZ_WSQ), 0, scr, r, lane); continue; } r -= I2;
        if (r < I2) { transpose_item(p.in[I_WXO] + (size_t)l * D * D, D, D, D, (bf16_t*)(ws + WS_WXO + l * SZ_WSQ), 0, scr, r, lane); continue; } r -= I2;
        if (r < I2) { transpose_item(p.in[I_WXK] + (size_t)l * D * D, D, D, D, (bf16_t*)(ws + WS_WKV + l * SZ_WKV), 0, scr, r, lane); continue; } r -= I2;
        if (r < I2) { transpose_item(p.in[I_WXV] + (size_t)l * D * D, D, D, D, (bf16_t*)(ws + WS_WKV + l * SZ_WKV + SZ_WSQ), 0, scr, r, lane); continue; } r -= I2;
        if (r < I3) { transpose_item(p.in[I_WF1] + (size_t)l * D * FF2, D, FF2, FF2, (bf16_t*)(ws + WS_WF1 + l * SZ_WF1), 1, scr, r, lane); continue; } r -= I3;
        transpose_item(p.in[I_WF2] + (size_t)l * FF * D, FF, D, D, (bf16_t*)(ws + WS_WF2 + l * SZ_WF2), 0, scr, r, lane);
    }
    {
        const int gt = blockIdx.x * NTHR + tid, NT = gridDim.x * NTHR;
        for (int idx = gt; idx < 4 * 256 * 1024; idx += NT) {
            const int n = idx & 1023, k = (idx >> 10) & 255, l = idx >> 18, g = k >> 6, c = k & 63;
            const float* wp = p.in[I_WPOOL] + ((size_t)(l * 4 + g) * 64 + c) * 64; const float* sc = p.in[I_PSCALE] + l * 256 + g * 64;
            const float* wb = p.in[I_WBB] + ((size_t)l * 256 + g * 64) * D + n;
            float s = 0.f;
#pragma unroll 8
            for (int d = 0; d < 64; ++d) s += wp[d] * sc[d] * wb[(size_t)d * D];
            ((bf16_t*)(ws + WS_WBB + l * SZ_WBB))[(size_t)n * 256 + k] = f2bf(s);
        }
    }
    for (int row = gw; row < MA; row += NGW) {
        const float* src = row < MP ? p.in[I_XP] + (size_t)row * D : p.in[I_XS] + (size_t)(row - MP) * D;
        norm_row(src, p.out + (size_t)row * D, nullptr, nullptr, p.in[I_NMIXPRE], (bf16_t*)(ws + WS_H) + (size_t)row * D, lane);
    }
    for (int row = gw; row < NB * 256; row += NGW) {
        f32x4 v[4]; float ss = 0.f;
#pragma unroll
        for (int j = 0; j < 4; ++j) { v[j] = *(const f32x4*)(p.in[I_MEM] + (size_t)row * D + 4 * lane + 256 * j); ss += (v[j][0] * v[j][0] + v[j][1] * v[j][1]) + (v[j][2] * v[j][2] + v[j][3] * v[j][3]); }
        const float rs = rsqrtf(wave_sum(ss) * (1.f / D) + EPS);
        for (int l = 0; l < 4; ++l)
#pragma unroll
            for (int j = 0; j < 4; ++j) { const f32x4 g = *(const f32x4*)(p.in[I_MEMN] + l * D + 4 * lane + 256 * j); const f32x4 o = v[j] * rs * g; u32x2 w; w.x = pk2(o[0], o[1]); w.y = pk2(o[2], o[3]);
                *(u32x2*)((bf16_t*)(ws + WS_MN) + ((size_t)l * 2048 + row) * D + 4 * lane + 256 * j) = w; }
    }
}

#define MFMA32(a, b, c) __builtin_amdgcn_mfma_f32_32x32x16_bf16((a), (b), (c), 0, 0, 0)
#define MFMA16(a, b, c) __builtin_amdgcn_mfma_f32_16x16x32_bf16((a), (b), (c), 0, 0, 0)
DI void sb_prompt_unit(const Ctx& p, int b, int h, int qb, LAS unsigned char* lds) {
    const bf16_t* proj = (const bf16_t*)(p.ws + WS_PROJ);
    LAS unsigned short* KS = (LAS unsigned short*)lds;
    LAS unsigned short* VT = KS + 64 * 72;
    const int tid = pg8::tid_(), lane = tid & 63, wv = tid >> 6, hi = lane >> 5, c = lane & 31;
    const int q0 = qb * 256 + wv * 32, tq = q0 + c;
    const size_t rowbase = (size_t)b * SEQ;
    bf16x8 qf[4];
    {
        const bf16_t* qp = proj + (rowbase + tq) * NINP + C_QA + h * 64 + 8 * hi;
#pragma unroll
        for (int kk = 0; kk < 4; ++kk) qf[kk] = *(const bf16x8*)(qp + 16 * kk);
    }
    f32x16 o0, o1;
#pragma unroll
    for (int i = 0; i < 16; ++i) { o0[i] = 0.f; o1[i] = 0.f; }
    float R = 0.f;
    const bf16_t* kbase = proj + rowbase * NINP + C_KA + h * 64 + 8 * wv;
    const bf16_t* vbase = proj + rowbase * NINP + C_VA + h * 64 + 8 * wv;
    int jt = 4 * qb + 3;
    u32x4 kr = *(const u32x4*)(kbase + (size_t)(64 * jt + lane) * NINP), vr = *(const u32x4*)(vbase + (size_t)(64 * jt + lane) * NINP);
    for (; jt >= 0; --jt) {
        __syncthreads();
        *(LAS u32x4*)(KS + lane * 72 + 8 * wv) = kr;
#pragma unroll
        for (int i = 0; i < 4; ++i) { const unsigned w = vr[i]; VT[(8 * wv + 2 * i) * 72 + lane] = (unsigned short)(w & 0xffffu); VT[(8 * wv + 2 * i + 1) * 72 + lane] = (unsigned short)(w >> 16); }
        __syncthreads();
        if (jt > 0) { kr = *(const u32x4*)(kbase + (size_t)(64 * (jt - 1) + lane) * NINP); vr = *(const u32x4*)(vbase + (size_t)(64 * (jt - 1) + lane) * NINP); }
        if (64 * jt < q0 + 31) {
            f32x16 z[2];
#pragma unroll
            for (int kb = 0; kb < 2; ++kb) {
                f32x16 acc;
#pragma unroll
                for (int i = 0; i < 16; ++i) acc[i] = 0.f;
#pragma unroll
                for (int kk = 0; kk < 4; ++kk) { const bf16x8 a = *(const LAS bf16x8*)(KS + (32 * kb + c) * 72 + 16 * kk + 8 * hi); acc = MFMA32(a, qf[kk], acc); }
                z[kb] = acc;
            }
            f32x16 e[2]; float T[8];
            const int sbase = 64 * jt + 4 * hi;
#pragma unroll
            for (int kb = 0; kb < 2; ++kb)
#pragma unroll
                for (int g = 0; g < 4; ++g) {
                    float lf[4];
#pragma unroll
                    for (int j = 0; j < 4; ++j) {
                        const int r = 4 * g + j; const float zz = z[kb][r] * 0.125f; const bool valid = (sbase + 32 * kb + 8 * g + j) < tq;
                        const float sp = softplusf_(zz); lf[j] = valid ? -sp : 0.f; z[kb][r] = valid ? zz - sp : -1.0e30f;
                    }
                    e[kb][4 * g + 3] = 0.f; e[kb][4 * g + 2] = lf[3]; e[kb][4 * g + 1] = lf[3] + lf[2]; e[kb][4 * g + 0] = lf[3] + lf[2] + lf[1];
                    T[kb * 4 + g] = e[kb][4 * g + 0] + lf[0];
                }
            float Tp[8], X[8];
#pragma unroll
            for (int gi = 0; gi < 8; ++gi) Tp[gi] = __shfl_xor(T[gi], 32);
            X[7] = 0.f;
#pragma unroll
            for (int gi = 6; gi >= 0; --gi) X[gi] = X[gi + 1] + (T[gi + 1] + Tp[gi + 1]);
            const float total = X[0] + (T[0] + Tp[0]);
#pragma unroll
            for (int kb = 0; kb < 2; ++kb)
#pragma unroll
                for (int g = 0; g < 4; ++g) {
                    const int gi = kb * 4 + g; const float off = R + X[gi] + (hi == 0 ? Tp[gi] : 0.f);
#pragma unroll
                    for (int j = 0; j < 4; ++j) { const int r = 4 * g + j; z[kb][r] = __expf(z[kb][r] + off + e[kb][r]); }
                }
            R += total;
#pragma unroll
            for (int kb = 0; kb < 2; ++kb)
#pragma unroll
                for (int s2 = 0; s2 < 2; ++s2) {
                    u32x4 pw; pw.x = pk2(z[kb][8 * s2 + 0], z[kb][8 * s2 + 1]); pw.y = pk2(z[kb][8 * s2 + 2], z[kb][8 * s2 + 3]); pw.z = pk2(z[kb][8 * s2 + 4], z[kb][8 * s2 + 5]); pw.w = pk2(z[kb][8 * s2 + 6], z[kb][8 * s2 + 7]);
                    const bf16x8 pb = __builtin_bit_cast(bf16x8, pw);
                    const int ko = 32 * kb + 16 * s2 + 4 * hi;
                    { const s16x4 lo = *(const LAS s16x4*)(VT + c * 72 + ko), hh = *(const LAS s16x4*)(VT + c * 72 + ko + 8);
                      const bf16x8 va = __builtin_shufflevector(lo, hh, 0, 1, 2, 3, 4, 5, 6, 7); o0 = MFMA32(va, pb, o0); }
                    { const s16x4 lo = *(const LAS s16x4*)(VT + (c + 32) * 72 + ko), hh = *(const LAS s16x4*)(VT + (c + 32) * 72 + ko + 8);
                      const bf16x8 va = __builtin_shufflevector(lo, hh, 0, 1, 2, 3, 4, 5, 6, 7); o1 = MFMA32(va, pb, o1); }
                }
        }
    }
    bf16_t* op = (bf16_t*)(p.ws + WS_OA) + (rowbase + tq) * 384 + h * 64 + 4 * hi;
#pragma unroll
    for (int g = 0; g < 4; ++g) {
        u32x2 w; w.x = pk2(o0[4 * g], o0[4 * g + 1]); w.y = pk2(o0[4 * g + 2], o0[4 * g + 3]); *(u32x2*)(op + 8 * g) = w;
        w.x = pk2(o1[4 * g], o1[4 * g + 1]); w.y = pk2(o1[4 * g + 2], o1[4 * g + 3]); *(u32x2*)(op + 32 + 8 * g) = w;
    }
}

DI void sb_sample_unit(const Ctx& p, int l, int b, int h, LAS unsigned char* lds) {
    const bf16_t* proj = (const bf16_t*)(p.ws + WS_PROJ);
    LAS float* qs = (LAS float*)lds;
    LAS float* Z = qs + 1024;
    LAS float* RED = Z + 16 * 1056;
    const int tid = pg8::tid_(), lane = tid & 63, wv = tid >> 6;
    const size_t srow = (size_t)MP + b * 16;
    for (int i = tid; i < 1024; i += NTHR) qs[i] = bf2f(proj[(srow + (i >> 6)) * NINP + C_QA + h * 64 + (i & 63)]) * 0.125f;
    __syncthreads();
    {
        float a0[16], a1[16];
#pragma unroll
        for (int i = 0; i < 16; ++i) { a0[i] = 0.f; a1[i] = 0.f; }
        const float* k0p = p.in[I_CSK] + ((((size_t)l * DB + b) * PAST + tid) * 6 + h) * 64; const float* k1p = k0p + (size_t)512 * 6 * 64;
        for (int d4 = 0; d4 < 16; ++d4) {
            const f32x4 ka = *(const f32x4*)(k0p + 4 * d4), kb = *(const f32x4*)(k1p + 4 * d4);
#pragma unroll
            for (int i = 0; i < 16; ++i) { const f32x4 q = *(const LAS f32x4*)(qs + i * 64 + 4 * d4);
                a0[i] += (q[0] * ka[0] + q[1] * ka[1]) + (q[2] * ka[2] + q[3] * ka[3]); a1[i] += (q[0] * kb[0] + q[1] * kb[1]) + (q[2] * kb[2] + q[3] * kb[3]); }
        }
#pragma unroll
        for (int i = 0; i < 16; ++i) { Z[i * 1056 + tid] = a0[i]; Z[i * 1056 + tid + 512] = a1[i]; }
        if (tid < 256) {
            const int i = tid >> 4, j = tid & 15; const bf16_t* kp = proj + (srow + j) * NINP + C_KA + h * 64; float s = 0.f;
            for (int d = 0; d < 64; ++d) s += qs[i * 64 + d] * bf2f(kp[d]);
            Z[i * 1056 + 1024 + j] = s;
        }
    }
    __syncthreads();
    for (int qq = 0; qq < 2; ++qq) {
        const int i = 2 * wv + qq, lim = PAST + i; LAS float* zr = Z + i * 1056;
        const int st = 17 * lane, en = (st + 17 < 1040) ? st + 17 : 1040;
        float tot = 0.f;
        for (int s = st; s < en; ++s) if (s < lim) tot -= softplusf_(zr[s]);
        float incl = tot;
#pragma unroll
        for (int o = 1; o < 64; o <<= 1) { const float t = __shfl_down(incl, o); if (lane + o < 64) incl += t; }
        float run = incl - tot;
        for (int s = en - 1; s >= st; --s) {
            const float zz = zr[s]; float w = 0.f;
            if (s < lim) { const float sp = softplusf_(zz); w = __expf(zz - sp + run); run -= sp; }
            zr[s] = w;
        }
    }
    __syncthreads();
    {
        const int d = tid & 63, g = tid >> 6;
        float o[16];
#pragma unroll
        for (int i = 0; i < 16; ++i) o[i] = 0.f;
        const float* vp = p.in[I_CSV] + (((size_t)l * DB + b) * PAST * 6 + h) * 64 + d;
        for (int s = 130 * g; s < 130 * g + 130; ++s) {
            const float v = s < PAST ? vp[(size_t)s * 384] : bf2f(proj[(srow + (s - PAST)) * NINP + C_VA + h * 64 + d]);
#pragma unroll
            for (int i = 0; i < 16; ++i) o[i] += Z[i * 1056 + s] * v;
        }
#pragma unroll
        for (int i = 0; i < 16; ++i) RED[(g * 16 + i) * 64 + d] = o[i];
    }
    __syncthreads();
    for (int i = tid; i < 1024; i += NTHR) {
        const int qi = i >> 6, d = i & 63; float s = 0.f;
#pragma unroll
        for (int g = 0; g < 8; ++g) s += RED[(g * 16 + qi) * 64 + d];
        ((bf16_t*)(p.ws + WS_OA))[(srow + qi) * 384 + h * 64 + d] = f2bf(s);
    }
}

DI void pool_unit(const Ctx& p, int l, int unit) {
    const bf16_t* proj = (const bf16_t*)(p.ws + WS_PROJ); bf16_t* pooled = (bf16_t*)(p.ws + WS_POOLED);
    const int tid = pg8::tid_(), ch = tid & 255, w = 2 << (ch >> 6);
    for (int i = 0; i < 32; ++i) {
        const int row = unit * 64 + (tid >> 8) + 2 * i;
        float s = 0.f, cnt, u0;
        if (row < MP) {
            const int t = row & (SEQ - 1); const int n = (t + 1 < w) ? t + 1 : w; cnt = (float)n;
            const bf16_t* up = proj + (size_t)row * NINP + C_U + ch; u0 = bf2f(up[0]);
            for (int j = 0; j < n; ++j) s += bf2f(*(up - (size_t)j * NINP));
            if (t >= SEQ - 15) p.out[O_POOLP + ((size_t)(l * NB + (row >> 11)) * 15 + (t - (SEQ - 15))) * 256 + ch] = u0;
        } else {
            const int rs = row - MP, b = rs >> 4, t = rs & 15; cnt = (float)w;
            const bf16_t* up = proj + (size_t)row * NINP + C_U + ch; u0 = bf2f(up[0]);
            const float* hist = p.in[I_SPOOL] + ((size_t)(l * DB + b) * 15) * 256 + ch;
            for (int j = 0; j < w; ++j) { const int tt = t - j; s += tt >= 0 ? bf2f(*(up - (size_t)j * NINP)) : hist[(15 + tt) * 256]; }
            if (t >= 1) p.out[O_POOLS + ((size_t)(l * DB + b) * 15 + (t - 1)) * 256 + ch] = u0;
        }
        pooled[(size_t)row * 256 + ch] = f2bf(s / cnt - u0);
    }
}


DI void kvout_unit(const Ctx& p, int l, int unit) {
    const bf16_t* proj = (const bf16_t*)(p.ws + WS_PROJ);
    for (int i = pg8::tid_(); i < 64 * 96; i += NTHR) {
        const int r = i / 96, ch = i % 96, row = unit * 64 + r;
        const u32x4 w = *(const u32x4*)(proj + (size_t)row * NINP + C_KA + 8 * ch);
        const bool isv = ch >= 48; const int c = 8 * (isv ? ch - 48 : ch);
        float* dst = (row < MP) ? p.out + (isv ? O_VP : O_KP) + ((size_t)l * MP + row) * 384 + c : p.out + (isv ? O_VS : O_KS) + ((size_t)l * MS + (row - MP)) * 384 + c;
        *(f32x4*)dst = (f32x4){bflo(w.x), bfhi(w.x), bflo(w.y), bfhi(w.y)}; *(f32x4*)(dst + 4) = (f32x4){bflo(w.z), bfhi(w.z), bflo(w.w), bfhi(w.w)};
    }
}
DI void memout_unit(const Ctx& p, int unit) {
    const bf16_t* mkv = (const bf16_t*)(p.ws + WS_MKV);
    for (int i = pg8::tid_(); i < 16 * 256; i += NTHR) {
        const int r = i >> 8, ch = i & 255, row = unit * 16 + r, col = 8 * ch;
        const u32x4 w = *(const u32x4*)(mkv + (size_t)row * 2048 + col);
        float* dst = p.out + (col >= 1024 ? O_MVP : O_MKP) + (size_t)row * D + (col & 1023);
        *(f32x4*)dst = (f32x4){bflo(w.x), bfhi(w.x), bflo(w.y), bfhi(w.y)}; *(f32x4*)(dst + 4) = (f32x4){bflo(w.z), bfhi(w.z), bflo(w.w), bfhi(w.w)};
    }
}
DI void memvt_unit(const Ctx& p, int unit) {
    const int l = unit >> 7, nb = (unit >> 3) & 15, b = unit & 7, tid = pg8::tid_(), n = nb * 64 + (tid & 63), wv = tid >> 6;
    const bf16_t* src = (const bf16_t*)(p.ws + WS_MKV) + ((size_t)l * 2048 + b * 256) * 2048 + 1024 + n;
    bf16_t* dst = (bf16_t*)(p.ws + WS_MEMVT) + ((size_t)l * 1024 + n) * 2048 + b * 256;
    for (int c = wv; c < 32; c += 8) {
        unsigned v[8];
#pragma unroll
        for (int j = 0; j < 8; ++j) v[j] = src[(size_t)(8 * c + j) * 2048];
        u32x4 w; w.x = v[0] | (v[1] << 16); w.y = v[2] | (v[3] << 16); w.z = v[4] | (v[5] << 16); w.w = v[6] | (v[7] << 16);
        *(u32x4*)(dst + 8 * c) = w;
    }
}

DI void gla_decay(const Ctx& p, int l, int h, size_t row0, int ntok, LAS unsigned char* lds) {
    const bf16_t* proj = (const bf16_t*)(p.ws + WS_PROJ);
    LAS float* Bc = (LAS float*)lds; LAS float* LR = (LAS float*)(lds + 24576); LAS float* A2 = (LAS float*)(lds + 28672); LAS float* BIA = (LAS float*)(lds + 34816); LAS float* SEG = (LAS float*)(lds + 35200);
    const int tid = pg8::tid_();
    for (int i = tid; i < 64 * 16; i += NTHR) { const int t = i >> 4, r = i & 15; LR[i] = t < ntok ? bf2f(proj[(row0 + t) * NINP + C_LR + r]) : 0.f; }
    for (int i = tid; i < 16 * 96; i += NTHR) { const int r = i / 96, k = i % 96; A2[i] = p.in[I_WA2][((size_t)l * 16 + r) * 384 + h * 96 + k]; }
    if (tid < 96) BIA[tid] = p.in[I_BA][l * 384 + h * 96 + tid];
    __syncthreads();
    for (int i = tid; i < 64 * 96; i += NTHR) {
        const int t = i / 96, k = i % 96; float s = BIA[k];
#pragma unroll
        for (int r = 0; r < 16; ++r) s += LR[t * 16 + r] * A2[r * 96 + k];
        Bc[i] = t < ntok ? -softplusf_(-s) * (1.f / 16.f) : 0.f;
    }
    __syncthreads();
    const int k = tid % 96, seg = tid / 96;
    if (tid < 384) { float run = 0.f; for (int i = 0; i < 16; ++i) { const int idx = (16 * seg + i) * 96 + k; run += Bc[idx]; Bc[idx] = run; } SEG[seg * 96 + k] = run; }
    __syncthreads();
    if (tid < 384 && seg > 0) { float off = 0.f; for (int s2 = 0; s2 < seg; ++s2) off += SEG[s2 * 96 + k]; for (int i = 0; i < 16; ++i) Bc[(16 * seg + i) * 96 + k] += off; }
    __syncthreads();
}
DI void gla_unit_rows(int gu, size_t& row0, int& ntok, int& bh, int& h) {
    if (gu < NGU_P) { bh = gu >> 5; const int c = gu & 31, b = bh >> 2; h = bh & 3; row0 = (size_t)b * SEQ + c * 64; ntok = 64; }
    else { bh = gu - NGU_P; const int b = bh >> 2; h = bh & 3; row0 = (size_t)MP + b * 16; ntok = 16; }
}
DI void gla_stage1_unit(const Ctx& p, int l, int gu, LAS unsigned char* lds) {
    const bf16_t* proj = (const bf16_t*)(p.ws + WS_PROJ);
    size_t row0; int ntok, bh, h; gla_unit_rows(gu, row0, ntok, bh, h);
    gla_decay(p, l, h, row0, ntok, lds);
    LAS float* Bc = (LAS float*)lds;
    LAS unsigned short* KT = (LAS unsigned short*)(lds + 36864);
    LAS unsigned short* VT = KT + 96 * 72;
    const int tid = pg8::tid_(), lane = tid & 63, wv = tid >> 6, fr = lane & 15, fq = lane >> 4;
    for (int i = tid; i < 64 * 96; i += NTHR) {
        const int t = i / 96, k = i % 96; float kv = 0.f, vv = 0.f;
        if (t < ntok) { const bf16_t* rp = proj + (row0 + t) * NINP + h * 96 + k; kv = bf2f(rp[C_KC]) * __expf(Bc[(ntok - 1) * 96 + k] - Bc[t * 96 + k]); vv = bf2f(rp[C_VC]); }
        KT[k * 72 + t] = f2bf(kv); VT[k * 72 + t] = f2bf(vv);
    }
    if (tid < 96) ((float*)(p.ws + WS_GDEC))[(size_t)gu * 96 + tid] = __expf(Bc[(ntok - 1) * 96 + tid]);
    __syncthreads();
    float* KV = (float*)(p.ws + WS_GKV) + (size_t)gu * (GK * GK);
    for (int tile = wv; tile < 36; tile += 8) {
        const int ki = tile / 6, vi = tile % 6; f32x4 acc = {0.f, 0.f, 0.f, 0.f};
#pragma unroll
        for (int ks = 0; ks < 2; ++ks) { const bf16x8 a = *(const LAS bf16x8*)(KT + (16 * ki + fr) * 72 + 32 * ks + 8 * fq), bb = *(const LAS bf16x8*)(VT + (16 * vi + fr) * 72 + 32 * ks + 8 * fq); acc = MFMA16(a, bb, acc); }
#pragma unroll
        for (int j = 0; j < 4; ++j) KV[(16 * ki + 4 * fq + j) * 96 + 16 * vi + fr] = acc[j];
    }
}
DI void gla_scan(const Ctx& p, int l) {
    const int gt = blockIdx.x * NTHR + pg8::tid_(), NT = gridDim.x * NTHR;
    const float* KV = (const float*)(p.ws + WS_GKV); const float* DEC = (const float*)(p.ws + WS_GDEC); float* SP = (float*)(p.ws + WS_GSP);
    for (int e = gt; e < 32 * GK * GK; e += NT) {
        const int bh = e / (GK * GK), kv = e % (GK * GK), k = kv / GK; float S = 0.f;
#pragma unroll 4
        for (int c = 0; c < 32; ++c) { const size_t gu = (size_t)bh * 32 + c; SP[gu * (GK * GK) + kv] = S; S = DEC[gu * 96 + k] * S + KV[gu * (GK * GK) + kv]; }
        p.out[O_GLAP + ((size_t)l * 32 + bh) * (GK * GK) + kv] = S;
    }
    for (int e = gt; e < 64 * GK * GK; e += NT) {
        const int bh = e / (GK * GK), kv = e % (GK * GK), k = kv / GK; const size_t gu = (size_t)NGU_P + bh;
        const float S0 = p.in[I_SGLA][((size_t)l * 64 + bh) * (GK * GK) + kv];
        p.out[O_GLAS + ((size_t)l * 64 + bh) * (GK * GK) + kv] = DEC[gu * 96 + k] * S0 + KV[gu * (GK * GK) + kv];
    }
}
DI void gla_stage3_unit(const Ctx& p, int l, int gu, LAS unsigned char* lds) {
    const bf16_t* proj = (const bf16_t*)(p.ws + WS_PROJ);
    size_t row0; int ntok, bh, h; gla_unit_rows(gu, row0, ntok, bh, h);
    gla_decay(p, l, h, row0, ntok, lds);
    LAS float* Bc = (LAS float*)lds;
    LAS unsigned short* QP = (LAS unsigned short*)(lds + 36864);
    LAS unsigned short* KP = QP + 64 * 104;
    LAS unsigned short* VT = KP + 64 * 104;
    LAS unsigned short* ST = VT + 96 * 72;
    LAS unsigned short* ATT = ST + 96 * 104;
    const int tid = pg8::tid_(), lane = tid & 63, wv = tid >> 6, fr = lane & 15, fq = lane >> 4;
    const float* Sprev = gu < NGU_P ? (const float*)(p.ws + WS_GSP) + (size_t)gu * (GK * GK) : p.in[I_SGLA] + ((size_t)l * 64 + bh) * (GK * GK);
    for (int i = tid; i < 64 * 96; i += NTHR) {
        const int t = i / 96, k = i % 96; float qv = 0.f, kv = 0.f, vv = 0.f;
        if (t < ntok) { const bf16_t* rp = proj + (row0 + t) * NINP + h * 96 + k; const float bb = Bc[i];
            qv = bf2f(rp[C_QC]) * 0.10206207261596575f * __expf(bb); kv = bf2f(rp[C_KC]) * __expf(-bb); vv = bf2f(rp[C_VC]); }
        QP[t * 104 + k] = f2bf(qv); KP[t * 104 + k] = f2bf(kv); VT[k * 72 + t] = f2bf(vv);
    }
    for (int i = tid; i < 96 * 96; i += NTHR) { const int k = i / 96, v = i % 96; ST[v * 104 + k] = f2bf(Sprev[i]); }
    __syncthreads();
    for (int tile = 2 * wv; tile < 2 * wv + 2; ++tile) {
        const int ti = tile >> 2, si = tile & 3; f32x4 acc = {0.f, 0.f, 0.f, 0.f};
        if (si <= ti) {
#pragma unroll
            for (int ks = 0; ks < 3; ++ks) { const bf16x8 a = *(const LAS bf16x8*)(QP + (16 * ti + fr) * 104 + 32 * ks + 8 * fq), bb = *(const LAS bf16x8*)(KP + (16 * si + fr) * 104 + 32 * ks + 8 * fq); acc = MFMA16(a, bb, acc); }
        }
#pragma unroll
        for (int j = 0; j < 4; ++j) { const int t = 16 * ti + 4 * fq + j, s = 16 * si + fr; ATT[t * 72 + s] = f2bf(s <= t ? acc[j] : 0.f); }
    }
    __syncthreads();
    LAS float* OT = Bc;
    for (int tile = wv; tile < 24; tile += 8) {
        const int ti = tile / 6, vi = tile % 6; f32x4 acc = {0.f, 0.f, 0.f, 0.f};
#pragma unroll
        for (int ks = 0; ks < 2; ++ks) { const bf16x8 a = *(const LAS bf16x8*)(ATT + (16 * ti + fr) * 72 + 32 * ks + 8 * fq), bb = *(const LAS bf16x8*)(VT + (16 * vi + fr) * 72 + 32 * ks + 8 * fq); acc = MFMA16(a, bb, acc); }
#pragma unroll
        for (int ks = 0; ks < 3; ++ks) { const bf16x8 a = *(const LAS bf16x8*)(QP + (16 * ti + fr) * 104 + 32 * ks + 8 * fq), bb = *(const LAS bf16x8*)(ST + (16 * vi + fr) * 104 + 32 * ks + 8 * fq); acc = MFMA16(a, bb, acc); }
#pragma unroll
        for (int j = 0; j < 4; ++j) OT[(16 * ti + 4 * fq + j) * 96 + 16 * vi + fr] = acc[j];
    }
    __syncthreads();
    bf16_t* oc = (bf16_t*)(p.ws + WS_OC);
    for (int tt = 0; tt < 8; ++tt) {
        const int t = wv * 8 + tt; if (t >= ntok) break;
        const float a0 = OT[t * 96 + lane], a1 = lane < 32 ? OT[t * 96 + 64 + lane] : 0.f;
        const float rs = rsqrtf(wave_sum(a0 * a0 + a1 * a1) * (1.f / 96.f) + EPS);
        const bf16_t* gp = proj + (row0 + t) * NINP + C_GC + h * 96; const float* gn = p.in[I_GLAN] + l * 384 + h * 96;
        { const float g = bf2f(gp[lane]); oc[(row0 + t) * 384 + h * 96 + lane] = f2bf(a0 * rs * gn[lane] * g * sigmoidf_(g)); }
        if (lane < 32) { const float g = bf2f(gp[64 + lane]); oc[(row0 + t) * 384 + h * 96 + 64 + lane] = f2bf(a1 * rs * gn[64 + lane] * g * sigmoidf_(g)); }
    }
}

DI void cross_sample_unit(const Ctx& p, int l, int b, int h, LAS unsigned char* lds) {
    LAS float* qs = (LAS float*)lds;
    LAS float* S = qs + 16 * 256;
    LAS float* PART = S + 16 * 260;
    const bf16_t* Q = (const bf16_t*)(p.ws + WS_Q);
    const int tid = pg8::tid_(), lane = tid & 63, wv = tid >> 6;
    const size_t srow = (size_t)MP + b * 16;
    for (int i = tid; i < 16 * 256; i += NTHR) qs[i] = bf2f(Q[(srow + (i >> 8)) * D + h * 256 + (i & 255)]) * 0.0625f;
    __syncthreads();
    const int m = tid & 255, half = tid >> 8;
    {
        float acc[16];
#pragma unroll
        for (int i = 0; i < 16; ++i) acc[i] = 0.f;
        const float* kp = p.in[I_CMK] + ((((size_t)l * DB + b) * 256 + m) * 4 + h) * 256 + 128 * half;
        for (int d4 = 0; d4 < 32; ++d4) {
            const f32x4 kv = *(const f32x4*)(kp + 4 * d4);
#pragma unroll
            for (int i = 0; i < 16; ++i) { const f32x4 q = *(const LAS f32x4*)(qs + i * 256 + 128 * half + 4 * d4); acc[i] += (q[0] * kv[0] + q[1] * kv[1]) + (q[2] * kv[2] + q[3] * kv[3]); }
        }
#pragma unroll
        for (int i = 0; i < 16; ++i) PART[(half * 16 + i) * 256 + m] = acc[i];
    }
    __syncthreads();
    for (int qq = 0; qq < 2; ++qq) {
        const int i = 2 * wv + qq; float v[4], mx = -3.0e38f;
#pragma unroll
        for (int j = 0; j < 4; ++j) { v[j] = PART[i * 256 + lane + 64 * j] + PART[(16 + i) * 256 + lane + 64 * j]; mx = fmaxf(mx, v[j]); }
        mx = wave_max(mx); float sum = 0.f;
#pragma unroll
        for (int j = 0; j < 4; ++j) { v[j] = __expf(v[j] - mx); sum += v[j]; }
        sum = wave_sum(sum); const float inv = 1.f / sum;
#pragma unroll
        for (int j = 0; j < 4; ++j) S[i * 260 + lane + 64 * j] = v[j] * inv;
    }
    __syncthreads();
    {
        float acc[16];
#pragma unroll
        for (int i = 0; i < 16; ++i) acc[i] = 0.f;
        const float* vp = p.in[I_CMV] + ((((size_t)l * DB + b) * 256 + 128 * half) * 4 + h) * 256 + m;
        for (int kk = 0; kk < 128; ++kk) {
            const float v = vp[(size_t)kk * 1024];
#pragma unroll
            for (int i = 0; i < 16; ++i) acc[i] += S[i * 260 + 128 * half + kk] * v;
        }
#pragma unroll
        for (int i = 0; i < 16; ++i) PART[(half * 16 + i) * 256 + m] = acc[i];
    }
    __syncthreads();
    bf16_t* O = (bf16_t*)(p.ws + WS_O);
    for (int i = tid; i < 16 * 256; i += NTHR) { const int qi = i >> 8, d = i & 255; O[(srow + qi) * D + h * 256 + d] = f2bf(PART[qi * 256 + d] + PART[(16 + qi) * 256 + d]); }
}

constexpr int PH_PER_LAYER = 15, N_PHASES = 1 + DEPTH * PH_PER_LAYER;
#define RUN_GEMM(EpiT, E, Aptr, lda_, Bptr, ldb_, K_, pm0_, nM_, nN_) do { const pg8::Gemm g_{(K_), (lda_), (ldb_)}; pg8::TileOrder S_; S_.init((Aptr), (lda_), (Bptr), (ldb_), (pm0_), (nM_), (nN_), G, bx); \
        pg8::gemm_phase<EpiT, pg8::TileOrder, true, true>(lds, g_, S_, (E)); } while (0)

__global__ void __launch_bounds__(NTHR, 2) fwd_kernel(Params p) {
    extern __shared__ __attribute__((aligned(16))) unsigned char lds_raw[];
#define PROJ ((bf16_t*)(ws + WS_PROJ))
#define H ((bf16_t*)(ws + WS_H))
#define MERGED ((bf16_t*)(ws + WS_MERGED))
#define Y ((bf16_t*)(ws + WS_Y))
#define QB ((bf16_t*)(ws + WS_Q))
#define PB ((bf16_t*)(ws + WS_P))
#define OB ((bf16_t*)(ws + WS_O))
#define ACT ((bf16_t*)(ws + WS_ACT))

    {
        volatile LAS unsigned* st0 = (volatile LAS unsigned*)((LAS unsigned char*)lds_raw + LDS_MISC + 32);
        if (pg8::tid_() == 0) { st0[0] = 0u; st0[1] = 0u; }
        __syncthreads();
    }
    XcdBarrier xbar = xcd_barrier_post((unsigned*)(p.ws + WS_CTL) + CW_BAR, (volatile LAS unsigned*)((LAS unsigned char*)lds_raw + LDS_MISC + 32));
    if (p.ph_lo == 0) {
        prologue(p, (LAS unsigned char*)lds_raw);
        if (blockIdx.x == 0 && pg8::tid_() == 0) {
            const float** tab = (const float**)(p.ws + WS_TAB);
#pragma unroll
            for (int i = 0; i < N_IN; ++i) tab[i] = p.in[i];
        }
        if (p.ph_hi > 1) cg::this_grid().sync();
    }
    for (int ph = p.ph_lo > 1 ? p.ph_lo : 1; ph < p.ph_hi; ++ph) {
        unsigned ldsb = (unsigned)(size_t)(LAS unsigned char*)lds_raw; asm volatile("" : "+s"(ldsb));
        LAS unsigned char* lds = (LAS unsigned char*)(size_t)ldsb;
        volatile LAS int* slot = (volatile LAS int*)(lds + LDS_MISC);
        unsigned char* ws = p.ws; asm volatile("" : "+s"(ws));
        Ctx c; c.ws = ws; c.in.t = (const float* const*)(ws + WS_TAB); c.out = p.out;
        unsigned* ctl = (unsigned*)(ws + WS_CTL);
        int G = gridDim.x, bx = blockIdx.x; asm volatile("" : "+s"(G), "+s"(bx));
        {
            const int l = (ph - 1) / PH_PER_LAYER, st = (ph - 1) % PH_PER_LAYER;
            switch (st) {
            case 0: {
                EpiBf16 E{PROJ, NINP, 0xffff};
                RUN_GEMM(EpiBf16, E, H, D, ws + WS_WIN + l * SZ_WIN, D, D, 0, MA / 256, NINP / 256);
                if (l == 0) {
                    const pg8::Gemm g{D, D, D}; MemKvOrder S{G, bx, (const char*)(ws + WS_MN), (const char*)(ws + WS_WKV)};
                    EpiBf16 E2{(bf16_t*)(ws + WS_MKV), 2048, 7};
                    pg8::gemm_phase<EpiBf16, MemKvOrder, true, true>(lds, g, S, E2);
                }
            } break;
            case 1: {
                unsigned* ctr = ctl + 64 * ph;
                constexpr int U_SBP = 384, U_SBS = U_SBP + DB * 6, U_GLA = U_SBS + NGU, U_POOL = U_GLA + MA / 64, U_KV = U_POOL + MA / 64, U_MO = U_KV + 512, U_VT = U_MO + 512;
                const int U_ALL = l == 0 ? U_VT : U_KV;
                for (;;) {
                    const int u = next_work(ctr, slot); if (u >= U_ALL) break;
                    if (u < U_SBP) { const int qb = 7 - u / 48, bh = u % 48; sb_prompt_unit(c, bh / 6, bh % 6, qb, lds); }
                    else if (u < U_SBS) { const int v = u - U_SBP; sb_sample_unit(c, l, v / 6, v % 6, lds); }
                    else if (u < U_GLA) gla_stage1_unit(c, l, u - U_SBS, lds);
                    else if (u < U_POOL) pool_unit(c, l, u - U_GLA);
                    else if (u < U_KV) kvout_unit(c, l, u - U_POOL);
                    else if (u < U_MO) memout_unit(c, u - U_KV);
                    else memvt_unit(c, u - U_MO);
                }
            } break;
            case 2: gla_scan(c, l); break;
            case 3: {
                unsigned* ctr = ctl + 64 * ph;
                for (;;) { const int u = next_work(ctr, slot); if (u >= NGU) break; gla_stage3_unit(c, l, u, lds); }
            } break;
            case 4: {
                EpiGate E1{MERGED, PROJ, C_GA, 0}, E2{MERGED, PROJ, C_GB, 1}, E3{MERGED, PROJ, C_GCG, 1};
                RUN_GEMM(EpiGate, E1, ws + WS_OA, 384, ws + WS_WBA + l * SZ_WBA, 384, 384, 0, MA / 256, 4);
                RUN_GEMM(EpiGate, E2, ws + WS_POOLED, 256, ws + WS_WBB + l * SZ_WBB, 256, 256, 0, MA / 256, 4);
                RUN_GEMM(EpiGate, E3, ws + WS_OC, 384, ws + WS_WBC + l * SZ_WBA, 384, 384, 0, MA / 256, 4);
            } break;
            case 5: { EpiBf16 E{Y, D, 0xffff}; RUN_GEMM(EpiBf16, E, MERGED, D, ws + WS_WMIX + l * SZ_WSQ, D, D, 0, MA / 256, 4); } break;
            case 6: norm_phase(c, c.in[I_NMIXPOST] + l * D, c.in[I_NXPRE] + l * D, G, bx); break;
            case 7: { EpiBf16 E{QB, D, 0xffff}; RUN_GEMM(EpiBf16, E, H, D, ws + WS_WXQ + l * SZ_WSQ, D, D, 0, MA / 256, 4); } break;
            case 8: {
                const pg8::Gemm g{256, D, 2048}; CrossOrder S{G, bx, (const char*)QB, (const char*)(ws + WS_MKV + (size_t)l * 2 * SZ_WKV), 0};
                EpiSoftmax E{PB, (LAS float*)(lds + LDS_X)};
                pg8::gemm_phase<EpiSoftmax, CrossOrder, true, true>(lds, g, S, E);
            } break;
            case 9: {
                const pg8::Gemm g{256, D, 2048}; CrossOrder S{G, bx, (const char*)PB, (const char*)(ws + WS_MEMVT + (size_t)l * SZ_WKV), 1};
                EpiBf16 E{OB, D, 0xffff};
                pg8::gemm_phase<EpiBf16, CrossOrder, true, true>(lds, g, S, E);
                for (int u = bx; u < DB * 4; u += G) { __syncthreads(); cross_sample_unit(c, l, u >> 2, u & 3, lds); }
            } break;
            case 10: { EpiBf16 E{Y, D, 0xffff}; RUN_GEMM(EpiBf16, E, OB, D, ws + WS_WXO + l * SZ_WSQ, D, D, 0, MA / 256, 4); } break;
            case 11: norm_phase(c, c.in[I_NXPOST] + l * D, c.in[I_NFPRE] + l * D, G, bx); break;
            case 12: { EpiSwiglu E{ACT}; RUN_GEMM(EpiSwiglu, E, H, D, ws + WS_WF1 + l * SZ_WF1, D, D, 0, MA / 256, FF2 / 256); } break;
            case 13: { EpiBf16 E{Y, D, 0xffff}; RUN_GEMM(EpiBf16, E, ACT, FF, ws + WS_WF2 + l * SZ_WF2, FF, FF, 0, MA / 256, 4); } break;
            default: norm_phase(c, c.in[I_NFPOST] + l * D, l < DEPTH - 1 ? c.in[I_NMIXPRE] + (l + 1) * D : nullptr, G, bx); break;
            }
        }
        if (ph + 1 < p.ph_hi) { if ((ph - 1) % PH_PER_LAYER == 8) { __threadfence(); __syncthreads(); } else xcd_barrier(xbar); }
    }
}

extern "C" void kernel_launch(void* const* d_in, const int* in_sizes, int n_in, void* d_out, int out_size, void* d_ws, size_t ws_size, hipStream_t stream) {
    static int grid = 0;
    if (grid == 0) {
        if (n_in != N_IN || (size_t)out_size != O_END || ws_size < WS_END) { fprintf(stderr, "kernel_launch: unexpected shapes: n_in %d out %d ws %zu (need %zu)\n", n_in, out_size, ws_size, (size_t)WS_END); grid = -1; return; }
        int dev = 0, cus = 0, per_cu = 0;
        (void)hipGetDevice(&dev); (void)hipDeviceGetAttribute(&cus, hipDeviceAttributeMultiprocessorCount, dev);
        (void)hipFuncSetAttribute((const void*)fwd_kernel, hipFuncAttributeMaxDynamicSharedMemorySize, LDS_BYTES);
        if (hipOccupancyMaxActiveBlocksPerMultiprocessor(&per_cu, (const void*)fwd_kernel, NTHR, LDS_BYTES) != hipSuccess || per_cu < 1) { fprintf(stderr, "kernel_launch: occupancy query gave %d\n", per_cu); per_cu = 1; }
        (void)hipGetLastError();
        grid = cus * per_cu;
    }
    if (grid < 0) return;
    (void)hipMemsetAsync((char*)d_ws + WS_CTL, 0, CTL_BYTES, stream);
    Params p{};
    for (int i = 0; i < N_IN; ++i) p.in[i] = (const float*)d_in[i];
    p.out = (float*)d_out; p.ws = (unsigned char*)d_ws;
#ifdef MULTI_LAUNCH
    for (int ph = 0; ph < N_PHASES; ++ph) { p.ph_lo = ph; p.ph_hi = ph + 1; hipLaunchKernelGGL(fwd_kernel, dim3(grid), dim3(NTHR), LDS_BYTES, stream, p); }
#else
    p.ph_lo = 0; p.ph_hi = N_PHASES;
    void* args[] = {&p};
    const hipError_t e = hipLaunchCooperativeKernel((const void*)fwd_kernel, dim3(grid), dim3(NTHR), args, LDS_BYTES, stream);
    if (e != hipSuccess) fprintf(stderr, "kernel_launch: cooperative launch failed: %s (grid %d)\n", hipGetErrorString(e), grid);
#endif
}
```

```cpp
#include <hip/hip_runtime.h>
#include <hip/hip_cooperative_groups.h>
#include <cstdio>
#include <cstdint>
namespace cg = cooperative_groups;

namespace pg8 {
#define PG8_LAS __attribute__((address_space(3)))
typedef unsigned short bf16_t;
typedef short bf16x8 __attribute__((ext_vector_type(8)));
typedef float f32x4 __attribute__((ext_vector_type(4)));
typedef unsigned u32x4 __attribute__((ext_vector_type(4)));
typedef unsigned u32x2 __attribute__((ext_vector_type(2)));
constexpr int BM = 256, BK = 64, HALF = 128, HTB = HALF * BK * 2  , STAGE_BYTES = 8 * HTB, NXCD = 8, WGM = 8;

__host__ __device__ __forceinline__ int lds_byte(int r, int c) { const int st = (r >> 4) * 2 + (c >> 5), rr = r & 15, cc = c & 31, ob = rr * 64 + cc * 2; return st * 1024 + (ob ^ (((ob >> 9) & 1) << 5)); }
__host__ __device__ __forceinline__ void stage_rc(int b, int& R, int& C) { const int st = b / 1024, sb = b % 1024, swz = sb ^ (((sb >> 9) & 1) << 5); R = (st >> 1) * 16 + swz / 64; C = (st & 1) * 32 + (swz % 64) / 2; }
__host__ __device__ __forceinline__ int perm32(int rho) { const int n = rho >> 4, i = rho & 15; return 8 * (i >> 2) + 4 * n + (i & 3); }

struct Unit { int pm, pn; const char* a; const char* b; };
struct Gemm { int K, lda, ldb; };

struct TileOrder {
    int nM, nN, G, c, lda, ldb; const char* A; const char* B;
    __device__ void init(const void* A_, int lda_, const void* B_, int ldb_, int, int nM_, int nN_, int G_, int c_) {
        A = (const char*)A_; B = (const char*)B_; lda = lda_; ldb = ldb_; nM = nM_; nN = nN_; G = G_; c = c_; }
    __device__ bool next(int i, Unit& u) const {
        const int nwg = nM * nN; const long L = (long)i * G + c; if (L >= nwg) return false;
        int wgid = (int)L; { const int q = nwg / NXCD, r = nwg % NXCD, xcd = wgid % NXCD, off = wgid / NXCD; wgid = (xcd < r ? xcd * (q + 1) : r * (q + 1) + (xcd - r) * q) + off; }
        const int nig = WGM * nN, gid = wgid / nig, fm = gid * WGM, gsz = (nM - fm) < WGM ? (nM - fm) : WGM;
        u.pm = fm + ((wgid % nig) % gsz); u.pn = (wgid % nig) / gsz; u.a = A + (size_t)u.pm * ((size_t)BM * 2 * lda); u.b = B + (size_t)u.pn * ((size_t)BM * 2 * ldb); return true;
    }
    __device__ __forceinline__ void a_ready(const Unit&) const {}
    __device__ __forceinline__ void done(const Unit&) const {}
};

__device__ __forceinline__ int tid_() { int t = threadIdx.x; asm volatile("" : "+v"(t)); return t; }
__device__ __forceinline__ unsigned cvt_pk_bf16(float lo, float hi) { unsigned r; asm volatile("v_cvt_pk_bf16_f32 %0, %1, %2" : "=v"(r) : "v"(lo), "v"(hi)); return r; }

template <class Epi, class Sched, bool ALIGN_EPI = false, bool SP2 = false>
__device__ __forceinline__ void gemm_phase(PG8_LAS unsigned char* lds, const Gemm g, const Sched& S, const Epi& E) {
    const int tid = pg8::tid_(), wid = __builtin_amdgcn_readfirstlane(tid >> 6), lane = tid & 63, wr = wid >> 2, wc = wid & 3, fr = lane & 15, fq = lane >> 4;
    const int K = g.K, nt = K / BK;
    unsigned voffA, voffB;
    { int R, C; stage_rc(tid * 16, R, C); const int Rb = Epi::PERM ? ((R & ~31) + perm32(R & 31)) : R;
        voffA = (unsigned)(R * g.lda + C) * 2u; voffB = (unsigned)(Rb * g.ldb + C) * 2u; }
    const size_t qstepA = (size_t)64 * g.lda * 2, qstepB = (size_t)64 * g.ldb * 2;
    const size_t kstep = (size_t)(BK * 2);
    const size_t hstepA = (size_t)HALF * g.lda * 2, hstepB = (size_t)HALF * g.ldb * 2;
    const unsigned ldsw = (unsigned)wid * 1024u;
    const int aoff = lds_byte(wr * 64 + fr, fq * 8), boff = lds_byte(wc * 32 + fr, fq * 8);
#define PG8_SA(b, h) (((b) * 2 + (h)) * HTB)
#define PG8_SB(b, h) ((4 + (b) * 2 + (h)) * HTB)
#define PG8_STAGE(bufoff, gbase, voff) do { _Pragma("unroll") for (int _i = 0; _i < 2; ++_i) { const char* sb_ = (const char*)(gbase) + (size_t)_i * q##voff; asm volatile("" : "+s"(sb_));   \
        __builtin_amdgcn_global_load_lds((const unsigned*)(sb_ + (voff)), (PG8_LAS unsigned*)(lds + (bufoff) + ldsw + _i * 8192), 16, 0, 0); } } while (0)
#define qvoffA qstepA
#define qvoffB qstepB
#define PG8_LDA(dst, b, h) do { _Pragma("unroll") for (int m = 0; m < 4; ++m) _Pragma("unroll") for (int k = 0; k < 2; ++k) dst[m][k] = *(const PG8_LAS bf16x8*)(lds + PG8_SA(b, h) + aoff + m * 2048 + k * 1024); } while (0)
#define PG8_LDB(dst, b, h) do { _Pragma("unroll") for (int n = 0; n < 2; ++n) _Pragma("unroll") for (int k = 0; k < 2; ++k) dst[n][k] = *(const PG8_LAS bf16x8*)(lds + PG8_SB(b, h) + boff + n * 2048 + k * 1024); } while (0)
#define PG8_MMA(ai, bj, At, Bt) do { __builtin_amdgcn_s_setprio(1); _Pragma("unroll") for (int m = 0; m < 4; ++m) _Pragma("unroll") for (int n = 0; n < 2; ++n) _Pragma("unroll") for (int k = 0; k < 2; ++k) \
        acc[ai][bj][m][n] = __builtin_amdgcn_mfma_f32_16x16x32_bf16(Bt[n][k], At[m][k], acc[ai][bj][m][n], 0, 0, 0); __builtin_amdgcn_s_setprio(0); } while (0)
#define PG8_WAIT_V(n) asm volatile("s_waitcnt vmcnt(" #n ")" ::: "memory")
#define PG8_WAIT_L(n) asm volatile("s_waitcnt lgkmcnt(" #n ")" ::: "memory")
#define PG8_BAR __builtin_amdgcn_s_barrier()
#define PG8_SCHED __builtin_amdgcn_sched_barrier(0)
    Unit cur, nxt; int ui = 0;
    if (!S.next(0, cur)) return;
    f32x4 acc[2][2][4][2];
#pragma unroll
    for (int a = 0; a < 2; ++a)
#pragma unroll
        for (int b = 0; b < 2; ++b)
#pragma unroll
            for (int m = 0; m < 4; ++m)
#pragma unroll
                for (int n = 0; n < 2; ++n) acc[a][b][m][n] = (f32x4){0.f, 0.f, 0.f, 0.f};
    bf16x8 At[4][2], B0[2][2], B1[2][2];
    const char* cA = cur.a; const char* cB = cur.b;
    S.a_ready(cur);
    if constexpr (SP2) {
        PG8_STAGE(PG8_SB(0, 0), cB, voffB); PG8_STAGE(PG8_SB(0, 1), cB + hstepB, voffB); PG8_STAGE(PG8_SA(0, 0), cA, voffA); PG8_STAGE(PG8_SA(0, 1), cA + hstepA, voffA);
        if (wr == 1) PG8_BAR;
        PG8_WAIT_V(2); PG8_BAR;
        PG8_STAGE(PG8_SB(1, 0), cB + kstep, voffB); PG8_STAGE(PG8_SA(1, 0), cA + kstep, voffA); PG8_STAGE(PG8_SB(1, 1), cB + hstepB + kstep, voffB);
        PG8_WAIT_V(6); PG8_BAR;
    } else {
        PG8_STAGE(PG8_SB(0, 0), cB, voffB); PG8_STAGE(PG8_SA(0, 0), cA, voffA); PG8_STAGE(PG8_SB(0, 1), cB + hstepB, voffB); PG8_STAGE(PG8_SA(0, 1), cA + hstepA, voffA);
        if (wr == 1) PG8_BAR;
        PG8_WAIT_V(4); PG8_BAR;
        PG8_STAGE(PG8_SB(1, 0), cB + kstep, voffB); PG8_STAGE(PG8_SA(1, 0), cA + kstep, voffA); PG8_STAGE(PG8_SB(1, 1), cB + hstepB + kstep, voffB);
        PG8_WAIT_V(6); PG8_BAR;
    }
    for (;;) {
        const bool has_next = S.next(ui + 1, nxt);
        const char* nA = has_next ? nxt.a : cA; const char* nB = has_next ? nxt.b : cB;
        for (int t = 0; t < nt; t += 2) {
            const bool last = (t == nt - 2);
            const char* a1 = cA + (size_t)(t + 1) * kstep;
            const char* a2 = last ? nA : cA + (size_t)(t + 2) * kstep; const char* b2 = last ? nB : cB + (size_t)(t + 2) * kstep;
            const char* a3 = a2 + kstep; const char* b3 = b2 + kstep;
            if (last && has_next) S.a_ready(nxt);
            if constexpr (SP2) {
            PG8_LDB(B0, 0, 0); PG8_LDB(B1, 0, 1); PG8_SCHED; PG8_LDA(At, 0, 0); PG8_STAGE(PG8_SA(1, 1), a1 + hstepA, voffA);
            PG8_WAIT_V(8); PG8_WAIT_L(0); PG8_BAR; PG8_MMA(0, 0, At, B0); PG8_MMA(0, 1, At, B1); PG8_BAR; PG8_SCHED;
            PG8_LDA(At, 0, 1); PG8_STAGE(PG8_SB(0, 0), b2, voffB); PG8_STAGE(PG8_SB(0, 1), b2 + hstepB, voffB); PG8_STAGE(PG8_SA(0, 0), a2, voffA);
            PG8_WAIT_V(8); PG8_WAIT_L(0); PG8_BAR; PG8_MMA(1, 0, At, B0); PG8_MMA(1, 1, At, B1); PG8_BAR; PG8_SCHED;
            PG8_LDB(B0, 1, 0); PG8_LDB(B1, 1, 1); PG8_SCHED; PG8_LDA(At, 1, 0); PG8_STAGE(PG8_SA(0, 1), a2 + hstepA, voffA);
            PG8_WAIT_V(8); PG8_WAIT_L(0); PG8_BAR; PG8_MMA(0, 0, At, B0); PG8_MMA(0, 1, At, B1); PG8_BAR; PG8_SCHED;
            PG8_LDA(At, 1, 1); PG8_STAGE(PG8_SB(1, 0), b3, voffB); PG8_STAGE(PG8_SB(1, 1), b3 + hstepB, voffB); PG8_STAGE(PG8_SA(1, 0), a3, voffA);
            PG8_WAIT_V(8); PG8_WAIT_L(0); PG8_BAR; PG8_MMA(1, 0, At, B0); PG8_MMA(1, 1, At, B1); PG8_BAR; PG8_SCHED;
            } else {
            PG8_LDB(B0, 0, 0); PG8_SCHED; PG8_LDA(At, 0, 0); PG8_STAGE(PG8_SA(1, 1), a1 + hstepA, voffA);
            PG8_WAIT_L(8); PG8_BAR; PG8_WAIT_L(0); PG8_MMA(0, 0, At, B0); PG8_BAR; PG8_SCHED;
            PG8_LDB(B1, 0, 1); PG8_STAGE(PG8_SB(0, 0), b2, voffB);
            PG8_BAR; PG8_WAIT_L(0); PG8_MMA(0, 1, At, B1); PG8_BAR;
            PG8_LDA(At, 0, 1); PG8_STAGE(PG8_SA(0, 0), a2, voffA);
            PG8_BAR; PG8_WAIT_L(0); PG8_MMA(1, 0, At, B0); PG8_BAR; PG8_SCHED;
            PG8_STAGE(PG8_SB(0, 1), b2 + hstepB, voffB);
            PG8_WAIT_V(6); PG8_BAR; PG8_MMA(1, 1, At, B1); PG8_BAR;
            PG8_LDB(B0, 1, 0); PG8_SCHED; PG8_LDA(At, 1, 0); PG8_STAGE(PG8_SA(0, 1), a2 + hstepA, voffA);
            PG8_WAIT_L(8); PG8_BAR; PG8_WAIT_L(0); PG8_MMA(0, 0, At, B0); PG8_BAR; PG8_SCHED;
            PG8_LDB(B1, 1, 1); PG8_STAGE(PG8_SB(1, 0), b3, voffB);
            PG8_BAR; PG8_WAIT_L(0); PG8_MMA(0, 1, At, B1); PG8_BAR;
            PG8_LDA(At, 1, 1); PG8_STAGE(PG8_SA(1, 0), a3, voffA);
            PG8_BAR; PG8_WAIT_L(0); PG8_MMA(1, 0, At, B0); PG8_BAR; PG8_SCHED;
            PG8_STAGE(PG8_SB(1, 1), b3 + hstepB, voffB);
            PG8_WAIT_V(6); PG8_BAR; PG8_MMA(1, 1, At, B1); PG8_BAR;
            }
        }
        if constexpr (ALIGN_EPI) { if (wr == 0) PG8_BAR; }
        if constexpr (!Epi::AFTER_DRAIN) { const int l2_ = tid_() & 63, fr2 = l2_ & 15, fq2 = l2_ >> 4;   E(acc, cur, wr, wc, fr2, fq2); S.done(cur); }
        if (!has_next) break;
#pragma unroll
        for (int a = 0; a < 2; ++a)
#pragma unroll
            for (int b = 0; b < 2; ++b)
#pragma unroll
                for (int m = 0; m < 4; ++m)
#pragma unroll
                    for (int n = 0; n < 2; ++n) acc[a][b][m][n] = (f32x4){0.f, 0.f, 0.f, 0.f};
        cur = nxt; cA = nA; cB = nB; ++ui;
        if constexpr (ALIGN_EPI) { if (wr == 1) PG8_BAR; }
    }
    PG8_WAIT_V(0);
    if constexpr (!ALIGN_EPI) { if (wr == 0) PG8_BAR; }
    PG8_BAR;
    if constexpr (Epi::AFTER_DRAIN) { E.fused(acc, cur, wr, wc, fr, fq, lds, wid, lane); S.done(cur); }
#undef PG8_SA
#undef PG8_SB
#undef PG8_STAGE
#undef qvoffA
#undef qvoffB
#undef PG8_LDA
#undef PG8_LDB
#undef PG8_MMA
#undef PG8_WAIT_V
#undef PG8_WAIT_L
#undef PG8_BAR
#undef PG8_SCHED
}
}

using pg8::bf16_t; using pg8::f32x4; using pg8::bf16x8; using pg8::u32x4; using pg8::u32x2;
#define DI __device__ __forceinline__
#define LAS __attribute__((address_space(3)))
typedef float f32x16 __attribute__((ext_vector_type(16)));
typedef short s16x4 __attribute__((ext_vector_type(4)));
typedef float f32x2_t __attribute__((ext_vector_type(2))); typedef __bf16 bf16x2_t __attribute__((ext_vector_type(2)));

constexpr int NTHR = 512, NWAVES = 8;
constexpr int D = 1024, NB = 8, SEQ = 2048, DEPTH = 4, DB = 16, DT = 16, PAST = 1024;
constexpr int MP = NB * SEQ, MS = DB * DT, MA = MP + MS;
constexpr int NIN = 6032, NINP = 6144;
constexpr int C_QA = 0, C_KA = 384, C_VA = 768, C_U = 1152, C_QC = 1408, C_KC = 1792, C_VC = 2176, C_GC = 2560, C_LR = 2944, C_GA = 2960, C_GB = 3984, C_GCG = 5008;
constexpr int FF = 2816, FF2 = 5632;
constexpr int GH = 4, GK = 96;
constexpr int NGU_P = NB * GH * 32, NGU_S = DB * GH, NGU = NGU_P + NGU_S;
constexpr float EPS = 1e-6f;

constexpr size_t O_YP = 0, O_YS = O_YP + (size_t)MP * D, O_KP = O_YS + (size_t)MS * D, O_VP = O_KP + (size_t)DEPTH * MP * 384, O_POOLP = O_VP + (size_t)DEPTH * MP * 384,
    O_GLAP = O_POOLP + (size_t)DEPTH * NB * 15 * 256, O_MKP = O_GLAP + (size_t)DEPTH * NB * GH * GK * GK, O_MVP = O_MKP + (size_t)DEPTH * NB * 256 * D,
    O_KS = O_MVP + (size_t)DEPTH * NB * 256 * D, O_VS = O_KS + (size_t)DEPTH * MS * 384, O_POOLS = O_VS + (size_t)DEPTH * MS * 384, O_GLAS = O_POOLS + (size_t)DEPTH * DB * 15 * 256,
    O_END = O_GLAS + (size_t)DEPTH * DB * GH * GK * GK;

enum { I_XP = 0, I_XS, I_MEM, I_CSK, I_CSV, I_SPOOL, I_SGLA, I_CMK, I_CMV, I_WIN, I_WA2, I_BA, I_GLAN, I_WPOOL, I_PSCALE, I_WBA, I_WBB, I_WBC, I_WMIX, I_MEMN, I_WXQ, I_WXK, I_WXV, I_WXO,
       I_WF1, I_WF2, I_NMIXPRE, I_NMIXPOST, I_NXPRE, I_NXPOST, I_NFPRE, I_NFPOST, N_IN };

constexpr size_t MiB = 1u << 20;
constexpr size_t SZ_WIN = (size_t)NINP * D * 2, SZ_WBA = (size_t)D * 384 * 2, SZ_WBB = (size_t)D * 256 * 2, SZ_WSQ = (size_t)D * D * 2, SZ_WKV = 2 * SZ_WSQ, SZ_WF1 = (size_t)FF2 * D * 2, SZ_WF2 = (size_t)D * FF * 2;
constexpr size_t WS_CTL = 0, CTL_BYTES = 1 * MiB, WS_TAB = CTL_BYTES - 4096;
constexpr size_t WS_WIN = WS_CTL + CTL_BYTES, WS_WBA = WS_WIN + 4 * SZ_WIN, WS_WBB = WS_WBA + 4 * SZ_WBA, WS_WBC = WS_WBB + 4 * SZ_WBB, WS_WMIX = WS_WBC + 4 * SZ_WBA,
    WS_WXQ = WS_WMIX + 4 * SZ_WSQ, WS_WXO = WS_WXQ + 4 * SZ_WSQ, WS_WKV = WS_WXO + 4 * SZ_WSQ, WS_WF1 = WS_WKV + 4 * SZ_WKV, WS_WF2 = WS_WF1 + 4 * SZ_WF1,
    WS_MN = WS_WF2 + 4 * SZ_WF2, WS_MKV = WS_MN + 4 * SZ_WKV, WS_MEMVT = WS_MKV + 8 * SZ_WKV, WS_PROJ = WS_MEMVT + 4 * SZ_WKV;
constexpr size_t SZ_ROWS = (size_t)MA * D * 2;
constexpr size_t SZ_PROJ = (size_t)MA * NINP * 2;
constexpr size_t WS_Q = WS_PROJ, WS_P = WS_Q + SZ_ROWS, WS_O = WS_P + SZ_ROWS, WS_ACT = WS_O + SZ_ROWS;
static_assert(WS_ACT + (size_t)MA * FF * 2 <= WS_PROJ + SZ_PROJ, "overlay fits");
constexpr size_t WS_H = WS_PROJ + SZ_PROJ, WS_MERGED = WS_H + SZ_ROWS, WS_Y = WS_MERGED + SZ_ROWS;
constexpr size_t WS_GKV = WS_H, WS_GSP = WS_GKV + 39 * MiB, WS_GDEC = WS_GSP + 37 * MiB;
static_assert((size_t)NGU * GK * GK * 4 <= 39 * MiB && (size_t)NGU_P * GK * GK * 4 <= 37 * MiB && WS_GDEC + (size_t)NGU * GK * 4 <= WS_Y + SZ_ROWS, "GLA overlay fits");
constexpr size_t WS_OA = WS_Y + SZ_ROWS, WS_POOLED = WS_OA + (size_t)MA * 384 * 2, WS_OC = WS_POOLED + (size_t)MA * 256 * 2, WS_END = WS_OC + (size_t)MA * 384 * 2;
static_assert(WS_WIN % 256 == 0 && WS_PROJ % 256 == 0 && WS_H % 256 == 0 && WS_OA % 256 == 0 && WS_POOLED % 256 == 0 && WS_OC % 256 == 0 && WS_P % 256 == 0, "alignment");

constexpr int CW_BAR = 16384;
constexpr int LDS_GEMM = 131072, LDS_X = LDS_GEMM, LDS_X_BYTES = 12288, LDS_MISC = LDS_X + LDS_X_BYTES, LDS_BYTES = LDS_MISC + 256;

struct Params { const float* in[N_IN]; float* out; unsigned char* ws; int ph_lo, ph_hi; };
struct InTab { const float* const* t;
    __device__ __forceinline__ const float* operator[](int i) const { const unsigned long long v = (unsigned long long)t[i];
        const unsigned lo = __builtin_amdgcn_readfirstlane((unsigned)v), hi = __builtin_amdgcn_readfirstlane((unsigned)(v >> 32)); return (const float*)(((unsigned long long)hi << 32) | lo); } };
struct Ctx { InTab in; float* out; unsigned char* ws; };

DI float bflo(unsigned w) { return __uint_as_float(w << 16); }
DI float bfhi(unsigned w) { return __uint_as_float(w & 0xffff0000u); }
DI float bf2f(unsigned short v) { return __uint_as_float((unsigned)v << 16); }
DI unsigned pk2(float lo, float hi) { f32x2_t v = {lo, hi}; bf16x2_t b = __builtin_convertvector(v, bf16x2_t); return __builtin_bit_cast(unsigned, b); }
DI unsigned short f2bf(float f) { return (unsigned short)(pk2(f, 0.f) & 0xffffu); }
DI float wave_sum(float v) {
#pragma unroll
    for (int o = 1; o < 64; o <<= 1) v += __shfl_xor(v, o);
    return v;
}
DI float wave_max(float v) {
#pragma unroll
    for (int o = 1; o < 64; o <<= 1) v = fmaxf(v, __shfl_xor(v, o));
    return v;
}
DI float sigmoidf_(float x) { return __builtin_amdgcn_rcpf(1.f + __expf(-x)); }
DI float softplusf_(float z) { return fmaxf(z, 0.f) + __logf(1.f + __expf(-fabsf(z))); }
DI int next_work(unsigned* ctr, volatile LAS int* slot) {
    __syncthreads();
    if (pg8::tid_() == 0) *slot = (int)atomicAdd(ctr, 1u);
    __syncthreads();
    return *slot;
}

typedef const pg8::f32x4 (&AccRef)[2][2][4][2];
struct EpiBf16 {
    static constexpr bool PERM = true, AFTER_DRAIN = false;
    bf16_t* O; int ldc; int pnmask;
    DI void operator()(AccRef acc, const pg8::Unit& u, int wr, int wc, int fr, int fq) const {
#pragma unroll
        for (int ai = 0; ai < 2; ++ai)
#pragma unroll
            for (int m = 0; m < 4; ++m) {
                bf16_t* rowp = O + (size_t)(u.pm * 256 + ai * 128 + wr * 64 + m * 16 + fr) * ldc + (u.pn & pnmask) * 256 + wc * 32 + 8 * fq;
#pragma unroll
                for (int bj = 0; bj < 2; ++bj) {
                    const f32x4 v0 = acc[ai][bj][m][0], v1 = acc[ai][bj][m][1];
                    u32x4 w; w.x = pk2(v0[0], v0[1]); w.y = pk2(v0[2], v0[3]); w.z = pk2(v1[0], v1[1]); w.w = pk2(v1[2], v1[3]);
                    *(u32x4*)(rowp + bj * 128) = w;
                }
            }
    }
};
struct EpiGate {
    static constexpr bool PERM = true, AFTER_DRAIN = false;
    bf16_t* merged; const bf16_t* proj; int goff; int accum;
    DI void operator()(AccRef acc, const pg8::Unit& u, int wr, int wc, int fr, int fq) const {
#pragma unroll
        for (int ai = 0; ai < 2; ++ai)
#pragma unroll
            for (int m = 0; m < 4; ++m) {
                const int row = u.pm * 256 + ai * 128 + wr * 64 + m * 16 + fr;
                const bf16_t* gp = proj + (size_t)row * NINP + goff + u.pn * 256 + wc * 32 + 8 * fq;
                bf16_t* mp = merged + (size_t)row * D + u.pn * 256 + wc * 32 + 8 * fq;
#pragma unroll
                for (int bj = 0; bj < 2; ++bj)
#pragma unroll
                    for (int n = 0; n < 2; ++n) {
                        const u32x2 g = *(const u32x2*)(gp + bj * 128 + 4 * n);
                        u32x2 pm2 = {0u, 0u}; if (accum) pm2 = *(const u32x2*)(mp + bj * 128 + 4 * n);
                        const f32x4 v = acc[ai][bj][m][n];
                        const float r0 = sigmoidf_(bflo(g.x)) * v[0] + bflo(pm2.x), r1 = sigmoidf_(bfhi(g.x)) * v[1] + bfhi(pm2.x);
                        const float r2 = sigmoidf_(bflo(g.y)) * v[2] + bflo(pm2.y), r3 = sigmoidf_(bfhi(g.y)) * v[3] + bfhi(pm2.y);
                        u32x2 w; w.x = pk2(r0, r1); w.y = pk2(r2, r3);
                        *(u32x2*)(mp + bj * 128 + 4 * n) = w;
                        asm volatile("" ::: "memory");
                    }
            }
    }
};
struct EpiSwiglu {
    static constexpr bool PERM = true, AFTER_DRAIN = false;
    bf16_t* act;
    DI void operator()(AccRef acc, const pg8::Unit& u, int wr, int wc, int fr, int fq) const {
#pragma unroll
        for (int ai = 0; ai < 2; ++ai)
#pragma unroll
            for (int m = 0; m < 4; ++m) {
                const int row = u.pm * 256 + ai * 128 + wr * 64 + m * 16 + fr;
#pragma unroll
                for (int bj = 0; bj < 2; ++bj) {
                    const int col0 = u.pn * 256 + bj * 128 + wc * 32 + 8 * fq;
                    const f32x4 g = acc[ai][bj][m][0], up = acc[ai][bj][m][1];
                    float r[4];
#pragma unroll
                    for (int j = 0; j < 4; ++j) r[j] = g[j] * sigmoidf_(g[j]) * up[j];
                    u32x2 w; w.x = pk2(r[0], r[1]); w.y = pk2(r[2], r[3]);
                    *(u32x2*)(act + (size_t)row * FF + (col0 >> 1)) = w;
                }
            }
    }
};
struct MemKvOrder {
    int G, c; const char* A; const char* B;
    DI bool next(int i, pg8::Unit& u) const {
        const int L = i * G + c; if (L >= 256) return false;
        const int l = L >> 6, r = L & 63; u.pm = l * 8 + (r & 7); u.pn = l * 8 + (r >> 3);
        u.a = A + (size_t)u.pm * (256 * D * 2); u.b = B + (size_t)u.pn * (256 * D * 2); return true;
    }
    DI void a_ready(const pg8::Unit&) const {}
    DI void done(const pg8::Unit&) const {}
};
struct CrossOrder {
    int G, c; const char* A; const char* B; int mode;
    DI bool next(int i, pg8::Unit& u) const {
        const int L = i * G + c; if (L >= 256) return false;
        u.pm = L >> 2; u.pn = L & 3; const int b = u.pm >> 3, h = u.pn;
        u.a = A + ((size_t)u.pm * 256 * D + h * 256) * 2;
        u.b = mode == 0 ? B + ((size_t)b * 256 * 2048 + h * 256) * 2 : B + ((size_t)h * 256 * 2048 + b * 256) * 2;
        return true;
    }
    DI void a_ready(const pg8::Unit&) const {}
    DI void done(const pg8::Unit&) const {}
};
struct EpiSoftmax {
    static constexpr bool PERM = true, AFTER_DRAIN = false;
    bf16_t* P; LAS float* xs;
    DI void operator()(AccRef acc, const pg8::Unit& u, int wr, int wc, int fr, int fq) const {
        const float sc = 0.0625f * 1.4426950408889634f;
        LAS float* xm = xs; LAS float* xsum = xs + 1024;
#pragma unroll
        for (int ai = 0; ai < 2; ++ai)
#pragma unroll
            for (int m = 0; m < 4; ++m) {
                float a = -3.0e38f;
#pragma unroll
                for (int bj = 0; bj < 2; ++bj)
#pragma unroll
                    for (int n = 0; n < 2; ++n) { const f32x4 v = acc[ai][bj][m][n]; a = fmaxf(a, fmaxf(fmaxf(v[0], v[1]), fmaxf(v[2], v[3]))); }
                a = fmaxf(a, __shfl_xor(a, 16)); a = fmaxf(a, __shfl_xor(a, 32));
                if (fq == 0) xm[(ai * 128 + wr * 64 + m * 16 + fr) * 4 + wc] = a;
                asm volatile("" ::: "memory");
            }
        __syncthreads();
#pragma unroll
        for (int ai = 0; ai < 2; ++ai)
#pragma unroll
            for (int m = 0; m < 4; ++m) {
                const f32x4 t = *(LAS f32x4*)(xm + (ai * 128 + wr * 64 + m * 16 + fr) * 4); const float mx = fmaxf(fmaxf(t[0], t[1]), fmaxf(t[2], t[3])) * sc;
                float s = 0.f;
#pragma unroll
                for (int bj = 0; bj < 2; ++bj)
#pragma unroll
                    for (int n = 0; n < 2; ++n)
#pragma unroll
                        for (int j = 0; j < 4; ++j) s += __builtin_amdgcn_exp2f(acc[ai][bj][m][n][j] * sc - mx);
                s += __shfl_xor(s, 16); s += __shfl_xor(s, 32);
                if (fq == 0) xsum[(ai * 128 + wr * 64 + m * 16 + fr) * 4 + wc] = s;
                asm volatile("" ::: "memory");
            }
        __syncthreads();
#pragma unroll
        for (int ai = 0; ai < 2; ++ai)
#pragma unroll
            for (int m = 0; m < 4; ++m) {
                const f32x4 t = *(LAS f32x4*)(xm + (ai * 128 + wr * 64 + m * 16 + fr) * 4); const float mx = fmaxf(fmaxf(t[0], t[1]), fmaxf(t[2], t[3])) * sc;
                const f32x4 t2 = *(LAS f32x4*)(xsum + (ai * 128 + wr * 64 + m * 16 + fr) * 4); const float inv = __builtin_amdgcn_rcpf((t2[0] + t2[1]) + (t2[2] + t2[3]));
                bf16_t* rowp = P + (size_t)(u.pm * 256 + ai * 128 + wr * 64 + m * 16 + fr) * D + u.pn * 256 + wc * 32 + 8 * fq;
#pragma unroll
                for (int bj = 0; bj < 2; ++bj)
#pragma unroll
                    for (int n = 0; n < 2; ++n) {
                        const f32x4 v = acc[ai][bj][m][n];
                        u32x2 w; w.x = pk2(__builtin_amdgcn_exp2f(v[0] * sc - mx) * inv, __builtin_amdgcn_exp2f(v[1] * sc - mx) * inv); w.y = pk2(__builtin_amdgcn_exp2f(v[2] * sc - mx) * inv, __builtin_amdgcn_exp2f(v[3] * sc - mx) * inv);
                        *(u32x2*)(rowp + bj * 128 + 4 * n) = w;
                    }
                asm volatile("" ::: "memory");
            }
        __syncthreads();
    }
};

#define XB_TMO      128
#define XB_XCNT(j)  (256  + 64 * (j))
#define XB_XSUB(j)  (1280 + 64 * (j))
#define XB_XGEN(j)  (2304 + 64 * (j))
#define XB_TOP      3328
#define XB_TOPGEN   3392
#define XCD_BAR_WORDS 3456
#define XB_SPIN_CAP (1u << 18)

__device__ __forceinline__ unsigned xb_ld(unsigned* p)              { return __hip_atomic_load(p, __ATOMIC_RELAXED, __HIP_MEMORY_SCOPE_AGENT); }
__device__ __forceinline__ unsigned xb_add(unsigned* p, unsigned v) { return __hip_atomic_fetch_add(p, v, __ATOMIC_RELAXED, __HIP_MEMORY_SCOPE_AGENT); }
__device__ __forceinline__ unsigned xb_xcc_id() { return (unsigned)__builtin_amdgcn_s_getreg((3 << 11) | 20) & 0xFu; }
#define XB_SPIN(cond, bar) do { unsigned _sp = 0; while (cond) { __builtin_amdgcn_s_sleep(1); \
    if ((++_sp & 255u) == 0u) { if (xb_ld(&(bar)[XB_TMO])) break; if (_sp > XB_SPIN_CAP) { atomicAdd(&(bar)[XB_TMO], 1u); break; } } } } while (0)

struct XcdBarrier {
    unsigned* bar; unsigned x;
    volatile LAS unsigned* st;
};

__device__ __forceinline__ XcdBarrier xcd_barrier_post(unsigned* bar, volatile LAS unsigned* st) {
    XcdBarrier b; b.bar = bar; b.x = xb_xcc_id(); b.st = st;
    if (threadIdx.x == 0) (void)xb_add(&bar[XB_XCNT(b.x)], 1u);
    return b;
}
__device__ __forceinline__ void xcd_barrier_complete(unsigned* bar, unsigned x, unsigned& nloc, unsigned& nx) {
    const unsigned G = gridDim.x * gridDim.y * gridDim.z;
    unsigned sum, cnt, mine, sp = 0u;
    for (;;) {
        sum = 0u; cnt = 0u; mine = 0u;
#pragma unroll
        for (unsigned j = 0; j < 16; ++j) { const unsigned c = xb_ld(&bar[XB_XCNT(j)]); sum += c; cnt += (c > 0u) ? 1u : 0u; mine = (j == x) ? c : mine; }
        if (sum == G) break;
        __builtin_amdgcn_s_sleep(1);
        if ((++sp & 255u) == 0u) { if (xb_ld(&bar[XB_TMO])) break; if (sp > XB_SPIN_CAP) { atomicAdd(&bar[XB_TMO], 1u); break; } }
    }
    nloc = mine > 0u ? mine : 1u; nx = cnt > 0u ? cnt : 1u;
}

__device__ __forceinline__ void xcd_barrier(const XcdBarrier& b) {
    asm volatile("s_waitcnt vmcnt(0)" ::: "memory");
    __syncthreads();
    if (threadIdx.x == 0) {
        unsigned* bar = b.bar;
        __builtin_amdgcn_s_waitcnt(0);
        unsigned nloc = b.st[0], nx = b.st[1];
        if (nloc == 0u) { xcd_barrier_complete(bar, b.x, nloc, nx); b.st[0] = nloc; b.st[1] = nx; }
        const unsigned old = xb_add(&bar[XB_XSUB(b.x)], 1u);
        const unsigned gen = old / nloc;
        if (old + 1u == (gen + 1u) * nloc) {
            __builtin_amdgcn_fence(__ATOMIC_RELEASE, "agent");
            asm volatile("s_waitcnt vmcnt(0)" ::: "memory");
            const unsigned og = xb_add(&bar[XB_TOP], 1u);
            const unsigned tg = og / nx;
            if (og + 1u == (tg + 1u) * nx) xb_add(&bar[XB_TOPGEN], 1u);
            else XB_SPIN(xb_ld(&bar[XB_TOPGEN]) == tg, bar);
            __builtin_amdgcn_fence(__ATOMIC_ACQUIRE, "agent");
            xb_add(&bar[XB_XGEN(b.x)], 1u);
            asm volatile("s_waitcnt vmcnt(0)" ::: "memory");
        } else {
            XB_SPIN(xb_ld(&bar[XB_XGEN(b.x)]) == gen, bar);
            __builtin_amdgcn_fence(__ATOMIC_ACQUIRE, "agent");
            asm volatile("s_waitcnt vmcnt(0)" ::: "memory");
        }
    }
    __syncthreads();
}


#define LDS_WAIT() asm volatile("s_waitcnt lgkmcnt(0)" ::: "memory")
DI void transpose_item(const float* W, int K, int N, int Npad, bf16_t* WT, int mode, LAS float* scr, int item, int lane) {
    const int nblk = Npad / 32, kb = item / nblk, nb = item % nblk, k0 = 64 * kb, n0 = 32 * nb;
    const int nn = n0 + (lane & 31); const bool ok = nn < N;
#pragma unroll 8
    for (int i = 0; i < 32; ++i) { const int kk = 2 * i + (lane >> 5); scr[kk * 33 + (lane & 31)] = ok ? W[(size_t)(k0 + kk) * N + nn] : 0.f; }
    LDS_WAIT(); asm volatile("" ::: "memory");
    const int c = lane & 7;
#pragma unroll
    for (int j = 0; j < 4; ++j) {
        const int n = (lane >> 3) + 8 * j; const LAS float* s = scr + (8 * c) * 33 + n;
        u32x4 o; o.x = pk2(s[0 * 33], s[1 * 33]); o.y = pk2(s[2 * 33], s[3 * 33]); o.z = pk2(s[4 * 33], s[5 * 33]); o.w = pk2(s[6 * 33], s[7 * 33]);
        int drow = n0 + n;
        if (mode == 1) { const int jj = drow >= FF ? drow - FF : drow, isu = drow >= FF ? 1 : 0; drow = (jj >> 2) * 8 + isu * 4 + (jj & 3); }
        *(u32x4*)(WT + (size_t)drow * K + k0 + 8 * c) = o;
    }
    LDS_WAIT(); asm volatile("" ::: "memory");
}

DI void norm_row(const float* xsrc, float* xdst, const bf16_t* y, const float* gpost, const float* gpre, bf16_t* h, int lane) {
    f32x4 v[4];
#pragma unroll
    for (int j = 0; j < 4; ++j) v[j] = *(const f32x4*)(xsrc + 4 * lane + 256 * j);
    if (y) {
        f32x4 yv[4]; float ss = 0.f;
#pragma unroll
        for (int j = 0; j < 4; ++j) { const u32x2 w = *(const u32x2*)(y + 4 * lane + 256 * j); yv[j] = (f32x4){bflo(w.x), bfhi(w.x), bflo(w.y), bfhi(w.y)}; ss += (yv[j][0] * yv[j][0] + yv[j][1] * yv[j][1]) + (yv[j][2] * yv[j][2] + yv[j][3] * yv[j][3]); }
        const float rs = rsqrtf(wave_sum(ss) * (1.f / D) + EPS);
#pragma unroll
        for (int j = 0; j < 4; ++j) { const f32x4 g = *(const f32x4*)(gpost + 4 * lane + 256 * j); v[j] = v[j] + yv[j] * rs * g; }
    }
#pragma unroll
    for (int j = 0; j < 4; ++j) *(f32x4*)(xdst + 4 * lane + 256 * j) = v[j];
    if (gpre) {
        float ss = 0.f;
#pragma unroll
        for (int j = 0; j < 4; ++j) ss += (v[j][0] * v[j][0] + v[j][1] * v[j][1]) + (v[j][2] * v[j][2] + v[j][3] * v[j][3]);
        const float rs = rsqrtf(wave_sum(ss) * (1.f / D) + EPS);
#pragma unroll
        for (int j = 0; j < 4; ++j) { const f32x4 g = *(const f32x4*)(gpre + 4 * lane + 256 * j); const f32x4 o = v[j] * rs * g; u32x2 w; w.x = pk2(o[0], o[1]); w.y = pk2(o[2], o[3]); *(u32x2*)(h + 4 * lane + 256 * j) = w; }
    }
}


DI void norm_phase(const Ctx& p, const float* gpost, const float* gpre, int G, int bx) {
    const int tid = pg8::tid_(), lane = tid & 63, wv = tid >> 6, gw = bx * NWAVES + wv, NGW = G * NWAVES;
    const bf16_t* Yb = (const bf16_t*)(p.ws + WS_Y); bf16_t* Hb = (bf16_t*)(p.ws + WS_H);
    for (int row = gw; row < MA; row += NGW) norm_row(p.out + (size_t)row * D, p.out + (size_t)row * D, Yb + (size_t)row * D, gpost, gpre, Hb + (size_t)row * D, lane);
}

DI void prologue(const Params& p, LAS unsigned char* lds) {
    const int tid = pg8::tid_(), lane = tid & 63, wv = tid >> 6;
    const int gw = blockIdx.x * NWAVES + wv, NGW = gridDim.x * NWAVES;
    LAS float* scr = (LAS float*)(lds + wv * 16384);
    unsigned char* ws = p.ws;
    constexpr int I0 = 3072, I1 = 192, I2 = 512, I3 = 2816, I4 = 1408, IPL = I0 + 2 * I1 + 5 * I2 + I3 + I4;
    for (int it = gw; it < 4 * IPL; it += NGW) {
        const int l = it / IPL; int r = it % IPL;
        if (r < I0) { transpose_item(p.in[I_WIN] + (size_t)l * D * NIN, D, NIN, NINP, (bf16_t*)(ws + WS_WIN + l * SZ_WIN), 0, scr, r, lane); continue; } r -= I0;
        if (r < I1) { transpose_item(p.in[I_WBA] + (size_t)l * 384 * D, 384, D, D, (bf16_t*)(ws + WS_WBA + l * SZ_WBA), 0, scr, r, lane); continue; } r -= I1;
        if (r < I1) { transpose_item(p.in[I_WBC] + (size_t)l * 384 * D, 384, D, D, (bf16_t*)(ws + WS_WBC + l * SZ_WBA), 0, scr, r, lane); continue; } r -= I1;
        if (r < I2) { transpose_item(p.in[I_WMIX] + (size_t)l * D * D, D, D, D, (bf16_t*)(ws + WS_WMIX + l * SZ_WSQ), 0, scr, r, lane); continue; } r -= I2;
        if (r < I2) { transpose_item(p.in[I_WXQ] + (size_t)l * D * D, D, D, D, (bf16_t*)(ws + WS_WXQ + l * SZ_WSQ), 0, scr, r, lane); continue; } r -= I2;
        if (r < I2) { transpose_item(p.in[I_WXO] + (size_t)l * D * D, D, D, D, (bf16_t*)(ws + WS_WXO + l * SZ_WSQ), 0, scr, r, lane); continue; } r -= I2;
        if (r < I2) { transpose_item(p.in[I_WXK] + (size_t)l * D * D, D, D, D, (bf16_t*)(ws + WS_WKV + l * SZ_WKV), 0, scr, r, lane); continue; } r -= I2;
        if (r < I2) { transpose_item(p.in[I_WXV] + (size_t)l * D * D, D, D, D, (bf16_t*)(ws + WS_WKV + l * SZ_WKV + SZ_WSQ), 0, scr, r, lane); continue; } r -= I2;
        if (r < I3) { transpose_item(p.in[I_WF1] + (size_t)l * D * FF2, D, FF2, FF2, (bf16_t*)(ws + WS_WF1 + l * SZ_WF1), 1, scr, r, lane); continue; } r -= I3;
        transpose_item(p.in[I_WF2] + (size_t)l * FF * D, FF, D, D, (bf16_t*)(ws + WS_WF2 + l * SZ_WF2), 0, scr, r, lane);
    }
    {
        const int gt = blockIdx.x * NTHR + tid, NT = gridDim.x * NTHR;
        for (int idx = gt; idx < 4 * 256 * 1024; idx += NT) {
            const int n = idx & 1023, k = (idx >> 10) & 255, l = idx >> 18, g = k >> 6, c = k & 63;
            const float* wp = p.in[I_WPOOL] + ((size_t)(l * 4 + g) * 64 + c) * 64; const float* sc = p.in[I_PSCALE] + l * 256 + g * 64;
            const float* wb = p.in[I_WBB] + ((size_t)l * 256 + g * 64) * D + n;
            float s = 0.f;
#pragma unroll 8
            for (int d = 0; d < 64; ++d) s += wp[d] * sc[d] * wb[(size_t)d * D];
            ((bf16_t*)(ws + WS_WBB + l * SZ_WBB))[(size_t)n * 256 + k] = f2bf(s);
        }
    }
    for (int row = gw; row < MA; row += NGW) {
        const float* src = row < MP ? p.in[I_XP] + (size_t)row * D : p.in[I_XS] + (size_t)(row - MP) * D;
        norm_row(src, p.out + (size_t)row * D, nullptr, nullptr, p.in[I_NMIXPRE], (bf16_t*)(ws + WS_H) + (size_t)row * D, lane);
    }
    for (int row = gw; row < NB * 256; row += NGW) {
        f32x4 v[4]; float ss = 0.f;
#pragma unroll
        for (int j = 0; j < 4; ++j) { v[j] = *(const f32x4*)(p.in[I_MEM] + (size_t)row * D + 4 * lane + 256 * j); ss += (v[j][0] * v[j][0] + v[j][1] * v[j][1]) + (v[j][2] * v[j][2] + v[j][3] * v[j][3]); }
        const float rs = rsqrtf(wave_sum(ss) * (1.f / D) + EPS);
        for (int l = 0; l < 4; ++l)
#pragma unroll
            for (int j = 0; j < 4; ++j) { const f32x4 g = *(const f32x4*)(p.in[I_MEMN] + l * D + 4 * lane + 256 * j); const f32x4 o = v[j] * rs * g; u32x2 w; w.x = pk2(o[0], o[1]); w.y = pk2(o[2], o[3]);
                *(u32x2*)((bf16_t*)(ws + WS_MN) + ((size_t)l * 2048 + row) * D + 4 * lane + 256 * j) = w; }
    }
}

#define MFMA32(a, b, c) __builtin_amdgcn_mfma_f32_32x32x16_bf16((a), (b), (c), 0, 0, 0)
#define MFMA16(a, b, c) __builtin_amdgcn_mfma_f32_16x16x32_bf16((a), (b), (c), 0, 0, 0)
DI void sb_prompt_unit(const Ctx& p, int b, int h, int qb, LAS unsigned char* lds) {
    const bf16_t* proj = (const bf16_t*)(p.ws + WS_PROJ);
    LAS unsigned short* KS = (LAS unsigned short*)lds;
    LAS unsigned short* VT = KS + 64 * 72;
    const int tid = pg8::tid_(), lane = tid & 63, wv = tid >> 6, hi = lane >> 5, c = lane & 31;
    const int q0 = qb * 256 + wv * 32, tq = q0 + c;
    const size_t rowbase = (size_t)b * SEQ;
    bf16x8 qf[4];
    {
        const bf16_t* qp = proj + (rowbase + tq) * NINP + C_QA + h * 64 + 8 * hi;
#pragma unroll
        for (int kk = 0; kk < 4; ++kk) qf[kk] = *(const bf16x8*)(qp + 16 * kk);
    }
    f32x16 o0, o1;
#pragma unroll
    for (int i = 0; i < 16; ++i) { o0[i] = 0.f; o1[i] = 0.f; }
    float R = 0.f;
    const bf16_t* kbase = proj + rowbase * NINP + C_KA + h * 64 + 8 * wv;
    const bf16_t* vbase = proj + rowbase * NINP + C_VA + h * 64 + 8 * wv;
    int jt = 4 * qb + 3;
    u32x4 kr = *(const u32x4*)(kbase + (size_t)(64 * jt + lane) * NINP), vr = *(const u32x4*)(vbase + (size_t)(64 * jt + lane) * NINP);
    for (; jt >= 0; --jt) {
        __syncthreads();
        *(LAS u32x4*)(KS + lane * 72 + 8 * wv) = kr;
#pragma unroll
        for (int i = 0; i < 4; ++i) { const unsigned w = vr[i]; VT[(8 * wv + 2 * i) * 72 + lane] = (unsigned short)(w & 0xffffu); VT[(8 * wv + 2 * i + 1) * 72 + lane] = (unsigned short)(w >> 16); }
        __syncthreads();
        if (jt > 0) { kr = *(const u32x4*)(kbase + (size_t)(64 * (jt - 1) + lane) * NINP); vr = *(const u32x4*)(vbase + (size_t)(64 * (jt - 1) + lane) * NINP); }
        if (64 * jt < q0 + 31) {
            f32x16 z[2];
#pragma unroll
            for (int kb = 0; kb < 2; ++kb) {
                f32x16 acc;
#pragma unroll
                for (int i = 0; i < 16; ++i) acc[i] = 0.f;
#pragma unroll
                for (int kk = 0; kk < 4; ++kk) { const bf16x8 a = *(const LAS bf16x8*)(KS + (32 * kb + c) * 72 + 16 * kk + 8 * hi); acc = MFMA32(a, qf[kk], acc); }
                z[kb] = acc;
            }
            f32x16 e[2]; float T[8];
            const int sbase = 64 * jt + 4 * hi;
#pragma unroll
            for (int kb = 0; kb < 2; ++kb)
#pragma unroll
                for (int g = 0; g < 4; ++g) {
                    float lf[4];
#pragma unroll
                    for (int j = 0; j < 4; ++j) {
                        const int r = 4 * g + j; const float zz = z[kb][r] * 0.125f; const bool valid = (sbase + 32 * kb + 8 * g + j) < tq;
                        const float sp = softplusf_(zz); lf[j] = valid ? -sp : 0.f; z[kb][r] = valid ? zz - sp : -1.0e30f;
                    }
                    e[kb][4 * g + 3] = 0.f; e[kb][4 * g + 2] = lf[3]; e[kb][4 * g + 1] = lf[3] + lf[2]; e[kb][4 * g + 0] = lf[3] + lf[2] + lf[1];
                    T[kb * 4 + g] = e[kb][4 * g + 0] + lf[0];
                }
            float Tp[8], X[8];
#pragma unroll
            for (int gi = 0; gi < 8; ++gi) Tp[gi] = __shfl_xor(T[gi], 32);
            X[7] = 0.f;
#pragma unroll
            for (int gi = 6; gi >= 0; --gi) X[gi] = X[gi + 1] + (T[gi + 1] + Tp[gi + 1]);
            const float total = X[0] + (T[0] + Tp[0]);
#pragma unroll
            for (int kb = 0; kb < 2; ++kb)
#pragma unroll
                for (int g = 0; g < 4; ++g) {
                    const int gi = kb * 4 + g; const float off = R + X[gi] + (hi == 0 ? Tp[gi] : 0.f);
#pragma unroll
                    for (int j = 0; j < 4; ++j) { const int r = 4 * g + j; z[kb][r] = __expf(z[kb][r] + off + e[kb][r]); }
                }
            R += total;
#pragma unroll
            for (int kb = 0; kb < 2; ++kb)
#pragma unroll
                for (int s2 = 0; s2 < 2; ++s2) {
                    u32x4 pw; pw.x = pk2(z[kb][8 * s2 + 0], z[kb][8 * s2 + 1]); pw.y = pk2(z[kb][8 * s2 + 2], z[kb][8 * s2 + 3]); pw.z = pk2(z[kb][8 * s2 + 4], z[kb][8 * s2 + 5]); pw.w = pk2(z[kb][8 * s2 + 6], z[kb][8 * s2 + 7]);
                    const bf16x8 pb = __builtin_bit_cast(bf16x8, pw);
                    const int ko = 32 * kb + 16 * s2 + 4 * hi;
                    { const s16x4 lo = *(const LAS s16x4*)(VT + c * 72 + ko), hh = *(const LAS s16x4*)(VT + c * 72 + ko + 8);
                      const bf16x8 va = __builtin_shufflevector(lo, hh, 0, 1, 2, 3, 4, 5, 6, 7); o0 = MFMA32(va, pb, o0); }
                    { const s16x4 lo = *(const LAS s16x4*)(VT + (c + 32) * 72 + ko), hh = *(const LAS s16x4*)(VT + (c + 32) * 72 + ko + 8);
                      const bf16x8 va = __builtin_shufflevector(lo, hh, 0, 1, 2, 3, 4, 5, 6, 7); o1 = MFMA32(va, pb, o1); }
                }
        }
    }
    bf16_t* op = (bf16_t*)(p.ws + WS_OA) + (rowbase + tq) * 384 + h * 64 + 4 * hi;
#pragma unroll
    for (int g = 0; g < 4; ++g) {
        u32x2 w; w.x = pk2(o0[4 * g], o0[4 * g + 1]); w.y = pk2(o0[4 * g + 2], o0[4 * g + 3]); *(u32x2*)(op + 8 * g) = w;
        w.x = pk2(o1[4 * g], o1[4 * g + 1]); w.y = pk2(o1[4 * g + 2], o1[4 * g + 3]); *(u32x2*)(op + 32 + 8 * g) = w;
    }
}

DI void sb_sample_unit(const Ctx& p, int l, int b, int h, LAS unsigned char* lds) {
    const bf16_t* proj = (const bf16_t*)(p.ws + WS_PROJ);
    LAS float* qs = (LAS float*)lds;
    LAS float* Z = qs + 1024;
    LAS float* RED = Z + 16 * 1056;
    const int tid = pg8::tid_(), lane = tid & 63, wv = tid >> 6;
    const size_t srow = (size_t)MP + b * 16;
    for (int i = tid; i < 1024; i += NTHR) qs[i] = bf2f(proj[(srow + (i >> 6)) * NINP + C_QA + h * 64 + (i & 63)]) * 0.125f;
    __syncthreads();
    {
        float a0[16], a1[16];
#pragma unroll
        for (int i = 0; i < 16; ++i) { a0[i] = 0.f; a1[i] = 0.f; }
        const float* k0p = p.in[I_CSK] + ((((size_t)l * DB + b) * PAST + tid) * 6 + h) * 64; const float* k1p = k0p + (size_t)512 * 6 * 64;
#pragma unroll 4
        for (int d4 = 0; d4 < 16; ++d4) {
            const f32x4 ka = *(const f32x4*)(k0p + 4 * d4), kb = *(const f32x4*)(k1p + 4 * d4);
#pragma unroll
            for (int i = 0; i < 16; ++i) { const f32x4 q = *(const LAS f32x4*)(qs + i * 64 + 4 * d4);
                a0[i] += (q[0] * ka[0] + q[1] * ka[1]) + (q[2] * ka[2] + q[3] * ka[3]); a1[i] += (q[0] * kb[0] + q[1] * kb[1]) + (q[2] * kb[2] + q[3] * kb[3]); }
        }
#pragma unroll
        for (int i = 0; i < 16; ++i) { Z[i * 1056 + tid] = a0[i]; Z[i * 1056 + tid + 512] = a1[i]; }
        if (tid < 256) {
            const int i = tid >> 4, j = tid & 15; const bf16_t* kp = proj + (srow + j) * NINP + C_KA + h * 64; float s = 0.f;
            for (int d = 0; d < 64; ++d) s += qs[i * 64 + d] * bf2f(kp[d]);
            Z[i * 1056 + 1024 + j] = s;
        }
    }
    __syncthreads();
    for (int qq = 0; qq < 2; ++qq) {
        const int i = 2 * wv + qq, lim = PAST + i; LAS float* zr = Z + i * 1056;
        const int st = 17 * lane, en = (st + 17 < 1040) ? st + 17 : 1040;
        float tot = 0.f;
        for (int s = st; s < en; ++s) if (s < lim) tot -= softplusf_(zr[s]);
        float incl = tot;
#pragma unroll
        for (int o = 1; o < 64; o <<= 1) { const float t = __shfl_down(incl, o); if (lane + o < 64) incl += t; }
        float run = incl - tot;
        for (int s = en - 1; s >= st; --s) {
            const float zz = zr[s]; float w = 0.f;
            if (s < lim) { const float sp = softplusf_(zz); w = __expf(zz - sp + run); run -= sp; }
            zr[s] = w;
        }
    }
    __syncthreads();
    {
        const int d = tid & 63, g = tid >> 6;
        float o[16];
#pragma unroll
        for (int i = 0; i < 16; ++i) o[i] = 0.f;
        const float* vp = p.in[I_CSV] + (((size_t)l * DB + b) * PAST * 6 + h) * 64 + d;
        for (int s0 = 130 * g; s0 < 130 * g + 130; s0 += 10) {
            float v[10];
#pragma unroll
            for (int j = 0; j < 10; ++j) { const int s = s0 + j; v[j] = s < PAST ? vp[(size_t)s * 384] : bf2f(proj[(srow + (s - PAST)) * NINP + C_VA + h * 64 + d]); }
#pragma unroll
            for (int j = 0; j < 10; ++j)
#pragma unroll
                for (int i = 0; i < 16; ++i) o[i] += Z[i * 1056 + s0 + j] * v[j];
        }
#pragma unroll
        for (int i = 0; i < 16; ++i) RED[(g * 16 + i) * 64 + d] = o[i];
    }
    __syncthreads();
    for (int i = tid; i < 1024; i += NTHR) {
        const int qi = i >> 6, d = i & 63; float s = 0.f;
#pragma unroll
        for (int g = 0; g < 8; ++g) s += RED[(g * 16 + qi) * 64 + d];
        ((bf16_t*)(p.ws + WS_OA))[(srow + qi) * 384 + h * 64 + d] = f2bf(s);
    }
}

DI void pool_unit(const Ctx& p, int l, int unit) {
    const bf16_t* proj = (const bf16_t*)(p.ws + WS_PROJ); bf16_t* pooled = (bf16_t*)(p.ws + WS_POOLED);
    const int tid = pg8::tid_(), ch = tid & 255, w = 2 << (ch >> 6);
    for (int i = 0; i < 32; ++i) {
        const int row = unit * 64 + (tid >> 8) + 2 * i;
        float s = 0.f, cnt, u0;
        if (row < MP) {
            const int t = row & (SEQ - 1); const int n = (t + 1 < w) ? t + 1 : w; cnt = (float)n;
            const bf16_t* up = proj + (size_t)row * NINP + C_U + ch; u0 = bf2f(up[0]);
            for (int j = 0; j < n; ++j) s += bf2f(*(up - (size_t)j * NINP));
            if (t >= SEQ - 15) p.out[O_POOLP + ((size_t)(l * NB + (row >> 11)) * 15 + (t - (SEQ - 15))) * 256 + ch] = u0;
        } else {
            const int rs = row - MP, b = rs >> 4, t = rs & 15; cnt = (float)w;
            const bf16_t* up = proj + (size_t)row * NINP + C_U + ch; u0 = bf2f(up[0]);
            const float* hist = p.in[I_SPOOL] + ((size_t)(l * DB + b) * 15) * 256 + ch;
            for (int j = 0; j < w; ++j) { const int tt = t - j; s += tt >= 0 ? bf2f(*(up - (size_t)j * NINP)) : hist[(15 + tt) * 256]; }
            if (t >= 1) p.out[O_POOLS + ((size_t)(l * DB + b) * 15 + (t - 1)) * 256 + ch] = u0;
        }
        pooled[(size_t)row * 256 + ch] = f2bf(s / cnt - u0);
    }
}


DI void kvout_unit(const Ctx& p, int l, int unit) {
    const bf16_t* proj = (const bf16_t*)(p.ws + WS_PROJ);
    for (int i = pg8::tid_(); i < 64 * 96; i += NTHR) {
        const int r = i / 96, ch = i % 96, row = unit * 64 + r;
        const u32x4 w = *(const u32x4*)(proj + (size_t)row * NINP + C_KA + 8 * ch);
        const bool isv = ch >= 48; const int c = 8 * (isv ? ch - 48 : ch);
        float* dst = (row < MP) ? p.out + (isv ? O_VP : O_KP) + ((size_t)l * MP + row) * 384 + c : p.out + (isv ? O_VS : O_KS) + ((size_t)l * MS + (row - MP)) * 384 + c;
        *(f32x4*)dst = (f32x4){bflo(w.x), bfhi(w.x), bflo(w.y), bfhi(w.y)}; *(f32x4*)(dst + 4) = (f32x4){bflo(w.z), bfhi(w.z), bflo(w.w), bfhi(w.w)};
    }
}
DI void memout_unit(const Ctx& p, int unit) {
    const bf16_t* mkv = (const bf16_t*)(p.ws + WS_MKV);
    for (int i = pg8::tid_(); i < 16 * 256; i += NTHR) {
        const int r = i >> 8, ch = i & 255, row = unit * 16 + r, col = 8 * ch;
        const u32x4 w = *(const u32x4*)(mkv + (size_t)row * 2048 + col);
        float* dst = p.out + (col >= 1024 ? O_MVP : O_MKP) + (size_t)row * D + (col & 1023);
        *(f32x4*)dst = (f32x4){bflo(w.x), bfhi(w.x), bflo(w.y), bfhi(w.y)}; *(f32x4*)(dst + 4) = (f32x4){bflo(w.z), bfhi(w.z), bflo(w.w), bfhi(w.w)};
    }
}
DI void memvt_unit(const Ctx& p, int unit) {
    const int l = unit >> 7, nb = (unit >> 3) & 15, b = unit & 7, tid = pg8::tid_(), n = nb * 64 + (tid & 63), wv = tid >> 6;
    const bf16_t* src = (const bf16_t*)(p.ws + WS_MKV) + ((size_t)l * 2048 + b * 256) * 2048 + 1024 + n;
    bf16_t* dst = (bf16_t*)(p.ws + WS_MEMVT) + ((size_t)l * 1024 + n) * 2048 + b * 256;
    for (int c = wv; c < 32; c += 8) {
        unsigned v[8];
#pragma unroll
        for (int j = 0; j < 8; ++j) v[j] = src[(size_t)(8 * c + j) * 2048];
        u32x4 w; w.x = v[0] | (v[1] << 16); w.y = v[2] | (v[3] << 16); w.z = v[4] | (v[5] << 16); w.w = v[6] | (v[7] << 16);
        *(u32x4*)(dst + 8 * c) = w;
    }
}

DI void gla_decay(const Ctx& p, int l, int h, size_t row0, int ntok, LAS unsigned char* lds) {
    const bf16_t* proj = (const bf16_t*)(p.ws + WS_PROJ);
    LAS float* Bc = (LAS float*)lds; LAS float* LR = (LAS float*)(lds + 24576); LAS float* A2 = (LAS float*)(lds + 28672); LAS float* BIA = (LAS float*)(lds + 34816); LAS float* SEG = (LAS float*)(lds + 35200);
    const int tid = pg8::tid_();
    for (int i = tid; i < 64 * 16; i += NTHR) { const int t = i >> 4, r = i & 15; LR[i] = t < ntok ? bf2f(proj[(row0 + t) * NINP + C_LR + r]) : 0.f; }
    for (int i = tid; i < 16 * 96; i += NTHR) { const int r = i / 96, k = i % 96; A2[i] = p.in[I_WA2][((size_t)l * 16 + r) * 384 + h * 96 + k]; }
    if (tid < 96) BIA[tid] = p.in[I_BA][l * 384 + h * 96 + tid];
    __syncthreads();
    for (int i = tid; i < 64 * 96; i += NTHR) {
        const int t = i / 96, k = i % 96; float s = BIA[k];
#pragma unroll
        for (int r = 0; r < 16; ++r) s += LR[t * 16 + r] * A2[r * 96 + k];
        Bc[i] = t < ntok ? -softplusf_(-s) * (1.f / 16.f) : 0.f;
    }
    __syncthreads();
    const int k = tid % 96, seg = tid / 96;
    if (tid < 384) { float run = 0.f; for (int i = 0; i < 16; ++i) { const int idx = (16 * seg + i) * 96 + k; run += Bc[idx]; Bc[idx] = run; } SEG[seg * 96 + k] = run; }
    __syncthreads();
    if (tid < 384 && seg > 0) { float off = 0.f; for (int s2 = 0; s2 < seg; ++s2) off += SEG[s2 * 96 + k]; for (int i = 0; i < 16; ++i) Bc[(16 * seg + i) * 96 + k] += off; }
    __syncthreads();
}
DI void gla_unit_rows(int gu, size_t& row0, int& ntok, int& bh, int& h) {
    if (gu < NGU_P) { bh = gu >> 5; const int c = gu & 31, b = bh >> 2; h = bh & 3; row0 = (size_t)b * SEQ + c * 64; ntok = 64; }
    else { bh = gu - NGU_P; const int b = bh >> 2; h = bh & 3; row0 = (size_t)MP + b * 16; ntok = 16; }
}
DI void gla_stage1_unit(const Ctx& p, int l, int gu, LAS unsigned char* lds) {
    const bf16_t* proj = (const bf16_t*)(p.ws + WS_PROJ);
    size_t row0; int ntok, bh, h; gla_unit_rows(gu, row0, ntok, bh, h);
    gla_decay(p, l, h, row0, ntok, lds);
    LAS float* Bc = (LAS float*)lds;
    LAS unsigned short* KT = (LAS unsigned short*)(lds + 36864);
    LAS unsigned short* VT = KT + 96 * 72;
    const int tid = pg8::tid_(), lane = tid & 63, wv = tid >> 6, fr = lane & 15, fq = lane >> 4;
    for (int i = tid; i < 64 * 96; i += NTHR) {
        const int t = i / 96, k = i % 96; float kv = 0.f, vv = 0.f;
        if (t < ntok) { const bf16_t* rp = proj + (row0 + t) * NINP + h * 96 + k; kv = bf2f(rp[C_KC]) * __expf(Bc[(ntok - 1) * 96 + k] - Bc[t * 96 + k]); vv = bf2f(rp[C_VC]); }
        KT[k * 72 + t] = f2bf(kv); VT[k * 72 + t] = f2bf(vv);
    }
    if (tid < 96) ((float*)(p.ws + WS_GDEC))[(size_t)gu * 96 + tid] = __expf(Bc[(ntok - 1) * 96 + tid]);
    __syncthreads();
    float* KV = (float*)(p.ws + WS_GKV) + (size_t)gu * (GK * GK);
    for (int tile = wv; tile < 36; tile += 8) {
        const int ki = tile / 6, vi = tile % 6; f32x4 acc = {0.f, 0.f, 0.f, 0.f};
#pragma unroll
        for (int ks = 0; ks < 2; ++ks) { const bf16x8 a = *(const LAS bf16x8*)(KT + (16 * ki + fr) * 72 + 32 * ks + 8 * fq), bb = *(const LAS bf16x8*)(VT + (16 * vi + fr) * 72 + 32 * ks + 8 * fq); acc = MFMA16(a, bb, acc); }
#pragma unroll
        for (int j = 0; j < 4; ++j) KV[(16 * ki + 4 * fq + j) * 96 + 16 * vi + fr] = acc[j];
    }
}
DI void gla_scan(const Ctx& p, int l) {
    const int gt = blockIdx.x * NTHR + pg8::tid_(), NT = gridDim.x * NTHR;
    const float* KV = (const float*)(p.ws + WS_GKV); const float* DEC = (const float*)(p.ws + WS_GDEC); float* SP = (float*)(p.ws + WS_GSP);
    for (int e = gt; e < 32 * GK * GK; e += NT) {
        const int bh = e / (GK * GK), kv = e % (GK * GK), k = kv / GK; float S = 0.f;
#pragma unroll 4
        for (int c = 0; c < 32; ++c) { const size_t gu = (size_t)bh * 32 + c; SP[gu * (GK * GK) + kv] = S; S = DEC[gu * 96 + k] * S + KV[gu * (GK * GK) + kv]; }
        p.out[O_GLAP + ((size_t)l * 32 + bh) * (GK * GK) + kv] = S;
    }
    for (int e = gt; e < 64 * GK * GK; e += NT) {
        const int bh = e / (GK * GK), kv = e % (GK * GK), k = kv / GK; const size_t gu = (size_t)NGU_P + bh;
        const float S0 = p.in[I_SGLA][((size_t)l * 64 + bh) * (GK * GK) + kv];
        p.out[O_GLAS + ((size_t)l * 64 + bh) * (GK * GK) + kv] = DEC[gu * 96 + k] * S0 + KV[gu * (GK * GK) + kv];
    }
}
DI void gla_stage3_unit(const Ctx& p, int l, int gu, LAS unsigned char* lds) {
    const bf16_t* proj = (const bf16_t*)(p.ws + WS_PROJ);
    size_t row0; int ntok, bh, h; gla_unit_rows(gu, row0, ntok, bh, h);
    gla_decay(p, l, h, row0, ntok, lds);
    LAS float* Bc = (LAS float*)lds;
    LAS unsigned short* QP = (LAS unsigned short*)(lds + 36864);
    LAS unsigned short* KP = QP + 64 * 104;
    LAS unsigned short* VT = KP + 64 * 104;
    LAS unsigned short* ST = VT + 96 * 72;
    LAS unsigned short* ATT = ST + 96 * 104;
    const int tid = pg8::tid_(), lane = tid & 63, wv = tid >> 6, fr = lane & 15, fq = lane >> 4;
    const float* Sprev = gu < NGU_P ? (const float*)(p.ws + WS_GSP) + (size_t)gu * (GK * GK) : p.in[I_SGLA] + ((size_t)l * 64 + bh) * (GK * GK);
    for (int i = tid; i < 64 * 96; i += NTHR) {
        const int t = i / 96, k = i % 96; float qv = 0.f, kv = 0.f, vv = 0.f;
        if (t < ntok) { const bf16_t* rp = proj + (row0 + t) * NINP + h * 96 + k; const float bb = Bc[i];
            qv = bf2f(rp[C_QC]) * 0.10206207261596575f * __expf(bb); kv = bf2f(rp[C_KC]) * __expf(-bb); vv = bf2f(rp[C_VC]); }
        QP[t * 104 + k] = f2bf(qv); KP[t * 104 + k] = f2bf(kv); VT[k * 72 + t] = f2bf(vv);
    }
    for (int i = tid; i < 96 * 96; i += NTHR) { const int k = i / 96, v = i % 96; ST[v * 104 + k] = f2bf(Sprev[i]); }
    __syncthreads();
    for (int tile = 2 * wv; tile < 2 * wv + 2; ++tile) {
        const int ti = tile >> 2, si = tile & 3; f32x4 acc = {0.f, 0.f, 0.f, 0.f};
        if (si <= ti) {
#pragma unroll
            for (int ks = 0; ks < 3; ++ks) { const bf16x8 a = *(const LAS bf16x8*)(QP + (16 * ti + fr) * 104 + 32 * ks + 8 * fq), bb = *(const LAS bf16x8*)(KP + (16 * si + fr) * 104 + 32 * ks + 8 * fq); acc = MFMA16(a, bb, acc); }
        }
#pragma unroll
        for (int j = 0; j < 4; ++j) { const int t = 16 * ti + 4 * fq + j, s = 16 * si + fr; ATT[t * 72 + s] = f2bf(s <= t ? acc[j] : 0.f); }
    }
    __syncthreads();
    LAS float* OT = Bc;
    for (int tile = wv; tile < 24; tile += 8) {
        const int ti = tile / 6, vi = tile % 6; f32x4 acc = {0.f, 0.f, 0.f, 0.f};
#pragma unroll
        for (int ks = 0; ks < 2; ++ks) { const bf16x8 a = *(const LAS bf16x8*)(ATT + (16 * ti + fr) * 72 + 32 * ks + 8 * fq), bb = *(const LAS bf16x8*)(VT + (16 * vi + fr) * 72 + 32 * ks + 8 * fq); acc = MFMA16(a, bb, acc); }
#pragma unroll
        for (int ks = 0; ks < 3; ++ks) { const bf16x8 a = *(const LAS bf16x8*)(QP + (16 * ti + fr) * 104 + 32 * ks + 8 * fq), bb = *(const LAS bf16x8*)(ST + (16 * vi + fr) * 104 + 32 * ks + 8 * fq); acc = MFMA16(a, bb, acc); }
#pragma unroll
        for (int j = 0; j < 4; ++j) OT[(16 * ti + 4 * fq + j) * 96 + 16 * vi + fr] = acc[j];
    }
    __syncthreads();
    bf16_t* oc = (bf16_t*)(p.ws + WS_OC);
    for (int tt = 0; tt < 8; ++tt) {
        const int t = wv * 8 + tt; if (t >= ntok) break;
        const float a0 = OT[t * 96 + lane], a1 = lane < 32 ? OT[t * 96 + 64 + lane] : 0.f;
        const float rs = rsqrtf(wave_sum(a0 * a0 + a1 * a1) * (1.f / 96.f) + EPS);
        const bf16_t* gp = proj + (row0 + t) * NINP + C_GC + h * 96; const float* gn = p.in[I_GLAN] + l * 384 + h * 96;
        { const float g = bf2f(gp[lane]); oc[(row0 + t) * 384 + h * 96 + lane] = f2bf(a0 * rs * gn[lane] * g * sigmoidf_(g)); }
        if (lane < 32) { const float g = bf2f(gp[64 + lane]); oc[(row0 + t) * 384 + h * 96 + 64 + lane] = f2bf(a1 * rs * gn[64 + lane] * g * sigmoidf_(g)); }
    }
}

DI void cross_sample_unit(const Ctx& p, int l, int b, int h, LAS unsigned char* lds) {
    LAS float* qs = (LAS float*)lds;
    LAS float* S = qs + 16 * 256;
    LAS float* PART = S + 16 * 260;
    const bf16_t* Q = (const bf16_t*)(p.ws + WS_Q);
    const int tid = pg8::tid_(), lane = tid & 63, wv = tid >> 6;
    const size_t srow = (size_t)MP + b * 16;
    for (int i = tid; i < 16 * 256; i += NTHR) qs[i] = bf2f(Q[(srow + (i >> 8)) * D + h * 256 + (i & 255)]) * 0.0625f;
    __syncthreads();
    const int m = tid & 255, half = tid >> 8;
    {
        float acc[16];
#pragma unroll
        for (int i = 0; i < 16; ++i) acc[i] = 0.f;
        const float* kp = p.in[I_CMK] + ((((size_t)l * DB + b) * 256 + m) * 4 + h) * 256 + 128 * half;
#pragma unroll 8
        for (int d4 = 0; d4 < 32; ++d4) {
            const f32x4 kv = *(const f32x4*)(kp + 4 * d4);
#pragma unroll
            for (int i = 0; i < 16; ++i) { const f32x4 q = *(const LAS f32x4*)(qs + i * 256 + 128 * half + 4 * d4); acc[i] += (q[0] * kv[0] + q[1] * kv[1]) + (q[2] * kv[2] + q[3] * kv[3]); }
        }
#pragma unroll
        for (int i = 0; i < 16; ++i) PART[(half * 16 + i) * 256 + m] = acc[i];
    }
    __syncthreads();
    for (int qq = 0; qq < 2; ++qq) {
        const int i = 2 * wv + qq; float v[4], mx = -3.0e38f;
#pragma unroll
        for (int j = 0; j < 4; ++j) { v[j] = PART[i * 256 + lane + 64 * j] + PART[(16 + i) * 256 + lane + 64 * j]; mx = fmaxf(mx, v[j]); }
        mx = wave_max(mx); float sum = 0.f;
#pragma unroll
        for (int j = 0; j < 4; ++j) { v[j] = __expf(v[j] - mx); sum += v[j]; }
        sum = wave_sum(sum); const float inv = 1.f / sum;
#pragma unroll
        for (int j = 0; j < 4; ++j) S[i * 260 + lane + 64 * j] = v[j] * inv;
    }
    __syncthreads();
    {
        float acc[16];
#pragma unroll
        for (int i = 0; i < 16; ++i) acc[i] = 0.f;
        const float* vp = p.in[I_CMV] + ((((size_t)l * DB + b) * 256 + 128 * half) * 4 + h) * 256 + m;
        for (int k0 = 0; k0 < 128; k0 += 8) {
            float v[8];
#pragma unroll
            for (int j = 0; j < 8; ++j) v[j] = vp[(size_t)(k0 + j) * 1024];
#pragma unroll
            for (int j = 0; j < 8; ++j)
#pragma unroll
                for (int i = 0; i < 16; ++i) acc[i] += S[i * 260 + 128 * half + k0 + j] * v[j];
        }
#pragma unroll
        for (int i = 0; i < 16; ++i) PART[(half * 16 + i) * 256 + m] = acc[i];
    }
    __syncthreads();
    bf16_t* O = (bf16_t*)(p.ws + WS_O);
    for (int i = tid; i < 16 * 256; i += NTHR) { const int qi = i >> 8, d = i & 255; O[(srow + qi) * D + h * 256 + d] = f2bf(PART[qi * 256 + d] + PART[(16 + qi) * 256 + d]); }
}

struct SkBf16 { bf16_t* O; int ldc; DI void operator()(int row, int col, f32x4 v) const { u32x2 w; w.x = pk2(v[0], v[1]); w.y = pk2(v[2], v[3]); *(u32x2*)(O + (size_t)(MP + row) * ldc + col) = w; } };
struct SkGate { bf16_t* merged; const bf16_t* proj; int goff; int accum;
    DI void operator()(int row, int col, f32x4 v) const {
        const u32x2 g = *(const u32x2*)(proj + (size_t)(MP + row) * NINP + goff + col); bf16_t* mp = merged + (size_t)(MP + row) * D + col;
        u32x2 pm2 = {0u, 0u}; if (accum) pm2 = *(const u32x2*)mp;
        u32x2 w; w.x = pk2(sigmoidf_(bflo(g.x)) * v[0] + bflo(pm2.x), sigmoidf_(bfhi(g.x)) * v[1] + bfhi(pm2.x)); w.y = pk2(sigmoidf_(bflo(g.y)) * v[2] + bflo(pm2.y), sigmoidf_(bfhi(g.y)) * v[3] + bfhi(pm2.y));
        *(u32x2*)mp = w; } };
template <class EF> DI void skinny_gemm(const bf16_t* A, int lda, const bf16_t* Bt, int ldb, int K, int N, int G, int bx, LAS unsigned char* lds, const EF& ef) {
    const int tid = pg8::tid_(), lane = tid & 63, wv = tid >> 6, fr = lane & 15, fq = lane >> 4, nks = K >> 5, nunits = 4 * (N >> 4);
    LAS f32x4* red = (LAS f32x4*)lds;
    for (int u = bx; u < nunits; u += G) {
        const int rb = u & 3, cb = u >> 2;
        f32x4 acc[4];
#pragma unroll
        for (int i = 0; i < 4; ++i) acc[i] = (f32x4){0.f, 0.f, 0.f, 0.f};
        const bf16_t* bp = Bt + (size_t)(16 * cb + fr) * ldb + 8 * fq; const bf16_t* ap = A + (size_t)(64 * rb + fr) * lda + 8 * fq;
        for (int ks = wv; ks < nks; ks += 8) {
            const bf16x8 bb = *(const bf16x8*)(bp + 32 * ks);
            bf16x8 aa[4];
#pragma unroll
            for (int i = 0; i < 4; ++i) aa[i] = *(const bf16x8*)(ap + (size_t)(16 * i) * lda + 32 * ks);
#pragma unroll
            for (int i = 0; i < 4; ++i) acc[i] = MFMA16(bb, aa[i], acc[i]);
        }
#pragma unroll
        for (int i = 0; i < 4; ++i) red[(wv * 4 + i) * 64 + lane] = acc[i];
        __syncthreads();
        if (tid < 256) {
            const int i = tid >> 6; f32x4 s = red[i * 64 + lane];
#pragma unroll
            for (int w = 1; w < 8; ++w) s = s + red[(w * 4 + i) * 64 + lane];
            ef(64 * rb + 16 * i + fr, 16 * cb + 4 * fq, s);
        }
        __syncthreads();
    }
}

constexpr int PH_PER_LAYER = 15, N_PHASES = 1 + DEPTH * PH_PER_LAYER;
#define RUN_GEMM(EpiT, E, Aptr, lda_, Bptr, ldb_, K_, pm0_, nM_, nN_) do { const pg8::Gemm g_{(K_), (lda_), (ldb_)}; pg8::TileOrder S_; S_.init((Aptr), (lda_), (Bptr), (ldb_), (pm0_), (nM_), (nN_), G, bx); \
        pg8::gemm_phase<EpiT, pg8::TileOrder, true, true>(lds, g_, S_, (E)); } while (0)

__global__ void __launch_bounds__(NTHR, 2) fwd_kernel(Params p) {
    extern __shared__ __attribute__((aligned(16))) unsigned char lds_raw[];
#define PROJ ((bf16_t*)(ws + WS_PROJ))
#define H ((bf16_t*)(ws + WS_H))
#define MERGED ((bf16_t*)(ws + WS_MERGED))
#define Y ((bf16_t*)(ws + WS_Y))
#define QB ((bf16_t*)(ws + WS_Q))
#define PB ((bf16_t*)(ws + WS_P))
#define OB ((bf16_t*)(ws + WS_O))
#define ACT ((bf16_t*)(ws + WS_ACT))

    {
        volatile LAS unsigned* st0 = (volatile LAS unsigned*)((LAS unsigned char*)lds_raw + LDS_MISC + 32);
        if (pg8::tid_() == 0) { st0[0] = 0u; st0[1] = 0u; }
        __syncthreads();
    }
    XcdBarrier xbar = xcd_barrier_post((unsigned*)(p.ws + WS_CTL) + CW_BAR, (volatile LAS unsigned*)((LAS unsigned char*)lds_raw + LDS_MISC + 32));
    if (p.ph_lo == 0) {
        prologue(p, (LAS unsigned char*)lds_raw);
        if (blockIdx.x == 0 && pg8::tid_() == 0) {
            const float** tab = (const float**)(p.ws + WS_TAB);
#pragma unroll
            for (int i = 0; i < N_IN; ++i) tab[i] = p.in[i];
        }
        if (p.ph_hi > 1) cg::this_grid().sync();
    }
    for (int ph = p.ph_lo > 1 ? p.ph_lo : 1; ph < p.ph_hi; ++ph) {
        unsigned ldsb = (unsigned)(size_t)(LAS unsigned char*)lds_raw; asm volatile("" : "+s"(ldsb));
        LAS unsigned char* lds = (LAS unsigned char*)(size_t)ldsb;
        volatile LAS int* slot = (volatile LAS int*)(lds + LDS_MISC);
        unsigned char* ws = p.ws; asm volatile("" : "+s"(ws));
        Ctx c; c.ws = ws; c.in.t = (const float* const*)(ws + WS_TAB); c.out = p.out;
        unsigned* ctl = (unsigned*)(ws + WS_CTL);
        int G = gridDim.x, bx = blockIdx.x; asm volatile("" : "+s"(G), "+s"(bx));
        {
            const int l = (ph - 1) / PH_PER_LAYER, st = (ph - 1) % PH_PER_LAYER;
            switch (st) {
            case 0: {
                EpiBf16 E{PROJ, NINP, 0xffff};
                RUN_GEMM(EpiBf16, E, H, D, ws + WS_WIN + l * SZ_WIN, D, D, 0, MA / 256, NINP / 256);
                if (l == 0) {
                    const pg8::Gemm g{D, D, D}; MemKvOrder S{G, bx, (const char*)(ws + WS_MN), (const char*)(ws + WS_WKV)};
                    EpiBf16 E2{(bf16_t*)(ws + WS_MKV), 2048, 7};
                    pg8::gemm_phase<EpiBf16, MemKvOrder, true, true>(lds, g, S, E2);
                }
            } break;
            case 1: {
                unsigned* ctr = ctl + 64 * ph;
                constexpr int U_SBP = 384, U_SBS = U_SBP + DB * 6, U_GLA = U_SBS + NGU, U_POOL = U_GLA + MA / 64, U_KV = U_POOL + MA / 64, U_MO = U_KV + 512, U_VT = U_MO + 512;
                const int U_ALL = l == 0 ? U_VT : U_KV;
                for (;;) {
                    const int u = next_work(ctr, slot); if (u >= U_ALL) break;
                    if (u < DB * 6) sb_sample_unit(c, l, u / 6, u % 6, lds);
                    else if (u < U_SBS) { const int v = u - DB * 6, qb = 7 - v / 48, bh = v % 48; sb_prompt_unit(c, bh / 6, bh % 6, qb, lds); }
                    else if (u < U_GLA) gla_stage1_unit(c, l, u - U_SBS, lds);
                    else if (u < U_POOL) pool_unit(c, l, u - U_GLA);
                    else if (u < U_KV) kvout_unit(c, l, u - U_POOL);
                    else if (u < U_MO) memout_unit(c, u - U_KV);
                    else memvt_unit(c, u - U_MO);
                }
            } break;
            case 2: gla_scan(c, l); break;
            case 3: {
                unsigned* ctr = ctl + 64 * ph;
                for (;;) { const int u = next_work(ctr, slot); if (u >= NGU) break; gla_stage3_unit(c, l, u, lds); }
            } break;
            case 4: {
                EpiGate E1{MERGED, PROJ, C_GA, 0}, E2{MERGED, PROJ, C_GB, 1}, E3{MERGED, PROJ, C_GCG, 1};
                RUN_GEMM(EpiGate, E1, ws + WS_OA, 384, ws + WS_WBA + l * SZ_WBA, 384, 384, 0, MP / 256, 4);
                RUN_GEMM(EpiGate, E2, ws + WS_POOLED, 256, ws + WS_WBB + l * SZ_WBB, 256, 256, 0, MP / 256, 4);
                RUN_GEMM(EpiGate, E3, ws + WS_OC, 384, ws + WS_WBC + l * SZ_WBA, 384, 384, 0, MP / 256, 4);
                { SkGate F1{MERGED, PROJ, C_GA, 0}, F2{MERGED, PROJ, C_GB, 1}, F3{MERGED, PROJ, C_GCG, 1};
                  skinny_gemm((const bf16_t*)(ws + WS_OA) + (size_t)MP * 384, 384, (const bf16_t*)(ws + WS_WBA + l * SZ_WBA), 384, 384, D, G, bx, lds, F1);
                  skinny_gemm((const bf16_t*)(ws + WS_POOLED) + (size_t)MP * 256, 256, (const bf16_t*)(ws + WS_WBB + l * SZ_WBB), 256, 256, D, G, bx, lds, F2);
                  skinny_gemm((const bf16_t*)(ws + WS_OC) + (size_t)MP * 384, 384, (const bf16_t*)(ws + WS_WBC + l * SZ_WBA), 384, 384, D, G, bx, lds, F3); }
            } break;
            case 5: { EpiBf16 E{Y, D, 0xffff}; RUN_GEMM(EpiBf16, E, MERGED, D, ws + WS_WMIX + l * SZ_WSQ, D, D, 0, MP / 256, 4);
                SkBf16 F{Y, D}; skinny_gemm((const bf16_t*)MERGED + (size_t)MP * D, D, (const bf16_t*)(ws + WS_WMIX + l * SZ_WSQ), D, D, D, G, bx, lds, F); } break;
            case 6: norm_phase(c, c.in[I_NMIXPOST] + l * D, c.in[I_NXPRE] + l * D, G, bx); break;
            case 7: { EpiBf16 E{QB, D, 0xffff}; RUN_GEMM(EpiBf16, E, H, D, ws + WS_WXQ + l * SZ_WSQ, D, D, 0, MP / 256, 4);
                SkBf16 F{QB, D}; skinny_gemm((const bf16_t*)H + (size_t)MP * D, D, (const bf16_t*)(ws + WS_WXQ + l * SZ_WSQ), D, D, D, G, bx, lds, F); } break;
            case 8: {
                const pg8::Gemm g{256, D, 2048}; CrossOrder S{G, bx, (const char*)QB, (const char*)(ws + WS_MKV + (size_t)l * 2 * SZ_WKV), 0};
                EpiSoftmax E{PB, (LAS float*)(lds + LDS_X)};
                pg8::gemm_phase<EpiSoftmax, CrossOrder, true, true>(lds, g, S, E);
            } break;
            case 9: {
                const pg8::Gemm g{256, D, 2048}; CrossOrder S{G, bx, (const char*)PB, (const char*)(ws + WS_MEMVT + (size_t)l * SZ_WKV), 1};
                EpiBf16 E{OB, D, 0xffff};
                pg8::gemm_phase<EpiBf16, CrossOrder, true, true>(lds, g, S, E);
                for (int u = bx; u < DB * 4; u += G) { __syncthreads(); cross_sample_unit(c, l, u >> 2, u & 3, lds); }
            } break;
            case 10: { EpiBf16 E{Y, D, 0xffff}; RUN_GEMM(EpiBf16, E, OB, D, ws + WS_WXO + l * SZ_WSQ, D, D, 0, MP / 256, 4);
                SkBf16 F{Y, D}; skinny_gemm((const bf16_t*)OB + (size_t)MP * D, D, (const bf16_t*)(ws + WS_WXO + l * SZ_WSQ), D, D, D, G, bx, lds, F); } break;
            case 11: norm_phase(c, c.in[I_NXPOST] + l * D, c.in[I_NFPRE] + l * D, G, bx); break;
            case 12: { EpiSwiglu E{ACT}; RUN_GEMM(EpiSwiglu, E, H, D, ws + WS_WF1 + l * SZ_WF1, D, D, 0, MA / 256, FF2 / 256); } break;
            case 13: { EpiBf16 E{Y, D, 0xffff}; RUN_GEMM(EpiBf16, E, ACT, FF, ws + WS_WF2 + l * SZ_WF2, FF, FF, 0, MP / 256, 4);
                SkBf16 F{Y, D}; skinny_gemm((const bf16_t*)ACT + (size_t)MP * FF, FF, (const bf16_t*)(ws + WS_WF2 + l * SZ_WF2), FF, FF, D, G, bx, lds, F); } break;
            default: norm_phase(c, c.in[I_NFPOST] + l * D, l < DEPTH - 1 ? c.in[I_NMIXPRE] + (l + 1) * D : nullptr, G, bx); break;
            }
        }
        if (ph + 1 < p.ph_hi) { if ((ph - 1) % PH_PER_LAYER == 8) { __threadfence(); __syncthreads(); } else xcd_barrier(xbar); }
    }
}

extern "C" void kernel_launch(void* const* d_in, const int* in_sizes, int n_in, void* d_out, int out_size, void* d_ws, size_t ws_size, hipStream_t stream) {
    static int grid = 0;
    if (grid == 0) {
        if (n_in != N_IN || (size_t)out_size != O_END || ws_size < WS_END) { fprintf(stderr, "kernel_launch: unexpected shapes: n_in %d out %d ws %zu (need %zu)\n", n_in, out_size, ws_size, (size_t)WS_END); grid = -1; return; }
        int dev = 0, cus = 0, per_cu = 0;
        (void)hipGetDevice(&dev); (void)hipDeviceGetAttribute(&cus, hipDeviceAttributeMultiprocessorCount, dev);
        (void)hipFuncSetAttribute((const void*)fwd_kernel, hipFuncAttributeMaxDynamicSharedMemorySize, LDS_BYTES);
        if (hipOccupancyMaxActiveBlocksPerMultiprocessor(&per_cu, (const void*)fwd_kernel, NTHR, LDS_BYTES) != hipSuccess || per_cu < 1) { fprintf(stderr, "kernel_launch: occupancy query gave %d\n", per_cu); per_cu = 1; }
        (void)hipGetLastError();
        grid = cus * per_cu;
    }
    if (grid < 0) return;
    (void)hipMemsetAsync((char*)d_ws + WS_CTL, 0, CTL_BYTES, stream);
    Params p{};
    for (int i = 0; i < N_IN; ++i) p.in[i] = (const float*)d_in[i];
    p.out = (float*)d_out; p.ws = (unsigned char*)d_ws;
#ifdef MULTI_LAUNCH
    for (int ph = 0; ph < N_PHASES; ++ph) { p.ph_lo = ph; p.ph_hi = ph + 1; hipLaunchKernelGGL(fwd_kernel, dim3(grid), dim3(NTHR), LDS_BYTES, stream, p); }
#else
    p.ph_lo = 0; p.ph_hi = N_PHASES;
    void* args[] = {&p};
    const hipError_t e = hipLaunchCooperativeKernel((const void*)fwd_kernel, dim3(grid), dim3(NTHR), args, LDS_BYTES, stream);
    if (e != hipSuccess) fprintf(stderr, "kernel_launch: cooperative launch failed: %s (grid %d)\n", hipGetErrorString(e), grid);
#endif
}
```

```cpp
#include <hip/hip_runtime.h>
#include <hip/hip_cooperative_groups.h>
#include <cstdio>
#include <cstdint>
namespace cg = cooperative_groups;

namespace pg8 {
#define PG8_LAS __attribute__((address_space(3)))
typedef unsigned short bf16_t;
typedef short bf16x8 __attribute__((ext_vector_type(8)));
typedef float f32x4 __attribute__((ext_vector_type(4)));
typedef unsigned u32x4 __attribute__((ext_vector_type(4)));
typedef unsigned u32x2 __attribute__((ext_vector_type(2)));
constexpr int BM = 256, BK = 64, HALF = 128, HTB = HALF * BK * 2  , STAGE_BYTES = 8 * HTB, NXCD = 8, WGM = 8;

__host__ __device__ __forceinline__ int lds_byte(int r, int c) { const int st = (r >> 4) * 2 + (c >> 5), rr = r & 15, cc = c & 31, ob = rr * 64 + cc * 2; return st * 1024 + (ob ^ (((ob >> 9) & 1) << 5)); }
__host__ __device__ __forceinline__ void stage_rc(int b, int& R, int& C) { const int st = b / 1024, sb = b % 1024, swz = sb ^ (((sb >> 9) & 1) << 5); R = (st >> 1) * 16 + swz / 64; C = (st & 1) * 32 + (swz % 64) / 2; }
__host__ __device__ __forceinline__ int perm32(int rho) { const int n = rho >> 4, i = rho & 15; return 8 * (i >> 2) + 4 * n + (i & 3); }

struct Unit { int pm, pn; const char* a; const char* b; };
struct Gemm { int K, lda, ldb; };

struct TileOrder {
    int nM, nN, G, c, lda, ldb; const char* A; const char* B;
    __device__ void init(const void* A_, int lda_, const void* B_, int ldb_, int, int nM_, int nN_, int G_, int c_) {
        A = (const char*)A_; B = (const char*)B_; lda = lda_; ldb = ldb_; nM = nM_; nN = nN_; G = G_; c = c_; }
    __device__ bool next(int i, Unit& u) const {
        const int nwg = nM * nN; const long L = (long)i * G + c; if (L >= nwg) return false;
        int wgid = (int)L; { const int q = nwg / NXCD, r = nwg % NXCD, xcd = wgid % NXCD, off = wgid / NXCD; wgid = (xcd < r ? xcd * (q + 1) : r * (q + 1) + (xcd - r) * q) + off; }
        const int nig = WGM * nN, gid = wgid / nig, fm = gid * WGM, gsz = (nM - fm) < WGM ? (nM - fm) : WGM;
        u.pm = fm + ((wgid % nig) % gsz); u.pn = (wgid % nig) / gsz; u.a = A + (size_t)u.pm * ((size_t)BM * 2 * lda); u.b = B + (size_t)u.pn * ((size_t)BM * 2 * ldb); return true;
    }
    __device__ __forceinline__ void a_ready(const Unit&) const {}
    __device__ __forceinline__ void done(const Unit&) const {}
};

__device__ __forceinline__ int tid_() { int t = threadIdx.x; asm volatile("" : "+v"(t)); return t; }
__device__ __forceinline__ unsigned cvt_pk_bf16(float lo, float hi) { unsigned r; asm volatile("v_cvt_pk_bf16_f32 %0, %1, %2" : "=v"(r) : "v"(lo), "v"(hi)); return r; }

template <class Epi, class Sched, bool ALIGN_EPI = false, bool SP2 = false>
__device__ __forceinline__ void gemm_phase(PG8_LAS unsigned char* lds, const Gemm g, const Sched& S, const Epi& E) {
    const int tid = pg8::tid_(), wid = __builtin_amdgcn_readfirstlane(tid >> 6), lane = tid & 63, wr = wid >> 2, wc = wid & 3, fr = lane & 15, fq = lane >> 4;
    const int K = g.K, nt = K / BK;
    unsigned voffA, voffB;
    { int R, C; stage_rc(tid * 16, R, C); const int Rb = Epi::PERM ? ((R & ~31) + perm32(R & 31)) : R;
        voffA = (unsigned)(R * g.lda + C) * 2u; voffB = (unsigned)(Rb * g.ldb + C) * 2u; }
    const size_t qstepA = (size_t)64 * g.lda * 2, qstepB = (size_t)64 * g.ldb * 2;
    const size_t kstep = (size_t)(BK * 2);
    const size_t hstepA = (size_t)HALF * g.lda * 2, hstepB = (size_t)HALF * g.ldb * 2;
    const unsigned ldsw = (unsigned)wid * 1024u;
    const int aoff = lds_byte(wr * 64 + fr, fq * 8), boff = lds_byte(wc * 32 + fr, fq * 8);
#define PG8_SA(b, h) (((b) * 2 + (h)) * HTB)
#define PG8_SB(b, h) ((4 + (b) * 2 + (h)) * HTB)
#define PG8_STAGE(bufoff, gbase, voff) do { _Pragma("unroll") for (int _i = 0; _i < 2; ++_i) { const char* sb_ = (const char*)(gbase) + (size_t)_i * q##voff; asm volatile("" : "+s"(sb_));   \
        __builtin_amdgcn_global_load_lds((const unsigned*)(sb_ + (voff)), (PG8_LAS unsigned*)(lds + (bufoff) + ldsw + _i * 8192), 16, 0, 0); } } while (0)
#define qvoffA qstepA
#define qvoffB qstepB
#define PG8_LDA(dst, b, h) do { _Pragma("unroll") for (int m = 0; m < 4; ++m) _Pragma("unroll") for (int k = 0; k < 2; ++k) dst[m][k] = *(const PG8_LAS bf16x8*)(lds + PG8_SA(b, h) + aoff + m * 2048 + k * 1024); } while (0)
#define PG8_LDB(dst, b, h) do { _Pragma("unroll") for (int n = 0; n < 2; ++n) _Pragma("unroll") for (int k = 0; k < 2; ++k) dst[n][k] = *(const PG8_LAS bf16x8*)(lds + PG8_SB(b, h) + boff + n * 2048 + k * 1024); } while (0)
#define PG8_MMA(ai, bj, At, Bt) do { __builtin_amdgcn_s_setprio(1); _Pragma("unroll") for (int m = 0; m < 4; ++m) _Pragma("unroll") for (int n = 0; n < 2; ++n) _Pragma("unroll") for (int k = 0; k < 2; ++k) \
        acc[ai][bj][m][n] = __builtin_amdgcn_mfma_f32_16x16x32_bf16(Bt[n][k], At[m][k], acc[ai][bj][m][n], 0, 0, 0); __builtin_amdgcn_s_setprio(0); } while (0)
#define PG8_WAIT_V(n) asm volatile("s_waitcnt vmcnt(" #n ")" ::: "memory")
#define PG8_WAIT_L(n) asm volatile("s_waitcnt lgkmcnt(" #n ")" ::: "memory")
#define PG8_BAR __builtin_amdgcn_s_barrier()
#define PG8_SCHED __builtin_amdgcn_sched_barrier(0)
    Unit cur, nxt; int ui = 0;
    if (!S.next(0, cur)) return;
    f32x4 acc[2][2][4][2];
#pragma unroll
    for (int a = 0; a < 2; ++a)
#pragma unroll
        for (int b = 0; b < 2; ++b)
#pragma unroll
            for (int m = 0; m < 4; ++m)
#pragma unroll
                for (int n = 0; n < 2; ++n) acc[a][b][m][n] = (f32x4){0.f, 0.f, 0.f, 0.f};
    bf16x8 At[4][2], B0[2][2], B1[2][2];
    const char* cA = cur.a; const char* cB = cur.b;
    S.a_ready(cur);
    if constexpr (SP2) {
        PG8_STAGE(PG8_SB(0, 0), cB, voffB); PG8_STAGE(PG8_SB(0, 1), cB + hstepB, voffB); PG8_STAGE(PG8_SA(0, 0), cA, voffA); PG8_STAGE(PG8_SA(0, 1), cA + hstepA, voffA);
        if (wr == 1) PG8_BAR;
        PG8_WAIT_V(2); PG8_BAR;
        PG8_STAGE(PG8_SB(1, 0), cB + kstep, voffB); PG8_STAGE(PG8_SA(1, 0), cA + kstep, voffA); PG8_STAGE(PG8_SB(1, 1), cB + hstepB + kstep, voffB);
        PG8_WAIT_V(6); PG8_BAR;
    } else {
        PG8_STAGE(PG8_SB(0, 0), cB, voffB); PG8_STAGE(PG8_SA(0, 0), cA, voffA); PG8_STAGE(PG8_SB(0, 1), cB + hstepB, voffB); PG8_STAGE(PG8_SA(0, 1), cA + hstepA, voffA);
        if (wr == 1) PG8_BAR;
        PG8_WAIT_V(4); PG8_BAR;
        PG8_STAGE(PG8_SB(1, 0), cB + kstep, voffB); PG8_STAGE(PG8_SA(1, 0), cA + kstep, voffA); PG8_STAGE(PG8_SB(1, 1), cB + hstepB + kstep, voffB);
        PG8_WAIT_V(6); PG8_BAR;
    }
    for (;;) {
        const bool has_next = S.next(ui + 1, nxt);
        const char* nA = has_next ? nxt.a : cA; const char* nB = has_next ? nxt.b : cB;
        for (int t = 0; t < nt; t += 2) {
            const bool last = (t == nt - 2);
            const char* a1 = cA + (size_t)(t + 1) * kstep;
            const char* a2 = last ? nA : cA + (size_t)(t + 2) * kstep; const char* b2 = last ? nB : cB + (size_t)(t + 2) * kstep;
            const char* a3 = a2 + kstep; const char* b3 = b2 + kstep;
            if (last && has_next) S.a_ready(nxt);
            if constexpr (SP2) {
            PG8_LDB(B0, 0, 0); PG8_LDB(B1, 0, 1); PG8_SCHED; PG8_LDA(At, 0, 0); PG8_STAGE(PG8_SA(1, 1), a1 + hstepA, voffA);
            PG8_WAIT_V(8); PG8_WAIT_L(0); PG8_BAR; PG8_MMA(0, 0, At, B0); PG8_MMA(0, 1, At, B1); PG8_BAR; PG8_SCHED;
            PG8_LDA(At, 0, 1); PG8_STAGE(PG8_SB(0, 0), b2, voffB); PG8_STAGE(PG8_SB(0, 1), b2 + hstepB, voffB); PG8_STAGE(PG8_SA(0, 0), a2, voffA);
            PG8_WAIT_V(8); PG8_WAIT_L(0); PG8_BAR; PG8_MMA(1, 0, At, B0); PG8_MMA(1, 1, At, B1); PG8_BAR; PG8_SCHED;
            PG8_LDB(B0, 1, 0); PG8_LDB(B1, 1, 1); PG8_SCHED; PG8_LDA(At, 1, 0); PG8_STAGE(PG8_SA(0, 1), a2 + hstepA, voffA);
            PG8_WAIT_V(8); PG8_WAIT_L(0); PG8_BAR; PG8_MMA(0, 0, At, B0); PG8_MMA(0, 1, At, B1); PG8_BAR; PG8_SCHED;
            PG8_LDA(At, 1, 1); PG8_STAGE(PG8_SB(1, 0), b3, voffB); PG8_STAGE(PG8_SB(1, 1), b3 + hstepB, voffB); PG8_STAGE(PG8_SA(1, 0), a3, voffA);
            PG8_WAIT_V(8); PG8_WAIT_L(0); PG8_BAR; PG8_MMA(1, 0, At, B0); PG8_MMA(1, 1, At, B1); PG8_BAR; PG8_SCHED;
            } else {
            PG8_LDB(B0, 0, 0); PG8_SCHED; PG8_LDA(At, 0, 0); PG8_STAGE(PG8_SA(1, 1), a1 + hstepA, voffA);
            PG8_WAIT_L(8); PG8_BAR; PG8_WAIT_L(0); PG8_MMA(0, 0, At, B0); PG8_BAR; PG8_SCHED;
            PG8_LDB(B1, 0, 1); PG8_STAGE(PG8_SB(0, 0), b2, voffB);
            PG8_BAR; PG8_WAIT_L(0); PG8_MMA(0, 1, At, B1); PG8_BAR;
            PG8_LDA(At, 0, 1); PG8_STAGE(PG8_SA(0, 0), a2, voffA);
            PG8_BAR; PG8_WAIT_L(0); PG8_MMA(1, 0, At, B0); PG8_BAR; PG8_SCHED;
            PG8_STAGE(PG8_SB(0, 1), b2 + hstepB, voffB);
            PG8_WAIT_V(6); PG8_BAR; PG8_MMA(1, 1, At, B1); PG8_BAR;
            PG8_LDB(B0, 1, 0); PG8_SCHED; PG8_LDA(At, 1, 0); PG8_STAGE(PG8_SA(0, 1), a2 + hstepA, voffA);
            PG8_WAIT_L(8); PG8_BAR; PG8_WAIT_L(0); PG8_MMA(0, 0, At, B0); PG8_BAR; PG8_SCHED;
            PG8_LDB(B1, 1, 1); PG8_STAGE(PG8_SB(1, 0), b3, voffB);
            PG8_BAR; PG8_WAIT_L(0); PG8_MMA(0, 1, At, B1); PG8_BAR;
            PG8_LDA(At, 1, 1); PG8_STAGE(PG8_SA(1, 0), a3, voffA);
            PG8_BAR; PG8_WAIT_L(0); PG8_MMA(1, 0, At, B0); PG8_BAR; PG8_SCHED;
            PG8_STAGE(PG8_SB(1, 1), b3 + hstepB, voffB);
            PG8_WAIT_V(6); PG8_BAR; PG8_MMA(1, 1, At, B1); PG8_BAR;
            }
        }
        if constexpr (ALIGN_EPI) { if (wr == 0) PG8_BAR; }
        if constexpr (!Epi::AFTER_DRAIN) { const int l2_ = tid_() & 63, fr2 = l2_ & 15, fq2 = l2_ >> 4;   E(acc, cur, wr, wc, fr2, fq2); S.done(cur); }
        if (!has_next) break;
#pragma unroll
        for (int a = 0; a < 2; ++a)
#pragma unroll
            for (int b = 0; b < 2; ++b)
#pragma unroll
                for (int m = 0; m < 4; ++m)
#pragma unroll
                    for (int n = 0; n < 2; ++n) acc[a][b][m][n] = (f32x4){0.f, 0.f, 0.f, 0.f};
        cur = nxt; cA = nA; cB = nB; ++ui;
        if constexpr (ALIGN_EPI) { if (wr == 1) PG8_BAR; }
    }
    PG8_WAIT_V(0);
    if constexpr (!ALIGN_EPI) { if (wr == 0) PG8_BAR; }
    PG8_BAR;
    if constexpr (Epi::AFTER_DRAIN) { E.fused(acc, cur, wr, wc, fr, fq, lds, wid, lane); S.done(cur); }
#undef PG8_SA
#undef PG8_SB
#undef PG8_STAGE
#undef qvoffA
#undef qvoffB
#undef PG8_LDA
#undef PG8_LDB
#undef PG8_MMA
#undef PG8_WAIT_V
#undef PG8_WAIT_L
#undef PG8_BAR
#undef PG8_SCHED
}
}

using pg8::bf16_t; using pg8::f32x4; using pg8::bf16x8; using pg8::u32x4; using pg8::u32x2;
#define DI __device__ __forceinline__
#define LAS __attribute__((address_space(3)))
typedef float f32x16 __attribute__((ext_vector_type(16)));
typedef short s16x4 __attribute__((ext_vector_type(4)));
typedef float f32x2_t __attribute__((ext_vector_type(2))); typedef __bf16 bf16x2_t __attribute__((ext_vector_type(2)));

constexpr int NTHR = 512, NWAVES = 8;
constexpr int D = 1024, NB = 8, SEQ = 2048, DEPTH = 4, DB = 16, DT = 16, PAST = 1024;
constexpr int MP = NB * SEQ, MS = DB * DT, MA = MP + MS;
constexpr int NIN = 6032, NINP = 6144;
constexpr int C_QA = 0, C_KA = 384, C_VA = 768, C_U = 1152, C_QC = 1408, C_KC = 1792, C_VC = 2176, C_GC = 2560, C_LR = 2944, C_GA = 2960, C_GB = 3984, C_GCG = 5008;
constexpr int FF = 2816, FF2 = 5632;
constexpr int GH = 4, GK = 96;
constexpr int NGU_P = NB * GH * 32, NGU_S = DB * GH, NGU = NGU_P + NGU_S;
constexpr float EPS = 1e-6f;

constexpr size_t O_YP = 0, O_YS = O_YP + (size_t)MP * D, O_KP = O_YS + (size_t)MS * D, O_VP = O_KP + (size_t)DEPTH * MP * 384, O_POOLP = O_VP + (size_t)DEPTH * MP * 384,
    O_GLAP = O_POOLP + (size_t)DEPTH * NB * 15 * 256, O_MKP = O_GLAP + (size_t)DEPTH * NB * GH * GK * GK, O_MVP = O_MKP + (size_t)DEPTH * NB * 256 * D,
    O_KS = O_MVP + (size_t)DEPTH * NB * 256 * D, O_VS = O_KS + (size_t)DEPTH * MS * 384, O_POOLS = O_VS + (size_t)DEPTH * MS * 384, O_GLAS = O_POOLS + (size_t)DEPTH * DB * 15 * 256,
    O_END = O_GLAS + (size_t)DEPTH * DB * GH * GK * GK;

enum { I_XP = 0, I_XS, I_MEM, I_CSK, I_CSV, I_SPOOL, I_SGLA, I_CMK, I_CMV, I_WIN, I_WA2, I_BA, I_GLAN, I_WPOOL, I_PSCALE, I_WBA, I_WBB, I_WBC, I_WMIX, I_MEMN, I_WXQ, I_WXK, I_WXV, I_WXO,
       I_WF1, I_WF2, I_NMIXPRE, I_NMIXPOST, I_NXPRE, I_NXPOST, I_NFPRE, I_NFPOST, N_IN };

constexpr size_t MiB = 1u << 20;
constexpr size_t SZ_WIN = (size_t)NINP * D * 2, SZ_WBA = (size_t)D * 384 * 2, SZ_WBB = (size_t)D * 256 * 2, SZ_WSQ = (size_t)D * D * 2, SZ_WKV = 2 * SZ_WSQ, SZ_WF1 = (size_t)FF2 * D * 2, SZ_WF2 = (size_t)D * FF * 2;
constexpr size_t WS_CTL = 0, CTL_BYTES = 1 * MiB, WS_TAB = CTL_BYTES - 4096;
constexpr size_t WS_WIN = WS_CTL + CTL_BYTES, WS_WBA = WS_WIN + 4 * SZ_WIN, WS_WBB = WS_WBA + 4 * SZ_WBA, WS_WBC = WS_WBB + 4 * SZ_WBB, WS_WMIX = WS_WBC + 4 * SZ_WBA,
    WS_WXQ = WS_WMIX + 4 * SZ_WSQ, WS_WXO = WS_WXQ + 4 * SZ_WSQ, WS_WKV = WS_WXO + 4 * SZ_WSQ, WS_WF1 = WS_WKV + 4 * SZ_WKV, WS_WF2 = WS_WF1 + 4 * SZ_WF1,
    WS_MN = WS_WF2 + 4 * SZ_WF2, WS_MKV = WS_MN + 4 * SZ_WKV, WS_MEMVT = WS_MKV + 8 * SZ_WKV, WS_PROJ = WS_MEMVT + 4 * SZ_WKV;
constexpr size_t SZ_ROWS = (size_t)MA * D * 2;
constexpr size_t SZ_PROJ = (size_t)MA * NINP * 2;
constexpr size_t WS_Q = WS_PROJ, WS_P = WS_Q + SZ_ROWS, WS_O = WS_P + SZ_ROWS, WS_ACT = WS_O + SZ_ROWS;
static_assert(WS_ACT + (size_t)MA * FF * 2 <= WS_PROJ + SZ_PROJ, "overlay fits");
constexpr size_t WS_H = WS_PROJ + SZ_PROJ, WS_MERGED = WS_H + SZ_ROWS, WS_Y = WS_MERGED + SZ_ROWS;
constexpr size_t WS_GKV = WS_H, WS_GSP = WS_GKV + 39 * MiB, WS_GDEC = WS_GSP + 37 * MiB;
static_assert((size_t)NGU * GK * GK * 4 <= 39 * MiB && (size_t)NGU_P * GK * GK * 4 <= 37 * MiB && WS_GDEC + (size_t)NGU * GK * 4 <= WS_Y + SZ_ROWS, "GLA overlay fits");
constexpr size_t WS_OA = WS_Y + SZ_ROWS, WS_POOLED = WS_OA + (size_t)MA * 384 * 2, WS_OC = WS_POOLED + (size_t)MA * 256 * 2, WS_BB = WS_OC + (size_t)MA * 384 * 2, WS_END = WS_BB + (size_t)NGU * 64 * GK * 4;
static_assert(WS_WIN % 256 == 0 && WS_PROJ % 256 == 0 && WS_H % 256 == 0 && WS_OA % 256 == 0 && WS_POOLED % 256 == 0 && WS_OC % 256 == 0 && WS_P % 256 == 0, "alignment");

constexpr int CW_BAR = 16384;
constexpr int LDS_GEMM = 131072, LDS_X = LDS_GEMM, LDS_X_BYTES = 12288, LDS_MISC = LDS_X + LDS_X_BYTES, LDS_BYTES = LDS_MISC + 256;

struct Params { const float* in[N_IN]; float* out; unsigned char* ws; int ph_lo, ph_hi; };
struct InTab { const float* const* t;
    __device__ __forceinline__ const float* operator[](int i) const { const unsigned long long v = (unsigned long long)t[i];
        const unsigned lo = __builtin_amdgcn_readfirstlane((unsigned)v), hi = __builtin_amdgcn_readfirstlane((unsigned)(v >> 32)); return (const float*)(((unsigned long long)hi << 32) | lo); } };
struct Ctx { InTab in; float* out; unsigned char* ws; };

DI float bflo(unsigned w) { return __uint_as_float(w << 16); }
DI float bfhi(unsigned w) { return __uint_as_float(w & 0xffff0000u); }
DI float bf2f(unsigned short v) { return __uint_as_float((unsigned)v << 16); }
DI unsigned pk2(float lo, float hi) { f32x2_t v = {lo, hi}; bf16x2_t b = __builtin_convertvector(v, bf16x2_t); return __builtin_bit_cast(unsigned, b); }
DI unsigned short f2bf(float f) { return (unsigned short)(pk2(f, 0.f) & 0xffffu); }
DI float wave_sum(float v) {
#pragma unroll
    for (int o = 1; o < 64; o <<= 1) v += __shfl_xor(v, o);
    return v;
}
DI float wave_max(float v) {
#pragma unroll
    for (int o = 1; o < 64; o <<= 1) v = fmaxf(v, __shfl_xor(v, o));
    return v;
}
DI float sigmoidf_(float x) { return __builtin_amdgcn_rcpf(1.f + __expf(-x)); }
DI float softplusf_(float z) { return fmaxf(z, 0.f) + __logf(1.f + __expf(-fabsf(z))); }
DI int next_work(unsigned* ctr, volatile LAS int* slot) {
    __syncthreads();
    if (pg8::tid_() == 0) *slot = (int)atomicAdd(ctr, 1u);
    __syncthreads();
    return *slot;
}

typedef const pg8::f32x4 (&AccRef)[2][2][4][2];
struct EpiBf16 {
    static constexpr bool PERM = true, AFTER_DRAIN = false;
    bf16_t* O; int ldc; int pnmask;
    DI void operator()(AccRef acc, const pg8::Unit& u, int wr, int wc, int fr, int fq) const {
#pragma unroll
        for (int ai = 0; ai < 2; ++ai)
#pragma unroll
            for (int m = 0; m < 4; ++m) {
                bf16_t* rowp = O + (size_t)(u.pm * 256 + ai * 128 + wr * 64 + m * 16 + fr) * ldc + (u.pn & pnmask) * 256 + wc * 32 + 8 * fq;
#pragma unroll
                for (int bj = 0; bj < 2; ++bj) {
                    const f32x4 v0 = acc[ai][bj][m][0], v1 = acc[ai][bj][m][1];
                    u32x4 w; w.x = pk2(v0[0], v0[1]); w.y = pk2(v0[2], v0[3]); w.z = pk2(v1[0], v1[1]); w.w = pk2(v1[2], v1[3]);
                    *(u32x4*)(rowp + bj * 128) = w;
                }
            }
    }
};
struct EpiGate {
    static constexpr bool PERM = true, AFTER_DRAIN = false;
    bf16_t* merged; const bf16_t* proj; int goff; int accum;
    DI void operator()(AccRef acc, const pg8::Unit& u, int wr, int wc, int fr, int fq) const {
#pragma unroll
        for (int ai = 0; ai < 2; ++ai)
#pragma unroll
            for (int m = 0; m < 4; ++m) {
                const int row = u.pm * 256 + ai * 128 + wr * 64 + m * 16 + fr;
                const bf16_t* gp = proj + (size_t)row * NINP + goff + u.pn * 256 + wc * 32 + 8 * fq;
                bf16_t* mp = merged + (size_t)row * D + u.pn * 256 + wc * 32 + 8 * fq;
#pragma unroll
                for (int bj = 0; bj < 2; ++bj)
#pragma unroll
                    for (int n = 0; n < 2; ++n) {
                        const u32x2 g = *(const u32x2*)(gp + bj * 128 + 4 * n);
                        u32x2 pm2 = {0u, 0u}; if (accum) pm2 = *(const u32x2*)(mp + bj * 128 + 4 * n);
                        const f32x4 v = acc[ai][bj][m][n];
                        const float r0 = sigmoidf_(bflo(g.x)) * v[0] + bflo(pm2.x), r1 = sigmoidf_(bfhi(g.x)) * v[1] + bfhi(pm2.x);
                        const float r2 = sigmoidf_(bflo(g.y)) * v[2] + bflo(pm2.y), r3 = sigmoidf_(bfhi(g.y)) * v[3] + bfhi(pm2.y);
                        u32x2 w; w.x = pk2(r0, r1); w.y = pk2(r2, r3);
                        *(u32x2*)(mp + bj * 128 + 4 * n) = w;
                        asm volatile("" ::: "memory");
                    }
            }
    }
};
struct EpiSwiglu {
    static constexpr bool PERM = true, AFTER_DRAIN = false;
    bf16_t* act;
    DI void operator()(AccRef acc, const pg8::Unit& u, int wr, int wc, int fr, int fq) const {
#pragma unroll
        for (int ai = 0; ai < 2; ++ai)
#pragma unroll
            for (int m = 0; m < 4; ++m) {
                const int row = u.pm * 256 + ai * 128 + wr * 64 + m * 16 + fr;
#pragma unroll
                for (int bj = 0; bj < 2; ++bj) {
                    const int col0 = u.pn * 256 + bj * 128 + wc * 32 + 8 * fq;
                    const f32x4 g = acc[ai][bj][m][0], up = acc[ai][bj][m][1];
                    float r[4];
#pragma unroll
                    for (int j = 0; j < 4; ++j) r[j] = g[j] * sigmoidf_(g[j]) * up[j];
                    u32x2 w; w.x = pk2(r[0], r[1]); w.y = pk2(r[2], r[3]);
                    *(u32x2*)(act + (size_t)row * FF + (col0 >> 1)) = w;
                }
            }
    }
};
struct MemKvOrder {
    int G, c; const char* A; const char* B;
    DI bool next(int i, pg8::Unit& u) const {
        const int L = i * G + c; if (L >= 256) return false;
        const int l = L >> 6, r = L & 63; u.pm = l * 8 + (r & 7); u.pn = l * 8 + (r >> 3);
        u.a = A + (size_t)u.pm * (256 * D * 2); u.b = B + (size_t)u.pn * (256 * D * 2); return true;
    }
    DI void a_ready(const pg8::Unit&) const {}
    DI void done(const pg8::Unit&) const {}
};
struct CrossOrder {
    int G, c; const char* A; const char* B; int mode;
    DI bool next(int i, pg8::Unit& u) const {
        const int L = i * G + c; if (L >= 256) return false;
        u.pm = L >> 2; u.pn = L & 3; const int b = u.pm >> 3, h = u.pn;
        u.a = A + ((size_t)u.pm * 256 * D + h * 256) * 2;
        u.b = mode == 0 ? B + ((size_t)b * 256 * 2048 + h * 256) * 2 : B + ((size_t)h * 256 * 2048 + b * 256) * 2;
        return true;
    }
    DI void a_ready(const pg8::Unit&) const {}
    DI void done(const pg8::Unit&) const {}
};
struct EpiSoftmax {
    static constexpr bool PERM = true, AFTER_DRAIN = false;
    bf16_t* P; LAS float* xs;
    DI void operator()(AccRef acc, const pg8::Unit& u, int wr, int wc, int fr, int fq) const {
        const float sc = 0.0625f * 1.4426950408889634f;
        LAS float* xm = xs; LAS float* xsum = xs + 1024;
#pragma unroll
        for (int ai = 0; ai < 2; ++ai)
#pragma unroll
            for (int m = 0; m < 4; ++m) {
                float a = -3.0e38f;
#pragma unroll
                for (int bj = 0; bj < 2; ++bj)
#pragma unroll
                    for (int n = 0; n < 2; ++n) { const f32x4 v = acc[ai][bj][m][n]; a = fmaxf(a, fmaxf(fmaxf(v[0], v[1]), fmaxf(v[2], v[3]))); }
                a = fmaxf(a, __shfl_xor(a, 16)); a = fmaxf(a, __shfl_xor(a, 32));
                if (fq == 0) xm[(ai * 128 + wr * 64 + m * 16 + fr) * 4 + wc] = a;
                asm volatile("" ::: "memory");
            }
        __syncthreads();
#pragma unroll
        for (int ai = 0; ai < 2; ++ai)
#pragma unroll
            for (int m = 0; m < 4; ++m) {
                const f32x4 t = *(LAS f32x4*)(xm + (ai * 128 + wr * 64 + m * 16 + fr) * 4); const float mx = fmaxf(fmaxf(t[0], t[1]), fmaxf(t[2], t[3])) * sc;
                float s = 0.f;
#pragma unroll
                for (int bj = 0; bj < 2; ++bj)
#pragma unroll
                    for (int n = 0; n < 2; ++n)
#pragma unroll
                        for (int j = 0; j < 4; ++j) s += __builtin_amdgcn_exp2f(acc[ai][bj][m][n][j] * sc - mx);
                s += __shfl_xor(s, 16); s += __shfl_xor(s, 32);
                if (fq == 0) xsum[(ai * 128 + wr * 64 + m * 16 + fr) * 4 + wc] = s;
                asm volatile("" ::: "memory");
            }
        __syncthreads();
#pragma unroll
        for (int ai = 0; ai < 2; ++ai)
#pragma unroll
            for (int m = 0; m < 4; ++m) {
                const f32x4 t = *(LAS f32x4*)(xm + (ai * 128 + wr * 64 + m * 16 + fr) * 4); const float mx = fmaxf(fmaxf(t[0], t[1]), fmaxf(t[2], t[3])) * sc;
                const f32x4 t2 = *(LAS f32x4*)(xsum + (ai * 128 + wr * 64 + m * 16 + fr) * 4); const float inv = __builtin_amdgcn_rcpf((t2[0] + t2[1]) + (t2[2] + t2[3]));
                bf16_t* rowp = P + (size_t)(u.pm * 256 + ai * 128 + wr * 64 + m * 16 + fr) * D + u.pn * 256 + wc * 32 + 8 * fq;
#pragma unroll
                for (int bj = 0; bj < 2; ++bj)
#pragma unroll
                    for (int n = 0; n < 2; ++n) {
                        const f32x4 v = acc[ai][bj][m][n];
                        u32x2 w; w.x = pk2(__builtin_amdgcn_exp2f(v[0] * sc - mx) * inv, __builtin_amdgcn_exp2f(v[1] * sc - mx) * inv); w.y = pk2(__builtin_amdgcn_exp2f(v[2] * sc - mx) * inv, __builtin_amdgcn_exp2f(v[3] * sc - mx) * inv);
                        *(u32x2*)(rowp + bj * 128 + 4 * n) = w;
                    }
                asm volatile("" ::: "memory");
            }
        __syncthreads();
    }
};

#define XB_TMO      128
#define XB_XCNT(j)  (256  + 64 * (j))
#define XB_XSUB(j)  (1280 + 64 * (j))
#define XB_XGEN(j)  (2304 + 64 * (j))
#define XB_TOP      3328
#define XB_TOPGEN   3392
#define XCD_BAR_WORDS 3456
#define XB_SPIN_CAP (1u << 18)

__device__ __forceinline__ unsigned xb_ld(unsigned* p)              { return __hip_atomic_load(p, __ATOMIC_RELAXED, __HIP_MEMORY_SCOPE_AGENT); }
__device__ __forceinline__ unsigned xb_add(unsigned* p, unsigned v) { return __hip_atomic_fetch_add(p, v, __ATOMIC_RELAXED, __HIP_MEMORY_SCOPE_AGENT); }
__device__ __forceinline__ unsigned xb_xcc_id() { return (unsigned)__builtin_amdgcn_s_getreg((3 << 11) | 20) & 0xFu; }
#define XB_SPIN(cond, bar) do { unsigned _sp = 0; while (cond) { __builtin_amdgcn_s_sleep(1); \
    if ((++_sp & 255u) == 0u) { if (xb_ld(&(bar)[XB_TMO])) break; if (_sp > XB_SPIN_CAP) { atomicAdd(&(bar)[XB_TMO], 1u); break; } } } } while (0)

struct XcdBarrier {
    unsigned* bar; unsigned x;
    volatile LAS unsigned* st;
};

__device__ __forceinline__ XcdBarrier xcd_barrier_post(unsigned* bar, volatile LAS unsigned* st) {
    XcdBarrier b; b.bar = bar; b.x = xb_xcc_id(); b.st = st;
    if (threadIdx.x == 0) (void)xb_add(&bar[XB_XCNT(b.x)], 1u);
    return b;
}
__device__ __forceinline__ void xcd_barrier_complete(unsigned* bar, unsigned x, unsigned& nloc, unsigned& nx) {
    const unsigned G = gridDim.x * gridDim.y * gridDim.z;
    unsigned sum, cnt, mine, sp = 0u;
    for (;;) {
        sum = 0u; cnt = 0u; mine = 0u;
#pragma unroll
        for (unsigned j = 0; j < 16; ++j) { const unsigned c = xb_ld(&bar[XB_XCNT(j)]); sum += c; cnt += (c > 0u) ? 1u : 0u; mine = (j == x) ? c : mine; }
        if (sum == G) break;
        __builtin_amdgcn_s_sleep(1);
        if ((++sp & 255u) == 0u) { if (xb_ld(&bar[XB_TMO])) break; if (sp > XB_SPIN_CAP) { atomicAdd(&bar[XB_TMO], 1u); break; } }
    }
    nloc = mine > 0u ? mine : 1u; nx = cnt > 0u ? cnt : 1u;
}

__device__ __forceinline__ void xcd_barrier(const XcdBarrier& b) {
    asm volatile("s_waitcnt vmcnt(0)" ::: "memory");
    __syncthreads();
    if (threadIdx.x == 0) {
        unsigned* bar = b.bar;
        __builtin_amdgcn_s_waitcnt(0);
        unsigned nloc = b.st[0], nx = b.st[1];
        if (nloc == 0u) { xcd_barrier_complete(bar, b.x, nloc, nx); b.st[0] = nloc; b.st[1] = nx; }
        const unsigned old = xb_add(&bar[XB_XSUB(b.x)], 1u);
        const unsigned gen = old / nloc;
        if (old + 1u == (gen + 1u) * nloc) {
            __builtin_amdgcn_fence(__ATOMIC_RELEASE, "agent");
            asm volatile("s_waitcnt vmcnt(0)" ::: "memory");
            const unsigned og = xb_add(&bar[XB_TOP], 1u);
            const unsigned tg = og / nx;
            if (og + 1u == (tg + 1u) * nx) xb_add(&bar[XB_TOPGEN], 1u);
            else XB_SPIN(xb_ld(&bar[XB_TOPGEN]) == tg, bar);
            __builtin_amdgcn_fence(__ATOMIC_ACQUIRE, "agent");
            xb_add(&bar[XB_XGEN(b.x)], 1u);
            asm volatile("s_waitcnt vmcnt(0)" ::: "memory");
        } else {
            XB_SPIN(xb_ld(&bar[XB_XGEN(b.x)]) == gen, bar);
            __builtin_amdgcn_fence(__ATOMIC_ACQUIRE, "agent");
            asm volatile("s_waitcnt vmcnt(0)" ::: "memory");
        }
    }
    __syncthreads();
}


#define LDS_WAIT() asm volatile("s_waitcnt lgkmcnt(0)" ::: "memory")
DI void transpose_item(const float* W, int K, int N, int Npad, bf16_t* WT, int mode, LAS float* scr, int item, int lane) {
    const int nblk = Npad / 32, kb = item / nblk, nb = item % nblk, k0 = 64 * kb, n0 = 32 * nb;
    const int nn = n0 + (lane & 31); const bool ok = nn < N;
    float tv[32];
#pragma unroll
    for (int i = 0; i < 32; ++i) tv[i] = ok ? W[(size_t)(k0 + 2 * i + (lane >> 5)) * N + nn] : 0.f;
#pragma unroll
    for (int i = 0; i < 32; ++i) scr[(2 * i + (lane >> 5)) * 33 + (lane & 31)] = tv[i];
    LDS_WAIT(); asm volatile("" ::: "memory");
    const int c = lane & 7;
#pragma unroll
    for (int j = 0; j < 4; ++j) {
        const int n = (lane >> 3) + 8 * j; const LAS float* s = scr + (8 * c) * 33 + n;
        u32x4 o; o.x = pk2(s[0 * 33], s[1 * 33]); o.y = pk2(s[2 * 33], s[3 * 33]); o.z = pk2(s[4 * 33], s[5 * 33]); o.w = pk2(s[6 * 33], s[7 * 33]);
        int drow = n0 + n;
        if (mode == 1) { const int jj = drow >= FF ? drow - FF : drow, isu = drow >= FF ? 1 : 0; drow = (jj >> 2) * 8 + isu * 4 + (jj & 3); }
        *(u32x4*)(WT + (size_t)drow * K + k0 + 8 * c) = o;
    }
    LDS_WAIT(); asm volatile("" ::: "memory");
}

DI void norm_row(const float* xsrc, float* xdst, const bf16_t* y, const float* gpost, const float* gpre, bf16_t* h, int lane) {
    f32x4 v[4];
#pragma unroll
    for (int j = 0; j < 4; ++j) v[j] = *(const f32x4*)(xsrc + 4 * lane + 256 * j);
    if (y) {
        f32x4 yv[4]; float ss = 0.f;
#pragma unroll
        for (int j = 0; j < 4; ++j) { const u32x2 w = *(const u32x2*)(y + 4 * lane + 256 * j); yv[j] = (f32x4){bflo(w.x), bfhi(w.x), bflo(w.y), bfhi(w.y)}; ss += (yv[j][0] * yv[j][0] + yv[j][1] * yv[j][1]) + (yv[j][2] * yv[j][2] + yv[j][3] * yv[j][3]); }
        const float rs = rsqrtf(wave_sum(ss) * (1.f / D) + EPS);
#pragma unroll
        for (int j = 0; j < 4; ++j) { const f32x4 g = *(const f32x4*)(gpost + 4 * lane + 256 * j); v[j] = v[j] + yv[j] * rs * g; }
    }
#pragma unroll
    for (int j = 0; j < 4; ++j) *(f32x4*)(xdst + 4 * lane + 256 * j) = v[j];
    if (gpre) {
        float ss = 0.f;
#pragma unroll
        for (int j = 0; j < 4; ++j) ss += (v[j][0] * v[j][0] + v[j][1] * v[j][1]) + (v[j][2] * v[j][2] + v[j][3] * v[j][3]);
        const float rs = rsqrtf(wave_sum(ss) * (1.f / D) + EPS);
#pragma unroll
        for (int j = 0; j < 4; ++j) { const f32x4 g = *(const f32x4*)(gpre + 4 * lane + 256 * j); const f32x4 o = v[j] * rs * g; u32x2 w; w.x = pk2(o[0], o[1]); w.y = pk2(o[2], o[3]); *(u32x2*)(h + 4 * lane + 256 * j) = w; }
    }
}


DI void norm_phase(const Ctx& p, const float* gpost, const float* gpre, int G, int bx) {
    const int tid = pg8::tid_(), lane = tid & 63, wv = tid >> 6, gw = bx * NWAVES + wv, NGW = G * NWAVES;
    const bf16_t* Yb = (const bf16_t*)(p.ws + WS_Y); bf16_t* Hb = (bf16_t*)(p.ws + WS_H);
    for (int row = gw; row < MA; row += NGW) norm_row(p.out + (size_t)row * D, p.out + (size_t)row * D, Yb + (size_t)row * D, gpost, gpre, Hb + (size_t)row * D, lane);
}

DI void prologue(const Params& p, LAS unsigned char* lds) {
    const int tid = pg8::tid_(), lane = tid & 63, wv = tid >> 6;
    const int gw = blockIdx.x * NWAVES + wv, NGW = gridDim.x * NWAVES;
    LAS float* scr = (LAS float*)(lds + wv * 16384);
    unsigned char* ws = p.ws;
    constexpr int I0 = 3072, I1 = 192, I2 = 512, I3 = 2816, I4 = 1408, IPL = I0 + 2 * I1 + 5 * I2 + I3 + I4;
    for (int it = gw; it < 4 * IPL; it += NGW) {
        const int l = it / IPL; int r = it % IPL;
        if (r < I0) { transpose_item(p.in[I_WIN] + (size_t)l * D * NIN, D, NIN, NINP, (bf16_t*)(ws + WS_WIN + l * SZ_WIN), 0, scr, r, lane); continue; } r -= I0;
        if (r < I1) { transpose_item(p.in[I_WBA] + (size_t)l * 384 * D, 384, D, D, (bf16_t*)(ws + WS_WBA + l * SZ_WBA), 0, scr, r, lane); continue; } r -= I1;
        if (r < I1) { transpose_item(p.in[I_WBC] + (size_t)l * 384 * D, 384, D, D, (bf16_t*)(ws + WS_WBC + l * SZ_WBA), 0, scr, r, lane); continue; } r -= I1;
        if (r < I2) { transpose_item(p.in[I_WMIX] + (size_t)l * D * D, D, D, D, (bf16_t*)(ws + WS_WMIX + l * SZ_WSQ), 0, scr, r, lane); continue; } r -= I2;
        if (r < I2) { transpose_item(p.in[I_WXQ] + (size_t)l * D * D, D, D, D, (bf16_t*)(ws + WS_WXQ + l * SZ_WSQ), 0, scr, r, lane); continue; } r -= I2;
        if (r < I2) { transpose_item(p.in[I_WXO] + (size_t)l * D * D, D, D, D, (bf16_t*)(ws + WS_WXO + l * SZ_WSQ), 0, scr, r, lane); continue; } r -= I2;
        if (r < I2) { transpose_item(p.in[I_WXK] + (size_t)l * D * D, D, D, D, (bf16_t*)(ws + WS_WKV + l * SZ_WKV), 0, scr, r, lane); continue; } r -= I2;
        if (r < I2) { transpose_item(p.in[I_WXV] + (size_t)l * D * D, D, D, D, (bf16_t*)(ws + WS_WKV + l * SZ_WKV + SZ_WSQ), 0, scr, r, lane); continue; } r -= I2;
        if (r < I3) { transpose_item(p.in[I_WF1] + (size_t)l * D * FF2, D, FF2, FF2, (bf16_t*)(ws + WS_WF1 + l * SZ_WF1), 1, scr, r, lane); continue; } r -= I3;
        transpose_item(p.in[I_WF2] + (size_t)l * FF * D, FF, D, D, (bf16_t*)(ws + WS_WF2 + l * SZ_WF2), 0, scr, r, lane);
    }
    for (int u = blockIdx.x; u < 128; u += gridDim.x) {
        const int l = u >> 5, g = (u >> 3) & 3, nb = (u >> 2) & 1, cq = u & 3;
        LAS float* Ps = (LAS float*)(lds + 8 * 16384);
        __syncthreads();
        for (int i = tid; i < 1024; i += NTHR) Ps[i] = p.in[I_WPOOL][((size_t)(l * 4 + g) * 64 + 16 * cq) * 64 + i];
        __syncthreads();
        const int n = nb * 512 + tid;
        const float* sc = p.in[I_PSCALE] + l * 256 + g * 64; const float* wb = p.in[I_WBB] + ((size_t)l * 256 + g * 64) * D + n;
        float acc[16];
#pragma unroll
        for (int c = 0; c < 16; ++c) acc[c] = 0.f;
#pragma unroll 2
        for (int d0 = 0; d0 < 64; d0 += 8) {
            float bc[8];
#pragma unroll
            for (int j = 0; j < 8; ++j) bc[j] = sc[d0 + j] * wb[(size_t)(d0 + j) * D];
#pragma unroll
            for (int c = 0; c < 16; ++c) { const f32x4 p0 = *(const LAS f32x4*)(Ps + c * 64 + d0), p1 = *(const LAS f32x4*)(Ps + c * 64 + d0 + 4);
                acc[c] += ((p0[0] * bc[0] + p0[1] * bc[1]) + (p0[2] * bc[2] + p0[3] * bc[3])) + ((p1[0] * bc[4] + p1[1] * bc[5]) + (p1[2] * bc[6] + p1[3] * bc[7])); }
        }
        unsigned ov[16];
#pragma unroll
        for (int c = 0; c < 16; ++c) ov[c] = f2bf(acc[c]);
        bf16_t* dst = (bf16_t*)(ws + WS_WBB + l * SZ_WBB) + (size_t)n * 256 + g * 64 + 16 * cq;
        u32x4 w0, w1; w0.x = ov[0] | (ov[1] << 16); w0.y = ov[2] | (ov[3] << 16); w0.z = ov[4] | (ov[5] << 16); w0.w = ov[6] | (ov[7] << 16);
        w1.x = ov[8] | (ov[9] << 16); w1.y = ov[10] | (ov[11] << 16); w1.z = ov[12] | (ov[13] << 16); w1.w = ov[14] | (ov[15] << 16);
        *(u32x4*)dst = w0; *(u32x4*)(dst + 8) = w1;
    }
    __syncthreads();
    for (int row = gw; row < MA; row += NGW) {
        const float* src = row < MP ? p.in[I_XP] + (size_t)row * D : p.in[I_XS] + (size_t)(row - MP) * D;
        norm_row(src, p.out + (size_t)row * D, nullptr, nullptr, p.in[I_NMIXPRE], (bf16_t*)(ws + WS_H) + (size_t)row * D, lane);
    }
    for (int row = gw; row < NB * 256; row += NGW) {
        f32x4 v[4]; float ss = 0.f;
#pragma unroll
        for (int j = 0; j < 4; ++j) { v[j] = *(const f32x4*)(p.in[I_MEM] + (size_t)row * D + 4 * lane + 256 * j); ss += (v[j][0] * v[j][0] + v[j][1] * v[j][1]) + (v[j][2] * v[j][2] + v[j][3] * v[j][3]); }
        const float rs = rsqrtf(wave_sum(ss) * (1.f / D) + EPS);
        for (int l = 0; l < 4; ++l)
#pragma unroll
            for (int j = 0; j < 4; ++j) { const f32x4 g = *(const f32x4*)(p.in[I_MEMN] + l * D + 4 * lane + 256 * j); const f32x4 o = v[j] * rs * g; u32x2 w; w.x = pk2(o[0], o[1]); w.y = pk2(o[2], o[3]);
                *(u32x2*)((bf16_t*)(ws + WS_MN) + ((size_t)l * 2048 + row) * D + 4 * lane + 256 * j) = w; }
    }
}

#define MFMA32(a, b, c) __builtin_amdgcn_mfma_f32_32x32x16_bf16((a), (b), (c), 0, 0, 0)
#define MFMA16(a, b, c) __builtin_amdgcn_mfma_f32_16x16x32_bf16((a), (b), (c), 0, 0, 0)
DI void sb_prompt_unit(const Ctx& p, int b, int h, int qb, LAS unsigned char* lds) {
    const bf16_t* proj = (const bf16_t*)(p.ws + WS_PROJ);
    LAS unsigned short* KS = (LAS unsigned short*)lds;
    LAS unsigned short* VT = KS + 64 * 72;
    const int tid = pg8::tid_(), lane = tid & 63, wv = tid >> 6, hi = lane >> 5, c = lane & 31;
    const int q0 = qb * 256 + wv * 32, tq = q0 + c;
    const size_t rowbase = (size_t)b * SEQ;
    bf16x8 qf[4];
    {
        const bf16_t* qp = proj + (rowbase + tq) * NINP + C_QA + h * 64 + 8 * hi;
#pragma unroll
        for (int kk = 0; kk < 4; ++kk) qf[kk] = *(const bf16x8*)(qp + 16 * kk);
    }
    f32x16 o0, o1;
#pragma unroll
    for (int i = 0; i < 16; ++i) { o0[i] = 0.f; o1[i] = 0.f; }
    float R = 0.f;
    const bf16_t* kbase = proj + rowbase * NINP + C_KA + h * 64 + 8 * wv;
    const bf16_t* vbase = proj + rowbase * NINP + C_VA + h * 64 + 8 * wv;
    int jt = 4 * qb + 3;
    u32x4 kr = *(const u32x4*)(kbase + (size_t)(64 * jt + lane) * NINP), vr = *(const u32x4*)(vbase + (size_t)(64 * jt + lane) * NINP);
    for (; jt >= 0; --jt) {
        __syncthreads();
        *(LAS u32x4*)(KS + lane * 72 + 8 * wv) = kr;
#pragma unroll
        for (int i = 0; i < 4; ++i) { const unsigned w = vr[i]; VT[(8 * wv + 2 * i) * 72 + lane] = (unsigned short)(w & 0xffffu); VT[(8 * wv + 2 * i + 1) * 72 + lane] = (unsigned short)(w >> 16); }
        __syncthreads();
        if (jt > 0) { kr = *(const u32x4*)(kbase + (size_t)(64 * (jt - 1) + lane) * NINP); vr = *(const u32x4*)(vbase + (size_t)(64 * (jt - 1) + lane) * NINP); }
        if (64 * jt < q0 + 31) {
            f32x16 z[2];
#pragma unroll
            for (int kb = 0; kb < 2; ++kb) {
                f32x16 acc;
#pragma unroll
                for (int i = 0; i < 16; ++i) acc[i] = 0.f;
#pragma unroll
                for (int kk = 0; kk < 4; ++kk) { const bf16x8 a = *(const LAS bf16x8*)(KS + (32 * kb + c) * 72 + 16 * kk + 8 * hi); acc = MFMA32(a, qf[kk], acc); }
                z[kb] = acc;
            }
            f32x16 e[2]; float T[8];
            const int sbase = 64 * jt + 4 * hi;
#pragma unroll
            for (int kb = 0; kb < 2; ++kb)
#pragma unroll
                for (int g = 0; g < 4; ++g) {
                    float lf[4];
#pragma unroll
                    for (int j = 0; j < 4; ++j) {
                        const int r = 4 * g + j; const float zz = z[kb][r] * 0.125f; const bool valid = (sbase + 32 * kb + 8 * g + j) < tq;
                        const float sp = softplusf_(zz); lf[j] = valid ? -sp : 0.f; z[kb][r] = valid ? zz - sp : -1.0e30f;
                    }
                    e[kb][4 * g + 3] = 0.f; e[kb][4 * g + 2] = lf[3]; e[kb][4 * g + 1] = lf[3] + lf[2]; e[kb][4 * g + 0] = lf[3] + lf[2] + lf[1];
                    T[kb * 4 + g] = e[kb][4 * g + 0] + lf[0];
                }
            float Tp[8], X[8];
#pragma unroll
            for (int gi = 0; gi < 8; ++gi) Tp[gi] = __shfl_xor(T[gi], 32);
            X[7] = 0.f;
#pragma unroll
            for (int gi = 6; gi >= 0; --gi) X[gi] = X[gi + 1] + (T[gi + 1] + Tp[gi + 1]);
            const float total = X[0] + (T[0] + Tp[0]);
#pragma unroll
            for (int kb = 0; kb < 2; ++kb)
#pragma unroll
                for (int g = 0; g < 4; ++g) {
                    const int gi = kb * 4 + g; const float off = R + X[gi] + (hi == 0 ? Tp[gi] : 0.f);
#pragma unroll
                    for (int j = 0; j < 4; ++j) { const int r = 4 * g + j; z[kb][r] = __expf(z[kb][r] + off + e[kb][r]); }
                }
            R += total;
#pragma unroll
            for (int kb = 0; kb < 2; ++kb)
#pragma unroll
                for (int s2 = 0; s2 < 2; ++s2) {
                    u32x4 pw; pw.x = pk2(z[kb][8 * s2 + 0], z[kb][8 * s2 + 1]); pw.y = pk2(z[kb][8 * s2 + 2], z[kb][8 * s2 + 3]); pw.z = pk2(z[kb][8 * s2 + 4], z[kb][8 * s2 + 5]); pw.w = pk2(z[kb][8 * s2 + 6], z[kb][8 * s2 + 7]);
                    const bf16x8 pb = __builtin_bit_cast(bf16x8, pw);
                    const int ko = 32 * kb + 16 * s2 + 4 * hi;
                    { const s16x4 lo = *(const LAS s16x4*)(VT + c * 72 + ko), hh = *(const LAS s16x4*)(VT + c * 72 + ko + 8);
                      const bf16x8 va = __builtin_shufflevector(lo, hh, 0, 1, 2, 3, 4, 5, 6, 7); o0 = MFMA32(va, pb, o0); }
                    { const s16x4 lo = *(const LAS s16x4*)(VT + (c + 32) * 72 + ko), hh = *(const LAS s16x4*)(VT + (c + 32) * 72 + ko + 8);
                      const bf16x8 va = __builtin_shufflevector(lo, hh, 0, 1, 2, 3, 4, 5, 6, 7); o1 = MFMA32(va, pb, o1); }
                }
        }
    }
    bf16_t* op = (bf16_t*)(p.ws + WS_OA) + (rowbase + tq) * 384 + h * 64 + 4 * hi;
#pragma unroll
    for (int g = 0; g < 4; ++g) {
        u32x2 w; w.x = pk2(o0[4 * g], o0[4 * g + 1]); w.y = pk2(o0[4 * g + 2], o0[4 * g + 3]); *(u32x2*)(op + 8 * g) = w;
        w.x = pk2(o1[4 * g], o1[4 * g + 1]); w.y = pk2(o1[4 * g + 2], o1[4 * g + 3]); *(u32x2*)(op + 32 + 8 * g) = w;
    }
}

DI void sb_sample_unit(const Ctx& p, int l, int b, int h, LAS unsigned char* lds) {
    const bf16_t* proj = (const bf16_t*)(p.ws + WS_PROJ);
    LAS float* qs = (LAS float*)lds;
    LAS float* Z = qs + 1024;
    LAS float* RED = Z + 16 * 1056;
    const int tid = pg8::tid_(), lane = tid & 63, wv = tid >> 6;
    const size_t srow = (size_t)MP + b * 16;
    for (int i = tid; i < 1024; i += NTHR) qs[i] = bf2f(proj[(srow + (i >> 6)) * NINP + C_QA + h * 64 + (i & 63)]) * 0.125f;
    __syncthreads();
    {
        float a0[16], a1[16];
#pragma unroll
        for (int i = 0; i < 16; ++i) { a0[i] = 0.f; a1[i] = 0.f; }
        const float* k0p = p.in[I_CSK] + ((((size_t)l * DB + b) * PAST + tid) * 6 + h) * 64; const float* k1p = k0p + (size_t)512 * 6 * 64;
#pragma unroll 4
        for (int d4 = 0; d4 < 16; ++d4) {
            const f32x4 ka = *(const f32x4*)(k0p + 4 * d4), kb = *(const f32x4*)(k1p + 4 * d4);
#pragma unroll
            for (int i = 0; i < 16; ++i) { const f32x4 q = *(const LAS f32x4*)(qs + i * 64 + 4 * d4);
                a0[i] += (q[0] * ka[0] + q[1] * ka[1]) + (q[2] * ka[2] + q[3] * ka[3]); a1[i] += (q[0] * kb[0] + q[1] * kb[1]) + (q[2] * kb[2] + q[3] * kb[3]); }
        }
#pragma unroll
        for (int i = 0; i < 16; ++i) { Z[i * 1056 + tid] = a0[i]; Z[i * 1056 + tid + 512] = a1[i]; }
        if (tid < 256) {
            const int i = tid >> 4, j = tid & 15; const bf16_t* kp = proj + (srow + j) * NINP + C_KA + h * 64; float s = 0.f;
            for (int d = 0; d < 64; ++d) s += qs[i * 64 + d] * bf2f(kp[d]);
            Z[i * 1056 + 1024 + j] = s;
        }
    }
    __syncthreads();
    for (int qq = 0; qq < 2; ++qq) {
        const int i = 2 * wv + qq, lim = PAST + i; LAS float* zr = Z + i * 1056;
        const int st = 17 * lane, en = (st + 17 < 1040) ? st + 17 : 1040;
        float tot = 0.f;
        for (int s = st; s < en; ++s) if (s < lim) tot -= softplusf_(zr[s]);
        float incl = tot;
#pragma unroll
        for (int o = 1; o < 64; o <<= 1) { const float t = __shfl_down(incl, o); if (lane + o < 64) incl += t; }
        float run = incl - tot;
        for (int s = en - 1; s >= st; --s) {
            const float zz = zr[s]; float w = 0.f;
            if (s < lim) { const float sp = softplusf_(zz); w = __expf(zz - sp + run); run -= sp; }
            zr[s] = w;
        }
    }
    __syncthreads();
    {
        const int d = tid & 63, g = tid >> 6;
        float o[16];
#pragma unroll
        for (int i = 0; i < 16; ++i) o[i] = 0.f;
        const float* vp = p.in[I_CSV] + (((size_t)l * DB + b) * PAST * 6 + h) * 64 + d;
        for (int s0 = 130 * g; s0 < 130 * g + 130; s0 += 10) {
            float v[10];
#pragma unroll
            for (int j = 0; j < 10; ++j) { const int s = s0 + j; v[j] = s < PAST ? vp[(size_t)s * 384] : bf2f(proj[(srow + (s - PAST)) * NINP + C_VA + h * 64 + d]); }
#pragma unroll
            for (int j = 0; j < 10; ++j)
#pragma unroll
                for (int i = 0; i < 16; ++i) o[i] += Z[i * 1056 + s0 + j] * v[j];
        }
#pragma unroll
        for (int i = 0; i < 16; ++i) RED[(g * 16 + i) * 64 + d] = o[i];
    }
    __syncthreads();
    for (int i = tid; i < 1024; i += NTHR) {
        const int qi = i >> 6, d = i & 63; float s = 0.f;
#pragma unroll
        for (int g = 0; g < 8; ++g) s += RED[(g * 16 + qi) * 64 + d];
        ((bf16_t*)(p.ws + WS_OA))[(srow + qi) * 384 + h * 64 + d] = f2bf(s);
    }
}

DI void pool_unit(const Ctx& p, int l, int unit) {
    const bf16_t* proj = (const bf16_t*)(p.ws + WS_PROJ); bf16_t* pooled = (bf16_t*)(p.ws + WS_POOLED);
    const int tid = pg8::tid_(), ch = tid & 255, w = 2 << (ch >> 6);
    for (int i = 0; i < 32; ++i) {
        const int row = unit * 64 + (tid >> 8) + 2 * i;
        float s = 0.f, cnt, u0;
        if (row < MP) {
            const int t = row & (SEQ - 1); const int n = (t + 1 < w) ? t + 1 : w; cnt = (float)n;
            const bf16_t* up = proj + (size_t)row * NINP + C_U + ch; u0 = bf2f(up[0]);
            for (int j = 0; j < n; ++j) s += bf2f(*(up - (size_t)j * NINP));
            if (t >= SEQ - 15) p.out[O_POOLP + ((size_t)(l * NB + (row >> 11)) * 15 + (t - (SEQ - 15))) * 256 + ch] = u0;
        } else {
            const int rs = row - MP, b = rs >> 4, t = rs & 15; cnt = (float)w;
            const bf16_t* up = proj + (size_t)row * NINP + C_U + ch; u0 = bf2f(up[0]);
            const float* hist = p.in[I_SPOOL] + ((size_t)(l * DB + b) * 15) * 256 + ch;
            for (int j = 0; j < w; ++j) { const int tt = t - j; s += tt >= 0 ? bf2f(*(up - (size_t)j * NINP)) : hist[(15 + tt) * 256]; }
            if (t >= 1) p.out[O_POOLS + ((size_t)(l * DB + b) * 15 + (t - 1)) * 256 + ch] = u0;
        }
        pooled[(size_t)row * 256 + ch] = f2bf(s / cnt - u0);
    }
}


DI void kvout_unit(const Ctx& p, int l, int unit) {
    const bf16_t* proj = (const bf16_t*)(p.ws + WS_PROJ);
    for (int i = pg8::tid_(); i < 64 * 96; i += NTHR) {
        const int r = i / 96, ch = i % 96, row = unit * 64 + r;
        const u32x4 w = *(const u32x4*)(proj + (size_t)row * NINP + C_KA + 8 * ch);
        const bool isv = ch >= 48; const int c = 8 * (isv ? ch - 48 : ch);
        float* dst = (row < MP) ? p.out + (isv ? O_VP : O_KP) + ((size_t)l * MP + row) * 384 + c : p.out + (isv ? O_VS : O_KS) + ((size_t)l * MS + (row - MP)) * 384 + c;
        *(f32x4*)dst = (f32x4){bflo(w.x), bfhi(w.x), bflo(w.y), bfhi(w.y)}; *(f32x4*)(dst + 4) = (f32x4){bflo(w.z), bfhi(w.z), bflo(w.w), bfhi(w.w)};
    }
}
DI void memout_unit(const Ctx& p, int unit) {
    const bf16_t* mkv = (const bf16_t*)(p.ws + WS_MKV);
    for (int i = pg8::tid_(); i < 16 * 256; i += NTHR) {
        const int r = i >> 8, ch = i & 255, row = unit * 16 + r, col = 8 * ch;
        const u32x4 w = *(const u32x4*)(mkv + (size_t)row * 2048 + col);
        float* dst = p.out + (col >= 1024 ? O_MVP : O_MKP) + (size_t)row * D + (col & 1023);
        *(f32x4*)dst = (f32x4){bflo(w.x), bfhi(w.x), bflo(w.y), bfhi(w.y)}; *(f32x4*)(dst + 4) = (f32x4){bflo(w.z), bfhi(w.z), bflo(w.w), bfhi(w.w)};
    }
}
DI void memvt_unit(const Ctx& p, int unit) {
    const int l = unit >> 7, nb = (unit >> 3) & 15, b = unit & 7, tid = pg8::tid_(), n = nb * 64 + (tid & 63), wv = tid >> 6;
    const bf16_t* src = (const bf16_t*)(p.ws + WS_MKV) + ((size_t)l * 2048 + b * 256) * 2048 + 1024 + n;
    bf16_t* dst = (bf16_t*)(p.ws + WS_MEMVT) + ((size_t)l * 1024 + n) * 2048 + b * 256;
    for (int c = wv; c < 32; c += 8) {
        unsigned v[8];
#pragma unroll
        for (int j = 0; j < 8; ++j) v[j] = src[(size_t)(8 * c + j) * 2048];
        u32x4 w; w.x = v[0] | (v[1] << 16); w.y = v[2] | (v[3] << 16); w.z = v[4] | (v[5] << 16); w.w = v[6] | (v[7] << 16);
        *(u32x4*)(dst + 8 * c) = w;
    }
}

DI void gla_decay(const Ctx& p, int l, int h, size_t row0, int ntok, LAS unsigned char* lds) {
    const bf16_t* proj = (const bf16_t*)(p.ws + WS_PROJ);
    LAS float* Bc = (LAS float*)lds; LAS float* LR = (LAS float*)(lds + 24576); LAS float* A2 = (LAS float*)(lds + 28672); LAS float* BIA = (LAS float*)(lds + 34816); LAS float* SEG = (LAS float*)(lds + 35200);
    const int tid = pg8::tid_();
    if (tid < 128) {
        const int t = tid >> 1, hf = tid & 1; u32x4 w = {0u, 0u, 0u, 0u};
        if (t < ntok) w = *(const u32x4*)(proj + (row0 + t) * NINP + C_LR + 8 * hf);
        LAS float* d = LR + t * 16 + 8 * hf;
        d[0] = bflo(w.x); d[1] = bfhi(w.x); d[2] = bflo(w.y); d[3] = bfhi(w.y); d[4] = bflo(w.z); d[5] = bfhi(w.z); d[6] = bflo(w.w); d[7] = bfhi(w.w);
    } else if (tid < 128 + 384) {
        const int i = tid - 128, r = i / 24, c4 = i % 24;
        *(LAS f32x4*)(A2 + r * 96 + 4 * c4) = *(const f32x4*)(p.in[I_WA2] + ((size_t)l * 16 + r) * 384 + h * 96 + 4 * c4);
    }
    if (tid < 96) BIA[tid] = p.in[I_BA][l * 384 + h * 96 + tid];
    __syncthreads();
    for (int i = tid; i < 64 * 96; i += NTHR) {
        const int t = i / 96, k = i % 96; float sacc = BIA[k];
#pragma unroll
        for (int r = 0; r < 16; ++r) sacc += LR[t * 16 + r] * A2[r * 96 + k];
        Bc[i] = t < ntok ? -softplusf_(-sacc) * (1.f / 16.f) : 0.f;
    }
    __syncthreads();
    const int k = tid % 96, seg = tid / 96;
    if (tid < 384) { float run = 0.f; for (int i = 0; i < 16; ++i) { const int idx = (16 * seg + i) * 96 + k; run += Bc[idx]; Bc[idx] = run; } SEG[seg * 96 + k] = run; }
    __syncthreads();
    if (tid < 384 && seg > 0) { float off = 0.f; for (int s2 = 0; s2 < seg; ++s2) off += SEG[s2 * 96 + k]; for (int i = 0; i < 16; ++i) Bc[(16 * seg + i) * 96 + k] += off; }
    __syncthreads();
}
DI void gla_unit_rows(int gu, size_t& row0, int& ntok, int& bh, int& h) {
    if (gu < NGU_P) { bh = gu >> 5; const int c = gu & 31, b = bh >> 2; h = bh & 3; row0 = (size_t)b * SEQ + c * 64; ntok = 64; }
    else { bh = gu - NGU_P; const int b = bh >> 2; h = bh & 3; row0 = (size_t)MP + b * 16; ntok = 16; }
}
DI void gla_stage1_unit(const Ctx& p, int l, int gu, LAS unsigned char* lds) {
    const bf16_t* proj = (const bf16_t*)(p.ws + WS_PROJ);
    size_t row0; int ntok, bh, h; gla_unit_rows(gu, row0, ntok, bh, h);
    gla_decay(p, l, h, row0, ntok, lds);
    LAS float* Bc = (LAS float*)lds;
    LAS unsigned short* KT = (LAS unsigned short*)(lds + 36864);
    LAS unsigned short* VT = KT + 96 * 72;
    const int tid = pg8::tid_(), lane = tid & 63, wv = tid >> 6, fr = lane & 15, fq = lane >> 4;
    {
        float* bb = (float*)(p.ws + WS_BB) + (size_t)gu * (64 * GK);
        for (int i = tid; i < 64 * GK / 4; i += NTHR) *(f32x4*)(bb + 4 * i) = *(const LAS f32x4*)(Bc + 4 * i);
    }
    for (int task = tid; task < 768; task += NTHR) {
        const int t = task & 63, ch = task >> 6; u32x4 kw = {0u, 0u, 0u, 0u}, vw = {0u, 0u, 0u, 0u};
        if (t < ntok) { const bf16_t* rp = proj + (row0 + t) * NINP + h * 96 + 8 * ch; kw = *(const u32x4*)(rp + C_KC); vw = *(const u32x4*)(rp + C_VC); }
        const unsigned kk[4] = {kw.x, kw.y, kw.z, kw.w}, vv[4] = {vw.x, vw.y, vw.z, vw.w};
#pragma unroll
        for (int j = 0; j < 4; ++j) {
            const int k0 = 8 * ch + 2 * j;
            const float e0 = __expf(Bc[(ntok - 1) * 96 + k0] - Bc[t * 96 + k0]), e1 = __expf(Bc[(ntok - 1) * 96 + k0 + 1] - Bc[t * 96 + k0 + 1]);
            KT[k0 * 72 + t] = f2bf(bflo(kk[j]) * e0); KT[(k0 + 1) * 72 + t] = f2bf(bfhi(kk[j]) * e1);
            VT[k0 * 72 + t] = (unsigned short)(vv[j] & 0xffffu); VT[(k0 + 1) * 72 + t] = (unsigned short)(vv[j] >> 16);
        }
    }
    if (tid < 96) ((float*)(p.ws + WS_GDEC))[(size_t)gu * 96 + tid] = __expf(Bc[(ntok - 1) * 96 + tid]);
    __syncthreads();
    float* KV = (float*)(p.ws + WS_GKV) + (size_t)gu * (GK * GK);
    for (int tile = wv; tile < 36; tile += 8) {
        const int ki = tile / 6, vi = tile % 6; f32x4 acc = {0.f, 0.f, 0.f, 0.f};
#pragma unroll
        for (int ks = 0; ks < 2; ++ks) { const bf16x8 a = *(const LAS bf16x8*)(KT + (16 * ki + fr) * 72 + 32 * ks + 8 * fq), bb = *(const LAS bf16x8*)(VT + (16 * vi + fr) * 72 + 32 * ks + 8 * fq); acc = MFMA16(a, bb, acc); }
#pragma unroll
        for (int j = 0; j < 4; ++j) KV[(16 * ki + 4 * fq + j) * 96 + 16 * vi + fr] = acc[j];
    }
}
DI void gla_scan(const Ctx& p, int l) {
    const int gt = blockIdx.x * NTHR + pg8::tid_(), NT = gridDim.x * NTHR;
    const float* KV = (const float*)(p.ws + WS_GKV); const float* DEC = (const float*)(p.ws + WS_GDEC); float* SP = (float*)(p.ws + WS_GSP);
    for (int e = gt; e < 32 * GK * GK; e += NT) {
        const int bh = e / (GK * GK), kv = e % (GK * GK), k = kv / GK; float S = 0.f;
#pragma unroll 4
        for (int c = 0; c < 32; ++c) { const size_t gu = (size_t)bh * 32 + c; SP[gu * (GK * GK) + kv] = S; S = DEC[gu * 96 + k] * S + KV[gu * (GK * GK) + kv]; }
        p.out[O_GLAP + ((size_t)l * 32 + bh) * (GK * GK) + kv] = S;
    }
    for (int e = gt; e < 64 * GK * GK; e += NT) {
        const int bh = e / (GK * GK), kv = e % (GK * GK), k = kv / GK; const size_t gu = (size_t)NGU_P + bh;
        const float S0 = p.in[I_SGLA][((size_t)l * 64 + bh) * (GK * GK) + kv];
        p.out[O_GLAS + ((size_t)l * 64 + bh) * (GK * GK) + kv] = DEC[gu * 96 + k] * S0 + KV[gu * (GK * GK) + kv];
    }
}
DI void gla_stage3_unit(const Ctx& p, int l, int gu, LAS unsigned char* lds) {
    const bf16_t* proj = (const bf16_t*)(p.ws + WS_PROJ);
    size_t row0; int ntok, bh, h; gla_unit_rows(gu, row0, ntok, bh, h);
    LAS float* OT = (LAS float*)lds;
    LAS unsigned short* QP = (LAS unsigned short*)(lds + 36864);
    LAS unsigned short* KP = QP + 64 * 104;
    LAS unsigned short* VT = KP + 64 * 104;
    LAS unsigned short* ST = VT + 96 * 72;
    LAS unsigned short* ATT = ST + 96 * 104;
    const int tid = pg8::tid_(), lane = tid & 63, wv = tid >> 6, fr = lane & 15, fq = lane >> 4;
    const float* Sprev = gu < NGU_P ? (const float*)(p.ws + WS_GSP) + (size_t)gu * (GK * GK) : p.in[I_SGLA] + ((size_t)l * 64 + bh) * (GK * GK);
    const float* bb = (const float*)(p.ws + WS_BB) + (size_t)gu * (64 * GK);
    __syncthreads();
    for (int task = tid; task < 768; task += NTHR) {
        const int t = task & 63, ch = task >> 6; u32x4 qw = {0u, 0u, 0u, 0u}, kw = qw, vw = qw; f32x4 b0 = {0.f, 0.f, 0.f, 0.f}, b1 = b0;
        if (t < ntok) { const bf16_t* rp = proj + (row0 + t) * NINP + h * 96 + 8 * ch; qw = *(const u32x4*)(rp + C_QC); kw = *(const u32x4*)(rp + C_KC); vw = *(const u32x4*)(rp + C_VC);
            b0 = *(const f32x4*)(bb + t * 96 + 8 * ch); b1 = *(const f32x4*)(bb + t * 96 + 8 * ch + 4); }
        const unsigned qq[4] = {qw.x, qw.y, qw.z, qw.w}, kk[4] = {kw.x, kw.y, kw.z, kw.w}, vv[4] = {vw.x, vw.y, vw.z, vw.w};
        const float be[8] = {b0[0], b0[1], b0[2], b0[3], b1[0], b1[1], b1[2], b1[3]};
        u32x4 qo, ko; unsigned qa[4], ka[4];
#pragma unroll
        for (int j = 0; j < 4; ++j) {
            const float e0 = __expf(be[2 * j]), e1 = __expf(be[2 * j + 1]), r0 = __builtin_amdgcn_rcpf(e0), r1 = __builtin_amdgcn_rcpf(e1);
            const bool ok = t < ntok;
            qa[j] = ok ? pk2(bflo(qq[j]) * 0.10206207261596575f * e0, bfhi(qq[j]) * 0.10206207261596575f * e1) : 0u;
            ka[j] = ok ? pk2(bflo(kk[j]) * r0, bfhi(kk[j]) * r1) : 0u;
            VT[(8 * ch + 2 * j) * 72 + t] = (unsigned short)(vv[j] & 0xffffu); VT[(8 * ch + 2 * j + 1) * 72 + t] = (unsigned short)(vv[j] >> 16);
        }
        qo.x = qa[0]; qo.y = qa[1]; qo.z = qa[2]; qo.w = qa[3]; ko.x = ka[0]; ko.y = ka[1]; ko.z = ka[2]; ko.w = ka[3];
        *(LAS u32x4*)(QP + t * 104 + 8 * ch) = qo; *(LAS u32x4*)(KP + t * 104 + 8 * ch) = ko;
    }
    for (int task = tid; task < 2304; task += NTHR) {
        const int k = task % 96, vc = task / 96; const f32x4 sv = *(const f32x4*)(Sprev + k * 96 + 4 * vc);
#pragma unroll
        for (int j = 0; j < 4; ++j) ST[(4 * vc + j) * 104 + k] = f2bf(sv[j]);
    }
    __syncthreads();
    for (int tile = 2 * wv; tile < 2 * wv + 2; ++tile) {
        const int ti = tile >> 2, si = tile & 3; f32x4 acc = {0.f, 0.f, 0.f, 0.f};
        if (si <= ti) {
#pragma unroll
            for (int ks = 0; ks < 3; ++ks) { const bf16x8 a = *(const LAS bf16x8*)(QP + (16 * ti + fr) * 104 + 32 * ks + 8 * fq), b2 = *(const LAS bf16x8*)(KP + (16 * si + fr) * 104 + 32 * ks + 8 * fq); acc = MFMA16(a, b2, acc); }
        }
#pragma unroll
        for (int j = 0; j < 4; ++j) { const int t = 16 * ti + 4 * fq + j, s2 = 16 * si + fr; ATT[t * 72 + s2] = f2bf(s2 <= t ? acc[j] : 0.f); }
    }
    __syncthreads();
    for (int tile = wv; tile < 24; tile += 8) {
        const int ti = tile / 6, vi = tile % 6; f32x4 acc = {0.f, 0.f, 0.f, 0.f};
#pragma unroll
        for (int ks = 0; ks < 2; ++ks) { const bf16x8 a = *(const LAS bf16x8*)(ATT + (16 * ti + fr) * 72 + 32 * ks + 8 * fq), b2 = *(const LAS bf16x8*)(VT + (16 * vi + fr) * 72 + 32 * ks + 8 * fq); acc = MFMA16(a, b2, acc); }
#pragma unroll
        for (int ks = 0; ks < 3; ++ks) { const bf16x8 a = *(const LAS bf16x8*)(QP + (16 * ti + fr) * 104 + 32 * ks + 8 * fq), b2 = *(const LAS bf16x8*)(ST + (16 * vi + fr) * 104 + 32 * ks + 8 * fq); acc = MFMA16(a, b2, acc); }
#pragma unroll
        for (int j = 0; j < 4; ++j) OT[(16 * ti + 4 * fq + j) * 96 + 16 * vi + fr] = acc[j];
    }
    __syncthreads();
    bf16_t* oc = (bf16_t*)(p.ws + WS_OC);
    const float* gn = p.in[I_GLAN] + l * 384 + h * 96; const float gn0 = gn[lane], gn1 = lane < 32 ? gn[64 + lane] : 0.f;
    float g0[8], g1[8];
#pragma unroll
    for (int tt = 0; tt < 8; ++tt) { const int t = wv * 8 + tt; g0[tt] = 0.f; g1[tt] = 0.f;
        if (t < ntok) { const bf16_t* gp = proj + (row0 + t) * NINP + C_GC + h * 96; g0[tt] = bf2f(gp[lane]); if (lane < 32) g1[tt] = bf2f(gp[64 + lane]); } }
#pragma unroll
    for (int tt = 0; tt < 8; ++tt) {
        const int t = wv * 8 + tt;
        if (t < ntok) {
            const float a0 = OT[t * 96 + lane], a1 = lane < 32 ? OT[t * 96 + 64 + lane] : 0.f;
            const float rs = rsqrtf(wave_sum(a0 * a0 + a1 * a1) * (1.f / 96.f) + EPS);
            oc[(row0 + t) * 384 + h * 96 + lane] = f2bf(a0 * rs * gn0 * g0[tt] * sigmoidf_(g0[tt]));
            if (lane < 32) oc[(row0 + t) * 384 + h * 96 + 64 + lane] = f2bf(a1 * rs * gn1 * g1[tt] * sigmoidf_(g1[tt]));
        }
    }
}

DI void cross_sample_unit(const Ctx& p, int l, int b, int h, LAS unsigned char* lds) {
    LAS float* qs = (LAS float*)lds;
    LAS float* S = qs + 16 * 256;
    LAS float* PART = S + 16 * 260;
    const bf16_t* Q = (const bf16_t*)(p.ws + WS_Q);
    const int tid = pg8::tid_(), lane = tid & 63, wv = tid >> 6;
    const size_t srow = (size_t)MP + b * 16;
    for (int i = tid; i < 16 * 256; i += NTHR) qs[i] = bf2f(Q[(srow + (i >> 8)) * D + h * 256 + (i & 255)]) * 0.0625f;
    __syncthreads();
    const int m = tid & 255, half = tid >> 8;
    {
        float acc[16];
#pragma unroll
        for (int i = 0; i < 16; ++i) acc[i] = 0.f;
        const float* kp = p.in[I_CMK] + ((((size_t)l * DB + b) * 256 + m) * 4 + h) * 256 + 128 * half;
#pragma unroll 8
        for (int d4 = 0; d4 < 32; ++d4) {
            const f32x4 kv = *(const f32x4*)(kp + 4 * d4);
#pragma unroll
            for (int i = 0; i < 16; ++i) { const f32x4 q = *(const LAS f32x4*)(qs + i * 256 + 128 * half + 4 * d4); acc[i] += (q[0] * kv[0] + q[1] * kv[1]) + (q[2] * kv[2] + q[3] * kv[3]); }
        }
#pragma unroll
        for (int i = 0; i < 16; ++i) PART[(half * 16 + i) * 256 + m] = acc[i];
    }
    __syncthreads();
    for (int qq = 0; qq < 2; ++qq) {
        const int i = 2 * wv + qq; float v[4], mx = -3.0e38f;
#pragma unroll
        for (int j = 0; j < 4; ++j) { v[j] = PART[i * 256 + lane + 64 * j] + PART[(16 + i) * 256 + lane + 64 * j]; mx = fmaxf(mx, v[j]); }
        mx = wave_max(mx); float sum = 0.f;
#pragma unroll
        for (int j = 0; j < 4; ++j) { v[j] = __expf(v[j] - mx); sum += v[j]; }
        sum = wave_sum(sum); const float inv = 1.f / sum;
#pragma unroll
        for (int j = 0; j < 4; ++j) S[i * 260 + lane + 64 * j] = v[j] * inv;
    }
    __syncthreads();
    {
        float acc[16];
#pragma unroll
        for (int i = 0; i < 16; ++i) acc[i] = 0.f;
        const float* vp = p.in[I_CMV] + ((((size_t)l * DB + b) * 256 + 128 * half) * 4 + h) * 256 + m;
        for (int k0 = 0; k0 < 128; k0 += 8) {
            float v[8];
#pragma unroll
            for (int j = 0; j < 8; ++j) v[j] = vp[(size_t)(k0 + j) * 1024];
#pragma unroll
            for (int j = 0; j < 8; ++j)
#pragma unroll
                for (int i = 0; i < 16; ++i) acc[i] += S[i * 260 + 128 * half + k0 + j] * v[j];
        }
#pragma unroll
        for (int i = 0; i < 16; ++i) PART[(half * 16 + i) * 256 + m] = acc[i];
    }
    __syncthreads();
    bf16_t* O = (bf16_t*)(p.ws + WS_O);
    for (int i = tid; i < 16 * 256; i += NTHR) { const int qi = i >> 8, d = i & 255; O[(srow + qi) * D + h * 256 + d] = f2bf(PART[qi * 256 + d] + PART[(16 + qi) * 256 + d]); }
}

struct SkBf16 { bf16_t* O; int ldc; DI void operator()(int row, int col, f32x4 v) const { u32x2 w; w.x = pk2(v[0], v[1]); w.y = pk2(v[2], v[3]); *(u32x2*)(O + (size_t)(MP + row) * ldc + col) = w; } };
struct SkGate { bf16_t* merged; const bf16_t* proj; int goff; int accum;
    DI void operator()(int row, int col, f32x4 v) const {
        const u32x2 g = *(const u32x2*)(proj + (size_t)(MP + row) * NINP + goff + col); bf16_t* mp = merged + (size_t)(MP + row) * D + col;
        u32x2 pm2 = {0u, 0u}; if (accum) pm2 = *(const u32x2*)mp;
        u32x2 w; w.x = pk2(sigmoidf_(bflo(g.x)) * v[0] + bflo(pm2.x), sigmoidf_(bfhi(g.x)) * v[1] + bfhi(pm2.x)); w.y = pk2(sigmoidf_(bflo(g.y)) * v[2] + bflo(pm2.y), sigmoidf_(bfhi(g.y)) * v[3] + bfhi(pm2.y));
        *(u32x2*)mp = w; } };
template <class EF> DI void skinny_gemm(const bf16_t* A, int lda, const bf16_t* Bt, int ldb, int K, int N, int G, int bx, LAS unsigned char* lds, const EF& ef) {
    const int tid = pg8::tid_(), lane = tid & 63, wv = tid >> 6, fr = lane & 15, fq = lane >> 4, nks = K >> 5, nunits = 4 * (N >> 4);
    LAS f32x4* red = (LAS f32x4*)lds;
    for (int u = bx; u < nunits; u += G) {
        const int rb = u & 3, cb = u >> 2;
        f32x4 acc[4];
#pragma unroll
        for (int i = 0; i < 4; ++i) acc[i] = (f32x4){0.f, 0.f, 0.f, 0.f};
        const bf16_t* bp = Bt + (size_t)(16 * cb + fr) * ldb + 8 * fq; const bf16_t* ap = A + (size_t)(64 * rb + fr) * lda + 8 * fq;
        for (int ks = wv; ks < nks; ks += 8) {
            const bf16x8 bb = *(const bf16x8*)(bp + 32 * ks);
            bf16x8 aa[4];
#pragma unroll
            for (int i = 0; i < 4; ++i) aa[i] = *(const bf16x8*)(ap + (size_t)(16 * i) * lda + 32 * ks);
#pragma unroll
            for (int i = 0; i < 4; ++i) acc[i] = MFMA16(bb, aa[i], acc[i]);
        }
#pragma unroll
        for (int i = 0; i < 4; ++i) red[(wv * 4 + i) * 64 + lane] = acc[i];
        __syncthreads();
        if (tid < 256) {
            const int i = tid >> 6; f32x4 s = red[i * 64 + lane];
#pragma unroll
            for (int w = 1; w < 8; ++w) s = s + red[(w * 4 + i) * 64 + lane];
            ef(64 * rb + 16 * i + fr, 16 * cb + 4 * fq, s);
        }
        __syncthreads();
    }
}

constexpr int PH_PER_LAYER = 15, N_PHASES = 1 + DEPTH * PH_PER_LAYER;
#define RUN_GEMM(EpiT, E, Aptr, lda_, Bptr, ldb_, K_, pm0_, nM_, nN_) do { const pg8::Gemm g_{(K_), (lda_), (ldb_)}; pg8::TileOrder S_; S_.init((Aptr), (lda_), (Bptr), (ldb_), (pm0_), (nM_), (nN_), G, bx); \
        pg8::gemm_phase<EpiT, pg8::TileOrder, true, true>(lds, g_, S_, (E)); } while (0)

__global__ void __launch_bounds__(NTHR, 2) fwd_kernel(Params p) {
    extern __shared__ __attribute__((aligned(16))) unsigned char lds_raw[];
#define PROJ ((bf16_t*)(ws + WS_PROJ))
#define H ((bf16_t*)(ws + WS_H))
#define MERGED ((bf16_t*)(ws + WS_MERGED))
#define Y ((bf16_t*)(ws + WS_Y))
#define QB ((bf16_t*)(ws + WS_Q))
#define PB ((bf16_t*)(ws + WS_P))
#define OB ((bf16_t*)(ws + WS_O))
#define ACT ((bf16_t*)(ws + WS_ACT))

    {
        volatile LAS unsigned* st0 = (volatile LAS unsigned*)((LAS unsigned char*)lds_raw + LDS_MISC + 32);
        if (pg8::tid_() == 0) { st0[0] = 0u; st0[1] = 0u; st0[8] = 0u; st0[9] = 0u; }
        __syncthreads();
    }
    XcdBarrier xbar = xcd_barrier_post((unsigned*)(p.ws + WS_CTL) + CW_BAR, (volatile LAS unsigned*)((LAS unsigned char*)lds_raw + LDS_MISC + 32));
    if (p.ph_lo == 0) {
        prologue(p, (LAS unsigned char*)lds_raw);
        if (blockIdx.x == 0 && pg8::tid_() == 0) {
            const float** tab = (const float**)(p.ws + WS_TAB);
#pragma unroll
            for (int i = 0; i < N_IN; ++i) tab[i] = p.in[i];
        }
        if (p.ph_hi > 1) cg::this_grid().sync();
    }
    for (int ph = p.ph_lo > 1 ? p.ph_lo : 1; ph < p.ph_hi; ++ph) {
        unsigned ldsb = (unsigned)(size_t)(LAS unsigned char*)lds_raw; asm volatile("" : "+s"(ldsb));
        LAS unsigned char* lds = (LAS unsigned char*)(size_t)ldsb;
        volatile LAS int* slot = (volatile LAS int*)(lds + LDS_MISC);
        unsigned char* ws = p.ws; asm volatile("" : "+s"(ws));
        Ctx c; c.ws = ws; c.in.t = (const float* const*)(ws + WS_TAB); c.out = p.out;
        unsigned* ctl = (unsigned*)(ws + WS_CTL);
        int G = gridDim.x, bx = blockIdx.x; asm volatile("" : "+s"(G), "+s"(bx));
        {
            const int l = (ph - 1) / PH_PER_LAYER, st = (ph - 1) % PH_PER_LAYER;
#ifdef PROBE_SEL
            if (bx == 0) { volatile LAS unsigned long long* a_ = (volatile LAS unsigned long long*)(lds + LDS_MISC + 64); a_[1] = __builtin_amdgcn_s_memrealtime(); }
#endif
            switch (st) {
            case 0: {
                EpiBf16 E{PROJ, NINP, 0xffff};
                RUN_GEMM(EpiBf16, E, H, D, ws + WS_WIN + l * SZ_WIN, D, D, 0, MA / 256, NINP / 256);
                if (l == 0) {
                    const pg8::Gemm g{D, D, D}; MemKvOrder S{G, bx, (const char*)(ws + WS_MN), (const char*)(ws + WS_WKV)};
                    EpiBf16 E2{(bf16_t*)(ws + WS_MKV), 2048, 7};
                    pg8::gemm_phase<EpiBf16, MemKvOrder, true, true>(lds, g, S, E2);
                }
            } break;
            case 1: {
                unsigned* ctr = ctl + 64 * ph;
                constexpr int U_SBP = 384, U_SBS = U_SBP + DB * 6, U_GLA = U_SBS + NGU, U_POOL = U_GLA + MA / 64, U_KV = U_POOL + MA / 64, U_MO = U_KV + 512, U_VT = U_MO + 512;
                const int U_ALL = l == 0 ? U_VT : U_KV;
                for (;;) {
                    const int u = next_work(ctr, slot); if (u >= U_ALL) break;
#ifdef PROBE_SEL
                    const int ut_ = u < DB * 6 ? 10 : (u < U_SBS ? 11 : (u < U_GLA ? 12 : 13));
                    if (bx == 0 && ut_ == PROBE_SEL) { volatile LAS unsigned long long* a_ = (volatile LAS unsigned long long*)(lds + LDS_MISC + 64); a_[3] = __builtin_amdgcn_s_memrealtime(); }
#endif
                    if (u < DB * 6) sb_sample_unit(c, l, u / 6, u % 6, lds);
                    else if (u < U_SBS) { const int v = u - DB * 6, qb = 7 - v / 48, bh = v % 48; sb_prompt_unit(c, bh / 6, bh % 6, qb, lds); }
                    else if (u < U_GLA) gla_stage1_unit(c, l, u - U_SBS, lds);
                    else if (u < U_POOL) pool_unit(c, l, u - U_GLA);
                    else if (u < U_KV) kvout_unit(c, l, u - U_POOL);
                    else if (u < U_MO) memout_unit(c, u - U_KV);
                    else memvt_unit(c, u - U_MO);
#ifdef PROBE_SEL
                    if (bx == 0 && ut_ == PROBE_SEL) { volatile LAS unsigned long long* a_ = (volatile LAS unsigned long long*)(lds + LDS_MISC + 64); __hip_atomic_fetch_add((LAS unsigned long long*)a_, __builtin_amdgcn_s_memrealtime() - a_[3], __ATOMIC_RELAXED, __HIP_MEMORY_SCOPE_WORKGROUP); }
#endif
                }
            } break;
            case 2: gla_scan(c, l); break;
            case 3: {
                unsigned* ctr = ctl + 64 * ph;
                for (;;) { const int u = next_work(ctr, slot); if (u >= NGU) break; gla_stage3_unit(c, l, u, lds); }
            } break;
            case 4: {
                EpiGate E1{MERGED, PROJ, C_GA, 0}, E2{MERGED, PROJ, C_GB, 1}, E3{MERGED, PROJ, C_GCG, 1};
                RUN_GEMM(EpiGate, E1, ws + WS_OA, 384, ws + WS_WBA + l * SZ_WBA, 384, 384, 0, MP / 256, 4);
                RUN_GEMM(EpiGate, E2, ws + WS_POOLED, 256, ws + WS_WBB + l * SZ_WBB, 256, 256, 0, MP / 256, 4);
                RUN_GEMM(EpiGate, E3, ws + WS_OC, 384, ws + WS_WBC + l * SZ_WBA, 384, 384, 0, MP / 256, 4);
                { SkGate F1{MERGED, PROJ, C_GA, 0}, F2{MERGED, PROJ, C_GB, 1}, F3{MERGED, PROJ, C_GCG, 1};
                  skinny_gemm((const bf16_t*)(ws + WS_OA) + (size_t)MP * 384, 384, (const bf16_t*)(ws + WS_WBA + l * SZ_WBA), 384, 384, D, G, bx, lds, F1);
                  skinny_gemm((const bf16_t*)(ws + WS_POOLED) + (size_t)MP * 256, 256, (const bf16_t*)(ws + WS_WBB + l * SZ_WBB), 256, 256, D, G, bx, lds, F2);
                  skinny_gemm((const bf16_t*)(ws + WS_OC) + (size_t)MP * 384, 384, (const bf16_t*)(ws + WS_WBC + l * SZ_WBA), 384, 384, D, G, bx, lds, F3); }
            } break;
            case 5: { EpiBf16 E{Y, D, 0xffff}; RUN_GEMM(EpiBf16, E, MERGED, D, ws + WS_WMIX + l * SZ_WSQ, D, D, 0, MP / 256, 4);
                SkBf16 F{Y, D}; skinny_gemm((const bf16_t*)MERGED + (size_t)MP * D, D, (const bf16_t*)(ws + WS_WMIX + l * SZ_WSQ), D, D, D, G, bx, lds, F); } break;
            case 6: norm_phase(c, c.in[I_NMIXPOST] + l * D, c.in[I_NXPRE] + l * D, G, bx); break;
            case 7: { EpiBf16 E{QB, D, 0xffff}; RUN_GEMM(EpiBf16, E, H, D, ws + WS_WXQ + l * SZ_WSQ, D, D, 0, MP / 256, 4);
                SkBf16 F{QB, D}; skinny_gemm((const bf16_t*)H + (size_t)MP * D, D, (const bf16_t*)(ws + WS_WXQ + l * SZ_WSQ), D, D, D, G, bx, lds, F); } break;
            case 8: {
                const pg8::Gemm g{256, D, 2048}; CrossOrder S{G, bx, (const char*)QB, (const char*)(ws + WS_MKV + (size_t)l * 2 * SZ_WKV), 0};
                EpiSoftmax E{PB, (LAS float*)(lds + LDS_X)};
                pg8::gemm_phase<EpiSoftmax, CrossOrder, true, true>(lds, g, S, E);
            } break;
            case 9: {
                const pg8::Gemm g{256, D, 2048}; CrossOrder S{G, bx, (const char*)PB, (const char*)(ws + WS_MEMVT + (size_t)l * SZ_WKV), 1};
                EpiBf16 E{OB, D, 0xffff};
                pg8::gemm_phase<EpiBf16, CrossOrder, true, true>(lds, g, S, E);
                for (int u = bx; u < DB * 4; u += G) { __syncthreads(); cross_sample_unit(c, l, u >> 2, u & 3, lds); }
            } break;
            case 10: { EpiBf16 E{Y, D, 0xffff}; RUN_GEMM(EpiBf16, E, OB, D, ws + WS_WXO + l * SZ_WSQ, D, D, 0, MP / 256, 4);
                SkBf16 F{Y, D}; skinny_gemm((const bf16_t*)OB + (size_t)MP * D, D, (const bf16_t*)(ws + WS_WXO + l * SZ_WSQ), D, D, D, G, bx, lds, F); } break;
            case 11: norm_phase(c, c.in[I_NXPOST] + l * D, c.in[I_NFPRE] + l * D, G, bx); break;
            case 12: { EpiSwiglu E{ACT}; RUN_GEMM(EpiSwiglu, E, H, D, ws + WS_WF1 + l * SZ_WF1, D, D, 0, MA / 256, FF2 / 256); } break;
            case 13: { EpiBf16 E{Y, D, 0xffff}; RUN_GEMM(EpiBf16, E, ACT, FF, ws + WS_WF2 + l * SZ_WF2, FF, FF, 0, MP / 256, 4);
                SkBf16 F{Y, D}; skinny_gemm((const bf16_t*)ACT + (size_t)MP * FF, FF, (const bf16_t*)(ws + WS_WF2 + l * SZ_WF2), FF, FF, D, G, bx, lds, F); } break;
            default: norm_phase(c, c.in[I_NFPOST] + l * D, l < DEPTH - 1 ? c.in[I_NMIXPRE] + (l + 1) * D : nullptr, G, bx); break;
            }
#ifdef PROBE_SEL
            {
                const int sel = PROBE_SEL; bool hit = false;
                if (sel == 2) hit = (st == 0 || st == 4 || st == 5 || st == 7 || st == 10 || st == 12 || st == 13);
                if (sel == 3) hit = (st == 2 || st == 3);
                if (sel == 4) hit = (st == 8 || st == 9);
                if (sel == 5) hit = (st == 6 || st == 11 || st == 14);
                if (sel == 6) hit = (st == 1);
                if (sel == 7) hit = (st == 0);
                if (sel == 8) hit = (st == 12);
                if (sel == 9) hit = (st == 13);
                if (bx == 0 && hit) { volatile LAS unsigned long long* a_ = (volatile LAS unsigned long long*)(lds + LDS_MISC + 64); __hip_atomic_fetch_add((LAS unsigned long long*)a_, __builtin_amdgcn_s_memrealtime() - a_[1], __ATOMIC_RELAXED, __HIP_MEMORY_SCOPE_WORKGROUP); }
            }
#endif
        }
#ifdef PROBE_SEL
        if (bx == 0) { volatile LAS unsigned long long* a_ = (volatile LAS unsigned long long*)(lds + LDS_MISC + 64); a_[2] = __builtin_amdgcn_s_memrealtime(); }
#endif
        if (ph + 1 < p.ph_hi) { if ((ph - 1) % PH_PER_LAYER == 8) { __threadfence(); __syncthreads(); } else xcd_barrier(xbar); }
#ifdef PROBE_SEL
        if (PROBE_SEL == 1 && bx == 0) { volatile LAS unsigned long long* a_ = (volatile LAS unsigned long long*)(lds + LDS_MISC + 64); __hip_atomic_fetch_add((LAS unsigned long long*)a_, __builtin_amdgcn_s_memrealtime() - a_[2], __ATOMIC_RELAXED, __HIP_MEMORY_SCOPE_WORKGROUP); }
#endif
    }
#ifdef PROBE_SEL
    __syncthreads();
    if (blockIdx.x == 0) {
        volatile LAS unsigned long long* a_ = (volatile LAS unsigned long long*)((LAS unsigned char*)lds_raw + LDS_MISC + 64);
        const unsigned long long d_ = a_[0] >> 9, s_ = __builtin_amdgcn_s_memrealtime();
        while (__builtin_amdgcn_s_memrealtime() - s_ < d_) __builtin_amdgcn_s_sleep(8);
    }
#endif
}

extern "C" void kernel_launch(void* const* d_in, const int* in_sizes, int n_in, void* d_out, int out_size, void* d_ws, size_t ws_size, hipStream_t stream) {
    static int grid = 0;
    if (grid == 0) {
        if (n_in != N_IN || (size_t)out_size != O_END || ws_size < WS_END) { fprintf(stderr, "kernel_launch: unexpected shapes: n_in %d out %d ws %zu (need %zu)\n", n_in, out_size, ws_size, (size_t)WS_END); grid = -1; return; }
        int dev = 0, cus = 0, per_cu = 0;
        (void)hipGetDevice(&dev); (void)hipDeviceGetAttribute(&cus, hipDeviceAttributeMultiprocessorCount, dev);
        (void)hipFuncSetAttribute((const void*)fwd_kernel, hipFuncAttributeMaxDynamicSharedMemorySize, LDS_BYTES);
        if (hipOccupancyMaxActiveBlocksPerMultiprocessor(&per_cu, (const void*)fwd_kernel, NTHR, LDS_BYTES) != hipSuccess || per_cu < 1) { fprintf(stderr, "kernel_launch: occupancy query gave %d\n", per_cu); per_cu = 1; }
        (void)hipGetLastError();
        grid = cus * per_cu;
    }
    if (grid < 0) return;
    (void)hipMemsetAsync((char*)d_ws + WS_CTL, 0, CTL_BYTES, stream);
    Params p{};
    for (int i = 0; i < N_IN; ++i) p.in[i] = (const float*)d_in[i];
    p.out = (float*)d_out; p.ws = (unsigned char*)d_ws;
#ifdef MULTI_LAUNCH
    for (int ph = 0; ph < N_PHASES; ++ph) { p.ph_lo = ph; p.ph_hi = ph + 1; hipLaunchKernelGGL(fwd_kernel, dim3(grid), dim3(NTHR), LDS_BYTES, stream, p); }
#else
    p.ph_lo = 0; p.ph_hi = N_PHASES;
    void* args[] = {&p};
    const hipError_t e = hipLaunchCooperativeKernel((const void*)fwd_kernel, dim3(grid), dim3(NTHR), args, LDS_BYTES, stream);
    if (e != hipSuccess) fprintf(stderr, "kernel_launch: cooperative launch failed: %s (grid %d)\n", hipGetErrorString(e), grid);
#endif
}
```

```cpp
#include <hip/hip_runtime.h>
#include <hip/hip_cooperative_groups.h>
#include <cstdio>
#include <cstdint>
namespace cg = cooperative_groups;

namespace pg8 {
#define PG8_LAS __attribute__((address_space(3)))
typedef unsigned short bf16_t;
typedef short bf16x8 __attribute__((ext_vector_type(8)));
typedef float f32x4 __attribute__((ext_vector_type(4)));
typedef unsigned u32x4 __attribute__((ext_vector_type(4)));
typedef unsigned u32x2 __attribute__((ext_vector_type(2)));
constexpr int BM = 256, BK = 64, HALF = 128, HTB = HALF * BK * 2  , STAGE_BYTES = 8 * HTB, NXCD = 8, WGM = 8;

__host__ __device__ __forceinline__ int lds_byte(int r, int c) { const int st = (r >> 4) * 2 + (c >> 5), rr = r & 15, cc = c & 31, ob = rr * 64 + cc * 2; return st * 1024 + (ob ^ (((ob >> 9) & 1) << 5)); }
__host__ __device__ __forceinline__ void stage_rc(int b, int& R, int& C) { const int st = b / 1024, sb = b % 1024, swz = sb ^ (((sb >> 9) & 1) << 5); R = (st >> 1) * 16 + swz / 64; C = (st & 1) * 32 + (swz % 64) / 2; }
__host__ __device__ __forceinline__ int perm32(int rho) { const int n = rho >> 4, i = rho & 15; return 8 * (i >> 2) + 4 * n + (i & 3); }

struct Unit { int pm, pn; const char* a; const char* b; };
struct Gemm { int K, lda, ldb; };

struct TileOrder {
    int nM, nN, G, c, lda, ldb; const char* A; const char* B;
    __device__ void init(const void* A_, int lda_, const void* B_, int ldb_, int, int nM_, int nN_, int G_, int c_) {
        A = (const char*)A_; B = (const char*)B_; lda = lda_; ldb = ldb_; nM = nM_; nN = nN_; G = G_; c = c_; }
    __device__ bool next(int i, Unit& u) const {
        const int nwg = nM * nN; const long L = (long)i * G + c; if (L >= nwg) return false;
        int wgid = (int)L; { const int q = nwg / NXCD, r = nwg % NXCD, xcd = wgid % NXCD, off = wgid / NXCD; wgid = (xcd < r ? xcd * (q + 1) : r * (q + 1) + (xcd - r) * q) + off; }
        const int nig = WGM * nN, gid = wgid / nig, fm = gid * WGM, gsz = (nM - fm) < WGM ? (nM - fm) : WGM;
        u.pm = fm + ((wgid % nig) % gsz); u.pn = (wgid % nig) / gsz; u.a = A + (size_t)u.pm * ((size_t)BM * 2 * lda); u.b = B + (size_t)u.pn * ((size_t)BM * 2 * ldb); return true;
    }
    __device__ __forceinline__ void a_ready(const Unit&) const {}
    __device__ __forceinline__ void done(const Unit&) const {}
};

__device__ __forceinline__ int tid_() { int t = threadIdx.x; asm volatile("" : "+v"(t)); return t; }
__device__ __forceinline__ unsigned cvt_pk_bf16(float lo, float hi) { unsigned r; asm volatile("v_cvt_pk_bf16_f32 %0, %1, %2" : "=v"(r) : "v"(lo), "v"(hi)); return r; }

template <class Epi, class Sched, bool ALIGN_EPI = false, bool SP2 = false>
__device__ __forceinline__ void gemm_phase(PG8_LAS unsigned char* lds, const Gemm g, const Sched& S, const Epi& E) {
    const int tid = pg8::tid_(), wid = __builtin_amdgcn_readfirstlane(tid >> 6), lane = tid & 63, wr = wid >> 2, wc = wid & 3, fr = lane & 15, fq = lane >> 4;
    const int K = g.K, nt = K / BK;
    unsigned voffA, voffB;
    { int R, C; stage_rc(tid * 16, R, C); const int Rb = Epi::PERM ? ((R & ~31) + perm32(R & 31)) : R;
        voffA = (unsigned)(R * g.lda + C) * 2u; voffB = (unsigned)(Rb * g.ldb + C) * 2u; }
    const size_t qstepA = (size_t)64 * g.lda * 2, qstepB = (size_t)64 * g.ldb * 2;
    const size_t kstep = (size_t)(BK * 2);
    const size_t hstepA = (size_t)HALF * g.lda * 2, hstepB = (size_t)HALF * g.ldb * 2;
    const unsigned ldsw = (unsigned)wid * 1024u;
    const int aoff = lds_byte(wr * 64 + fr, fq * 8), boff = lds_byte(wc * 32 + fr, fq * 8);
#define PG8_SA(b, h) (((b) * 2 + (h)) * HTB)
#define PG8_SB(b, h) ((4 + (b) * 2 + (h)) * HTB)
#define PG8_STAGE(bufoff, gbase, voff) do { _Pragma("unroll") for (int _i = 0; _i < 2; ++_i) { const char* sb_ = (const char*)(gbase) + (size_t)_i * q##voff; asm volatile("" : "+s"(sb_));   \
        __builtin_amdgcn_global_load_lds((const unsigned*)(sb_ + (voff)), (PG8_LAS unsigned*)(lds + (bufoff) + ldsw + _i * 8192), 16, 0, 0); } } while (0)
#define qvoffA qstepA
#define qvoffB qstepB
#define PG8_LDA(dst, b, h) do { _Pragma("unroll") for (int m = 0; m < 4; ++m) _Pragma("unroll") for (int k = 0; k < 2; ++k) dst[m][k] = *(const PG8_LAS bf16x8*)(lds + PG8_SA(b, h) + aoff + m * 2048 + k * 1024); } while (0)
#define PG8_LDB(dst, b, h) do { _Pragma("unroll") for (int n = 0; n < 2; ++n) _Pragma("unroll") for (int k = 0; k < 2; ++k) dst[n][k] = *(const PG8_LAS bf16x8*)(lds + PG8_SB(b, h) + boff + n * 2048 + k * 1024); } while (0)
#define PG8_MMA(ai, bj, At, Bt) do { __builtin_amdgcn_s_setprio(1); _Pragma("unroll") for (int m = 0; m < 4; ++m) _Pragma("unroll") for (int n = 0; n < 2; ++n) _Pragma("unroll") for (int k = 0; k < 2; ++k) \
        acc[ai][bj][m][n] = __builtin_amdgcn_mfma_f32_16x16x32_bf16(Bt[n][k], At[m][k], acc[ai][bj][m][n], 0, 0, 0); __builtin_amdgcn_s_setprio(0); } while (0)
#define PG8_WAIT_V(n) asm volatile("s_waitcnt vmcnt(" #n ")" ::: "memory")
#define PG8_WAIT_L(n) asm volatile("s_waitcnt lgkmcnt(" #n ")" ::: "memory")
#define PG8_BAR __builtin_amdgcn_s_barrier()
#define PG8_SCHED __builtin_amdgcn_sched_barrier(0)
    Unit cur, nxt; int ui = 0;
    if (!S.next(0, cur)) return;
    f32x4 acc[2][2][4][2];
#pragma unroll
    for (int a = 0; a < 2; ++a)
#pragma unroll
        for (int b = 0; b < 2; ++b)
#pragma unroll
            for (int m = 0; m < 4; ++m)
#pragma unroll
                for (int n = 0; n < 2; ++n) acc[a][b][m][n] = (f32x4){0.f, 0.f, 0.f, 0.f};
    bf16x8 At[4][2], B0[2][2], B1[2][2];
    const char* cA = cur.a; const char* cB = cur.b;
    S.a_ready(cur);
    if constexpr (SP2) {
        PG8_STAGE(PG8_SB(0, 0), cB, voffB); PG8_STAGE(PG8_SB(0, 1), cB + hstepB, voffB); PG8_STAGE(PG8_SA(0, 0), cA, voffA); PG8_STAGE(PG8_SA(0, 1), cA + hstepA, voffA);
        if (wr == 1) PG8_BAR;
        PG8_WAIT_V(2); PG8_BAR;
        PG8_STAGE(PG8_SB(1, 0), cB + kstep, voffB); PG8_STAGE(PG8_SA(1, 0), cA + kstep, voffA); PG8_STAGE(PG8_SB(1, 1), cB + hstepB + kstep, voffB);
        PG8_WAIT_V(6); PG8_BAR;
    } else {
        PG8_STAGE(PG8_SB(0, 0), cB, voffB); PG8_STAGE(PG8_SA(0, 0), cA, voffA); PG8_STAGE(PG8_SB(0, 1), cB + hstepB, voffB); PG8_STAGE(PG8_SA(0, 1), cA + hstepA, voffA);
        if (wr == 1) PG8_BAR;
        PG8_WAIT_V(4); PG8_BAR;
        PG8_STAGE(PG8_SB(1, 0), cB + kstep, voffB); PG8_STAGE(PG8_SA(1, 0), cA + kstep, voffA); PG8_STAGE(PG8_SB(1, 1), cB + hstepB + kstep, voffB);
        PG8_WAIT_V(6); PG8_BAR;
    }
    for (;;) {
        const bool has_next = S.next(ui + 1, nxt);
        const char* nA = has_next ? nxt.a : cA; const char* nB = has_next ? nxt.b : cB;
        for (int t = 0; t < nt; t += 2) {
            const bool last = (t == nt - 2);
            const char* a1 = cA + (size_t)(t + 1) * kstep;
            const char* a2 = last ? nA : cA + (size_t)(t + 2) * kstep; const char* b2 = last ? nB : cB + (size_t)(t + 2) * kstep;
            const char* a3 = a2 + kstep; const char* b3 = b2 + kstep;
            if (last && has_next) S.a_ready(nxt);
            if constexpr (SP2) {
            PG8_LDB(B0, 0, 0); PG8_LDB(B1, 0, 1); PG8_SCHED; PG8_LDA(At, 0, 0); PG8_STAGE(PG8_SA(1, 1), a1 + hstepA, voffA);
            PG8_WAIT_V(8); PG8_WAIT_L(0); PG8_BAR; PG8_MMA(0, 0, At, B0); PG8_MMA(0, 1, At, B1); PG8_BAR; PG8_SCHED;
            PG8_LDA(At, 0, 1); PG8_STAGE(PG8_SB(0, 0), b2, voffB); PG8_STAGE(PG8_SB(0, 1), b2 + hstepB, voffB); PG8_STAGE(PG8_SA(0, 0), a2, voffA);
            PG8_WAIT_V(8); PG8_WAIT_L(0); PG8_BAR; PG8_MMA(1, 0, At, B0); PG8_MMA(1, 1, At, B1); PG8_BAR; PG8_SCHED;
            PG8_LDB(B0, 1, 0); PG8_LDB(B1, 1, 1); PG8_SCHED; PG8_LDA(At, 1, 0); PG8_STAGE(PG8_SA(0, 1), a2 + hstepA, voffA);
            PG8_WAIT_V(8); PG8_WAIT_L(0); PG8_BAR; PG8_MMA(0, 0, At, B0); PG8_MMA(0, 1, At, B1); PG8_BAR; PG8_SCHED;
            PG8_LDA(At, 1, 1); PG8_STAGE(PG8_SB(1, 0), b3, voffB); PG8_STAGE(PG8_SB(1, 1), b3 + hstepB, voffB); PG8_STAGE(PG8_SA(1, 0), a3, voffA);
            PG8_WAIT_V(8); PG8_WAIT_L(0); PG8_BAR; PG8_MMA(1, 0, At, B0); PG8_MMA(1, 1, At, B1); PG8_BAR; PG8_SCHED;
            } else {
            PG8_LDB(B0, 0, 0); PG8_SCHED; PG8_LDA(At, 0, 0); PG8_STAGE(PG8_SA(1, 1), a1 + hstepA, voffA);
            PG8_WAIT_L(8); PG8_BAR; PG8_WAIT_L(0); PG8_MMA(0, 0, At, B0); PG8_BAR; PG8_SCHED;
            PG8_LDB(B1, 0, 1); PG8_STAGE(PG8_SB(0, 0), b2, voffB);
            PG8_BAR; PG8_WAIT_L(0); PG8_MMA(0, 1, At, B1); PG8_BAR;
            PG8_LDA(At, 0, 1); PG8_STAGE(PG8_SA(0, 0), a2, voffA);
            PG8_BAR; PG8_WAIT_L(0); PG8_MMA(1, 0, At, B0); PG8_BAR; PG8_SCHED;
            PG8_STAGE(PG8_SB(0, 1), b2 + hstepB, voffB);
            PG8_WAIT_V(6); PG8_BAR; PG8_MMA(1, 1, At, B1); PG8_BAR;
            PG8_LDB(B0, 1, 0); PG8_SCHED; PG8_LDA(At, 1, 0); PG8_STAGE(PG8_SA(0, 1), a2 + hstepA, voffA);
            PG8_WAIT_L(8); PG8_BAR; PG8_WAIT_L(0); PG8_MMA(0, 0, At, B0); PG8_BAR; PG8_SCHED;
            PG8_LDB(B1, 1, 1); PG8_STAGE(PG8_SB(1, 0), b3, voffB);
            PG8_BAR; PG8_WAIT_L(0); PG8_MMA(0, 1, At, B1); PG8_BAR;
            PG8_LDA(At, 1, 1); PG8_STAGE(PG8_SA(1, 0), a3, voffA);
            PG8_BAR; PG8_WAIT_L(0); PG8_MMA(1, 0, At, B0); PG8_BAR; PG8_SCHED;
            PG8_STAGE(PG8_SB(1, 1), b3 + hstepB, voffB);
            PG8_WAIT_V(6); PG8_BAR; PG8_MMA(1, 1, At, B1); PG8_BAR;
            }
        }
        if constexpr (ALIGN_EPI) { if (wr == 0) PG8_BAR; }
        if constexpr (!Epi::AFTER_DRAIN) { const int l2_ = tid_() & 63, fr2 = l2_ & 15, fq2 = l2_ >> 4;   E(acc, cur, wr, wc, fr2, fq2); S.done(cur); }
        if (!has_next) break;
#pragma unroll
        for (int a = 0; a < 2; ++a)
#pragma unroll
            for (int b = 0; b < 2; ++b)
#pragma unroll
                for (int m = 0; m < 4; ++m)
#pragma unroll
                    for (int n = 0; n < 2; ++n) acc[a][b][m][n] = (f32x4){0.f, 0.f, 0.f, 0.f};
        cur = nxt; cA = nA; cB = nB; ++ui;
        if constexpr (ALIGN_EPI) { if (wr == 1) PG8_BAR; }
    }
    PG8_WAIT_V(0);
    if constexpr (!ALIGN_EPI) { if (wr == 0) PG8_BAR; }
    PG8_BAR;
    if constexpr (Epi::AFTER_DRAIN) { E.fused(acc, cur, wr, wc, fr, fq, lds, wid, lane); S.done(cur); }
#undef PG8_SA
#undef PG8_SB
#undef PG8_STAGE
#undef qvoffA
#undef qvoffB
#undef PG8_LDA
#undef PG8_LDB
#undef PG8_MMA
#undef PG8_WAIT_V
#undef PG8_WAIT_L
#undef PG8_BAR
#undef PG8_SCHED
}
}

using pg8::bf16_t; using pg8::f32x4; using pg8::bf16x8; using pg8::u32x4; using pg8::u32x2;
#define DI __device__ __forceinline__
#define LAS __attribute__((address_space(3)))
typedef float f32x16 __attribute__((ext_vector_type(16)));
typedef short s16x4 __attribute__((ext_vector_type(4)));
typedef float f32x2_t __attribute__((ext_vector_type(2))); typedef __bf16 bf16x2_t __attribute__((ext_vector_type(2)));

constexpr int NTHR = 512, NWAVES = 8;
constexpr int D = 1024, NB = 8, SEQ = 2048, DEPTH = 4, DB = 16, DT = 16, PAST = 1024;
constexpr int MP = NB * SEQ, MS = DB * DT, MA = MP + MS;
constexpr int NIN = 6032, NINP = 6144;
constexpr int C_QA = 0, C_KA = 384, C_VA = 768, C_U = 1152, C_QC = 1408, C_KC = 1792, C_VC = 2176, C_GC = 2560, C_LR = 2944, C_GA = 2960, C_GB = 3984, C_GCG = 5008;
constexpr int FF = 2816, FF2 = 5632;
constexpr int GH = 4, GK = 96;
constexpr int NGU_P = NB * GH * 32, NGU_S = DB * GH, NGU = NGU_P + NGU_S;
constexpr float EPS = 1e-6f;

constexpr size_t O_YP = 0, O_YS = O_YP + (size_t)MP * D, O_KP = O_YS + (size_t)MS * D, O_VP = O_KP + (size_t)DEPTH * MP * 384, O_POOLP = O_VP + (size_t)DEPTH * MP * 384,
    O_GLAP = O_POOLP + (size_t)DEPTH * NB * 15 * 256, O_MKP = O_GLAP + (size_t)DEPTH * NB * GH * GK * GK, O_MVP = O_MKP + (size_t)DEPTH * NB * 256 * D,
    O_KS = O_MVP + (size_t)DEPTH * NB * 256 * D, O_VS = O_KS + (size_t)DEPTH * MS * 384, O_POOLS = O_VS + (size_t)DEPTH * MS * 384, O_GLAS = O_POOLS + (size_t)DEPTH * DB * 15 * 256,
    O_END = O_GLAS + (size_t)DEPTH * DB * GH * GK * GK;

enum { I_XP = 0, I_XS, I_MEM, I_CSK, I_CSV, I_SPOOL, I_SGLA, I_CMK, I_CMV, I_WIN, I_WA2, I_BA, I_GLAN, I_WPOOL, I_PSCALE, I_WBA, I_WBB, I_WBC, I_WMIX, I_MEMN, I_WXQ, I_WXK, I_WXV, I_WXO,
       I_WF1, I_WF2, I_NMIXPRE, I_NMIXPOST, I_NXPRE, I_NXPOST, I_NFPRE, I_NFPOST, N_IN };

constexpr size_t MiB = 1u << 20;
constexpr size_t SZ_WIN = (size_t)NINP * D * 2, SZ_WBA = (size_t)D * 384 * 2, SZ_WBB = (size_t)D * 256 * 2, SZ_WSQ = (size_t)D * D * 2, SZ_WKV = 2 * SZ_WSQ, SZ_WF1 = (size_t)FF2 * D * 2, SZ_WF2 = (size_t)D * FF * 2;
constexpr size_t WS_CTL = 0, CTL_BYTES = 1 * MiB, WS_TAB = CTL_BYTES - 4096;
constexpr size_t WS_WIN = WS_CTL + CTL_BYTES, WS_WBA = WS_WIN + 4 * SZ_WIN, WS_WBB = WS_WBA + 4 * SZ_WBA, WS_WBC = WS_WBB + 4 * SZ_WBB, WS_WMIX = WS_WBC + 4 * SZ_WBA,
    WS_WXQ = WS_WMIX + 4 * SZ_WSQ, WS_WXO = WS_WXQ + 4 * SZ_WSQ, WS_WKV = WS_WXO + 4 * SZ_WSQ, WS_WF1 = WS_WKV + 4 * SZ_WKV, WS_WF2 = WS_WF1 + 4 * SZ_WF1,
    WS_MN = WS_WF2 + 4 * SZ_WF2, WS_MKV = WS_MN + 4 * SZ_WKV, WS_MEMVT = WS_MKV + 8 * SZ_WKV, WS_PROJ = WS_MEMVT + 4 * SZ_WKV;
constexpr size_t SZ_ROWS = (size_t)MA * D * 2;
constexpr size_t SZ_PROJ = (size_t)MA * NINP * 2;
constexpr size_t WS_Q = WS_PROJ, WS_P = WS_Q + SZ_ROWS, WS_O = WS_P + SZ_ROWS, WS_ACT = WS_O + SZ_ROWS;
static_assert(WS_ACT + (size_t)MA * FF * 2 <= WS_PROJ + SZ_PROJ, "overlay fits");
constexpr size_t WS_H = WS_PROJ + SZ_PROJ, WS_MERGED = WS_H + SZ_ROWS, WS_Y = WS_MERGED + SZ_ROWS;
constexpr size_t WS_GKV = WS_H, WS_GSP = WS_GKV + 39 * MiB, WS_GDEC = WS_GSP + 37 * MiB;
static_assert((size_t)NGU * GK * GK * 4 <= 39 * MiB && (size_t)NGU_P * GK * GK * 4 <= 37 * MiB && WS_GDEC + (size_t)NGU * GK * 4 <= WS_Y + SZ_ROWS, "GLA overlay fits");
constexpr size_t WS_OA = WS_Y + SZ_ROWS, WS_POOLED = WS_OA + (size_t)MA * 384 * 2, WS_OC = WS_POOLED + (size_t)MA * 256 * 2, WS_BB = WS_OC + (size_t)MA * 384 * 2, WS_XB = WS_BB + (size_t)NGU * 64 * GK * 4, WS_END = WS_XB + SZ_ROWS;
static_assert(WS_WIN % 256 == 0 && WS_PROJ % 256 == 0 && WS_H % 256 == 0 && WS_OA % 256 == 0 && WS_POOLED % 256 == 0 && WS_OC % 256 == 0 && WS_P % 256 == 0, "alignment");

constexpr int CW_BAR = 16384;
constexpr int LDS_GEMM = 131072, LDS_X = LDS_GEMM, LDS_X_BYTES = 12288, LDS_MISC = LDS_X + LDS_X_BYTES, LDS_BYTES = LDS_MISC + 256;

struct Params { const float* in[N_IN]; float* out; unsigned char* ws; int ph_lo, ph_hi; };
struct InTab { const float* const* t;
    __device__ __forceinline__ const float* operator[](int i) const { const unsigned long long v = (unsigned long long)t[i];
        const unsigned lo = __builtin_amdgcn_readfirstlane((unsigned)v), hi = __builtin_amdgcn_readfirstlane((unsigned)(v >> 32)); return (const float*)(((unsigned long long)hi << 32) | lo); } };
struct Ctx { InTab in; float* out; unsigned char* ws; };

DI float bflo(unsigned w) { return __uint_as_float(w << 16); }
DI float bfhi(unsigned w) { return __uint_as_float(w & 0xffff0000u); }
DI float bf2f(unsigned short v) { return __uint_as_float((unsigned)v << 16); }
DI unsigned pk2(float lo, float hi) { f32x2_t v = {lo, hi}; bf16x2_t b = __builtin_convertvector(v, bf16x2_t); return __builtin_bit_cast(unsigned, b); }
DI unsigned short f2bf(float f) { return (unsigned short)(pk2(f, 0.f) & 0xffffu); }
DI float wave_sum(float v) {
#pragma unroll
    for (int o = 1; o < 64; o <<= 1) v += __shfl_xor(v, o);
    return v;
}
DI float wave_max(float v) {
#pragma unroll
    for (int o = 1; o < 64; o <<= 1) v = fmaxf(v, __shfl_xor(v, o));
    return v;
}
DI float sigmoidf_(float x) { return __builtin_amdgcn_rcpf(1.f + __expf(-x)); }
DI float softplusf_(float z) { return fmaxf(z, 0.f) + __logf(1.f + __expf(-fabsf(z))); }
DI int next_work(unsigned* ctr, volatile LAS int* slot) {
    __syncthreads();
    if (pg8::tid_() == 0) *slot = (int)atomicAdd(ctr, 1u);
    __syncthreads();
    return *slot;
}

typedef const pg8::f32x4 (&AccRef)[2][2][4][2];
struct EpiBf16 {
    static constexpr bool PERM = true, AFTER_DRAIN = false;
    bf16_t* O; int ldc; int pnmask;
    DI void operator()(AccRef acc, const pg8::Unit& u, int wr, int wc, int fr, int fq) const {
#pragma unroll
        for (int ai = 0; ai < 2; ++ai)
#pragma unroll
            for (int m = 0; m < 4; ++m) {
                bf16_t* rowp = O + (size_t)(u.pm * 256 + ai * 128 + wr * 64 + m * 16 + fr) * ldc + (u.pn & pnmask) * 256 + wc * 32 + 8 * fq;
#pragma unroll
                for (int bj = 0; bj < 2; ++bj) {
                    const f32x4 v0 = acc[ai][bj][m][0], v1 = acc[ai][bj][m][1];
                    u32x4 w; w.x = pk2(v0[0], v0[1]); w.y = pk2(v0[2], v0[3]); w.z = pk2(v1[0], v1[1]); w.w = pk2(v1[2], v1[3]);
                    *(u32x4*)(rowp + bj * 128) = w;
                }
            }
    }
};
struct EpiGate {
    static constexpr bool PERM = true, AFTER_DRAIN = false;
    bf16_t* merged; const bf16_t* proj; int goff; int accum;
    DI void operator()(AccRef acc, const pg8::Unit& u, int wr, int wc, int fr, int fq) const {
#pragma unroll
        for (int ai = 0; ai < 2; ++ai)
#pragma unroll
            for (int m = 0; m < 4; ++m) {
                const int row = u.pm * 256 + ai * 128 + wr * 64 + m * 16 + fr;
                const bf16_t* gp = proj + (size_t)row * NINP + goff + u.pn * 256 + wc * 32 + 8 * fq;
                bf16_t* mp = merged + (size_t)row * D + u.pn * 256 + wc * 32 + 8 * fq;
#pragma unroll
                for (int bj = 0; bj < 2; ++bj)
#pragma unroll
                    for (int n = 0; n < 2; ++n) {
                        const u32x2 g = *(const u32x2*)(gp + bj * 128 + 4 * n);
                        u32x2 pm2 = {0u, 0u}; if (accum) pm2 = *(const u32x2*)(mp + bj * 128 + 4 * n);
                        const f32x4 v = acc[ai][bj][m][n];
                        const float r0 = sigmoidf_(bflo(g.x)) * v[0] + bflo(pm2.x), r1 = sigmoidf_(bfhi(g.x)) * v[1] + bfhi(pm2.x);
                        const float r2 = sigmoidf_(bflo(g.y)) * v[2] + bflo(pm2.y), r3 = sigmoidf_(bfhi(g.y)) * v[3] + bfhi(pm2.y);
                        u32x2 w; w.x = pk2(r0, r1); w.y = pk2(r2, r3);
                        *(u32x2*)(mp + bj * 128 + 4 * n) = w;
                        asm volatile("" ::: "memory");
                    }
            }
    }
};
struct EpiSwiglu {
    static constexpr bool PERM = true, AFTER_DRAIN = false;
    bf16_t* act;
    DI void operator()(AccRef acc, const pg8::Unit& u, int wr, int wc, int fr, int fq) const {
#pragma unroll
        for (int ai = 0; ai < 2; ++ai)
#pragma unroll
            for (int m = 0; m < 4; ++m) {
                const int row = u.pm * 256 + ai * 128 + wr * 64 + m * 16 + fr;
#pragma unroll
                for (int bj = 0; bj < 2; ++bj) {
                    const int col0 = u.pn * 256 + bj * 128 + wc * 32 + 8 * fq;
                    const f32x4 g = acc[ai][bj][m][0], up = acc[ai][bj][m][1];
                    float r[4];
#pragma unroll
                    for (int j = 0; j < 4; ++j) r[j] = g[j] * sigmoidf_(g[j]) * up[j];
                    u32x2 w; w.x = pk2(r[0], r[1]); w.y = pk2(r[2], r[3]);
                    *(u32x2*)(act + (size_t)row * FF + (col0 >> 1)) = w;
                }
            }
    }
};
struct MemKvOrder {
    int G, c; const char* A; const char* B;
    DI bool next(int i, pg8::Unit& u) const {
        const int L = i * G + c; if (L >= 256) return false;
        const int l = L >> 6, r = L & 63; u.pm = l * 8 + (r & 7); u.pn = l * 8 + (r >> 3);
        u.a = A + (size_t)u.pm * (256 * D * 2); u.b = B + (size_t)u.pn * (256 * D * 2); return true;
    }
    DI void a_ready(const pg8::Unit&) const {}
    DI void done(const pg8::Unit&) const {}
};
struct CrossOrder {
    int G, c; const char* A; const char* B; int mode;
    DI bool next(int i, pg8::Unit& u) const {
        const int L = i * G + c; if (L >= 256) return false;
        u.pm = L >> 2; u.pn = L & 3; const int b = u.pm >> 3, h = u.pn;
        u.a = A + ((size_t)u.pm * 256 * D + h * 256) * 2;
        u.b = mode == 0 ? B + ((size_t)b * 256 * 2048 + h * 256) * 2 : B + ((size_t)h * 256 * 2048 + b * 256) * 2;
        return true;
    }
    DI void a_ready(const pg8::Unit&) const {}
    DI void done(const pg8::Unit&) const {}
};
struct EpiSoftmax {
    static constexpr bool PERM = true, AFTER_DRAIN = false;
    bf16_t* P; LAS float* xs;
    DI void operator()(AccRef acc, const pg8::Unit& u, int wr, int wc, int fr, int fq) const {
        const float sc = 0.0625f * 1.4426950408889634f;
        LAS float* xm = xs; LAS float* xsum = xs + 1024;
#pragma unroll
        for (int ai = 0; ai < 2; ++ai)
#pragma unroll
            for (int m = 0; m < 4; ++m) {
                float a = -3.0e38f;
#pragma unroll
                for (int bj = 0; bj < 2; ++bj)
#pragma unroll
                    for (int n = 0; n < 2; ++n) { const f32x4 v = acc[ai][bj][m][n]; a = fmaxf(a, fmaxf(fmaxf(v[0], v[1]), fmaxf(v[2], v[3]))); }
                a = fmaxf(a, __shfl_xor(a, 16)); a = fmaxf(a, __shfl_xor(a, 32));
                if (fq == 0) xm[(ai * 128 + wr * 64 + m * 16 + fr) * 4 + wc] = a;
                asm volatile("" ::: "memory");
            }
        __syncthreads();
#pragma unroll
        for (int ai = 0; ai < 2; ++ai)
#pragma unroll
            for (int m = 0; m < 4; ++m) {
                const f32x4 t = *(LAS f32x4*)(xm + (ai * 128 + wr * 64 + m * 16 + fr) * 4); const float mx = fmaxf(fmaxf(t[0], t[1]), fmaxf(t[2], t[3])) * sc;
                float s = 0.f;
#pragma unroll
                for (int bj = 0; bj < 2; ++bj)
#pragma unroll
                    for (int n = 0; n < 2; ++n)
#pragma unroll
                        for (int j = 0; j < 4; ++j) s += __builtin_amdgcn_exp2f(acc[ai][bj][m][n][j] * sc - mx);
                s += __shfl_xor(s, 16); s += __shfl_xor(s, 32);
                if (fq == 0) xsum[(ai * 128 + wr * 64 + m * 16 + fr) * 4 + wc] = s;
                asm volatile("" ::: "memory");
            }
        __syncthreads();
#pragma unroll
        for (int ai = 0; ai < 2; ++ai)
#pragma unroll
            for (int m = 0; m < 4; ++m) {
                const f32x4 t = *(LAS f32x4*)(xm + (ai * 128 + wr * 64 + m * 16 + fr) * 4); const float mx = fmaxf(fmaxf(t[0], t[1]), fmaxf(t[2], t[3])) * sc;
                const f32x4 t2 = *(LAS f32x4*)(xsum + (ai * 128 + wr * 64 + m * 16 + fr) * 4); const float inv = __builtin_amdgcn_rcpf((t2[0] + t2[1]) + (t2[2] + t2[3]));
                bf16_t* rowp = P + (size_t)(u.pm * 256 + ai * 128 + wr * 64 + m * 16 + fr) * D + u.pn * 256 + wc * 32 + 8 * fq;
#pragma unroll
                for (int bj = 0; bj < 2; ++bj)
#pragma unroll
                    for (int n = 0; n < 2; ++n) {
                        const f32x4 v = acc[ai][bj][m][n];
                        u32x2 w; w.x = pk2(__builtin_amdgcn_exp2f(v[0] * sc - mx) * inv, __builtin_amdgcn_exp2f(v[1] * sc - mx) * inv); w.y = pk2(__builtin_amdgcn_exp2f(v[2] * sc - mx) * inv, __builtin_amdgcn_exp2f(v[3] * sc - mx) * inv);
                        *(u32x2*)(rowp + bj * 128 + 4 * n) = w;
                    }
                asm volatile("" ::: "memory");
            }
        __syncthreads();
    }
};

#define XB_TMO      128
#define XB_XCNT(j)  (256  + 64 * (j))
#define XB_XSUB(j)  (1280 + 64 * (j))
#define XB_XGEN(j)  (2304 + 64 * (j))
#define XB_TOP      3328
#define XB_TOPGEN   3392
#define XCD_BAR_WORDS 3456
#define XB_SPIN_CAP (1u << 18)

__device__ __forceinline__ unsigned xb_ld(unsigned* p)              { return __hip_atomic_load(p, __ATOMIC_RELAXED, __HIP_MEMORY_SCOPE_AGENT); }
__device__ __forceinline__ unsigned xb_add(unsigned* p, unsigned v) { return __hip_atomic_fetch_add(p, v, __ATOMIC_RELAXED, __HIP_MEMORY_SCOPE_AGENT); }
__device__ __forceinline__ unsigned xb_xcc_id() { return (unsigned)__builtin_amdgcn_s_getreg((3 << 11) | 20) & 0xFu; }
#define XB_SPIN(cond, bar) do { unsigned _sp = 0; while (cond) { __builtin_amdgcn_s_sleep(1); \
    if ((++_sp & 255u) == 0u) { if (xb_ld(&(bar)[XB_TMO])) break; if (_sp > XB_SPIN_CAP) { atomicAdd(&(bar)[XB_TMO], 1u); break; } } } } while (0)

struct XcdBarrier {
    unsigned* bar; unsigned x;
    volatile LAS unsigned* st;
};

__device__ __forceinline__ XcdBarrier xcd_barrier_post(unsigned* bar, volatile LAS unsigned* st) {
    XcdBarrier b; b.bar = bar; b.x = xb_xcc_id(); b.st = st;
    if (threadIdx.x == 0) (void)xb_add(&bar[XB_XCNT(b.x)], 1u);
    return b;
}
__device__ __forceinline__ void xcd_barrier_complete(unsigned* bar, unsigned x, unsigned& nloc, unsigned& nx) {
    const unsigned G = gridDim.x * gridDim.y * gridDim.z;
    unsigned sum, cnt, mine, sp = 0u;
    for (;;) {
        sum = 0u; cnt = 0u; mine = 0u;
#pragma unroll
        for (unsigned j = 0; j < 16; ++j) { const unsigned c = xb_ld(&bar[XB_XCNT(j)]); sum += c; cnt += (c > 0u) ? 1u : 0u; mine = (j == x) ? c : mine; }
        if (sum == G) break;
        __builtin_amdgcn_s_sleep(1);
        if ((++sp & 255u) == 0u) { if (xb_ld(&bar[XB_TMO])) break; if (sp > XB_SPIN_CAP) { atomicAdd(&bar[XB_TMO], 1u); break; } }
    }
    nloc = mine > 0u ? mine : 1u; nx = cnt > 0u ? cnt : 1u;
}

__device__ __forceinline__ void xcd_barrier(const XcdBarrier& b) {
    asm volatile("s_waitcnt vmcnt(0)" ::: "memory");
    __syncthreads();
    if (threadIdx.x == 0) {
        unsigned* bar = b.bar;
        __builtin_amdgcn_s_waitcnt(0);
        unsigned nloc = b.st[0], nx = b.st[1];
        if (nloc == 0u) { xcd_barrier_complete(bar, b.x, nloc, nx); b.st[0] = nloc; b.st[1] = nx; }
        const unsigned old = xb_add(&bar[XB_XSUB(b.x)], 1u);
        const unsigned gen = old / nloc;
        if (old + 1u == (gen + 1u) * nloc) {
            __builtin_amdgcn_fence(__ATOMIC_RELEASE, "agent");
            asm volatile("s_waitcnt vmcnt(0)" ::: "memory");
            const unsigned og = xb_add(&bar[XB_TOP], 1u);
            const unsigned tg = og / nx;
            if (og + 1u == (tg + 1u) * nx) xb_add(&bar[XB_TOPGEN], 1u);
            else XB_SPIN(xb_ld(&bar[XB_TOPGEN]) == tg, bar);
            __builtin_amdgcn_fence(__ATOMIC_ACQUIRE, "agent");
            xb_add(&bar[XB_XGEN(b.x)], 1u);
            asm volatile("s_waitcnt vmcnt(0)" ::: "memory");
        } else {
            XB_SPIN(xb_ld(&bar[XB_XGEN(b.x)]) == gen, bar);
            __builtin_amdgcn_fence(__ATOMIC_ACQUIRE, "agent");
            asm volatile("s_waitcnt vmcnt(0)" ::: "memory");
        }
    }
    __syncthreads();
}


#define LDS_WAIT() asm volatile("s_waitcnt lgkmcnt(0)" ::: "memory")
DI void transpose_item(const float* W, int K, int N, int Npad, bf16_t* WT, int mode, LAS float* scr, int item, int lane) {
    const int nblk = Npad / 32, kb = item / nblk, nb = item % nblk, k0 = 64 * kb, n0 = 32 * nb;
    const int nn = n0 + (lane & 31); const bool ok = nn < N;
    float tv[32];
#pragma unroll
    for (int i = 0; i < 32; ++i) tv[i] = ok ? W[(size_t)(k0 + 2 * i + (lane >> 5)) * N + nn] : 0.f;
#pragma unroll
    for (int i = 0; i < 32; ++i) scr[(2 * i + (lane >> 5)) * 33 + (lane & 31)] = tv[i];
    LDS_WAIT(); asm volatile("" ::: "memory");
    const int c = lane & 7;
#pragma unroll
    for (int j = 0; j < 4; ++j) {
        const int n = (lane >> 3) + 8 * j; const LAS float* s = scr + (8 * c) * 33 + n;
        u32x4 o; o.x = pk2(s[0 * 33], s[1 * 33]); o.y = pk2(s[2 * 33], s[3 * 33]); o.z = pk2(s[4 * 33], s[5 * 33]); o.w = pk2(s[6 * 33], s[7 * 33]);
        int drow = n0 + n;
        if (mode == 1) { const int jj = drow >= FF ? drow - FF : drow, isu = drow >= FF ? 1 : 0; drow = (jj >> 2) * 8 + isu * 4 + (jj & 3); }
        *(u32x4*)(WT + (size_t)drow * K + k0 + 8 * c) = o;
    }
    LDS_WAIT(); asm volatile("" ::: "memory");
}

DI void norm_row(const float* xsrc32, bf16_t* xb, float* xdst32, const bf16_t* y, const float* gpost, const float* gpre, bf16_t* h, int lane) {
    f32x4 v[4];
    if (xsrc32) {
#pragma unroll
        for (int j = 0; j < 4; ++j) v[j] = *(const f32x4*)(xsrc32 + 4 * lane + 256 * j);
    } else {
#pragma unroll
        for (int j = 0; j < 4; ++j) { const u32x2 w = *(const u32x2*)(xb + 4 * lane + 256 * j); v[j] = (f32x4){bflo(w.x), bfhi(w.x), bflo(w.y), bfhi(w.y)}; }
    }
    if (y) {
        f32x4 yv[4]; float ss = 0.f;
#pragma unroll
        for (int j = 0; j < 4; ++j) { const u32x2 w = *(const u32x2*)(y + 4 * lane + 256 * j); yv[j] = (f32x4){bflo(w.x), bfhi(w.x), bflo(w.y), bfhi(w.y)}; ss += (yv[j][0] * yv[j][0] + yv[j][1] * yv[j][1]) + (yv[j][2] * yv[j][2] + yv[j][3] * yv[j][3]); }
        const float rs = rsqrtf(wave_sum(ss) * (1.f / D) + EPS);
#pragma unroll
        for (int j = 0; j < 4; ++j) { const f32x4 g = *(const f32x4*)(gpost + 4 * lane + 256 * j); v[j] = v[j] + yv[j] * rs * g; }
    }
    if (xdst32) {
#pragma unroll
        for (int j = 0; j < 4; ++j) *(f32x4*)(xdst32 + 4 * lane + 256 * j) = v[j];
    } else {
#pragma unroll
        for (int j = 0; j < 4; ++j) { u32x2 w; w.x = pk2(v[j][0], v[j][1]); w.y = pk2(v[j][2], v[j][3]); *(u32x2*)(xb + 4 * lane + 256 * j) = w; }
    }
    if (gpre) {
        float ss = 0.f;
#pragma unroll
        for (int j = 0; j < 4; ++j) ss += (v[j][0] * v[j][0] + v[j][1] * v[j][1]) + (v[j][2] * v[j][2] + v[j][3] * v[j][3]);
        const float rs = rsqrtf(wave_sum(ss) * (1.f / D) + EPS);
#pragma unroll
        for (int j = 0; j < 4; ++j) { const f32x4 g = *(const f32x4*)(gpre + 4 * lane + 256 * j); const f32x4 o = v[j] * rs * g; u32x2 w; w.x = pk2(o[0], o[1]); w.y = pk2(o[2], o[3]); *(u32x2*)(h + 4 * lane + 256 * j) = w; }
    }
}

DI void norm_phase(const Ctx& p, const float* gpost, const float* gpre, int G, int bx) {
    const int tid = pg8::tid_(), lane = tid & 63, wv = tid >> 6, gw = bx * NWAVES + wv, NGW = G * NWAVES;
    const bf16_t* Yb = (const bf16_t*)(p.ws + WS_Y); bf16_t* Hb = (bf16_t*)(p.ws + WS_H); bf16_t* Xb = (bf16_t*)(p.ws + WS_XB);
    for (int row = gw; row < MA; row += NGW) norm_row(nullptr, Xb + (size_t)row * D, gpre ? nullptr : p.out + (size_t)row * D, Yb + (size_t)row * D, gpost, gpre, Hb + (size_t)row * D, lane);
}

DI void prologue(const Params& p, LAS unsigned char* lds) {
    const int tid = pg8::tid_(), lane = tid & 63, wv = tid >> 6;
    const int gw = blockIdx.x * NWAVES + wv, NGW = gridDim.x * NWAVES;
    LAS float* scr = (LAS float*)(lds + wv * 16384);
    unsigned char* ws = p.ws;
    constexpr int I0 = 3072, I1 = 192, I2 = 512, I3 = 2816, I4 = 1408, IPL = I0 + 2 * I1 + 5 * I2 + I3 + I4;
    for (int it = gw; it < 4 * IPL; it += NGW) {
        const int l = it / IPL; int r = it % IPL;
        if (r < I0) { transpose_item(p.in[I_WIN] + (size_t)l * D * NIN, D, NIN, NINP, (bf16_t*)(ws + WS_WIN + l * SZ_WIN), 0, scr, r, lane); continue; } r -= I0;
        if (r < I1) { transpose_item(p.in[I_WBA] + (size_t)l * 384 * D, 384, D, D, (bf16_t*)(ws + WS_WBA + l * SZ_WBA), 0, scr, r, lane); continue; } r -= I1;
        if (r < I1) { transpose_item(p.in[I_WBC] + (size_t)l * 384 * D, 384, D, D, (bf16_t*)(ws + WS_WBC + l * SZ_WBA), 0, scr, r, lane); continue; } r -= I1;
        if (r < I2) { transpose_item(p.in[I_WMIX] + (size_t)l * D * D, D, D, D, (bf16_t*)(ws + WS_WMIX + l * SZ_WSQ), 0, scr, r, lane); continue; } r -= I2;
        if (r < I2) { transpose_item(p.in[I_WXQ] + (size_t)l * D * D, D, D, D, (bf16_t*)(ws + WS_WXQ + l * SZ_WSQ), 0, scr, r, lane); continue; } r -= I2;
        if (r < I2) { transpose_item(p.in[I_WXO] + (size_t)l * D * D, D, D, D, (bf16_t*)(ws + WS_WXO + l * SZ_WSQ), 0, scr, r, lane); continue; } r -= I2;
        if (r < I2) { transpose_item(p.in[I_WXK] + (size_t)l * D * D, D, D, D, (bf16_t*)(ws + WS_WKV + l * SZ_WKV), 0, scr, r, lane); continue; } r -= I2;
        if (r < I2) { transpose_item(p.in[I_WXV] + (size_t)l * D * D, D, D, D, (bf16_t*)(ws + WS_WKV + l * SZ_WKV + SZ_WSQ), 0, scr, r, lane); continue; } r -= I2;
        if (r < I3) { transpose_item(p.in[I_WF1] + (size_t)l * D * FF2, D, FF2, FF2, (bf16_t*)(ws + WS_WF1 + l * SZ_WF1), 1, scr, r, lane); continue; } r -= I3;
        transpose_item(p.in[I_WF2] + (size_t)l * FF * D, FF, D, D, (bf16_t*)(ws + WS_WF2 + l * SZ_WF2), 0, scr, r, lane);
    }
    for (int u = blockIdx.x; u < 128; u += gridDim.x) {
        const int l = u >> 5, g = (u >> 3) & 3, nb = (u >> 2) & 1, cq = u & 3;
        LAS float* Ps = (LAS float*)(lds + 8 * 16384);
        __syncthreads();
        for (int i = tid; i < 1024; i += NTHR) Ps[i] = p.in[I_WPOOL][((size_t)(l * 4 + g) * 64 + 16 * cq) * 64 + i];
        __syncthreads();
        const int n = nb * 512 + tid;
        const float* sc = p.in[I_PSCALE] + l * 256 + g * 64; const float* wb = p.in[I_WBB] + ((size_t)l * 256 + g * 64) * D + n;
        float acc[16];
#pragma unroll
        for (int c = 0; c < 16; ++c) acc[c] = 0.f;
#pragma unroll 2
        for (int d0 = 0; d0 < 64; d0 += 8) {
            float bc[8];
#pragma unroll
            for (int j = 0; j < 8; ++j) bc[j] = sc[d0 + j] * wb[(size_t)(d0 + j) * D];
#pragma unroll
            for (int c = 0; c < 16; ++c) { const f32x4 p0 = *(const LAS f32x4*)(Ps + c * 64 + d0), p1 = *(const LAS f32x4*)(Ps + c * 64 + d0 + 4);
                acc[c] += ((p0[0] * bc[0] + p0[1] * bc[1]) + (p0[2] * bc[2] + p0[3] * bc[3])) + ((p1[0] * bc[4] + p1[1] * bc[5]) + (p1[2] * bc[6] + p1[3] * bc[7])); }
        }
        unsigned ov[16];
#pragma unroll
        for (int c = 0; c < 16; ++c) ov[c] = f2bf(acc[c]);
        bf16_t* dst = (bf16_t*)(ws + WS_WBB + l * SZ_WBB) + (size_t)n * 256 + g * 64 + 16 * cq;
        u32x4 w0, w1; w0.x = ov[0] | (ov[1] << 16); w0.y = ov[2] | (ov[3] << 16); w0.z = ov[4] | (ov[5] << 16); w0.w = ov[6] | (ov[7] << 16);
        w1.x = ov[8] | (ov[9] << 16); w1.y = ov[10] | (ov[11] << 16); w1.z = ov[12] | (ov[13] << 16); w1.w = ov[14] | (ov[15] << 16);
        *(u32x4*)dst = w0; *(u32x4*)(dst + 8) = w1;
    }
    __syncthreads();
    for (int row = gw; row < MA; row += NGW) {
        const float* src = row < MP ? p.in[I_XP] + (size_t)row * D : p.in[I_XS] + (size_t)(row - MP) * D;
        norm_row(src, (bf16_t*)(ws + WS_XB) + (size_t)row * D, nullptr, nullptr, nullptr, p.in[I_NMIXPRE], (bf16_t*)(ws + WS_H) + (size_t)row * D, lane);
    }
    for (int row = gw; row < NB * 256; row += NGW) {
        f32x4 v[4]; float ss = 0.f;
#pragma unroll
        for (int j = 0; j < 4; ++j) { v[j] = *(const f32x4*)(p.in[I_MEM] + (size_t)row * D + 4 * lane + 256 * j); ss += (v[j][0] * v[j][0] + v[j][1] * v[j][1]) + (v[j][2] * v[j][2] + v[j][3] * v[j][3]); }
        const float rs = rsqrtf(wave_sum(ss) * (1.f / D) + EPS);
        for (int l = 0; l < 4; ++l)
#pragma unroll
            for (int j = 0; j < 4; ++j) { const f32x4 g = *(const f32x4*)(p.in[I_MEMN] + l * D + 4 * lane + 256 * j); const f32x4 o = v[j] * rs * g; u32x2 w; w.x = pk2(o[0], o[1]); w.y = pk2(o[2], o[3]);
                *(u32x2*)((bf16_t*)(ws + WS_MN) + ((size_t)l * 2048 + row) * D + 4 * lane + 256 * j) = w; }
    }
}

#define MFMA32(a, b, c) __builtin_amdgcn_mfma_f32_32x32x16_bf16((a), (b), (c), 0, 0, 0)
#define MFMA16(a, b, c) __builtin_amdgcn_mfma_f32_16x16x32_bf16((a), (b), (c), 0, 0, 0)
DI void sb_prompt_unit(const Ctx& p, int b, int h, int qb, LAS unsigned char* lds) {
    const bf16_t* proj = (const bf16_t*)(p.ws + WS_PROJ);
    LAS unsigned short* KS = (LAS unsigned short*)lds;
    LAS unsigned short* VT = KS + 64 * 72;
    const int tid = pg8::tid_(), lane = tid & 63, wv = tid >> 6, hi = lane >> 5, c = lane & 31;
    const int q0 = qb * 256 + wv * 32, tq = q0 + c;
    const size_t rowbase = (size_t)b * SEQ;
    bf16x8 qf[4];
    {
        const bf16_t* qp = proj + (rowbase + tq) * NINP + C_QA + h * 64 + 8 * hi;
#pragma unroll
        for (int kk = 0; kk < 4; ++kk) qf[kk] = *(const bf16x8*)(qp + 16 * kk);
    }
    f32x16 o0, o1;
#pragma unroll
    for (int i = 0; i < 16; ++i) { o0[i] = 0.f; o1[i] = 0.f; }
    float R = 1.f;
    const bf16_t* kbase = proj + rowbase * NINP + C_KA + h * 64 + 8 * wv;
    const bf16_t* vbase = proj + rowbase * NINP + C_VA + h * 64 + 8 * wv;
    int jt = 4 * qb + 3;
    u32x4 kr = *(const u32x4*)(kbase + (size_t)(64 * jt + lane) * NINP), vr = *(const u32x4*)(vbase + (size_t)(64 * jt + lane) * NINP);
    for (; jt >= 0; --jt) {
        __syncthreads();
        *(LAS u32x4*)(KS + lane * 72 + 8 * wv) = kr;
#pragma unroll
        for (int i = 0; i < 4; ++i) { const unsigned w = vr[i]; VT[(8 * wv + 2 * i) * 72 + lane] = (unsigned short)(w & 0xffffu); VT[(8 * wv + 2 * i + 1) * 72 + lane] = (unsigned short)(w >> 16); }
        __syncthreads();
        if (jt > 0) { kr = *(const u32x4*)(kbase + (size_t)(64 * (jt - 1) + lane) * NINP); vr = *(const u32x4*)(vbase + (size_t)(64 * (jt - 1) + lane) * NINP); }
        if (64 * jt < q0 + 31) {
            f32x16 z[2];
#pragma unroll
            for (int kb = 0; kb < 2; ++kb) {
                f32x16 acc;
#pragma unroll
                for (int i = 0; i < 16; ++i) acc[i] = 0.f;
#pragma unroll
                for (int kk = 0; kk < 4; ++kk) { const bf16x8 a = *(const LAS bf16x8*)(KS + (32 * kb + c) * 72 + 16 * kk + 8 * hi); acc = MFMA32(a, qf[kk], acc); }
                z[kb] = acc;
            }
            f32x16 e[2]; float T[8];
            const int sbase = 64 * jt + 4 * hi;
#pragma unroll
            for (int kb = 0; kb < 2; ++kb)
#pragma unroll
                for (int g = 0; g < 4; ++g) {
                    float fl[4];
#pragma unroll
                    for (int j = 0; j < 4; ++j) {
                        const int r = 4 * g + j; const bool valid = (sbase + 32 * kb + 8 * g + j) < tq;
                        const float zz = fminf(fmaxf(z[kb][r], -240.f), 240.f);
                        const float t = __builtin_amdgcn_exp2f(zz * (-0.125f * 1.4426950408889634f));
                        const float be = __builtin_amdgcn_rcpf(1.f + t);
                        fl[j] = valid ? t * be : 1.f; z[kb][r] = valid ? be : 0.f;
                    }
                    e[kb][4 * g + 3] = 1.f; e[kb][4 * g + 2] = fl[3]; e[kb][4 * g + 1] = fl[3] * fl[2]; e[kb][4 * g + 0] = e[kb][4 * g + 1] * fl[1];
                    T[kb * 4 + g] = e[kb][4 * g + 0] * fl[0];
                }
            float Tp[8], X[8];
#pragma unroll
            for (int gi = 0; gi < 8; ++gi) Tp[gi] = __shfl_xor(T[gi], 32);
            X[7] = 1.f;
#pragma unroll
            for (int gi = 6; gi >= 0; --gi) X[gi] = X[gi + 1] * (T[gi + 1] * Tp[gi + 1]);
            const float total = X[0] * (T[0] * Tp[0]);
#pragma unroll
            for (int kb = 0; kb < 2; ++kb)
#pragma unroll
                for (int g = 0; g < 4; ++g) {
                    const int gi = kb * 4 + g; const float off = R * X[gi] * (hi == 0 ? Tp[gi] : 1.f);
#pragma unroll
                    for (int j = 0; j < 4; ++j) { const int r = 4 * g + j; z[kb][r] = z[kb][r] * (off * e[kb][r]); }
                }
            R *= total;
#pragma unroll
            for (int kb = 0; kb < 2; ++kb)
#pragma unroll
                for (int s2 = 0; s2 < 2; ++s2) {
                    u32x4 pw; pw.x = pk2(z[kb][8 * s2 + 0], z[kb][8 * s2 + 1]); pw.y = pk2(z[kb][8 * s2 + 2], z[kb][8 * s2 + 3]); pw.z = pk2(z[kb][8 * s2 + 4], z[kb][8 * s2 + 5]); pw.w = pk2(z[kb][8 * s2 + 6], z[kb][8 * s2 + 7]);
                    const bf16x8 pb = __builtin_bit_cast(bf16x8, pw);
                    const int ko = 32 * kb + 16 * s2 + 4 * hi;
                    { const s16x4 lo = *(const LAS s16x4*)(VT + c * 72 + ko), hh = *(const LAS s16x4*)(VT + c * 72 + ko + 8);
                      const bf16x8 va = __builtin_shufflevector(lo, hh, 0, 1, 2, 3, 4, 5, 6, 7); o0 = MFMA32(va, pb, o0); }
                    { const s16x4 lo = *(const LAS s16x4*)(VT + (c + 32) * 72 + ko), hh = *(const LAS s16x4*)(VT + (c + 32) * 72 + ko + 8);
                      const bf16x8 va = __builtin_shufflevector(lo, hh, 0, 1, 2, 3, 4, 5, 6, 7); o1 = MFMA32(va, pb, o1); }
                }
        }
    }
    bf16_t* op = (bf16_t*)(p.ws + WS_OA) + (rowbase + tq) * 384 + h * 64 + 4 * hi;
#pragma unroll
    for (int g = 0; g < 4; ++g) {
        u32x2 w; w.x = pk2(o0[4 * g], o0[4 * g + 1]); w.y = pk2(o0[4 * g + 2], o0[4 * g + 3]); *(u32x2*)(op + 8 * g) = w;
        w.x = pk2(o1[4 * g], o1[4 * g + 1]); w.y = pk2(o1[4 * g + 2], o1[4 * g + 3]); *(u32x2*)(op + 32 + 8 * g) = w;
    }
}

DI void sb_sample_unit(const Ctx& p, int l, int b, int h, LAS unsigned char* lds) {
    const bf16_t* proj = (const bf16_t*)(p.ws + WS_PROJ);
    LAS float* qs = (LAS float*)lds;
    LAS float* Z = qs + 1024;
    LAS float* RED = Z + 16 * 1056;
    const int tid = pg8::tid_(), lane = tid & 63, wv = tid >> 6;
    const size_t srow = (size_t)MP + b * 16;
    for (int i = tid; i < 1024; i += NTHR) qs[i] = bf2f(proj[(srow + (i >> 6)) * NINP + C_QA + h * 64 + (i & 63)]) * 0.125f;
    __syncthreads();
    {
        float a0[16], a1[16];
#pragma unroll
        for (int i = 0; i < 16; ++i) { a0[i] = 0.f; a1[i] = 0.f; }
        const float* k0p = p.in[I_CSK] + ((((size_t)l * DB + b) * PAST + tid) * 6 + h) * 64; const float* k1p = k0p + (size_t)512 * 6 * 64;
#pragma unroll 4
        for (int d4 = 0; d4 < 16; ++d4) {
            const f32x4 ka = *(const f32x4*)(k0p + 4 * d4), kb = *(const f32x4*)(k1p + 4 * d4);
#pragma unroll
            for (int i = 0; i < 16; ++i) { const f32x4 q = *(const LAS f32x4*)(qs + i * 64 + 4 * d4);
                a0[i] += (q[0] * ka[0] + q[1] * ka[1]) + (q[2] * ka[2] + q[3] * ka[3]); a1[i] += (q[0] * kb[0] + q[1] * kb[1]) + (q[2] * kb[2] + q[3] * kb[3]); }
        }
#pragma unroll
        for (int i = 0; i < 16; ++i) { Z[i * 1056 + tid] = a0[i]; Z[i * 1056 + tid + 512] = a1[i]; }
        if (tid < 256) {
            const int i = tid >> 4, j = tid & 15; const bf16_t* kp = proj + (srow + j) * NINP + C_KA + h * 64; float s = 0.f;
            for (int d = 0; d < 64; ++d) s += qs[i * 64 + d] * bf2f(kp[d]);
            Z[i * 1056 + 1024 + j] = s;
        }
    }
    __syncthreads();
    for (int qq = 0; qq < 2; ++qq) {
        const int i = 2 * wv + qq, lim = PAST + i; LAS float* zr = Z + i * 1056;
        const int st = 17 * lane, en = (st + 17 < 1040) ? st + 17 : 1040;
        float tot = 0.f;
        for (int s = st; s < en; ++s) if (s < lim) tot -= softplusf_(zr[s]);
        float incl = tot;
#pragma unroll
        for (int o = 1; o < 64; o <<= 1) { const float t = __shfl_down(incl, o); if (lane + o < 64) incl += t; }
        float run = incl - tot;
        for (int s = en - 1; s >= st; --s) {
            const float zz = zr[s]; float w = 0.f;
            if (s < lim) { const float sp = softplusf_(zz); w = __expf(zz - sp + run); run -= sp; }
            zr[s] = w;
        }
    }
    __syncthreads();
    {
        const int d = tid & 63, g = tid >> 6;
        float o[16];
#pragma unroll
        for (int i = 0; i < 16; ++i) o[i] = 0.f;
        const float* vp = p.in[I_CSV] + (((size_t)l * DB + b) * PAST * 6 + h) * 64 + d;
        for (int s0 = 130 * g; s0 < 130 * g + 130; s0 += 10) {
            float v[10];
#pragma unroll
            for (int j = 0; j < 10; ++j) { const int s = s0 + j; v[j] = s < PAST ? vp[(size_t)s * 384] : bf2f(proj[(srow + (s - PAST)) * NINP + C_VA + h * 64 + d]); }
#pragma unroll
            for (int j = 0; j < 10; ++j)
#pragma unroll
                for (int i = 0; i < 16; ++i) o[i] += Z[i * 1056 + s0 + j] * v[j];
        }
#pragma unroll
        for (int i = 0; i < 16; ++i) RED[(g * 16 + i) * 64 + d] = o[i];
    }
    __syncthreads();
    for (int i = tid; i < 1024; i += NTHR) {
        const int qi = i >> 6, d = i & 63; float s = 0.f;
#pragma unroll
        for (int g = 0; g < 8; ++g) s += RED[(g * 16 + qi) * 64 + d];
        ((bf16_t*)(p.ws + WS_OA))[(srow + qi) * 384 + h * 64 + d] = f2bf(s);
    }
}

DI void pool_unit(const Ctx& p, int l, int unit) {
    const bf16_t* proj = (const bf16_t*)(p.ws + WS_PROJ); bf16_t* pooled = (bf16_t*)(p.ws + WS_POOLED);
    const int tid = pg8::tid_(), ch = tid & 255, w = 2 << (ch >> 6);
    for (int i = 0; i < 32; ++i) {
        const int row = unit * 64 + (tid >> 8) + 2 * i;
        float s = 0.f, cnt, u0;
        if (row < MP) {
            const int t = row & (SEQ - 1); const int n = (t + 1 < w) ? t + 1 : w; cnt = (float)n;
            const bf16_t* up = proj + (size_t)row * NINP + C_U + ch; u0 = bf2f(up[0]);
            for (int j = 0; j < n; ++j) s += bf2f(*(up - (size_t)j * NINP));
            if (t >= SEQ - 15) p.out[O_POOLP + ((size_t)(l * NB + (row >> 11)) * 15 + (t - (SEQ - 15))) * 256 + ch] = u0;
        } else {
            const int rs = row - MP, b = rs >> 4, t = rs & 15; cnt = (float)w;
            const bf16_t* up = proj + (size_t)row * NINP + C_U + ch; u0 = bf2f(up[0]);
            const float* hist = p.in[I_SPOOL] + ((size_t)(l * DB + b) * 15) * 256 + ch;
            for (int j = 0; j < w; ++j) { const int tt = t - j; s += tt >= 0 ? bf2f(*(up - (size_t)j * NINP)) : hist[(15 + tt) * 256]; }
            if (t >= 1) p.out[O_POOLS + ((size_t)(l * DB + b) * 15 + (t - 1)) * 256 + ch] = u0;
        }
        pooled[(size_t)row * 256 + ch] = f2bf(s / cnt - u0);
    }
}


DI void kvout_unit(const Ctx& p, int l, int unit) {
    const bf16_t* proj = (const bf16_t*)(p.ws + WS_PROJ);
    for (int i = pg8::tid_(); i < 64 * 96; i += NTHR) {
        const int r = i / 96, ch = i % 96, row = unit * 64 + r;
        const u32x4 w = *(const u32x4*)(proj + (size_t)row * NINP + C_KA + 8 * ch);
        const bool isv = ch >= 48; const int c = 8 * (isv ? ch - 48 : ch);
        float* dst = (row < MP) ? p.out + (isv ? O_VP : O_KP) + ((size_t)l * MP + row) * 384 + c : p.out + (isv ? O_VS : O_KS) + ((size_t)l * MS + (row - MP)) * 384 + c;
        *(f32x4*)dst = (f32x4){bflo(w.x), bfhi(w.x), bflo(w.y), bfhi(w.y)}; *(f32x4*)(dst + 4) = (f32x4){bflo(w.z), bfhi(w.z), bflo(w.w), bfhi(w.w)};
    }
}
DI void memout_unit(const Ctx& p, int unit) {
    const bf16_t* mkv = (const bf16_t*)(p.ws + WS_MKV);
    for (int i = pg8::tid_(); i < 16 * 256; i += NTHR) {
        const int r = i >> 8, ch = i & 255, row = unit * 16 + r, col = 8 * ch;
        const u32x4 w = *(const u32x4*)(mkv + (size_t)row * 2048 + col);
        float* dst = p.out + (col >= 1024 ? O_MVP : O_MKP) + (size_t)row * D + (col & 1023);
        *(f32x4*)dst = (f32x4){bflo(w.x), bfhi(w.x), bflo(w.y), bfhi(w.y)}; *(f32x4*)(dst + 4) = (f32x4){bflo(w.z), bfhi(w.z), bflo(w.w), bfhi(w.w)};
    }
}
DI void memvt_unit(const Ctx& p, int unit) {
    const int l = unit >> 7, nb = (unit >> 3) & 15, b = unit & 7, tid = pg8::tid_(), n = nb * 64 + (tid & 63), wv = tid >> 6;
    const bf16_t* src = (const bf16_t*)(p.ws + WS_MKV) + ((size_t)l * 2048 + b * 256) * 2048 + 1024 + n;
    bf16_t* dst = (bf16_t*)(p.ws + WS_MEMVT) + ((size_t)l * 1024 + n) * 2048 + b * 256;
    for (int c = wv; c < 32; c += 8) {
        unsigned v[8];
#pragma unroll
        for (int j = 0; j < 8; ++j) v[j] = src[(size_t)(8 * c + j) * 2048];
        u32x4 w; w.x = v[0] | (v[1] << 16); w.y = v[2] | (v[3] << 16); w.z = v[4] | (v[5] << 16); w.w = v[6] | (v[7] << 16);
        *(u32x4*)(dst + 8 * c) = w;
    }
}

DI void gla_decay(const Ctx& p, int l, int h, size_t row0, int ntok, LAS unsigned char* lds) {
    const bf16_t* proj = (const bf16_t*)(p.ws + WS_PROJ);
    LAS float* Bc = (LAS float*)lds; LAS float* LR = (LAS float*)(lds + 24576); LAS float* A2 = (LAS float*)(lds + 28672); LAS float* BIA = (LAS float*)(lds + 34816); LAS float* SEG = (LAS float*)(lds + 35200);
    const int tid = pg8::tid_();
    if (tid < 128) {
        const int t = tid >> 1, hf = tid & 1; u32x4 w = {0u, 0u, 0u, 0u};
        if (t < ntok) w = *(const u32x4*)(proj + (row0 + t) * NINP + C_LR + 8 * hf);
        LAS float* d = LR + t * 16 + 8 * hf;
        d[0] = bflo(w.x); d[1] = bfhi(w.x); d[2] = bflo(w.y); d[3] = bfhi(w.y); d[4] = bflo(w.z); d[5] = bfhi(w.z); d[6] = bflo(w.w); d[7] = bfhi(w.w);
    } else if (tid < 128 + 384) {
        const int i = tid - 128, r = i / 24, c4 = i % 24;
        *(LAS f32x4*)(A2 + r * 96 + 4 * c4) = *(const f32x4*)(p.in[I_WA2] + ((size_t)l * 16 + r) * 384 + h * 96 + 4 * c4);
    }
    if (tid < 96) BIA[tid] = p.in[I_BA][l * 384 + h * 96 + tid];
    __syncthreads();
    for (int i = tid; i < 64 * 96; i += NTHR) {
        const int t = i / 96, k = i % 96; float sacc = BIA[k];
#pragma unroll
        for (int r = 0; r < 16; ++r) sacc += LR[t * 16 + r] * A2[r * 96 + k];
        Bc[i] = t < ntok ? -softplusf_(-sacc) * (1.f / 16.f) : 0.f;
    }
    __syncthreads();
    const int k = tid % 96, seg = tid / 96;
    if (tid < 384) { float run = 0.f; for (int i = 0; i < 16; ++i) { const int idx = (16 * seg + i) * 96 + k; run += Bc[idx]; Bc[idx] = run; } SEG[seg * 96 + k] = run; }
    __syncthreads();
    if (tid < 384 && seg > 0) { float off = 0.f; for (int s2 = 0; s2 < seg; ++s2) off += SEG[s2 * 96 + k]; for (int i = 0; i < 16; ++i) Bc[(16 * seg + i) * 96 + k] += off; }
    __syncthreads();
}
DI void gla_unit_rows(int gu, size_t& row0, int& ntok, int& bh, int& h) {
    if (gu < NGU_P) { bh = gu >> 5; const int c = gu & 31, b = bh >> 2; h = bh & 3; row0 = (size_t)b * SEQ + c * 64; ntok = 64; }
    else { bh = gu - NGU_P; const int b = bh >> 2; h = bh & 3; row0 = (size_t)MP + b * 16; ntok = 16; }
}
DI void gla_stage1_unit(const Ctx& p, int l, int gu, LAS unsigned char* lds) {
    const bf16_t* proj = (const bf16_t*)(p.ws + WS_PROJ);
    size_t row0; int ntok, bh, h; gla_unit_rows(gu, row0, ntok, bh, h);
    gla_decay(p, l, h, row0, ntok, lds);
    LAS float* Bc = (LAS float*)lds;
    LAS unsigned short* KT = (LAS unsigned short*)(lds + 36864);
    LAS unsigned short* VT = KT + 96 * 72;
    const int tid = pg8::tid_(), lane = tid & 63, wv = tid >> 6, fr = lane & 15, fq = lane >> 4;
    {
        float* bb = (float*)(p.ws + WS_BB) + (size_t)gu * (64 * GK);
        for (int i = tid; i < 64 * GK / 4; i += NTHR) *(f32x4*)(bb + 4 * i) = *(const LAS f32x4*)(Bc + 4 * i);
    }
    for (int task = tid; task < 768; task += NTHR) {
        const int t = task & 63, ch = task >> 6; u32x4 kw = {0u, 0u, 0u, 0u}, vw = {0u, 0u, 0u, 0u};
        if (t < ntok) { const bf16_t* rp = proj + (row0 + t) * NINP + h * 96 + 8 * ch; kw = *(const u32x4*)(rp + C_KC); vw = *(const u32x4*)(rp + C_VC); }
        const unsigned kk[4] = {kw.x, kw.y, kw.z, kw.w}, vv[4] = {vw.x, vw.y, vw.z, vw.w};
#pragma unroll
        for (int j = 0; j < 4; ++j) {
            const int k0 = 8 * ch + 2 * j;
            const float e0 = __expf(Bc[(ntok - 1) * 96 + k0] - Bc[t * 96 + k0]), e1 = __expf(Bc[(ntok - 1) * 96 + k0 + 1] - Bc[t * 96 + k0 + 1]);
            KT[k0 * 72 + t] = f2bf(bflo(kk[j]) * e0); KT[(k0 + 1) * 72 + t] = f2bf(bfhi(kk[j]) * e1);
            VT[k0 * 72 + t] = (unsigned short)(vv[j] & 0xffffu); VT[(k0 + 1) * 72 + t] = (unsigned short)(vv[j] >> 16);
        }
    }
    if (tid < 96) ((float*)(p.ws + WS_GDEC))[(size_t)gu * 96 + tid] = __expf(Bc[(ntok - 1) * 96 + tid]);
    __syncthreads();
    float* KV = (float*)(p.ws + WS_GKV) + (size_t)gu * (GK * GK);
    for (int tile = wv; tile < 36; tile += 8) {
        const int ki = tile / 6, vi = tile % 6; f32x4 acc = {0.f, 0.f, 0.f, 0.f};
#pragma unroll
        for (int ks = 0; ks < 2; ++ks) { const bf16x8 a = *(const LAS bf16x8*)(KT + (16 * ki + fr) * 72 + 32 * ks + 8 * fq), bb = *(const LAS bf16x8*)(VT + (16 * vi + fr) * 72 + 32 * ks + 8 * fq); acc = MFMA16(a, bb, acc); }
#pragma unroll
        for (int j = 0; j < 4; ++j) KV[(16 * ki + 4 * fq + j) * 96 + 16 * vi + fr] = acc[j];
    }
}
DI void gla_scan(const Ctx& p, int l) {
    const int gt = blockIdx.x * NTHR + pg8::tid_(), NT = gridDim.x * NTHR;
    const float* KV = (const float*)(p.ws + WS_GKV); const float* DEC = (const float*)(p.ws + WS_GDEC); float* SP = (float*)(p.ws + WS_GSP);
    for (int e = gt; e < 32 * GK * GK; e += NT) {
        const int bh = e / (GK * GK), kv = e % (GK * GK), k = kv / GK; float S = 0.f;
#pragma unroll 4
        for (int c = 0; c < 32; ++c) { const size_t gu = (size_t)bh * 32 + c; SP[gu * (GK * GK) + kv] = S; S = DEC[gu * 96 + k] * S + KV[gu * (GK * GK) + kv]; }
        p.out[O_GLAP + ((size_t)l * 32 + bh) * (GK * GK) + kv] = S;
    }
    for (int e = gt; e < 64 * GK * GK; e += NT) {
        const int bh = e / (GK * GK), kv = e % (GK * GK), k = kv / GK; const size_t gu = (size_t)NGU_P + bh;
        const float S0 = p.in[I_SGLA][((size_t)l * 64 + bh) * (GK * GK) + kv];
        p.out[O_GLAS + ((size_t)l * 64 + bh) * (GK * GK) + kv] = DEC[gu * 96 + k] * S0 + KV[gu * (GK * GK) + kv];
    }
}
DI void gla_stage3_unit(const Ctx& p, int l, int gu, LAS unsigned char* lds) {
    const bf16_t* proj = (const bf16_t*)(p.ws + WS_PROJ);
    size_t row0; int ntok, bh, h; gla_unit_rows(gu, row0, ntok, bh, h);
    LAS float* OT = (LAS float*)lds;
    LAS unsigned short* QP = (LAS unsigned short*)(lds + 36864);
    LAS unsigned short* KP = QP + 64 * 104;
    LAS unsigned short* VT = KP + 64 * 104;
    LAS unsigned short* ST = VT + 96 * 72;
    LAS unsigned short* ATT = ST + 96 * 104;
    const int tid = pg8::tid_(), lane = tid & 63, wv = tid >> 6, fr = lane & 15, fq = lane >> 4;
    const float* Sprev = gu < NGU_P ? (const float*)(p.ws + WS_GSP) + (size_t)gu * (GK * GK) : p.in[I_SGLA] + ((size_t)l * 64 + bh) * (GK * GK);
    const float* bb = (const float*)(p.ws + WS_BB) + (size_t)gu * (64 * GK);
    __syncthreads();
    for (int task = tid; task < 768; task += NTHR) {
        const int t = task & 63, ch = task >> 6; u32x4 qw = {0u, 0u, 0u, 0u}, kw = qw, vw = qw; f32x4 b0 = {0.f, 0.f, 0.f, 0.f}, b1 = b0;
        if (t < ntok) { const bf16_t* rp = proj + (row0 + t) * NINP + h * 96 + 8 * ch; qw = *(const u32x4*)(rp + C_QC); kw = *(const u32x4*)(rp + C_KC); vw = *(const u32x4*)(rp + C_VC);
            b0 = *(const f32x4*)(bb + t * 96 + 8 * ch); b1 = *(const f32x4*)(bb + t * 96 + 8 * ch + 4); }
        const unsigned qq[4] = {qw.x, qw.y, qw.z, qw.w}, kk[4] = {kw.x, kw.y, kw.z, kw.w}, vv[4] = {vw.x, vw.y, vw.z, vw.w};
        const float be[8] = {b0[0], b0[1], b0[2], b0[3], b1[0], b1[1], b1[2], b1[3]};
        u32x4 qo, ko; unsigned qa[4], ka[4];
#pragma unroll
        for (int j = 0; j < 4; ++j) {
            const float e0 = __expf(be[2 * j]), e1 = __expf(be[2 * j + 1]), r0 = __builtin_amdgcn_rcpf(e0), r1 = __builtin_amdgcn_rcpf(e1);
            const bool ok = t < ntok;
            qa[j] = ok ? pk2(bflo(qq[j]) * 0.10206207261596575f * e0, bfhi(qq[j]) * 0.10206207261596575f * e1) : 0u;
            ka[j] = ok ? pk2(bflo(kk[j]) * r0, bfhi(kk[j]) * r1) : 0u;
            VT[(8 * ch + 2 * j) * 72 + t] = (unsigned short)(vv[j] & 0xffffu); VT[(8 * ch + 2 * j + 1) * 72 + t] = (unsigned short)(vv[j] >> 16);
        }
        qo.x = qa[0]; qo.y = qa[1]; qo.z = qa[2]; qo.w = qa[3]; ko.x = ka[0]; ko.y = ka[1]; ko.z = ka[2]; ko.w = ka[3];
        *(LAS u32x4*)(QP + t * 104 + 8 * ch) = qo; *(LAS u32x4*)(KP + t * 104 + 8 * ch) = ko;
    }
    for (int task = tid; task < 2304; task += NTHR) {
        const int k = task % 96, vc = task / 96; const f32x4 sv = *(const f32x4*)(Sprev + k * 96 + 4 * vc);
#pragma unroll
        for (int j = 0; j < 4; ++j) ST[(4 * vc + j) * 104 + k] = f2bf(sv[j]);
    }
    __syncthreads();
    for (int tile = 2 * wv; tile < 2 * wv + 2; ++tile) {
        const int ti = tile >> 2, si = tile & 3; f32x4 acc = {0.f, 0.f, 0.f, 0.f};
        if (si <= ti) {
#pragma unroll
            for (int ks = 0; ks < 3; ++ks) { const bf16x8 a = *(const LAS bf16x8*)(QP + (16 * ti + fr) * 104 + 32 * ks + 8 * fq), b2 = *(const LAS bf16x8*)(KP + (16 * si + fr) * 104 + 32 * ks + 8 * fq); acc = MFMA16(a, b2, acc); }
        }
#pragma unroll
        for (int j = 0; j < 4; ++j) { const int t = 16 * ti + 4 * fq + j, s2 = 16 * si + fr; ATT[t * 72 + s2] = f2bf(s2 <= t ? acc[j] : 0.f); }
    }
    __syncthreads();
    for (int tile = wv; tile < 24; tile += 8) {
        const int ti = tile / 6, vi = tile % 6; f32x4 acc = {0.f, 0.f, 0.f, 0.f};
#pragma unroll
        for (int ks = 0; ks < 2; ++ks) { const bf16x8 a = *(const LAS bf16x8*)(ATT + (16 * ti + fr) * 72 + 32 * ks + 8 * fq), b2 = *(const LAS bf16x8*)(VT + (16 * vi + fr) * 72 + 32 * ks + 8 * fq); acc = MFMA16(a, b2, acc); }
#pragma unroll
        for (int ks = 0; ks < 3; ++ks) { const bf16x8 a = *(const LAS bf16x8*)(QP + (16 * ti + fr) * 104 + 32 * ks + 8 * fq), b2 = *(const LAS bf16x8*)(ST + (16 * vi + fr) * 104 + 32 * ks + 8 * fq); acc = MFMA16(a, b2, acc); }
#pragma unroll
        for (int j = 0; j < 4; ++j) OT[(16 * ti + 4 * fq + j) * 96 + 16 * vi + fr] = acc[j];
    }
    __syncthreads();
    bf16_t* oc = (bf16_t*)(p.ws + WS_OC);
    const float* gn = p.in[I_GLAN] + l * 384 + h * 96; const float gn0 = gn[lane], gn1 = lane < 32 ? gn[64 + lane] : 0.f;
    float g0[8], g1[8];
#pragma unroll
    for (int tt = 0; tt < 8; ++tt) { const int t = wv * 8 + tt; g0[tt] = 0.f; g1[tt] = 0.f;
        if (t < ntok) { const bf16_t* gp = proj + (row0 + t) * NINP + C_GC + h * 96; g0[tt] = bf2f(gp[lane]); if (lane < 32) g1[tt] = bf2f(gp[64 + lane]); } }
#pragma unroll
    for (int tt = 0; tt < 8; ++tt) {
        const int t = wv * 8 + tt;
        if (t < ntok) {
            const float a0 = OT[t * 96 + lane], a1 = lane < 32 ? OT[t * 96 + 64 + lane] : 0.f;
            const float rs = rsqrtf(wave_sum(a0 * a0 + a1 * a1) * (1.f / 96.f) + EPS);
            oc[(row0 + t) * 384 + h * 96 + lane] = f2bf(a0 * rs * gn0 * g0[tt] * sigmoidf_(g0[tt]));
            if (lane < 32) oc[(row0 + t) * 384 + h * 96 + 64 + lane] = f2bf(a1 * rs * gn1 * g1[tt] * sigmoidf_(g1[tt]));
        }
    }
}

DI void cross_sample_unit(const Ctx& p, int l, int b, int h, int qh, LAS unsigned char* lds) {
    LAS float* qs = (LAS float*)lds;
    LAS float* ST = qs + 8 * 256;
    LAS float* PART = ST + 256 * 8;
    const bf16_t* Q = (const bf16_t*)(p.ws + WS_Q);
    const int tid = pg8::tid_(), lane = tid & 63, wv = tid >> 6;
    const size_t srow = (size_t)MP + b * 16 + 8 * qh;
    for (int i = tid; i < 8 * 256; i += NTHR) qs[i] = bf2f(Q[(srow + (i >> 8)) * D + h * 256 + (i & 255)]) * 0.0625f;
    __syncthreads();
    const int m = tid & 255, half = tid >> 8;
    {
        float acc[8];
#pragma unroll
        for (int i = 0; i < 8; ++i) acc[i] = 0.f;
        const float* kp = p.in[I_CMK] + ((((size_t)l * DB + b) * 256 + m) * 4 + h) * 256 + 128 * half;
#pragma unroll 8
        for (int d4 = 0; d4 < 32; ++d4) {
            const f32x4 kv = *(const f32x4*)(kp + 4 * d4);
#pragma unroll
            for (int i = 0; i < 8; ++i) { const f32x4 q = *(const LAS f32x4*)(qs + i * 256 + 128 * half + 4 * d4); acc[i] += (q[0] * kv[0] + q[1] * kv[1]) + (q[2] * kv[2] + q[3] * kv[3]); }
        }
#pragma unroll
        for (int i = 0; i < 8; ++i) PART[(half * 8 + i) * 256 + m] = acc[i];
    }
    __syncthreads();
    {
        const int i = wv; float v[4], mx = -3.0e38f;
#pragma unroll
        for (int j = 0; j < 4; ++j) { v[j] = PART[i * 256 + lane + 64 * j] + PART[(8 + i) * 256 + lane + 64 * j]; mx = fmaxf(mx, v[j]); }
        mx = wave_max(mx); float sum = 0.f;
#pragma unroll
        for (int j = 0; j < 4; ++j) { v[j] = __expf(v[j] - mx); sum += v[j]; }
        sum = wave_sum(sum); const float inv = 1.f / sum;
#pragma unroll
        for (int j = 0; j < 4; ++j) ST[(lane + 64 * j) * 8 + i] = v[j] * inv;
    }
    __syncthreads();
    {
        float acc[8];
#pragma unroll
        for (int i = 0; i < 8; ++i) acc[i] = 0.f;
        const float* vp = p.in[I_CMV] + ((((size_t)l * DB + b) * 256 + 128 * half) * 4 + h) * 256 + m;
        for (int k0 = 0; k0 < 128; k0 += 8) {
            float v[8];
#pragma unroll
            for (int j = 0; j < 8; ++j) v[j] = vp[(size_t)(k0 + j) * 1024];
#pragma unroll
            for (int j = 0; j < 8; ++j) {
                const f32x4 s0 = *(const LAS f32x4*)(ST + (128 * half + k0 + j) * 8), s1 = *(const LAS f32x4*)(ST + (128 * half + k0 + j) * 8 + 4);
                acc[0] += s0[0] * v[j]; acc[1] += s0[1] * v[j]; acc[2] += s0[2] * v[j]; acc[3] += s0[3] * v[j];
                acc[4] += s1[0] * v[j]; acc[5] += s1[1] * v[j]; acc[6] += s1[2] * v[j]; acc[7] += s1[3] * v[j];
            }
        }
#pragma unroll
        for (int i = 0; i < 8; ++i) PART[(half * 8 + i) * 256 + m] = acc[i];
    }
    __syncthreads();
    bf16_t* O = (bf16_t*)(p.ws + WS_O);
    for (int i = tid; i < 8 * 256; i += NTHR) { const int qi = i >> 8, d = i & 255; O[(srow + qi) * D + h * 256 + d] = f2bf(PART[qi * 256 + d] + PART[(8 + qi) * 256 + d]); }
}

struct SkBf16 { bf16_t* O; int ldc; DI void operator()(int row, int col, f32x4 v) const { u32x2 w; w.x = pk2(v[0], v[1]); w.y = pk2(v[2], v[3]); *(u32x2*)(O + (size_t)(MP + row) * ldc + col) = w; } };
struct SkGate { bf16_t* merged; const bf16_t* proj; int goff; int accum;
    DI void operator()(int row, int col, f32x4 v) const {
        const u32x2 g = *(const u32x2*)(proj + (size_t)(MP + row) * NINP + goff + col); bf16_t* mp = merged + (size_t)(MP + row) * D + col;
        u32x2 pm2 = {0u, 0u}; if (accum) pm2 = *(const u32x2*)mp;
        u32x2 w; w.x = pk2(sigmoidf_(bflo(g.x)) * v[0] + bflo(pm2.x), sigmoidf_(bfhi(g.x)) * v[1] + bfhi(pm2.x)); w.y = pk2(sigmoidf_(bflo(g.y)) * v[2] + bflo(pm2.y), sigmoidf_(bfhi(g.y)) * v[3] + bfhi(pm2.y));
        *(u32x2*)mp = w; } };
template <class EF> DI void skinny_gemm(const bf16_t* A, int lda, const bf16_t* Bt, int ldb, int K, int N, int G, int bx, LAS unsigned char* lds, const EF& ef) {
    const int tid = pg8::tid_(), lane = tid & 63, wv = tid >> 6, fr = lane & 15, fq = lane >> 4, nks = K >> 5, nunits = 4 * (N >> 4);
    LAS f32x4* red = (LAS f32x4*)lds;
    for (int u = bx; u < nunits; u += G) {
        const int rb = u & 3, cb = u >> 2;
        f32x4 acc[4];
#pragma unroll
        for (int i = 0; i < 4; ++i) acc[i] = (f32x4){0.f, 0.f, 0.f, 0.f};
        const bf16_t* bp = Bt + (size_t)(16 * cb + fr) * ldb + 8 * fq; const bf16_t* ap = A + (size_t)(64 * rb + fr) * lda + 8 * fq;
        for (int ks = wv; ks < nks; ks += 8) {
            const bf16x8 bb = *(const bf16x8*)(bp + 32 * ks);
            bf16x8 aa[4];
#pragma unroll
            for (int i = 0; i < 4; ++i) aa[i] = *(const bf16x8*)(ap + (size_t)(16 * i) * lda + 32 * ks);
#pragma unroll
            for (int i = 0; i < 4; ++i) acc[i] = MFMA16(bb, aa[i], acc[i]);
        }
#pragma unroll
        for (int i = 0; i < 4; ++i) red[(wv * 4 + i) * 64 + lane] = acc[i];
        __syncthreads();
        if (tid < 256) {
            const int i = tid >> 6; f32x4 s = red[i * 64 + lane];
#pragma unroll
            for (int w = 1; w < 8; ++w) s = s + red[(w * 4 + i) * 64 + lane];
            ef(64 * rb + 16 * i + fr, 16 * cb + 4 * fq, s);
        }
        __syncthreads();
    }
}

constexpr int PH_PER_LAYER = 15, N_PHASES = 1 + DEPTH * PH_PER_LAYER;
#define RUN_GEMM(EpiT, E, Aptr, lda_, Bptr, ldb_, K_, pm0_, nM_, nN_) do { const pg8::Gemm g_{(K_), (lda_), (ldb_)}; pg8::TileOrder S_; S_.init((Aptr), (lda_), (Bptr), (ldb_), (pm0_), (nM_), (nN_), G, bx); \
        pg8::gemm_phase<EpiT, pg8::TileOrder, true, true>(lds, g_, S_, (E)); } while (0)

__global__ void __launch_bounds__(NTHR, 2) fwd_kernel(Params p) {
    extern __shared__ __attribute__((aligned(16))) unsigned char lds_raw[];
#define PROJ ((bf16_t*)(ws + WS_PROJ))
#define H ((bf16_t*)(ws + WS_H))
#define MERGED ((bf16_t*)(ws + WS_MERGED))
#define Y ((bf16_t*)(ws + WS_Y))
#define QB ((bf16_t*)(ws + WS_Q))
#define PB ((bf16_t*)(ws + WS_P))
#define OB ((bf16_t*)(ws + WS_O))
#define ACT ((bf16_t*)(ws + WS_ACT))

    {
        volatile LAS unsigned* st0 = (volatile LAS unsigned*)((LAS unsigned char*)lds_raw + LDS_MISC + 32);
        if (pg8::tid_() == 0) { st0[0] = 0u; st0[1] = 0u; st0[8] = 0u; st0[9] = 0u; }
        __syncthreads();
    }
    XcdBarrier xbar = xcd_barrier_post((unsigned*)(p.ws + WS_CTL) + CW_BAR, (volatile LAS unsigned*)((LAS unsigned char*)lds_raw + LDS_MISC + 32));
    if (p.ph_lo == 0) {
        prologue(p, (LAS unsigned char*)lds_raw);
        if (blockIdx.x == 0 && pg8::tid_() == 0) {
            const float** tab = (const float**)(p.ws + WS_TAB);
#pragma unroll
            for (int i = 0; i < N_IN; ++i) tab[i] = p.in[i];
        }
        if (p.ph_hi > 1) cg::this_grid().sync();
    }
    for (int ph = p.ph_lo > 1 ? p.ph_lo : 1; ph < p.ph_hi; ++ph) {
        unsigned ldsb = (unsigned)(size_t)(LAS unsigned char*)lds_raw; asm volatile("" : "+s"(ldsb));
        LAS unsigned char* lds = (LAS unsigned char*)(size_t)ldsb;
        volatile LAS int* slot = (volatile LAS int*)(lds + LDS_MISC);
        unsigned char* ws = p.ws; asm volatile("" : "+s"(ws));
        Ctx c; c.ws = ws; c.in.t = (const float* const*)(ws + WS_TAB); c.out = p.out;
        unsigned* ctl = (unsigned*)(ws + WS_CTL);
        int G = gridDim.x, bx = blockIdx.x; asm volatile("" : "+s"(G), "+s"(bx));
        {
            const int l = (ph - 1) / PH_PER_LAYER, st = (ph - 1) % PH_PER_LAYER;
#ifdef PROBE_SEL
            if (bx == 0) { volatile LAS unsigned long long* a_ = (volatile LAS unsigned long long*)(lds + LDS_MISC + 64); a_[1] = __builtin_amdgcn_s_memrealtime(); }
#endif
            switch (st) {
            case 0: {
                EpiBf16 E{PROJ, NINP, 0xffff};
                RUN_GEMM(EpiBf16, E, H, D, ws + WS_WIN + l * SZ_WIN, D, D, 0, MA / 256, NINP / 256);
                if (l == 0) {
                    const pg8::Gemm g{D, D, D}; MemKvOrder S{G, bx, (const char*)(ws + WS_MN), (const char*)(ws + WS_WKV)};
                    EpiBf16 E2{(bf16_t*)(ws + WS_MKV), 2048, 7};
                    pg8::gemm_phase<EpiBf16, MemKvOrder, true, true>(lds, g, S, E2);
                }
            } break;
            case 1: {
                unsigned* ctr = ctl + 64 * ph;
                constexpr int U_SBP = 384, U_SBS = U_SBP + DB * 6, U_GLA = U_SBS + NGU, U_POOL = U_GLA + MA / 64, U_KV = U_POOL + MA / 64, U_MO = U_KV + 512, U_VT = U_MO + 512;
                const int U_ALL = l == 0 ? U_VT : U_KV;
                for (;;) {
                    const int u = next_work(ctr, slot); if (u >= U_ALL) break;
#ifdef PROBE_SEL
                    const int ut_ = u < DB * 6 ? 10 : (u < U_SBS ? 11 : (u < U_GLA ? 12 : 13));
                    if (bx == 0 && ut_ == PROBE_SEL) { volatile LAS unsigned long long* a_ = (volatile LAS unsigned long long*)(lds + LDS_MISC + 64); a_[3] = __builtin_amdgcn_s_memrealtime(); }
#endif
                    if (u < DB * 6) sb_sample_unit(c, l, u / 6, u % 6, lds);
                    else if (u < U_SBS) { const int v = u - DB * 6, qb = 7 - v / 48, bh = v % 48; sb_prompt_unit(c, bh / 6, bh % 6, qb, lds); }
                    else if (u < U_GLA) gla_stage1_unit(c, l, u - U_SBS, lds);
                    else if (u < U_POOL) pool_unit(c, l, u - U_GLA);
                    else if (u < U_KV) kvout_unit(c, l, u - U_POOL);
                    else if (u < U_MO) memout_unit(c, u - U_KV);
                    else memvt_unit(c, u - U_MO);
#ifdef PROBE_SEL
                    if (bx == 0 && ut_ == PROBE_SEL) { volatile LAS unsigned long long* a_ = (volatile LAS unsigned long long*)(lds + LDS_MISC + 64); __hip_atomic_fetch_add((LAS unsigned long long*)a_, __builtin_amdgcn_s_memrealtime() - a_[3], __ATOMIC_RELAXED, __HIP_MEMORY_SCOPE_WORKGROUP); }
#endif
                }
            } break;
            case 2: gla_scan(c, l); break;
            case 3: {
                unsigned* ctr = ctl + 64 * ph;
                for (;;) { const int u = next_work(ctr, slot); if (u >= NGU) break; gla_stage3_unit(c, l, u, lds); }
            } break;
            case 4: {
                EpiGate E1{MERGED, PROJ, C_GA, 0}, E2{MERGED, PROJ, C_GB, 1}, E3{MERGED, PROJ, C_GCG, 1};
                RUN_GEMM(EpiGate, E1, ws + WS_OA, 384, ws + WS_WBA + l * SZ_WBA, 384, 384, 0, MP / 256, 4);
                RUN_GEMM(EpiGate, E2, ws + WS_POOLED, 256, ws + WS_WBB + l * SZ_WBB, 256, 256, 0, MP / 256, 4);
                RUN_GEMM(EpiGate, E3, ws + WS_OC, 384, ws + WS_WBC + l * SZ_WBA, 384, 384, 0, MP / 256, 4);
                { SkGate F1{MERGED, PROJ, C_GA, 0}, F2{MERGED, PROJ, C_GB, 1}, F3{MERGED, PROJ, C_GCG, 1};
                  skinny_gemm((const bf16_t*)(ws + WS_OA) + (size_t)MP * 384, 384, (const bf16_t*)(ws + WS_WBA + l * SZ_WBA), 384, 384, D, G, bx, lds, F1);
                  skinny_gemm((const bf16_t*)(ws + WS_POOLED) + (size_t)MP * 256, 256, (const bf16_t*)(ws + WS_WBB + l * SZ_WBB), 256, 256, D, G, bx, lds, F2);
                  skinny_gemm((const bf16_t*)(ws + WS_OC) + (size_t)MP * 384, 384, (const bf16_t*)(ws + WS_WBC + l * SZ_WBA), 384, 384, D, G, bx, lds, F3); }
            } break;
            case 5: { EpiBf16 E{Y, D, 0xffff}; RUN_GEMM(EpiBf16, E, MERGED, D, ws + WS_WMIX + l * SZ_WSQ, D, D, 0, MP / 256, 4);
                SkBf16 F{Y, D}; skinny_gemm((const bf16_t*)MERGED + (size_t)MP * D, D, (const bf16_t*)(ws + WS_WMIX + l * SZ_WSQ), D, D, D, G, bx, lds, F); } break;
            case 6: norm_phase(c, c.in[I_NMIXPOST] + l * D, c.in[I_NXPRE] + l * D, G, bx); break;
            case 7: { EpiBf16 E{QB, D, 0xffff}; RUN_GEMM(EpiBf16, E, H, D, ws + WS_WXQ + l * SZ_WSQ, D, D, 0, MP / 256, 4);
                SkBf16 F{QB, D}; skinny_gemm((const bf16_t*)H + (size_t)MP * D, D, (const bf16_t*)(ws + WS_WXQ + l * SZ_WSQ), D, D, D, G, bx, lds, F); } break;
            case 8: {
                const pg8::Gemm g{256, D, 2048}; CrossOrder S{G, bx, (const char*)QB, (const char*)(ws + WS_MKV + (size_t)l * 2 * SZ_WKV), 0};
                EpiSoftmax E{PB, (LAS float*)(lds + LDS_X)};
                pg8::gemm_phase<EpiSoftmax, CrossOrder, true, true>(lds, g, S, E);
            } break;
            case 9: {
                const pg8::Gemm g{256, D, 2048}; CrossOrder S{G, bx, (const char*)PB, (const char*)(ws + WS_MEMVT + (size_t)l * SZ_WKV), 1};
                EpiBf16 E{OB, D, 0xffff};
                pg8::gemm_phase<EpiBf16, CrossOrder, true, true>(lds, g, S, E);
                for (int u = bx; u < DB * 4 * 2; u += G) { __syncthreads(); cross_sample_unit(c, l, u >> 3, (u >> 1) & 3, u & 1, lds); }
            } break;
            case 10: { EpiBf16 E{Y, D, 0xffff}; RUN_GEMM(EpiBf16, E, OB, D, ws + WS_WXO + l * SZ_WSQ, D, D, 0, MP / 256, 4);
                SkBf16 F{Y, D}; skinny_gemm((const bf16_t*)OB + (size_t)MP * D, D, (const bf16_t*)(ws + WS_WXO + l * SZ_WSQ), D, D, D, G, bx, lds, F); } break;
            case 11: norm_phase(c, c.in[I_NXPOST] + l * D, c.in[I_NFPRE] + l * D, G, bx); break;
            case 12: { EpiSwiglu E{ACT}; RUN_GEMM(EpiSwiglu, E, H, D, ws + WS_WF1 + l * SZ_WF1, D, D, 0, MA / 256, FF2 / 256); } break;
            case 13: { EpiBf16 E{Y, D, 0xffff}; RUN_GEMM(EpiBf16, E, ACT, FF, ws + WS_WF2 + l * SZ_WF2, FF, FF, 0, MP / 256, 4);
                SkBf16 F{Y, D}; skinny_gemm((const bf16_t*)ACT + (size_t)MP * FF, FF, (const bf16_t*)(ws + WS_WF2 + l * SZ_WF2), FF, FF, D, G, bx, lds, F); } break;
            default: norm_phase(c, c.in[I_NFPOST] + l * D, l < DEPTH - 1 ? c.in[I_NMIXPRE] + (l + 1) * D : nullptr, G, bx); break;
            }
#ifdef PROBE_SEL
            {
                const int sel = PROBE_SEL; bool hit = false;
                if (sel == 2) hit = (st == 0 || st == 4 || st == 5 || st == 7 || st == 10 || st == 12 || st == 13);
                if (sel == 3) hit = (st == 2 || st == 3);
                if (sel == 4) hit = (st == 8 || st == 9);
                if (sel == 5) hit = (st == 6 || st == 11 || st == 14);
                if (sel == 6) hit = (st == 1);
                if (sel == 7) hit = (st == 0);
                if (sel == 8) hit = (st == 12);
                if (sel == 9) hit = (st == 13);
                if (bx == 0 && hit) { volatile LAS unsigned long long* a_ = (volatile LAS unsigned long long*)(lds + LDS_MISC + 64); __hip_atomic_fetch_add((LAS unsigned long long*)a_, __builtin_amdgcn_s_memrealtime() - a_[1], __ATOMIC_RELAXED, __HIP_MEMORY_SCOPE_WORKGROUP); }
            }
#endif
        }
#ifdef PROBE_SEL
        if (bx == 0) { volatile LAS unsigned long long* a_ = (volatile LAS unsigned long long*)(lds + LDS_MISC + 64); a_[2] = __builtin_amdgcn_s_memrealtime(); }
#endif
        if (ph + 1 < p.ph_hi) { if ((ph - 1) % PH_PER_LAYER == 8) { __threadfence(); __syncthreads(); } else xcd_barrier(xbar); }
#ifdef PROBE_SEL
        if (PROBE_SEL == 1 && bx == 0) { volatile LAS unsigned long long* a_ = (volatile LAS unsigned long long*)(lds + LDS_MISC + 64); __hip_atomic_fetch_add((LAS unsigned long long*)a_, __builtin_amdgcn_s_memrealtime() - a_[2], __ATOMIC_RELAXED, __HIP_MEMORY_SCOPE_WORKGROUP); }
#endif
    }
#ifdef PROBE_SEL
    __syncthreads();
    if (blockIdx.x == 0) {
        volatile LAS unsigned long long* a_ = (volatile LAS unsigned long long*)((LAS unsigned char*)lds_raw + LDS_MISC + 64);
        const unsigned long long d_ = a_[0] >> 9, s_ = __builtin_amdgcn_s_memrealtime();
        while (__builtin_amdgcn_s_memrealtime() - s_ < d_) __builtin_amdgcn_s_sleep(8);
    }
#endif
}

extern "C" void kernel_launch(void* const* d_in, const int* in_sizes, int n_in, void* d_out, int out_size, void* d_ws, size_t ws_size, hipStream_t stream) {
    static int grid = 0;
    if (grid == 0) {
        if (n_in != N_IN || (size_t)out_size != O_END || ws_size < WS_END) { fprintf(stderr, "kernel_launch: unexpected shapes: n_in %d out %d ws %zu (need %zu)\n", n_in, out_size, ws_size, (size_t)WS_END); grid = -1; return; }
        int dev = 0, cus = 0, per_cu = 0;
        (void)hipGetDevice(&dev); (void)hipDeviceGetAttribute(&cus, hipDeviceAttributeMultiprocessorCount, dev);
        (void)hipFuncSetAttribute((const void*)fwd_kernel, hipFuncAttributeMaxDynamicSharedMemorySize, LDS_BYTES);
        if (hipOccupancyMaxActiveBlocksPerMultiprocessor(&per_cu, (const void*)fwd_kernel, NTHR, LDS_BYTES) != hipSuccess || per_cu < 1) { fprintf(stderr, "kernel_launch: occupancy query gave %d\n", per_cu); per_cu = 1; }
        (void)hipGetLastError();
        grid = cus * per_cu;
    }
    if (grid < 0) return;
    (void)hipMemsetAsync((char*)d_ws + WS_CTL, 0, CTL_BYTES, stream);
    Params p{};
    for (int i = 0; i < N_IN; ++i) p.in[i] = (const float*)d_in[i];
    p.out = (float*)d_out; p.ws = (unsigned char*)d_ws;
#ifdef MULTI_LAUNCH
    for (int ph = 0; ph < N_PHASES; ++ph) { p.ph_lo = ph; p.ph_hi = ph + 1; hipLaunchKernelGGL(fwd_kernel, dim3(grid), dim3(NTHR), LDS_BYTES, stream, p); }
#else
    p.ph_lo = 0; p.ph_hi = N_PHASES;
    void* args[] = {&p};
    const hipError_t e = hipLaunchCooperativeKernel((const void*)fwd_kernel, dim3(grid), dim3(NTHR), args, LDS_BYTES, stream);
    if (e != hipSuccess) fprintf(stderr, "kernel_launch: cooperative launch failed: %s (grid %d)\n", hipGetErrorString(e), grid);
#endif
}
```

```cpp
#include <hip/hip_runtime.h>
#include <hip/hip_cooperative_groups.h>
#include <cstdio>
#include <cstdint>
namespace cg = cooperative_groups;

namespace pg8 {
#define PG8_LAS __attribute__((address_space(3)))
typedef unsigned short bf16_t;
typedef short bf16x8 __attribute__((ext_vector_type(8)));
typedef float f32x4 __attribute__((ext_vector_type(4)));
typedef unsigned u32x4 __attribute__((ext_vector_type(4)));
typedef unsigned u32x2 __attribute__((ext_vector_type(2)));
constexpr int BM = 256, BK = 64, HALF = 128, HTB = HALF * BK * 2  , STAGE_BYTES = 8 * HTB, NXCD = 8, WGM = 8;

__host__ __device__ __forceinline__ int lds_byte(int r, int c) { const int st = (r >> 4) * 2 + (c >> 5), rr = r & 15, cc = c & 31, ob = rr * 64 + cc * 2; return st * 1024 + (ob ^ (((ob >> 9) & 1) << 5)); }
__host__ __device__ __forceinline__ void stage_rc(int b, int& R, int& C) { const int st = b / 1024, sb = b % 1024, swz = sb ^ (((sb >> 9) & 1) << 5); R = (st >> 1) * 16 + swz / 64; C = (st & 1) * 32 + (swz % 64) / 2; }
__host__ __device__ __forceinline__ int perm32(int rho) { const int n = rho >> 4, i = rho & 15; return 8 * (i >> 2) + 4 * n + (i & 3); }

struct Unit { int pm, pn; const char* a; const char* b; };
struct Gemm { int K, lda, ldb; };

struct TileOrder {
    int nM, nN, G, c, lda, ldb; const char* A; const char* B;
    __device__ void init(const void* A_, int lda_, const void* B_, int ldb_, int, int nM_, int nN_, int G_, int c_) {
        A = (const char*)A_; B = (const char*)B_; lda = lda_; ldb = ldb_; nM = nM_; nN = nN_; G = G_; c = c_; }
    __device__ bool next(int i, Unit& u) const {
        const int nwg = nM * nN; const long L = (long)i * G + c; if (L >= nwg) return false;
        int wgid = (int)L; { const int q = nwg / NXCD, r = nwg % NXCD, xcd = wgid % NXCD, off = wgid / NXCD; wgid = (xcd < r ? xcd * (q + 1) : r * (q + 1) + (xcd - r) * q) + off; }
        const int nig = WGM * nN, gid = wgid / nig, fm = gid * WGM, gsz = (nM - fm) < WGM ? (nM - fm) : WGM;
        u.pm = fm + ((wgid % nig) % gsz); u.pn = (wgid % nig) / gsz; u.a = A + (size_t)u.pm * ((size_t)BM * 2 * lda); u.b = B + (size_t)u.pn * ((size_t)BM * 2 * ldb); return true;
    }
    __device__ __forceinline__ void a_ready(const Unit&) const {}
    __device__ __forceinline__ void done(const Unit&) const {}
};

__device__ __forceinline__ int tid_() { int t = threadIdx.x; asm volatile("" : "+v"(t)); return t; }
__device__ __forceinline__ unsigned cvt_pk_bf16(float lo, float hi) { unsigned r; asm volatile("v_cvt_pk_bf16_f32 %0, %1, %2" : "=v"(r) : "v"(lo), "v"(hi)); return r; }

template <class Epi, class Sched, bool ALIGN_EPI = false, bool SP2 = false>
__device__ __forceinline__ void gemm_phase(PG8_LAS unsigned char* lds, const Gemm g, const Sched& S, const Epi& E) {
    const int tid = pg8::tid_(), wid = __builtin_amdgcn_readfirstlane(tid >> 6), lane = tid & 63, wr = wid >> 2, wc = wid & 3, fr = lane & 15, fq = lane >> 4;
    const int K = g.K, nt = K / BK;
    unsigned voffA, voffB;
    { int R, C; stage_rc(tid * 16, R, C); const int Rb = Epi::PERM ? ((R & ~31) + perm32(R & 31)) : R;
        voffA = (unsigned)(R * g.lda + C) * 2u; voffB = (unsigned)(Rb * g.ldb + C) * 2u; }
    const size_t qstepA = (size_t)64 * g.lda * 2, qstepB = (size_t)64 * g.ldb * 2;
    const size_t kstep = (size_t)(BK * 2);
    const size_t hstepA = (size_t)HALF * g.lda * 2, hstepB = (size_t)HALF * g.ldb * 2;
    const unsigned ldsw = (unsigned)wid * 1024u;
    const int aoff = lds_byte(wr * 64 + fr, fq * 8), boff = lds_byte(wc * 32 + fr, fq * 8);
#define PG8_SA(b, h) (((b) * 2 + (h)) * HTB)
#define PG8_SB(b, h) ((4 + (b) * 2 + (h)) * HTB)
#define PG8_STAGE(bufoff, gbase, voff) do { _Pragma("unroll") for (int _i = 0; _i < 2; ++_i) { const char* sb_ = (const char*)(gbase) + (size_t)_i * q##voff; asm volatile("" : "+s"(sb_));   \
        __builtin_amdgcn_global_load_lds((const unsigned*)(sb_ + (voff)), (PG8_LAS unsigned*)(lds + (bufoff) + ldsw + _i * 8192), 16, 0, 0); } } while (0)
#define qvoffA qstepA
#define qvoffB qstepB
#define PG8_LDA(dst, b, h) do { _Pragma("unroll") for (int m = 0; m < 4; ++m) _Pragma("unroll") for (int k = 0; k < 2; ++k) dst[m][k] = *(const PG8_LAS bf16x8*)(lds + PG8_SA(b, h) + aoff + m * 2048 + k * 1024); } while (0)
#define PG8_LDB(dst, b, h) do { _Pragma("unroll") for (int n = 0; n < 2; ++n) _Pragma("unroll") for (int k = 0; k < 2; ++k) dst[n][k] = *(const PG8_LAS bf16x8*)(lds + PG8_SB(b, h) + boff + n * 2048 + k * 1024); } while (0)
#define PG8_MMA(ai, bj, At, Bt) do { __builtin_amdgcn_s_setprio(1); _Pragma("unroll") for (int m = 0; m < 4; ++m) _Pragma("unroll") for (int n = 0; n < 2; ++n) _Pragma("unroll") for (int k = 0; k < 2; ++k) \
        acc[ai][bj][m][n] = __builtin_amdgcn_mfma_f32_16x16x32_bf16(Bt[n][k], At[m][k], acc[ai][bj][m][n], 0, 0, 0); __builtin_amdgcn_s_setprio(0); } while (0)
#define PG8_WAIT_V(n) asm volatile("s_waitcnt vmcnt(" #n ")" ::: "memory")
#define PG8_WAIT_L(n) asm volatile("s_waitcnt lgkmcnt(" #n ")" ::: "memory")
#define PG8_BAR __builtin_amdgcn_s_barrier()
#define PG8_SCHED __builtin_amdgcn_sched_barrier(0)
    Unit cur, nxt; int ui = 0;
    if (!S.next(0, cur)) return;
    f32x4 acc[2][2][4][2];
#pragma unroll
    for (int a = 0; a < 2; ++a)
#pragma unroll
        for (int b = 0; b < 2; ++b)
#pragma unroll
            for (int m = 0; m < 4; ++m)
#pragma unroll
                for (int n = 0; n < 2; ++n) acc[a][b][m][n] = (f32x4){0.f, 0.f, 0.f, 0.f};
    bf16x8 At[4][2], B0[2][2], B1[2][2];
    const char* cA = cur.a; const char* cB = cur.b;
    S.a_ready(cur);
    if constexpr (SP2) {
        PG8_STAGE(PG8_SB(0, 0), cB, voffB); PG8_STAGE(PG8_SB(0, 1), cB + hstepB, voffB); PG8_STAGE(PG8_SA(0, 0), cA, voffA); PG8_STAGE(PG8_SA(0, 1), cA + hstepA, voffA);
        if (wr == 1) PG8_BAR;
        PG8_WAIT_V(2); PG8_BAR;
        PG8_STAGE(PG8_SB(1, 0), cB + kstep, voffB); PG8_STAGE(PG8_SA(1, 0), cA + kstep, voffA); PG8_STAGE(PG8_SB(1, 1), cB + hstepB + kstep, voffB);
        PG8_WAIT_V(6); PG8_BAR;
    } else {
        PG8_STAGE(PG8_SB(0, 0), cB, voffB); PG8_STAGE(PG8_SA(0, 0), cA, voffA); PG8_STAGE(PG8_SB(0, 1), cB + hstepB, voffB); PG8_STAGE(PG8_SA(0, 1), cA + hstepA, voffA);
        if (wr == 1) PG8_BAR;
        PG8_WAIT_V(4); PG8_BAR;
        PG8_STAGE(PG8_SB(1, 0), cB + kstep, voffB); PG8_STAGE(PG8_SA(1, 0), cA + kstep, voffA); PG8_STAGE(PG8_SB(1, 1), cB + hstepB + kstep, voffB);
        PG8_WAIT_V(6); PG8_BAR;
    }
    for (;;) {
        const bool has_next = S.next(ui + 1, nxt);
        const char* nA = has_next ? nxt.a : cA; const char* nB = has_next ? nxt.b : cB;
        for (int t = 0; t < nt; t += 2) {
            const bool last = (t == nt - 2);
            const char* a1 = cA + (size_t)(t + 1) * kstep;
            const char* a2 = last ? nA : cA + (size_t)(t + 2) * kstep; const char* b2 = last ? nB : cB + (size_t)(t + 2) * kstep;
            const char* a3 = a2 + kstep; const char* b3 = b2 + kstep;
            if (last && has_next) S.a_ready(nxt);
            if constexpr (SP2) {
            PG8_LDB(B0, 0, 0); PG8_LDB(B1, 0, 1); PG8_SCHED; PG8_LDA(At, 0, 0); PG8_STAGE(PG8_SA(1, 1), a1 + hstepA, voffA);
            PG8_WAIT_V(8); PG8_WAIT_L(0); PG8_BAR; PG8_MMA(0, 0, At, B0); PG8_MMA(0, 1, At, B1); PG8_BAR; PG8_SCHED;
            PG8_LDA(At, 0, 1); PG8_STAGE(PG8_SB(0, 0), b2, voffB); PG8_STAGE(PG8_SB(0, 1), b2 + hstepB, voffB); PG8_STAGE(PG8_SA(0, 0), a2, voffA);
            PG8_WAIT_V(8); PG8_WAIT_L(0); PG8_BAR; PG8_MMA(1, 0, At, B0); PG8_MMA(1, 1, At, B1); PG8_BAR; PG8_SCHED;
            PG8_LDB(B0, 1, 0); PG8_LDB(B1, 1, 1); PG8_SCHED; PG8_LDA(At, 1, 0); PG8_STAGE(PG8_SA(0, 1), a2 + hstepA, voffA);
            PG8_WAIT_V(8); PG8_WAIT_L(0); PG8_BAR; PG8_MMA(0, 0, At, B0); PG8_MMA(0, 1, At, B1); PG8_BAR; PG8_SCHED;
            PG8_LDA(At, 1, 1); PG8_STAGE(PG8_SB(1, 0), b3, voffB); PG8_STAGE(PG8_SB(1, 1), b3 + hstepB, voffB); PG8_STAGE(PG8_SA(1, 0), a3, voffA);
            PG8_WAIT_V(8); PG8_WAIT_L(0); PG8_BAR; PG8_MMA(1, 0, At, B0); PG8_MMA(1, 1, At, B1); PG8_BAR; PG8_SCHED;
            } else {
            PG8_LDB(B0, 0, 0); PG8_SCHED; PG8_LDA(At, 0, 0); PG8_STAGE(PG8_SA(1, 1), a1 + hstepA, voffA);
            PG8_WAIT_L(8); PG8_BAR; PG8_WAIT_L(0); PG8_MMA(0, 0, At, B0); PG8_BAR; PG8_SCHED;
            PG8_LDB(B1, 0, 1); PG8_STAGE(PG8_SB(0, 0), b2, voffB);
            PG8_BAR; PG8_WAIT_L(0); PG8_MMA(0, 1, At, B1); PG8_BAR;
            PG8_LDA(At, 0, 1); PG8_STAGE(PG8_SA(0, 0), a2, voffA);
            PG8_BAR; PG8_WAIT_L(0); PG8_MMA(1, 0, At, B0); PG8_BAR; PG8_SCHED;
            PG8_STAGE(PG8_SB(0, 1), b2 + hstepB, voffB);
            PG8_WAIT_V(6); PG8_BAR; PG8_MMA(1, 1, At, B1); PG8_BAR;
            PG8_LDB(B0, 1, 0); PG8_SCHED; PG8_LDA(At, 1, 0); PG8_STAGE(PG8_SA(0, 1), a2 + hstepA, voffA);
            PG8_WAIT_L(8); PG8_BAR; PG8_WAIT_L(0); PG8_MMA(0, 0, At, B0); PG8_BAR; PG8_SCHED;
            PG8_LDB(B1, 1, 1); PG8_STAGE(PG8_SB(1, 0), b3, voffB);
            PG8_BAR; PG8_WAIT_L(0); PG8_MMA(0, 1, At, B1); PG8_BAR;
            PG8_LDA(At, 1, 1); PG8_STAGE(PG8_SA(1, 0), a3, voffA);
            PG8_BAR; PG8_WAIT_L(0); PG8_MMA(1, 0, At, B0); PG8_BAR; PG8_SCHED;
            PG8_STAGE(PG8_SB(1, 1), b3 + hstepB, voffB);
            PG8_WAIT_V(6); PG8_BAR; PG8_MMA(1, 1, At, B1); PG8_BAR;
            }
        }
        if constexpr (ALIGN_EPI) { if (wr == 0) PG8_BAR; }
        if constexpr (!Epi::AFTER_DRAIN) { const int l2_ = tid_() & 63, fr2 = l2_ & 15, fq2 = l2_ >> 4;   E(acc, cur, wr, wc, fr2, fq2); S.done(cur); }
        if (!has_next) break;
#pragma unroll
        for (int a = 0; a < 2; ++a)
#pragma unroll
            for (int b = 0; b < 2; ++b)
#pragma unroll
                for (int m = 0; m < 4; ++m)
#pragma unroll
                    for (int n = 0; n < 2; ++n) acc[a][b][m][n] = (f32x4){0.f, 0.f, 0.f, 0.f};
        cur = nxt; cA = nA; cB = nB; ++ui;
        if constexpr (ALIGN_EPI) { if (wr == 1) PG8_BAR; }
    }
    PG8_WAIT_V(0);
    if constexpr (!ALIGN_EPI) { if (wr == 0) PG8_BAR; }
    PG8_BAR;
    if constexpr (Epi::AFTER_DRAIN) { E.fused(acc, cur, wr, wc, fr, fq, lds, wid, lane); S.done(cur); }
#undef PG8_SA
#undef PG8_SB
#undef PG8_STAGE
#undef qvoffA
#undef qvoffB
#undef PG8_LDA
#undef PG8_LDB
#undef PG8_MMA
#undef PG8_WAIT_V
#undef PG8_WAIT_L
#undef PG8_BAR
#undef PG8_SCHED
}
}

using pg8::bf16_t; using pg8::f32x4; using pg8::bf16x8; using pg8::u32x4; using pg8::u32x2;
#define DI __device__ __forceinline__
#define LAS __attribute__((address_space(3)))
typedef float f32x16 __attribute__((ext_vector_type(16)));
typedef short s16x4 __attribute__((ext_vector_type(4)));
typedef float f32x2_t __attribute__((ext_vector_type(2))); typedef __bf16 bf16x2_t __attribute__((ext_vector_type(2)));

constexpr int NTHR = 512, NWAVES = 8;
constexpr int D = 1024, NB = 8, SEQ = 2048, DEPTH = 4, DB = 16, DT = 16, PAST = 1024;
constexpr int MP = NB * SEQ, MS = DB * DT, MA = MP + MS;
constexpr int NIN = 6032, NINP = 6144;
constexpr int C_QA = 0, C_KA = 384, C_VA = 768, C_U = 1152, C_QC = 1408, C_KC = 1792, C_VC = 2176, C_GC = 2560, C_LR = 2944, C_GA = 2960, C_GB = 3984, C_GCG = 5008;
constexpr int FF = 2816, FF2 = 5632;
constexpr int GH = 4, GK = 96;
constexpr int NGU_P = NB * GH * 32, NGU_S = DB * GH, NGU = NGU_P + NGU_S;
constexpr float EPS = 1e-6f;

constexpr size_t O_YP = 0, O_YS = O_YP + (size_t)MP * D, O_KP = O_YS + (size_t)MS * D, O_VP = O_KP + (size_t)DEPTH * MP * 384, O_POOLP = O_VP + (size_t)DEPTH * MP * 384,
    O_GLAP = O_POOLP + (size_t)DEPTH * NB * 15 * 256, O_MKP = O_GLAP + (size_t)DEPTH * NB * GH * GK * GK, O_MVP = O_MKP + (size_t)DEPTH * NB * 256 * D,
    O_KS = O_MVP + (size_t)DEPTH * NB * 256 * D, O_VS = O_KS + (size_t)DEPTH * MS * 384, O_POOLS = O_VS + (size_t)DEPTH * MS * 384, O_GLAS = O_POOLS + (size_t)DEPTH * DB * 15 * 256,
    O_END = O_GLAS + (size_t)DEPTH * DB * GH * GK * GK;

enum { I_XP = 0, I_XS, I_MEM, I_CSK, I_CSV, I_SPOOL, I_SGLA, I_CMK, I_CMV, I_WIN, I_WA2, I_BA, I_GLAN, I_WPOOL, I_PSCALE, I_WBA, I_WBB, I_WBC, I_WMIX, I_MEMN, I_WXQ, I_WXK, I_WXV, I_WXO,
       I_WF1, I_WF2, I_NMIXPRE, I_NMIXPOST, I_NXPRE, I_NXPOST, I_NFPRE, I_NFPOST, N_IN };

constexpr size_t MiB = 1u << 20;
constexpr size_t SZ_WIN = (size_t)NINP * D * 2, SZ_WBA = (size_t)D * 384 * 2, SZ_WBB = (size_t)D * 256 * 2, SZ_WSQ = (size_t)D * D * 2, SZ_WKV = 2 * SZ_WSQ, SZ_WF1 = (size_t)FF2 * D * 2, SZ_WF2 = (size_t)D * FF * 2;
constexpr size_t WS_CTL = 0, CTL_BYTES = 1 * MiB, WS_TAB = CTL_BYTES - 4096;
constexpr size_t WS_WIN = WS_CTL + CTL_BYTES, WS_WBA = WS_WIN + 4 * SZ_WIN, WS_WBB = WS_WBA + 4 * SZ_WBA, WS_WBC = WS_WBB + 4 * SZ_WBB, WS_WMIX = WS_WBC + 4 * SZ_WBA,
    WS_WXQ = WS_WMIX + 4 * SZ_WSQ, WS_WXO = WS_WXQ + 4 * SZ_WSQ, WS_WKV = WS_WXO + 4 * SZ_WSQ, WS_WF1 = WS_WKV + 4 * SZ_WKV, WS_WF2 = WS_WF1 + 4 * SZ_WF1,
    WS_MN = WS_WF2 + 4 * SZ_WF2, WS_MKV = WS_MN + 4 * SZ_WKV, WS_MEMVT = WS_MKV + 8 * SZ_WKV, WS_PROJ = WS_MEMVT + 4 * SZ_WKV;
constexpr size_t SZ_ROWS = (size_t)MA * D * 2;
constexpr size_t SZ_PROJ = (size_t)MA * NINP * 2;
constexpr size_t WS_Q = WS_PROJ, WS_P = WS_Q + SZ_ROWS, WS_O = WS_P + SZ_ROWS, WS_ACT = WS_O + SZ_ROWS;
static_assert(WS_ACT + (size_t)MA * FF * 2 <= WS_PROJ + SZ_PROJ, "overlay fits");
constexpr size_t WS_H = WS_PROJ + SZ_PROJ, WS_MERGED = WS_H + SZ_ROWS, WS_Y = WS_MERGED + SZ_ROWS;
constexpr size_t WS_GKV = WS_H, WS_GSP = WS_GKV + 39 * MiB, WS_GDEC = WS_GSP + 37 * MiB;
static_assert((size_t)NGU * GK * GK * 4 <= 39 * MiB && (size_t)NGU_P * GK * GK * 4 <= 37 * MiB && WS_GDEC + (size_t)NGU * GK * 4 <= WS_Y + SZ_ROWS, "GLA overlay fits");
constexpr size_t WS_OA = WS_Y + SZ_ROWS, WS_POOLED = WS_OA + (size_t)MA * 384 * 2, WS_OC = WS_POOLED + (size_t)MA * 256 * 2, WS_BB = WS_OC + (size_t)MA * 384 * 2, WS_XB = WS_BB + (size_t)NGU * 64 * GK * 4, WS_END = WS_XB + SZ_ROWS;
static_assert(WS_WIN % 256 == 0 && WS_PROJ % 256 == 0 && WS_H % 256 == 0 && WS_OA % 256 == 0 && WS_POOLED % 256 == 0 && WS_OC % 256 == 0 && WS_P % 256 == 0, "alignment");

constexpr int CW_BAR = 16384;
constexpr int LDS_GEMM = 131072, LDS_X = LDS_GEMM, LDS_X_BYTES = 12288, LDS_MISC = LDS_X + LDS_X_BYTES, LDS_BYTES = LDS_MISC + 256;

struct Params { const float* in[N_IN]; float* out; unsigned char* ws; int ph_lo, ph_hi; };
struct InTab { const float* const* t;
    __device__ __forceinline__ const float* operator[](int i) const { const unsigned long long v = (unsigned long long)t[i];
        const unsigned lo = __builtin_amdgcn_readfirstlane((unsigned)v), hi = __builtin_amdgcn_readfirstlane((unsigned)(v >> 32)); return (const float*)(((unsigned long long)hi << 32) | lo); } };
struct Ctx { InTab in; float* out; unsigned char* ws; };

DI float bflo(unsigned w) { return __uint_as_float(w << 16); }
DI float bfhi(unsigned w) { return __uint_as_float(w & 0xffff0000u); }
DI float bf2f(unsigned short v) { return __uint_as_float((unsigned)v << 16); }
DI unsigned pk2(float lo, float hi) { f32x2_t v = {lo, hi}; bf16x2_t b = __builtin_convertvector(v, bf16x2_t); return __builtin_bit_cast(unsigned, b); }
DI unsigned short f2bf(float f) { return (unsigned short)(pk2(f, 0.f) & 0xffffu); }
DI float wave_sum(float v) {
#pragma unroll
    for (int o = 1; o < 64; o <<= 1) v += __shfl_xor(v, o);
    return v;
}
DI float wave_max(float v) {
#pragma unroll
    for (int o = 1; o < 64; o <<= 1) v = fmaxf(v, __shfl_xor(v, o));
    return v;
}
DI float sigmoidf_(float x) { return __builtin_amdgcn_rcpf(1.f + __expf(-x)); }
DI float softplusf_(float z) { return fmaxf(z, 0.f) + __logf(1.f + __expf(-fabsf(z))); }
DI int next_work(unsigned* ctr, volatile LAS int* slot) {
    __syncthreads();
    if (pg8::tid_() == 0) *slot = (int)atomicAdd(ctr, 1u);
    __syncthreads();
    return *slot;
}

typedef const pg8::f32x4 (&AccRef)[2][2][4][2];
struct EpiBf16 {
    static constexpr bool PERM = true, AFTER_DRAIN = false;
    bf16_t* O; int ldc; int pnmask;
    DI void operator()(AccRef acc, const pg8::Unit& u, int wr, int wc, int fr, int fq) const {
#pragma unroll
        for (int ai = 0; ai < 2; ++ai)
#pragma unroll
            for (int m = 0; m < 4; ++m) {
                bf16_t* rowp = O + (size_t)(u.pm * 256 + ai * 128 + wr * 64 + m * 16 + fr) * ldc + (u.pn & pnmask) * 256 + wc * 32 + 8 * fq;
#pragma unroll
                for (int bj = 0; bj < 2; ++bj) {
                    const f32x4 v0 = acc[ai][bj][m][0], v1 = acc[ai][bj][m][1];
                    u32x4 w; w.x = pk2(v0[0], v0[1]); w.y = pk2(v0[2], v0[3]); w.z = pk2(v1[0], v1[1]); w.w = pk2(v1[2], v1[3]);
                    *(u32x4*)(rowp + bj * 128) = w;
                }
            }
    }
};
struct EpiGate {
    static constexpr bool PERM = true, AFTER_DRAIN = false;
    bf16_t* merged; const bf16_t* proj; int goff; int accum;
    DI void operator()(AccRef acc, const pg8::Unit& u, int wr, int wc, int fr, int fq) const {
#pragma unroll
        for (int ai = 0; ai < 2; ++ai)
#pragma unroll
            for (int m = 0; m < 4; ++m) {
                const int row = u.pm * 256 + ai * 128 + wr * 64 + m * 16 + fr;
                const bf16_t* gp = proj + (size_t)row * NINP + goff + u.pn * 256 + wc * 32 + 8 * fq;
                bf16_t* mp = merged + (size_t)row * D + u.pn * 256 + wc * 32 + 8 * fq;
#pragma unroll
                for (int bj = 0; bj < 2; ++bj)
#pragma unroll
                    for (int n = 0; n < 2; ++n) {
                        const u32x2 g = *(const u32x2*)(gp + bj * 128 + 4 * n);
                        u32x2 pm2 = {0u, 0u}; if (accum) pm2 = *(const u32x2*)(mp + bj * 128 + 4 * n);
                        const f32x4 v = acc[ai][bj][m][n];
                        const float r0 = sigmoidf_(bflo(g.x)) * v[0] + bflo(pm2.x), r1 = sigmoidf_(bfhi(g.x)) * v[1] + bfhi(pm2.x);
                        const float r2 = sigmoidf_(bflo(g.y)) * v[2] + bflo(pm2.y), r3 = sigmoidf_(bfhi(g.y)) * v[3] + bfhi(pm2.y);
                        u32x2 w; w.x = pk2(r0, r1); w.y = pk2(r2, r3);
                        *(u32x2*)(mp + bj * 128 + 4 * n) = w;
                        asm volatile("" ::: "memory");
                    }
            }
    }
};
struct EpiSwiglu {
    static constexpr bool PERM = true, AFTER_DRAIN = false;
    bf16_t* act;
    DI void operator()(AccRef acc, const pg8::Unit& u, int wr, int wc, int fr, int fq) const {
#pragma unroll
        for (int ai = 0; ai < 2; ++ai)
#pragma unroll
            for (int m = 0; m < 4; ++m) {
                const int row = u.pm * 256 + ai * 128 + wr * 64 + m * 16 + fr;
#pragma unroll
                for (int bj = 0; bj < 2; ++bj) {
                    const int col0 = u.pn * 256 + bj * 128 + wc * 32 + 8 * fq;
                    const f32x4 g = acc[ai][bj][m][0], up = acc[ai][bj][m][1];
                    float r[4];
#pragma unroll
                    for (int j = 0; j < 4; ++j) r[j] = g[j] * sigmoidf_(g[j]) * up[j];
                    u32x2 w; w.x = pk2(r[0], r[1]); w.y = pk2(r[2], r[3]);
                    *(u32x2*)(act + (size_t)row * FF + (col0 >> 1)) = w;
                }
            }
    }
};
struct MemKvOrder {
    int G, c; const char* A; const char* B;
    DI bool next(int i, pg8::Unit& u) const {
        const int L = i * G + c; if (L >= 256) return false;
        const int l = L >> 6, r = L & 63; u.pm = l * 8 + (r & 7); u.pn = l * 8 + (r >> 3);
        u.a = A + (size_t)u.pm * (256 * D * 2); u.b = B + (size_t)u.pn * (256 * D * 2); return true;
    }
    DI void a_ready(const pg8::Unit&) const {}
    DI void done(const pg8::Unit&) const {}
};
struct CrossOrder {
    int G, c; const char* A; const char* B; int mode;
    DI bool next(int i, pg8::Unit& u) const {
        const int L = i * G + c; if (L >= 256) return false;
        u.pm = L >> 2; u.pn = L & 3; const int b = u.pm >> 3, h = u.pn;
        u.a = A + ((size_t)u.pm * 256 * D + h * 256) * 2;
        u.b = mode == 0 ? B + ((size_t)b * 256 * 2048 + h * 256) * 2 : B + ((size_t)h * 256 * 2048 + b * 256) * 2;
        return true;
    }
    DI void a_ready(const pg8::Unit&) const {}
    DI void done(const pg8::Unit&) const {}
};
struct EpiSoftmax {
    static constexpr bool PERM = true, AFTER_DRAIN = false;
    bf16_t* P; LAS float* xs;
    DI void operator()(AccRef acc, const pg8::Unit& u, int wr, int wc, int fr, int fq) const {
        const float sc = 0.0625f * 1.4426950408889634f;
        LAS float* xm = xs; LAS float* xsum = xs + 1024;
#pragma unroll
        for (int ai = 0; ai < 2; ++ai)
#pragma unroll
            for (int m = 0; m < 4; ++m) {
                float a = -3.0e38f;
#pragma unroll
                for (int bj = 0; bj < 2; ++bj)
#pragma unroll
                    for (int n = 0; n < 2; ++n) { const f32x4 v = acc[ai][bj][m][n]; a = fmaxf(a, fmaxf(fmaxf(v[0], v[1]), fmaxf(v[2], v[3]))); }
                a = fmaxf(a, __shfl_xor(a, 16)); a = fmaxf(a, __shfl_xor(a, 32));
                if (fq == 0) xm[(ai * 128 + wr * 64 + m * 16 + fr) * 4 + wc] = a;
                asm volatile("" ::: "memory");
            }
        __syncthreads();
#pragma unroll
        for (int ai = 0; ai < 2; ++ai)
#pragma unroll
            for (int m = 0; m < 4; ++m) {
                const f32x4 t = *(LAS f32x4*)(xm + (ai * 128 + wr * 64 + m * 16 + fr) * 4); const float mx = fmaxf(fmaxf(t[0], t[1]), fmaxf(t[2], t[3])) * sc;
                float s = 0.f;
#pragma unroll
                for (int bj = 0; bj < 2; ++bj)
#pragma unroll
                    for (int n = 0; n < 2; ++n)
#pragma unroll
                        for (int j = 0; j < 4; ++j) s += __builtin_amdgcn_exp2f(acc[ai][bj][m][n][j] * sc - mx);
                s += __shfl_xor(s, 16); s += __shfl_xor(s, 32);
                if (fq == 0) xsum[(ai * 128 + wr * 64 + m * 16 + fr) * 4 + wc] = s;
                asm volatile("" ::: "memory");
            }
        __syncthreads();
#pragma unroll
        for (int ai = 0; ai < 2; ++ai)
#pragma unroll
            for (int m = 0; m < 4; ++m) {
                const f32x4 t = *(LAS f32x4*)(xm + (ai * 128 + wr * 64 + m * 16 + fr) * 4); const float mx = fmaxf(fmaxf(t[0], t[1]), fmaxf(t[2], t[3])) * sc;
                const f32x4 t2 = *(LAS f32x4*)(xsum + (ai * 128 + wr * 64 + m * 16 + fr) * 4); const float inv = __builtin_amdgcn_rcpf((t2[0] + t2[1]) + (t2[2] + t2[3]));
                bf16_t* rowp = P + (size_t)(u.pm * 256 + ai * 128 + wr * 64 + m * 16 + fr) * D + u.pn * 256 + wc * 32 + 8 * fq;
#pragma unroll
                for (int bj = 0; bj < 2; ++bj)
#pragma unroll
                    for (int n = 0; n < 2; ++n) {
                        const f32x4 v = acc[ai][bj][m][n];
                        u32x2 w; w.x = pk2(__builtin_amdgcn_exp2f(v[0] * sc - mx) * inv, __builtin_amdgcn_exp2f(v[1] * sc - mx) * inv); w.y = pk2(__builtin_amdgcn_exp2f(v[2] * sc - mx) * inv, __builtin_amdgcn_exp2f(v[3] * sc - mx) * inv);
                        *(u32x2*)(rowp + bj * 128 + 4 * n) = w;
                    }
                asm volatile("" ::: "memory");
            }
        __syncthreads();
    }
};

#define XB_TMO      128
#define XB_XCNT(j)  (256  + 64 * (j))
#define XB_XSUB(j)  (1280 + 64 * (j))
#define XB_XGEN(j)  (2304 + 64 * (j))
#define XB_TOP      3328
#define XB_TOPGEN   3392
#define XCD_BAR_WORDS 3456
#define XB_SPIN_CAP (1u << 18)

__device__ __forceinline__ unsigned xb_ld(unsigned* p)              { return __hip_atomic_load(p, __ATOMIC_RELAXED, __HIP_MEMORY_SCOPE_AGENT); }
__device__ __forceinline__ unsigned xb_add(unsigned* p, unsigned v) { return __hip_atomic_fetch_add(p, v, __ATOMIC_RELAXED, __HIP_MEMORY_SCOPE_AGENT); }
__device__ __forceinline__ unsigned xb_xcc_id() { return (unsigned)__builtin_amdgcn_s_getreg((3 << 11) | 20) & 0xFu; }
#define XB_SPIN(cond, bar) do { unsigned _sp = 0; while (cond) { __builtin_amdgcn_s_sleep(1); \
    if ((++_sp & 255u) == 0u) { if (xb_ld(&(bar)[XB_TMO])) break; if (_sp > XB_SPIN_CAP) { atomicAdd(&(bar)[XB_TMO], 1u); break; } } } } while (0)

struct XcdBarrier {
    unsigned* bar; unsigned x;
    volatile LAS unsigned* st;
};

__device__ __forceinline__ XcdBarrier xcd_barrier_post(unsigned* bar, volatile LAS unsigned* st) {
    XcdBarrier b; b.bar = bar; b.x = xb_xcc_id(); b.st = st;
    if (threadIdx.x == 0) (void)xb_add(&bar[XB_XCNT(b.x)], 1u);
    return b;
}
__device__ __forceinline__ void xcd_barrier_complete(unsigned* bar, unsigned x, unsigned& nloc, unsigned& nx) {
    const unsigned G = gridDim.x * gridDim.y * gridDim.z;
    unsigned sum, cnt, mine, sp = 0u;
    for (;;) {
        sum = 0u; cnt = 0u; mine = 0u;
#pragma unroll
        for (unsigned j = 0; j < 16; ++j) { const unsigned c = xb_ld(&bar[XB_XCNT(j)]); sum += c; cnt += (c > 0u) ? 1u : 0u; mine = (j == x) ? c : mine; }
        if (sum == G) break;
        __builtin_amdgcn_s_sleep(1);
        if ((++sp & 255u) == 0u) { if (xb_ld(&bar[XB_TMO])) break; if (sp > XB_SPIN_CAP) { atomicAdd(&bar[XB_TMO], 1u); break; } }
    }
    nloc = mine > 0u ? mine : 1u; nx = cnt > 0u ? cnt : 1u;
}

__device__ __forceinline__ void xcd_barrier(const XcdBarrier& b) {
    asm volatile("s_waitcnt vmcnt(0)" ::: "memory");
    __syncthreads();
    if (threadIdx.x == 0) {
        unsigned* bar = b.bar;
        __builtin_amdgcn_s_waitcnt(0);
        unsigned nloc = b.st[0], nx = b.st[1];
        if (nloc == 0u) { xcd_barrier_complete(bar, b.x, nloc, nx); b.st[0] = nloc; b.st[1] = nx; }
        const unsigned old = xb_add(&bar[XB_XSUB(b.x)], 1u);
        const unsigned gen = old / nloc;
        if (old + 1u == (gen + 1u) * nloc) {
            __builtin_amdgcn_fence(__ATOMIC_RELEASE, "agent");
            asm volatile("s_waitcnt vmcnt(0)" ::: "memory");
            const unsigned og = xb_add(&bar[XB_TOP], 1u);
            const unsigned tg = og / nx;
            if (og + 1u == (tg + 1u) * nx) xb_add(&bar[XB_TOPGEN], 1u);
            else XB_SPIN(xb_ld(&bar[XB_TOPGEN]) == tg, bar);
            __builtin_amdgcn_fence(__ATOMIC_ACQUIRE, "agent");
            xb_add(&bar[XB_XGEN(b.x)], 1u);
            asm volatile("s_waitcnt vmcnt(0)" ::: "memory");
        } else {
            XB_SPIN(xb_ld(&bar[XB_XGEN(b.x)]) == gen, bar);
            __builtin_amdgcn_fence(__ATOMIC_ACQUIRE, "agent");
            asm volatile("s_waitcnt vmcnt(0)" ::: "memory");
        }
    }
    __syncthreads();
}


#define LDS_WAIT() asm volatile("s_waitcnt lgkmcnt(0)" ::: "memory")
DI void transpose_item(const float* W, int K, int N, int Npad, bf16_t* WT, int mode, LAS float* scr, int item, int lane) {
    const int nblk = Npad / 32, kb = item / nblk, nb = item % nblk, k0 = 64 * kb, n0 = 32 * nb;
    const int nn = n0 + (lane & 31); const bool ok = nn < N;
    float tv[32];
#pragma unroll
    for (int i = 0; i < 32; ++i) tv[i] = ok ? W[(size_t)(k0 + 2 * i + (lane >> 5)) * N + nn] : 0.f;
#pragma unroll
    for (int i = 0; i < 32; ++i) scr[(2 * i + (lane >> 5)) * 33 + (lane & 31)] = tv[i];
    LDS_WAIT(); asm volatile("" ::: "memory");
    const int c = lane & 7;
#pragma unroll
    for (int j = 0; j < 4; ++j) {
        const int n = (lane >> 3) + 8 * j; const LAS float* s = scr + (8 * c) * 33 + n;
        u32x4 o; o.x = pk2(s[0 * 33], s[1 * 33]); o.y = pk2(s[2 * 33], s[3 * 33]); o.z = pk2(s[4 * 33], s[5 * 33]); o.w = pk2(s[6 * 33], s[7 * 33]);
        int drow = n0 + n;
        if (mode == 1) { const int jj = drow >= FF ? drow - FF : drow, isu = drow >= FF ? 1 : 0; drow = (jj >> 2) * 8 + isu * 4 + (jj & 3); }
        *(u32x4*)(WT + (size_t)drow * K + k0 + 8 * c) = o;
    }
    LDS_WAIT(); asm volatile("" ::: "memory");
}

DI void norm_row(const float* xsrc32, bf16_t* xb, float* xdst32, const bf16_t* y, const float* gpost, const float* gpre, bf16_t* h, int lane) {
    f32x4 v[4];
    if (xsrc32) {
#pragma unroll
        for (int j = 0; j < 4; ++j) v[j] = *(const f32x4*)(xsrc32 + 4 * lane + 256 * j);
    } else {
#pragma unroll
        for (int j = 0; j < 4; ++j) { const u32x2 w = *(const u32x2*)(xb + 4 * lane + 256 * j); v[j] = (f32x4){bflo(w.x), bfhi(w.x), bflo(w.y), bfhi(w.y)}; }
    }
    if (y) {
        f32x4 yv[4]; float ss = 0.f;
#pragma unroll
        for (int j = 0; j < 4; ++j) { const u32x2 w = *(const u32x2*)(y + 4 * lane + 256 * j); yv[j] = (f32x4){bflo(w.x), bfhi(w.x), bflo(w.y), bfhi(w.y)}; ss += (yv[j][0] * yv[j][0] + yv[j][1] * yv[j][1]) + (yv[j][2] * yv[j][2] + yv[j][3] * yv[j][3]); }
        const float rs = rsqrtf(wave_sum(ss) * (1.f / D) + EPS);
#pragma unroll
        for (int j = 0; j < 4; ++j) { const f32x4 g = *(const f32x4*)(gpost + 4 * lane + 256 * j); v[j] = v[j] + yv[j] * rs * g; }
    }
    if (xdst32) {
#pragma unroll
        for (int j = 0; j < 4; ++j) *(f32x4*)(xdst32 + 4 * lane + 256 * j) = v[j];
    } else {
#pragma unroll
        for (int j = 0; j < 4; ++j) { u32x2 w; w.x = pk2(v[j][0], v[j][1]); w.y = pk2(v[j][2], v[j][3]); *(u32x2*)(xb + 4 * lane + 256 * j) = w; }
    }
    if (gpre) {
        float ss = 0.f;
#pragma unroll
        for (int j = 0; j < 4; ++j) ss += (v[j][0] * v[j][0] + v[j][1] * v[j][1]) + (v[j][2] * v[j][2] + v[j][3] * v[j][3]);
        const float rs = rsqrtf(wave_sum(ss) * (1.f / D) + EPS);
#pragma unroll
        for (int j = 0; j < 4; ++j) { const f32x4 g = *(const f32x4*)(gpre + 4 * lane + 256 * j); const f32x4 o = v[j] * rs * g; u32x2 w; w.x = pk2(o[0], o[1]); w.y = pk2(o[2], o[3]); *(u32x2*)(h + 4 * lane + 256 * j) = w; }
    }
}

DI void norm_phase(const Ctx& p, const float* gpost, const float* gpre, int G, int bx) {
    const int tid = pg8::tid_(), lane = tid & 63, wv = tid >> 6, gw = bx * NWAVES + wv, NGW = G * NWAVES;
    const bf16_t* Yb = (const bf16_t*)(p.ws + WS_Y); bf16_t* Hb = (bf16_t*)(p.ws + WS_H); bf16_t* Xb = (bf16_t*)(p.ws + WS_XB);
    for (int row = gw; row < MA; row += NGW) norm_row(nullptr, Xb + (size_t)row * D, gpre ? nullptr : p.out + (size_t)row * D, Yb + (size_t)row * D, gpost, gpre, Hb + (size_t)row * D, lane);
}

DI void prologue(const Params& p, LAS unsigned char* lds) {
    const int tid = pg8::tid_(), lane = tid & 63, wv = tid >> 6;
    const int gw = blockIdx.x * NWAVES + wv, NGW = gridDim.x * NWAVES;
    LAS float* scr = (LAS float*)(lds + wv * 16384);
    unsigned char* ws = p.ws;
    constexpr int I0 = 3072, I1 = 192, I2 = 512, I3 = 2816, I4 = 1408, IPL = I0 + 2 * I1 + 5 * I2 + I3 + I4;
    for (int it = gw; it < 4 * IPL; it += NGW) {
        const int l = it / IPL; int r = it % IPL;
        if (r < I0) { transpose_item(p.in[I_WIN] + (size_t)l * D * NIN, D, NIN, NINP, (bf16_t*)(ws + WS_WIN + l * SZ_WIN), 0, scr, r, lane); continue; } r -= I0;
        if (r < I1) { transpose_item(p.in[I_WBA] + (size_t)l * 384 * D, 384, D, D, (bf16_t*)(ws + WS_WBA + l * SZ_WBA), 0, scr, r, lane); continue; } r -= I1;
        if (r < I1) { transpose_item(p.in[I_WBC] + (size_t)l * 384 * D, 384, D, D, (bf16_t*)(ws + WS_WBC + l * SZ_WBA), 0, scr, r, lane); continue; } r -= I1;
        if (r < I2) { transpose_item(p.in[I_WMIX] + (size_t)l * D * D, D, D, D, (bf16_t*)(ws + WS_WMIX + l * SZ_WSQ), 0, scr, r, lane); continue; } r -= I2;
        if (r < I2) { transpose_item(p.in[I_WXQ] + (size_t)l * D * D, D, D, D, (bf16_t*)(ws + WS_WXQ + l * SZ_WSQ), 0, scr, r, lane); continue; } r -= I2;
        if (r < I2) { transpose_item(p.in[I_WXO] + (size_t)l * D * D, D, D, D, (bf16_t*)(ws + WS_WXO + l * SZ_WSQ), 0, scr, r, lane); continue; } r -= I2;
        if (r < I2) { transpose_item(p.in[I_WXK] + (size_t)l * D * D, D, D, D, (bf16_t*)(ws + WS_WKV + l * SZ_WKV), 0, scr, r, lane); continue; } r -= I2;
        if (r < I2) { transpose_item(p.in[I_WXV] + (size_t)l * D * D, D, D, D, (bf16_t*)(ws + WS_WKV + l * SZ_WKV + SZ_WSQ), 0, scr, r, lane); continue; } r -= I2;
        if (r < I3) { transpose_item(p.in[I_WF1] + (size_t)l * D * FF2, D, FF2, FF2, (bf16_t*)(ws + WS_WF1 + l * SZ_WF1), 1, scr, r, lane); continue; } r -= I3;
        transpose_item(p.in[I_WF2] + (size_t)l * FF * D, FF, D, D, (bf16_t*)(ws + WS_WF2 + l * SZ_WF2), 0, scr, r, lane);
    }
    for (int u = blockIdx.x; u < 128; u += gridDim.x) {
        const int l = u >> 5, g = (u >> 3) & 3, nb = (u >> 2) & 1, cq = u & 3;
        LAS float* Ps = (LAS float*)(lds + 8 * 16384);
        __syncthreads();
        for (int i = tid; i < 1024; i += NTHR) Ps[i] = p.in[I_WPOOL][((size_t)(l * 4 + g) * 64 + 16 * cq) * 64 + i];
        __syncthreads();
        const int n = nb * 512 + tid;
        const float* sc = p.in[I_PSCALE] + l * 256 + g * 64; const float* wb = p.in[I_WBB] + ((size_t)l * 256 + g * 64) * D + n;
        float acc[16];
#pragma unroll
        for (int c = 0; c < 16; ++c) acc[c] = 0.f;
#pragma unroll 2
        for (int d0 = 0; d0 < 64; d0 += 8) {
            float bc[8];
#pragma unroll
            for (int j = 0; j < 8; ++j) bc[j] = sc[d0 + j] * wb[(size_t)(d0 + j) * D];
#pragma unroll
            for (int c = 0; c < 16; ++c) { const f32x4 p0 = *(const LAS f32x4*)(Ps + c * 64 + d0), p1 = *(const LAS f32x4*)(Ps + c * 64 + d0 + 4);
                acc[c] += ((p0[0] * bc[0] + p0[1] * bc[1]) + (p0[2] * bc[2] + p0[3] * bc[3])) + ((p1[0] * bc[4] + p1[1] * bc[5]) + (p1[2] * bc[6] + p1[3] * bc[7])); }
        }
        unsigned ov[16];
#pragma unroll
        for (int c = 0; c < 16; ++c) ov[c] = f2bf(acc[c]);
        bf16_t* dst = (bf16_t*)(ws + WS_WBB + l * SZ_WBB) + (size_t)n * 256 + g * 64 + 16 * cq;
        u32x4 w0, w1; w0.x = ov[0] | (ov[1] << 16); w0.y = ov[2] | (ov[3] << 16); w0.z = ov[4] | (ov[5] << 16); w0.w = ov[6] | (ov[7] << 16);
        w1.x = ov[8] | (ov[9] << 16); w1.y = ov[10] | (ov[11] << 16); w1.z = ov[12] | (ov[13] << 16); w1.w = ov[14] | (ov[15] << 16);
        *(u32x4*)dst = w0; *(u32x4*)(dst + 8) = w1;
    }
    __syncthreads();
    for (int row = gw; row < MA; row += NGW) {
        const float* src = row < MP ? p.in[I_XP] + (size_t)row * D : p.in[I_XS] + (size_t)(row - MP) * D;
        norm_row(src, (bf16_t*)(ws + WS_XB) + (size_t)row * D, nullptr, nullptr, nullptr, p.in[I_NMIXPRE], (bf16_t*)(ws + WS_H) + (size_t)row * D, lane);
    }
    for (int row = gw; row < NB * 256; row += NGW) {
        f32x4 v[4]; float ss = 0.f;
#pragma unroll
        for (int j = 0; j < 4; ++j) { v[j] = *(const f32x4*)(p.in[I_MEM] + (size_t)row * D + 4 * lane + 256 * j); ss += (v[j][0] * v[j][0] + v[j][1] * v[j][1]) + (v[j][2] * v[j][2] + v[j][3] * v[j][3]); }
        const float rs = rsqrtf(wave_sum(ss) * (1.f / D) + EPS);
        for (int l = 0; l < 4; ++l)
#pragma unroll
            for (int j = 0; j < 4; ++j) { const f32x4 g = *(const f32x4*)(p.in[I_MEMN] + l * D + 4 * lane + 256 * j); const f32x4 o = v[j] * rs * g; u32x2 w; w.x = pk2(o[0], o[1]); w.y = pk2(o[2], o[3]);
                *(u32x2*)((bf16_t*)(ws + WS_MN) + ((size_t)l * 2048 + row) * D + 4 * lane + 256 * j) = w; }
    }
}

#define MFMA32(a, b, c) __builtin_amdgcn_mfma_f32_32x32x16_bf16((a), (b), (c), 0, 0, 0)
#define MFMA16(a, b, c) __builtin_amdgcn_mfma_f32_16x16x32_bf16((a), (b), (c), 0, 0, 0)
DI void sb_prompt_unit(const Ctx& p, int b, int h, int qb, LAS unsigned char* lds) {
    const bf16_t* proj = (const bf16_t*)(p.ws + WS_PROJ);
    LAS unsigned short* KS = (LAS unsigned short*)lds;
    LAS unsigned short* VT = KS + 64 * 72;
    const int tid = pg8::tid_(), lane = tid & 63, wv = tid >> 6, hi = lane >> 5, c = lane & 31;
    const int q0 = qb * 256 + wv * 32, tq = q0 + c;
    const size_t rowbase = (size_t)b * SEQ;
    bf16x8 qf[4];
    {
        const bf16_t* qp = proj + (rowbase + tq) * NINP + C_QA + h * 64 + 8 * hi;
#pragma unroll
        for (int kk = 0; kk < 4; ++kk) qf[kk] = *(const bf16x8*)(qp + 16 * kk);
    }
    f32x16 o0, o1;
#pragma unroll
    for (int i = 0; i < 16; ++i) { o0[i] = 0.f; o1[i] = 0.f; }
    float R = 1.f;
    const bf16_t* kbase = proj + rowbase * NINP + C_KA + h * 64 + 8 * wv;
    const bf16_t* vbase = proj + rowbase * NINP + C_VA + h * 64 + 8 * wv;
    int jt = 4 * qb + 3;
    u32x4 kr = *(const u32x4*)(kbase + (size_t)(64 * jt + lane) * NINP), vr = *(const u32x4*)(vbase + (size_t)(64 * jt + lane) * NINP);
    for (; jt >= 0; --jt) {
        __syncthreads();
        *(LAS u32x4*)(KS + lane * 72 + 8 * wv) = kr;
#pragma unroll
        for (int i = 0; i < 4; ++i) { const unsigned w = vr[i]; VT[(8 * wv + 2 * i) * 72 + lane] = (unsigned short)(w & 0xffffu); VT[(8 * wv + 2 * i + 1) * 72 + lane] = (unsigned short)(w >> 16); }
        __syncthreads();
        if (jt > 0) { kr = *(const u32x4*)(kbase + (size_t)(64 * (jt - 1) + lane) * NINP); vr = *(const u32x4*)(vbase + (size_t)(64 * (jt - 1) + lane) * NINP); }
        if (64 * jt < q0 + 31) {
            f32x16 z[2];
#pragma unroll
            for (int kb = 0; kb < 2; ++kb) {
                f32x16 acc;
#pragma unroll
                for (int i = 0; i < 16; ++i) acc[i] = 0.f;
#pragma unroll
                for (int kk = 0; kk < 4; ++kk) { const bf16x8 a = *(const LAS bf16x8*)(KS + (32 * kb + c) * 72 + 16 * kk + 8 * hi); acc = MFMA32(a, qf[kk], acc); }
                z[kb] = acc;
            }
            f32x16 e[2]; float T[8];
            const int sbase = 64 * jt + 4 * hi;
#pragma unroll
            for (int kb = 0; kb < 2; ++kb)
#pragma unroll
                for (int g = 0; g < 4; ++g) {
                    float fl[4];
#pragma unroll
                    for (int j = 0; j < 4; ++j) {
                        const int r = 4 * g + j; const bool valid = (sbase + 32 * kb + 8 * g + j) < tq;
                        const float zz = fminf(fmaxf(z[kb][r], -240.f), 240.f);
                        const float t = __builtin_amdgcn_exp2f(zz * (-0.125f * 1.4426950408889634f));
                        const float be = __builtin_amdgcn_rcpf(1.f + t);
                        fl[j] = valid ? t * be : 1.f; z[kb][r] = valid ? be : 0.f;
                    }
                    e[kb][4 * g + 3] = 1.f; e[kb][4 * g + 2] = fl[3]; e[kb][4 * g + 1] = fl[3] * fl[2]; e[kb][4 * g + 0] = e[kb][4 * g + 1] * fl[1];
                    T[kb * 4 + g] = e[kb][4 * g + 0] * fl[0];
                }
            float Tp[8], X[8];
#pragma unroll
            for (int gi = 0; gi < 8; ++gi) Tp[gi] = __shfl_xor(T[gi], 32);
            X[7] = 1.f;
#pragma unroll
            for (int gi = 6; gi >= 0; --gi) X[gi] = X[gi + 1] * (T[gi + 1] * Tp[gi + 1]);
            const float total = X[0] * (T[0] * Tp[0]);
#pragma unroll
            for (int kb = 0; kb < 2; ++kb)
#pragma unroll
                for (int g = 0; g < 4; ++g) {
                    const int gi = kb * 4 + g; const float off = R * X[gi] * (hi == 0 ? Tp[gi] : 1.f);
#pragma unroll
                    for (int j = 0; j < 4; ++j) { const int r = 4 * g + j; z[kb][r] = z[kb][r] * (off * e[kb][r]); }
                }
            R *= total;
#pragma unroll
            for (int kb = 0; kb < 2; ++kb)
#pragma unroll
                for (int s2 = 0; s2 < 2; ++s2) {
                    u32x4 pw; pw.x = pk2(z[kb][8 * s2 + 0], z[kb][8 * s2 + 1]); pw.y = pk2(z[kb][8 * s2 + 2], z[kb][8 * s2 + 3]); pw.z = pk2(z[kb][8 * s2 + 4], z[kb][8 * s2 + 5]); pw.w = pk2(z[kb][8 * s2 + 6], z[kb][8 * s2 + 7]);
                    const bf16x8 pb = __builtin_bit_cast(bf16x8, pw);
                    const int ko = 32 * kb + 16 * s2 + 4 * hi;
                    { const s16x4 lo = *(const LAS s16x4*)(VT + c * 72 + ko), hh = *(const LAS s16x4*)(VT + c * 72 + ko + 8);
                      const bf16x8 va = __builtin_shufflevector(lo, hh, 0, 1, 2, 3, 4, 5, 6, 7); o0 = MFMA32(va, pb, o0); }
                    { const s16x4 lo = *(const LAS s16x4*)(VT + (c + 32) * 72 + ko), hh = *(const LAS s16x4*)(VT + (c + 32) * 72 + ko + 8);
                      const bf16x8 va = __builtin_shufflevector(lo, hh, 0, 1, 2, 3, 4, 5, 6, 7); o1 = MFMA32(va, pb, o1); }
                }
        }
    }
    bf16_t* op = (bf16_t*)(p.ws + WS_OA) + (rowbase + tq) * 384 + h * 64 + 4 * hi;
#pragma unroll
    for (int g = 0; g < 4; ++g) {
        u32x2 w; w.x = pk2(o0[4 * g], o0[4 * g + 1]); w.y = pk2(o0[4 * g + 2], o0[4 * g + 3]); *(u32x2*)(op + 8 * g) = w;
        w.x = pk2(o1[4 * g], o1[4 * g + 1]); w.y = pk2(o1[4 * g + 2], o1[4 * g + 3]); *(u32x2*)(op + 32 + 8 * g) = w;
    }
}

DI void sb_sample_unit(const Ctx& p, int l, int b, int h, LAS unsigned char* lds) {
    const bf16_t* proj = (const bf16_t*)(p.ws + WS_PROJ);
    LAS float* qs = (LAS float*)lds;
    LAS float* Z = qs + 1024;
    LAS float* RED = Z + 16 * 1056;
    const int tid = pg8::tid_(), lane = tid & 63, wv = tid >> 6;
    const size_t srow = (size_t)MP + b * 16;
    for (int i = tid; i < 1024; i += NTHR) qs[i] = bf2f(proj[(srow + (i >> 6)) * NINP + C_QA + h * 64 + (i & 63)]) * 0.125f;
    __syncthreads();
    {
        float a0[16], a1[16];
#pragma unroll
        for (int i = 0; i < 16; ++i) { a0[i] = 0.f; a1[i] = 0.f; }
        const float* k0p = p.in[I_CSK] + ((((size_t)l * DB + b) * PAST + tid) * 6 + h) * 64; const float* k1p = k0p + (size_t)512 * 6 * 64;
#pragma unroll 8
        for (int d4 = 0; d4 < 16; ++d4) {
            const f32x4 ka = *(const f32x4*)(k0p + 4 * d4), kb = *(const f32x4*)(k1p + 4 * d4);
#pragma unroll
            for (int i = 0; i < 16; ++i) { const f32x4 q = *(const LAS f32x4*)(qs + i * 64 + 4 * d4);
                a0[i] += (q[0] * ka[0] + q[1] * ka[1]) + (q[2] * ka[2] + q[3] * ka[3]); a1[i] += (q[0] * kb[0] + q[1] * kb[1]) + (q[2] * kb[2] + q[3] * kb[3]); }
        }
#pragma unroll
        for (int i = 0; i < 16; ++i) { Z[i * 1056 + tid] = a0[i]; Z[i * 1056 + tid + 512] = a1[i]; }
        if (tid < 256) {
            const int i = tid >> 4, j = tid & 15; const bf16_t* kp = proj + (srow + j) * NINP + C_KA + h * 64; float s = 0.f;
            for (int d = 0; d < 64; ++d) s += qs[i * 64 + d] * bf2f(kp[d]);
            Z[i * 1056 + 1024 + j] = s;
        }
    }
    __syncthreads();
    for (int qq = 0; qq < 2; ++qq) {
        const int i = 2 * wv + qq, lim = PAST + i; LAS float* zr = Z + i * 1056;
        const int st = 17 * lane, en = (st + 17 < 1040) ? st + 17 : 1040;
        float tot = 0.f;
        for (int s = st; s < en; ++s) if (s < lim) tot -= softplusf_(zr[s]);
        float incl = tot;
#pragma unroll
        for (int o = 1; o < 64; o <<= 1) { const float t = __shfl_down(incl, o); if (lane + o < 64) incl += t; }
        float run = incl - tot;
        for (int s = en - 1; s >= st; --s) {
            const float zz = zr[s]; float w = 0.f;
            if (s < lim) { const float sp = softplusf_(zz); w = __expf(zz - sp + run); run -= sp; }
            zr[s] = w;
        }
    }
    __syncthreads();
    {
        const int d = tid & 63, g = tid >> 6;
        float o[16];
#pragma unroll
        for (int i = 0; i < 16; ++i) o[i] = 0.f;
        const float* vp = p.in[I_CSV] + (((size_t)l * DB + b) * PAST * 6 + h) * 64 + d;
        for (int s0 = 130 * g; s0 < 130 * g + 130; s0 += 26) {
            float v[26];
#pragma unroll
            for (int j = 0; j < 26; ++j) { const int s = s0 + j; v[j] = s < PAST ? vp[(size_t)s * 384] : bf2f(proj[(srow + (s - PAST)) * NINP + C_VA + h * 64 + d]); }
#pragma unroll
            for (int j = 0; j < 26; ++j)
#pragma unroll
                for (int i = 0; i < 16; ++i) o[i] += Z[i * 1056 + s0 + j] * v[j];
        }
#pragma unroll
        for (int i = 0; i < 16; ++i) RED[(g * 16 + i) * 64 + d] = o[i];
    }
    __syncthreads();
    for (int i = tid; i < 1024; i += NTHR) {
        const int qi = i >> 6, d = i & 63; float s = 0.f;
#pragma unroll
        for (int g = 0; g < 8; ++g) s += RED[(g * 16 + qi) * 64 + d];
        ((bf16_t*)(p.ws + WS_OA))[(srow + qi) * 384 + h * 64 + d] = f2bf(s);
    }
}

template <int W> DI void pool_rows(const float (&uu)[48], int t0, float* outp, bf16_t* pooled_col) {
    float s = 0.f;
#pragma unroll
    for (int i = 16 - W; i < 16; ++i) s += uu[i];
#pragma unroll
    for (int r = 0; r < 32; ++r) {
        s += uu[16 + r] - uu[16 + r - W];
        const int t = t0 + r; const float cnt = (float)((t + 1 < W) ? t + 1 : W);
        pooled_col[(size_t)r * 256] = f2bf(s / cnt - uu[16 + r]);
        if (t >= SEQ - 15) outp[(size_t)(t - (SEQ - 15)) * 256] = uu[16 + r];
    }
}
DI void pool_unit(const Ctx& p, int l, int unit) {
    const bf16_t* proj = (const bf16_t*)(p.ws + WS_PROJ); bf16_t* pooled = (bf16_t*)(p.ws + WS_POOLED);
    const int tid = pg8::tid_(), ch = tid & 255, w = 2 << (ch >> 6);
    if (unit < MP / 64) {
        const int r0 = unit * 64 + 32 * (tid >> 8), t0 = r0 & (SEQ - 1), b = r0 >> 11;
        float uu[48];
        const bf16_t* up = proj + (size_t)(r0 - 16) * NINP + C_U + ch;
#pragma unroll
        for (int i = 0; i < 48; ++i) uu[i] = (t0 - 16 + i >= 0) ? bf2f(up[(size_t)i * NINP]) : 0.f;
        float* outp = p.out + O_POOLP + ((size_t)(l * NB + b) * 15) * 256 + ch; bf16_t* pc = pooled + (size_t)r0 * 256 + ch;
        if (w == 2) pool_rows<2>(uu, t0, outp, pc); else if (w == 4) pool_rows<4>(uu, t0, outp, pc); else if (w == 8) pool_rows<8>(uu, t0, outp, pc); else pool_rows<16>(uu, t0, outp, pc);
        return;
    }
    for (int i = 0; i < 32; ++i) {
        const int row = unit * 64 + (tid >> 8) + 2 * i;
        const int rs = row - MP, b = rs >> 4, t = rs & 15; float s = 0.f;
        const bf16_t* up = proj + (size_t)row * NINP + C_U + ch; const float u0 = bf2f(up[0]);
        const float* hist = p.in[I_SPOOL] + ((size_t)(l * DB + b) * 15) * 256 + ch;
        for (int j = 0; j < w; ++j) { const int tt = t - j; s += tt >= 0 ? bf2f(*(up - (size_t)j * NINP)) : hist[(15 + tt) * 256]; }
        if (t >= 1) p.out[O_POOLS + ((size_t)(l * DB + b) * 15 + (t - 1)) * 256 + ch] = u0;
        pooled[(size_t)row * 256 + ch] = f2bf(s / (float)w - u0);
    }
}

DI void kvout_unit(const Ctx& p, int l, int unit) {
    const bf16_t* proj = (const bf16_t*)(p.ws + WS_PROJ);
#pragma unroll 4
    for (int i = pg8::tid_(); i < 64 * 96; i += NTHR) {
        const int r = i / 96, ch = i % 96, row = unit * 64 + r;
        const u32x4 w = *(const u32x4*)(proj + (size_t)row * NINP + C_KA + 8 * ch);
        const bool isv = ch >= 48; const int c = 8 * (isv ? ch - 48 : ch);
        float* dst = (row < MP) ? p.out + (isv ? O_VP : O_KP) + ((size_t)l * MP + row) * 384 + c : p.out + (isv ? O_VS : O_KS) + ((size_t)l * MS + (row - MP)) * 384 + c;
        *(f32x4*)dst = (f32x4){bflo(w.x), bfhi(w.x), bflo(w.y), bfhi(w.y)}; *(f32x4*)(dst + 4) = (f32x4){bflo(w.z), bfhi(w.z), bflo(w.w), bfhi(w.w)};
    }
}
DI void memout_unit(const Ctx& p, int unit) {
    const bf16_t* mkv = (const bf16_t*)(p.ws + WS_MKV);
    for (int i = pg8::tid_(); i < 16 * 256; i += NTHR) {
        const int r = i >> 8, ch = i & 255, row = unit * 16 + r, col = 8 * ch;
        const u32x4 w = *(const u32x4*)(mkv + (size_t)row * 2048 + col);
        float* dst = p.out + (col >= 1024 ? O_MVP : O_MKP) + (size_t)row * D + (col & 1023);
        *(f32x4*)dst = (f32x4){bflo(w.x), bfhi(w.x), bflo(w.y), bfhi(w.y)}; *(f32x4*)(dst + 4) = (f32x4){bflo(w.z), bfhi(w.z), bflo(w.w), bfhi(w.w)};
    }
}
DI void memvt_unit(const Ctx& p, int unit) {
    const int l = unit >> 7, nb = (unit >> 3) & 15, b = unit & 7, tid = pg8::tid_(), n = nb * 64 + (tid & 63), wv = tid >> 6;
    const bf16_t* src = (const bf16_t*)(p.ws + WS_MKV) + ((size_t)l * 2048 + b * 256) * 2048 + 1024 + n;
    bf16_t* dst = (bf16_t*)(p.ws + WS_MEMVT) + ((size_t)l * 1024 + n) * 2048 + b * 256;
    for (int c = wv; c < 32; c += 8) {
        unsigned v[8];
#pragma unroll
        for (int j = 0; j < 8; ++j) v[j] = src[(size_t)(8 * c + j) * 2048];
        u32x4 w; w.x = v[0] | (v[1] << 16); w.y = v[2] | (v[3] << 16); w.z = v[4] | (v[5] << 16); w.w = v[6] | (v[7] << 16);
        *(u32x4*)(dst + 8 * c) = w;
    }
}

DI void gla_decay(const Ctx& p, int l, int h, size_t row0, int ntok, LAS unsigned char* lds) {
    const bf16_t* proj = (const bf16_t*)(p.ws + WS_PROJ);
    LAS float* Bc = (LAS float*)lds; LAS float* LR = (LAS float*)(lds + 24576); LAS float* A2 = (LAS float*)(lds + 28672); LAS float* BIA = (LAS float*)(lds + 34816); LAS float* SEG = (LAS float*)(lds + 35200);
    const int tid = pg8::tid_();
    if (tid < 128) {
        const int t = tid >> 1, hf = tid & 1; u32x4 w = {0u, 0u, 0u, 0u};
        if (t < ntok) w = *(const u32x4*)(proj + (row0 + t) * NINP + C_LR + 8 * hf);
        LAS float* d = LR + t * 16 + 8 * hf;
        d[0] = bflo(w.x); d[1] = bfhi(w.x); d[2] = bflo(w.y); d[3] = bfhi(w.y); d[4] = bflo(w.z); d[5] = bfhi(w.z); d[6] = bflo(w.w); d[7] = bfhi(w.w);
    } else if (tid < 128 + 384) {
        const int i = tid - 128, r = i / 24, c4 = i % 24;
        *(LAS f32x4*)(A2 + r * 96 + 4 * c4) = *(const f32x4*)(p.in[I_WA2] + ((size_t)l * 16 + r) * 384 + h * 96 + 4 * c4);
    }
    if (tid < 96) BIA[tid] = p.in[I_BA][l * 384 + h * 96 + tid];
    __syncthreads();
    for (int i = tid; i < 64 * 96; i += NTHR) {
        const int t = i / 96, k = i % 96; float sacc = BIA[k];
#pragma unroll
        for (int r = 0; r < 16; ++r) sacc += LR[t * 16 + r] * A2[r * 96 + k];
        Bc[i] = t < ntok ? -softplusf_(-sacc) * (1.f / 16.f) : 0.f;
    }
    __syncthreads();
    const int k = tid % 96, seg = tid / 96;
    if (tid < 384) { float run = 0.f; for (int i = 0; i < 16; ++i) { const int idx = (16 * seg + i) * 96 + k; run += Bc[idx]; Bc[idx] = run; } SEG[seg * 96 + k] = run; }
    __syncthreads();
    if (tid < 384 && seg > 0) { float off = 0.f; for (int s2 = 0; s2 < seg; ++s2) off += SEG[s2 * 96 + k]; for (int i = 0; i < 16; ++i) Bc[(16 * seg + i) * 96 + k] += off; }
    __syncthreads();
}
DI void gla_unit_rows(int gu, size_t& row0, int& ntok, int& bh, int& h) {
    if (gu < NGU_P) { bh = gu >> 5; const int c = gu & 31, b = bh >> 2; h = bh & 3; row0 = (size_t)b * SEQ + c * 64; ntok = 64; }
    else { bh = gu - NGU_P; const int b = bh >> 2; h = bh & 3; row0 = (size_t)MP + b * 16; ntok = 16; }
}
DI void gla_stage1_unit(const Ctx& p, int l, int gu, LAS unsigned char* lds) {
    const bf16_t* proj = (const bf16_t*)(p.ws + WS_PROJ);
    size_t row0; int ntok, bh, h; gla_unit_rows(gu, row0, ntok, bh, h);
    gla_decay(p, l, h, row0, ntok, lds);
    LAS float* Bc = (LAS float*)lds;
    LAS unsigned short* KT = (LAS unsigned short*)(lds + 36864);
    LAS unsigned short* VT = KT + 96 * 72;
    const int tid = pg8::tid_(), lane = tid & 63, wv = tid >> 6, fr = lane & 15, fq = lane >> 4;
    {
        float* bb = (float*)(p.ws + WS_BB) + (size_t)gu * (64 * GK);
        for (int i = tid; i < 64 * GK / 4; i += NTHR) *(f32x4*)(bb + 4 * i) = *(const LAS f32x4*)(Bc + 4 * i);
    }
    for (int task = tid; task < 768; task += NTHR) {
        const int t = task & 63, ch = task >> 6; u32x4 kw = {0u, 0u, 0u, 0u}, vw = {0u, 0u, 0u, 0u};
        if (t < ntok) { const bf16_t* rp = proj + (row0 + t) * NINP + h * 96 + 8 * ch; kw = *(const u32x4*)(rp + C_KC); vw = *(const u32x4*)(rp + C_VC); }
        const unsigned kk[4] = {kw.x, kw.y, kw.z, kw.w}, vv[4] = {vw.x, vw.y, vw.z, vw.w};
#pragma unroll
        for (int j = 0; j < 4; ++j) {
            const int k0 = 8 * ch + 2 * j;
            const float e0 = __expf(Bc[(ntok - 1) * 96 + k0] - Bc[t * 96 + k0]), e1 = __expf(Bc[(ntok - 1) * 96 + k0 + 1] - Bc[t * 96 + k0 + 1]);
            KT[k0 * 72 + t] = f2bf(bflo(kk[j]) * e0); KT[(k0 + 1) * 72 + t] = f2bf(bfhi(kk[j]) * e1);
            VT[k0 * 72 + t] = (unsigned short)(vv[j] & 0xffffu); VT[(k0 + 1) * 72 + t] = (unsigned short)(vv[j] >> 16);
        }
    }
    if (tid < 96) ((float*)(p.ws + WS_GDEC))[(size_t)gu * 96 + tid] = __expf(Bc[(ntok - 1) * 96 + tid]);
    __syncthreads();
    float* KV = (float*)(p.ws + WS_GKV) + (size_t)gu * (GK * GK);
    for (int tile = wv; tile < 36; tile += 8) {
        const int ki = tile / 6, vi = tile % 6; f32x4 acc = {0.f, 0.f, 0.f, 0.f};
#pragma unroll
        for (int ks = 0; ks < 2; ++ks) { const bf16x8 a = *(const LAS bf16x8*)(KT + (16 * ki + fr) * 72 + 32 * ks + 8 * fq), bb = *(const LAS bf16x8*)(VT + (16 * vi + fr) * 72 + 32 * ks + 8 * fq); acc = MFMA16(a, bb, acc); }
#pragma unroll
        for (int j = 0; j < 4; ++j) KV[(16 * ki + 4 * fq + j) * 96 + 16 * vi + fr] = acc[j];
    }
}
DI void gla_scan(const Ctx& p, int l) {
    const int gt = blockIdx.x * NTHR + pg8::tid_(), NT = gridDim.x * NTHR;
    const float* KV = (const float*)(p.ws + WS_GKV); const float* DEC = (const float*)(p.ws + WS_GDEC); float* SP = (float*)(p.ws + WS_GSP);
    for (int e = gt; e < 32 * GK * GK; e += NT) {
        const int bh = e / (GK * GK), kv = e % (GK * GK), k = kv / GK; float S = 0.f;
        float kvv[32], dcv[32];
#pragma unroll
        for (int c = 0; c < 32; ++c) { const size_t gu = (size_t)bh * 32 + c; kvv[c] = KV[gu * (GK * GK) + kv]; dcv[c] = DEC[gu * 96 + k]; }
#pragma unroll
        for (int c = 0; c < 32; ++c) { const size_t gu = (size_t)bh * 32 + c; SP[gu * (GK * GK) + kv] = S; S = dcv[c] * S + kvv[c]; }
        p.out[O_GLAP + ((size_t)l * 32 + bh) * (GK * GK) + kv] = S;
    }
    for (int e = gt; e < 64 * GK * GK; e += NT) {
        const int bh = e / (GK * GK), kv = e % (GK * GK), k = kv / GK; const size_t gu = (size_t)NGU_P + bh;
        const float S0 = p.in[I_SGLA][((size_t)l * 64 + bh) * (GK * GK) + kv];
        p.out[O_GLAS + ((size_t)l * 64 + bh) * (GK * GK) + kv] = DEC[gu * 96 + k] * S0 + KV[gu * (GK * GK) + kv];
    }
}
DI void gla_stage3_unit(const Ctx& p, int l, int gu, LAS unsigned char* lds) {
    const bf16_t* proj = (const bf16_t*)(p.ws + WS_PROJ);
    size_t row0; int ntok, bh, h; gla_unit_rows(gu, row0, ntok, bh, h);
    LAS float* OT = (LAS float*)lds;
    LAS unsigned short* QP = (LAS unsigned short*)(lds + 36864);
    LAS unsigned short* KP = QP + 64 * 104;
    LAS unsigned short* VT = KP + 64 * 104;
    LAS unsigned short* ST = VT + 96 * 72;
    LAS unsigned short* ATT = ST + 96 * 104;
    const int tid = pg8::tid_(), lane = tid & 63, wv = tid >> 6, fr = lane & 15, fq = lane >> 4;
    const float* Sprev = gu < NGU_P ? (const float*)(p.ws + WS_GSP) + (size_t)gu * (GK * GK) : p.in[I_SGLA] + ((size_t)l * 64 + bh) * (GK * GK);
    const float* bb = (const float*)(p.ws + WS_BB) + (size_t)gu * (64 * GK);
    __syncthreads();
    for (int task = tid; task < 768; task += NTHR) {
        const int t = task & 63, ch = task >> 6; u32x4 qw = {0u, 0u, 0u, 0u}, kw = qw, vw = qw; f32x4 b0 = {0.f, 0.f, 0.f, 0.f}, b1 = b0;
        if (t < ntok) { const bf16_t* rp = proj + (row0 + t) * NINP + h * 96 + 8 * ch; qw = *(const u32x4*)(rp + C_QC); kw = *(const u32x4*)(rp + C_KC); vw = *(const u32x4*)(rp + C_VC);
            b0 = *(const f32x4*)(bb + t * 96 + 8 * ch); b1 = *(const f32x4*)(bb + t * 96 + 8 * ch + 4); }
        const unsigned qq[4] = {qw.x, qw.y, qw.z, qw.w}, kk[4] = {kw.x, kw.y, kw.z, kw.w}, vv[4] = {vw.x, vw.y, vw.z, vw.w};
        const float be[8] = {b0[0], b0[1], b0[2], b0[3], b1[0], b1[1], b1[2], b1[3]};
        u32x4 qo, ko; unsigned qa[4], ka[4];
#pragma unroll
        for (int j = 0; j < 4; ++j) {
            const float e0 = __expf(be[2 * j]), e1 = __expf(be[2 * j + 1]), r0 = __builtin_amdgcn_rcpf(e0), r1 = __builtin_amdgcn_rcpf(e1);
            const bool ok = t < ntok;
            qa[j] = ok ? pk2(bflo(qq[j]) * 0.10206207261596575f * e0, bfhi(qq[j]) * 0.10206207261596575f * e1) : 0u;
            ka[j] = ok ? pk2(bflo(kk[j]) * r0, bfhi(kk[j]) * r1) : 0u;
            VT[(8 * ch + 2 * j) * 72 + t] = (unsigned short)(vv[j] & 0xffffu); VT[(8 * ch + 2 * j + 1) * 72 + t] = (unsigned short)(vv[j] >> 16);
        }
        qo.x = qa[0]; qo.y = qa[1]; qo.z = qa[2]; qo.w = qa[3]; ko.x = ka[0]; ko.y = ka[1]; ko.z = ka[2]; ko.w = ka[3];
        *(LAS u32x4*)(QP + t * 104 + 8 * ch) = qo; *(LAS u32x4*)(KP + t * 104 + 8 * ch) = ko;
    }
    for (int task = tid; task < 2304; task += NTHR) {
        const int k = task % 96, vc = task / 96; const f32x4 sv = *(const f32x4*)(Sprev + k * 96 + 4 * vc);
#pragma unroll
        for (int j = 0; j < 4; ++j) ST[(4 * vc + j) * 104 + k] = f2bf(sv[j]);
    }
    __syncthreads();
    for (int tile = 2 * wv; tile < 2 * wv + 2; ++tile) {
        const int ti = tile >> 2, si = tile & 3; f32x4 acc = {0.f, 0.f, 0.f, 0.f};
        if (si <= ti) {
#pragma unroll
            for (int ks = 0; ks < 3; ++ks) { const bf16x8 a = *(const LAS bf16x8*)(QP + (16 * ti + fr) * 104 + 32 * ks + 8 * fq), b2 = *(const LAS bf16x8*)(KP + (16 * si + fr) * 104 + 32 * ks + 8 * fq); acc = MFMA16(a, b2, acc); }
        }
#pragma unroll
        for (int j = 0; j < 4; ++j) { const int t = 16 * ti + 4 * fq + j, s2 = 16 * si + fr; ATT[t * 72 + s2] = f2bf(s2 <= t ? acc[j] : 0.f); }
    }
    __syncthreads();
    for (int tile = wv; tile < 24; tile += 8) {
        const int ti = tile / 6, vi = tile % 6; f32x4 acc = {0.f, 0.f, 0.f, 0.f};
#pragma unroll
        for (int ks = 0; ks < 2; ++ks) { const bf16x8 a = *(const LAS bf16x8*)(ATT + (16 * ti + fr) * 72 + 32 * ks + 8 * fq), b2 = *(const LAS bf16x8*)(VT + (16 * vi + fr) * 72 + 32 * ks + 8 * fq); acc = MFMA16(a, b2, acc); }
#pragma unroll
        for (int ks = 0; ks < 3; ++ks) { const bf16x8 a = *(const LAS bf16x8*)(QP + (16 * ti + fr) * 104 + 32 * ks + 8 * fq), b2 = *(const LAS bf16x8*)(ST + (16 * vi + fr) * 104 + 32 * ks + 8 * fq); acc = MFMA16(a, b2, acc); }
#pragma unroll
        for (int j = 0; j < 4; ++j) OT[(16 * ti + 4 * fq + j) * 96 + 16 * vi + fr] = acc[j];
    }
    __syncthreads();
    bf16_t* oc = (bf16_t*)(p.ws + WS_OC);
    const float* gn = p.in[I_GLAN] + l * 384 + h * 96; const float gn0 = gn[lane], gn1 = lane < 32 ? gn[64 + lane] : 0.f;
    float g0[8], g1[8];
#pragma unroll
    for (int tt = 0; tt < 8; ++tt) { const int t = wv * 8 + tt; g0[tt] = 0.f; g1[tt] = 0.f;
        if (t < ntok) { const bf16_t* gp = proj + (row0 + t) * NINP + C_GC + h * 96; g0[tt] = bf2f(gp[lane]); if (lane < 32) g1[tt] = bf2f(gp[64 + lane]); } }
#pragma unroll
    for (int tt = 0; tt < 8; ++tt) {
        const int t = wv * 8 + tt;
        if (t < ntok) {
            const float a0 = OT[t * 96 + lane], a1 = lane < 32 ? OT[t * 96 + 64 + lane] : 0.f;
            const float rs = rsqrtf(wave_sum(a0 * a0 + a1 * a1) * (1.f / 96.f) + EPS);
            oc[(row0 + t) * 384 + h * 96 + lane] = f2bf(a0 * rs * gn0 * g0[tt] * sigmoidf_(g0[tt]));
            if (lane < 32) oc[(row0 + t) * 384 + h * 96 + 64 + lane] = f2bf(a1 * rs * gn1 * g1[tt] * sigmoidf_(g1[tt]));
        }
    }
}

DI void cross_sample_unit(const Ctx& p, int l, int b, int h, int qh, LAS unsigned char* lds) {
    LAS float* qs = (LAS float*)lds;
    LAS float* ST = qs + 8 * 256;
    LAS float* PART = ST + 256 * 8;
    const bf16_t* Q = (const bf16_t*)(p.ws + WS_Q);
    const int tid = pg8::tid_(), lane = tid & 63, wv = tid >> 6;
    const size_t srow = (size_t)MP + b * 16 + 8 * qh;
    for (int i = tid; i < 8 * 256; i += NTHR) qs[i] = bf2f(Q[(srow + (i >> 8)) * D + h * 256 + (i & 255)]) * 0.0625f;
    __syncthreads();
    const int m = tid & 255, half = tid >> 8;
    {
        float acc[8];
#pragma unroll
        for (int i = 0; i < 8; ++i) acc[i] = 0.f;
        const float* kp = p.in[I_CMK] + ((((size_t)l * DB + b) * 256 + m) * 4 + h) * 256 + 128 * half;
#pragma unroll 16
        for (int d4 = 0; d4 < 32; ++d4) {
            const f32x4 kv = *(const f32x4*)(kp + 4 * d4);
#pragma unroll
            for (int i = 0; i < 8; ++i) { const f32x4 q = *(const LAS f32x4*)(qs + i * 256 + 128 * half + 4 * d4); acc[i] += (q[0] * kv[0] + q[1] * kv[1]) + (q[2] * kv[2] + q[3] * kv[3]); }
        }
#pragma unroll
        for (int i = 0; i < 8; ++i) PART[(half * 8 + i) * 256 + m] = acc[i];
    }
    __syncthreads();
    {
        const int i = wv; float v[4], mx = -3.0e38f;
#pragma unroll
        for (int j = 0; j < 4; ++j) { v[j] = PART[i * 256 + lane + 64 * j] + PART[(8 + i) * 256 + lane + 64 * j]; mx = fmaxf(mx, v[j]); }
        mx = wave_max(mx); float sum = 0.f;
#pragma unroll
        for (int j = 0; j < 4; ++j) { v[j] = __expf(v[j] - mx); sum += v[j]; }
        sum = wave_sum(sum); const float inv = 1.f / sum;
#pragma unroll
        for (int j = 0; j < 4; ++j) ST[(lane + 64 * j) * 8 + i] = v[j] * inv;
    }
    __syncthreads();
    {
        float acc[8];
#pragma unroll
        for (int i = 0; i < 8; ++i) acc[i] = 0.f;
        const float* vp = p.in[I_CMV] + ((((size_t)l * DB + b) * 256 + 128 * half) * 4 + h) * 256 + m;
        for (int k0 = 0; k0 < 128; k0 += 32) {
            float v[32];
#pragma unroll
            for (int j = 0; j < 32; ++j) v[j] = vp[(size_t)(k0 + j) * 1024];
#pragma unroll
            for (int j = 0; j < 32; ++j) {
                const f32x4 s0 = *(const LAS f32x4*)(ST + (128 * half + k0 + j) * 8), s1 = *(const LAS f32x4*)(ST + (128 * half + k0 + j) * 8 + 4);
                acc[0] += s0[0] * v[j]; acc[1] += s0[1] * v[j]; acc[2] += s0[2] * v[j]; acc[3] += s0[3] * v[j];
                acc[4] += s1[0] * v[j]; acc[5] += s1[1] * v[j]; acc[6] += s1[2] * v[j]; acc[7] += s1[3] * v[j];
            }
        }
#pragma unroll
        for (int i = 0; i < 8; ++i) PART[(half * 8 + i) * 256 + m] = acc[i];
    }
    __syncthreads();
    bf16_t* O = (bf16_t*)(p.ws + WS_O);
    for (int i = tid; i < 8 * 256; i += NTHR) { const int qi = i >> 8, d = i & 255; O[(srow + qi) * D + h * 256 + d] = f2bf(PART[qi * 256 + d] + PART[(8 + qi) * 256 + d]); }
}

struct SkBf16 { bf16_t* O; int ldc; DI void operator()(int row, int col, f32x4 v) const { u32x2 w; w.x = pk2(v[0], v[1]); w.y = pk2(v[2], v[3]); *(u32x2*)(O + (size_t)(MP + row) * ldc + col) = w; } };
struct SkGate { bf16_t* merged; const bf16_t* proj; int goff; int accum;
    DI void operator()(int row, int col, f32x4 v) const {
        const u32x2 g = *(const u32x2*)(proj + (size_t)(MP + row) * NINP + goff + col); bf16_t* mp = merged + (size_t)(MP + row) * D + col;
        u32x2 pm2 = {0u, 0u}; if (accum) pm2 = *(const u32x2*)mp;
        u32x2 w; w.x = pk2(sigmoidf_(bflo(g.x)) * v[0] + bflo(pm2.x), sigmoidf_(bfhi(g.x)) * v[1] + bfhi(pm2.x)); w.y = pk2(sigmoidf_(bflo(g.y)) * v[2] + bflo(pm2.y), sigmoidf_(bfhi(g.y)) * v[3] + bfhi(pm2.y));
        *(u32x2*)mp = w; } };
template <class EF> DI void skinny_gemm(const bf16_t* A, int lda, const bf16_t* Bt, int ldb, int K, int N, int G, int bx, LAS unsigned char* lds, const EF& ef) {
    const int tid = pg8::tid_(), lane = tid & 63, wv = tid >> 6, fr = lane & 15, fq = lane >> 4, nks = K >> 5, nunits = 4 * (N >> 4);
    LAS f32x4* red = (LAS f32x4*)lds;
    for (int u = bx; u < nunits; u += G) {
        const int rb = u & 3, cb = u >> 2;
        f32x4 acc[4];
#pragma unroll
        for (int i = 0; i < 4; ++i) acc[i] = (f32x4){0.f, 0.f, 0.f, 0.f};
        const bf16_t* bp = Bt + (size_t)(16 * cb + fr) * ldb + 8 * fq; const bf16_t* ap = A + (size_t)(64 * rb + fr) * lda + 8 * fq;
        for (int ks = wv; ks < nks; ks += 8) {
            const bf16x8 bb = *(const bf16x8*)(bp + 32 * ks);
            bf16x8 aa[4];
#pragma unroll
            for (int i = 0; i < 4; ++i) aa[i] = *(const bf16x8*)(ap + (size_t)(16 * i) * lda + 32 * ks);
#pragma unroll
            for (int i = 0; i < 4; ++i) acc[i] = MFMA16(bb, aa[i], acc[i]);
        }
#pragma unroll
        for (int i = 0; i < 4; ++i) red[(wv * 4 + i) * 64 + lane] = acc[i];
        __syncthreads();
        if (tid < 256) {
            const int i = tid >> 6; f32x4 s = red[i * 64 + lane];
#pragma unroll
            for (int w = 1; w < 8; ++w) s = s + red[(w * 4 + i) * 64 + lane];
            ef(64 * rb + 16 * i + fr, 16 * cb + 4 * fq, s);
        }
        __syncthreads();
    }
}

constexpr int PH_PER_LAYER = 15, N_PHASES = 1 + DEPTH * PH_PER_LAYER;
#define RUN_GEMM(EpiT, E, Aptr, lda_, Bptr, ldb_, K_, pm0_, nM_, nN_) do { const pg8::Gemm g_{(K_), (lda_), (ldb_)}; pg8::TileOrder S_; S_.init((Aptr), (lda_), (Bptr), (ldb_), (pm0_), (nM_), (nN_), G, bx); \
        pg8::gemm_phase<EpiT, pg8::TileOrder, true, true>(lds, g_, S_, (E)); } while (0)

__global__ void __launch_bounds__(NTHR, 2) fwd_kernel(Params p) {
    extern __shared__ __attribute__((aligned(16))) unsigned char lds_raw[];
#define PROJ ((bf16_t*)(ws + WS_PROJ))
#define H ((bf16_t*)(ws + WS_H))
#define MERGED ((bf16_t*)(ws + WS_MERGED))
#define Y ((bf16_t*)(ws + WS_Y))
#define QB ((bf16_t*)(ws + WS_Q))
#define PB ((bf16_t*)(ws + WS_P))
#define OB ((bf16_t*)(ws + WS_O))
#define ACT ((bf16_t*)(ws + WS_ACT))

    {
        volatile LAS unsigned* st0 = (volatile LAS unsigned*)((LAS unsigned char*)lds_raw + LDS_MISC + 32);
        if (pg8::tid_() == 0) { st0[0] = 0u; st0[1] = 0u; st0[8] = 0u; st0[9] = 0u; }
        __syncthreads();
    }
    XcdBarrier xbar = xcd_barrier_post((unsigned*)(p.ws + WS_CTL) + CW_BAR, (volatile LAS unsigned*)((LAS unsigned char*)lds_raw + LDS_MISC + 32));
    if (p.ph_lo == 0) {
        prologue(p, (LAS unsigned char*)lds_raw);
        if (blockIdx.x == 0 && pg8::tid_() == 0) {
            const float** tab = (const float**)(p.ws + WS_TAB);
#pragma unroll
            for (int i = 0; i < N_IN; ++i) tab[i] = p.in[i];
        }
        if (p.ph_hi > 1) xcd_barrier(xbar);
        if (p.ph_hi < 0) cg::this_grid().sync();
    }
    for (int ph = p.ph_lo > 1 ? p.ph_lo : 1; ph < p.ph_hi; ++ph) {
        unsigned ldsb = (unsigned)(size_t)(LAS unsigned char*)lds_raw; asm volatile("" : "+s"(ldsb));
        LAS unsigned char* lds = (LAS unsigned char*)(size_t)ldsb;
        volatile LAS int* slot = (volatile LAS int*)(lds + LDS_MISC);
        unsigned char* ws = p.ws; asm volatile("" : "+s"(ws));
        Ctx c; c.ws = ws; c.in.t = (const float* const*)(ws + WS_TAB); c.out = p.out;
        unsigned* ctl = (unsigned*)(ws + WS_CTL);
        int G = gridDim.x, bx = blockIdx.x; asm volatile("" : "+s"(G), "+s"(bx));
        {
            const int l = (ph - 1) / PH_PER_LAYER, st = (ph - 1) % PH_PER_LAYER;
#ifdef PROBE_SEL
            if (bx == 0) { volatile LAS unsigned long long* a_ = (volatile LAS unsigned long long*)(lds + LDS_MISC + 64); a_[1] = __builtin_amdgcn_s_memrealtime(); }
#endif
            switch (st) {
            case 0: {
                EpiBf16 E{PROJ, NINP, 0xffff};
                RUN_GEMM(EpiBf16, E, H, D, ws + WS_WIN + l * SZ_WIN, D, D, 0, MA / 256, NINP / 256);
                if (l == 0) {
                    const pg8::Gemm g{D, D, D}; MemKvOrder S{G, bx, (const char*)(ws + WS_MN), (const char*)(ws + WS_WKV)};
                    EpiBf16 E2{(bf16_t*)(ws + WS_MKV), 2048, 7};
                    pg8::gemm_phase<EpiBf16, MemKvOrder, true, true>(lds, g, S, E2);
                }
            } break;
            case 1: {
                unsigned* ctr = ctl + 64 * ph;
                constexpr int U_SBP = 384, U_SBS = U_SBP + DB * 6, U_GLA = U_SBS + NGU, U_POOL = U_GLA + MA / 64, U_KV = U_POOL + MA / 64, U_MO = U_KV + 512, U_VT = U_MO + 512;
                const int U_ALL = l == 0 ? U_VT : U_KV;
                for (;;) {
                    const int u = next_work(ctr, slot); if (u >= U_ALL) break;
#ifdef PROBE_SEL
                    const int ut_ = u < DB * 6 ? 10 : (u < U_SBS ? 11 : (u < U_GLA ? 12 : 13));
                    if (bx == 0 && ut_ == PROBE_SEL) { volatile LAS unsigned long long* a_ = (volatile LAS unsigned long long*)(lds + LDS_MISC + 64); a_[3] = __builtin_amdgcn_s_memrealtime(); }
#endif
                    if (u < DB * 6) sb_sample_unit(c, l, u / 6, u % 6, lds);
                    else if (u < U_SBS) { const int v = u - DB * 6, qb = 7 - v / 48, bh = v % 48; sb_prompt_unit(c, bh / 6, bh % 6, qb, lds); }
                    else if (u < U_GLA) gla_stage1_unit(c, l, u - U_SBS, lds);
                    else if (u < U_POOL) pool_unit(c, l, u - U_GLA);
                    else if (u < U_KV) kvout_unit(c, l, u - U_POOL);
                    else if (u < U_MO) memout_unit(c, u - U_KV);
                    else memvt_unit(c, u - U_MO);
#ifdef PROBE_SEL
                    if (bx == 0 && ut_ == PROBE_SEL) { volatile LAS unsigned long long* a_ = (volatile LAS unsigned long long*)(lds + LDS_MISC + 64); __hip_atomic_fetch_add((LAS unsigned long long*)a_, __builtin_amdgcn_s_memrealtime() - a_[3], __ATOMIC_RELAXED, __HIP_MEMORY_SCOPE_WORKGROUP); }
#endif
                }
            } break;
            case 2: gla_scan(c, l); break;
            case 3: {
                unsigned* ctr = ctl + 64 * ph;
                for (;;) { const int u = next_work(ctr, slot); if (u >= NGU) break; gla_stage3_unit(c, l, u, lds); }
            } break;
            case 4: {
                EpiGate E1{MERGED, PROJ, C_GA, 0}, E2{MERGED, PROJ, C_GB, 1}, E3{MERGED, PROJ, C_GCG, 1};
                RUN_GEMM(EpiGate, E1, ws + WS_OA, 384, ws + WS_WBA + l * SZ_WBA, 384, 384, 0, MP / 256, 4);
                RUN_GEMM(EpiGate, E2, ws + WS_POOLED, 256, ws + WS_WBB + l * SZ_WBB, 256, 256, 0, MP / 256, 4);
                RUN_GEMM(EpiGate, E3, ws + WS_OC, 384, ws + WS_WBC + l * SZ_WBA, 384, 384, 0, MP / 256, 4);
                { SkGate F1{MERGED, PROJ, C_GA, 0}, F2{MERGED, PROJ, C_GB, 1}, F3{MERGED, PROJ, C_GCG, 1};
                  skinny_gemm((const bf16_t*)(ws + WS_OA) + (size_t)MP * 384, 384, (const bf16_t*)(ws + WS_WBA + l * SZ_WBA), 384, 384, D, G, bx, lds, F1);
                  skinny_gemm((const bf16_t*)(ws + WS_POOLED) + (size_t)MP * 256, 256, (const bf16_t*)(ws + WS_WBB + l * SZ_WBB), 256, 256, D, G, bx, lds, F2);
                  skinny_gemm((const bf16_t*)(ws + WS_OC) + (size_t)MP * 384, 384, (const bf16_t*)(ws + WS_WBC + l * SZ_WBA), 384, 384, D, G, bx, lds, F3); }
            } break;
            case 5: { EpiBf16 E{Y, D, 0xffff}; RUN_GEMM(EpiBf16, E, MERGED, D, ws + WS_WMIX + l * SZ_WSQ, D, D, 0, MP / 256, 4);
                SkBf16 F{Y, D}; skinny_gemm((const bf16_t*)MERGED + (size_t)MP * D, D, (const bf16_t*)(ws + WS_WMIX + l * SZ_WSQ), D, D, D, G, bx, lds, F); } break;
            case 6: norm_phase(c, c.in[I_NMIXPOST] + l * D, c.in[I_NXPRE] + l * D, G, bx); break;
            case 7: { EpiBf16 E{QB, D, 0xffff}; RUN_GEMM(EpiBf16, E, H, D, ws + WS_WXQ + l * SZ_WSQ, D, D, 0, MP / 256, 4);
                SkBf16 F{QB, D}; skinny_gemm((const bf16_t*)H + (size_t)MP * D, D, (const bf16_t*)(ws + WS_WXQ + l * SZ_WSQ), D, D, D, G, bx, lds, F); } break;
            case 8: {
                const pg8::Gemm g{256, D, 2048}; CrossOrder S{G, bx, (const char*)QB, (const char*)(ws + WS_MKV + (size_t)l * 2 * SZ_WKV), 0};
                EpiSoftmax E{PB, (LAS float*)(lds + LDS_X)};
                pg8::gemm_phase<EpiSoftmax, CrossOrder, true, true>(lds, g, S, E);
            } break;
            case 9: {
                const pg8::Gemm g{256, D, 2048}; CrossOrder S{G, bx, (const char*)PB, (const char*)(ws + WS_MEMVT + (size_t)l * SZ_WKV), 1};
                EpiBf16 E{OB, D, 0xffff};
                pg8::gemm_phase<EpiBf16, CrossOrder, true, true>(lds, g, S, E);
                for (int u = bx; u < DB * 4 * 2; u += G) { __syncthreads(); cross_sample_unit(c, l, u >> 3, (u >> 1) & 3, u & 1, lds); }
            } break;
            case 10: { EpiBf16 E{Y, D, 0xffff}; RUN_GEMM(EpiBf16, E, OB, D, ws + WS_WXO + l * SZ_WSQ, D, D, 0, MP / 256, 4);
                SkBf16 F{Y, D}; skinny_gemm((const bf16_t*)OB + (size_t)MP * D, D, (const bf16_t*)(ws + WS_WXO + l * SZ_WSQ), D, D, D, G, bx, lds, F); } break;
            case 11: norm_phase(c, c.in[I_NXPOST] + l * D, c.in[I_NFPRE] + l * D, G, bx); break;
            case 12: { EpiSwiglu E{ACT}; RUN_GEMM(EpiSwiglu, E, H, D, ws + WS_WF1 + l * SZ_WF1, D, D, 0, MA / 256, FF2 / 256); } break;
            case 13: { EpiBf16 E{Y, D, 0xffff}; RUN_GEMM(EpiBf16, E, ACT, FF, ws + WS_WF2 + l * SZ_WF2, FF, FF, 0, MP / 256, 4);
                SkBf16 F{Y, D}; skinny_gemm((const bf16_t*)ACT + (size_t)MP * FF, FF, (const bf16_t*)(ws + WS_WF2 + l * SZ_WF2), FF, FF, D, G, bx, lds, F); } break;
            default: norm_phase(c, c.in[I_NFPOST] + l * D, l < DEPTH - 1 ? c.in[I_NMIXPRE] + (l + 1) * D : nullptr, G, bx); break;
            }
#ifdef PROBE_SEL
            {
                const int sel = PROBE_SEL; bool hit = false;
                if (sel == 2) hit = (st == 0 || st == 4 || st == 5 || st == 7 || st == 10 || st == 12 || st == 13);
                if (sel == 3) hit = (st == 2 || st == 3);
                if (sel == 4) hit = (st == 8 || st == 9);
                if (sel == 5) hit = (st == 6 || st == 11 || st == 14);
                if (sel == 6) hit = (st == 1);
                if (sel == 7) hit = (st == 0);
                if (sel == 8) hit = (st == 12);
                if (sel == 9) hit = (st == 13);
                if (bx == 0 && hit) { volatile LAS unsigned long long* a_ = (volatile LAS unsigned long long*)(lds + LDS_MISC + 64); __hip_atomic_fetch_add((LAS unsigned long long*)a_, __builtin_amdgcn_s_memrealtime() - a_[1], __ATOMIC_RELAXED, __HIP_MEMORY_SCOPE_WORKGROUP); }
            }
#endif
        }
#ifdef PROBE_SEL
        if (bx == 0) { volatile LAS unsigned long long* a_ = (volatile LAS unsigned long long*)(lds + LDS_MISC + 64); a_[2] = __builtin_amdgcn_s_memrealtime(); }
#endif
        if (ph + 1 < p.ph_hi) { if ((ph - 1) % PH_PER_LAYER == 8) { __threadfence(); __syncthreads(); } else xcd_barrier(xbar); }
#ifdef PROBE_SEL
        if (PROBE_SEL == 1 && bx == 0) { volatile LAS unsigned long long* a_ = (volatile LAS unsigned long long*)(lds + LDS_MISC + 64); __hip_atomic_fetch_add((LAS unsigned long long*)a_, __builtin_amdgcn_s_memrealtime() - a_[2], __ATOMIC_RELAXED, __HIP_MEMORY_SCOPE_WORKGROUP); }
#endif
    }
#ifdef PROBE_SEL
    __syncthreads();
    if (blockIdx.x == 0) {
        volatile LAS unsigned long long* a_ = (volatile LAS unsigned long long*)((LAS unsigned char*)lds_raw + LDS_MISC + 64);
        const unsigned long long d_ = a_[0] >> 9, s_ = __builtin_amdgcn_s_memrealtime();
        while (__builtin_amdgcn_s_memrealtime() - s_ < d_) __builtin_amdgcn_s_sleep(8);
    }
#endif
}

extern "C" void kernel_launch(void* const* d_in, const int* in_sizes, int n_in, void* d_out, int out_size, void* d_ws, size_t ws_size, hipStream_t stream) {
    static int grid = 0;
    if (grid == 0) {
        if (n_in != N_IN || (size_t)out_size != O_END || ws_size < WS_END) { fprintf(stderr, "kernel_launch: unexpected shapes: n_in %d out %d ws %zu (need %zu)\n", n_in, out_size, ws_size, (size_t)WS_END); grid = -1; return; }
        int dev = 0, cus = 0, per_cu = 0;
        (void)hipGetDevice(&dev); (void)hipDeviceGetAttribute(&cus, hipDeviceAttributeMultiprocessorCount, dev);
        (void)hipFuncSetAttribute((const void*)fwd_kernel, hipFuncAttributeMaxDynamicSharedMemorySize, LDS_BYTES);
        if (hipOccupancyMaxActiveBlocksPerMultiprocessor(&per_cu, (const void*)fwd_kernel, NTHR, LDS_BYTES) != hipSuccess || per_cu < 1) { fprintf(stderr, "kernel_launch: occupancy query gave %d\n", per_cu); per_cu = 1; }
        (void)hipGetLastError();
        grid = cus * per_cu;
    }
    if (grid < 0) return;
    (void)hipMemsetAsync((char*)d_ws + WS_CTL, 0, CTL_BYTES, stream);
    Params p{};
    for (int i = 0; i < N_IN; ++i) p.in[i] = (const float*)d_in[i];
    p.out = (float*)d_out; p.ws = (unsigned char*)d_ws;
#ifdef MULTI_LAUNCH
    for (int ph = 0; ph < N_PHASES; ++ph) { p.ph_lo = ph; p.ph_hi = ph + 1; hipLaunchKernelGGL(fwd_kernel, dim3(grid), dim3(NTHR), LDS_BYTES, stream, p); }
#else
    p.ph_lo = 0; p.ph_hi = N_PHASES;
    void* args[] = {&p};
    const hipError_t e = hipLaunchCooperativeKernel((const void*)fwd_kernel, dim3(grid), dim3(NTHR), args, LDS_BYTES, stream);
    if (e != hipSuccess) fprintf(stderr, "kernel_launch: cooperative launch failed: %s (grid %d)\n", hipGetErrorString(e), grid);
#endif
}
```

```cpp
#include <hip/hip_runtime.h>
#include <hip/hip_cooperative_groups.h>
#include <cstdio>
#include <cstdint>
namespace cg = cooperative_groups;

namespace pg8 {
#define PG8_LAS __attribute__((address_space(3)))
typedef unsigned short bf16_t;
typedef short bf16x8 __attribute__((ext_vector_type(8)));
typedef float f32x4 __attribute__((ext_vector_type(4)));
typedef unsigned u32x4 __attribute__((ext_vector_type(4)));
typedef unsigned u32x2 __attribute__((ext_vector_type(2)));
constexpr int BM = 256, BK = 64, HALF = 128, HTB = HALF * BK * 2  , STAGE_BYTES = 8 * HTB, NXCD = 8, WGM = 8;

__host__ __device__ __forceinline__ int lds_byte(int r, int c) { const int st = (r >> 4) * 2 + (c >> 5), rr = r & 15, cc = c & 31, ob = rr * 64 + cc * 2; return st * 1024 + (ob ^ (((ob >> 9) & 1) << 5)); }
__host__ __device__ __forceinline__ void stage_rc(int b, int& R, int& C) { const int st = b / 1024, sb = b % 1024, swz = sb ^ (((sb >> 9) & 1) << 5); R = (st >> 1) * 16 + swz / 64; C = (st & 1) * 32 + (swz % 64) / 2; }
__host__ __device__ __forceinline__ int perm32(int rho) { const int n = rho >> 4, i = rho & 15; return 8 * (i >> 2) + 4 * n + (i & 3); }

struct Unit { int pm, pn; const char* a; const char* b; };
struct Gemm { int K, lda, ldb; };

struct TileOrder {
    int nM, nN, G, c, lda, ldb; const char* A; const char* B;
    __device__ void init(const void* A_, int lda_, const void* B_, int ldb_, int, int nM_, int nN_, int G_, int c_) {
        A = (const char*)A_; B = (const char*)B_; lda = lda_; ldb = ldb_; nM = nM_; nN = nN_; G = G_; c = c_; }
    __device__ bool next(int i, Unit& u) const {
        const int nwg = nM * nN; const long L = (long)i * G + c; if (L >= nwg) return false;
        int wgid = (int)L; { const int q = nwg / NXCD, r = nwg % NXCD, xcd = wgid % NXCD, off = wgid / NXCD; wgid = (xcd < r ? xcd * (q + 1) : r * (q + 1) + (xcd - r) * q) + off; }
        const int nig = WGM * nN, gid = wgid / nig, fm = gid * WGM, gsz = (nM - fm) < WGM ? (nM - fm) : WGM;
        u.pm = fm + ((wgid % nig) % gsz); u.pn = (wgid % nig) / gsz; u.a = A + (size_t)u.pm * ((size_t)BM * 2 * lda); u.b = B + (size_t)u.pn * ((size_t)BM * 2 * ldb); return true;
    }
    __device__ __forceinline__ void a_ready(const Unit&) const {}
    __device__ __forceinline__ void done(const Unit&) const {}
};

__device__ __forceinline__ int tid_() { int t = threadIdx.x; asm volatile("" : "+v"(t)); return t; }
__device__ __forceinline__ unsigned cvt_pk_bf16(float lo, float hi) { unsigned r; asm volatile("v_cvt_pk_bf16_f32 %0, %1, %2" : "=v"(r) : "v"(lo), "v"(hi)); return r; }

template <class Epi, class Sched, bool ALIGN_EPI = false, bool SP2 = false>
__device__ __forceinline__ void gemm_phase(PG8_LAS unsigned char* lds, const Gemm g, const Sched& S, const Epi& E) {
    const int tid = pg8::tid_(), wid = __builtin_amdgcn_readfirstlane(tid >> 6), lane = tid & 63, wr = wid >> 2, wc = wid & 3, fr = lane & 15, fq = lane >> 4;
    const int K = g.K, nt = K / BK;
    unsigned voffA, voffB;
    { int R, C; stage_rc(tid * 16, R, C); const int Rb = Epi::PERM ? ((R & ~31) + perm32(R & 31)) : R;
        voffA = (unsigned)(R * g.lda + C) * 2u; voffB = (unsigned)(Rb * g.ldb + C) * 2u; }
    const size_t qstepA = (size_t)64 * g.lda * 2, qstepB = (size_t)64 * g.ldb * 2;
    const size_t kstep = (size_t)(BK * 2);
    const size_t hstepA = (size_t)HALF * g.lda * 2, hstepB = (size_t)HALF * g.ldb * 2;
    const unsigned ldsw = (unsigned)wid * 1024u;
    const int aoff = lds_byte(wr * 64 + fr, fq * 8), boff = lds_byte(wc * 32 + fr, fq * 8);
#define PG8_SA(b, h) (((b) * 2 + (h)) * HTB)
#define PG8_SB(b, h) ((4 + (b) * 2 + (h)) * HTB)
#define PG8_STAGE(bufoff, gbase, voff) do { _Pragma("unroll") for (int _i = 0; _i < 2; ++_i) { const char* sb_ = (const char*)(gbase) + (size_t)_i * q##voff; asm volatile("" : "+s"(sb_));   \
        __builtin_amdgcn_global_load_lds((const unsigned*)(sb_ + (voff)), (PG8_LAS unsigned*)(lds + (bufoff) + ldsw + _i * 8192), 16, 0, 0); } } while (0)
#define qvoffA qstepA
#define qvoffB qstepB
#define PG8_LDA(dst, b, h) do { _Pragma("unroll") for (int m = 0; m < 4; ++m) _Pragma("unroll") for (int k = 0; k < 2; ++k) dst[m][k] = *(const PG8_LAS bf16x8*)(lds + PG8_SA(b, h) + aoff + m * 2048 + k * 1024); } while (0)
#define PG8_LDB(dst, b, h) do { _Pragma("unroll") for (int n = 0; n < 2; ++n) _Pragma("unroll") for (int k = 0; k < 2; ++k) dst[n][k] = *(const PG8_LAS bf16x8*)(lds + PG8_SB(b, h) + boff + n * 2048 + k * 1024); } while (0)
#define PG8_MMA(ai, bj, At, Bt) do { __builtin_amdgcn_s_setprio(1); _Pragma("unroll") for (int m = 0; m < 4; ++m) _Pragma("unroll") for (int n = 0; n < 2; ++n) _Pragma("unroll") for (int k = 0; k < 2; ++k) \
        acc[ai][bj][m][n] = __builtin_amdgcn_mfma_f32_16x16x32_bf16(Bt[n][k], At[m][k], acc[ai][bj][m][n], 0, 0, 0); __builtin_amdgcn_s_setprio(0); } while (0)
#define PG8_WAIT_V(n) asm volatile("s_waitcnt vmcnt(" #n ")" ::: "memory")
#define PG8_WAIT_L(n) asm volatile("s_waitcnt lgkmcnt(" #n ")" ::: "memory")
#define PG8_BAR __builtin_amdgcn_s_barrier()
#define PG8_SCHED __builtin_amdgcn_sched_barrier(0)
    Unit cur, nxt; int ui = 0;
    if (!S.next(0, cur)) return;
    f32x4 acc[2][2][4][2];
#pragma unroll
    for (int a = 0; a < 2; ++a)
#pragma unroll
        for (int b = 0; b < 2; ++b)
#pragma unroll
            for (int m = 0; m < 4; ++m)
#pragma unroll
                for (int n = 0; n < 2; ++n) acc[a][b][m][n] = (f32x4){0.f, 0.f, 0.f, 0.f};
    bf16x8 At[4][2], B0[2][2], B1[2][2];
    const char* cA = cur.a; const char* cB = cur.b;
    S.a_ready(cur);
    if constexpr (SP2) {
        PG8_STAGE(PG8_SB(0, 0), cB, voffB); PG8_STAGE(PG8_SB(0, 1), cB + hstepB, voffB); PG8_STAGE(PG8_SA(0, 0), cA, voffA); PG8_STAGE(PG8_SA(0, 1), cA + hstepA, voffA);
        if (wr == 1) PG8_BAR;
        PG8_WAIT_V(2); PG8_BAR;
        PG8_STAGE(PG8_SB(1, 0), cB + kstep, voffB); PG8_STAGE(PG8_SA(1, 0), cA + kstep, voffA); PG8_STAGE(PG8_SB(1, 1), cB + hstepB + kstep, voffB);
        PG8_WAIT_V(6); PG8_BAR;
    } else {
        PG8_STAGE(PG8_SB(0, 0), cB, voffB); PG8_STAGE(PG8_SA(0, 0), cA, voffA); PG8_STAGE(PG8_SB(0, 1), cB + hstepB, voffB); PG8_STAGE(PG8_SA(0, 1), cA + hstepA, voffA);
        if (wr == 1) PG8_BAR;
        PG8_WAIT_V(4); PG8_BAR;
        PG8_STAGE(PG8_SB(1, 0), cB + kstep, voffB); PG8_STAGE(PG8_SA(1, 0), cA + kstep, voffA); PG8_STAGE(PG8_SB(1, 1), cB + hstepB + kstep, voffB);
        PG8_WAIT_V(6); PG8_BAR;
    }
    for (;;) {
        const bool has_next = S.next(ui + 1, nxt);
        const char* nA = has_next ? nxt.a : cA; const char* nB = has_next ? nxt.b : cB;
        for (int t = 0; t < nt; t += 2) {
            const bool last = (t == nt - 2);
            const char* a1 = cA + (size_t)(t + 1) * kstep;
            const char* a2 = last ? nA : cA + (size_t)(t + 2) * kstep; const char* b2 = last ? nB : cB + (size_t)(t + 2) * kstep;
            const char* a3 = a2 + kstep; const char* b3 = b2 + kstep;
            if (last && has_next) S.a_ready(nxt);
            if constexpr (SP2) {
            PG8_LDB(B0, 0, 0); PG8_LDB(B1, 0, 1); PG8_SCHED; PG8_LDA(At, 0, 0); PG8_STAGE(PG8_SA(1, 1), a1 + hstepA, voffA);
            PG8_WAIT_V(8); PG8_WAIT_L(0); PG8_BAR; PG8_MMA(0, 0, At, B0); PG8_MMA(0, 1, At, B1); PG8_BAR; PG8_SCHED;
            PG8_LDA(At, 0, 1); PG8_STAGE(PG8_SB(0, 0), b2, voffB); PG8_STAGE(PG8_SB(0, 1), b2 + hstepB, voffB); PG8_STAGE(PG8_SA(0, 0), a2, voffA);
            PG8_WAIT_V(8); PG8_WAIT_L(0); PG8_BAR; PG8_MMA(1, 0, At, B0); PG8_MMA(1, 1, At, B1); PG8_BAR; PG8_SCHED;
            PG8_LDB(B0, 1, 0); PG8_LDB(B1, 1, 1); PG8_SCHED; PG8_LDA(At, 1, 0); PG8_STAGE(PG8_SA(0, 1), a2 + hstepA, voffA);
            PG8_WAIT_V(8); PG8_WAIT_L(0); PG8_BAR; PG8_MMA(0, 0, At, B0); PG8_MMA(0, 1, At, B1); PG8_BAR; PG8_SCHED;
            PG8_LDA(At, 1, 1); PG8_STAGE(PG8_SB(1, 0), b3, voffB); PG8_STAGE(PG8_SB(1, 1), b3 + hstepB, voffB); PG8_STAGE(PG8_SA(1, 0), a3, voffA);
            PG8_WAIT_V(8); PG8_WAIT_L(0); PG8_BAR; PG8_MMA(1, 0, At, B0); PG8_MMA(1, 1, At, B1); PG8_BAR; PG8_SCHED;
            } else {
            PG8_LDB(B0, 0, 0); PG8_SCHED; PG8_LDA(At, 0, 0); PG8_STAGE(PG8_SA(1, 1), a1 + hstepA, voffA);
            PG8_WAIT_L(8); PG8_BAR; PG8_WAIT_L(0); PG8_MMA(0, 0, At, B0); PG8_BAR; PG8_SCHED;
            PG8_LDB(B1, 0, 1); PG8_STAGE(PG8_SB(0, 0), b2, voffB);
            PG8_BAR; PG8_WAIT_L(0); PG8_MMA(0, 1, At, B1); PG8_BAR;
            PG8_LDA(At, 0, 1); PG8_STAGE(PG8_SA(0, 0), a2, voffA);
            PG8_BAR; PG8_WAIT_L(0); PG8_MMA(1, 0, At, B0); PG8_BAR; PG8_SCHED;
            PG8_STAGE(PG8_SB(0, 1), b2 + hstepB, voffB);
            PG8_WAIT_V(6); PG8_BAR; PG8_MMA(1, 1, At, B1); PG8_BAR;
            PG8_LDB(B0, 1, 0); PG8_SCHED; PG8_LDA(At, 1, 0); PG8_STAGE(PG8_SA(0, 1), a2 + hstepA, voffA);
            PG8_WAIT_L(8); PG8_BAR; PG8_WAIT_L(0); PG8_MMA(0, 0, At, B0); PG8_BAR; PG8_SCHED;
            PG8_LDB(B1, 1, 1); PG8_STAGE(PG8_SB(1, 0), b3, voffB);
            PG8_BAR; PG8_WAIT_L(0); PG8_MMA(0, 1, At, B1); PG8_BAR;
            PG8_LDA(At, 1, 1); PG8_STAGE(PG8_SA(1, 0), a3, voffA);
            PG8_BAR; PG8_WAIT_L(0); PG8_MMA(1, 0, At, B0); PG8_BAR; PG8_SCHED;
            PG8_STAGE(PG8_SB(1, 1), b3 + hstepB, voffB);
            PG8_WAIT_V(6); PG8_BAR; PG8_MMA(1, 1, At, B1); PG8_BAR;
            }
        }
        if constexpr (ALIGN_EPI) { if (wr == 0) PG8_BAR; }
        if constexpr (!Epi::AFTER_DRAIN) { const int l2_ = tid_() & 63, fr2 = l2_ & 15, fq2 = l2_ >> 4;   E(acc, cur, wr, wc, fr2, fq2); S.done(cur); }
        if (!has_next) break;
#pragma unroll
        for (int a = 0; a < 2; ++a)
#pragma unroll
            for (int b = 0; b < 2; ++b)
#pragma unroll
                for (int m = 0; m < 4; ++m)
#pragma unroll
                    for (int n = 0; n < 2; ++n) acc[a][b][m][n] = (f32x4){0.f, 0.f, 0.f, 0.f};
        cur = nxt; cA = nA; cB = nB; ++ui;
        if constexpr (ALIGN_EPI) { if (wr == 1) PG8_BAR; }
    }
    PG8_WAIT_V(0);
    if constexpr (!ALIGN_EPI) { if (wr == 0) PG8_BAR; }
    PG8_BAR;
    if constexpr (Epi::AFTER_DRAIN) { E.fused(acc, cur, wr, wc, fr, fq, lds, wid, lane); S.done(cur); }
#undef PG8_SA
#undef PG8_SB
#undef PG8_STAGE
#undef qvoffA
#undef qvoffB
#undef PG8_LDA
#undef PG8_LDB
#undef PG8_MMA
#undef PG8_WAIT_V
#undef PG8_WAIT_L
#undef PG8_BAR
#undef PG8_SCHED
}
}

using pg8::bf16_t; using pg8::f32x4; using pg8::bf16x8; using pg8::u32x4; using pg8::u32x2;
#define DI __device__ __forceinline__
#define LAS __attribute__((address_space(3)))
typedef float f32x16 __attribute__((ext_vector_type(16)));
typedef short s16x4 __attribute__((ext_vector_type(4)));
typedef float f32x2_t __attribute__((ext_vector_type(2))); typedef __bf16 bf16x2_t __attribute__((ext_vector_type(2)));

constexpr int NTHR = 512, NWAVES = 8;
constexpr int D = 1024, NB = 8, SEQ = 2048, DEPTH = 4, DB = 16, DT = 16, PAST = 1024;
constexpr int MP = NB * SEQ, MS = DB * DT, MA = MP + MS;
constexpr int NIN = 6032, NINP = 6144;
constexpr int C_QA = 0, C_KA = 384, C_VA = 768, C_U = 1152, C_QC = 1408, C_KC = 1792, C_VC = 2176, C_GC = 2560, C_LR = 2944, C_GA = 2960, C_GB = 3984, C_GCG = 5008;
constexpr int FF = 2816, FF2 = 5632;
constexpr int GH = 4, GK = 96;
constexpr int NGU_P = NB * GH * 32, NGU_S = DB * GH, NGU = NGU_P + NGU_S;
constexpr float EPS = 1e-6f;

constexpr size_t O_YP = 0, O_YS = O_YP + (size_t)MP * D, O_KP = O_YS + (size_t)MS * D, O_VP = O_KP + (size_t)DEPTH * MP * 384, O_POOLP = O_VP + (size_t)DEPTH * MP * 384,
    O_GLAP = O_POOLP + (size_t)DEPTH * NB * 15 * 256, O_MKP = O_GLAP + (size_t)DEPTH * NB * GH * GK * GK, O_MVP = O_MKP + (size_t)DEPTH * NB * 256 * D,
    O_KS = O_MVP + (size_t)DEPTH * NB * 256 * D, O_VS = O_KS + (size_t)DEPTH * MS * 384, O_POOLS = O_VS + (size_t)DEPTH * MS * 384, O_GLAS = O_POOLS + (size_t)DEPTH * DB * 15 * 256,
    O_END = O_GLAS + (size_t)DEPTH * DB * GH * GK * GK;

enum { I_XP = 0, I_XS, I_MEM, I_CSK, I_CSV, I_SPOOL, I_SGLA, I_CMK, I_CMV, I_WIN, I_WA2, I_BA, I_GLAN, I_WPOOL, I_PSCALE, I_WBA, I_WBB, I_WBC, I_WMIX, I_MEMN, I_WXQ, I_WXK, I_WXV, I_WXO,
       I_WF1, I_WF2, I_NMIXPRE, I_NMIXPOST, I_NXPRE, I_NXPOST, I_NFPRE, I_NFPOST, N_IN };

constexpr size_t MiB = 1u << 20;
constexpr size_t SZ_WIN = (size_t)NINP * D * 2, SZ_WBA = (size_t)D * 384 * 2, SZ_WBB = (size_t)D * 256 * 2, SZ_WSQ = (size_t)D * D * 2, SZ_WKV = 2 * SZ_WSQ, SZ_WF1 = (size_t)FF2 * D * 2, SZ_WF2 = (size_t)D * FF * 2;
constexpr size_t WS_CTL = 0, CTL_BYTES = 1 * MiB, WS_TAB = CTL_BYTES - 4096;
constexpr size_t WS_WIN = WS_CTL + CTL_BYTES, WS_WBA = WS_WIN + 4 * SZ_WIN, WS_WBB = WS_WBA + 4 * SZ_WBA, WS_WBC = WS_WBB + 4 * SZ_WBB, WS_WMIX = WS_WBC + 4 * SZ_WBA,
    WS_WXQ = WS_WMIX + 4 * SZ_WSQ, WS_WXO = WS_WXQ + 4 * SZ_WSQ, WS_WKV = WS_WXO + 4 * SZ_WSQ, WS_WF1 = WS_WKV + 4 * SZ_WKV, WS_WF2 = WS_WF1 + 4 * SZ_WF1,
    WS_MN = WS_WF2 + 4 * SZ_WF2, WS_MKV = WS_MN + 4 * SZ_WKV, WS_MEMVT = WS_MKV + 8 * SZ_WKV, WS_PROJ = WS_MEMVT + 4 * SZ_WKV;
constexpr size_t SZ_ROWS = (size_t)MA * D * 2;
constexpr size_t SZ_PROJ = (size_t)MA * NINP * 2;
constexpr size_t WS_Q = WS_PROJ, WS_P = WS_Q + SZ_ROWS, WS_O = WS_P + SZ_ROWS, WS_ACT = WS_O + SZ_ROWS;
static_assert(WS_ACT + (size_t)MA * FF * 2 <= WS_PROJ + SZ_PROJ, "overlay fits");
constexpr size_t WS_H = WS_PROJ + SZ_PROJ, WS_MERGED = WS_H + SZ_ROWS, WS_Y = WS_MERGED + SZ_ROWS;
constexpr size_t WS_GKV = WS_H, WS_GSP = WS_GKV + 39 * MiB, WS_GDEC = WS_GSP + 37 * MiB;
static_assert((size_t)NGU * GK * GK * 4 <= 39 * MiB && (size_t)NGU_P * GK * GK * 4 <= 37 * MiB && WS_GDEC + (size_t)NGU * GK * 4 <= WS_Y + SZ_ROWS, "GLA overlay fits");
constexpr size_t WS_OA = WS_Y + SZ_ROWS, WS_POOLED = WS_OA + (size_t)MA * 384 * 2, WS_OC = WS_POOLED + (size_t)MA * 256 * 2, WS_BB = WS_OC + (size_t)MA * 384 * 2, WS_XB = WS_BB + (size_t)NGU * 64 * GK * 4, WS_END = WS_XB + SZ_ROWS;
static_assert(WS_WIN % 256 == 0 && WS_PROJ % 256 == 0 && WS_H % 256 == 0 && WS_OA % 256 == 0 && WS_POOLED % 256 == 0 && WS_OC % 256 == 0 && WS_P % 256 == 0, "alignment");

constexpr int CW_BAR = 16384;
constexpr int LDS_GEMM = 131072, LDS_X = LDS_GEMM, LDS_X_BYTES = 12288, LDS_MISC = LDS_X + LDS_X_BYTES, LDS_BYTES = LDS_MISC + 256;

struct Params { const float* in[N_IN]; float* out; unsigned char* ws; int ph_lo, ph_hi; };
struct InTab { const float* const* t;
    __device__ __forceinline__ const float* operator[](int i) const { const unsigned long long v = (unsigned long long)t[i];
        const unsigned lo = __builtin_amdgcn_readfirstlane((unsigned)v), hi = __builtin_amdgcn_readfirstlane((unsigned)(v >> 32)); return (const float*)(((unsigned long long)hi << 32) | lo); } };
struct Ctx { InTab in; float* out; unsigned char* ws; };

DI float bflo(unsigned w) { return __uint_as_float(w << 16); }
DI float bfhi(unsigned w) { return __uint_as_float(w & 0xffff0000u); }
DI float bf2f(unsigned short v) { return __uint_as_float((unsigned)v << 16); }
DI unsigned pk2(float lo, float hi) { f32x2_t v = {lo, hi}; bf16x2_t b = __builtin_convertvector(v, bf16x2_t); return __builtin_bit_cast(unsigned, b); }
DI unsigned short f2bf(float f) { return (unsigned short)(pk2(f, 0.f) & 0xffffu); }
DI float wave_sum(float v) {
#pragma unroll
    for (int o = 1; o < 64; o <<= 1) v += __shfl_xor(v, o);
    return v;
}
DI float wave_max(float v) {
#pragma unroll
    for (int o = 1; o < 64; o <<= 1) v = fmaxf(v, __shfl_xor(v, o));
    return v;
}
DI float sigmoidf_(float x) { return __builtin_amdgcn_rcpf(1.f + __expf(-x)); }
DI float softplusf_(float z) { return fmaxf(z, 0.f) + __logf(1.f + __expf(-fabsf(z))); }
DI int next_work(unsigned* ctr, volatile LAS int* slot) {
    __syncthreads();
    if (pg8::tid_() == 0) *slot = (int)atomicAdd(ctr, 1u);
    __syncthreads();
    return *slot;
}

typedef const pg8::f32x4 (&AccRef)[2][2][4][2];
struct EpiBf16 {
    static constexpr bool PERM = true, AFTER_DRAIN = false;
    bf16_t* O; int ldc; int pnmask;
    DI void operator()(AccRef acc, const pg8::Unit& u, int wr, int wc, int fr, int fq) const {
#pragma unroll
        for (int ai = 0; ai < 2; ++ai)
#pragma unroll
            for (int m = 0; m < 4; ++m) {
                bf16_t* rowp = O + (size_t)(u.pm * 256 + ai * 128 + wr * 64 + m * 16 + fr) * ldc + (u.pn & pnmask) * 256 + wc * 32 + 8 * fq;
#pragma unroll
                for (int bj = 0; bj < 2; ++bj) {
                    const f32x4 v0 = acc[ai][bj][m][0], v1 = acc[ai][bj][m][1];
                    u32x4 w; w.x = pk2(v0[0], v0[1]); w.y = pk2(v0[2], v0[3]); w.z = pk2(v1[0], v1[1]); w.w = pk2(v1[2], v1[3]);
                    *(u32x4*)(rowp + bj * 128) = w;
                }
            }
    }
};
struct EpiGate {
    static constexpr bool PERM = true, AFTER_DRAIN = false;
    bf16_t* merged; const bf16_t* proj; int goff; int accum;
    DI void operator()(AccRef acc, const pg8::Unit& u, int wr, int wc, int fr, int fq) const {
#pragma unroll
        for (int ai = 0; ai < 2; ++ai)
#pragma unroll
            for (int m = 0; m < 4; ++m) {
                const int row = u.pm * 256 + ai * 128 + wr * 64 + m * 16 + fr;
                const bf16_t* gp = proj + (size_t)row * NINP + goff + u.pn * 256 + wc * 32 + 8 * fq;
                bf16_t* mp = merged + (size_t)row * D + u.pn * 256 + wc * 32 + 8 * fq;
#pragma unroll
                for (int bj = 0; bj < 2; ++bj)
#pragma unroll
                    for (int n = 0; n < 2; ++n) {
                        const u32x2 g = *(const u32x2*)(gp + bj * 128 + 4 * n);
                        u32x2 pm2 = {0u, 0u}; if (accum) pm2 = *(const u32x2*)(mp + bj * 128 + 4 * n);
                        const f32x4 v = acc[ai][bj][m][n];
                        const float r0 = sigmoidf_(bflo(g.x)) * v[0] + bflo(pm2.x), r1 = sigmoidf_(bfhi(g.x)) * v[1] + bfhi(pm2.x);
                        const float r2 = sigmoidf_(bflo(g.y)) * v[2] + bflo(pm2.y), r3 = sigmoidf_(bfhi(g.y)) * v[3] + bfhi(pm2.y);
                        u32x2 w; w.x = pk2(r0, r1); w.y = pk2(r2, r3);
                        *(u32x2*)(mp + bj * 128 + 4 * n) = w;
                        asm volatile("" ::: "memory");
                    }
            }
    }
};
struct EpiSwiglu {
    static constexpr bool PERM = true, AFTER_DRAIN = false;
    bf16_t* act;
    DI void operator()(AccRef acc, const pg8::Unit& u, int wr, int wc, int fr, int fq) const {
#pragma unroll
        for (int ai = 0; ai < 2; ++ai)
#pragma unroll
            for (int m = 0; m < 4; ++m) {
                const int row = u.pm * 256 + ai * 128 + wr * 64 + m * 16 + fr;
#pragma unroll
                for (int bj = 0; bj < 2; ++bj) {
                    const int col0 = u.pn * 256 + bj * 128 + wc * 32 + 8 * fq;
                    const f32x4 g = acc[ai][bj][m][0], up = acc[ai][bj][m][1];
                    float r[4];
#pragma unroll
                    for (int j = 0; j < 4; ++j) r[j] = g[j] * sigmoidf_(g[j]) * up[j];
                    u32x2 w; w.x = pk2(r[0], r[1]); w.y = pk2(r[2], r[3]);
                    *(u32x2*)(act + (size_t)row * FF + (col0 >> 1)) = w;
                }
            }
    }
};
struct MemKvOrder {
    int G, c; const char* A; const char* B;
    DI bool next(int i, pg8::Unit& u) const {
        const int L = i * G + c; if (L >= 256) return false;
        const int l = L >> 6, r = L & 63; u.pm = l * 8 + (r & 7); u.pn = l * 8 + (r >> 3);
        u.a = A + (size_t)u.pm * (256 * D * 2); u.b = B + (size_t)u.pn * (256 * D * 2); return true;
    }
    DI void a_ready(const pg8::Unit&) const {}
    DI void done(const pg8::Unit&) const {}
};
struct CrossOrder {
    int G, c; const char* A; const char* B; int mode;
    DI bool next(int i, pg8::Unit& u) const {
        const int L = i * G + c; if (L >= 256) return false;
        u.pm = L >> 2; u.pn = L & 3; const int b = u.pm >> 3, h = u.pn;
        u.a = A + ((size_t)u.pm * 256 * D + h * 256) * 2;
        u.b = mode == 0 ? B + ((size_t)b * 256 * 2048 + h * 256) * 2 : B + ((size_t)h * 256 * 2048 + b * 256) * 2;
        return true;
    }
    DI void a_ready(const pg8::Unit&) const {}
    DI void done(const pg8::Unit&) const {}
};
struct EpiSoftmax {
    static constexpr bool PERM = true, AFTER_DRAIN = false;
    bf16_t* P; LAS float* xs;
    DI void operator()(AccRef acc, const pg8::Unit& u, int wr, int wc, int fr, int fq) const {
        const float sc = 0.0625f * 1.4426950408889634f;
        LAS float* xm = xs; LAS float* xsum = xs + 1024;
#pragma unroll
        for (int ai = 0; ai < 2; ++ai)
#pragma unroll
            for (int m = 0; m < 4; ++m) {
                float a = -3.0e38f;
#pragma unroll
                for (int bj = 0; bj < 2; ++bj)
#pragma unroll
                    for (int n = 0; n < 2; ++n) { const f32x4 v = acc[ai][bj][m][n]; a = fmaxf(a, fmaxf(fmaxf(v[0], v[1]), fmaxf(v[2], v[3]))); }
                a = fmaxf(a, __shfl_xor(a, 16)); a = fmaxf(a, __shfl_xor(a, 32));
                if (fq == 0) xm[(ai * 128 + wr * 64 + m * 16 + fr) * 4 + wc] = a;
                asm volatile("" ::: "memory");
            }
        __syncthreads();
#pragma unroll
        for (int ai = 0; ai < 2; ++ai)
#pragma unroll
            for (int m = 0; m < 4; ++m) {
                const f32x4 t = *(LAS f32x4*)(xm + (ai * 128 + wr * 64 + m * 16 + fr) * 4); const float mx = fmaxf(fmaxf(t[0], t[1]), fmaxf(t[2], t[3])) * sc;
                float s = 0.f;
#pragma unroll
                for (int bj = 0; bj < 2; ++bj)
#pragma unroll
                    for (int n = 0; n < 2; ++n)
#pragma unroll
                        for (int j = 0; j < 4; ++j) s += __builtin_amdgcn_exp2f(acc[ai][bj][m][n][j] * sc - mx);
                s += __shfl_xor(s, 16); s += __shfl_xor(s, 32);
                if (fq == 0) xsum[(ai * 128 + wr * 64 + m * 16 + fr) * 4 + wc] = s;
                asm volatile("" ::: "memory");
            }
        __syncthreads();
#pragma unroll
        for (int ai = 0; ai < 2; ++ai)
#pragma unroll
            for (int m = 0; m < 4; ++m) {
                const f32x4 t = *(LAS f32x4*)(xm + (ai * 128 + wr * 64 + m * 16 + fr) * 4); const float mx = fmaxf(fmaxf(t[0], t[1]), fmaxf(t[2], t[3])) * sc;
                const f32x4 t2 = *(LAS f32x4*)(xsum + (ai * 128 + wr * 64 + m * 16 + fr) * 4); const float inv = __builtin_amdgcn_rcpf((t2[0] + t2[1]) + (t2[2] + t2[3]));
                bf16_t* rowp = P + (size_t)(u.pm * 256 + ai * 128 + wr * 64 + m * 16 + fr) * D + u.pn * 256 + wc * 32 + 8 * fq;
#pragma unroll
                for (int bj = 0; bj < 2; ++bj)
#pragma unroll
                    for (int n = 0; n < 2; ++n) {
                        const f32x4 v = acc[ai][bj][m][n];
                        u32x2 w; w.x = pk2(__builtin_amdgcn_exp2f(v[0] * sc - mx) * inv, __builtin_amdgcn_exp2f(v[1] * sc - mx) * inv); w.y = pk2(__builtin_amdgcn_exp2f(v[2] * sc - mx) * inv, __builtin_amdgcn_exp2f(v[3] * sc - mx) * inv);
                        *(u32x2*)(rowp + bj * 128 + 4 * n) = w;
                    }
                asm volatile("" ::: "memory");
            }
        __syncthreads();
    }
};

#define XB_TMO      128
#define XB_XCNT(j)  (256  + 64 * (j))
#define XB_XSUB(j)  (1280 + 64 * (j))
#define XB_XGEN(j)  (2304 + 64 * (j))
#define XB_TOP      3328
#define XB_TOPGEN   3392
#define XCD_BAR_WORDS 3456
#define XB_SPIN_CAP (1u << 18)

__device__ __forceinline__ unsigned xb_ld(unsigned* p)              { return __hip_atomic_load(p, __ATOMIC_RELAXED, __HIP_MEMORY_SCOPE_AGENT); }
__device__ __forceinline__ unsigned xb_add(unsigned* p, unsigned v) { return __hip_atomic_fetch_add(p, v, __ATOMIC_RELAXED, __HIP_MEMORY_SCOPE_AGENT); }
__device__ __forceinline__ unsigned xb_xcc_id() { return (unsigned)__builtin_amdgcn_s_getreg((3 << 11) | 20) & 0xFu; }
#define XB_SPIN(cond, bar) do { unsigned _sp = 0; while (cond) { __builtin_amdgcn_s_sleep(1); \
    if ((++_sp & 255u) == 0u) { if (xb_ld(&(bar)[XB_TMO])) break; if (_sp > XB_SPIN_CAP) { atomicAdd(&(bar)[XB_TMO], 1u); break; } } } } while (0)

struct XcdBarrier {
    unsigned* bar; unsigned x;
    volatile LAS unsigned* st;
};

__device__ __forceinline__ XcdBarrier xcd_barrier_post(unsigned* bar, volatile LAS unsigned* st) {
    XcdBarrier b; b.bar = bar; b.x = xb_xcc_id(); b.st = st;
    if (threadIdx.x == 0) (void)xb_add(&bar[XB_XCNT(b.x)], 1u);
    return b;
}
__device__ __forceinline__ void xcd_barrier_complete(unsigned* bar, unsigned x, unsigned& nloc, unsigned& nx) {
    const unsigned G = gridDim.x * gridDim.y * gridDim.z;
    unsigned sum, cnt, mine, sp = 0u;
    for (;;) {
        sum = 0u; cnt = 0u; mine = 0u;
#pragma unroll
        for (unsigned j = 0; j < 16; ++j) { const unsigned c = xb_ld(&bar[XB_XCNT(j)]); sum += c; cnt += (c > 0u) ? 1u : 0u; mine = (j == x) ? c : mine; }
        if (sum == G) break;
        __builtin_amdgcn_s_sleep(1);
        if ((++sp & 255u) == 0u) { if (xb_ld(&bar[XB_TMO])) break; if (sp > XB_SPIN_CAP) { atomicAdd(&bar[XB_TMO], 1u); break; } }
    }
    nloc = mine > 0u ? mine : 1u; nx = cnt > 0u ? cnt : 1u;
}

__device__ __forceinline__ void xcd_barrier(const XcdBarrier& b) {
    asm volatile("s_waitcnt vmcnt(0)" ::: "memory");
    __syncthreads();
    if (threadIdx.x == 0) {
        unsigned* bar = b.bar;
        __builtin_amdgcn_s_waitcnt(0);
        unsigned nloc = b.st[0], nx = b.st[1];
        if (nloc == 0u) { xcd_barrier_complete(bar, b.x, nloc, nx); b.st[0] = nloc; b.st[1] = nx; }
        const unsigned old = xb_add(&bar[XB_XSUB(b.x)], 1u);
        const unsigned gen = old / nloc;
        if (old + 1u == (gen + 1u) * nloc) {
            __builtin_amdgcn_fence(__ATOMIC_RELEASE, "agent");
            asm volatile("s_waitcnt vmcnt(0)" ::: "memory");
            const unsigned og = xb_add(&bar[XB_TOP], 1u);
            const unsigned tg = og / nx;
            if (og + 1u == (tg + 1u) * nx) xb_add(&bar[XB_TOPGEN], 1u);
            else XB_SPIN(xb_ld(&bar[XB_TOPGEN]) == tg, bar);
            __builtin_amdgcn_fence(__ATOMIC_ACQUIRE, "agent");
            xb_add(&bar[XB_XGEN(b.x)], 1u);
            asm volatile("s_waitcnt vmcnt(0)" ::: "memory");
        } else {
            XB_SPIN(xb_ld(&bar[XB_XGEN(b.x)]) == gen, bar);
            __builtin_amdgcn_fence(__ATOMIC_ACQUIRE, "agent");
            asm volatile("s_waitcnt vmcnt(0)" ::: "memory");
        }
    }
    __syncthreads();
}


#define LDS_WAIT() asm volatile("s_waitcnt lgkmcnt(0)" ::: "memory")
DI void transpose_item(const float* W, int K, int N, int Npad, bf16_t* WT, int mode, LAS float* scr, int item, int lane) {
    const int nblk = Npad / 32, kb = item / nblk, nb = item % nblk, k0 = 64 * kb, n0 = 32 * nb;
    const int nn = n0 + (lane & 31); const bool ok = nn < N;
    float tv[32];
#pragma unroll
    for (int i = 0; i < 32; ++i) tv[i] = ok ? W[(size_t)(k0 + 2 * i + (lane >> 5)) * N + nn] : 0.f;
#pragma unroll
    for (int i = 0; i < 32; ++i) scr[(2 * i + (lane >> 5)) * 33 + (lane & 31)] = tv[i];
    LDS_WAIT(); asm volatile("" ::: "memory");
    const int c = lane & 7;
#pragma unroll
    for (int j = 0; j < 4; ++j) {
        const int n = (lane >> 3) + 8 * j; const LAS float* s = scr + (8 * c) * 33 + n;
        u32x4 o; o.x = pk2(s[0 * 33], s[1 * 33]); o.y = pk2(s[2 * 33], s[3 * 33]); o.z = pk2(s[4 * 33], s[5 * 33]); o.w = pk2(s[6 * 33], s[7 * 33]);
        int drow = n0 + n;
        if (mode == 1) { const int jj = drow >= FF ? drow - FF : drow, isu = drow >= FF ? 1 : 0; drow = (jj >> 2) * 8 + isu * 4 + (jj & 3); }
        *(u32x4*)(WT + (size_t)drow * K + k0 + 8 * c) = o;
    }
    LDS_WAIT(); asm volatile("" ::: "memory");
}

DI void norm_row(const float* xsrc32, bf16_t* xb, float* xdst32, const bf16_t* y, const float* gpost, const float* gpre, bf16_t* h, int lane) {
    f32x4 v[4];
    if (xsrc32) {
#pragma unroll
        for (int j = 0; j < 4; ++j) v[j] = *(const f32x4*)(xsrc32 + 4 * lane + 256 * j);
    } else {
#pragma unroll
        for (int j = 0; j < 4; ++j) { const u32x2 w = *(const u32x2*)(xb + 4 * lane + 256 * j); v[j] = (f32x4){bflo(w.x), bfhi(w.x), bflo(w.y), bfhi(w.y)}; }
    }
    if (y) {
        f32x4 yv[4]; float ss = 0.f;
#pragma unroll
        for (int j = 0; j < 4; ++j) { const u32x2 w = *(const u32x2*)(y + 4 * lane + 256 * j); yv[j] = (f32x4){bflo(w.x), bfhi(w.x), bflo(w.y), bfhi(w.y)}; ss += (yv[j][0] * yv[j][0] + yv[j][1] * yv[j][1]) + (yv[j][2] * yv[j][2] + yv[j][3] * yv[j][3]); }
        const float rs = rsqrtf(wave_sum(ss) * (1.f / D) + EPS);
#pragma unroll
        for (int j = 0; j < 4; ++j) { const f32x4 g = *(const f32x4*)(gpost + 4 * lane + 256 * j); v[j] = v[j] + yv[j] * rs * g; }
    }
    if (xdst32) {
#pragma unroll
        for (int j = 0; j < 4; ++j) *(f32x4*)(xdst32 + 4 * lane + 256 * j) = v[j];
    } else {
#pragma unroll
        for (int j = 0; j < 4; ++j) { u32x2 w; w.x = pk2(v[j][0], v[j][1]); w.y = pk2(v[j][2], v[j][3]); *(u32x2*)(xb + 4 * lane + 256 * j) = w; }
    }
    if (gpre) {
        float ss = 0.f;
#pragma unroll
        for (int j = 0; j < 4; ++j) ss += (v[j][0] * v[j][0] + v[j][1] * v[j][1]) + (v[j][2] * v[j][2] + v[j][3] * v[j][3]);
        const float rs = rsqrtf(wave_sum(ss) * (1.f / D) + EPS);
#pragma unroll
        for (int j = 0; j < 4; ++j) { const f32x4 g = *(const f32x4*)(gpre + 4 * lane + 256 * j); const f32x4 o = v[j] * rs * g; u32x2 w; w.x = pk2(o[0], o[1]); w.y = pk2(o[2], o[3]); *(u32x2*)(h + 4 * lane + 256 * j) = w; }
    }
}

DI void norm_phase(const Ctx& p, const float* gpost, const float* gpre, int G, int bx) {
    const int tid = pg8::tid_(), lane = tid & 63, wv = tid >> 6, gw = bx * NWAVES + wv, NGW = G * NWAVES;
    const bf16_t* Yb = (const bf16_t*)(p.ws + WS_Y); bf16_t* Hb = (bf16_t*)(p.ws + WS_H); bf16_t* Xb = (bf16_t*)(p.ws + WS_XB);
    for (int row = gw; row < MA; row += NGW) norm_row(nullptr, Xb + (size_t)row * D, gpre ? nullptr : p.out + (size_t)row * D, Yb + (size_t)row * D, gpost, gpre, Hb + (size_t)row * D, lane);
}

DI void prologue(const Params& p, LAS unsigned char* lds) {
    const int tid = pg8::tid_(), lane = tid & 63, wv = tid >> 6;
    const int gw = blockIdx.x * NWAVES + wv, NGW = gridDim.x * NWAVES;
    LAS float* scr = (LAS float*)(lds + wv * 16384);
    unsigned char* ws = p.ws;
    constexpr int I0 = 3072, I1 = 192, I2 = 512, I3 = 2816, I4 = 1408, IPL = I0 + 2 * I1 + 5 * I2 + I3 + I4;
    for (int it = gw; it < 4 * IPL; it += NGW) {
        const int l = it / IPL; int r = it % IPL;
        if (r < I0) { transpose_item(p.in[I_WIN] + (size_t)l * D * NIN, D, NIN, NINP, (bf16_t*)(ws + WS_WIN + l * SZ_WIN), 0, scr, r, lane); continue; } r -= I0;
        if (r < I1) { transpose_item(p.in[I_WBA] + (size_t)l * 384 * D, 384, D, D, (bf16_t*)(ws + WS_WBA + l * SZ_WBA), 0, scr, r, lane); continue; } r -= I1;
        if (r < I1) { transpose_item(p.in[I_WBC] + (size_t)l * 384 * D, 384, D, D, (bf16_t*)(ws + WS_WBC + l * SZ_WBA), 0, scr, r, lane); continue; } r -= I1;
        if (r < I2) { transpose_item(p.in[I_WMIX] + (size_t)l * D * D, D, D, D, (bf16_t*)(ws + WS_WMIX + l * SZ_WSQ), 0, scr, r, lane); continue; } r -= I2;
        if (r < I2) { transpose_item(p.in[I_WXQ] + (size_t)l * D * D, D, D, D, (bf16_t*)(ws + WS_WXQ + l * SZ_WSQ), 0, scr, r, lane); continue; } r -= I2;
        if (r < I2) { transpose_item(p.in[I_WXO] + (size_t)l * D * D, D, D, D, (bf16_t*)(ws + WS_WXO + l * SZ_WSQ), 0, scr, r, lane); continue; } r -= I2;
        if (r < I2) { transpose_item(p.in[I_WXK] + (size_t)l * D * D, D, D, D, (bf16_t*)(ws + WS_WKV + l * SZ_WKV), 0, scr, r, lane); continue; } r -= I2;
        if (r < I2) { transpose_item(p.in[I_WXV] + (size_t)l * D * D, D, D, D, (bf16_t*)(ws + WS_WKV + l * SZ_WKV + SZ_WSQ), 0, scr, r, lane); continue; } r -= I2;
        if (r < I3) { transpose_item(p.in[I_WF1] + (size_t)l * D * FF2, D, FF2, FF2, (bf16_t*)(ws + WS_WF1 + l * SZ_WF1), 1, scr, r, lane); continue; } r -= I3;
        transpose_item(p.in[I_WF2] + (size_t)l * FF * D, FF, D, D, (bf16_t*)(ws + WS_WF2 + l * SZ_WF2), 0, scr, r, lane);
    }
    for (int u = blockIdx.x; u < 128; u += gridDim.x) {
        const int l = u >> 5, g = (u >> 3) & 3, nb = (u >> 2) & 1, cq = u & 3;
        LAS float* Ps = (LAS float*)(lds + 8 * 16384);
        __syncthreads();
        for (int i = tid; i < 1024; i += NTHR) Ps[i] = p.in[I_WPOOL][((size_t)(l * 4 + g) * 64 + 16 * cq) * 64 + i];
        __syncthreads();
        const int n = nb * 512 + tid;
        const float* sc = p.in[I_PSCALE] + l * 256 + g * 64; const float* wb = p.in[I_WBB] + ((size_t)l * 256 + g * 64) * D + n;
        float acc[16];
#pragma unroll
        for (int c = 0; c < 16; ++c) acc[c] = 0.f;
#pragma unroll 2
        for (int d0 = 0; d0 < 64; d0 += 8) {
            float bc[8];
#pragma unroll
            for (int j = 0; j < 8; ++j) bc[j] = sc[d0 + j] * wb[(size_t)(d0 + j) * D];
#pragma unroll
            for (int c = 0; c < 16; ++c) { const f32x4 p0 = *(const LAS f32x4*)(Ps + c * 64 + d0), p1 = *(const LAS f32x4*)(Ps + c * 64 + d0 + 4);
                acc[c] += ((p0[0] * bc[0] + p0[1] * bc[1]) + (p0[2] * bc[2] + p0[3] * bc[3])) + ((p1[0] * bc[4] + p1[1] * bc[5]) + (p1[2] * bc[6] + p1[3] * bc[7])); }
        }
        unsigned ov[16];
#pragma unroll
        for (int c = 0; c < 16; ++c) ov[c] = f2bf(acc[c]);
        bf16_t* dst = (bf16_t*)(ws + WS_WBB + l * SZ_WBB) + (size_t)n * 256 + g * 64 + 16 * cq;
        u32x4 w0, w1; w0.x = ov[0] | (ov[1] << 16); w0.y = ov[2] | (ov[3] << 16); w0.z = ov[4] | (ov[5] << 16); w0.w = ov[6] | (ov[7] << 16);
        w1.x = ov[8] | (ov[9] << 16); w1.y = ov[10] | (ov[11] << 16); w1.z = ov[12] | (ov[13] << 16); w1.w = ov[14] | (ov[15] << 16);
        *(u32x4*)dst = w0; *(u32x4*)(dst + 8) = w1;
    }
    __syncthreads();
    for (int row = gw; row < MA; row += NGW) {
        const float* src = row < MP ? p.in[I_XP] + (size_t)row * D : p.in[I_XS] + (size_t)(row - MP) * D;
        norm_row(src, (bf16_t*)(ws + WS_XB) + (size_t)row * D, nullptr, nullptr, nullptr, p.in[I_NMIXPRE], (bf16_t*)(ws + WS_H) + (size_t)row * D, lane);
    }
    for (int row = gw; row < NB * 256; row += NGW) {
        f32x4 v[4]; float ss = 0.f;
#pragma unroll
        for (int j = 0; j < 4; ++j) { v[j] = *(const f32x4*)(p.in[I_MEM] + (size_t)row * D + 4 * lane + 256 * j); ss += (v[j][0] * v[j][0] + v[j][1] * v[j][1]) + (v[j][2] * v[j][2] + v[j][3] * v[j][3]); }
        const float rs = rsqrtf(wave_sum(ss) * (1.f / D) + EPS);
        for (int l = 0; l < 4; ++l)
#pragma unroll
            for (int j = 0; j < 4; ++j) { const f32x4 g = *(const f32x4*)(p.in[I_MEMN] + l * D + 4 * lane + 256 * j); const f32x4 o = v[j] * rs * g; u32x2 w; w.x = pk2(o[0], o[1]); w.y = pk2(o[2], o[3]);
                *(u32x2*)((bf16_t*)(ws + WS_MN) + ((size_t)l * 2048 + row) * D + 4 * lane + 256 * j) = w; }
    }
}

#define MFMA32(a, b, c) __builtin_amdgcn_mfma_f32_32x32x16_bf16((a), (b), (c), 0, 0, 0)
#define MFMA16(a, b, c) __builtin_amdgcn_mfma_f32_16x16x32_bf16((a), (b), (c), 0, 0, 0)
template <bool MASKED> DI void sb_tile_weights(f32x16 (&z)[2], float& R, int jt, int tq, int hi) {
    f32x16 e[2]; float T[8];
    const int sbase = 64 * jt + 4 * hi;
#pragma unroll
    for (int kb = 0; kb < 2; ++kb)
#pragma unroll
        for (int g = 0; g < 4; ++g) {
            float fl[4];
#pragma unroll
            for (int j = 0; j < 4; ++j) {
                const int r = 4 * g + j; const bool valid = !MASKED || (sbase + 32 * kb + 8 * g + j) < tq;
                const float zz = fminf(fmaxf(z[kb][r], -240.f), 240.f);
                const float t = __builtin_amdgcn_exp2f(zz * (-0.125f * 1.4426950408889634f));
                const float be = __builtin_amdgcn_rcpf(1.f + t);
                fl[j] = valid ? t * be : 1.f; z[kb][r] = valid ? be : 0.f;
            }
            e[kb][4 * g + 3] = 1.f; e[kb][4 * g + 2] = fl[3]; e[kb][4 * g + 1] = fl[3] * fl[2]; e[kb][4 * g + 0] = e[kb][4 * g + 1] * fl[1];
            T[kb * 4 + g] = e[kb][4 * g + 0] * fl[0];
        }
    float Tp[8], X[8];
#pragma unroll
    for (int gi = 0; gi < 8; ++gi) Tp[gi] = __shfl_xor(T[gi], 32);
    X[7] = 1.f;
#pragma unroll
    for (int gi = 6; gi >= 0; --gi) X[gi] = X[gi + 1] * (T[gi + 1] * Tp[gi + 1]);
    const float total = X[0] * (T[0] * Tp[0]);
#pragma unroll
    for (int kb = 0; kb < 2; ++kb)
#pragma unroll
        for (int g = 0; g < 4; ++g) {
            const int gi = kb * 4 + g; const float off = R * X[gi] * (hi == 0 ? Tp[gi] : 1.f);
#pragma unroll
            for (int j = 0; j < 4; ++j) { const int r = 4 * g + j; z[kb][r] = z[kb][r] * (off * e[kb][r]); }
        }
    R *= total;
}

DI void sb_prompt_unit(const Ctx& p, int b, int h, int qb, LAS unsigned char* lds) {
    const bf16_t* proj = (const bf16_t*)(p.ws + WS_PROJ);
    LAS unsigned short* KS = (LAS unsigned short*)lds;
    LAS unsigned short* VT = KS + 64 * 72;
    const int tid = pg8::tid_(), lane = tid & 63, wv = tid >> 6, hi = lane >> 5, c = lane & 31;
    const int q0 = qb * 256 + wv * 32, tq = q0 + c;
    const size_t rowbase = (size_t)b * SEQ;
    bf16x8 qf[4];
    {
        const bf16_t* qp = proj + (rowbase + tq) * NINP + C_QA + h * 64 + 8 * hi;
#pragma unroll
        for (int kk = 0; kk < 4; ++kk) qf[kk] = *(const bf16x8*)(qp + 16 * kk);
    }
    f32x16 o0, o1;
#pragma unroll
    for (int i = 0; i < 16; ++i) { o0[i] = 0.f; o1[i] = 0.f; }
    float R = 1.f;
    const bf16_t* kbase = proj + rowbase * NINP + C_KA + h * 64 + 8 * wv;
    const bf16_t* vbase = proj + rowbase * NINP + C_VA + h * 64 + 8 * wv;
    int jt = 4 * qb + 3;
    u32x4 kr = *(const u32x4*)(kbase + (size_t)(64 * jt + lane) * NINP), vr = *(const u32x4*)(vbase + (size_t)(64 * jt + lane) * NINP);
    for (; jt >= 0; --jt) {
        __syncthreads();
        *(LAS u32x4*)(KS + lane * 72 + 8 * wv) = kr;
#pragma unroll
        for (int i = 0; i < 4; ++i) { const unsigned w = vr[i]; VT[(8 * wv + 2 * i) * 72 + lane] = (unsigned short)(w & 0xffffu); VT[(8 * wv + 2 * i + 1) * 72 + lane] = (unsigned short)(w >> 16); }
        __syncthreads();
        if (jt > 0) { kr = *(const u32x4*)(kbase + (size_t)(64 * (jt - 1) + lane) * NINP); vr = *(const u32x4*)(vbase + (size_t)(64 * (jt - 1) + lane) * NINP); }
        if (64 * jt < q0 + 31) {
            f32x16 z[2];
#pragma unroll
            for (int kb = 0; kb < 2; ++kb) {
                f32x16 acc;
#pragma unroll
                for (int i = 0; i < 16; ++i) acc[i] = 0.f;
#pragma unroll
                for (int kk = 0; kk < 4; ++kk) { const bf16x8 a = *(const LAS bf16x8*)(KS + (32 * kb + c) * 72 + 16 * kk + 8 * hi); acc = MFMA32(a, qf[kk], acc); }
                z[kb] = acc;
            }
            if (64 * jt + 63 < q0) sb_tile_weights<false>(z, R, jt, tq, hi); else sb_tile_weights<true>(z, R, jt, tq, hi);
#pragma unroll
            for (int kb = 0; kb < 2; ++kb)
#pragma unroll
                for (int s2 = 0; s2 < 2; ++s2) {
                    u32x4 pw; pw.x = pk2(z[kb][8 * s2 + 0], z[kb][8 * s2 + 1]); pw.y = pk2(z[kb][8 * s2 + 2], z[kb][8 * s2 + 3]); pw.z = pk2(z[kb][8 * s2 + 4], z[kb][8 * s2 + 5]); pw.w = pk2(z[kb][8 * s2 + 6], z[kb][8 * s2 + 7]);
                    const bf16x8 pb = __builtin_bit_cast(bf16x8, pw);
                    const int ko = 32 * kb + 16 * s2 + 4 * hi;
                    { const s16x4 lo = *(const LAS s16x4*)(VT + c * 72 + ko), hh = *(const LAS s16x4*)(VT + c * 72 + ko + 8);
                      const bf16x8 va = __builtin_shufflevector(lo, hh, 0, 1, 2, 3, 4, 5, 6, 7); o0 = MFMA32(va, pb, o0); }
                    { const s16x4 lo = *(const LAS s16x4*)(VT + (c + 32) * 72 + ko), hh = *(const LAS s16x4*)(VT + (c + 32) * 72 + ko + 8);
                      const bf16x8 va = __builtin_shufflevector(lo, hh, 0, 1, 2, 3, 4, 5, 6, 7); o1 = MFMA32(va, pb, o1); }
                }
        }
    }
    bf16_t* op = (bf16_t*)(p.ws + WS_OA) + (rowbase + tq) * 384 + h * 64 + 4 * hi;
#pragma unroll
    for (int g = 0; g < 4; ++g) {
        u32x2 w; w.x = pk2(o0[4 * g], o0[4 * g + 1]); w.y = pk2(o0[4 * g + 2], o0[4 * g + 3]); *(u32x2*)(op + 8 * g) = w;
        w.x = pk2(o1[4 * g], o1[4 * g + 1]); w.y = pk2(o1[4 * g + 2], o1[4 * g + 3]); *(u32x2*)(op + 32 + 8 * g) = w;
    }
}

DI void sb_sample_unit(const Ctx& p, int l, int b, int h, LAS unsigned char* lds) {
    const bf16_t* proj = (const bf16_t*)(p.ws + WS_PROJ);
    LAS float* qs = (LAS float*)lds;
    LAS float* Z = qs + 1024;
    LAS float* RED = Z + 16 * 1056;
    const int tid = pg8::tid_(), lane = tid & 63, wv = tid >> 6;
    const size_t srow = (size_t)MP + b * 16;
    for (int i = tid; i < 1024; i += NTHR) qs[i] = bf2f(proj[(srow + (i >> 6)) * NINP + C_QA + h * 64 + (i & 63)]) * 0.125f;
    __syncthreads();
    {
        float a0[16], a1[16];
#pragma unroll
        for (int i = 0; i < 16; ++i) { a0[i] = 0.f; a1[i] = 0.f; }
        const float* k0p = p.in[I_CSK] + ((((size_t)l * DB + b) * PAST + tid) * 6 + h) * 64; const float* k1p = k0p + (size_t)512 * 6 * 64;
#pragma unroll 8
        for (int d4 = 0; d4 < 16; ++d4) {
            const f32x4 ka = *(const f32x4*)(k0p + 4 * d4), kb = *(const f32x4*)(k1p + 4 * d4);
#pragma unroll
            for (int i = 0; i < 16; ++i) { const f32x4 q = *(const LAS f32x4*)(qs + i * 64 + 4 * d4);
                a0[i] += (q[0] * ka[0] + q[1] * ka[1]) + (q[2] * ka[2] + q[3] * ka[3]); a1[i] += (q[0] * kb[0] + q[1] * kb[1]) + (q[2] * kb[2] + q[3] * kb[3]); }
        }
#pragma unroll
        for (int i = 0; i < 16; ++i) { Z[i * 1056 + tid] = a0[i]; Z[i * 1056 + tid + 512] = a1[i]; }
        if (tid < 256) {
            const int i = tid >> 4, j = tid & 15; const bf16_t* kp = proj + (srow + j) * NINP + C_KA + h * 64; float s = 0.f;
            for (int d = 0; d < 64; ++d) s += qs[i * 64 + d] * bf2f(kp[d]);
            Z[i * 1056 + 1024 + j] = s;
        }
    }
    __syncthreads();
    for (int qq = 0; qq < 2; ++qq) {
        const int i = 2 * wv + qq, lim = PAST + i; LAS float* zr = Z + i * 1056;
        const int st = 17 * lane, en = (st + 17 < 1040) ? st + 17 : 1040;
        float tot = 0.f;
        for (int s = st; s < en; ++s) if (s < lim) tot -= softplusf_(zr[s]);
        float incl = tot;
#pragma unroll
        for (int o = 1; o < 64; o <<= 1) { const float t = __shfl_down(incl, o); if (lane + o < 64) incl += t; }
        float run = incl - tot;
        for (int s = en - 1; s >= st; --s) {
            const float zz = zr[s]; float w = 0.f;
            if (s < lim) { const float sp = softplusf_(zz); w = __expf(zz - sp + run); run -= sp; }
            zr[s] = w;
        }
    }
    __syncthreads();
    {
        const int d = tid & 63, g = tid >> 6;
        float o[16];
#pragma unroll
        for (int i = 0; i < 16; ++i) o[i] = 0.f;
        const float* vp = p.in[I_CSV] + (((size_t)l * DB + b) * PAST * 6 + h) * 64 + d;
        for (int s0 = 130 * g; s0 < 130 * g + 130; s0 += 26) {
            float v[26];
#pragma unroll
            for (int j = 0; j < 26; ++j) { const int s = s0 + j; v[j] = s < PAST ? vp[(size_t)s * 384] : bf2f(proj[(srow + (s - PAST)) * NINP + C_VA + h * 64 + d]); }
#pragma unroll
            for (int j = 0; j < 26; ++j)
#pragma unroll
                for (int i = 0; i < 16; ++i) o[i] += Z[i * 1056 + s0 + j] * v[j];
        }
#pragma unroll
        for (int i = 0; i < 16; ++i) RED[(g * 16 + i) * 64 + d] = o[i];
    }
    __syncthreads();
    for (int i = tid; i < 1024; i += NTHR) {
        const int qi = i >> 6, d = i & 63; float s = 0.f;
#pragma unroll
        for (int g = 0; g < 8; ++g) s += RED[(g * 16 + qi) * 64 + d];
        ((bf16_t*)(p.ws + WS_OA))[(srow + qi) * 384 + h * 64 + d] = f2bf(s);
    }
}

template <int W> DI void pool_rows(const float (&uu)[48], int t0, float* outp, bf16_t* pooled_col) {
    float s = 0.f;
#pragma unroll
    for (int i = 16 - W; i < 16; ++i) s += uu[i];
#pragma unroll
    for (int r = 0; r < 32; ++r) {
        s += uu[16 + r] - uu[16 + r - W];
        const int t = t0 + r; const float cnt = (float)((t + 1 < W) ? t + 1 : W);
        pooled_col[(size_t)r * 256] = f2bf(s / cnt - uu[16 + r]);
        if (t >= SEQ - 15) outp[(size_t)(t - (SEQ - 15)) * 256] = uu[16 + r];
    }
}
DI void pool_unit(const Ctx& p, int l, int unit) {
    const bf16_t* proj = (const bf16_t*)(p.ws + WS_PROJ); bf16_t* pooled = (bf16_t*)(p.ws + WS_POOLED);
    const int tid = pg8::tid_(), ch = tid & 255, w = 2 << (ch >> 6);
    if (unit < MP / 64) {
        const int r0 = unit * 64 + 32 * (tid >> 8), t0 = r0 & (SEQ - 1), b = r0 >> 11;
        float uu[48];
        const bf16_t* up = proj + (size_t)(r0 - 16) * NINP + C_U + ch;
#pragma unroll
        for (int i = 0; i < 48; ++i) uu[i] = (t0 - 16 + i >= 0) ? bf2f(up[(size_t)i * NINP]) : 0.f;
        float* outp = p.out + O_POOLP + ((size_t)(l * NB + b) * 15) * 256 + ch; bf16_t* pc = pooled + (size_t)r0 * 256 + ch;
        if (w == 2) pool_rows<2>(uu, t0, outp, pc); else if (w == 4) pool_rows<4>(uu, t0, outp, pc); else if (w == 8) pool_rows<8>(uu, t0, outp, pc); else pool_rows<16>(uu, t0, outp, pc);
        return;
    }
    for (int i = 0; i < 32; ++i) {
        const int row = unit * 64 + (tid >> 8) + 2 * i;
        const int rs = row - MP, b = rs >> 4, t = rs & 15; float s = 0.f;
        const bf16_t* up = proj + (size_t)row * NINP + C_U + ch; const float u0 = bf2f(up[0]);
        const float* hist = p.in[I_SPOOL] + ((size_t)(l * DB + b) * 15) * 256 + ch;
        for (int j = 0; j < w; ++j) { const int tt = t - j; s += tt >= 0 ? bf2f(*(up - (size_t)j * NINP)) : hist[(15 + tt) * 256]; }
        if (t >= 1) p.out[O_POOLS + ((size_t)(l * DB + b) * 15 + (t - 1)) * 256 + ch] = u0;
        pooled[(size_t)row * 256 + ch] = f2bf(s / (float)w - u0);
    }
}

DI void kvout_unit(const Ctx& p, int l, int unit) {
    const bf16_t* proj = (const bf16_t*)(p.ws + WS_PROJ);
#pragma unroll 4
    for (int i = pg8::tid_(); i < 64 * 96; i += NTHR) {
        const int r = i / 96, ch = i % 96, row = unit * 64 + r;
        const u32x4 w = *(const u32x4*)(proj + (size_t)row * NINP + C_KA + 8 * ch);
        const bool isv = ch >= 48; const int c = 8 * (isv ? ch - 48 : ch);
        float* dst = (row < MP) ? p.out + (isv ? O_VP : O_KP) + ((size_t)l * MP + row) * 384 + c : p.out + (isv ? O_VS : O_KS) + ((size_t)l * MS + (row - MP)) * 384 + c;
        *(f32x4*)dst = (f32x4){bflo(w.x), bfhi(w.x), bflo(w.y), bfhi(w.y)}; *(f32x4*)(dst + 4) = (f32x4){bflo(w.z), bfhi(w.z), bflo(w.w), bfhi(w.w)};
    }
}
DI void memout_unit(const Ctx& p, int unit) {
    const bf16_t* mkv = (const bf16_t*)(p.ws + WS_MKV);
    for (int i = pg8::tid_(); i < 16 * 256; i += NTHR) {
        const int r = i >> 8, ch = i & 255, row = unit * 16 + r, col = 8 * ch;
        const u32x4 w = *(const u32x4*)(mkv + (size_t)row * 2048 + col);
        float* dst = p.out + (col >= 1024 ? O_MVP : O_MKP) + (size_t)row * D + (col & 1023);
        *(f32x4*)dst = (f32x4){bflo(w.x), bfhi(w.x), bflo(w.y), bfhi(w.y)}; *(f32x4*)(dst + 4) = (f32x4){bflo(w.z), bfhi(w.z), bflo(w.w), bfhi(w.w)};
    }
}
DI void memvt_unit(const Ctx& p, int unit) {
    const int l = unit >> 7, nb = (unit >> 3) & 15, b = unit & 7, tid = pg8::tid_(), n = nb * 64 + (tid & 63), wv = tid >> 6;
    const bf16_t* src = (const bf16_t*)(p.ws + WS_MKV) + ((size_t)l * 2048 + b * 256) * 2048 + 1024 + n;
    bf16_t* dst = (bf16_t*)(p.ws + WS_MEMVT) + ((size_t)l * 1024 + n) * 2048 + b * 256;
    for (int c = wv; c < 32; c += 8) {
        unsigned v[8];
#pragma unroll
        for (int j = 0; j < 8; ++j) v[j] = src[(size_t)(8 * c + j) * 2048];
        u32x4 w; w.x = v[0] | (v[1] << 16); w.y = v[2] | (v[3] << 16); w.z = v[4] | (v[5] << 16); w.w = v[6] | (v[7] << 16);
        *(u32x4*)(dst + 8 * c) = w;
    }
}

DI void gla_decay(const Ctx& p, int l, int h, size_t row0, int ntok, LAS unsigned char* lds) {
    const bf16_t* proj = (const bf16_t*)(p.ws + WS_PROJ);
    LAS float* Bc = (LAS float*)lds; LAS float* LR = (LAS float*)(lds + 24576); LAS float* A2 = (LAS float*)(lds + 28672); LAS float* BIA = (LAS float*)(lds + 34816); LAS float* SEG = (LAS float*)(lds + 35200);
    const int tid = pg8::tid_();
    if (tid < 128) {
        const int t = tid >> 1, hf = tid & 1; u32x4 w = {0u, 0u, 0u, 0u};
        if (t < ntok) w = *(const u32x4*)(proj + (row0 + t) * NINP + C_LR + 8 * hf);
        LAS float* d = LR + t * 16 + 8 * hf;
        d[0] = bflo(w.x); d[1] = bfhi(w.x); d[2] = bflo(w.y); d[3] = bfhi(w.y); d[4] = bflo(w.z); d[5] = bfhi(w.z); d[6] = bflo(w.w); d[7] = bfhi(w.w);
    } else if (tid < 128 + 384) {
        const int i = tid - 128, r = i / 24, c4 = i % 24;
        *(LAS f32x4*)(A2 + r * 96 + 4 * c4) = *(const f32x4*)(p.in[I_WA2] + ((size_t)l * 16 + r) * 384 + h * 96 + 4 * c4);
    }
    if (tid < 96) BIA[tid] = p.in[I_BA][l * 384 + h * 96 + tid];
    __syncthreads();
    for (int i = tid; i < 64 * 96; i += NTHR) {
        const int t = i / 96, k = i % 96; float sacc = BIA[k];
#pragma unroll
        for (int r = 0; r < 16; ++r) sacc += LR[t * 16 + r] * A2[r * 96 + k];
        Bc[i] = t < ntok ? -softplusf_(-sacc) * (1.f / 16.f) : 0.f;
    }
    __syncthreads();
    const int k = tid % 96, seg = tid / 96;
    if (tid < 384) { float run = 0.f; for (int i = 0; i < 16; ++i) { const int idx = (16 * seg + i) * 96 + k; run += Bc[idx]; Bc[idx] = run; } SEG[seg * 96 + k] = run; }
    __syncthreads();
    if (tid < 384 && seg > 0) { float off = 0.f; for (int s2 = 0; s2 < seg; ++s2) off += SEG[s2 * 96 + k]; for (int i = 0; i < 16; ++i) Bc[(16 * seg + i) * 96 + k] += off; }
    __syncthreads();
}
DI void gla_unit_rows(int gu, size_t& row0, int& ntok, int& bh, int& h) {
    if (gu < NGU_P) { bh = gu >> 5; const int c = gu & 31, b = bh >> 2; h = bh & 3; row0 = (size_t)b * SEQ + c * 64; ntok = 64; }
    else { bh = gu - NGU_P; const int b = bh >> 2; h = bh & 3; row0 = (size_t)MP + b * 16; ntok = 16; }
}
DI void gla_stage1_unit(const Ctx& p, int l, int gu, LAS unsigned char* lds) {
    const bf16_t* proj = (const bf16_t*)(p.ws + WS_PROJ);
    size_t row0; int ntok, bh, h; gla_unit_rows(gu, row0, ntok, bh, h);
    gla_decay(p, l, h, row0, ntok, lds);
    LAS float* Bc = (LAS float*)lds;
    LAS unsigned short* KT = (LAS unsigned short*)(lds + 36864);
    LAS unsigned short* VT = KT + 96 * 72;
    const int tid = pg8::tid_(), lane = tid & 63, wv = tid >> 6, fr = lane & 15, fq = lane >> 4;
    {
        float* bb = (float*)(p.ws + WS_BB) + (size_t)gu * (64 * GK);
        for (int i = tid; i < 64 * GK / 4; i += NTHR) *(f32x4*)(bb + 4 * i) = *(const LAS f32x4*)(Bc + 4 * i);
    }
    for (int task = tid; task < 768; task += NTHR) {
        const int t = task & 63, ch = task >> 6; u32x4 kw = {0u, 0u, 0u, 0u}, vw = {0u, 0u, 0u, 0u};
        if (t < ntok) { const bf16_t* rp = proj + (row0 + t) * NINP + h * 96 + 8 * ch; kw = *(const u32x4*)(rp + C_KC); vw = *(const u32x4*)(rp + C_VC); }
        const unsigned kk[4] = {kw.x, kw.y, kw.z, kw.w}, vv[4] = {vw.x, vw.y, vw.z, vw.w};
#pragma unroll
        for (int j = 0; j < 4; ++j) {
            const int k0 = 8 * ch + 2 * j;
            const float e0 = __expf(Bc[(ntok - 1) * 96 + k0] - Bc[t * 96 + k0]), e1 = __expf(Bc[(ntok - 1) * 96 + k0 + 1] - Bc[t * 96 + k0 + 1]);
            KT[k0 * 72 + t] = f2bf(bflo(kk[j]) * e0); KT[(k0 + 1) * 72 + t] = f2bf(bfhi(kk[j]) * e1);
            VT[k0 * 72 + t] = (unsigned short)(vv[j] & 0xffffu); VT[(k0 + 1) * 72 + t] = (unsigned short)(vv[j] >> 16);
        }
    }
    if (tid < 96) ((float*)(p.ws + WS_GDEC))[(size_t)gu * 96 + tid] = __expf(Bc[(ntok - 1) * 96 + tid]);
    __syncthreads();
    float* KV = (float*)(p.ws + WS_GKV) + (size_t)gu * (GK * GK);
    for (int tile = wv; tile < 36; tile += 8) {
        const int ki = tile / 6, vi = tile % 6; f32x4 acc = {0.f, 0.f, 0.f, 0.f};
#pragma unroll
        for (int ks = 0; ks < 2; ++ks) { const bf16x8 a = *(const LAS bf16x8*)(KT + (16 * ki + fr) * 72 + 32 * ks + 8 * fq), bb = *(const LAS bf16x8*)(VT + (16 * vi + fr) * 72 + 32 * ks + 8 * fq); acc = MFMA16(a, bb, acc); }
#pragma unroll
        for (int j = 0; j < 4; ++j) KV[(16 * ki + 4 * fq + j) * 96 + 16 * vi + fr] = acc[j];
    }
}
DI void gla_scan(const Ctx& p, int l) {
    const int gt = blockIdx.x * NTHR + pg8::tid_(), NT = gridDim.x * NTHR;
    const float* KV = (const float*)(p.ws + WS_GKV); const float* DEC = (const float*)(p.ws + WS_GDEC); float* SP = (float*)(p.ws + WS_GSP);
    for (int e = gt; e < 32 * GK * GK; e += NT) {
        const int bh = e / (GK * GK), kv = e % (GK * GK), k = kv / GK; float S = 0.f;
        float kvv[32], dcv[32];
#pragma unroll
        for (int c = 0; c < 32; ++c) { const size_t gu = (size_t)bh * 32 + c; kvv[c] = KV[gu * (GK * GK) + kv]; dcv[c] = DEC[gu * 96 + k]; }
#pragma unroll
        for (int c = 0; c < 32; ++c) { const size_t gu = (size_t)bh * 32 + c; SP[gu * (GK * GK) + kv] = S; S = dcv[c] * S + kvv[c]; }
        p.out[O_GLAP + ((size_t)l * 32 + bh) * (GK * GK) + kv] = S;
    }
    for (int e = gt; e < 64 * GK * GK; e += NT) {
        const int bh = e / (GK * GK), kv = e % (GK * GK), k = kv / GK; const size_t gu = (size_t)NGU_P + bh;
        const float S0 = p.in[I_SGLA][((size_t)l * 64 + bh) * (GK * GK) + kv];
        p.out[O_GLAS + ((size_t)l * 64 + bh) * (GK * GK) + kv] = DEC[gu * 96 + k] * S0 + KV[gu * (GK * GK) + kv];
    }
}
DI void gla_stage3_unit(const Ctx& p, int l, int gu, LAS unsigned char* lds) {
    const bf16_t* proj = (const bf16_t*)(p.ws + WS_PROJ);
    size_t row0; int ntok, bh, h; gla_unit_rows(gu, row0, ntok, bh, h);
    LAS float* OT = (LAS float*)lds;
    LAS unsigned short* QP = (LAS unsigned short*)(lds + 36864);
    LAS unsigned short* KP = QP + 64 * 104;
    LAS unsigned short* VT = KP + 64 * 104;
    LAS unsigned short* ST = VT + 96 * 72;
    LAS unsigned short* ATT = ST + 96 * 104;
    const int tid = pg8::tid_(), lane = tid & 63, wv = tid >> 6, fr = lane & 15, fq = lane >> 4;
    const float* Sprev = gu < NGU_P ? (const float*)(p.ws + WS_GSP) + (size_t)gu * (GK * GK) : p.in[I_SGLA] + ((size_t)l * 64 + bh) * (GK * GK);
    const float* bb = (const float*)(p.ws + WS_BB) + (size_t)gu * (64 * GK);
    __syncthreads();
    for (int task = tid; task < 768; task += NTHR) {
        const int t = task & 63, ch = task >> 6; u32x4 qw = {0u, 0u, 0u, 0u}, kw = qw, vw = qw; f32x4 b0 = {0.f, 0.f, 0.f, 0.f}, b1 = b0;
        if (t < ntok) { const bf16_t* rp = proj + (row0 + t) * NINP + h * 96 + 8 * ch; qw = *(const u32x4*)(rp + C_QC); kw = *(const u32x4*)(rp + C_KC); vw = *(const u32x4*)(rp + C_VC);
            b0 = *(const f32x4*)(bb + t * 96 + 8 * ch); b1 = *(const f32x4*)(bb + t * 96 + 8 * ch + 4); }
        const unsigned qq[4] = {qw.x, qw.y, qw.z, qw.w}, kk[4] = {kw.x, kw.y, kw.z, kw.w}, vv[4] = {vw.x, vw.y, vw.z, vw.w};
        const float be[8] = {b0[0], b0[1], b0[2], b0[3], b1[0], b1[1], b1[2], b1[3]};
        u32x4 qo, ko; unsigned qa[4], ka[4];
#pragma unroll
        for (int j = 0; j < 4; ++j) {
            const float e0 = __expf(be[2 * j]), e1 = __expf(be[2 * j + 1]), r0 = __builtin_amdgcn_rcpf(e0), r1 = __builtin_amdgcn_rcpf(e1);
            const bool ok = t < ntok;
            qa[j] = ok ? pk2(bflo(qq[j]) * 0.10206207261596575f * e0, bfhi(qq[j]) * 0.10206207261596575f * e1) : 0u;
            ka[j] = ok ? pk2(bflo(kk[j]) * r0, bfhi(kk[j]) * r1) : 0u;
            VT[(8 * ch + 2 * j) * 72 + t] = (unsigned short)(vv[j] & 0xffffu); VT[(8 * ch + 2 * j + 1) * 72 + t] = (unsigned short)(vv[j] >> 16);
        }
        qo.x = qa[0]; qo.y = qa[1]; qo.z = qa[2]; qo.w = qa[3]; ko.x = ka[0]; ko.y = ka[1]; ko.z = ka[2]; ko.w = ka[3];
        *(LAS u32x4*)(QP + t * 104 + 8 * ch) = qo; *(LAS u32x4*)(KP + t * 104 + 8 * ch) = ko;
    }
    for (int task = tid; task < 2304; task += NTHR) {
        const int k = task % 96, vc = task / 96; const f32x4 sv = *(const f32x4*)(Sprev + k * 96 + 4 * vc);
#pragma unroll
        for (int j = 0; j < 4; ++j) ST[(4 * vc + j) * 104 + k] = f2bf(sv[j]);
    }
    __syncthreads();
    for (int tile = 2 * wv; tile < 2 * wv + 2; ++tile) {
        const int ti = tile >> 2, si = tile & 3; f32x4 acc = {0.f, 0.f, 0.f, 0.f};
        if (si <= ti) {
#pragma unroll
            for (int ks = 0; ks < 3; ++ks) { const bf16x8 a = *(const LAS bf16x8*)(QP + (16 * ti + fr) * 104 + 32 * ks + 8 * fq), b2 = *(const LAS bf16x8*)(KP + (16 * si + fr) * 104 + 32 * ks + 8 * fq); acc = MFMA16(a, b2, acc); }
        }
#pragma unroll
        for (int j = 0; j < 4; ++j) { const int t = 16 * ti + 4 * fq + j, s2 = 16 * si + fr; ATT[t * 72 + s2] = f2bf(s2 <= t ? acc[j] : 0.f); }
    }
    __syncthreads();
    for (int tile = wv; tile < 24; tile += 8) {
        const int ti = tile / 6, vi = tile % 6; f32x4 acc = {0.f, 0.f, 0.f, 0.f};
#pragma unroll
        for (int ks = 0; ks < 2; ++ks) { const bf16x8 a = *(const LAS bf16x8*)(ATT + (16 * ti + fr) * 72 + 32 * ks + 8 * fq), b2 = *(const LAS bf16x8*)(VT + (16 * vi + fr) * 72 + 32 * ks + 8 * fq); acc = MFMA16(a, b2, acc); }
#pragma unroll
        for (int ks = 0; ks < 3; ++ks) { const bf16x8 a = *(const LAS bf16x8*)(QP + (16 * ti + fr) * 104 + 32 * ks + 8 * fq), b2 = *(const LAS bf16x8*)(ST + (16 * vi + fr) * 104 + 32 * ks + 8 * fq); acc = MFMA16(a, b2, acc); }
#pragma unroll
        for (int j = 0; j < 4; ++j) OT[(16 * ti + 4 * fq + j) * 96 + 16 * vi + fr] = acc[j];
    }
    __syncthreads();
    bf16_t* oc = (bf16_t*)(p.ws + WS_OC);
    const float* gn = p.in[I_GLAN] + l * 384 + h * 96; const float gn0 = gn[lane], gn1 = lane < 32 ? gn[64 + lane] : 0.f;
    float g0[8], g1[8];
#pragma unroll
    for (int tt = 0; tt < 8; ++tt) { const int t = wv * 8 + tt; g0[tt] = 0.f; g1[tt] = 0.f;
        if (t < ntok) { const bf16_t* gp = proj + (row0 + t) * NINP + C_GC + h * 96; g0[tt] = bf2f(gp[lane]); if (lane < 32) g1[tt] = bf2f(gp[64 + lane]); } }
#pragma unroll
    for (int tt = 0; tt < 8; ++tt) {
        const int t = wv * 8 + tt;
        if (t < ntok) {
            const float a0 = OT[t * 96 + lane], a1 = lane < 32 ? OT[t * 96 + 64 + lane] : 0.f;
            const float rs = rsqrtf(wave_sum(a0 * a0 + a1 * a1) * (1.f / 96.f) + EPS);
            oc[(row0 + t) * 384 + h * 96 + lane] = f2bf(a0 * rs * gn0 * g0[tt] * sigmoidf_(g0[tt]));
            if (lane < 32) oc[(row0 + t) * 384 + h * 96 + 64 + lane] = f2bf(a1 * rs * gn1 * g1[tt] * sigmoidf_(g1[tt]));
        }
    }
}

DI void cross_sample_unit(const Ctx& p, int l, int b, int h, int qh, LAS unsigned char* lds) {
    LAS float* qs = (LAS float*)lds;
    LAS float* ST = qs + 8 * 256;
    LAS float* PART = ST + 256 * 8;
    const bf16_t* Q = (const bf16_t*)(p.ws + WS_Q);
    const int tid = pg8::tid_(), lane = tid & 63, wv = tid >> 6;
    const size_t srow = (size_t)MP + b * 16 + 8 * qh;
    for (int i = tid; i < 8 * 256; i += NTHR) qs[i] = bf2f(Q[(srow + (i >> 8)) * D + h * 256 + (i & 255)]) * 0.0625f;
    __syncthreads();
    const int m = tid & 255, half = tid >> 8;
    {
        float acc[8];
#pragma unroll
        for (int i = 0; i < 8; ++i) acc[i] = 0.f;
        const float* kp = p.in[I_CMK] + ((((size_t)l * DB + b) * 256 + m) * 4 + h) * 256 + 128 * half;
#pragma unroll 16
        for (int d4 = 0; d4 < 32; ++d4) {
            const f32x4 kv = *(const f32x4*)(kp + 4 * d4);
#pragma unroll
            for (int i = 0; i < 8; ++i) { const f32x4 q = *(const LAS f32x4*)(qs + i * 256 + 128 * half + 4 * d4); acc[i] += (q[0] * kv[0] + q[1] * kv[1]) + (q[2] * kv[2] + q[3] * kv[3]); }
        }
#pragma unroll
        for (int i = 0; i < 8; ++i) PART[(half * 8 + i) * 256 + m] = acc[i];
    }
    __syncthreads();
    {
        const int i = wv; float v[4], mx = -3.0e38f;
#pragma unroll
        for (int j = 0; j < 4; ++j) { v[j] = PART[i * 256 + lane + 64 * j] + PART[(8 + i) * 256 + lane + 64 * j]; mx = fmaxf(mx, v[j]); }
        mx = wave_max(mx); float sum = 0.f;
#pragma unroll
        for (int j = 0; j < 4; ++j) { v[j] = __expf(v[j] - mx); sum += v[j]; }
        sum = wave_sum(sum); const float inv = 1.f / sum;
#pragma unroll
        for (int j = 0; j < 4; ++j) ST[(lane + 64 * j) * 8 + i] = v[j] * inv;
    }
    __syncthreads();
    {
        float acc[8];
#pragma unroll
        for (int i = 0; i < 8; ++i) acc[i] = 0.f;
        const float* vp = p.in[I_CMV] + ((((size_t)l * DB + b) * 256 + 128 * half) * 4 + h) * 256 + m;
        for (int k0 = 0; k0 < 128; k0 += 32) {
            float v[32];
#pragma unroll
            for (int j = 0; j < 32; ++j) v[j] = vp[(size_t)(k0 + j) * 1024];
#pragma unroll
            for (int j = 0; j < 32; ++j) {
                const f32x4 s0 = *(const LAS f32x4*)(ST + (128 * half + k0 + j) * 8), s1 = *(const LAS f32x4*)(ST + (128 * half + k0 + j) * 8 + 4);
                acc[0] += s0[0] * v[j]; acc[1] += s0[1] * v[j]; acc[2] += s0[2] * v[j]; acc[3] += s0[3] * v[j];
                acc[4] += s1[0] * v[j]; acc[5] += s1[1] * v[j]; acc[6] += s1[2] * v[j]; acc[7] += s1[3] * v[j];
            }
        }
#pragma unroll
        for (int i = 0; i < 8; ++i) PART[(half * 8 + i) * 256 + m] = acc[i];
    }
    __syncthreads();
    bf16_t* O = (bf16_t*)(p.ws + WS_O);
    for (int i = tid; i < 8 * 256; i += NTHR) { const int qi = i >> 8, d = i & 255; O[(srow + qi) * D + h * 256 + d] = f2bf(PART[qi * 256 + d] + PART[(8 + qi) * 256 + d]); }
}

struct SkBf16 { bf16_t* O; int ldc; DI void operator()(int row, int col, f32x4 v) const { u32x2 w; w.x = pk2(v[0], v[1]); w.y = pk2(v[2], v[3]); *(u32x2*)(O + (size_t)(MP + row) * ldc + col) = w; } };
struct SkGate { bf16_t* merged; const bf16_t* proj; int goff; int accum;
    DI void operator()(int row, int col, f32x4 v) const {
        const u32x2 g = *(const u32x2*)(proj + (size_t)(MP + row) * NINP + goff + col); bf16_t* mp = merged + (size_t)(MP + row) * D + col;
        u32x2 pm2 = {0u, 0u}; if (accum) pm2 = *(const u32x2*)mp;
        u32x2 w; w.x = pk2(sigmoidf_(bflo(g.x)) * v[0] + bflo(pm2.x), sigmoidf_(bfhi(g.x)) * v[1] + bfhi(pm2.x)); w.y = pk2(sigmoidf_(bflo(g.y)) * v[2] + bflo(pm2.y), sigmoidf_(bfhi(g.y)) * v[3] + bfhi(pm2.y));
        *(u32x2*)mp = w; } };
template <class EF> DI void skinny_gemm(const bf16_t* A, int lda, const bf16_t* Bt, int ldb, int K, int N, int G, int bx, LAS unsigned char* lds, const EF& ef) {
    const int tid = pg8::tid_(), lane = tid & 63, wv = tid >> 6, fr = lane & 15, fq = lane >> 4, nks = K >> 5, nunits = 4 * (N >> 4);
    LAS f32x4* red = (LAS f32x4*)lds;
    for (int u = bx; u < nunits; u += G) {
        const int rb = u & 3, cb = u >> 2;
        f32x4 acc[4];
#pragma unroll
        for (int i = 0; i < 4; ++i) acc[i] = (f32x4){0.f, 0.f, 0.f, 0.f};
        const bf16_t* bp = Bt + (size_t)(16 * cb + fr) * ldb + 8 * fq; const bf16_t* ap = A + (size_t)(64 * rb + fr) * lda + 8 * fq;
        for (int ks = wv; ks < nks; ks += 8) {
            const bf16x8 bb = *(const bf16x8*)(bp + 32 * ks);
            bf16x8 aa[4];
#pragma unroll
            for (int i = 0; i < 4; ++i) aa[i] = *(const bf16x8*)(ap + (size_t)(16 * i) * lda + 32 * ks);
#pragma unroll
            for (int i = 0; i < 4; ++i) acc[i] = MFMA16(bb, aa[i], acc[i]);
        }
#pragma unroll
        for (int i = 0; i < 4; ++i) red[(wv * 4 + i) * 64 + lane] = acc[i];
        __syncthreads();
        if (tid < 256) {
            const int i = tid >> 6; f32x4 s = red[i * 64 + lane];
#pragma unroll
            for (int w = 1; w < 8; ++w) s = s + red[(w * 4 + i) * 64 + lane];
            ef(64 * rb + 16 * i + fr, 16 * cb + 4 * fq, s);
        }
        __syncthreads();
    }
}

constexpr int PH_PER_LAYER = 15, N_PHASES = 1 + DEPTH * PH_PER_LAYER;
#define RUN_GEMM(EpiT, E, Aptr, lda_, Bptr, ldb_, K_, pm0_, nM_, nN_) do { const pg8::Gemm g_{(K_), (lda_), (ldb_)}; pg8::TileOrder S_; S_.init((Aptr), (lda_), (Bptr), (ldb_), (pm0_), (nM_), (nN_), G, bx); \
        pg8::gemm_phase<EpiT, pg8::TileOrder, true, true>(lds, g_, S_, (E)); } while (0)

__global__ void __launch_bounds__(NTHR, 2) fwd_kernel(Params p) {
    extern __shared__ __attribute__((aligned(16))) unsigned char lds_raw[];
#define PROJ ((bf16_t*)(ws + WS_PROJ))
#define H ((bf16_t*)(ws + WS_H))
#define MERGED ((bf16_t*)(ws + WS_MERGED))
#define Y ((bf16_t*)(ws + WS_Y))
#define QB ((bf16_t*)(ws + WS_Q))
#define PB ((bf16_t*)(ws + WS_P))
#define OB ((bf16_t*)(ws + WS_O))
#define ACT ((bf16_t*)(ws + WS_ACT))

    {
        volatile LAS unsigned* st0 = (volatile LAS unsigned*)((LAS unsigned char*)lds_raw + LDS_MISC + 32);
        if (pg8::tid_() == 0) { st0[0] = 0u; st0[1] = 0u; st0[8] = 0u; st0[9] = 0u; }
        __syncthreads();
    }
    XcdBarrier xbar = xcd_barrier_post((unsigned*)(p.ws + WS_CTL) + CW_BAR, (volatile LAS unsigned*)((LAS unsigned char*)lds_raw + LDS_MISC + 32));
    if (p.ph_lo == 0) {
        prologue(p, (LAS unsigned char*)lds_raw);
        if (blockIdx.x == 0 && pg8::tid_() == 0) {
            const float** tab = (const float**)(p.ws + WS_TAB);
#pragma unroll
            for (int i = 0; i < N_IN; ++i) tab[i] = p.in[i];
        }
        if (p.ph_hi > 1) xcd_barrier(xbar);
        if (p.ph_hi < 0) cg::this_grid().sync();
    }
    for (int ph = p.ph_lo > 1 ? p.ph_lo : 1; ph < p.ph_hi; ++ph) {
        unsigned ldsb = (unsigned)(size_t)(LAS unsigned char*)lds_raw; asm volatile("" : "+s"(ldsb));
        LAS unsigned char* lds = (LAS unsigned char*)(size_t)ldsb;
        volatile LAS int* slot = (volatile LAS int*)(lds + LDS_MISC);
        unsigned char* ws = p.ws; asm volatile("" : "+s"(ws));
        Ctx c; c.ws = ws; c.in.t = (const float* const*)(ws + WS_TAB); c.out = p.out;
        unsigned* ctl = (unsigned*)(ws + WS_CTL);
        int G = gridDim.x, bx = blockIdx.x; asm volatile("" : "+s"(G), "+s"(bx));
        {
            const int l = (ph - 1) / PH_PER_LAYER, st = (ph - 1) % PH_PER_LAYER;
#ifdef PROBE_SEL
            if (bx == 0) { volatile LAS unsigned long long* a_ = (volatile LAS unsigned long long*)(lds + LDS_MISC + 64); a_[1] = __builtin_amdgcn_s_memrealtime(); }
#endif
            switch (st) {
            case 0: {
                EpiBf16 E{PROJ, NINP, 0xffff};
                RUN_GEMM(EpiBf16, E, H, D, ws + WS_WIN + l * SZ_WIN, D, D, 0, MA / 256, NINP / 256);
                if (l == 0) {
                    const pg8::Gemm g{D, D, D}; MemKvOrder S{G, bx, (const char*)(ws + WS_MN), (const char*)(ws + WS_WKV)};
                    EpiBf16 E2{(bf16_t*)(ws + WS_MKV), 2048, 7};
                    pg8::gemm_phase<EpiBf16, MemKvOrder, true, true>(lds, g, S, E2);
                }
            } break;
            case 1: {
                unsigned* ctr = ctl + 64 * ph;
                constexpr int U_SBP = 384, U_SBS = U_SBP + DB * 6, U_GLA = U_SBS + NGU, U_POOL = U_GLA + MA / 64, U_KV = U_POOL + MA / 64, U_MO = U_KV + 512, U_VT = U_MO + 512;
                const int U_ALL = l == 0 ? U_VT : U_KV;
                for (;;) {
                    const int u = next_work(ctr, slot); if (u >= U_ALL) break;
#ifdef PROBE_SEL
                    const int ut_ = u < DB * 6 ? 10 : (u < U_SBS ? 11 : (u < U_GLA ? 12 : 13));
                    if (bx == 0 && ut_ == PROBE_SEL) { volatile LAS unsigned long long* a_ = (volatile LAS unsigned long long*)(lds + LDS_MISC + 64); a_[3] = __builtin_amdgcn_s_memrealtime(); }
#endif
                    if (u < DB * 6) sb_sample_unit(c, l, u / 6, u % 6, lds);
                    else if (u < U_SBS) { const int v = u - DB * 6, qb = 7 - v / 48, bh = v % 48; sb_prompt_unit(c, bh / 6, bh % 6, qb, lds); }
                    else if (u < U_GLA) gla_stage1_unit(c, l, u - U_SBS, lds);
                    else if (u < U_POOL) pool_unit(c, l, u - U_GLA);
                    else if (u < U_KV) kvout_unit(c, l, u - U_POOL);
                    else if (u < U_MO) memout_unit(c, u - U_KV);
                    else memvt_unit(c, u - U_MO);
#ifdef PROBE_SEL
                    if (bx == 0 && ut_ == PROBE_SEL) { volatile LAS unsigned long long* a_ = (volatile LAS unsigned long long*)(lds + LDS_MISC + 64); __hip_atomic_fetch_add((LAS unsigned long long*)a_, __builtin_amdgcn_s_memrealtime() - a_[3], __ATOMIC_RELAXED, __HIP_MEMORY_SCOPE_WORKGROUP); }
#endif
                }
            } break;
            case 2: gla_scan(c, l); break;
            case 3: {
                unsigned* ctr = ctl + 64 * ph;
                for (;;) { const int u = next_work(ctr, slot); if (u >= NGU) break; gla_stage3_unit(c, l, u, lds); }
            } break;
            case 4: {
                EpiGate E1{MERGED, PROJ, C_GA, 0}, E2{MERGED, PROJ, C_GB, 1}, E3{MERGED, PROJ, C_GCG, 1};
                RUN_GEMM(EpiGate, E1, ws + WS_OA, 384, ws + WS_WBA + l * SZ_WBA, 384, 384, 0, MP / 256, 4);
                RUN_GEMM(EpiGate, E2, ws + WS_POOLED, 256, ws + WS_WBB + l * SZ_WBB, 256, 256, 0, MP / 256, 4);
                RUN_GEMM(EpiGate, E3, ws + WS_OC, 384, ws + WS_WBC + l * SZ_WBA, 384, 384, 0, MP / 256, 4);
                { SkGate F1{MERGED, PROJ, C_GA, 0}, F2{MERGED, PROJ, C_GB, 1}, F3{MERGED, PROJ, C_GCG, 1};
                  skinny_gemm((const bf16_t*)(ws + WS_OA) + (size_t)MP * 384, 384, (const bf16_t*)(ws + WS_WBA + l * SZ_WBA), 384, 384, D, G, bx, lds, F1);
                  skinny_gemm((const bf16_t*)(ws + WS_POOLED) + (size_t)MP * 256, 256, (const bf16_t*)(ws + WS_WBB + l * SZ_WBB), 256, 256, D, G, bx, lds, F2);
                  skinny_gemm((const bf16_t*)(ws + WS_OC) + (size_t)MP * 384, 384, (const bf16_t*)(ws + WS_WBC + l * SZ_WBA), 384, 384, D, G, bx, lds, F3); }
            } break;
            case 5: { EpiBf16 E{Y, D, 0xffff}; RUN_GEMM(EpiBf16, E, MERGED, D, ws + WS_WMIX + l * SZ_WSQ, D, D, 0, MP / 256, 4);
                SkBf16 F{Y, D}; skinny_gemm((const bf16_t*)MERGED + (size_t)MP * D, D, (const bf16_t*)(ws + WS_WMIX + l * SZ_WSQ), D, D, D, G, bx, lds, F); } break;
            case 6: norm_phase(c, c.in[I_NMIXPOST] + l * D, c.in[I_NXPRE] + l * D, G, bx); break;
            case 7: { EpiBf16 E{QB, D, 0xffff}; RUN_GEMM(EpiBf16, E, H, D, ws + WS_WXQ + l * SZ_WSQ, D, D, 0, MP / 256, 4);
                SkBf16 F{QB, D}; skinny_gemm((const bf16_t*)H + (size_t)MP * D, D, (const bf16_t*)(ws + WS_WXQ + l * SZ_WSQ), D, D, D, G, bx, lds, F); } break;
            case 8: {
                const pg8::Gemm g{256, D, 2048}; CrossOrder S{G, bx, (const char*)QB, (const char*)(ws + WS_MKV + (size_t)l * 2 * SZ_WKV), 0};
                EpiSoftmax E{PB, (LAS float*)(lds + LDS_X)};
                pg8::gemm_phase<EpiSoftmax, CrossOrder, true, true>(lds, g, S, E);
            } break;
            case 9: {
                const pg8::Gemm g{256, D, 2048}; CrossOrder S{G, bx, (const char*)PB, (const char*)(ws + WS_MEMVT + (size_t)l * SZ_WKV), 1};
                EpiBf16 E{OB, D, 0xffff};
                pg8::gemm_phase<EpiBf16, CrossOrder, true, true>(lds, g, S, E);
                for (int u = bx; u < DB * 4 * 2; u += G) { __syncthreads(); cross_sample_unit(c, l, u >> 3, (u >> 1) & 3, u & 1, lds); }
            } break;
            case 10: { EpiBf16 E{Y, D, 0xffff}; RUN_GEMM(EpiBf16, E, OB, D, ws + WS_WXO + l * SZ_WSQ, D, D, 0, MP / 256, 4);
                SkBf16 F{Y, D}; skinny_gemm((const bf16_t*)OB + (size_t)MP * D, D, (const bf16_t*)(ws + WS_WXO + l * SZ_WSQ), D, D, D, G, bx, lds, F); } break;
            case 11: norm_phase(c, c.in[I_NXPOST] + l * D, c.in[I_NFPRE] + l * D, G, bx); break;
            case 12: { EpiSwiglu E{ACT}; RUN_GEMM(EpiSwiglu, E, H, D, ws + WS_WF1 + l * SZ_WF1, D, D, 0, MA / 256, FF2 / 256); } break;
            case 13: { EpiBf16 E{Y, D, 0xffff}; RUN_GEMM(EpiBf16, E, ACT, FF, ws + WS_WF2 + l * SZ_WF2, FF, FF, 0, MP / 256, 4);
                SkBf16 F{Y, D}; skinny_gemm((const bf16_t*)ACT + (size_t)MP * FF, FF, (const bf16_t*)(ws + WS_WF2 + l * SZ_WF2), FF, FF, D, G, bx, lds, F); } break;
            default: norm_phase(c, c.in[I_NFPOST] + l * D, l < DEPTH - 1 ? c.in[I_NMIXPRE] + (l + 1) * D : nullptr, G, bx); break;
            }
#ifdef PROBE_SEL
            {
                const int sel = PROBE_SEL; bool hit = false;
                if (sel == 2) hit = (st == 0 || st == 4 || st == 5 || st == 7 || st == 10 || st == 12 || st == 13);
                if (sel == 3) hit = (st == 2 || st == 3);
                if (sel == 4) hit = (st == 8 || st == 9);
                if (sel == 5) hit = (st == 6 || st == 11 || st == 14);
                if (sel == 6) hit = (st == 1);
                if (sel == 7) hit = (st == 0);
                if (sel == 8) hit = (st == 12);
                if (sel == 9) hit = (st == 13);
                if (bx == 0 && hit) { volatile LAS unsigned long long* a_ = (volatile LAS unsigned long long*)(lds + LDS_MISC + 64); __hip_atomic_fetch_add((LAS unsigned long long*)a_, __builtin_amdgcn_s_memrealtime() - a_[1], __ATOMIC_RELAXED, __HIP_MEMORY_SCOPE_WORKGROUP); }
            }
#endif
        }
#ifdef PROBE_SEL
        if (bx == 0) { volatile LAS unsigned long long* a_ = (volatile LAS unsigned long long*)(lds + LDS_MISC + 64); a_[2] = __builtin_amdgcn_s_memrealtime(); }
#endif
        if (ph + 1 < p.ph_hi) { if ((ph - 1) % PH_PER_LAYER == 8) { __threadfence(); __syncthreads(); } else xcd_barrier(xbar); }
#ifdef PROBE_SEL
        if (PROBE_SEL == 1 && bx == 0) { volatile LAS unsigned long long* a_ = (volatile LAS unsigned long long*)(lds + LDS_MISC + 64); __hip_atomic_fetch_add((LAS unsigned long long*)a_, __builtin_amdgcn_s_memrealtime() - a_[2], __ATOMIC_RELAXED, __HIP_MEMORY_SCOPE_WORKGROUP); }
#endif
    }
#ifdef PROBE_SEL
    __syncthreads();
    if (blockIdx.x == 0) {
        volatile LAS unsigned long long* a_ = (volatile LAS unsigned long long*)((LAS unsigned char*)lds_raw + LDS_MISC + 64);
        const unsigned long long d_ = a_[0] >> 9, s_ = __builtin_amdgcn_s_memrealtime();
        while (__builtin_amdgcn_s_memrealtime() - s_ < d_) __builtin_amdgcn_s_sleep(8);
    }
#endif
}

extern "C" void kernel_launch(void* const* d_in, const int* in_sizes, int n_in, void* d_out, int out_size, void* d_ws, size_t ws_size, hipStream_t stream) {
    static int grid = 0;
    if (grid == 0) {
        if (n_in != N_IN || (size_t)out_size != O_END || ws_size < WS_END) { fprintf(stderr, "kernel_launch: unexpected shapes: n_in %d out %d ws %zu (need %zu)\n", n_in, out_size, ws_size, (size_t)WS_END); grid = -1; return; }
        int dev = 0, cus = 0, per_cu = 0;
        (void)hipGetDevice(&dev); (void)hipDeviceGetAttribute(&cus, hipDeviceAttributeMultiprocessorCount, dev);
        (void)hipFuncSetAttribute((const void*)fwd_kernel, hipFuncAttributeMaxDynamicSharedMemorySize, LDS_BYTES);
        if (hipOccupancyMaxActiveBlocksPerMultiprocessor(&per_cu, (const void*)fwd_kernel, NTHR, LDS_BYTES) != hipSuccess || per_cu < 1) { fprintf(stderr, "kernel_launch: occupancy query gave %d\n", per_cu); per_cu = 1; }
        (void)hipGetLastError();
        grid = cus * per_cu;
    }
    if (grid < 0) return;
    (void)hipMemsetAsync((char*)d_ws + WS_CTL, 0, CTL_BYTES, stream);
    Params p{};
    for (int i = 0; i < N_IN; ++i) p.in[i] = (const float*)d_in[i];
    p.out = (float*)d_out; p.ws = (unsigned char*)d_ws;
#ifdef MULTI_LAUNCH
    for (int ph = 0; ph < N_PHASES; ++ph) { p.ph_lo = ph; p.ph_hi = ph + 1; hipLaunchKernelGGL(fwd_kernel, dim3(grid), dim3(NTHR), LDS_BYTES, stream, p); }
#else
    p.ph_lo = 0; p.ph_hi = N_PHASES;
    void* args[] = {&p};
    const hipError_t e = hipLaunchCooperativeKernel((const void*)fwd_kernel, dim3(grid), dim3(NTHR), args, LDS_BYTES, stream);
    if (e != hipSuccess) fprintf(stderr, "kernel_launch: cooperative launch failed: %s (grid %d)\n", hipGetErrorString(e), grid);
#endif
}
```

```cpp
#include <hip/hip_runtime.h>
#include <hip/hip_cooperative_groups.h>
#include <cstdio>
#include <cstdint>
namespace cg = cooperative_groups;

namespace pg8 {
#define PG8_LAS __attribute__((address_space(3)))
typedef unsigned short bf16_t;
typedef short bf16x8 __attribute__((ext_vector_type(8)));
typedef float f32x4 __attribute__((ext_vector_type(4)));
typedef unsigned u32x4 __attribute__((ext_vector_type(4)));
typedef unsigned u32x2 __attribute__((ext_vector_type(2)));
constexpr int BM = 256, BK = 64, HALF = 128, HTB = HALF * BK * 2  , STAGE_BYTES = 8 * HTB, NXCD = 8, WGM = 8;

__host__ __device__ __forceinline__ int lds_byte(int r, int c) { const int st = (r >> 4) * 2 + (c >> 5), rr = r & 15, cc = c & 31, ob = rr * 64 + cc * 2; return st * 1024 + (ob ^ (((ob >> 9) & 1) << 5)); }
__host__ __device__ __forceinline__ void stage_rc(int b, int& R, int& C) { const int st = b / 1024, sb = b % 1024, swz = sb ^ (((sb >> 9) & 1) << 5); R = (st >> 1) * 16 + swz / 64; C = (st & 1) * 32 + (swz % 64) / 2; }
__host__ __device__ __forceinline__ int perm32(int rho) { const int n = rho >> 4, i = rho & 15; return 8 * (i >> 2) + 4 * n + (i & 3); }

struct Unit { int pm, pn; const char* a; const char* b; };
struct Gemm { int K, lda, ldb; };

struct TileOrder {
    int nM, nN, G, c, lda, ldb; const char* A; const char* B;
    __device__ void init(const void* A_, int lda_, const void* B_, int ldb_, int, int nM_, int nN_, int G_, int c_) {
        A = (const char*)A_; B = (const char*)B_; lda = lda_; ldb = ldb_; nM = nM_; nN = nN_; G = G_; c = c_; }
    __device__ bool next(int i, Unit& u) const {
        const int nwg = nM * nN; const long L = (long)i * G + c; if (L >= nwg) return false;
        int wgid = (int)L; { const int q = nwg / NXCD, r = nwg % NXCD, xcd = wgid % NXCD, off = wgid / NXCD; wgid = (xcd < r ? xcd * (q + 1) : r * (q + 1) + (xcd - r) * q) + off; }
        const int nig = WGM * nN, gid = wgid / nig, fm = gid * WGM, gsz = (nM - fm) < WGM ? (nM - fm) : WGM;
        u.pm = fm + ((wgid % nig) % gsz); u.pn = (wgid % nig) / gsz; u.a = A + (size_t)u.pm * ((size_t)BM * 2 * lda); u.b = B + (size_t)u.pn * ((size_t)BM * 2 * ldb); return true;
    }
    __device__ __forceinline__ void a_ready(const Unit&) const {}
    __device__ __forceinline__ void done(const Unit&) const {}
};

__device__ __forceinline__ int tid_() { int t = threadIdx.x; asm volatile("" : "+v"(t)); return t; }
__device__ __forceinline__ unsigned cvt_pk_bf16(float lo, float hi) { unsigned r; asm volatile("v_cvt_pk_bf16_f32 %0, %1, %2" : "=v"(r) : "v"(lo), "v"(hi)); return r; }

template <class Epi, class Sched, bool ALIGN_EPI = false, bool SP2 = false>
__device__ __forceinline__ void gemm_phase(PG8_LAS unsigned char* lds, const Gemm g, const Sched& S, const Epi& E) {
    const int tid = pg8::tid_(), wid = __builtin_amdgcn_readfirstlane(tid >> 6), lane = tid & 63, wr = wid >> 2, wc = wid & 3, fr = lane & 15, fq = lane >> 4;
    const int K = g.K, nt = K / BK;
    unsigned voffA, voffB;
    { int R, C; stage_rc(tid * 16, R, C); const int Rb = Epi::PERM ? ((R & ~31) + perm32(R & 31)) : R;
        voffA = (unsigned)(R * g.lda + C) * 2u; voffB = (unsigned)(Rb * g.ldb + C) * 2u; }
    const size_t qstepA = (size_t)64 * g.lda * 2, qstepB = (size_t)64 * g.ldb * 2;
    const size_t kstep = (size_t)(BK * 2);
    const size_t hstepA = (size_t)HALF * g.lda * 2, hstepB = (size_t)HALF * g.ldb * 2;
    const unsigned ldsw = (unsigned)wid * 1024u;
    const int aoff = lds_byte(wr * 64 + fr, fq * 8), boff = lds_byte(wc * 32 + fr, fq * 8);
#define PG8_SA(b, h) (((b) * 2 + (h)) * HTB)
#define PG8_SB(b, h) ((4 + (b) * 2 + (h)) * HTB)
#define PG8_STAGE(bufoff, gbase, voff) do { _Pragma("unroll") for (int _i = 0; _i < 2; ++_i) { const char* sb_ = (const char*)(gbase) + (size_t)_i * q##voff; asm volatile("" : "+s"(sb_));   \
        __builtin_amdgcn_global_load_lds((const unsigned*)(sb_ + (voff)), (PG8_LAS unsigned*)(lds + (bufoff) + ldsw + _i * 8192), 16, 0, 0); } } while (0)
#define qvoffA qstepA
#define qvoffB qstepB
#define PG8_LDA(dst, b, h) do { _Pragma("unroll") for (int m = 0; m < 4; ++m) _Pragma("unroll") for (int k = 0; k < 2; ++k) dst[m][k] = *(const PG8_LAS bf16x8*)(lds + PG8_SA(b, h) + aoff + m * 2048 + k * 1024); } while (0)
#define PG8_LDB(dst, b, h) do { _Pragma("unroll") for (int n = 0; n < 2; ++n) _Pragma("unroll") for (int k = 0; k < 2; ++k) dst[n][k] = *(const PG8_LAS bf16x8*)(lds + PG8_SB(b, h) + boff + n * 2048 + k * 1024); } while (0)
#define PG8_MMA(ai, bj, At, Bt) do { __builtin_amdgcn_s_setprio(1); _Pragma("unroll") for (int m = 0; m < 4; ++m) _Pragma("unroll") for (int n = 0; n < 2; ++n) _Pragma("unroll") for (int k = 0; k < 2; ++k) \
        acc[ai][bj][m][n] = __builtin_amdgcn_mfma_f32_16x16x32_bf16(Bt[n][k], At[m][k], acc[ai][bj][m][n], 0, 0, 0); __builtin_amdgcn_s_setprio(0); } while (0)
#define PG8_WAIT_V(n) asm volatile("s_waitcnt vmcnt(" #n ")" ::: "memory")
#define PG8_WAIT_L(n) asm volatile("s_waitcnt lgkmcnt(" #n ")" ::: "memory")
#define PG8_BAR __builtin_amdgcn_s_barrier()
#define PG8_SCHED __builtin_amdgcn_sched_barrier(0)
    Unit cur, nxt; int ui = 0;
    if (!S.next(0, cur)) return;
    f32x4 acc[2][2][4][2];
#pragma unroll
    for (int a = 0; a < 2; ++a)
#pragma unroll
        for (int b = 0; b < 2; ++b)
#pragma unroll
            for (int m = 0; m < 4; ++m)
#pragma unroll
                for (int n = 0; n < 2; ++n) acc[a][b][m][n] = (f32x4){0.f, 0.f, 0.f, 0.f};
    bf16x8 At[4][2], B0[2][2], B1[2][2];
    const char* cA = cur.a; const char* cB = cur.b;
    S.a_ready(cur);
    if constexpr (SP2) {
        PG8_STAGE(PG8_SB(0, 0), cB, voffB); PG8_STAGE(PG8_SB(0, 1), cB + hstepB, voffB); PG8_STAGE(PG8_SA(0, 0), cA, voffA); PG8_STAGE(PG8_SA(0, 1), cA + hstepA, voffA);
        if (wr == 1) PG8_BAR;
        PG8_WAIT_V(2); PG8_BAR;
        PG8_STAGE(PG8_SB(1, 0), cB + kstep, voffB); PG8_STAGE(PG8_SA(1, 0), cA + kstep, voffA); PG8_STAGE(PG8_SB(1, 1), cB + hstepB + kstep, voffB);
        PG8_WAIT_V(6); PG8_BAR;
    } else {
        PG8_STAGE(PG8_SB(0, 0), cB, voffB); PG8_STAGE(PG8_SA(0, 0), cA, voffA); PG8_STAGE(PG8_SB(0, 1), cB + hstepB, voffB); PG8_STAGE(PG8_SA(0, 1), cA + hstepA, voffA);
        if (wr == 1) PG8_BAR;
        PG8_WAIT_V(4); PG8_BAR;
        PG8_STAGE(PG8_SB(1, 0), cB + kstep, voffB); PG8_STAGE(PG8_SA(1, 0), cA + kstep, voffA); PG8_STAGE(PG8_SB(1, 1), cB + hstepB + kstep, voffB);
        PG8_WAIT_V(6); PG8_BAR;
    }
    for (;;) {
        const bool has_next = S.next(ui + 1, nxt);
        const char* nA = has_next ? nxt.a : cA; const char* nB = has_next ? nxt.b : cB;
        for (int t = 0; t < nt; t += 2) {
            const bool last = (t == nt - 2);
            const char* a1 = cA + (size_t)(t + 1) * kstep;
            const char* a2 = last ? nA : cA + (size_t)(t + 2) * kstep; const char* b2 = last ? nB : cB + (size_t)(t + 2) * kstep;
            const char* a3 = a2 + kstep; const char* b3 = b2 + kstep;
            if (last && has_next) S.a_ready(nxt);
            if constexpr (SP2) {
            PG8_LDB(B0, 0, 0); PG8_LDB(B1, 0, 1); PG8_SCHED; PG8_LDA(At, 0, 0); PG8_STAGE(PG8_SA(1, 1), a1 + hstepA, voffA);
            PG8_WAIT_V(8); PG8_WAIT_L(0); PG8_BAR; PG8_MMA(0, 0, At, B0); PG8_MMA(0, 1, At, B1); PG8_BAR; PG8_SCHED;
            PG8_LDA(At, 0, 1); PG8_STAGE(PG8_SB(0, 0), b2, voffB); PG8_STAGE(PG8_SB(0, 1), b2 + hstepB, voffB); PG8_STAGE(PG8_SA(0, 0), a2, voffA);
            PG8_WAIT_V(8); PG8_WAIT_L(0); PG8_BAR; PG8_MMA(1, 0, At, B0); PG8_MMA(1, 1, At, B1); PG8_BAR; PG8_SCHED;
            PG8_LDB(B0, 1, 0); PG8_LDB(B1, 1, 1); PG8_SCHED; PG8_LDA(At, 1, 0); PG8_STAGE(PG8_SA(0, 1), a2 + hstepA, voffA);
            PG8_WAIT_V(8); PG8_WAIT_L(0); PG8_BAR; PG8_MMA(0, 0, At, B0); PG8_MMA(0, 1, At, B1); PG8_BAR; PG8_SCHED;
            PG8_LDA(At, 1, 1); PG8_STAGE(PG8_SB(1, 0), b3, voffB); PG8_STAGE(PG8_SB(1, 1), b3 + hstepB, voffB); PG8_STAGE(PG8_SA(1, 0), a3, voffA);
            PG8_WAIT_V(8); PG8_WAIT_L(0); PG8_BAR; PG8_MMA(1, 0, At, B0); PG8_MMA(1, 1, At, B1); PG8_BAR; PG8_SCHED;
            } else {
            PG8_LDB(B0, 0, 0); PG8_SCHED; PG8_LDA(At, 0, 0); PG8_STAGE(PG8_SA(1, 1), a1 + hstepA, voffA);
            PG8_WAIT_L(8); PG8_BAR; PG8_WAIT_L(0); PG8_MMA(0, 0, At, B0); PG8_BAR; PG8_SCHED;
            PG8_LDB(B1, 0, 1); PG8_STAGE(PG8_SB(0, 0), b2, voffB);
            PG8_BAR; PG8_WAIT_L(0); PG8_MMA(0, 1, At, B1); PG8_BAR;
            PG8_LDA(At, 0, 1); PG8_STAGE(PG8_SA(0, 0), a2, voffA);
            PG8_BAR; PG8_WAIT_L(0); PG8_MMA(1, 0, At, B0); PG8_BAR; PG8_SCHED;
            PG8_STAGE(PG8_SB(0, 1), b2 + hstepB, voffB);
            PG8_WAIT_V(6); PG8_BAR; PG8_MMA(1, 1, At, B1); PG8_BAR;
            PG8_LDB(B0, 1, 0); PG8_SCHED; PG8_LDA(At, 1, 0); PG8_STAGE(PG8_SA(0, 1), a2 + hstepA, voffA);
            PG8_WAIT_L(8); PG8_BAR; PG8_WAIT_L(0); PG8_MMA(0, 0, At, B0); PG8_BAR; PG8_SCHED;
            PG8_LDB(B1, 1, 1); PG8_STAGE(PG8_SB(1, 0), b3, voffB);
            PG8_BAR; PG8_WAIT_L(0); PG8_MMA(0, 1, At, B1); PG8_BAR;
            PG8_LDA(At, 1, 1); PG8_STAGE(PG8_SA(1, 0), a3, voffA);
            PG8_BAR; PG8_WAIT_L(0); PG8_MMA(1, 0, At, B0); PG8_BAR; PG8_SCHED;
            PG8_STAGE(PG8_SB(1, 1), b3 + hstepB, voffB);
            PG8_WAIT_V(6); PG8_BAR; PG8_MMA(1, 1, At, B1); PG8_BAR;
            }
        }
        if constexpr (ALIGN_EPI) { if (wr == 0) PG8_BAR; }
        if constexpr (!Epi::AFTER_DRAIN) { const int l2_ = tid_() & 63, fr2 = l2_ & 15, fq2 = l2_ >> 4;   E(acc, cur, wr, wc, fr2, fq2); S.done(cur); }
        if (!has_next) break;
#pragma unroll
        for (int a = 0; a < 2; ++a)
#pragma unroll
            for (int b = 0; b < 2; ++b)
#pragma unroll
                for (int m = 0; m < 4; ++m)
#pragma unroll
                    for (int n = 0; n < 2; ++n) acc[a][b][m][n] = (f32x4){0.f, 0.f, 0.f, 0.f};
        cur = nxt; cA = nA; cB = nB; ++ui;
        if constexpr (ALIGN_EPI) { if (wr == 1) PG8_BAR; }
    }
    PG8_WAIT_V(0);
    if constexpr (!ALIGN_EPI) { if (wr == 0) PG8_BAR; }
    PG8_BAR;
    if constexpr (Epi::AFTER_DRAIN) { E.fused(acc, cur, wr, wc, fr, fq, lds, wid, lane); S.done(cur); }
#undef PG8_SA
#undef PG8_SB
#undef PG8_STAGE
#undef qvoffA
#undef qvoffB
#undef PG8_LDA
#undef PG8_LDB
#undef PG8_MMA
#undef PG8_WAIT_V
#undef PG8_WAIT_L
#undef PG8_BAR
#undef PG8_SCHED
}
}

using pg8::bf16_t; using pg8::f32x4; using pg8::bf16x8; using pg8::u32x4; using pg8::u32x2;
#define DI __device__ __forceinline__
#define LAS __attribute__((address_space(3)))
typedef float f32x16 __attribute__((ext_vector_type(16)));
typedef short s16x4 __attribute__((ext_vector_type(4)));
typedef float f32x2_t __attribute__((ext_vector_type(2))); typedef __bf16 bf16x2_t __attribute__((ext_vector_type(2)));

constexpr int NTHR = 512, NWAVES = 8;
constexpr int D = 1024, NB = 8, SEQ = 2048, DEPTH = 4, DB = 16, DT = 16, PAST = 1024;
constexpr int MP = NB * SEQ, MS = DB * DT, MA = MP + MS;
constexpr int NIN = 6032, NINP = 6144;
constexpr int C_QA = 0, C_KA = 384, C_VA = 768, C_U = 1152, C_QC = 1408, C_KC = 1792, C_VC = 2176, C_GC = 2560, C_LR = 2944, C_GA = 2960, C_GB = 3984, C_GCG = 5008;
constexpr int FF = 2816, FF2 = 5632;
constexpr int GH = 4, GK = 96;
constexpr int NGU_P = NB * GH * 32, NGU_S = DB * GH, NGU = NGU_P + NGU_S;
constexpr float EPS = 1e-6f;

constexpr size_t O_YP = 0, O_YS = O_YP + (size_t)MP * D, O_KP = O_YS + (size_t)MS * D, O_VP = O_KP + (size_t)DEPTH * MP * 384, O_POOLP = O_VP + (size_t)DEPTH * MP * 384,
    O_GLAP = O_POOLP + (size_t)DEPTH * NB * 15 * 256, O_MKP = O_GLAP + (size_t)DEPTH * NB * GH * GK * GK, O_MVP = O_MKP + (size_t)DEPTH * NB * 256 * D,
    O_KS = O_MVP + (size_t)DEPTH * NB * 256 * D, O_VS = O_KS + (size_t)DEPTH * MS * 384, O_POOLS = O_VS + (size_t)DEPTH * MS * 384, O_GLAS = O_POOLS + (size_t)DEPTH * DB * 15 * 256,
    O_END = O_GLAS + (size_t)DEPTH * DB * GH * GK * GK;

enum { I_XP = 0, I_XS, I_MEM, I_CSK, I_CSV, I_SPOOL, I_SGLA, I_CMK, I_CMV, I_WIN, I_WA2, I_BA, I_GLAN, I_WPOOL, I_PSCALE, I_WBA, I_WBB, I_WBC, I_WMIX, I_MEMN, I_WXQ, I_WXK, I_WXV, I_WXO,
       I_WF1, I_WF2, I_NMIXPRE, I_NMIXPOST, I_NXPRE, I_NXPOST, I_NFPRE, I_NFPOST, N_IN };

constexpr size_t MiB = 1u << 20;
constexpr size_t SZ_WIN = (size_t)NINP * D * 2, SZ_WBA = (size_t)D * 384 * 2, SZ_WBB = (size_t)D * 256 * 2, SZ_WSQ = (size_t)D * D * 2, SZ_WKV = 2 * SZ_WSQ, SZ_WF1 = (size_t)FF2 * D * 2, SZ_WF2 = (size_t)D * FF * 2;
constexpr size_t WS_CTL = 0, CTL_BYTES = 1 * MiB, WS_TAB = CTL_BYTES - 4096;
constexpr size_t WS_WIN = WS_CTL + CTL_BYTES, WS_WBA = WS_WIN + 4 * SZ_WIN, WS_WBB = WS_WBA + 4 * SZ_WBA, WS_WBC = WS_WBB + 4 * SZ_WBB, WS_WMIX = WS_WBC + 4 * SZ_WBA,
    WS_WXQ = WS_WMIX + 4 * SZ_WSQ, WS_WXO = WS_WXQ + 4 * SZ_WSQ, WS_WKV = WS_WXO + 4 * SZ_WSQ, WS_WF1 = WS_WKV + 4 * SZ_WKV, WS_WF2 = WS_WF1 + 4 * SZ_WF1,
    WS_MN = WS_WF2 + 4 * SZ_WF2, WS_MKV = WS_MN + 4 * SZ_WKV, WS_MEMVT = WS_MKV + 8 * SZ_WKV, WS_PROJ = WS_MEMVT + 4 * SZ_WKV;
constexpr size_t SZ_ROWS = (size_t)MA * D * 2;
constexpr size_t SZ_PROJ = (size_t)MA * NINP * 2;
constexpr size_t WS_Q = WS_PROJ, WS_P = WS_Q + SZ_ROWS, WS_O = WS_P + SZ_ROWS, WS_ACT = WS_O + SZ_ROWS;
static_assert(WS_ACT + (size_t)MA * FF * 2 <= WS_PROJ + SZ_PROJ, "overlay fits");
constexpr size_t WS_H = WS_PROJ + SZ_PROJ, WS_MERGED = WS_H + SZ_ROWS, WS_Y = WS_MERGED + SZ_ROWS;
constexpr size_t WS_GKV = WS_H, WS_GSP = WS_GKV + 39 * MiB, WS_GDEC = WS_GSP + 37 * MiB;
static_assert((size_t)NGU * GK * GK * 4 <= 39 * MiB && (size_t)NGU_P * GK * GK * 4 <= 37 * MiB && WS_GDEC + (size_t)NGU * GK * 4 <= WS_Y + SZ_ROWS, "GLA overlay fits");
constexpr size_t WS_OA = WS_Y + SZ_ROWS, WS_POOLED = WS_OA + (size_t)MA * 384 * 2, WS_OC = WS_POOLED + (size_t)MA * 256 * 2, WS_BB = WS_OC + (size_t)MA * 384 * 2, WS_XB = WS_BB + (size_t)NGU * 64 * GK * 4, WS_RN = WS_XB + SZ_ROWS, WS_END = WS_RN + (size_t)MA * 4;
static_assert(WS_WIN % 256 == 0 && WS_PROJ % 256 == 0 && WS_H % 256 == 0 && WS_OA % 256 == 0 && WS_POOLED % 256 == 0 && WS_OC % 256 == 0 && WS_P % 256 == 0, "alignment");

constexpr int CW_BAR = 16384;
constexpr int LDS_GEMM = 131072, LDS_X = LDS_GEMM, LDS_X_BYTES = 12288, LDS_MISC = LDS_X + LDS_X_BYTES, LDS_BYTES = LDS_MISC + 256;

struct Params { const float* in[N_IN]; float* out; unsigned char* ws; int ph_lo, ph_hi; };
struct InTab { const float* const* t;
    __device__ __forceinline__ const float* operator[](int i) const { const unsigned long long v = (unsigned long long)t[i];
        const unsigned lo = __builtin_amdgcn_readfirstlane((unsigned)v), hi = __builtin_amdgcn_readfirstlane((unsigned)(v >> 32)); return (const float*)(((unsigned long long)hi << 32) | lo); } };
struct Ctx { InTab in; float* out; unsigned char* ws; };

DI float bflo(unsigned w) { return __uint_as_float(w << 16); }
DI float bfhi(unsigned w) { return __uint_as_float(w & 0xffff0000u); }
DI float bf2f(unsigned short v) { return __uint_as_float((unsigned)v << 16); }
DI unsigned pk2(float lo, float hi) { f32x2_t v = {lo, hi}; bf16x2_t b = __builtin_convertvector(v, bf16x2_t); return __builtin_bit_cast(unsigned, b); }
DI unsigned short f2bf(float f) { return (unsigned short)(pk2(f, 0.f) & 0xffffu); }
DI float wave_sum(float v) {
#pragma unroll
    for (int o = 1; o < 64; o <<= 1) v += __shfl_xor(v, o);
    return v;
}
DI float wave_max(float v) {
#pragma unroll
    for (int o = 1; o < 64; o <<= 1) v = fmaxf(v, __shfl_xor(v, o));
    return v;
}
DI float sigmoidf_(float x) { return __builtin_amdgcn_rcpf(1.f + __expf(-x)); }
DI float softplusf_(float z) { return fmaxf(z, 0.f) + __logf(1.f + __expf(-fabsf(z))); }
DI int next_work(unsigned* ctr, volatile LAS int* slot) {
    __syncthreads();
    if (pg8::tid_() == 0) *slot = (int)atomicAdd(ctr, 1u);
    __syncthreads();
    return *slot;
}

typedef const pg8::f32x4 (&AccRef)[2][2][4][2];
struct EpiBf16 {
    static constexpr bool PERM = true, AFTER_DRAIN = false;
    bf16_t* O; int ldc; int pnmask;
    DI void operator()(AccRef acc, const pg8::Unit& u, int wr, int wc, int fr, int fq) const {
#pragma unroll
        for (int ai = 0; ai < 2; ++ai)
#pragma unroll
            for (int m = 0; m < 4; ++m) {
                bf16_t* rowp = O + (size_t)(u.pm * 256 + ai * 128 + wr * 64 + m * 16 + fr) * ldc + (u.pn & pnmask) * 256 + wc * 32 + 8 * fq;
#pragma unroll
                for (int bj = 0; bj < 2; ++bj) {
                    const f32x4 v0 = acc[ai][bj][m][0], v1 = acc[ai][bj][m][1];
                    u32x4 w; w.x = pk2(v0[0], v0[1]); w.y = pk2(v0[2], v0[3]); w.z = pk2(v1[0], v1[1]); w.w = pk2(v1[2], v1[3]);
                    *(u32x4*)(rowp + bj * 128) = w;
                }
            }
    }
};
struct EpiGate {
    static constexpr bool PERM = true, AFTER_DRAIN = false;
    bf16_t* merged; const bf16_t* proj; int goff; int accum;
    DI void operator()(AccRef acc, const pg8::Unit& u, int wr, int wc, int fr, int fq) const {
#pragma unroll
        for (int ai = 0; ai < 2; ++ai)
#pragma unroll
            for (int m = 0; m < 4; ++m) {
                const int row = u.pm * 256 + ai * 128 + wr * 64 + m * 16 + fr;
                const bf16_t* gp = proj + (size_t)row * NINP + goff + u.pn * 256 + wc * 32 + 8 * fq;
                bf16_t* mp = merged + (size_t)row * D + u.pn * 256 + wc * 32 + 8 * fq;
#pragma unroll
                for (int bj = 0; bj < 2; ++bj)
#pragma unroll
                    for (int n = 0; n < 2; ++n) {
                        const u32x2 g = *(const u32x2*)(gp + bj * 128 + 4 * n);
                        u32x2 pm2 = {0u, 0u}; if (accum) pm2 = *(const u32x2*)(mp + bj * 128 + 4 * n);
                        const f32x4 v = acc[ai][bj][m][n];
                        const float r0 = sigmoidf_(bflo(g.x)) * v[0] + bflo(pm2.x), r1 = sigmoidf_(bfhi(g.x)) * v[1] + bfhi(pm2.x);
                        const float r2 = sigmoidf_(bflo(g.y)) * v[2] + bflo(pm2.y), r3 = sigmoidf_(bfhi(g.y)) * v[3] + bfhi(pm2.y);
                        u32x2 w; w.x = pk2(r0, r1); w.y = pk2(r2, r3);
                        *(u32x2*)(mp + bj * 128 + 4 * n) = w;
                        asm volatile("" ::: "memory");
                    }
            }
    }
};
struct EpiSwiglu {
    static constexpr bool PERM = true, AFTER_DRAIN = false;
    bf16_t* act;
    DI void operator()(AccRef acc, const pg8::Unit& u, int wr, int wc, int fr, int fq) const {
#pragma unroll
        for (int ai = 0; ai < 2; ++ai)
#pragma unroll
            for (int m = 0; m < 4; ++m) {
                const int row = u.pm * 256 + ai * 128 + wr * 64 + m * 16 + fr;
#pragma unroll
                for (int bj = 0; bj < 2; ++bj) {
                    const int col0 = u.pn * 256 + bj * 128 + wc * 32 + 8 * fq;
                    const f32x4 g = acc[ai][bj][m][0], up = acc[ai][bj][m][1];
                    float r[4];
#pragma unroll
                    for (int j = 0; j < 4; ++j) r[j] = g[j] * sigmoidf_(g[j]) * up[j];
                    u32x2 w; w.x = pk2(r[0], r[1]); w.y = pk2(r[2], r[3]);
                    *(u32x2*)(act + (size_t)row * FF + (col0 >> 1)) = w;
                }
            }
    }
};
struct MemKvOrder {
    int G, c; const char* A; const char* B;
    DI bool next(int i, pg8::Unit& u) const {
        const int L = i * G + c; if (L >= 256) return false;
        const int l = L >> 6, r = L & 63; u.pm = l * 8 + (r & 7); u.pn = l * 8 + (r >> 3);
        u.a = A + (size_t)u.pm * (256 * D * 2); u.b = B + (size_t)u.pn * (256 * D * 2); return true;
    }
    DI void a_ready(const pg8::Unit&) const {}
    DI void done(const pg8::Unit&) const {}
};
struct CrossOrder {
    int G, c; const char* A; const char* B; int mode;
    DI bool next(int i, pg8::Unit& u) const {
        const int L = i * G + c; if (L >= 256) return false;
        u.pm = L >> 2; u.pn = L & 3; const int b = u.pm >> 3, h = u.pn;
        u.a = A + ((size_t)u.pm * 256 * D + h * 256) * 2;
        u.b = mode == 0 ? B + ((size_t)b * 256 * 2048 + h * 256) * 2 : B + ((size_t)h * 256 * 2048 + b * 256) * 2;
        return true;
    }
    DI void a_ready(const pg8::Unit&) const {}
    DI void done(const pg8::Unit&) const {}
};
struct EpiSoftmax {
    static constexpr bool PERM = true, AFTER_DRAIN = false;
    bf16_t* P; LAS float* xs;
    DI void operator()(AccRef acc, const pg8::Unit& u, int wr, int wc, int fr, int fq) const {
        const float sc = 0.0625f * 1.4426950408889634f;
        LAS float* xm = xs; LAS float* xsum = xs + 1024;
#pragma unroll
        for (int ai = 0; ai < 2; ++ai)
#pragma unroll
            for (int m = 0; m < 4; ++m) {
                float a = -3.0e38f;
#pragma unroll
                for (int bj = 0; bj < 2; ++bj)
#pragma unroll
                    for (int n = 0; n < 2; ++n) { const f32x4 v = acc[ai][bj][m][n]; a = fmaxf(a, fmaxf(fmaxf(v[0], v[1]), fmaxf(v[2], v[3]))); }
                a = fmaxf(a, __shfl_xor(a, 16)); a = fmaxf(a, __shfl_xor(a, 32));
                if (fq == 0) xm[(ai * 128 + wr * 64 + m * 16 + fr) * 4 + wc] = a;
                asm volatile("" ::: "memory");
            }
        __syncthreads();
#pragma unroll
        for (int ai = 0; ai < 2; ++ai)
#pragma unroll
            for (int m = 0; m < 4; ++m) {
                const f32x4 t = *(LAS f32x4*)(xm + (ai * 128 + wr * 64 + m * 16 + fr) * 4); const float mx = fmaxf(fmaxf(t[0], t[1]), fmaxf(t[2], t[3])) * sc;
                float s = 0.f;
#pragma unroll
                for (int bj = 0; bj < 2; ++bj)
#pragma unroll
                    for (int n = 0; n < 2; ++n)
#pragma unroll
                        for (int j = 0; j < 4; ++j) s += __builtin_amdgcn_exp2f(acc[ai][bj][m][n][j] * sc - mx);
                s += __shfl_xor(s, 16); s += __shfl_xor(s, 32);
                if (fq == 0) xsum[(ai * 128 + wr * 64 + m * 16 + fr) * 4 + wc] = s;
                asm volatile("" ::: "memory");
            }
        __syncthreads();
#pragma unroll
        for (int ai = 0; ai < 2; ++ai)
#pragma unroll
            for (int m = 0; m < 4; ++m) {
                const f32x4 t = *(LAS f32x4*)(xm + (ai * 128 + wr * 64 + m * 16 + fr) * 4); const float mx = fmaxf(fmaxf(t[0], t[1]), fmaxf(t[2], t[3])) * sc;
                const f32x4 t2 = *(LAS f32x4*)(xsum + (ai * 128 + wr * 64 + m * 16 + fr) * 4); const float inv = __builtin_amdgcn_rcpf((t2[0] + t2[1]) + (t2[2] + t2[3]));
                bf16_t* rowp = P + (size_t)(u.pm * 256 + ai * 128 + wr * 64 + m * 16 + fr) * D + u.pn * 256 + wc * 32 + 8 * fq;
#pragma unroll
                for (int bj = 0; bj < 2; ++bj)
#pragma unroll
                    for (int n = 0; n < 2; ++n) {
                        const f32x4 v = acc[ai][bj][m][n];
                        u32x2 w; w.x = pk2(__builtin_amdgcn_exp2f(v[0] * sc - mx) * inv, __builtin_amdgcn_exp2f(v[1] * sc - mx) * inv); w.y = pk2(__builtin_amdgcn_exp2f(v[2] * sc - mx) * inv, __builtin_amdgcn_exp2f(v[3] * sc - mx) * inv);
                        *(u32x2*)(rowp + bj * 128 + 4 * n) = w;
                    }
                asm volatile("" ::: "memory");
            }
        __syncthreads();
    }
};

#define XB_TMO      128
#define XB_XCNT(j)  (256  + 64 * (j))
#define XB_XSUB(j)  (1280 + 64 * (j))
#define XB_XGEN(j)  (2304 + 64 * (j))
#define XB_TOP      3328
#define XB_TOPGEN   3392
#define XCD_BAR_WORDS 3456
#define XB_SPIN_CAP (1u << 18)

__device__ __forceinline__ unsigned xb_ld(unsigned* p)              { return __hip_atomic_load(p, __ATOMIC_RELAXED, __HIP_MEMORY_SCOPE_AGENT); }
__device__ __forceinline__ unsigned xb_add(unsigned* p, unsigned v) { return __hip_atomic_fetch_add(p, v, __ATOMIC_RELAXED, __HIP_MEMORY_SCOPE_AGENT); }
__device__ __forceinline__ unsigned xb_xcc_id() { return (unsigned)__builtin_amdgcn_s_getreg((3 << 11) | 20) & 0xFu; }
#define XB_SPIN(cond, bar) do { unsigned _sp = 0; while (cond) { __builtin_amdgcn_s_sleep(1); \
    if ((++_sp & 255u) == 0u) { if (xb_ld(&(bar)[XB_TMO])) break; if (_sp > XB_SPIN_CAP) { atomicAdd(&(bar)[XB_TMO], 1u); break; } } } } while (0)

struct XcdBarrier {
    unsigned* bar; unsigned x;
    volatile LAS unsigned* st;
};

__device__ __forceinline__ XcdBarrier xcd_barrier_post(unsigned* bar, volatile LAS unsigned* st) {
    XcdBarrier b; b.bar = bar; b.x = xb_xcc_id(); b.st = st;
    if (threadIdx.x == 0) (void)xb_add(&bar[XB_XCNT(b.x)], 1u);
    return b;
}
__device__ __forceinline__ void xcd_barrier_complete(unsigned* bar, unsigned x, unsigned& nloc, unsigned& nx) {
    const unsigned G = gridDim.x * gridDim.y * gridDim.z;
    unsigned sum, cnt, mine, sp = 0u;
    for (;;) {
        sum = 0u; cnt = 0u; mine = 0u;
#pragma unroll
        for (unsigned j = 0; j < 16; ++j) { const unsigned c = xb_ld(&bar[XB_XCNT(j)]); sum += c; cnt += (c > 0u) ? 1u : 0u; mine = (j == x) ? c : mine; }
        if (sum == G) break;
        __builtin_amdgcn_s_sleep(1);
        if ((++sp & 255u) == 0u) { if (xb_ld(&bar[XB_TMO])) break; if (sp > XB_SPIN_CAP) { atomicAdd(&bar[XB_TMO], 1u); break; } }
    }
    nloc = mine > 0u ? mine : 1u; nx = cnt > 0u ? cnt : 1u;
}

__device__ __forceinline__ void xcd_barrier(const XcdBarrier& b) {
    asm volatile("s_waitcnt vmcnt(0)" ::: "memory");
    __syncthreads();
    if (threadIdx.x == 0) {
        unsigned* bar = b.bar;
        __builtin_amdgcn_s_waitcnt(0);
        unsigned nloc = b.st[0], nx = b.st[1];
        if (nloc == 0u) { xcd_barrier_complete(bar, b.x, nloc, nx); b.st[0] = nloc; b.st[1] = nx; }
        const unsigned old = xb_add(&bar[XB_XSUB(b.x)], 1u);
        const unsigned gen = old / nloc;
        if (old + 1u == (gen + 1u) * nloc) {
            __builtin_amdgcn_fence(__ATOMIC_RELEASE, "agent");
            asm volatile("s_waitcnt vmcnt(0)" ::: "memory");
            const unsigned og = xb_add(&bar[XB_TOP], 1u);
            const unsigned tg = og / nx;
            if (og + 1u == (tg + 1u) * nx) xb_add(&bar[XB_TOPGEN], 1u);
            else XB_SPIN(xb_ld(&bar[XB_TOPGEN]) == tg, bar);
            __builtin_amdgcn_fence(__ATOMIC_ACQUIRE, "agent");
            xb_add(&bar[XB_XGEN(b.x)], 1u);
            asm volatile("s_waitcnt vmcnt(0)" ::: "memory");
        } else {
            XB_SPIN(xb_ld(&bar[XB_XGEN(b.x)]) == gen, bar);
            __builtin_amdgcn_fence(__ATOMIC_ACQUIRE, "agent");
            asm volatile("s_waitcnt vmcnt(0)" ::: "memory");
        }
    }
    __syncthreads();
}


#define LDS_WAIT() asm volatile("s_waitcnt lgkmcnt(0)" ::: "memory")
DI void transpose_item(const float* W, int K, int N, int Npad, bf16_t* WT, int mode, LAS float* scr, int item, int lane, const float* gk = nullptr) {
    const int nblk = Npad / 32, kb = item / nblk, nb = item % nblk, k0 = 64 * kb, n0 = 32 * nb;
    const int nn = n0 + (lane & 31); const bool ok = nn < N;
    float tv[32];
#pragma unroll
    for (int i = 0; i < 32; ++i) tv[i] = ok ? W[(size_t)(k0 + 2 * i + (lane >> 5)) * N + nn] : 0.f;
    if (gk) {
#pragma unroll
        for (int i = 0; i < 32; ++i) tv[i] *= gk[k0 + 2 * i + (lane >> 5)];
    }
#pragma unroll
    for (int i = 0; i < 32; ++i) scr[(2 * i + (lane >> 5)) * 33 + (lane & 31)] = tv[i];
    LDS_WAIT(); asm volatile("" ::: "memory");
    const int c = lane & 7;
#pragma unroll
    for (int j = 0; j < 4; ++j) {
        const int n = (lane >> 3) + 8 * j; const LAS float* s = scr + (8 * c) * 33 + n;
        u32x4 o; o.x = pk2(s[0 * 33], s[1 * 33]); o.y = pk2(s[2 * 33], s[3 * 33]); o.z = pk2(s[4 * 33], s[5 * 33]); o.w = pk2(s[6 * 33], s[7 * 33]);
        int drow = n0 + n;
        if (mode == 1) { const int jj = drow >= FF ? drow - FF : drow, isu = drow >= FF ? 1 : 0; drow = (jj >> 2) * 8 + isu * 4 + (jj & 3); }
        *(u32x4*)(WT + (size_t)drow * K + k0 + 8 * c) = o;
    }
    LDS_WAIT(); asm volatile("" ::: "memory");
}

DI void norm_row(const float* xsrc32, bf16_t* xn, float* rn, float* xdst32, const bf16_t* y, const float* gpost, int lane) {
    f32x4 v[4];
    if (xsrc32) {
#pragma unroll
        for (int j = 0; j < 4; ++j) v[j] = *(const f32x4*)(xsrc32 + 4 * lane + 256 * j);
    } else {
        const float r = *rn;
#pragma unroll
        for (int j = 0; j < 4; ++j) { const u32x2 w = *(const u32x2*)(xn + 4 * lane + 256 * j); v[j] = (f32x4){bflo(w.x), bfhi(w.x), bflo(w.y), bfhi(w.y)} * r; }
    }
    if (y) {
        f32x4 yv[4]; float ss = 0.f;
#pragma unroll
        for (int j = 0; j < 4; ++j) { const u32x2 w = *(const u32x2*)(y + 4 * lane + 256 * j); yv[j] = (f32x4){bflo(w.x), bfhi(w.x), bflo(w.y), bfhi(w.y)}; ss += (yv[j][0] * yv[j][0] + yv[j][1] * yv[j][1]) + (yv[j][2] * yv[j][2] + yv[j][3] * yv[j][3]); }
        const float rs = rsqrtf(wave_sum(ss) * (1.f / D) + EPS);
#pragma unroll
        for (int j = 0; j < 4; ++j) { const f32x4 g = *(const f32x4*)(gpost + 4 * lane + 256 * j); v[j] = v[j] + yv[j] * rs * g; }
    }
    if (xdst32) {
#pragma unroll
        for (int j = 0; j < 4; ++j) *(f32x4*)(xdst32 + 4 * lane + 256 * j) = v[j];
    } else {
        float ss = 0.f;
#pragma unroll
        for (int j = 0; j < 4; ++j) ss += (v[j][0] * v[j][0] + v[j][1] * v[j][1]) + (v[j][2] * v[j][2] + v[j][3] * v[j][3]);
        const float ms = wave_sum(ss) * (1.f / D) + EPS, rs = rsqrtf(ms);
#pragma unroll
        for (int j = 0; j < 4; ++j) { const f32x4 o = v[j] * rs; u32x2 w; w.x = pk2(o[0], o[1]); w.y = pk2(o[2], o[3]); *(u32x2*)(xn + 4 * lane + 256 * j) = w; }
        if (lane == 0) *rn = ms * rs;
    }
}

DI void norm_phase(const Ctx& p, const float* gpost, bool last, int G, int bx) {
    const int tid = pg8::tid_(), lane = tid & 63, wv = tid >> 6, gw = bx * NWAVES + wv, NGW = G * NWAVES;
    const bf16_t* Yb = (const bf16_t*)(p.ws + WS_Y); bf16_t* Xb = (bf16_t*)(p.ws + WS_XB); float* Rn = (float*)(p.ws + WS_RN);
    for (int row = gw; row < MA; row += NGW) norm_row(nullptr, Xb + (size_t)row * D, Rn + row, last ? p.out + (size_t)row * D : nullptr, Yb + (size_t)row * D, gpost, lane);
}

DI void prologue(const Params& p, LAS unsigned char* lds) {
    const int tid = pg8::tid_(), lane = tid & 63, wv = tid >> 6;
    const int gw = blockIdx.x * NWAVES + wv, NGW = gridDim.x * NWAVES;
    LAS float* scr = (LAS float*)(lds + wv * 16384);
    unsigned char* ws = p.ws;
    constexpr int I0 = 3072, I1 = 192, I2 = 512, I3 = 2816, I4 = 1408, IPL = I0 + 2 * I1 + 5 * I2 + I3 + I4;
    for (int it = gw; it < 4 * IPL; it += NGW) {
        const int l = it / IPL; int r = it % IPL;
        if (r < I0) { transpose_item(p.in[I_WIN] + (size_t)l * D * NIN, D, NIN, NINP, (bf16_t*)(ws + WS_WIN + l * SZ_WIN), 0, scr, r, lane, p.in[I_NMIXPRE] + l * D); continue; } r -= I0;
        if (r < I1) { transpose_item(p.in[I_WBA] + (size_t)l * 384 * D, 384, D, D, (bf16_t*)(ws + WS_WBA + l * SZ_WBA), 0, scr, r, lane); continue; } r -= I1;
        if (r < I1) { transpose_item(p.in[I_WBC] + (size_t)l * 384 * D, 384, D, D, (bf16_t*)(ws + WS_WBC + l * SZ_WBA), 0, scr, r, lane); continue; } r -= I1;
        if (r < I2) { transpose_item(p.in[I_WMIX] + (size_t)l * D * D, D, D, D, (bf16_t*)(ws + WS_WMIX + l * SZ_WSQ), 0, scr, r, lane); continue; } r -= I2;
        if (r < I2) { transpose_item(p.in[I_WXQ] + (size_t)l * D * D, D, D, D, (bf16_t*)(ws + WS_WXQ + l * SZ_WSQ), 0, scr, r, lane, p.in[I_NXPRE] + l * D); continue; } r -= I2;
        if (r < I2) { transpose_item(p.in[I_WXO] + (size_t)l * D * D, D, D, D, (bf16_t*)(ws + WS_WXO + l * SZ_WSQ), 0, scr, r, lane); continue; } r -= I2;
        if (r < I2) { transpose_item(p.in[I_WXK] + (size_t)l * D * D, D, D, D, (bf16_t*)(ws + WS_WKV + l * SZ_WKV), 0, scr, r, lane); continue; } r -= I2;
        if (r < I2) { transpose_item(p.in[I_WXV] + (size_t)l * D * D, D, D, D, (bf16_t*)(ws + WS_WKV + l * SZ_WKV + SZ_WSQ), 0, scr, r, lane); continue; } r -= I2;
        if (r < I3) { transpose_item(p.in[I_WF1] + (size_t)l * D * FF2, D, FF2, FF2, (bf16_t*)(ws + WS_WF1 + l * SZ_WF1), 1, scr, r, lane, p.in[I_NFPRE] + l * D); continue; } r -= I3;
        transpose_item(p.in[I_WF2] + (size_t)l * FF * D, FF, D, D, (bf16_t*)(ws + WS_WF2 + l * SZ_WF2), 0, scr, r, lane);
    }
    for (int u = blockIdx.x; u < 128; u += gridDim.x) {
        const int l = u >> 5, g = (u >> 3) & 3, nb = (u >> 2) & 1, cq = u & 3;
        LAS float* Ps = (LAS float*)(lds + 8 * 16384);
        __syncthreads();
        for (int i = tid; i < 1024; i += NTHR) Ps[i] = p.in[I_WPOOL][((size_t)(l * 4 + g) * 64 + 16 * cq) * 64 + i];
        __syncthreads();
        const int n = nb * 512 + tid;
        const float* sc = p.in[I_PSCALE] + l * 256 + g * 64; const float* wb = p.in[I_WBB] + ((size_t)l * 256 + g * 64) * D + n;
        float acc[16];
#pragma unroll
        for (int c = 0; c < 16; ++c) acc[c] = 0.f;
#pragma unroll 2
        for (int d0 = 0; d0 < 64; d0 += 8) {
            float bc[8];
#pragma unroll
            for (int j = 0; j < 8; ++j) bc[j] = sc[d0 + j] * wb[(size_t)(d0 + j) * D];
#pragma unroll
            for (int c = 0; c < 16; ++c) { const f32x4 p0 = *(const LAS f32x4*)(Ps + c * 64 + d0), p1 = *(const LAS f32x4*)(Ps + c * 64 + d0 + 4);
                acc[c] += ((p0[0] * bc[0] + p0[1] * bc[1]) + (p0[2] * bc[2] + p0[3] * bc[3])) + ((p1[0] * bc[4] + p1[1] * bc[5]) + (p1[2] * bc[6] + p1[3] * bc[7])); }
        }
        unsigned ov[16];
#pragma unroll
        for (int c = 0; c < 16; ++c) ov[c] = f2bf(acc[c]);
        bf16_t* dst = (bf16_t*)(ws + WS_WBB + l * SZ_WBB) + (size_t)n * 256 + g * 64 + 16 * cq;
        u32x4 w0, w1; w0.x = ov[0] | (ov[1] << 16); w0.y = ov[2] | (ov[3] << 16); w0.z = ov[4] | (ov[5] << 16); w0.w = ov[6] | (ov[7] << 16);
        w1.x = ov[8] | (ov[9] << 16); w1.y = ov[10] | (ov[11] << 16); w1.z = ov[12] | (ov[13] << 16); w1.w = ov[14] | (ov[15] << 16);
        *(u32x4*)dst = w0; *(u32x4*)(dst + 8) = w1;
    }
    __syncthreads();
    for (int row = gw; row < MA; row += NGW) {
        const float* src = row < MP ? p.in[I_XP] + (size_t)row * D : p.in[I_XS] + (size_t)(row - MP) * D;
        norm_row(src, (bf16_t*)(ws + WS_XB) + (size_t)row * D, (float*)(ws + WS_RN) + row, nullptr, nullptr, nullptr, lane);
    }
    for (int row = gw; row < NB * 256; row += NGW) {
        f32x4 v[4]; float ss = 0.f;
#pragma unroll
        for (int j = 0; j < 4; ++j) { v[j] = *(const f32x4*)(p.in[I_MEM] + (size_t)row * D + 4 * lane + 256 * j); ss += (v[j][0] * v[j][0] + v[j][1] * v[j][1]) + (v[j][2] * v[j][2] + v[j][3] * v[j][3]); }
        const float rs = rsqrtf(wave_sum(ss) * (1.f / D) + EPS);
        for (int l = 0; l < 4; ++l)
#pragma unroll
            for (int j = 0; j < 4; ++j) { const f32x4 g = *(const f32x4*)(p.in[I_MEMN] + l * D + 4 * lane + 256 * j); const f32x4 o = v[j] * rs * g; u32x2 w; w.x = pk2(o[0], o[1]); w.y = pk2(o[2], o[3]);
                *(u32x2*)((bf16_t*)(ws + WS_MN) + ((size_t)l * 2048 + row) * D + 4 * lane + 256 * j) = w; }
    }
}

#define MFMA32(a, b, c) __builtin_amdgcn_mfma_f32_32x32x16_bf16((a), (b), (c), 0, 0, 0)
#define MFMA16(a, b, c) __builtin_amdgcn_mfma_f32_16x16x32_bf16((a), (b), (c), 0, 0, 0)
template <bool MASKED> DI void sb_tile_weights(f32x16 (&z)[2], float& R, int jt, int tq, int hi) {
    f32x16 e[2]; float T[8];
    const int sbase = 64 * jt + 4 * hi;
#pragma unroll
    for (int kb = 0; kb < 2; ++kb)
#pragma unroll
        for (int g = 0; g < 4; ++g) {
            float fl[4];
#pragma unroll
            for (int j = 0; j < 4; ++j) {
                const int r = 4 * g + j; const bool valid = !MASKED || (sbase + 32 * kb + 8 * g + j) < tq;
                const float zz = fminf(fmaxf(z[kb][r], -240.f), 240.f);
                const float t = __builtin_amdgcn_exp2f(zz * (-0.125f * 1.4426950408889634f));
                const float be = __builtin_amdgcn_rcpf(1.f + t);
                fl[j] = valid ? t * be : 1.f; z[kb][r] = valid ? be : 0.f;
            }
            e[kb][4 * g + 3] = 1.f; e[kb][4 * g + 2] = fl[3]; e[kb][4 * g + 1] = fl[3] * fl[2]; e[kb][4 * g + 0] = e[kb][4 * g + 1] * fl[1];
            T[kb * 4 + g] = e[kb][4 * g + 0] * fl[0];
        }
    float Tp[8], X[8];
#pragma unroll
    for (int gi = 0; gi < 8; ++gi) Tp[gi] = __shfl_xor(T[gi], 32);
    X[7] = 1.f;
#pragma unroll
    for (int gi = 6; gi >= 0; --gi) X[gi] = X[gi + 1] * (T[gi + 1] * Tp[gi + 1]);
    const float total = X[0] * (T[0] * Tp[0]);
#pragma unroll
    for (int kb = 0; kb < 2; ++kb)
#pragma unroll
        for (int g = 0; g < 4; ++g) {
            const int gi = kb * 4 + g; const float off = R * X[gi] * (hi == 0 ? Tp[gi] : 1.f);
#pragma unroll
            for (int j = 0; j < 4; ++j) { const int r = 4 * g + j; z[kb][r] = z[kb][r] * (off * e[kb][r]); }
        }
    R *= total;
}

DI void sb_prompt_unit(const Ctx& p, int b, int h, int qb, LAS unsigned char* lds) {
    const bf16_t* proj = (const bf16_t*)(p.ws + WS_PROJ);
    LAS unsigned short* KS = (LAS unsigned short*)lds;
    LAS unsigned short* VT = KS + 64 * 72;
    const int tid = pg8::tid_(), lane = tid & 63, wv = tid >> 6, hi = lane >> 5, c = lane & 31;
    const int q0 = qb * 256 + wv * 32, tq = q0 + c;
    const size_t rowbase = (size_t)b * SEQ;
    bf16x8 qf[4];
    {
        const bf16_t* qp = proj + (rowbase + tq) * NINP + C_QA + h * 64 + 8 * hi;
#pragma unroll
        for (int kk = 0; kk < 4; ++kk) qf[kk] = *(const bf16x8*)(qp + 16 * kk);
    }
    f32x16 o0, o1;
#pragma unroll
    for (int i = 0; i < 16; ++i) { o0[i] = 0.f; o1[i] = 0.f; }
    float R = 1.f;
    const bf16_t* kbase = proj + rowbase * NINP + C_KA + h * 64 + 8 * wv;
    const bf16_t* vbase = proj + rowbase * NINP + C_VA + h * 64 + 8 * wv;
    int jt = 4 * qb + 3;
    u32x4 kr = *(const u32x4*)(kbase + (size_t)(64 * jt + lane) * NINP), vr = *(const u32x4*)(vbase + (size_t)(64 * jt + lane) * NINP);
    for (; jt >= 0; --jt) {
        __syncthreads();
        *(LAS u32x4*)(KS + lane * 72 + 8 * wv) = kr;
#pragma unroll
        for (int i = 0; i < 4; ++i) { const unsigned w = vr[i]; VT[(8 * wv + 2 * i) * 72 + lane] = (unsigned short)(w & 0xffffu); VT[(8 * wv + 2 * i + 1) * 72 + lane] = (unsigned short)(w >> 16); }
        __syncthreads();
        if (jt > 0) { kr = *(const u32x4*)(kbase + (size_t)(64 * (jt - 1) + lane) * NINP); vr = *(const u32x4*)(vbase + (size_t)(64 * (jt - 1) + lane) * NINP); }
        if (64 * jt < q0 + 31) {
            f32x16 z[2];
#pragma unroll
            for (int kb = 0; kb < 2; ++kb) {
                f32x16 acc;
#pragma unroll
                for (int i = 0; i < 16; ++i) acc[i] = 0.f;
#pragma unroll
                for (int kk = 0; kk < 4; ++kk) { const bf16x8 a = *(const LAS bf16x8*)(KS + (32 * kb + c) * 72 + 16 * kk + 8 * hi); acc = MFMA32(a, qf[kk], acc); }
                z[kb] = acc;
            }
            if (64 * jt + 63 < q0) sb_tile_weights<false>(z, R, jt, tq, hi); else sb_tile_weights<true>(z, R, jt, tq, hi);
#pragma unroll
            for (int kb = 0; kb < 2; ++kb)
#pragma unroll
                for (int s2 = 0; s2 < 2; ++s2) {
                    u32x4 pw; pw.x = pk2(z[kb][8 * s2 + 0], z[kb][8 * s2 + 1]); pw.y = pk2(z[kb][8 * s2 + 2], z[kb][8 * s2 + 3]); pw.z = pk2(z[kb][8 * s2 + 4], z[kb][8 * s2 + 5]); pw.w = pk2(z[kb][8 * s2 + 6], z[kb][8 * s2 + 7]);
                    const bf16x8 pb = __builtin_bit_cast(bf16x8, pw);
                    const int ko = 32 * kb + 16 * s2 + 4 * hi;
                    { const s16x4 lo = *(const LAS s16x4*)(VT + c * 72 + ko), hh = *(const LAS s16x4*)(VT + c * 72 + ko + 8);
                      const bf16x8 va = __builtin_shufflevector(lo, hh, 0, 1, 2, 3, 4, 5, 6, 7); o0 = MFMA32(va, pb, o0); }
                    { const s16x4 lo = *(const LAS s16x4*)(VT + (c + 32) * 72 + ko), hh = *(const LAS s16x4*)(VT + (c + 32) * 72 + ko + 8);
                      const bf16x8 va = __builtin_shufflevector(lo, hh, 0, 1, 2, 3, 4, 5, 6, 7); o1 = MFMA32(va, pb, o1); }
                }
        }
    }
    bf16_t* op = (bf16_t*)(p.ws + WS_OA) + (rowbase + tq) * 384 + h * 64 + 4 * hi;
#pragma unroll
    for (int g = 0; g < 4; ++g) {
        u32x2 w; w.x = pk2(o0[4 * g], o0[4 * g + 1]); w.y = pk2(o0[4 * g + 2], o0[4 * g + 3]); *(u32x2*)(op + 8 * g) = w;
        w.x = pk2(o1[4 * g], o1[4 * g + 1]); w.y = pk2(o1[4 * g + 2], o1[4 * g + 3]); *(u32x2*)(op + 32 + 8 * g) = w;
    }
}

DI void sb_sample_unit(const Ctx& p, int l, int b, int h, LAS unsigned char* lds) {
    const bf16_t* proj = (const bf16_t*)(p.ws + WS_PROJ);
    LAS float* qs = (LAS float*)lds;
    LAS float* Z = qs + 1024;
    LAS float* RED = Z + 16 * 1056;
    const int tid = pg8::tid_(), lane = tid & 63, wv = tid >> 6;
    const size_t srow = (size_t)MP + b * 16;
    for (int i = tid; i < 1024; i += NTHR) qs[i] = bf2f(proj[(srow + (i >> 6)) * NINP + C_QA + h * 64 + (i & 63)]) * 0.125f;
    __syncthreads();
    {
        float a0[16], a1[16];
#pragma unroll
        for (int i = 0; i < 16; ++i) { a0[i] = 0.f; a1[i] = 0.f; }
        const float* k0p = p.in[I_CSK] + ((((size_t)l * DB + b) * PAST + tid) * 6 + h) * 64; const float* k1p = k0p + (size_t)512 * 6 * 64;
#pragma unroll 8
        for (int d4 = 0; d4 < 16; ++d4) {
            const f32x4 ka = *(const f32x4*)(k0p + 4 * d4), kb = *(const f32x4*)(k1p + 4 * d4);
#pragma unroll
            for (int i = 0; i < 16; ++i) { const f32x4 q = *(const LAS f32x4*)(qs + i * 64 + 4 * d4);
                a0[i] += (q[0] * ka[0] + q[1] * ka[1]) + (q[2] * ka[2] + q[3] * ka[3]); a1[i] += (q[0] * kb[0] + q[1] * kb[1]) + (q[2] * kb[2] + q[3] * kb[3]); }
        }
#pragma unroll
        for (int i = 0; i < 16; ++i) { Z[i * 1056 + tid] = a0[i]; Z[i * 1056 + tid + 512] = a1[i]; }
        if (tid < 256) {
            const int i = tid >> 4, j = tid & 15; const bf16_t* kp = proj + (srow + j) * NINP + C_KA + h * 64; float s = 0.f;
            for (int d = 0; d < 64; ++d) s += qs[i * 64 + d] * bf2f(kp[d]);
            Z[i * 1056 + 1024 + j] = s;
        }
    }
    __syncthreads();
    for (int qq = 0; qq < 2; ++qq) {
        const int i = 2 * wv + qq, lim = PAST + i; LAS float* zr = Z + i * 1056;
        const int st = 17 * lane, en = (st + 17 < 1040) ? st + 17 : 1040;
        float tot = 0.f;
        for (int s = st; s < en; ++s) if (s < lim) tot -= softplusf_(zr[s]);
        float incl = tot;
#pragma unroll
        for (int o = 1; o < 64; o <<= 1) { const float t = __shfl_down(incl, o); if (lane + o < 64) incl += t; }
        float run = incl - tot;
        for (int s = en - 1; s >= st; --s) {
            const float zz = zr[s]; float w = 0.f;
            if (s < lim) { const float sp = softplusf_(zz); w = __expf(zz - sp + run); run -= sp; }
            zr[s] = w;
        }
    }
    __syncthreads();
    {
        const int d = tid & 63, g = tid >> 6;
        float o[16];
#pragma unroll
        for (int i = 0; i < 16; ++i) o[i] = 0.f;
        const float* vp = p.in[I_CSV] + (((size_t)l * DB + b) * PAST * 6 + h) * 64 + d;
        for (int s0 = 130 * g; s0 < 130 * g + 130; s0 += 26) {
            float v[26];
#pragma unroll
            for (int j = 0; j < 26; ++j) { const int s = s0 + j; v[j] = s < PAST ? vp[(size_t)s * 384] : bf2f(proj[(srow + (s - PAST)) * NINP + C_VA + h * 64 + d]); }
#pragma unroll
            for (int j = 0; j < 26; ++j)
#pragma unroll
                for (int i = 0; i < 16; ++i) o[i] += Z[i * 1056 + s0 + j] * v[j];
        }
#pragma unroll
        for (int i = 0; i < 16; ++i) RED[(g * 16 + i) * 64 + d] = o[i];
    }
    __syncthreads();
    for (int i = tid; i < 1024; i += NTHR) {
        const int qi = i >> 6, d = i & 63; float s = 0.f;
#pragma unroll
        for (int g = 0; g < 8; ++g) s += RED[(g * 16 + qi) * 64 + d];
        ((bf16_t*)(p.ws + WS_OA))[(srow + qi) * 384 + h * 64 + d] = f2bf(s);
    }
}

template <int W> DI void pool_rows(const float (&uu)[48], int t0, float* outp, bf16_t* pooled_col) {
    float s = 0.f;
#pragma unroll
    for (int i = 16 - W; i < 16; ++i) s += uu[i];
#pragma unroll
    for (int r = 0; r < 32; ++r) {
        s += uu[16 + r] - uu[16 + r - W];
        const int t = t0 + r; const float cnt = (float)((t + 1 < W) ? t + 1 : W);
        pooled_col[(size_t)r * 256] = f2bf(s / cnt - uu[16 + r]);
        if (t >= SEQ - 15) outp[(size_t)(t - (SEQ - 15)) * 256] = uu[16 + r];
    }
}
DI void pool_unit(const Ctx& p, int l, int unit) {
    const bf16_t* proj = (const bf16_t*)(p.ws + WS_PROJ); bf16_t* pooled = (bf16_t*)(p.ws + WS_POOLED);
    const int tid = pg8::tid_(), ch = tid & 255, w = 2 << (ch >> 6);
    if (unit < MP / 64) {
        const int r0 = unit * 64 + 32 * (tid >> 8), t0 = r0 & (SEQ - 1), b = r0 >> 11;
        float uu[48];
        const bf16_t* up = proj + (size_t)(r0 - 16) * NINP + C_U + ch;
#pragma unroll
        for (int i = 0; i < 48; ++i) uu[i] = (t0 - 16 + i >= 0) ? bf2f(up[(size_t)i * NINP]) : 0.f;
        float* outp = p.out + O_POOLP + ((size_t)(l * NB + b) * 15) * 256 + ch; bf16_t* pc = pooled + (size_t)r0 * 256 + ch;
        if (w == 2) pool_rows<2>(uu, t0, outp, pc); else if (w == 4) pool_rows<4>(uu, t0, outp, pc); else if (w == 8) pool_rows<8>(uu, t0, outp, pc); else pool_rows<16>(uu, t0, outp, pc);
        return;
    }
    for (int i = 0; i < 32; ++i) {
        const int row = unit * 64 + (tid >> 8) + 2 * i;
        const int rs = row - MP, b = rs >> 4, t = rs & 15; float s = 0.f;
        const bf16_t* up = proj + (size_t)row * NINP + C_U + ch; const float u0 = bf2f(up[0]);
        const float* hist = p.in[I_SPOOL] + ((size_t)(l * DB + b) * 15) * 256 + ch;
        for (int j = 0; j < w; ++j) { const int tt = t - j; s += tt >= 0 ? bf2f(*(up - (size_t)j * NINP)) : hist[(15 + tt) * 256]; }
        if (t >= 1) p.out[O_POOLS + ((size_t)(l * DB + b) * 15 + (t - 1)) * 256 + ch] = u0;
        pooled[(size_t)row * 256 + ch] = f2bf(s / (float)w - u0);
    }
}

DI void kvout_unit(const Ctx& p, int l, int unit) {
    const bf16_t* proj = (const bf16_t*)(p.ws + WS_PROJ);
#pragma unroll 4
    for (int i = pg8::tid_(); i < 64 * 96; i += NTHR) {
        const int r = i / 96, ch = i % 96, row = unit * 64 + r;
        const u32x4 w = *(const u32x4*)(proj + (size_t)row * NINP + C_KA + 8 * ch);
        const bool isv = ch >= 48; const int c = 8 * (isv ? ch - 48 : ch);
        float* dst = (row < MP) ? p.out + (isv ? O_VP : O_KP) + ((size_t)l * MP + row) * 384 + c : p.out + (isv ? O_VS : O_KS) + ((size_t)l * MS + (row - MP)) * 384 + c;
        *(f32x4*)dst = (f32x4){bflo(w.x), bfhi(w.x), bflo(w.y), bfhi(w.y)}; *(f32x4*)(dst + 4) = (f32x4){bflo(w.z), bfhi(w.z), bflo(w.w), bfhi(w.w)};
    }
}
DI void memout_unit(const Ctx& p, int unit) {
    const bf16_t* mkv = (const bf16_t*)(p.ws + WS_MKV);
    for (int i = pg8::tid_(); i < 16 * 256; i += NTHR) {
        const int r = i >> 8, ch = i & 255, row = unit * 16 + r, col = 8 * ch;
        const u32x4 w = *(const u32x4*)(mkv + (size_t)row * 2048 + col);
        float* dst = p.out + (col >= 1024 ? O_MVP : O_MKP) + (size_t)row * D + (col & 1023);
        *(f32x4*)dst = (f32x4){bflo(w.x), bfhi(w.x), bflo(w.y), bfhi(w.y)}; *(f32x4*)(dst + 4) = (f32x4){bflo(w.z), bfhi(w.z), bflo(w.w), bfhi(w.w)};
    }
}
DI void memvt_unit(const Ctx& p, int unit) {
    const int l = unit >> 7, nb = (unit >> 3) & 15, b = unit & 7, tid = pg8::tid_(), n = nb * 64 + (tid & 63), wv = tid >> 6;
    const bf16_t* src = (const bf16_t*)(p.ws + WS_MKV) + ((size_t)l * 2048 + b * 256) * 2048 + 1024 + n;
    bf16_t* dst = (bf16_t*)(p.ws + WS_MEMVT) + ((size_t)l * 1024 + n) * 2048 + b * 256;
    for (int c = wv; c < 32; c += 8) {
        unsigned v[8];
#pragma unroll
        for (int j = 0; j < 8; ++j) v[j] = src[(size_t)(8 * c + j) * 2048];
        u32x4 w; w.x = v[0] | (v[1] << 16); w.y = v[2] | (v[3] << 16); w.z = v[4] | (v[5] << 16); w.w = v[6] | (v[7] << 16);
        *(u32x4*)(dst + 8 * c) = w;
    }
}

DI void gla_decay(const Ctx& p, int l, int h, size_t row0, int ntok, LAS unsigned char* lds) {
    const bf16_t* proj = (const bf16_t*)(p.ws + WS_PROJ);
    LAS float* Bc = (LAS float*)lds; LAS float* LR = (LAS float*)(lds + 24576); LAS float* A2 = (LAS float*)(lds + 28672); LAS float* BIA = (LAS float*)(lds + 34816); LAS float* SEG = (LAS float*)(lds + 35200);
    const int tid = pg8::tid_();
    if (tid < 128) {
        const int t = tid >> 1, hf = tid & 1; u32x4 w = {0u, 0u, 0u, 0u};
        if (t < ntok) w = *(const u32x4*)(proj + (row0 + t) * NINP + C_LR + 8 * hf);
        LAS float* d = LR + t * 16 + 8 * hf;
        d[0] = bflo(w.x); d[1] = bfhi(w.x); d[2] = bflo(w.y); d[3] = bfhi(w.y); d[4] = bflo(w.z); d[5] = bfhi(w.z); d[6] = bflo(w.w); d[7] = bfhi(w.w);
    } else if (tid < 128 + 384) {
        const int i = tid - 128, r = i / 24, c4 = i % 24;
        *(LAS f32x4*)(A2 + r * 96 + 4 * c4) = *(const f32x4*)(p.in[I_WA2] + ((size_t)l * 16 + r) * 384 + h * 96 + 4 * c4);
    }
    if (tid < 96) BIA[tid] = p.in[I_BA][l * 384 + h * 96 + tid];
    __syncthreads();
    for (int i = tid; i < 64 * 96; i += NTHR) {
        const int t = i / 96, k = i % 96; float sacc = BIA[k];
#pragma unroll
        for (int r = 0; r < 16; ++r) sacc += LR[t * 16 + r] * A2[r * 96 + k];
        Bc[i] = t < ntok ? -softplusf_(-sacc) * (1.f / 16.f) : 0.f;
    }
    __syncthreads();
    const int k = tid % 96, seg = tid / 96;
    if (tid < 384) { float run = 0.f; for (int i = 0; i < 16; ++i) { const int idx = (16 * seg + i) * 96 + k; run += Bc[idx]; Bc[idx] = run; } SEG[seg * 96 + k] = run; }
    __syncthreads();
    if (tid < 384 && seg > 0) { float off = 0.f; for (int s2 = 0; s2 < seg; ++s2) off += SEG[s2 * 96 + k]; for (int i = 0; i < 16; ++i) Bc[(16 * seg + i) * 96 + k] += off; }
    __syncthreads();
}
DI void gla_unit_rows(int gu, size_t& row0, int& ntok, int& bh, int& h) {
    if (gu < NGU_P) { bh = gu >> 5; const int c = gu & 31, b = bh >> 2; h = bh & 3; row0 = (size_t)b * SEQ + c * 64; ntok = 64; }
    else { bh = gu - NGU_P; const int b = bh >> 2; h = bh & 3; row0 = (size_t)MP + b * 16; ntok = 16; }
}
DI void gla_stage1_unit(const Ctx& p, int l, int gu, LAS unsigned char* lds) {
    const bf16_t* proj = (const bf16_t*)(p.ws + WS_PROJ);
    size_t row0; int ntok, bh, h; gla_unit_rows(gu, row0, ntok, bh, h);
    gla_decay(p, l, h, row0, ntok, lds);
    LAS float* Bc = (LAS float*)lds;
    LAS unsigned short* KT = (LAS unsigned short*)(lds + 36864);
    LAS unsigned short* VT = KT + 96 * 72;
    const int tid = pg8::tid_(), lane = tid & 63, wv = tid >> 6, fr = lane & 15, fq = lane >> 4;
    {
        float* bb = (float*)(p.ws + WS_BB) + (size_t)gu * (64 * GK);
        for (int i = tid; i < 64 * GK / 4; i += NTHR) *(f32x4*)(bb + 4 * i) = *(const LAS f32x4*)(Bc + 4 * i);
    }
    for (int task = tid; task < 768; task += NTHR) {
        const int t = task & 63, ch = task >> 6; u32x4 kw = {0u, 0u, 0u, 0u}, vw = {0u, 0u, 0u, 0u};
        if (t < ntok) { const bf16_t* rp = proj + (row0 + t) * NINP + h * 96 + 8 * ch; kw = *(const u32x4*)(rp + C_KC); vw = *(const u32x4*)(rp + C_VC); }
        const unsigned kk[4] = {kw.x, kw.y, kw.z, kw.w}, vv[4] = {vw.x, vw.y, vw.z, vw.w};
#pragma unroll
        for (int j = 0; j < 4; ++j) {
            const int k0 = 8 * ch + 2 * j;
            const float e0 = __expf(Bc[(ntok - 1) * 96 + k0] - Bc[t * 96 + k0]), e1 = __expf(Bc[(ntok - 1) * 96 + k0 + 1] - Bc[t * 96 + k0 + 1]);
            KT[k0 * 72 + t] = f2bf(bflo(kk[j]) * e0); KT[(k0 + 1) * 72 + t] = f2bf(bfhi(kk[j]) * e1);
            VT[k0 * 72 + t] = (unsigned short)(vv[j] & 0xffffu); VT[(k0 + 1) * 72 + t] = (unsigned short)(vv[j] >> 16);
        }
    }
    if (tid < 96) ((float*)(p.ws + WS_GDEC))[(size_t)gu * 96 + tid] = __expf(Bc[(ntok - 1) * 96 + tid]);
    __syncthreads();
    float* KV = (float*)(p.ws + WS_GKV) + (size_t)gu * (GK * GK);
    for (int tile = wv; tile < 36; tile += 8) {
        const int ki = tile / 6, vi = tile % 6; f32x4 acc = {0.f, 0.f, 0.f, 0.f};
#pragma unroll
        for (int ks = 0; ks < 2; ++ks) { const bf16x8 a = *(const LAS bf16x8*)(KT + (16 * ki + fr) * 72 + 32 * ks + 8 * fq), bb = *(const LAS bf16x8*)(VT + (16 * vi + fr) * 72 + 32 * ks + 8 * fq); acc = MFMA16(a, bb, acc); }
#pragma unroll
        for (int j = 0; j < 4; ++j) KV[(16 * ki + 4 * fq + j) * 96 + 16 * vi + fr] = acc[j];
    }
}
DI void gla_scan(const Ctx& p, int l) {
    const int gt = blockIdx.x * NTHR + pg8::tid_(), NT = gridDim.x * NTHR;
    const float* KV = (const float*)(p.ws + WS_GKV); const float* DEC = (const float*)(p.ws + WS_GDEC); float* SP = (float*)(p.ws + WS_GSP);
    for (int e = gt; e < 32 * GK * GK; e += NT) {
        const int bh = e / (GK * GK), kv = e % (GK * GK), k = kv / GK; float S = 0.f;
        float kvv[32], dcv[32];
#pragma unroll
        for (int c = 0; c < 32; ++c) { const size_t gu = (size_t)bh * 32 + c; kvv[c] = KV[gu * (GK * GK) + kv]; dcv[c] = DEC[gu * 96 + k]; }
#pragma unroll
        for (int c = 0; c < 32; ++c) { const size_t gu = (size_t)bh * 32 + c; SP[gu * (GK * GK) + kv] = S; S = dcv[c] * S + kvv[c]; }
        p.out[O_GLAP + ((size_t)l * 32 + bh) * (GK * GK) + kv] = S;
    }
    for (int e = gt; e < 64 * GK * GK; e += NT) {
        const int bh = e / (GK * GK), kv = e % (GK * GK), k = kv / GK; const size_t gu = (size_t)NGU_P + bh;
        const float S0 = p.in[I_SGLA][((size_t)l * 64 + bh) * (GK * GK) + kv];
        p.out[O_GLAS + ((size_t)l * 64 + bh) * (GK * GK) + kv] = DEC[gu * 96 + k] * S0 + KV[gu * (GK * GK) + kv];
    }
}
DI void gla_stage3_unit(const Ctx& p, int l, int gu, LAS unsigned char* lds) {
    const bf16_t* proj = (const bf16_t*)(p.ws + WS_PROJ);
    size_t row0; int ntok, bh, h; gla_unit_rows(gu, row0, ntok, bh, h);
    LAS float* OT = (LAS float*)lds;
    LAS unsigned short* QP = (LAS unsigned short*)(lds + 36864);
    LAS unsigned short* KP = QP + 64 * 104;
    LAS unsigned short* VT = KP + 64 * 104;
    LAS unsigned short* ST = VT + 96 * 72;
    LAS unsigned short* ATT = ST + 96 * 104;
    const int tid = pg8::tid_(), lane = tid & 63, wv = tid >> 6, fr = lane & 15, fq = lane >> 4;
    const float* Sprev = gu < NGU_P ? (const float*)(p.ws + WS_GSP) + (size_t)gu * (GK * GK) : p.in[I_SGLA] + ((size_t)l * 64 + bh) * (GK * GK);
    const float* bb = (const float*)(p.ws + WS_BB) + (size_t)gu * (64 * GK);
    __syncthreads();
    for (int task = tid; task < 768; task += NTHR) {
        const int t = task & 63, ch = task >> 6; u32x4 qw = {0u, 0u, 0u, 0u}, kw = qw, vw = qw; f32x4 b0 = {0.f, 0.f, 0.f, 0.f}, b1 = b0;
        if (t < ntok) { const bf16_t* rp = proj + (row0 + t) * NINP + h * 96 + 8 * ch; qw = *(const u32x4*)(rp + C_QC); kw = *(const u32x4*)(rp + C_KC); vw = *(const u32x4*)(rp + C_VC);
            b0 = *(const f32x4*)(bb + t * 96 + 8 * ch); b1 = *(const f32x4*)(bb + t * 96 + 8 * ch + 4); }
        const unsigned qq[4] = {qw.x, qw.y, qw.z, qw.w}, kk[4] = {kw.x, kw.y, kw.z, kw.w}, vv[4] = {vw.x, vw.y, vw.z, vw.w};
        const float be[8] = {b0[0], b0[1], b0[2], b0[3], b1[0], b1[1], b1[2], b1[3]};
        u32x4 qo, ko; unsigned qa[4], ka[4];
#pragma unroll
        for (int j = 0; j < 4; ++j) {
            const float e0 = __expf(be[2 * j]), e1 = __expf(be[2 * j + 1]), r0 = __builtin_amdgcn_rcpf(e0), r1 = __builtin_amdgcn_rcpf(e1);
            const bool ok = t < ntok;
            qa[j] = ok ? pk2(bflo(qq[j]) * 0.10206207261596575f * e0, bfhi(qq[j]) * 0.10206207261596575f * e1) : 0u;
            ka[j] = ok ? pk2(bflo(kk[j]) * r0, bfhi(kk[j]) * r1) : 0u;
            VT[(8 * ch + 2 * j) * 72 + t] = (unsigned short)(vv[j] & 0xffffu); VT[(8 * ch + 2 * j + 1) * 72 + t] = (unsigned short)(vv[j] >> 16);
        }
        qo.x = qa[0]; qo.y = qa[1]; qo.z = qa[2]; qo.w = qa[3]; ko.x = ka[0]; ko.y = ka[1]; ko.z = ka[2]; ko.w = ka[3];
        *(LAS u32x4*)(QP + t * 104 + 8 * ch) = qo; *(LAS u32x4*)(KP + t * 104 + 8 * ch) = ko;
    }
    for (int task = tid; task < 2304; task += NTHR) {
        const int k = task % 96, vc = task / 96; const f32x4 sv = *(const f32x4*)(Sprev + k * 96 + 4 * vc);
#pragma unroll
        for (int j = 0; j < 4; ++j) ST[(4 * vc + j) * 104 + k] = f2bf(sv[j]);
    }
    __syncthreads();
    for (int tile = 2 * wv; tile < 2 * wv + 2; ++tile) {
        const int ti = tile >> 2, si = tile & 3; f32x4 acc = {0.f, 0.f, 0.f, 0.f};
        if (si <= ti) {
#pragma unroll
            for (int ks = 0; ks < 3; ++ks) { const bf16x8 a = *(const LAS bf16x8*)(QP + (16 * ti + fr) * 104 + 32 * ks + 8 * fq), b2 = *(const LAS bf16x8*)(KP + (16 * si + fr) * 104 + 32 * ks + 8 * fq); acc = MFMA16(a, b2, acc); }
        }
#pragma unroll
        for (int j = 0; j < 4; ++j) { const int t = 16 * ti + 4 * fq + j, s2 = 16 * si + fr; ATT[t * 72 + s2] = f2bf(s2 <= t ? acc[j] : 0.f); }
    }
    __syncthreads();
    for (int tile = wv; tile < 24; tile += 8) {
        const int ti = tile / 6, vi = tile % 6; f32x4 acc = {0.f, 0.f, 0.f, 0.f};
#pragma unroll
        for (int ks = 0; ks < 2; ++ks) { const bf16x8 a = *(const LAS bf16x8*)(ATT + (16 * ti + fr) * 72 + 32 * ks + 8 * fq), b2 = *(const LAS bf16x8*)(VT + (16 * vi + fr) * 72 + 32 * ks + 8 * fq); acc = MFMA16(a, b2, acc); }
#pragma unroll
        for (int ks = 0; ks < 3; ++ks) { const bf16x8 a = *(const LAS bf16x8*)(QP + (16 * ti + fr) * 104 + 32 * ks + 8 * fq), b2 = *(const LAS bf16x8*)(ST + (16 * vi + fr) * 104 + 32 * ks + 8 * fq); acc = MFMA16(a, b2, acc); }
#pragma unroll
        for (int j = 0; j < 4; ++j) OT[(16 * ti + 4 * fq + j) * 96 + 16 * vi + fr] = acc[j];
    }
    __syncthreads();
    bf16_t* oc = (bf16_t*)(p.ws + WS_OC);
    const float* gn = p.in[I_GLAN] + l * 384 + h * 96; const float gn0 = gn[lane], gn1 = lane < 32 ? gn[64 + lane] : 0.f;
    float g0[8], g1[8];
#pragma unroll
    for (int tt = 0; tt < 8; ++tt) { const int t = wv * 8 + tt; g0[tt] = 0.f; g1[tt] = 0.f;
        if (t < ntok) { const bf16_t* gp = proj + (row0 + t) * NINP + C_GC + h * 96; g0[tt] = bf2f(gp[lane]); if (lane < 32) g1[tt] = bf2f(gp[64 + lane]); } }
#pragma unroll
    for (int tt = 0; tt < 8; ++tt) {
        const int t = wv * 8 + tt;
        if (t < ntok) {
            const float a0 = OT[t * 96 + lane], a1 = lane < 32 ? OT[t * 96 + 64 + lane] : 0.f;
            const float rs = rsqrtf(wave_sum(a0 * a0 + a1 * a1) * (1.f / 96.f) + EPS);
            oc[(row0 + t) * 384 + h * 96 + lane] = f2bf(a0 * rs * gn0 * g0[tt] * sigmoidf_(g0[tt]));
            if (lane < 32) oc[(row0 + t) * 384 + h * 96 + 64 + lane] = f2bf(a1 * rs * gn1 * g1[tt] * sigmoidf_(g1[tt]));
        }
    }
}

DI void cross_sample_unit(const Ctx& p, int l, int b, int h, int qh, LAS unsigned char* lds) {
    LAS float* qs = (LAS float*)lds;
    LAS float* ST = qs + 8 * 256;
    LAS float* PART = ST + 256 * 8;
    const bf16_t* Q = (const bf16_t*)(p.ws + WS_Q);
    const int tid = pg8::tid_(), lane = tid & 63, wv = tid >> 6;
    const size_t srow = (size_t)MP + b * 16 + 8 * qh;
    for (int i = tid; i < 8 * 256; i += NTHR) qs[i] = bf2f(Q[(srow + (i >> 8)) * D + h * 256 + (i & 255)]) * 0.0625f;
    __syncthreads();
    const int m = tid & 255, half = tid >> 8;
    {
        float acc[8];
#pragma unroll
        for (int i = 0; i < 8; ++i) acc[i] = 0.f;
        const float* kp = p.in[I_CMK] + ((((size_t)l * DB + b) * 256 + m) * 4 + h) * 256 + 128 * half;
#pragma unroll 16
        for (int d4 = 0; d4 < 32; ++d4) {
            const f32x4 kv = *(const f32x4*)(kp + 4 * d4);
#pragma unroll
            for (int i = 0; i < 8; ++i) { const f32x4 q = *(const LAS f32x4*)(qs + i * 256 + 128 * half + 4 * d4); acc[i] += (q[0] * kv[0] + q[1] * kv[1]) + (q[2] * kv[2] + q[3] * kv[3]); }
        }
#pragma unroll
        for (int i = 0; i < 8; ++i) PART[(half * 8 + i) * 256 + m] = acc[i];
    }
    __syncthreads();
    {
        const int i = wv; float v[4], mx = -3.0e38f;
#pragma unroll
        for (int j = 0; j < 4; ++j) { v[j] = PART[i * 256 + lane + 64 * j] + PART[(8 + i) * 256 + lane + 64 * j]; mx = fmaxf(mx, v[j]); }
        mx = wave_max(mx); float sum = 0.f;
#pragma unroll
        for (int j = 0; j < 4; ++j) { v[j] = __expf(v[j] - mx); sum += v[j]; }
        sum = wave_sum(sum); const float inv = 1.f / sum;
#pragma unroll
        for (int j = 0; j < 4; ++j) ST[(lane + 64 * j) * 8 + i] = v[j] * inv;
    }
    __syncthreads();
    {
        float acc[8];
#pragma unroll
        for (int i = 0; i < 8; ++i) acc[i] = 0.f;
        const float* vp = p.in[I_CMV] + ((((size_t)l * DB + b) * 256 + 128 * half) * 4 + h) * 256 + m;
        for (int k0 = 0; k0 < 128; k0 += 32) {
            float v[32];
#pragma unroll
            for (int j = 0; j < 32; ++j) v[j] = vp[(size_t)(k0 + j) * 1024];
#pragma unroll
            for (int j = 0; j < 32; ++j) {
                const f32x4 s0 = *(const LAS f32x4*)(ST + (128 * half + k0 + j) * 8), s1 = *(const LAS f32x4*)(ST + (128 * half + k0 + j) * 8 + 4);
                acc[0] += s0[0] * v[j]; acc[1] += s0[1] * v[j]; acc[2] += s0[2] * v[j]; acc[3] += s0[3] * v[j];
                acc[4] += s1[0] * v[j]; acc[5] += s1[1] * v[j]; acc[6] += s1[2] * v[j]; acc[7] += s1[3] * v[j];
            }
        }
#pragma unroll
        for (int i = 0; i < 8; ++i) PART[(half * 8 + i) * 256 + m] = acc[i];
    }
    __syncthreads();
    bf16_t* O = (bf16_t*)(p.ws + WS_O);
    for (int i = tid; i < 8 * 256; i += NTHR) { const int qi = i >> 8, d = i & 255; O[(srow + qi) * D + h * 256 + d] = f2bf(PART[qi * 256 + d] + PART[(8 + qi) * 256 + d]); }
}

struct SkBf16 { bf16_t* O; int ldc; DI void operator()(int row, int col, f32x4 v) const { u32x2 w; w.x = pk2(v[0], v[1]); w.y = pk2(v[2], v[3]); *(u32x2*)(O + (size_t)(MP + row) * ldc + col) = w; } };
struct SkGate { bf16_t* merged; const bf16_t* proj; int goff; int accum;
    DI void operator()(int row, int col, f32x4 v) const {
        const u32x2 g = *(const u32x2*)(proj + (size_t)(MP + row) * NINP + goff + col); bf16_t* mp = merged + (size_t)(MP + row) * D + col;
        u32x2 pm2 = {0u, 0u}; if (accum) pm2 = *(const u32x2*)mp;
        u32x2 w; w.x = pk2(sigmoidf_(bflo(g.x)) * v[0] + bflo(pm2.x), sigmoidf_(bfhi(g.x)) * v[1] + bfhi(pm2.x)); w.y = pk2(sigmoidf_(bflo(g.y)) * v[2] + bflo(pm2.y), sigmoidf_(bfhi(g.y)) * v[3] + bfhi(pm2.y));
        *(u32x2*)mp = w; } };
template <class EF> DI void skinny_gemm(const bf16_t* A, int lda, const bf16_t* Bt, int ldb, int K, int N, int G, int bx, LAS unsigned char* lds, const EF& ef) {
    const int tid = pg8::tid_(), lane = tid & 63, wv = tid >> 6, fr = lane & 15, fq = lane >> 4, nks = K >> 5, nunits = 4 * (N >> 4);
    LAS f32x4* red = (LAS f32x4*)lds;
    for (int u = bx; u < nunits; u += G) {
        const int rb = u & 3, cb = u >> 2;
        f32x4 acc[4];
#pragma unroll
        for (int i = 0; i < 4; ++i) acc[i] = (f32x4){0.f, 0.f, 0.f, 0.f};
        const bf16_t* bp = Bt + (size_t)(16 * cb + fr) * ldb + 8 * fq; const bf16_t* ap = A + (size_t)(64 * rb + fr) * lda + 8 * fq;
        for (int ks = wv; ks < nks; ks += 8) {
            const bf16x8 bb = *(const bf16x8*)(bp + 32 * ks);
            bf16x8 aa[4];
#pragma unroll
            for (int i = 0; i < 4; ++i) aa[i] = *(const bf16x8*)(ap + (size_t)(16 * i) * lda + 32 * ks);
#pragma unroll
            for (int i = 0; i < 4; ++i) acc[i] = MFMA16(bb, aa[i], acc[i]);
        }
#pragma unroll
        for (int i = 0; i < 4; ++i) red[(wv * 4 + i) * 64 + lane] = acc[i];
        __syncthreads();
        if (tid < 256) {
            const int i = tid >> 6; f32x4 s = red[i * 64 + lane];
#pragma unroll
            for (int w = 1; w < 8; ++w) s = s + red[(w * 4 + i) * 64 + lane];
            ef(64 * rb + 16 * i + fr, 16 * cb + 4 * fq, s);
        }
        __syncthreads();
    }
}

constexpr int PH_PER_LAYER = 15, N_PHASES = 1 + DEPTH * PH_PER_LAYER;
#define RUN_GEMM(EpiT, E, Aptr, lda_, Bptr, ldb_, K_, pm0_, nM_, nN_) do { const pg8::Gemm g_{(K_), (lda_), (ldb_)}; pg8::TileOrder S_; S_.init((Aptr), (lda_), (Bptr), (ldb_), (pm0_), (nM_), (nN_), G, bx); \
        pg8::gemm_phase<EpiT, pg8::TileOrder, true, true>(lds, g_, S_, (E)); } while (0)

__global__ void __launch_bounds__(NTHR, 2) fwd_kernel(Params p) {
    extern __shared__ __attribute__((aligned(16))) unsigned char lds_raw[];
#define PROJ ((bf16_t*)(ws + WS_PROJ))
#define H ((bf16_t*)(ws + WS_XB))
#define MERGED ((bf16_t*)(ws + WS_MERGED))
#define Y ((bf16_t*)(ws + WS_Y))
#define QB ((bf16_t*)(ws + WS_Q))
#define PB ((bf16_t*)(ws + WS_P))
#define OB ((bf16_t*)(ws + WS_O))
#define ACT ((bf16_t*)(ws + WS_ACT))

    {
        volatile LAS unsigned* st0 = (volatile LAS unsigned*)((LAS unsigned char*)lds_raw + LDS_MISC + 32);
        if (pg8::tid_() == 0) { st0[0] = 0u; st0[1] = 0u; st0[8] = 0u; st0[9] = 0u; }
        __syncthreads();
    }
    XcdBarrier xbar = xcd_barrier_post((unsigned*)(p.ws + WS_CTL) + CW_BAR, (volatile LAS unsigned*)((LAS unsigned char*)lds_raw + LDS_MISC + 32));
    if (p.ph_lo == 0) {
        prologue(p, (LAS unsigned char*)lds_raw);
        if (blockIdx.x == 0 && pg8::tid_() == 0) {
            const float** tab = (const float**)(p.ws + WS_TAB);
#pragma unroll
            for (int i = 0; i < N_IN; ++i) tab[i] = p.in[i];
        }
        if (p.ph_hi > 1) xcd_barrier(xbar);
        if (p.ph_hi < 0) cg::this_grid().sync();
    }
    for (int ph = p.ph_lo > 1 ? p.ph_lo : 1; ph < p.ph_hi; ++ph) {
        unsigned ldsb = (unsigned)(size_t)(LAS unsigned char*)lds_raw; asm volatile("" : "+s"(ldsb));
        LAS unsigned char* lds = (LAS unsigned char*)(size_t)ldsb;
        volatile LAS int* slot = (volatile LAS int*)(lds + LDS_MISC);
        unsigned char* ws = p.ws; asm volatile("" : "+s"(ws));
        Ctx c; c.ws = ws; c.in.t = (const float* const*)(ws + WS_TAB); c.out = p.out;
        unsigned* ctl = (unsigned*)(ws + WS_CTL);
        int G = gridDim.x, bx = blockIdx.x; asm volatile("" : "+s"(G), "+s"(bx));
        {
            const int l = (ph - 1) / PH_PER_LAYER, st = (ph - 1) % PH_PER_LAYER;
#ifdef PROBE_SEL
            if (bx == 0) { volatile LAS unsigned long long* a_ = (volatile LAS unsigned long long*)(lds + LDS_MISC + 64); a_[1] = __builtin_amdgcn_s_memrealtime(); }
#endif
            switch (st) {
            case 0: {
                EpiBf16 E{PROJ, NINP, 0xffff};
                RUN_GEMM(EpiBf16, E, H, D, ws + WS_WIN + l * SZ_WIN, D, D, 0, MA / 256, NINP / 256);
                if (l == 0) {
                    const pg8::Gemm g{D, D, D}; MemKvOrder S{G, bx, (const char*)(ws + WS_MN), (const char*)(ws + WS_WKV)};
                    EpiBf16 E2{(bf16_t*)(ws + WS_MKV), 2048, 7};
                    pg8::gemm_phase<EpiBf16, MemKvOrder, true, true>(lds, g, S, E2);
                }
            } break;
            case 1: {
                unsigned* ctr = ctl + 64 * ph;
                constexpr int U_SBP = 384, U_SBS = U_SBP + DB * 6, U_GLA = U_SBS + NGU, U_POOL = U_GLA + MA / 64, U_KV = U_POOL + MA / 64, U_MO = U_KV + 512, U_VT = U_MO + 512;
                const int U_ALL = l == 0 ? U_VT : U_KV;
                for (;;) {
                    const int u = next_work(ctr, slot); if (u >= U_ALL) break;
#ifdef PROBE_SEL
                    const int ut_ = u < DB * 6 ? 10 : (u < U_SBS ? 11 : (u < U_GLA ? 12 : 13));
                    if (bx == 0 && ut_ == PROBE_SEL) { volatile LAS unsigned long long* a_ = (volatile LAS unsigned long long*)(lds + LDS_MISC + 64); a_[3] = __builtin_amdgcn_s_memrealtime(); }
#endif
                    if (u < DB * 6) sb_sample_unit(c, l, u / 6, u % 6, lds);
                    else if (u < U_SBS) { const int v = u - DB * 6, qb = 7 - v / 48, bh = v % 48; sb_prompt_unit(c, bh / 6, bh % 6, qb, lds); }
                    else if (u < U_GLA) gla_stage1_unit(c, l, u - U_SBS, lds);
                    else if (u < U_POOL) pool_unit(c, l, u - U_GLA);
                    else if (u < U_KV) kvout_unit(c, l, u - U_POOL);
                    else if (u < U_MO) memout_unit(c, u - U_KV);
                    else memvt_unit(c, u - U_MO);
#ifdef PROBE_SEL
                    if (bx == 0 && ut_ == PROBE_SEL) { volatile LAS unsigned long long* a_ = (volatile LAS unsigned long long*)(lds + LDS_MISC + 64); __hip_atomic_fetch_add((LAS unsigned long long*)a_, __builtin_amdgcn_s_memrealtime() - a_[3], __ATOMIC_RELAXED, __HIP_MEMORY_SCOPE_WORKGROUP); }
#endif
                }
            } break;
            case 2: gla_scan(c, l); break;
            case 3: {
                unsigned* ctr = ctl + 64 * ph;
                for (;;) { const int u = next_work(ctr, slot); if (u >= NGU) break; gla_stage3_unit(c, l, u, lds); }
            } break;
            case 4: {
                EpiGate E1{MERGED, PROJ, C_GA, 0}, E2{MERGED, PROJ, C_GB, 1}, E3{MERGED, PROJ, C_GCG, 1};
                RUN_GEMM(EpiGate, E1, ws + WS_OA, 384, ws + WS_WBA + l * SZ_WBA, 384, 384, 0, MP / 256, 4);
                RUN_GEMM(EpiGate, E2, ws + WS_POOLED, 256, ws + WS_WBB + l * SZ_WBB, 256, 256, 0, MP / 256, 4);
                RUN_GEMM(EpiGate, E3, ws + WS_OC, 384, ws + WS_WBC + l * SZ_WBA, 384, 384, 0, MP / 256, 4);
                { SkGate F1{MERGED, PROJ, C_GA, 0}, F2{MERGED, PROJ, C_GB, 1}, F3{MERGED, PROJ, C_GCG, 1};
                  skinny_gemm((const bf16_t*)(ws + WS_OA) + (size_t)MP * 384, 384, (const bf16_t*)(ws + WS_WBA + l * SZ_WBA), 384, 384, D, G, bx, lds, F1);
                  skinny_gemm((const bf16_t*)(ws + WS_POOLED) + (size_t)MP * 256, 256, (const bf16_t*)(ws + WS_WBB + l * SZ_WBB), 256, 256, D, G, bx, lds, F2);
                  skinny_gemm((const bf16_t*)(ws + WS_OC) + (size_t)MP * 384, 384, (const bf16_t*)(ws + WS_WBC + l * SZ_WBA), 384, 384, D, G, bx, lds, F3); }
            } break;
            case 5: { EpiBf16 E{Y, D, 0xffff}; RUN_GEMM(EpiBf16, E, MERGED, D, ws + WS_WMIX + l * SZ_WSQ, D, D, 0, MP / 256, 4);
                SkBf16 F{Y, D}; skinny_gemm((const bf16_t*)MERGED + (size_t)MP * D, D, (const bf16_t*)(ws + WS_WMIX + l * SZ_WSQ), D, D, D, G, bx, lds, F); } break;
            case 6: norm_phase(c, c.in[I_NMIXPOST] + l * D, false, G, bx); break;
            case 7: { EpiBf16 E{QB, D, 0xffff}; RUN_GEMM(EpiBf16, E, H, D, ws + WS_WXQ + l * SZ_WSQ, D, D, 0, MP / 256, 4);
                SkBf16 F{QB, D}; skinny_gemm((const bf16_t*)H + (size_t)MP * D, D, (const bf16_t*)(ws + WS_WXQ + l * SZ_WSQ), D, D, D, G, bx, lds, F); } break;
            case 8: {
                const pg8::Gemm g{256, D, 2048}; CrossOrder S{G, bx, (const char*)QB, (const char*)(ws + WS_MKV + (size_t)l * 2 * SZ_WKV), 0};
                EpiSoftmax E{PB, (LAS float*)(lds + LDS_X)};
                pg8::gemm_phase<EpiSoftmax, CrossOrder, true, true>(lds, g, S, E);
            } break;
            case 9: {
                const pg8::Gemm g{256, D, 2048}; CrossOrder S{G, bx, (const char*)PB, (const char*)(ws + WS_MEMVT + (size_t)l * SZ_WKV), 1};
                EpiBf16 E{OB, D, 0xffff};
                pg8::gemm_phase<EpiBf16, CrossOrder, true, true>(lds, g, S, E);
                for (int u = bx; u < DB * 4 * 2; u += G) { __syncthreads(); cross_sample_unit(c, l, u >> 3, (u >> 1) & 3, u & 1, lds); }
            } break;
            case 10: { EpiBf16 E{Y, D, 0xffff}; RUN_GEMM(EpiBf16, E, OB, D, ws + WS_WXO + l * SZ_WSQ, D, D, 0, MP / 256, 4);
                SkBf16 F{Y, D}; skinny_gemm((const bf16_t*)OB + (size_t)MP * D, D, (const bf16_t*)(ws + WS_WXO + l * SZ_WSQ), D, D, D, G, bx, lds, F); } break;
            case 11: norm_phase(c, c.in[I_NXPOST] + l * D, false, G, bx); break;
            case 12: { EpiSwiglu E{ACT}; RUN_GEMM(EpiSwiglu, E, H, D, ws + WS_WF1 + l * SZ_WF1, D, D, 0, MA / 256, FF2 / 256); } break;
            case 13: { EpiBf16 E{Y, D, 0xffff}; RUN_GEMM(EpiBf16, E, ACT, FF, ws + WS_WF2 + l * SZ_WF2, FF, FF, 0, MP / 256, 4);
                SkBf16 F{Y, D}; skinny_gemm((const bf16_t*)ACT + (size_t)MP * FF, FF, (const bf16_t*)(ws + WS_WF2 + l * SZ_WF2), FF, FF, D, G, bx, lds, F); } break;
            default: norm_phase(c, c.in[I_NFPOST] + l * D, l == DEPTH - 1, G, bx); break;
            }
#ifdef PROBE_SEL
            {
                const int sel = PROBE_SEL; bool hit = false;
                if (sel == 2) hit = (st == 0 || st == 4 || st == 5 || st == 7 || st == 10 || st == 12 || st == 13);
                if (sel == 3) hit = (st == 2 || st == 3);
                if (sel == 4) hit = (st == 8 || st == 9);
                if (sel == 5) hit = (st == 6 || st == 11 || st == 14);
                if (sel == 6) hit = (st == 1);
                if (sel == 7) hit = (st == 0);
                if (sel == 8) hit = (st == 12);
                if (sel == 9) hit = (st == 13);
                if (bx == 0 && hit) { volatile LAS unsigned long long* a_ = (volatile LAS unsigned long long*)(lds + LDS_MISC + 64); __hip_atomic_fetch_add((LAS unsigned long long*)a_, __builtin_amdgcn_s_memrealtime() - a_[1], __ATOMIC_RELAXED, __HIP_MEMORY_SCOPE_WORKGROUP); }
            }
#endif
        }
#ifdef PROBE_SEL
        if (bx == 0) { volatile LAS unsigned long long* a_ = (volatile LAS unsigned long long*)(lds + LDS_MISC + 64); a_[2] = __builtin_amdgcn_s_memrealtime(); }
#endif
        if (ph + 1 < p.ph_hi) { if ((ph - 1) % PH_PER_LAYER == 8) { __threadfence(); __syncthreads(); } else xcd_barrier(xbar); }
#ifdef PROBE_SEL
        if (PROBE_SEL == 1 && bx == 0) { volatile LAS unsigned long long* a_ = (volatile LAS unsigned long long*)(lds + LDS_MISC + 64); __hip_atomic_fetch_add((LAS unsigned long long*)a_, __builtin_amdgcn_s_memrealtime() - a_[2], __ATOMIC_RELAXED, __HIP_MEMORY_SCOPE_WORKGROUP); }
#endif
    }
#ifdef PROBE_SEL
    __syncthreads();
    if (blockIdx.x == 0) {
        volatile LAS unsigned long long* a_ = (volatile LAS unsigned long long*)((LAS unsigned char*)lds_raw + LDS_MISC + 64);
        const unsigned long long d_ = a_[0] >> 9, s_ = __builtin_amdgcn_s_memrealtime();
        while (__builtin_amdgcn_s_memrealtime() - s_ < d_) __builtin_amdgcn_s_sleep(8);
    }
#endif
}

extern "C" void kernel_launch(void* const* d_in, const int* in_sizes, int n_in, void* d_out, int out_size, void* d_ws, size_t ws_size, hipStream_t stream) {
    static int grid = 0;
    if (grid == 0) {
        if (n_in != N_IN || (size_t)out_size != O_END || ws_size < WS_END) { fprintf(stderr, "kernel_launch: unexpected shapes: n_in %d out %d ws %zu (need %zu)\n", n_in, out_size, ws_size, (size_t)WS_END); grid = -1; return; }
        int dev = 0, cus = 0, per_cu = 0;
        (void)hipGetDevice(&dev); (void)hipDeviceGetAttribute(&cus, hipDeviceAttributeMultiprocessorCount, dev);
        (void)hipFuncSetAttribute((const void*)fwd_kernel, hipFuncAttributeMaxDynamicSharedMemorySize, LDS_BYTES);
        if (hipOccupancyMaxActiveBlocksPerMultiprocessor(&per_cu, (const void*)fwd_kernel, NTHR, LDS_BYTES) != hipSuccess || per_cu < 1) { fprintf(stderr, "kernel_launch: occupancy query gave %d\n", per_cu); per_cu = 1; }
        (void)hipGetLastError();
        grid = cus * per_cu;
    }
    if (grid < 0) return;
    (void)hipMemsetAsync((char*)d_ws + WS_CTL, 0, CTL_BYTES, stream);
    Params p{};
    for (int i = 0; i < N_IN; ++i) p.in[i] = (const float*)d_in[i];
    p.out = (float*)d_out; p.ws = (unsigned char*)d_ws;
#ifdef MULTI_LAUNCH
    for (int ph = 0; ph < N_PHASES; ++ph) { p.ph_lo = ph; p.ph_hi = ph + 1; hipLaunchKernelGGL(fwd_kernel, dim3(grid), dim3(NTHR), LDS_BYTES, stream, p); }
#else
    p.ph_lo = 0; p.ph_hi = N_PHASES;
    void* args[] = {&p};
    const hipError_t e = hipLaunchCooperativeKernel((const void*)fwd_kernel, dim3(grid), dim3(NTHR), args, LDS_BYTES, stream);
    if (e != hipSuccess) fprintf(stderr, "kernel_launch: cooperative launch failed: %s (grid %d)\n", hipGetErrorString(e), grid);
#endif
}
```

```cpp
#include <hip/hip_runtime.h>
#include <hip/hip_cooperative_groups.h>
#include <cstdio>
#include <cstdint>
namespace cg = cooperative_groups;

namespace pg8 {
#define PG8_LAS __attribute__((address_space(3)))
typedef unsigned short bf16_t;
typedef short bf16x8 __attribute__((ext_vector_type(8)));
typedef float f32x4 __attribute__((ext_vector_type(4)));
typedef unsigned u32x4 __attribute__((ext_vector_type(4)));
typedef unsigned u32x2 __attribute__((ext_vector_type(2)));
constexpr int BM = 256, BK = 64, HALF = 128, HTB = HALF * BK * 2  , STAGE_BYTES = 8 * HTB, NXCD = 8, WGM = 8;

__host__ __device__ __forceinline__ int lds_byte(int r, int c) { const int st = (r >> 4) * 2 + (c >> 5), rr = r & 15, cc = c & 31, ob = rr * 64 + cc * 2; return st * 1024 + (ob ^ (((ob >> 9) & 1) << 5)); }
__host__ __device__ __forceinline__ void stage_rc(int b, int& R, int& C) { const int st = b / 1024, sb = b % 1024, swz = sb ^ (((sb >> 9) & 1) << 5); R = (st >> 1) * 16 + swz / 64; C = (st & 1) * 32 + (swz % 64) / 2; }
__host__ __device__ __forceinline__ int perm32(int rho) { const int n = rho >> 4, i = rho & 15; return 8 * (i >> 2) + 4 * n + (i & 3); }

struct Unit { int pm, pn; const char* a; const char* b; };
struct Gemm { int K, lda, ldb; };

struct TileOrder {
    int nM, nN, G, c, lda, ldb; const char* A; const char* B;
    __device__ void init(const void* A_, int lda_, const void* B_, int ldb_, int, int nM_, int nN_, int G_, int c_) {
        A = (const char*)A_; B = (const char*)B_; lda = lda_; ldb = ldb_; nM = nM_; nN = nN_; G = G_; c = c_; }
    __device__ bool next(int i, Unit& u) const {
        const int nwg = nM * nN; const long L = (long)i * G + c; if (L >= nwg) return false;
        int wgid = (int)L; { const int q = nwg / NXCD, r = nwg % NXCD, xcd = wgid % NXCD, off = wgid / NXCD; wgid = (xcd < r ? xcd * (q + 1) : r * (q + 1) + (xcd - r) * q) + off; }
        const int nig = WGM * nN, gid = wgid / nig, fm = gid * WGM, gsz = (nM - fm) < WGM ? (nM - fm) : WGM;
        u.pm = fm + ((wgid % nig) % gsz); u.pn = (wgid % nig) / gsz; u.a = A + (size_t)u.pm * ((size_t)BM * 2 * lda); u.b = B + (size_t)u.pn * ((size_t)BM * 2 * ldb); return true;
    }
    __device__ __forceinline__ void a_ready(const Unit&) const {}
    __device__ __forceinline__ void done(const Unit&) const {}
};

__device__ __forceinline__ int tid_() { int t = threadIdx.x; asm volatile("" : "+v"(t)); return t; }
__device__ __forceinline__ unsigned cvt_pk_bf16(float lo, float hi) { unsigned r; asm volatile("v_cvt_pk_bf16_f32 %0, %1, %2" : "=v"(r) : "v"(lo), "v"(hi)); return r; }

template <class Epi, class Sched, bool ALIGN_EPI = false, bool SP2 = false>
__device__ __forceinline__ void gemm_phase(PG8_LAS unsigned char* lds, const Gemm g, const Sched& S, const Epi& E) {
    const int tid = pg8::tid_(), wid = __builtin_amdgcn_readfirstlane(tid >> 6), lane = tid & 63, wr = wid >> 2, wc = wid & 3, fr = lane & 15, fq = lane >> 4;
    const int K = g.K, nt = K / BK;
    unsigned voffA, voffB;
    { int R, C; stage_rc(tid * 16, R, C); const int Rb = Epi::PERM ? ((R & ~31) + perm32(R & 31)) : R;
        voffA = (unsigned)(R * g.lda + C) * 2u; voffB = (unsigned)(Rb * g.ldb + C) * 2u; }
    const size_t qstepA = (size_t)64 * g.lda * 2, qstepB = (size_t)64 * g.ldb * 2;
    const size_t kstep = (size_t)(BK * 2);
    const size_t hstepA = (size_t)HALF * g.lda * 2, hstepB = (size_t)HALF * g.ldb * 2;
    const unsigned ldsw = (unsigned)wid * 1024u;
    const int aoff = lds_byte(wr * 64 + fr, fq * 8), boff = lds_byte(wc * 32 + fr, fq * 8);
#define PG8_SA(b, h) (((b) * 2 + (h)) * HTB)
#define PG8_SB(b, h) ((4 + (b) * 2 + (h)) * HTB)
#define PG8_STAGE(bufoff, gbase, voff) do { _Pragma("unroll") for (int _i = 0; _i < 2; ++_i) { const char* sb_ = (const char*)(gbase) + (size_t)_i * q##voff; asm volatile("" : "+s"(sb_));   \
        __builtin_amdgcn_global_load_lds((const unsigned*)(sb_ + (voff)), (PG8_LAS unsigned*)(lds + (bufoff) + ldsw + _i * 8192), 16, 0, 0); } } while (0)
#define qvoffA qstepA
#define qvoffB qstepB
#define PG8_LDA(dst, b, h) do { _Pragma("unroll") for (int m = 0; m < 4; ++m) _Pragma("unroll") for (int k = 0; k < 2; ++k) dst[m][k] = *(const PG8_LAS bf16x8*)(lds + PG8_SA(b, h) + aoff + m * 2048 + k * 1024); } while (0)
#define PG8_LDB(dst, b, h) do { _Pragma("unroll") for (int n = 0; n < 2; ++n) _Pragma("unroll") for (int k = 0; k < 2; ++k) dst[n][k] = *(const PG8_LAS bf16x8*)(lds + PG8_SB(b, h) + boff + n * 2048 + k * 1024); } while (0)
#define PG8_MMA(ai, bj, At, Bt) do { __builtin_amdgcn_s_setprio(1); _Pragma("unroll") for (int m = 0; m < 4; ++m) _Pragma("unroll") for (int n = 0; n < 2; ++n) _Pragma("unroll") for (int k = 0; k < 2; ++k) \
        acc[ai][bj][m][n] = __builtin_amdgcn_mfma_f32_16x16x32_bf16(Bt[n][k], At[m][k], acc[ai][bj][m][n], 0, 0, 0); __builtin_amdgcn_s_setprio(0); } while (0)
#define PG8_WAIT_V(n) asm volatile("s_waitcnt vmcnt(" #n ")" ::: "memory")
#define PG8_WAIT_L(n) asm volatile("s_waitcnt lgkmcnt(" #n ")" ::: "memory")
#define PG8_BAR __builtin_amdgcn_s_barrier()
#define PG8_SCHED __builtin_amdgcn_sched_barrier(0)
    Unit cur, nxt; int ui = 0;
    if (!S.next(0, cur)) return;
    f32x4 acc[2][2][4][2];
#pragma unroll
    for (int a = 0; a < 2; ++a)
#pragma unroll
        for (int b = 0; b < 2; ++b)
#pragma unroll
            for (int m = 0; m < 4; ++m)
#pragma unroll
                for (int n = 0; n < 2; ++n) acc[a][b][m][n] = (f32x4){0.f, 0.f, 0.f, 0.f};
    bf16x8 At[4][2], B0[2][2], B1[2][2];
    const char* cA = cur.a; const char* cB = cur.b;
    S.a_ready(cur);
    if constexpr (SP2) {
        PG8_STAGE(PG8_SB(0, 0), cB, voffB); PG8_STAGE(PG8_SB(0, 1), cB + hstepB, voffB); PG8_STAGE(PG8_SA(0, 0), cA, voffA); PG8_STAGE(PG8_SA(0, 1), cA + hstepA, voffA);
        if (wr == 1) PG8_BAR;
        PG8_WAIT_V(2); PG8_BAR;
        PG8_STAGE(PG8_SB(1, 0), cB + kstep, voffB); PG8_STAGE(PG8_SA(1, 0), cA + kstep, voffA); PG8_STAGE(PG8_SB(1, 1), cB + hstepB + kstep, voffB);
        PG8_WAIT_V(6); PG8_BAR;
    } else {
        PG8_STAGE(PG8_SB(0, 0), cB, voffB); PG8_STAGE(PG8_SA(0, 0), cA, voffA); PG8_STAGE(PG8_SB(0, 1), cB + hstepB, voffB); PG8_STAGE(PG8_SA(0, 1), cA + hstepA, voffA);
        if (wr == 1) PG8_BAR;
        PG8_WAIT_V(4); PG8_BAR;
        PG8_STAGE(PG8_SB(1, 0), cB + kstep, voffB); PG8_STAGE(PG8_SA(1, 0), cA + kstep, voffA); PG8_STAGE(PG8_SB(1, 1), cB + hstepB + kstep, voffB);
        PG8_WAIT_V(6); PG8_BAR;
    }
    for (;;) {
        const bool has_next = S.next(ui + 1, nxt);
        const char* nA = has_next ? nxt.a : cA; const char* nB = has_next ? nxt.b : cB;
        for (int t = 0; t < nt; t += 2) {
            const bool last = (t == nt - 2);
            const char* a1 = cA + (size_t)(t + 1) * kstep;
            const char* a2 = last ? nA : cA + (size_t)(t + 2) * kstep; const char* b2 = last ? nB : cB + (size_t)(t + 2) * kstep;
            const char* a3 = a2 + kstep; const char* b3 = b2 + kstep;
            if (last && has_next) S.a_ready(nxt);
            if constexpr (SP2) {
            PG8_LDB(B0, 0, 0); PG8_LDB(B1, 0, 1); PG8_SCHED; PG8_LDA(At, 0, 0); PG8_STAGE(PG8_SA(1, 1), a1 + hstepA, voffA);
            PG8_WAIT_V(8); PG8_WAIT_L(0); PG8_BAR; PG8_MMA(0, 0, At, B0); PG8_MMA(0, 1, At, B1); PG8_BAR; PG8_SCHED;
            PG8_LDA(At, 0, 1); PG8_STAGE(PG8_SB(0, 0), b2, voffB); PG8_STAGE(PG8_SB(0, 1), b2 + hstepB, voffB); PG8_STAGE(PG8_SA(0, 0), a2, voffA);
            PG8_WAIT_V(8); PG8_WAIT_L(0); PG8_BAR; PG8_MMA(1, 0, At, B0); PG8_MMA(1, 1, At, B1); PG8_BAR; PG8_SCHED;
            PG8_LDB(B0, 1, 0); PG8_LDB(B1, 1, 1); PG8_SCHED; PG8_LDA(At, 1, 0); PG8_STAGE(PG8_SA(0, 1), a2 + hstepA, voffA);
            PG8_WAIT_V(8); PG8_WAIT_L(0); PG8_BAR; PG8_MMA(0, 0, At, B0); PG8_MMA(0, 1, At, B1); PG8_BAR; PG8_SCHED;
            PG8_LDA(At, 1, 1); PG8_STAGE(PG8_SB(1, 0), b3, voffB); PG8_STAGE(PG8_SB(1, 1), b3 + hstepB, voffB); PG8_STAGE(PG8_SA(1, 0), a3, voffA);
            PG8_WAIT_V(8); PG8_WAIT_L(0); PG8_BAR; PG8_MMA(1, 0, At, B0); PG8_MMA(1, 1, At, B1); PG8_BAR; PG8_SCHED;
            } else {
            PG8_LDB(B0, 0, 0); PG8_SCHED; PG8_LDA(At, 0, 0); PG8_STAGE(PG8_SA(1, 1), a1 + hstepA, voffA);
            PG8_WAIT_L(8); PG8_BAR; PG8_WAIT_L(0); PG8_MMA(0, 0, At, B0); PG8_BAR; PG8_SCHED;
            PG8_LDB(B1, 0, 1); PG8_STAGE(PG8_SB(0, 0), b2, voffB);
            PG8_BAR; PG8_WAIT_L(0); PG8_MMA(0, 1, At, B1); PG8_BAR;
            PG8_LDA(At, 0, 1); PG8_STAGE(PG8_SA(0, 0), a2, voffA);
            PG8_BAR; PG8_WAIT_L(0); PG8_MMA(1, 0, At, B0); PG8_BAR; PG8_SCHED;
            PG8_STAGE(PG8_SB(0, 1), b2 + hstepB, voffB);
            PG8_WAIT_V(6); PG8_BAR; PG8_MMA(1, 1, At, B1); PG8_BAR;
            PG8_LDB(B0, 1, 0); PG8_SCHED; PG8_LDA(At, 1, 0); PG8_STAGE(PG8_SA(0, 1), a2 + hstepA, voffA);
            PG8_WAIT_L(8); PG8_BAR; PG8_WAIT_L(0); PG8_MMA(0, 0, At, B0); PG8_BAR; PG8_SCHED;
            PG8_LDB(B1, 1, 1); PG8_STAGE(PG8_SB(1, 0), b3, voffB);
            PG8_BAR; PG8_WAIT_L(0); PG8_MMA(0, 1, At, B1); PG8_BAR;
            PG8_LDA(At, 1, 1); PG8_STAGE(PG8_SA(1, 0), a3, voffA);
            PG8_BAR; PG8_WAIT_L(0); PG8_MMA(1, 0, At, B0); PG8_BAR; PG8_SCHED;
            PG8_STAGE(PG8_SB(1, 1), b3 + hstepB, voffB);
            PG8_WAIT_V(6); PG8_BAR; PG8_MMA(1, 1, At, B1); PG8_BAR;
            }
        }
        if constexpr (ALIGN_EPI) { if (wr == 0) PG8_BAR; }
        if constexpr (!Epi::AFTER_DRAIN) { const int l2_ = tid_() & 63, fr2 = l2_ & 15, fq2 = l2_ >> 4;   E(acc, cur, wr, wc, fr2, fq2); S.done(cur); }
        if (!has_next) break;
#pragma unroll
        for (int a = 0; a < 2; ++a)
#pragma unroll
            for (int b = 0; b < 2; ++b)
#pragma unroll
                for (int m = 0; m < 4; ++m)
#pragma unroll
                    for (int n = 0; n < 2; ++n) acc[a][b][m][n] = (f32x4){0.f, 0.f, 0.f, 0.f};
        cur = nxt; cA = nA; cB = nB; ++ui;
        if constexpr (ALIGN_EPI) { if (wr == 1) PG8_BAR; }
    }
    PG8_WAIT_V(0);
    if constexpr (!ALIGN_EPI) { if (wr == 0) PG8_BAR; }
    PG8_BAR;
    if constexpr (Epi::AFTER_DRAIN) { E.fused(acc, cur, wr, wc, fr, fq, lds, wid, lane); S.done(cur); }
#undef PG8_SA
#undef PG8_SB
#undef PG8_STAGE
#undef qvoffA
#undef qvoffB
#undef PG8_LDA
#undef PG8_LDB
#undef PG8_MMA
#undef PG8_WAIT_V
#undef PG8_WAIT_L
#undef PG8_BAR
#undef PG8_SCHED
}
}

using pg8::bf16_t; using pg8::f32x4; using pg8::bf16x8; using pg8::u32x4; using pg8::u32x2;
#define DI __device__ __forceinline__
#define LAS __attribute__((address_space(3)))
typedef float f32x16 __attribute__((ext_vector_type(16)));
typedef short s16x4 __attribute__((ext_vector_type(4)));
typedef float f32x2_t __attribute__((ext_vector_type(2))); typedef __bf16 bf16x2_t __attribute__((ext_vector_type(2)));

constexpr int NTHR = 512, NWAVES = 8;
constexpr int D = 1024, NB = 8, SEQ = 2048, DEPTH = 4, DB = 16, DT = 16, PAST = 1024;
constexpr int MP = NB * SEQ, MS = DB * DT, MA = MP + MS;
constexpr int NIN = 6032, NINP = 6144;
constexpr int C_QA = 0, C_KA = 384, C_VA = 768, C_U = 1152, C_QC = 1408, C_KC = 1792, C_VC = 2176, C_GC = 2560, C_LR = 2944, C_GA = 2960, C_GB = 3984, C_GCG = 5008;
constexpr int FF = 2816, FF2 = 5632;
constexpr int GH = 4, GK = 96;
constexpr int NGU_P = NB * GH * 32, NGU_S = DB * GH, NGU = NGU_P + NGU_S;
constexpr float EPS = 1e-6f;

constexpr size_t O_YP = 0, O_YS = O_YP + (size_t)MP * D, O_KP = O_YS + (size_t)MS * D, O_VP = O_KP + (size_t)DEPTH * MP * 384, O_POOLP = O_VP + (size_t)DEPTH * MP * 384,
    O_GLAP = O_POOLP + (size_t)DEPTH * NB * 15 * 256, O_MKP = O_GLAP + (size_t)DEPTH * NB * GH * GK * GK, O_MVP = O_MKP + (size_t)DEPTH * NB * 256 * D,
    O_KS = O_MVP + (size_t)DEPTH * NB * 256 * D, O_VS = O_KS + (size_t)DEPTH * MS * 384, O_POOLS = O_VS + (size_t)DEPTH * MS * 384, O_GLAS = O_POOLS + (size_t)DEPTH * DB * 15 * 256,
    O_END = O_GLAS + (size_t)DEPTH * DB * GH * GK * GK;

enum { I_XP = 0, I_XS, I_MEM, I_CSK, I_CSV, I_SPOOL, I_SGLA, I_CMK, I_CMV, I_WIN, I_WA2, I_BA, I_GLAN, I_WPOOL, I_PSCALE, I_WBA, I_WBB, I_WBC, I_WMIX, I_MEMN, I_WXQ, I_WXK, I_WXV, I_WXO,
       I_WF1, I_WF2, I_NMIXPRE, I_NMIXPOST, I_NXPRE, I_NXPOST, I_NFPRE, I_NFPOST, N_IN };

constexpr size_t MiB = 1u << 20;
constexpr size_t SZ_WIN = (size_t)NINP * D * 2, SZ_WBA = (size_t)D * 384 * 2, SZ_WBB = (size_t)D * 256 * 2, SZ_WSQ = (size_t)D * D * 2, SZ_WKV = 2 * SZ_WSQ, SZ_WF1 = (size_t)FF2 * D * 2, SZ_WF2 = (size_t)D * FF * 2;
constexpr size_t WS_CTL = 0, CTL_BYTES = 1 * MiB, WS_TAB = CTL_BYTES - 4096;
constexpr size_t WS_WIN = WS_CTL + CTL_BYTES, WS_WBA = WS_WIN + 4 * SZ_WIN, WS_WBB = WS_WBA + 4 * SZ_WBA, WS_WBC = WS_WBB + 4 * SZ_WBB, WS_WMIX = WS_WBC + 4 * SZ_WBA,
    WS_WXQ = WS_WMIX + 4 * SZ_WSQ, WS_WXO = WS_WXQ + 4 * SZ_WSQ, WS_WKV = WS_WXO + 4 * SZ_WSQ, WS_WF1 = WS_WKV + 4 * SZ_WKV, WS_WF2 = WS_WF1 + 4 * SZ_WF1,
    WS_MN = WS_WF2 + 4 * SZ_WF2, WS_MKV = WS_MN + 4 * SZ_WKV, WS_MEMVT = WS_MKV + 8 * SZ_WKV, WS_PROJ = WS_MEMVT + 4 * SZ_WKV;
constexpr size_t SZ_ROWS = (size_t)MA * D * 2;
constexpr size_t SZ_PROJ = (size_t)MA * NINP * 2;
constexpr size_t WS_Q = WS_PROJ, WS_P = WS_Q + SZ_ROWS, WS_O = WS_P + SZ_ROWS, WS_ACT = WS_O + SZ_ROWS;
static_assert(WS_ACT + (size_t)MA * FF * 2 <= WS_PROJ + SZ_PROJ, "overlay fits");
constexpr size_t WS_H = WS_PROJ + SZ_PROJ, WS_MERGED = WS_H + SZ_ROWS, WS_Y = WS_MERGED + SZ_ROWS;
constexpr size_t WS_GKV = WS_H, WS_GSP = WS_GKV + 39 * MiB, WS_GDEC = WS_GSP + 37 * MiB;
static_assert((size_t)NGU * GK * GK * 4 <= 39 * MiB && (size_t)NGU_P * GK * GK * 4 <= 37 * MiB && WS_GDEC + (size_t)NGU * GK * 4 <= WS_Y + SZ_ROWS, "GLA overlay fits");
constexpr size_t WS_OA = WS_Y + SZ_ROWS, WS_POOLED = WS_OA + (size_t)MA * 384 * 2, WS_OC = WS_POOLED + (size_t)MA * 256 * 2, WS_BB = WS_OC + (size_t)MA * 384 * 2, WS_XB = WS_BB + (size_t)NGU * 64 * GK * 4, WS_RN = WS_XB + SZ_ROWS, WS_END = WS_RN + (size_t)MA * 4;
static_assert(WS_WIN % 256 == 0 && WS_PROJ % 256 == 0 && WS_H % 256 == 0 && WS_OA % 256 == 0 && WS_POOLED % 256 == 0 && WS_OC % 256 == 0 && WS_P % 256 == 0, "alignment");

constexpr int CW_BAR = 16384;
constexpr int LDS_GEMM = 131072, LDS_X = LDS_GEMM, LDS_X_BYTES = 12288, LDS_MISC = LDS_X + LDS_X_BYTES, LDS_BYTES = LDS_MISC + 256;

struct Params { const float* in[N_IN]; float* out; unsigned char* ws; int ph_lo, ph_hi; };
struct InTab { const float* const* t;
    __device__ __forceinline__ const float* operator[](int i) const { const unsigned long long v = (unsigned long long)t[i];
        const unsigned lo = __builtin_amdgcn_readfirstlane((unsigned)v), hi = __builtin_amdgcn_readfirstlane((unsigned)(v >> 32)); return (const float*)(((unsigned long long)hi << 32) | lo); } };
struct Ctx { InTab in; float* out; unsigned char* ws; };

DI float bflo(unsigned w) { return __uint_as_float(w << 16); }
DI float bfhi(unsigned w) { return __uint_as_float(w & 0xffff0000u); }
DI float bf2f(unsigned short v) { return __uint_as_float((unsigned)v << 16); }
DI unsigned pk2(float lo, float hi) { f32x2_t v = {lo, hi}; bf16x2_t b = __builtin_convertvector(v, bf16x2_t); return __builtin_bit_cast(unsigned, b); }
DI unsigned short f2bf(float f) { return (unsigned short)(pk2(f, 0.f) & 0xffffu); }
DI float wave_sum(float v) {
#pragma unroll
    for (int o = 1; o < 64; o <<= 1) v += __shfl_xor(v, o);
    return v;
}
DI float wave_max(float v) {
#pragma unroll
    for (int o = 1; o < 64; o <<= 1) v = fmaxf(v, __shfl_xor(v, o));
    return v;
}
DI float sigmoidf_(float x) { return __builtin_amdgcn_rcpf(1.f + __expf(-x)); }
DI float softplusf_(float z) { return fmaxf(z, 0.f) + __logf(1.f + __expf(-fabsf(z))); }
DI int next_work(unsigned* ctr, volatile LAS int* slot) {
    __syncthreads();
    if (pg8::tid_() == 0) *slot = (int)atomicAdd(ctr, 1u);
    __syncthreads();
    return *slot;
}

typedef const pg8::f32x4 (&AccRef)[2][2][4][2];
struct EpiBf16 {
    static constexpr bool PERM = true, AFTER_DRAIN = false;
    bf16_t* O; int ldc; int pnmask;
    DI void operator()(AccRef acc, const pg8::Unit& u, int wr, int wc, int fr, int fq) const {
#pragma unroll
        for (int ai = 0; ai < 2; ++ai)
#pragma unroll
            for (int m = 0; m < 4; ++m) {
                bf16_t* rowp = O + (size_t)(u.pm * 256 + ai * 128 + wr * 64 + m * 16 + fr) * ldc + (u.pn & pnmask) * 256 + wc * 32 + 8 * fq;
#pragma unroll
                for (int bj = 0; bj < 2; ++bj) {
                    const f32x4 v0 = acc[ai][bj][m][0], v1 = acc[ai][bj][m][1];
                    u32x4 w; w.x = pk2(v0[0], v0[1]); w.y = pk2(v0[2], v0[3]); w.z = pk2(v1[0], v1[1]); w.w = pk2(v1[2], v1[3]);
                    *(u32x4*)(rowp + bj * 128) = w;
                }
            }
    }
};
struct EpiGate {
    static constexpr bool PERM = true, AFTER_DRAIN = false;
    bf16_t* merged; const bf16_t* proj; int goff; int accum;
    DI void operator()(AccRef acc, const pg8::Unit& u, int wr, int wc, int fr, int fq) const {
#pragma unroll
        for (int ai = 0; ai < 2; ++ai)
#pragma unroll
            for (int m = 0; m < 4; ++m) {
                const int row = u.pm * 256 + ai * 128 + wr * 64 + m * 16 + fr;
                const bf16_t* gp = proj + (size_t)row * NINP + goff + u.pn * 256 + wc * 32 + 8 * fq;
                bf16_t* mp = merged + (size_t)row * D + u.pn * 256 + wc * 32 + 8 * fq;
#pragma unroll
                for (int bj = 0; bj < 2; ++bj)
#pragma unroll
                    for (int n = 0; n < 2; ++n) {
                        const u32x2 g = *(const u32x2*)(gp + bj * 128 + 4 * n);
                        u32x2 pm2 = {0u, 0u}; if (accum) pm2 = *(const u32x2*)(mp + bj * 128 + 4 * n);
                        const f32x4 v = acc[ai][bj][m][n];
                        const float r0 = sigmoidf_(bflo(g.x)) * v[0] + bflo(pm2.x), r1 = sigmoidf_(bfhi(g.x)) * v[1] + bfhi(pm2.x);
                        const float r2 = sigmoidf_(bflo(g.y)) * v[2] + bflo(pm2.y), r3 = sigmoidf_(bfhi(g.y)) * v[3] + bfhi(pm2.y);
                        u32x2 w; w.x = pk2(r0, r1); w.y = pk2(r2, r3);
                        *(u32x2*)(mp + bj * 128 + 4 * n) = w;
                        asm volatile("" ::: "memory");
                    }
            }
    }
};
struct EpiSwiglu {
    static constexpr bool PERM = true, AFTER_DRAIN = false;
    bf16_t* act;
    DI void operator()(AccRef acc, const pg8::Unit& u, int wr, int wc, int fr, int fq) const {
#pragma unroll
        for (int ai = 0; ai < 2; ++ai)
#pragma unroll
            for (int m = 0; m < 4; ++m) {
                const int row = u.pm * 256 + ai * 128 + wr * 64 + m * 16 + fr;
#pragma unroll
                for (int bj = 0; bj < 2; ++bj) {
                    const int col0 = u.pn * 256 + bj * 128 + wc * 32 + 8 * fq;
                    const f32x4 g = acc[ai][bj][m][0], up = acc[ai][bj][m][1];
                    float r[4];
#pragma unroll
                    for (int j = 0; j < 4; ++j) r[j] = g[j] * sigmoidf_(g[j]) * up[j];
                    u32x2 w; w.x = pk2(r[0], r[1]); w.y = pk2(r[2], r[3]);
                    *(u32x2*)(act + (size_t)row * FF + (col0 >> 1)) = w;
                }
            }
    }
};
struct MemKvOrder {
    int G, c; const char* A; const char* B;
    DI bool next(int i, pg8::Unit& u) const {
        const int L = i * G + c; if (L >= 256) return false;
        const int l = L >> 6, r = L & 63; u.pm = l * 8 + (r & 7); u.pn = l * 8 + (r >> 3);
        u.a = A + (size_t)u.pm * (256 * D * 2); u.b = B + (size_t)u.pn * (256 * D * 2); return true;
    }
    DI void a_ready(const pg8::Unit&) const {}
    DI void done(const pg8::Unit&) const {}
};
struct CrossOrder {
    int G, c; const char* A; const char* B; int mode;
    DI bool next(int i, pg8::Unit& u) const {
        const int L = i * G + c; if (L >= 256) return false;
        u.pm = L >> 2; u.pn = L & 3; const int b = u.pm >> 3, h = u.pn;
        u.a = A + ((size_t)u.pm * 256 * D + h * 256) * 2;
        u.b = mode == 0 ? B + ((size_t)b * 256 * 2048 + h * 256) * 2 : B + ((size_t)h * 256 * 2048 + b * 256) * 2;
        return true;
    }
    DI void a_ready(const pg8::Unit&) const {}
    DI void done(const pg8::Unit&) const {}
};
struct EpiSoftmax {
    static constexpr bool PERM = true, AFTER_DRAIN = false;
    bf16_t* P; LAS float* xs;
    DI void operator()(AccRef acc, const pg8::Unit& u, int wr, int wc, int fr, int fq) const {
        const float sc = 0.0625f * 1.4426950408889634f;
        LAS float* xm = xs; LAS float* xsum = xs + 1024;
#pragma unroll
        for (int ai = 0; ai < 2; ++ai)
#pragma unroll
            for (int m = 0; m < 4; ++m) {
                float a = -3.0e38f;
#pragma unroll
                for (int bj = 0; bj < 2; ++bj)
#pragma unroll
                    for (int n = 0; n < 2; ++n) { const f32x4 v = acc[ai][bj][m][n]; a = fmaxf(a, fmaxf(fmaxf(v[0], v[1]), fmaxf(v[2], v[3]))); }
                a = fmaxf(a, __shfl_xor(a, 16)); a = fmaxf(a, __shfl_xor(a, 32));
                if (fq == 0) xm[(ai * 128 + wr * 64 + m * 16 + fr) * 4 + wc] = a;
                asm volatile("" ::: "memory");
            }
        __syncthreads();
#pragma unroll
        for (int ai = 0; ai < 2; ++ai)
#pragma unroll
            for (int m = 0; m < 4; ++m) {
                const f32x4 t = *(LAS f32x4*)(xm + (ai * 128 + wr * 64 + m * 16 + fr) * 4); const float mx = fmaxf(fmaxf(t[0], t[1]), fmaxf(t[2], t[3])) * sc;
                float s = 0.f;
#pragma unroll
                for (int bj = 0; bj < 2; ++bj)
#pragma unroll
                    for (int n = 0; n < 2; ++n)
#pragma unroll
                        for (int j = 0; j < 4; ++j) s += __builtin_amdgcn_exp2f(acc[ai][bj][m][n][j] * sc - mx);
                s += __shfl_xor(s, 16); s += __shfl_xor(s, 32);
                if (fq == 0) xsum[(ai * 128 + wr * 64 + m * 16 + fr) * 4 + wc] = s;
                asm volatile("" ::: "memory");
            }
        __syncthreads();
#pragma unroll
        for (int ai = 0; ai < 2; ++ai)
#pragma unroll
            for (int m = 0; m < 4; ++m) {
                const f32x4 t = *(LAS f32x4*)(xm + (ai * 128 + wr * 64 + m * 16 + fr) * 4); const float mx = fmaxf(fmaxf(t[0], t[1]), fmaxf(t[2], t[3])) * sc;
                const f32x4 t2 = *(LAS f32x4*)(xsum + (ai * 128 + wr * 64 + m * 16 + fr) * 4); const float inv = __builtin_amdgcn_rcpf((t2[0] + t2[1]) + (t2[2] + t2[3]));
                bf16_t* rowp = P + (size_t)(u.pm * 256 + ai * 128 + wr * 64 + m * 16 + fr) * D + u.pn * 256 + wc * 32 + 8 * fq;
#pragma unroll
                for (int bj = 0; bj < 2; ++bj)
#pragma unroll
                    for (int n = 0; n < 2; ++n) {
                        const f32x4 v = acc[ai][bj][m][n];
                        u32x2 w; w.x = pk2(__builtin_amdgcn_exp2f(v[0] * sc - mx) * inv, __builtin_amdgcn_exp2f(v[1] * sc - mx) * inv); w.y = pk2(__builtin_amdgcn_exp2f(v[2] * sc - mx) * inv, __builtin_amdgcn_exp2f(v[3] * sc - mx) * inv);
                        *(u32x2*)(rowp + bj * 128 + 4 * n) = w;
                    }
                asm volatile("" ::: "memory");
            }
        __syncthreads();
    }
};

#define XB_TMO      128
#define XB_XCNT(j)  (256  + 64 * (j))
#define XB_XSUB(j)  (1280 + 64 * (j))
#define XB_XGEN(j)  (2304 + 64 * (j))
#define XB_TOP      3328
#define XB_TOPGEN   3392
#define XCD_BAR_WORDS 3456
#define XB_SPIN_CAP (1u << 18)

__device__ __forceinline__ unsigned xb_ld(unsigned* p)              { return __hip_atomic_load(p, __ATOMIC_RELAXED, __HIP_MEMORY_SCOPE_AGENT); }
__device__ __forceinline__ unsigned xb_add(unsigned* p, unsigned v) { return __hip_atomic_fetch_add(p, v, __ATOMIC_RELAXED, __HIP_MEMORY_SCOPE_AGENT); }
__device__ __forceinline__ unsigned xb_xcc_id() { return (unsigned)__builtin_amdgcn_s_getreg((3 << 11) | 20) & 0xFu; }
#define XB_SPIN(cond, bar) do { unsigned _sp = 0; while (cond) { __builtin_amdgcn_s_sleep(1); \
    if ((++_sp & 255u) == 0u) { if (xb_ld(&(bar)[XB_TMO])) break; if (_sp > XB_SPIN_CAP) { atomicAdd(&(bar)[XB_TMO], 1u); break; } } } } while (0)

struct XcdBarrier {
    unsigned* bar; unsigned x;
    volatile LAS unsigned* st;
};

__device__ __forceinline__ XcdBarrier xcd_barrier_post(unsigned* bar, volatile LAS unsigned* st) {
    XcdBarrier b; b.bar = bar; b.x = xb_xcc_id(); b.st = st;
    if (threadIdx.x == 0) (void)xb_add(&bar[XB_XCNT(b.x)], 1u);
    return b;
}
__device__ __forceinline__ void xcd_barrier_complete(unsigned* bar, unsigned x, unsigned& nloc, unsigned& nx) {
    const unsigned G = gridDim.x * gridDim.y * gridDim.z;
    unsigned sum, cnt, mine, sp = 0u;
    for (;;) {
        sum = 0u; cnt = 0u; mine = 0u;
#pragma unroll
        for (unsigned j = 0; j < 16; ++j) { const unsigned c = xb_ld(&bar[XB_XCNT(j)]); sum += c; cnt += (c > 0u) ? 1u : 0u; mine = (j == x) ? c : mine; }
        if (sum == G) break;
        __builtin_amdgcn_s_sleep(1);
        if ((++sp & 255u) == 0u) { if (xb_ld(&bar[XB_TMO])) break; if (sp > XB_SPIN_CAP) { atomicAdd(&bar[XB_TMO], 1u); break; } }
    }
    nloc = mine > 0u ? mine : 1u; nx = cnt > 0u ? cnt : 1u;
}

__device__ __forceinline__ void xcd_barrier(const XcdBarrier& b) {
    asm volatile("s_waitcnt vmcnt(0)" ::: "memory");
    __syncthreads();
    if (threadIdx.x == 0) {
        unsigned* bar = b.bar;
        __builtin_amdgcn_s_waitcnt(0);
        unsigned nloc = b.st[0], nx = b.st[1];
        if (nloc == 0u) { xcd_barrier_complete(bar, b.x, nloc, nx); b.st[0] = nloc; b.st[1] = nx; }
        const unsigned old = xb_add(&bar[XB_XSUB(b.x)], 1u);
        const unsigned gen = old / nloc;
        if (old + 1u == (gen + 1u) * nloc) {
            __builtin_amdgcn_fence(__ATOMIC_RELEASE, "agent");
            asm volatile("s_waitcnt vmcnt(0)" ::: "memory");
            const unsigned og = xb_add(&bar[XB_TOP], 1u);
            const unsigned tg = og / nx;
            if (og + 1u == (tg + 1u) * nx) xb_add(&bar[XB_TOPGEN], 1u);
            else XB_SPIN(xb_ld(&bar[XB_TOPGEN]) == tg, bar);
            __builtin_amdgcn_fence(__ATOMIC_ACQUIRE, "agent");
            xb_add(&bar[XB_XGEN(b.x)], 1u);
            asm volatile("s_waitcnt vmcnt(0)" ::: "memory");
        } else {
            XB_SPIN(xb_ld(&bar[XB_XGEN(b.x)]) == gen, bar);
            __builtin_amdgcn_fence(__ATOMIC_ACQUIRE, "agent");
            asm volatile("s_waitcnt vmcnt(0)" ::: "memory");
        }
    }
    __syncthreads();
}


#define LDS_WAIT() asm volatile("s_waitcnt lgkmcnt(0)" ::: "memory")
DI void transpose_item(const float* W, int K, int N, int Npad, bf16_t* WT, int mode, LAS float* scr, int item, int lane, const float* gk = nullptr) {
    const int nblk = Npad / 32, kb = item / nblk, nb = item % nblk, k0 = 64 * kb, n0 = 32 * nb;
    const int nn = n0 + (lane & 31); const bool ok = nn < N;
    float tv[32];
#pragma unroll
    for (int i = 0; i < 32; ++i) tv[i] = ok ? W[(size_t)(k0 + 2 * i + (lane >> 5)) * N + nn] : 0.f;
    if (gk) {
#pragma unroll
        for (int i = 0; i < 32; ++i) tv[i] *= gk[k0 + 2 * i + (lane >> 5)];
    }
#pragma unroll
    for (int i = 0; i < 32; ++i) scr[(2 * i + (lane >> 5)) * 33 + (lane & 31)] = tv[i];
    LDS_WAIT(); asm volatile("" ::: "memory");
    const int c = lane & 7;
#pragma unroll
    for (int j = 0; j < 4; ++j) {
        const int n = (lane >> 3) + 8 * j; const LAS float* s = scr + (8 * c) * 33 + n;
        u32x4 o; o.x = pk2(s[0 * 33], s[1 * 33]); o.y = pk2(s[2 * 33], s[3 * 33]); o.z = pk2(s[4 * 33], s[5 * 33]); o.w = pk2(s[6 * 33], s[7 * 33]);
        int drow = n0 + n;
        if (mode == 1) { const int jj = drow >= FF ? drow - FF : drow, isu = drow >= FF ? 1 : 0; drow = (jj >> 2) * 8 + isu * 4 + (jj & 3); }
        *(u32x4*)(WT + (size_t)drow * K + k0 + 8 * c) = o;
    }
    LDS_WAIT(); asm volatile("" ::: "memory");
}

template <int NR> DI void norm_rows(const float* xsrc32, bf16_t* xn, float* rn, float* xdst32, const bf16_t* y, const float* gpost, size_t rstride, int lane) {
    f32x4 v[NR][4];
    if (xsrc32) {
#pragma unroll
        for (int r = 0; r < NR; ++r)
#pragma unroll
            for (int j = 0; j < 4; ++j) v[r][j] = *(const f32x4*)(xsrc32 + r * rstride + 4 * lane + 256 * j);
    } else {
        float rr[NR]; u32x2 w[NR][4];
#pragma unroll
        for (int r = 0; r < NR; ++r) { rr[r] = rn[r * (rstride / D)];
#pragma unroll
            for (int j = 0; j < 4; ++j) w[r][j] = *(const u32x2*)(xn + r * rstride + 4 * lane + 256 * j); }
#pragma unroll
        for (int r = 0; r < NR; ++r)
#pragma unroll
            for (int j = 0; j < 4; ++j) v[r][j] = (f32x4){bflo(w[r][j].x), bfhi(w[r][j].x), bflo(w[r][j].y), bfhi(w[r][j].y)} * rr[r];
    }
    if (y) {
        u32x2 yw[NR][4]; f32x4 g[4];
#pragma unroll
        for (int r = 0; r < NR; ++r)
#pragma unroll
            for (int j = 0; j < 4; ++j) yw[r][j] = *(const u32x2*)(y + r * rstride + 4 * lane + 256 * j);
#pragma unroll
        for (int j = 0; j < 4; ++j) g[j] = *(const f32x4*)(gpost + 4 * lane + 256 * j);
#pragma unroll
        for (int r = 0; r < NR; ++r) {
            f32x4 yv[4]; float ss = 0.f;
#pragma unroll
            for (int j = 0; j < 4; ++j) { yv[j] = (f32x4){bflo(yw[r][j].x), bfhi(yw[r][j].x), bflo(yw[r][j].y), bfhi(yw[r][j].y)}; ss += (yv[j][0] * yv[j][0] + yv[j][1] * yv[j][1]) + (yv[j][2] * yv[j][2] + yv[j][3] * yv[j][3]); }
            const float rs = rsqrtf(wave_sum(ss) * (1.f / D) + EPS);
#pragma unroll
            for (int j = 0; j < 4; ++j) v[r][j] = v[r][j] + yv[j] * rs * g[j];
        }
    }
#pragma unroll
    for (int r = 0; r < NR; ++r) {
        if (xdst32) {
#pragma unroll
            for (int j = 0; j < 4; ++j) *(f32x4*)(xdst32 + r * rstride + 4 * lane + 256 * j) = v[r][j];
        } else {
            float ss = 0.f;
#pragma unroll
            for (int j = 0; j < 4; ++j) ss += (v[r][j][0] * v[r][j][0] + v[r][j][1] * v[r][j][1]) + (v[r][j][2] * v[r][j][2] + v[r][j][3] * v[r][j][3]);
            const float ms = wave_sum(ss) * (1.f / D) + EPS, rs = rsqrtf(ms);
#pragma unroll
            for (int j = 0; j < 4; ++j) { const f32x4 o = v[r][j] * rs; u32x2 w; w.x = pk2(o[0], o[1]); w.y = pk2(o[2], o[3]); *(u32x2*)(xn + r * rstride + 4 * lane + 256 * j) = w; }
            if (lane == 0) rn[r * (rstride / D)] = ms * rs;
        }
    }
}
DI void norm_row(const float* xsrc32, bf16_t* xn, float* rn, float* xdst32, const bf16_t* y, const float* gpost, int lane) { norm_rows<1>(xsrc32, xn, rn, xdst32, y, gpost, (size_t)D, lane); }

DI void norm_phase(const Ctx& p, const float* gpost, bool last, int G, int bx) {
    const int tid = pg8::tid_(), lane = tid & 63, wv = tid >> 6, gw = bx * NWAVES + wv, NGW = G * NWAVES;
    const bf16_t* Yb = (const bf16_t*)(p.ws + WS_Y); bf16_t* Xb = (bf16_t*)(p.ws + WS_XB); float* Rn = (float*)(p.ws + WS_RN);
    int row = gw; const size_t rst = (size_t)NGW * D;
    for (; row + 3 * NGW < MA; row += 4 * NGW) norm_rows<4>(nullptr, Xb + (size_t)row * D, Rn + row, last ? p.out + (size_t)row * D : nullptr, Yb + (size_t)row * D, gpost, rst, lane);
    for (; row < MA; row += NGW) norm_row(nullptr, Xb + (size_t)row * D, Rn + row, last ? p.out + (size_t)row * D : nullptr, Yb + (size_t)row * D, gpost, lane);
}

DI void prologue(const Params& p, LAS unsigned char* lds) {
    const int tid = pg8::tid_(), lane = tid & 63, wv = tid >> 6;
    const int gw = blockIdx.x * NWAVES + wv, NGW = gridDim.x * NWAVES;
    LAS float* scr = (LAS float*)(lds + wv * 16384);
    unsigned char* ws = p.ws;
    constexpr int I0 = 3072, I1 = 192, I2 = 512, I3 = 2816, I4 = 1408, IPL = I0 + 2 * I1 + 5 * I2 + I3 + I4;
    for (int it = gw; it < 4 * IPL; it += NGW) {
        const int l = it / IPL; int r = it % IPL;
        if (r < I0) { transpose_item(p.in[I_WIN] + (size_t)l * D * NIN, D, NIN, NINP, (bf16_t*)(ws + WS_WIN + l * SZ_WIN), 0, scr, r, lane, p.in[I_NMIXPRE] + l * D); continue; } r -= I0;
        if (r < I1) { transpose_item(p.in[I_WBA] + (size_t)l * 384 * D, 384, D, D, (bf16_t*)(ws + WS_WBA + l * SZ_WBA), 0, scr, r, lane); continue; } r -= I1;
        if (r < I1) { transpose_item(p.in[I_WBC] + (size_t)l * 384 * D, 384, D, D, (bf16_t*)(ws + WS_WBC + l * SZ_WBA), 0, scr, r, lane); continue; } r -= I1;
        if (r < I2) { transpose_item(p.in[I_WMIX] + (size_t)l * D * D, D, D, D, (bf16_t*)(ws + WS_WMIX + l * SZ_WSQ), 0, scr, r, lane); continue; } r -= I2;
        if (r < I2) { transpose_item(p.in[I_WXQ] + (size_t)l * D * D, D, D, D, (bf16_t*)(ws + WS_WXQ + l * SZ_WSQ), 0, scr, r, lane, p.in[I_NXPRE] + l * D); continue; } r -= I2;
        if (r < I2) { transpose_item(p.in[I_WXO] + (size_t)l * D * D, D, D, D, (bf16_t*)(ws + WS_WXO + l * SZ_WSQ), 0, scr, r, lane); continue; } r -= I2;
        if (r < I2) { transpose_item(p.in[I_WXK] + (size_t)l * D * D, D, D, D, (bf16_t*)(ws + WS_WKV + l * SZ_WKV), 0, scr, r, lane); continue; } r -= I2;
        if (r < I2) { transpose_item(p.in[I_WXV] + (size_t)l * D * D, D, D, D, (bf16_t*)(ws + WS_WKV + l * SZ_WKV + SZ_WSQ), 0, scr, r, lane); continue; } r -= I2;
        if (r < I3) { transpose_item(p.in[I_WF1] + (size_t)l * D * FF2, D, FF2, FF2, (bf16_t*)(ws + WS_WF1 + l * SZ_WF1), 1, scr, r, lane, p.in[I_NFPRE] + l * D); continue; } r -= I3;
        transpose_item(p.in[I_WF2] + (size_t)l * FF * D, FF, D, D, (bf16_t*)(ws + WS_WF2 + l * SZ_WF2), 0, scr, r, lane);
    }
    for (int u = blockIdx.x; u < 128; u += gridDim.x) {
        const int l = u >> 5, g = (u >> 3) & 3, nb = (u >> 2) & 1, cq = u & 3;
        LAS float* Ps = (LAS float*)(lds + 8 * 16384);
        __syncthreads();
        for (int i = tid; i < 1024; i += NTHR) Ps[i] = p.in[I_WPOOL][((size_t)(l * 4 + g) * 64 + 16 * cq) * 64 + i];
        __syncthreads();
        const int n = nb * 512 + tid;
        const float* sc = p.in[I_PSCALE] + l * 256 + g * 64; const float* wb = p.in[I_WBB] + ((size_t)l * 256 + g * 64) * D + n;
        float acc[16];
#pragma unroll
        for (int c = 0; c < 16; ++c) acc[c] = 0.f;
#pragma unroll 2
        for (int d0 = 0; d0 < 64; d0 += 8) {
            float bc[8];
#pragma unroll
            for (int j = 0; j < 8; ++j) bc[j] = sc[d0 + j] * wb[(size_t)(d0 + j) * D];
#pragma unroll
            for (int c = 0; c < 16; ++c) { const f32x4 p0 = *(const LAS f32x4*)(Ps + c * 64 + d0), p1 = *(const LAS f32x4*)(Ps + c * 64 + d0 + 4);
                acc[c] += ((p0[0] * bc[0] + p0[1] * bc[1]) + (p0[2] * bc[2] + p0[3] * bc[3])) + ((p1[0] * bc[4] + p1[1] * bc[5]) + (p1[2] * bc[6] + p1[3] * bc[7])); }
        }
        unsigned ov[16];
#pragma unroll
        for (int c = 0; c < 16; ++c) ov[c] = f2bf(acc[c]);
        bf16_t* dst = (bf16_t*)(ws + WS_WBB + l * SZ_WBB) + (size_t)n * 256 + g * 64 + 16 * cq;
        u32x4 w0, w1; w0.x = ov[0] | (ov[1] << 16); w0.y = ov[2] | (ov[3] << 16); w0.z = ov[4] | (ov[5] << 16); w0.w = ov[6] | (ov[7] << 16);
        w1.x = ov[8] | (ov[9] << 16); w1.y = ov[10] | (ov[11] << 16); w1.z = ov[12] | (ov[13] << 16); w1.w = ov[14] | (ov[15] << 16);
        *(u32x4*)dst = w0; *(u32x4*)(dst + 8) = w1;
    }
    __syncthreads();
    for (int row = gw; row < MA; row += NGW) {
        const float* src = row < MP ? p.in[I_XP] + (size_t)row * D : p.in[I_XS] + (size_t)(row - MP) * D;
        norm_row(src, (bf16_t*)(ws + WS_XB) + (size_t)row * D, (float*)(ws + WS_RN) + row, nullptr, nullptr, nullptr, lane);
    }
    for (int row = gw; row < NB * 256; row += NGW) {
        f32x4 v[4]; float ss = 0.f;
#pragma unroll
        for (int j = 0; j < 4; ++j) { v[j] = *(const f32x4*)(p.in[I_MEM] + (size_t)row * D + 4 * lane + 256 * j); ss += (v[j][0] * v[j][0] + v[j][1] * v[j][1]) + (v[j][2] * v[j][2] + v[j][3] * v[j][3]); }
        const float rs = rsqrtf(wave_sum(ss) * (1.f / D) + EPS);
        for (int l = 0; l < 4; ++l)
#pragma unroll
            for (int j = 0; j < 4; ++j) { const f32x4 g = *(const f32x4*)(p.in[I_MEMN] + l * D + 4 * lane + 256 * j); const f32x4 o = v[j] * rs * g; u32x2 w; w.x = pk2(o[0], o[1]); w.y = pk2(o[2], o[3]);
                *(u32x2*)((bf16_t*)(ws + WS_MN) + ((size_t)l * 2048 + row) * D + 4 * lane + 256 * j) = w; }
    }
}

#define MFMA32(a, b, c) __builtin_amdgcn_mfma_f32_32x32x16_bf16((a), (b), (c), 0, 0, 0)
#define MFMA16(a, b, c) __builtin_amdgcn_mfma_f32_16x16x32_bf16((a), (b), (c), 0, 0, 0)
template <bool MASKED> DI void sb_tile_weights(f32x16 (&z)[2], float& R, int jt, int tq, int hi) {
    f32x16 e[2]; float T[8];
    const int sbase = 64 * jt + 4 * hi;
#pragma unroll
    for (int kb = 0; kb < 2; ++kb)
#pragma unroll
        for (int g = 0; g < 4; ++g) {
            float fl[4];
#pragma unroll
            for (int j = 0; j < 4; ++j) {
                const int r = 4 * g + j; const bool valid = !MASKED || (sbase + 32 * kb + 8 * g + j) < tq;
                const float zz = fminf(fmaxf(z[kb][r], -240.f), 240.f);
                const float t = __builtin_amdgcn_exp2f(zz * (-0.125f * 1.4426950408889634f));
                const float be = __builtin_amdgcn_rcpf(1.f + t);
                fl[j] = valid ? t * be : 1.f; z[kb][r] = valid ? be : 0.f;
            }
            e[kb][4 * g + 3] = 1.f; e[kb][4 * g + 2] = fl[3]; e[kb][4 * g + 1] = fl[3] * fl[2]; e[kb][4 * g + 0] = e[kb][4 * g + 1] * fl[1];
            T[kb * 4 + g] = e[kb][4 * g + 0] * fl[0];
        }
    float Tp[8], X[8];
#pragma unroll
    for (int gi = 0; gi < 8; ++gi) Tp[gi] = __shfl_xor(T[gi], 32);
    X[7] = 1.f;
#pragma unroll
    for (int gi = 6; gi >= 0; --gi) X[gi] = X[gi + 1] * (T[gi + 1] * Tp[gi + 1]);
    const float total = X[0] * (T[0] * Tp[0]);
#pragma unroll
    for (int kb = 0; kb < 2; ++kb)
#pragma unroll
        for (int g = 0; g < 4; ++g) {
            const int gi = kb * 4 + g; const float off = R * X[gi] * (hi == 0 ? Tp[gi] : 1.f);
#pragma unroll
            for (int j = 0; j < 4; ++j) { const int r = 4 * g + j; z[kb][r] = z[kb][r] * (off * e[kb][r]); }
        }
    R *= total;
}

DI void sb_prompt_unit(const Ctx& p, int b, int h, int qb, LAS unsigned char* lds) {
    const bf16_t* proj = (const bf16_t*)(p.ws + WS_PROJ);
    LAS unsigned short* KS = (LAS unsigned short*)lds;
    LAS unsigned short* VT = KS + 64 * 72;
    const int tid = pg8::tid_(), lane = tid & 63, wv = tid >> 6, hi = lane >> 5, c = lane & 31;
    const int q0 = qb * 256 + wv * 32, tq = q0 + c;
    const size_t rowbase = (size_t)b * SEQ;
    bf16x8 qf[4];
    {
        const bf16_t* qp = proj + (rowbase + tq) * NINP + C_QA + h * 64 + 8 * hi;
#pragma unroll
        for (int kk = 0; kk < 4; ++kk) qf[kk] = *(const bf16x8*)(qp + 16 * kk);
    }
    f32x16 o0, o1;
#pragma unroll
    for (int i = 0; i < 16; ++i) { o0[i] = 0.f; o1[i] = 0.f; }
    float R = 1.f;
    const bf16_t* kbase = proj + rowbase * NINP + C_KA + h * 64 + 8 * wv;
    const bf16_t* vbase = proj + rowbase * NINP + C_VA + h * 64 + 8 * wv;
    int jt = 4 * qb + 3;
    u32x4 kr = *(const u32x4*)(kbase + (size_t)(64 * jt + lane) * NINP), vr = *(const u32x4*)(vbase + (size_t)(64 * jt + lane) * NINP);
    for (; jt >= 0; --jt) {
        __syncthreads();
        *(LAS u32x4*)(KS + lane * 72 + 8 * wv) = kr;
#pragma unroll
        for (int i = 0; i < 4; ++i) { const unsigned w = vr[i]; VT[(8 * wv + 2 * i) * 72 + lane] = (unsigned short)(w & 0xffffu); VT[(8 * wv + 2 * i + 1) * 72 + lane] = (unsigned short)(w >> 16); }
        __syncthreads();
        if (jt > 0) { kr = *(const u32x4*)(kbase + (size_t)(64 * (jt - 1) + lane) * NINP); vr = *(const u32x4*)(vbase + (size_t)(64 * (jt - 1) + lane) * NINP); }
        if (64 * jt < q0 + 31) {
            f32x16 z[2];
#pragma unroll
            for (int kb = 0; kb < 2; ++kb) {
                f32x16 acc;
#pragma unroll
                for (int i = 0; i < 16; ++i) acc[i] = 0.f;
#pragma unroll
                for (int kk = 0; kk < 4; ++kk) { const bf16x8 a = *(const LAS bf16x8*)(KS + (32 * kb + c) * 72 + 16 * kk + 8 * hi); acc = MFMA32(a, qf[kk], acc); }
                z[kb] = acc;
            }
            if (64 * jt + 63 < q0) sb_tile_weights<false>(z, R, jt, tq, hi); else sb_tile_weights<true>(z, R, jt, tq, hi);
#pragma unroll
            for (int kb = 0; kb < 2; ++kb)
#pragma unroll
                for (int s2 = 0; s2 < 2; ++s2) {
                    u32x4 pw; pw.x = pk2(z[kb][8 * s2 + 0], z[kb][8 * s2 + 1]); pw.y = pk2(z[kb][8 * s2 + 2], z[kb][8 * s2 + 3]); pw.z = pk2(z[kb][8 * s2 + 4], z[kb][8 * s2 + 5]); pw.w = pk2(z[kb][8 * s2 + 6], z[kb][8 * s2 + 7]);
                    const bf16x8 pb = __builtin_bit_cast(bf16x8, pw);
                    const int ko = 32 * kb + 16 * s2 + 4 * hi;
                    { const s16x4 lo = *(const LAS s16x4*)(VT + c * 72 + ko), hh = *(const LAS s16x4*)(VT + c * 72 + ko + 8);
                      const bf16x8 va = __builtin_shufflevector(lo, hh, 0, 1, 2, 3, 4, 5, 6, 7); o0 = MFMA32(va, pb, o0); }
                    { const s16x4 lo = *(const LAS s16x4*)(VT + (c + 32) * 72 + ko), hh = *(const LAS s16x4*)(VT + (c + 32) * 72 + ko + 8);
                      const bf16x8 va = __builtin_shufflevector(lo, hh, 0, 1, 2, 3, 4, 5, 6, 7); o1 = MFMA32(va, pb, o1); }
                }
        }
    }
    bf16_t* op = (bf16_t*)(p.ws + WS_OA) + (rowbase + tq) * 384 + h * 64 + 4 * hi;
#pragma unroll
    for (int g = 0; g < 4; ++g) {
        u32x2 w; w.x = pk2(o0[4 * g], o0[4 * g + 1]); w.y = pk2(o0[4 * g + 2], o0[4 * g + 3]); *(u32x2*)(op + 8 * g) = w;
        w.x = pk2(o1[4 * g], o1[4 * g + 1]); w.y = pk2(o1[4 * g + 2], o1[4 * g + 3]); *(u32x2*)(op + 32 + 8 * g) = w;
    }
}

DI void sb_sample_unit(const Ctx& p, int l, int b, int h, LAS unsigned char* lds) {
    const bf16_t* proj = (const bf16_t*)(p.ws + WS_PROJ);
    LAS float* qs = (LAS float*)lds;
    LAS float* Z = qs + 1024;
    LAS float* RED = Z + 16 * 1056;
    const int tid = pg8::tid_(), lane = tid & 63, wv = tid >> 6;
    const size_t srow = (size_t)MP + b * 16;
    for (int i = tid; i < 1024; i += NTHR) qs[i] = bf2f(proj[(srow + (i >> 6)) * NINP + C_QA + h * 64 + (i & 63)]) * 0.125f;
    __syncthreads();
    {
        float a0[16], a1[16];
#pragma unroll
        for (int i = 0; i < 16; ++i) { a0[i] = 0.f; a1[i] = 0.f; }
        const float* k0p = p.in[I_CSK] + ((((size_t)l * DB + b) * PAST + tid) * 6 + h) * 64; const float* k1p = k0p + (size_t)512 * 6 * 64;
#pragma unroll 8
        for (int d4 = 0; d4 < 16; ++d4) {
            const f32x4 ka = *(const f32x4*)(k0p + 4 * d4), kb = *(const f32x4*)(k1p + 4 * d4);
#pragma unroll
            for (int i = 0; i < 16; ++i) { const f32x4 q = *(const LAS f32x4*)(qs + i * 64 + 4 * d4);
                a0[i] += (q[0] * ka[0] + q[1] * ka[1]) + (q[2] * ka[2] + q[3] * ka[3]); a1[i] += (q[0] * kb[0] + q[1] * kb[1]) + (q[2] * kb[2] + q[3] * kb[3]); }
        }
#pragma unroll
        for (int i = 0; i < 16; ++i) { Z[i * 1056 + tid] = a0[i]; Z[i * 1056 + tid + 512] = a1[i]; }
        if (tid < 256) {
            const int i = tid >> 4, j = tid & 15; const bf16_t* kp = proj + (srow + j) * NINP + C_KA + h * 64; float s = 0.f;
            for (int d = 0; d < 64; ++d) s += qs[i * 64 + d] * bf2f(kp[d]);
            Z[i * 1056 + 1024 + j] = s;
        }
    }
    __syncthreads();
    for (int qq = 0; qq < 2; ++qq) {
        const int i = 2 * wv + qq, lim = PAST + i; LAS float* zr = Z + i * 1056;
        const int st = 17 * lane, en = (st + 17 < 1040) ? st + 17 : 1040;
        float tot = 0.f;
        for (int s = st; s < en; ++s) if (s < lim) tot -= softplusf_(zr[s]);
        float incl = tot;
#pragma unroll
        for (int o = 1; o < 64; o <<= 1) { const float t = __shfl_down(incl, o); if (lane + o < 64) incl += t; }
        float run = incl - tot;
        for (int s = en - 1; s >= st; --s) {
            const float zz = zr[s]; float w = 0.f;
            if (s < lim) { const float sp = softplusf_(zz); w = __expf(zz - sp + run); run -= sp; }
            zr[s] = w;
        }
    }
    __syncthreads();
    {
        const int d = tid & 63, g = tid >> 6;
        float o[16];
#pragma unroll
        for (int i = 0; i < 16; ++i) o[i] = 0.f;
        const float* vp = p.in[I_CSV] + (((size_t)l * DB + b) * PAST * 6 + h) * 64 + d;
        for (int s0 = 130 * g; s0 < 130 * g + 130; s0 += 26) {
            float v[26];
#pragma unroll
            for (int j = 0; j < 26; ++j) { const int s = s0 + j; v[j] = s < PAST ? vp[(size_t)s * 384] : bf2f(proj[(srow + (s - PAST)) * NINP + C_VA + h * 64 + d]); }
#pragma unroll
            for (int j = 0; j < 26; ++j)
#pragma unroll
                for (int i = 0; i < 16; ++i) o[i] += Z[i * 1056 + s0 + j] * v[j];
        }
#pragma unroll
        for (int i = 0; i < 16; ++i) RED[(g * 16 + i) * 64 + d] = o[i];
    }
    __syncthreads();
    for (int i = tid; i < 1024; i += NTHR) {
        const int qi = i >> 6, d = i & 63; float s = 0.f;
#pragma unroll
        for (int g = 0; g < 8; ++g) s += RED[(g * 16 + qi) * 64 + d];
        ((bf16_t*)(p.ws + WS_OA))[(srow + qi) * 384 + h * 64 + d] = f2bf(s);
    }
}

template <int W> DI void pool_rows(const float (&uu)[48], int t0, float* outp, bf16_t* pooled_col) {
    float s = 0.f;
#pragma unroll
    for (int i = 16 - W; i < 16; ++i) s += uu[i];
#pragma unroll
    for (int r = 0; r < 32; ++r) {
        s += uu[16 + r] - uu[16 + r - W];
        const int t = t0 + r; const float cnt = (float)((t + 1 < W) ? t + 1 : W);
        pooled_col[(size_t)r * 256] = f2bf(s / cnt - uu[16 + r]);
        if (t >= SEQ - 15) outp[(size_t)(t - (SEQ - 15)) * 256] = uu[16 + r];
    }
}
DI void pool_unit(const Ctx& p, int l, int unit) {
    const bf16_t* proj = (const bf16_t*)(p.ws + WS_PROJ); bf16_t* pooled = (bf16_t*)(p.ws + WS_POOLED);
    const int tid = pg8::tid_(), ch = tid & 255, w = 2 << (ch >> 6);
    if (unit < MP / 64) {
        const int r0 = unit * 64 + 32 * (tid >> 8), t0 = r0 & (SEQ - 1), b = r0 >> 11;
        float uu[48];
        const bf16_t* up = proj + (size_t)(r0 - 16) * NINP + C_U + ch;
#pragma unroll
        for (int i = 0; i < 48; ++i) uu[i] = (t0 - 16 + i >= 0) ? bf2f(up[(size_t)i * NINP]) : 0.f;
        float* outp = p.out + O_POOLP + ((size_t)(l * NB + b) * 15) * 256 + ch; bf16_t* pc = pooled + (size_t)r0 * 256 + ch;
        if (w == 2) pool_rows<2>(uu, t0, outp, pc); else if (w == 4) pool_rows<4>(uu, t0, outp, pc); else if (w == 8) pool_rows<8>(uu, t0, outp, pc); else pool_rows<16>(uu, t0, outp, pc);
        return;
    }
    for (int i = 0; i < 32; ++i) {
        const int row = unit * 64 + (tid >> 8) + 2 * i;
        const int rs = row - MP, b = rs >> 4, t = rs & 15; float s = 0.f;
        const bf16_t* up = proj + (size_t)row * NINP + C_U + ch; const float u0 = bf2f(up[0]);
        const float* hist = p.in[I_SPOOL] + ((size_t)(l * DB + b) * 15) * 256 + ch;
        for (int j = 0; j < w; ++j) { const int tt = t - j; s += tt >= 0 ? bf2f(*(up - (size_t)j * NINP)) : hist[(15 + tt) * 256]; }
        if (t >= 1) p.out[O_POOLS + ((size_t)(l * DB + b) * 15 + (t - 1)) * 256 + ch] = u0;
        pooled[(size_t)row * 256 + ch] = f2bf(s / (float)w - u0);
    }
}

DI void kvout_unit(const Ctx& p, int l, int unit) {
    const bf16_t* proj = (const bf16_t*)(p.ws + WS_PROJ);
#pragma unroll 4
    for (int i = pg8::tid_(); i < 64 * 96; i += NTHR) {
        const int r = i / 96, ch = i % 96, row = unit * 64 + r;
        const u32x4 w = *(const u32x4*)(proj + (size_t)row * NINP + C_KA + 8 * ch);
        const bool isv = ch >= 48; const int c = 8 * (isv ? ch - 48 : ch);
        float* dst = (row < MP) ? p.out + (isv ? O_VP : O_KP) + ((size_t)l * MP + row) * 384 + c : p.out + (isv ? O_VS : O_KS) + ((size_t)l * MS + (row - MP)) * 384 + c;
        *(f32x4*)dst = (f32x4){bflo(w.x), bfhi(w.x), bflo(w.y), bfhi(w.y)}; *(f32x4*)(dst + 4) = (f32x4){bflo(w.z), bfhi(w.z), bflo(w.w), bfhi(w.w)};
    }
}
DI void memout_unit(const Ctx& p, int unit) {
    const bf16_t* mkv = (const bf16_t*)(p.ws + WS_MKV);
    for (int i = pg8::tid_(); i < 16 * 256; i += NTHR) {
        const int r = i >> 8, ch = i & 255, row = unit * 16 + r, col = 8 * ch;
        const u32x4 w = *(const u32x4*)(mkv + (size_t)row * 2048 + col);
        float* dst = p.out + (col >= 1024 ? O_MVP : O_MKP) + (size_t)row * D + (col & 1023);
        *(f32x4*)dst = (f32x4){bflo(w.x), bfhi(w.x), bflo(w.y), bfhi(w.y)}; *(f32x4*)(dst + 4) = (f32x4){bflo(w.z), bfhi(w.z), bflo(w.w), bfhi(w.w)};
    }
}
DI void memvt_unit(const Ctx& p, int unit) {
    const int l = unit >> 7, nb = (unit >> 3) & 15, b = unit & 7, tid = pg8::tid_(), n = nb * 64 + (tid & 63), wv = tid >> 6;
    const bf16_t* src = (const bf16_t*)(p.ws + WS_MKV) + ((size_t)l * 2048 + b * 256) * 2048 + 1024 + n;
    bf16_t* dst = (bf16_t*)(p.ws + WS_MEMVT) + ((size_t)l * 1024 + n) * 2048 + b * 256;
    for (int c = wv; c < 32; c += 8) {
        unsigned v[8];
#pragma unroll
        for (int j = 0; j < 8; ++j) v[j] = src[(size_t)(8 * c + j) * 2048];
        u32x4 w; w.x = v[0] | (v[1] << 16); w.y = v[2] | (v[3] << 16); w.z = v[4] | (v[5] << 16); w.w = v[6] | (v[7] << 16);
        *(u32x4*)(dst + 8 * c) = w;
    }
}

DI void gla_decay(const Ctx& p, int l, int h, size_t row0, int ntok, LAS unsigned char* lds) {
    const bf16_t* proj = (const bf16_t*)(p.ws + WS_PROJ);
    LAS float* Bc = (LAS float*)lds; LAS float* LR = (LAS float*)(lds + 24576); LAS float* A2 = (LAS float*)(lds + 28672); LAS float* BIA = (LAS float*)(lds + 34816); LAS float* SEG = (LAS float*)(lds + 35200);
    const int tid = pg8::tid_();
    if (tid < 128) {
        const int t = tid >> 1, hf = tid & 1; u32x4 w = {0u, 0u, 0u, 0u};
        if (t < ntok) w = *(const u32x4*)(proj + (row0 + t) * NINP + C_LR + 8 * hf);
        LAS float* d = LR + t * 16 + 8 * hf;
        d[0] = bflo(w.x); d[1] = bfhi(w.x); d[2] = bflo(w.y); d[3] = bfhi(w.y); d[4] = bflo(w.z); d[5] = bfhi(w.z); d[6] = bflo(w.w); d[7] = bfhi(w.w);
    } else if (tid < 128 + 384) {
        const int i = tid - 128, r = i / 24, c4 = i % 24;
        *(LAS f32x4*)(A2 + r * 96 + 4 * c4) = *(const f32x4*)(p.in[I_WA2] + ((size_t)l * 16 + r) * 384 + h * 96 + 4 * c4);
    }
    if (tid < 96) BIA[tid] = p.in[I_BA][l * 384 + h * 96 + tid];
    __syncthreads();
    for (int i = tid; i < 64 * 96; i += NTHR) {
        const int t = i / 96, k = i % 96; float sacc = BIA[k];
#pragma unroll
        for (int r = 0; r < 16; ++r) sacc += LR[t * 16 + r] * A2[r * 96 + k];
        Bc[i] = t < ntok ? -softplusf_(-sacc) * (1.f / 16.f) : 0.f;
    }
    __syncthreads();
    const int k = tid % 96, seg = tid / 96;
    if (tid < 384) { float run = 0.f; for (int i = 0; i < 16; ++i) { const int idx = (16 * seg + i) * 96 + k; run += Bc[idx]; Bc[idx] = run; } SEG[seg * 96 + k] = run; }
    __syncthreads();
    if (tid < 384 && seg > 0) { float off = 0.f; for (int s2 = 0; s2 < seg; ++s2) off += SEG[s2 * 96 + k]; for (int i = 0; i < 16; ++i) Bc[(16 * seg + i) * 96 + k] += off; }
    __syncthreads();
}
DI void gla_unit_rows(int gu, size_t& row0, int& ntok, int& bh, int& h) {
    if (gu < NGU_P) { bh = gu >> 5; const int c = gu & 31, b = bh >> 2; h = bh & 3; row0 = (size_t)b * SEQ + c * 64; ntok = 64; }
    else { bh = gu - NGU_P; const int b = bh >> 2; h = bh & 3; row0 = (size_t)MP + b * 16; ntok = 16; }
}
DI void gla_stage1_unit(const Ctx& p, int l, int gu, LAS unsigned char* lds) {
    const bf16_t* proj = (const bf16_t*)(p.ws + WS_PROJ);
    size_t row0; int ntok, bh, h; gla_unit_rows(gu, row0, ntok, bh, h);
    gla_decay(p, l, h, row0, ntok, lds);
    LAS float* Bc = (LAS float*)lds;
    LAS unsigned short* KT = (LAS unsigned short*)(lds + 36864);
    LAS unsigned short* VT = KT + 96 * 72;
    const int tid = pg8::tid_(), lane = tid & 63, wv = tid >> 6, fr = lane & 15, fq = lane >> 4;
    {
        float* bb = (float*)(p.ws + WS_BB) + (size_t)gu * (64 * GK);
        for (int i = tid; i < 64 * GK / 4; i += NTHR) *(f32x4*)(bb + 4 * i) = *(const LAS f32x4*)(Bc + 4 * i);
    }
    for (int task = tid; task < 768; task += NTHR) {
        const int t = task & 63, ch = task >> 6; u32x4 kw = {0u, 0u, 0u, 0u}, vw = {0u, 0u, 0u, 0u};
        if (t < ntok) { const bf16_t* rp = proj + (row0 + t) * NINP + h * 96 + 8 * ch; kw = *(const u32x4*)(rp + C_KC); vw = *(const u32x4*)(rp + C_VC); }
        const unsigned kk[4] = {kw.x, kw.y, kw.z, kw.w}, vv[4] = {vw.x, vw.y, vw.z, vw.w};
#pragma unroll
        for (int j = 0; j < 4; ++j) {
            const int k0 = 8 * ch + 2 * j;
            const float e0 = __expf(Bc[(ntok - 1) * 96 + k0] - Bc[t * 96 + k0]), e1 = __expf(Bc[(ntok - 1) * 96 + k0 + 1] - Bc[t * 96 + k0 + 1]);
            KT[k0 * 72 + t] = f2bf(bflo(kk[j]) * e0); KT[(k0 + 1) * 72 + t] = f2bf(bfhi(kk[j]) * e1);
            VT[k0 * 72 + t] = (unsigned short)(vv[j] & 0xffffu); VT[(k0 + 1) * 72 + t] = (unsigned short)(vv[j] >> 16);
        }
    }
    if (tid < 96) ((float*)(p.ws + WS_GDEC))[(size_t)gu * 96 + tid] = __expf(Bc[(ntok - 1) * 96 + tid]);
    __syncthreads();
    float* KV = (float*)(p.ws + WS_GKV) + (size_t)gu * (GK * GK);
    for (int tile = wv; tile < 36; tile += 8) {
        const int ki = tile / 6, vi = tile % 6; f32x4 acc = {0.f, 0.f, 0.f, 0.f};
#pragma unroll
        for (int ks = 0; ks < 2; ++ks) { const bf16x8 a = *(const LAS bf16x8*)(KT + (16 * ki + fr) * 72 + 32 * ks + 8 * fq), bb = *(const LAS bf16x8*)(VT + (16 * vi + fr) * 72 + 32 * ks + 8 * fq); acc = MFMA16(a, bb, acc); }
#pragma unroll
        for (int j = 0; j < 4; ++j) KV[(16 * ki + 4 * fq + j) * 96 + 16 * vi + fr] = acc[j];
    }
}
DI void gla_scan(const Ctx& p, int l) {
    const int gt = blockIdx.x * NTHR + pg8::tid_(), NT = gridDim.x * NTHR;
    const float* KV = (const float*)(p.ws + WS_GKV); const float* DEC = (const float*)(p.ws + WS_GDEC); float* SP = (float*)(p.ws + WS_GSP);
    for (int e = gt; e < 32 * GK * GK; e += NT) {
        const int bh = e / (GK * GK), kv = e % (GK * GK), k = kv / GK; float S = 0.f;
        float kvv[32], dcv[32];
#pragma unroll
        for (int c = 0; c < 32; ++c) { const size_t gu = (size_t)bh * 32 + c; kvv[c] = KV[gu * (GK * GK) + kv]; dcv[c] = DEC[gu * 96 + k]; }
#pragma unroll
        for (int c = 0; c < 32; ++c) { const size_t gu = (size_t)bh * 32 + c; SP[gu * (GK * GK) + kv] = S; S = dcv[c] * S + kvv[c]; }
        p.out[O_GLAP + ((size_t)l * 32 + bh) * (GK * GK) + kv] = S;
    }
    for (int e = gt; e < 64 * GK * GK; e += NT) {
        const int bh = e / (GK * GK), kv = e % (GK * GK), k = kv / GK; const size_t gu = (size_t)NGU_P + bh;
        const float S0 = p.in[I_SGLA][((size_t)l * 64 + bh) * (GK * GK) + kv];
        p.out[O_GLAS + ((size_t)l * 64 + bh) * (GK * GK) + kv] = DEC[gu * 96 + k] * S0 + KV[gu * (GK * GK) + kv];
    }
}
DI void gla_stage3_unit(const Ctx& p, int l, int gu, LAS unsigned char* lds) {
    const bf16_t* proj = (const bf16_t*)(p.ws + WS_PROJ);
    size_t row0; int ntok, bh, h; gla_unit_rows(gu, row0, ntok, bh, h);
    LAS float* OT = (LAS float*)lds;
    LAS unsigned short* QP = (LAS unsigned short*)(lds + 36864);
    LAS unsigned short* KP = QP + 64 * 104;
    LAS unsigned short* VT = KP + 64 * 104;
    LAS unsigned short* ST = VT + 96 * 72;
    LAS unsigned short* ATT = ST + 96 * 104;
    const int tid = pg8::tid_(), lane = tid & 63, wv = tid >> 6, fr = lane & 15, fq = lane >> 4;
    const float* Sprev = gu < NGU_P ? (const float*)(p.ws + WS_GSP) + (size_t)gu * (GK * GK) : p.in[I_SGLA] + ((size_t)l * 64 + bh) * (GK * GK);
    const float* bb = (const float*)(p.ws + WS_BB) + (size_t)gu * (64 * GK);
    __syncthreads();
    for (int task = tid; task < 768; task += NTHR) {
        const int t = task & 63, ch = task >> 6; u32x4 qw = {0u, 0u, 0u, 0u}, kw = qw, vw = qw; f32x4 b0 = {0.f, 0.f, 0.f, 0.f}, b1 = b0;
        if (t < ntok) { const bf16_t* rp = proj + (row0 + t) * NINP + h * 96 + 8 * ch; qw = *(const u32x4*)(rp + C_QC); kw = *(const u32x4*)(rp + C_KC); vw = *(const u32x4*)(rp + C_VC);
            b0 = *(const f32x4*)(bb + t * 96 + 8 * ch); b1 = *(const f32x4*)(bb + t * 96 + 8 * ch + 4); }
        const unsigned qq[4] = {qw.x, qw.y, qw.z, qw.w}, kk[4] = {kw.x, kw.y, kw.z, kw.w}, vv[4] = {vw.x, vw.y, vw.z, vw.w};
        const float be[8] = {b0[0], b0[1], b0[2], b0[3], b1[0], b1[1], b1[2], b1[3]};
        u32x4 qo, ko; unsigned qa[4], ka[4];
#pragma unroll
        for (int j = 0; j < 4; ++j) {
            const float e0 = __expf(be[2 * j]), e1 = __expf(be[2 * j + 1]), r0 = __builtin_amdgcn_rcpf(e0), r1 = __builtin_amdgcn_rcpf(e1);
            const bool ok = t < ntok;
            qa[j] = ok ? pk2(bflo(qq[j]) * 0.10206207261596575f * e0, bfhi(qq[j]) * 0.10206207261596575f * e1) : 0u;
            ka[j] = ok ? pk2(bflo(kk[j]) * r0, bfhi(kk[j]) * r1) : 0u;
            VT[(8 * ch + 2 * j) * 72 + t] = (unsigned short)(vv[j] & 0xffffu); VT[(8 * ch + 2 * j + 1) * 72 + t] = (unsigned short)(vv[j] >> 16);
        }
        qo.x = qa[0]; qo.y = qa[1]; qo.z = qa[2]; qo.w = qa[3]; ko.x = ka[0]; ko.y = ka[1]; ko.z = ka[2]; ko.w = ka[3];
        *(LAS u32x4*)(QP + t * 104 + 8 * ch) = qo; *(LAS u32x4*)(KP + t * 104 + 8 * ch) = ko;
    }
    for (int task = tid; task < 2304; task += NTHR) {
        const int k = task % 96, vc = task / 96; const f32x4 sv = *(const f32x4*)(Sprev + k * 96 + 4 * vc);
#pragma unroll
        for (int j = 0; j < 4; ++j) ST[(4 * vc + j) * 104 + k] = f2bf(sv[j]);
    }
    __syncthreads();
    for (int tile = 2 * wv; tile < 2 * wv + 2; ++tile) {
        const int ti = tile >> 2, si = tile & 3; f32x4 acc = {0.f, 0.f, 0.f, 0.f};
        if (si <= ti) {
#pragma unroll
            for (int ks = 0; ks < 3; ++ks) { const bf16x8 a = *(const LAS bf16x8*)(QP + (16 * ti + fr) * 104 + 32 * ks + 8 * fq), b2 = *(const LAS bf16x8*)(KP + (16 * si + fr) * 104 + 32 * ks + 8 * fq); acc = MFMA16(a, b2, acc); }
        }
#pragma unroll
        for (int j = 0; j < 4; ++j) { const int t = 16 * ti + 4 * fq + j, s2 = 16 * si + fr; ATT[t * 72 + s2] = f2bf(s2 <= t ? acc[j] : 0.f); }
    }
    __syncthreads();
    for (int tile = wv; tile < 24; tile += 8) {
        const int ti = tile / 6, vi = tile % 6; f32x4 acc = {0.f, 0.f, 0.f, 0.f};
#pragma unroll
        for (int ks = 0; ks < 2; ++ks) { const bf16x8 a = *(const LAS bf16x8*)(ATT + (16 * ti + fr) * 72 + 32 * ks + 8 * fq), b2 = *(const LAS bf16x8*)(VT + (16 * vi + fr) * 72 + 32 * ks + 8 * fq); acc = MFMA16(a, b2, acc); }
#pragma unroll
        for (int ks = 0; ks < 3; ++ks) { const bf16x8 a = *(const LAS bf16x8*)(QP + (16 * ti + fr) * 104 + 32 * ks + 8 * fq), b2 = *(const LAS bf16x8*)(ST + (16 * vi + fr) * 104 + 32 * ks + 8 * fq); acc = MFMA16(a, b2, acc); }
#pragma unroll
        for (int j = 0; j < 4; ++j) OT[(16 * ti + 4 * fq + j) * 96 + 16 * vi + fr] = acc[j];
    }
    __syncthreads();
    bf16_t* oc = (bf16_t*)(p.ws + WS_OC);
    const float* gn = p.in[I_GLAN] + l * 384 + h * 96; const float gn0 = gn[lane], gn1 = lane < 32 ? gn[64 + lane] : 0.f;
    float g0[8], g1[8];
#pragma unroll
    for (int tt = 0; tt < 8; ++tt) { const int t = wv * 8 + tt; g0[tt] = 0.f; g1[tt] = 0.f;
        if (t < ntok) { const bf16_t* gp = proj + (row0 + t) * NINP + C_GC + h * 96; g0[tt] = bf2f(gp[lane]); if (lane < 32) g1[tt] = bf2f(gp[64 + lane]); } }
#pragma unroll
    for (int tt = 0; tt < 8; ++tt) {
        const int t = wv * 8 + tt;
        if (t < ntok) {
            const float a0 = OT[t * 96 + lane], a1 = lane < 32 ? OT[t * 96 + 64 + lane] : 0.f;
            const float rs = rsqrtf(wave_sum(a0 * a0 + a1 * a1) * (1.f / 96.f) + EPS);
            oc[(row0 + t) * 384 + h * 96 + lane] = f2bf(a0 * rs * gn0 * g0[tt] * sigmoidf_(g0[tt]));
            if (lane < 32) oc[(row0 + t) * 384 + h * 96 + 64 + lane] = f2bf(a1 * rs * gn1 * g1[tt] * sigmoidf_(g1[tt]));
        }
    }
}

DI void cross_sample_unit(const Ctx& p, int l, int b, int h, int qh, LAS unsigned char* lds) {
    LAS float* qs = (LAS float*)lds;
    LAS float* ST = qs + 8 * 256;
    LAS float* PART = ST + 256 * 8;
    const bf16_t* Q = (const bf16_t*)(p.ws + WS_Q);
    const int tid = pg8::tid_(), lane = tid & 63, wv = tid >> 6;
    const size_t srow = (size_t)MP + b * 16 + 8 * qh;
    for (int i = tid; i < 8 * 256; i += NTHR) qs[i] = bf2f(Q[(srow + (i >> 8)) * D + h * 256 + (i & 255)]) * 0.0625f;
    __syncthreads();
    const int m = tid & 255, half = tid >> 8;
    {
        float acc[8];
#pragma unroll
        for (int i = 0; i < 8; ++i) acc[i] = 0.f;
        const float* kp = p.in[I_CMK] + ((((size_t)l * DB + b) * 256 + m) * 4 + h) * 256 + 128 * half;
#pragma unroll 16
        for (int d4 = 0; d4 < 32; ++d4) {
            const f32x4 kv = *(const f32x4*)(kp + 4 * d4);
#pragma unroll
            for (int i = 0; i < 8; ++i) { const f32x4 q = *(const LAS f32x4*)(qs + i * 256 + 128 * half + 4 * d4); acc[i] += (q[0] * kv[0] + q[1] * kv[1]) + (q[2] * kv[2] + q[3] * kv[3]); }
        }
#pragma unroll
        for (int i = 0; i < 8; ++i) PART[(half * 8 + i) * 256 + m] = acc[i];
    }
    __syncthreads();
    {
        const int i = wv; float v[4], mx = -3.0e38f;
#pragma unroll
        for (int j = 0; j < 4; ++j) { v[j] = PART[i * 256 + lane + 64 * j] + PART[(8 + i) * 256 + lane + 64 * j]; mx = fmaxf(mx, v[j]); }
        mx = wave_max(mx); float sum = 0.f;
#pragma unroll
        for (int j = 0; j < 4; ++j) { v[j] = __expf(v[j] - mx); sum += v[j]; }
        sum = wave_sum(sum); const float inv = 1.f / sum;
#pragma unroll
        for (int j = 0; j < 4; ++j) ST[(lane + 64 * j) * 8 + i] = v[j] * inv;
    }
    __syncthreads();
    {
        float acc[8];
#pragma unroll
        for (int i = 0; i < 8; ++i) acc[i] = 0.f;
        const float* vp = p.in[I_CMV] + ((((size_t)l * DB + b) * 256 + 128 * half) * 4 + h) * 256 + m;
        for (int k0 = 0; k0 < 128; k0 += 32) {
            float v[32];
#pragma unroll
            for (int j = 0; j < 32; ++j) v[j] = vp[(size_t)(k0 + j) * 1024];
#pragma unroll
            for (int j = 0; j < 32; ++j) {
                const f32x4 s0 = *(const LAS f32x4*)(ST + (128 * half + k0 + j) * 8), s1 = *(const LAS f32x4*)(ST + (128 * half + k0 + j) * 8 + 4);
                acc[0] += s0[0] * v[j]; acc[1] += s0[1] * v[j]; acc[2] += s0[2] * v[j]; acc[3] += s0[3] * v[j];
                acc[4] += s1[0] * v[j]; acc[5] += s1[1] * v[j]; acc[6] += s1[2] * v[j]; acc[7] += s1[3] * v[j];
            }
        }
#pragma unroll
        for (int i = 0; i < 8; ++i) PART[(half * 8 + i) * 256 + m] = acc[i];
    }
    __syncthreads();
    bf16_t* O = (bf16_t*)(p.ws + WS_O);
    for (int i = tid; i < 8 * 256; i += NTHR) { const int qi = i >> 8, d = i & 255; O[(srow + qi) * D + h * 256 + d] = f2bf(PART[qi * 256 + d] + PART[(8 + qi) * 256 + d]); }
}

struct SkBf16 { bf16_t* O; int ldc; DI void operator()(int row, int col, f32x4 v) const { u32x2 w; w.x = pk2(v[0], v[1]); w.y = pk2(v[2], v[3]); *(u32x2*)(O + (size_t)(MP + row) * ldc + col) = w; } };
struct SkGate { bf16_t* merged; const bf16_t* proj; int goff; int accum;
    DI void operator()(int row, int col, f32x4 v) const {
        const u32x2 g = *(const u32x2*)(proj + (size_t)(MP + row) * NINP + goff + col); bf16_t* mp = merged + (size_t)(MP + row) * D + col;
        u32x2 pm2 = {0u, 0u}; if (accum) pm2 = *(const u32x2*)mp;
        u32x2 w; w.x = pk2(sigmoidf_(bflo(g.x)) * v[0] + bflo(pm2.x), sigmoidf_(bfhi(g.x)) * v[1] + bfhi(pm2.x)); w.y = pk2(sigmoidf_(bflo(g.y)) * v[2] + bflo(pm2.y), sigmoidf_(bfhi(g.y)) * v[3] + bfhi(pm2.y));
        *(u32x2*)mp = w; } };
template <class EF> DI void skinny_gemm(const bf16_t* A, int lda, const bf16_t* Bt, int ldb, int K, int N, int G, int bx, LAS unsigned char* lds, const EF& ef) {
    const int tid = pg8::tid_(), lane = tid & 63, wv = tid >> 6, fr = lane & 15, fq = lane >> 4, nks = K >> 5, nunits = 4 * (N >> 4);
    LAS f32x4* red = (LAS f32x4*)lds;
    for (int u = bx; u < nunits; u += G) {
        const int rb = u & 3, cb = u >> 2;
        f32x4 acc[4];
#pragma unroll
        for (int i = 0; i < 4; ++i) acc[i] = (f32x4){0.f, 0.f, 0.f, 0.f};
        const bf16_t* bp = Bt + (size_t)(16 * cb + fr) * ldb + 8 * fq; const bf16_t* ap = A + (size_t)(64 * rb + fr) * lda + 8 * fq;
        for (int ks = wv; ks < nks; ks += 8) {
            const bf16x8 bb = *(const bf16x8*)(bp + 32 * ks);
            bf16x8 aa[4];
#pragma unroll
            for (int i = 0; i < 4; ++i) aa[i] = *(const bf16x8*)(ap + (size_t)(16 * i) * lda + 32 * ks);
#pragma unroll
            for (int i = 0; i < 4; ++i) acc[i] = MFMA16(bb, aa[i], acc[i]);
        }
#pragma unroll
        for (int i = 0; i < 4; ++i) red[(wv * 4 + i) * 64 + lane] = acc[i];
        __syncthreads();
        if (tid < 256) {
            const int i = tid >> 6; f32x4 s = red[i * 64 + lane];
#pragma unroll
            for (int w = 1; w < 8; ++w) s = s + red[(w * 4 + i) * 64 + lane];
            ef(64 * rb + 16 * i + fr, 16 * cb + 4 * fq, s);
        }
        __syncthreads();
    }
}

constexpr int PH_PER_LAYER = 15, N_PHASES = 1 + DEPTH * PH_PER_LAYER;
#define RUN_GEMM(EpiT, E, Aptr, lda_, Bptr, ldb_, K_, pm0_, nM_, nN_) do { const pg8::Gemm g_{(K_), (lda_), (ldb_)}; pg8::TileOrder S_; S_.init((Aptr), (lda_), (Bptr), (ldb_), (pm0_), (nM_), (nN_), G, bx); \
        pg8::gemm_phase<EpiT, pg8::TileOrder, true, true>(lds, g_, S_, (E)); } while (0)

__global__ void __launch_bounds__(NTHR, 2) fwd_kernel(Params p) {
    extern __shared__ __attribute__((aligned(16))) unsigned char lds_raw[];
#define PROJ ((bf16_t*)(ws + WS_PROJ))
#define H ((bf16_t*)(ws + WS_XB))
#define MERGED ((bf16_t*)(ws + WS_MERGED))
#define Y ((bf16_t*)(ws + WS_Y))
#define QB ((bf16_t*)(ws + WS_Q))
#define PB ((bf16_t*)(ws + WS_P))
#define OB ((bf16_t*)(ws + WS_O))
#define ACT ((bf16_t*)(ws + WS_ACT))

    {
        volatile LAS unsigned* st0 = (volatile LAS unsigned*)((LAS unsigned char*)lds_raw + LDS_MISC + 32);
        if (pg8::tid_() == 0) { st0[0] = 0u; st0[1] = 0u; st0[8] = 0u; st0[9] = 0u; }
        __syncthreads();
    }
    XcdBarrier xbar = xcd_barrier_post((unsigned*)(p.ws + WS_CTL) + CW_BAR, (volatile LAS unsigned*)((LAS unsigned char*)lds_raw + LDS_MISC + 32));
    if (p.ph_lo == 0) {
        prologue(p, (LAS unsigned char*)lds_raw);
        if (blockIdx.x == 0 && pg8::tid_() == 0) {
            const float** tab = (const float**)(p.ws + WS_TAB);
#pragma unroll
            for (int i = 0; i < N_IN; ++i) tab[i] = p.in[i];
        }
        if (p.ph_hi > 1) xcd_barrier(xbar);
        if (p.ph_hi < 0) cg::this_grid().sync();
    }
    for (int ph = p.ph_lo > 1 ? p.ph_lo : 1; ph < p.ph_hi; ++ph) {
        unsigned ldsb = (unsigned)(size_t)(LAS unsigned char*)lds_raw; asm volatile("" : "+s"(ldsb));
        LAS unsigned char* lds = (LAS unsigned char*)(size_t)ldsb;
        volatile LAS int* slot = (volatile LAS int*)(lds + LDS_MISC);
        unsigned char* ws = p.ws; asm volatile("" : "+s"(ws));
        Ctx c; c.ws = ws; c.in.t = (const float* const*)(ws + WS_TAB); c.out = p.out;
        unsigned* ctl = (unsigned*)(ws + WS_CTL);
        int G = gridDim.x, bx = blockIdx.x; asm volatile("" : "+s"(G), "+s"(bx));
        {
            const int l = (ph - 1) / PH_PER_LAYER, st = (ph - 1) % PH_PER_LAYER;
#ifdef PROBE_SEL
            if (bx == 0) { volatile LAS unsigned long long* a_ = (volatile LAS unsigned long long*)(lds + LDS_MISC + 64); a_[1] = __builtin_amdgcn_s_memrealtime(); }
#endif
            switch (st) {
            case 0: {
                EpiBf16 E{PROJ, NINP, 0xffff};
                RUN_GEMM(EpiBf16, E, H, D, ws + WS_WIN + l * SZ_WIN, D, D, 0, MA / 256, NINP / 256);
                if (l == 0) {
                    const pg8::Gemm g{D, D, D}; MemKvOrder S{G, bx, (const char*)(ws + WS_MN), (const char*)(ws + WS_WKV)};
                    EpiBf16 E2{(bf16_t*)(ws + WS_MKV), 2048, 7};
                    pg8::gemm_phase<EpiBf16, MemKvOrder, true, true>(lds, g, S, E2);
                }
            } break;
            case 1: {
                unsigned* ctr = ctl + 64 * ph;
                constexpr int U_SBP = 384, U_SBS = U_SBP + DB * 6, U_GLA = U_SBS + NGU, U_POOL = U_GLA + MA / 64, U_KV = U_POOL + MA / 64, U_MO = U_KV + 512, U_VT = U_MO + 512;
                const int U_ALL = l == 0 ? U_VT : U_KV;
                for (;;) {
                    const int u = next_work(ctr, slot); if (u >= U_ALL) break;
#ifdef PROBE_SEL
                    const int ut_ = u < DB * 6 ? 10 : (u < U_SBS ? 11 : (u < U_GLA ? 12 : 13));
                    if (bx == 0 && ut_ == PROBE_SEL) { volatile LAS unsigned long long* a_ = (volatile LAS unsigned long long*)(lds + LDS_MISC + 64); a_[3] = __builtin_amdgcn_s_memrealtime(); }
#endif
                    if (u < DB * 6) sb_sample_unit(c, l, u / 6, u % 6, lds);
                    else if (u < U_SBS) { const int v = u - DB * 6, qb = 7 - v / 48, bh = v % 48; sb_prompt_unit(c, bh / 6, bh % 6, qb, lds); }
                    else if (u < U_GLA) gla_stage1_unit(c, l, u - U_SBS, lds);
                    else if (u < U_POOL) pool_unit(c, l, u - U_GLA);
                    else if (u < U_KV) kvout_unit(c, l, u - U_POOL);
                    else if (u < U_MO) memout_unit(c, u - U_KV);
                    else memvt_unit(c, u - U_MO);
#ifdef PROBE_SEL
                    if (bx == 0 && ut_ == PROBE_SEL) { volatile LAS unsigned long long* a_ = (volatile LAS unsigned long long*)(lds + LDS_MISC + 64); __hip_atomic_fetch_add((LAS unsigned long long*)a_, __builtin_amdgcn_s_memrealtime() - a_[3], __ATOMIC_RELAXED, __HIP_MEMORY_SCOPE_WORKGROUP); }
#endif
                }
            } break;
            case 2: gla_scan(c, l); break;
            case 3: {
                unsigned* ctr = ctl + 64 * ph;
                for (;;) { const int u = next_work(ctr, slot); if (u >= NGU) break; gla_stage3_unit(c, l, u, lds); }
            } break;
            case 4: {
                EpiGate E1{MERGED, PROJ, C_GA, 0}, E2{MERGED, PROJ, C_GB, 1}, E3{MERGED, PROJ, C_GCG, 1};
                RUN_GEMM(EpiGate, E1, ws + WS_OA, 384, ws + WS_WBA + l * SZ_WBA, 384, 384, 0, MP / 256, 4);
                RUN_GEMM(EpiGate, E2, ws + WS_POOLED, 256, ws + WS_WBB + l * SZ_WBB, 256, 256, 0, MP / 256, 4);
                RUN_GEMM(EpiGate, E3, ws + WS_OC, 384, ws + WS_WBC + l * SZ_WBA, 384, 384, 0, MP / 256, 4);
                { SkGate F1{MERGED, PROJ, C_GA, 0}, F2{MERGED, PROJ, C_GB, 1}, F3{MERGED, PROJ, C_GCG, 1};
                  skinny_gemm((const bf16_t*)(ws + WS_OA) + (size_t)MP * 384, 384, (const bf16_t*)(ws + WS_WBA + l * SZ_WBA), 384, 384, D, G, bx, lds, F1);
                  skinny_gemm((const bf16_t*)(ws + WS_POOLED) + (size_t)MP * 256, 256, (const bf16_t*)(ws + WS_WBB + l * SZ_WBB), 256, 256, D, G, bx, lds, F2);
                  skinny_gemm((const bf16_t*)(ws + WS_OC) + (size_t)MP * 384, 384, (const bf16_t*)(ws + WS_WBC + l * SZ_WBA), 384, 384, D, G, bx, lds, F3); }
            } break;
            case 5: { EpiBf16 E{Y, D, 0xffff}; RUN_GEMM(EpiBf16, E, MERGED, D, ws + WS_WMIX + l * SZ_WSQ, D, D, 0, MP / 256, 4);
                SkBf16 F{Y, D}; skinny_gemm((const bf16_t*)MERGED + (size_t)MP * D, D, (const bf16_t*)(ws + WS_WMIX + l * SZ_WSQ), D, D, D, G, bx, lds, F); } break;
            case 6: norm_phase(c, c.in[I_NMIXPOST] + l * D, false, G, bx); break;
            case 7: { EpiBf16 E{QB, D, 0xffff}; RUN_GEMM(EpiBf16, E, H, D, ws + WS_WXQ + l * SZ_WSQ, D, D, 0, MP / 256, 4);
                SkBf16 F{QB, D}; skinny_gemm((const bf16_t*)H + (size_t)MP * D, D, (const bf16_t*)(ws + WS_WXQ + l * SZ_WSQ), D, D, D, G, bx, lds, F); } break;
            case 8: {
                const pg8::Gemm g{256, D, 2048}; CrossOrder S{G, bx, (const char*)QB, (const char*)(ws + WS_MKV + (size_t)l * 2 * SZ_WKV), 0};
                EpiSoftmax E{PB, (LAS float*)(lds + LDS_X)};
                pg8::gemm_phase<EpiSoftmax, CrossOrder, true, true>(lds, g, S, E);
            } break;
            case 9: {
                const pg8::Gemm g{256, D, 2048}; CrossOrder S{G, bx, (const char*)PB, (const char*)(ws + WS_MEMVT + (size_t)l * SZ_WKV), 1};
                EpiBf16 E{OB, D, 0xffff};
                pg8::gemm_phase<EpiBf16, CrossOrder, true, true>(lds, g, S, E);
                for (int u = bx; u < DB * 4 * 2; u += G) { __syncthreads(); cross_sample_unit(c, l, u >> 3, (u >> 1) & 3, u & 1, lds); }
            } break;
            case 10: { EpiBf16 E{Y, D, 0xffff}; RUN_GEMM(EpiBf16, E, OB, D, ws + WS_WXO + l * SZ_WSQ, D, D, 0, MP / 256, 4);
                SkBf16 F{Y, D}; skinny_gemm((const bf16_t*)OB + (size_t)MP * D, D, (const bf16_t*)(ws + WS_WXO + l * SZ_WSQ), D, D, D, G, bx, lds, F); } break;
            case 11: norm_phase(c, c.in[I_NXPOST] + l * D, false, G, bx); break;
            case 12: { EpiSwiglu E{ACT}; RUN_GEMM(EpiSwiglu, E, H, D, ws + WS_WF1 + l * SZ_WF1, D, D, 0, MA / 256, FF2 / 256); } break;
            case 13: { EpiBf16 E{Y, D, 0xffff}; RUN_GEMM(EpiBf16, E, ACT, FF, ws + WS_WF2 + l * SZ_WF2, FF, FF, 0, MP / 256, 4);
                SkBf16 F{Y, D}; skinny_gemm((const bf16_t*)ACT + (size_t)MP * FF, FF, (const bf16_t*)(ws + WS_WF2 + l * SZ_WF2), FF, FF, D, G, bx, lds, F); } break;
            default: norm_phase(c, c.in[I_NFPOST] + l * D, l == DEPTH - 1, G, bx); break;
            }
#ifdef PROBE_SEL
            {
                const int sel = PROBE_SEL; bool hit = false;
                if (sel == 2) hit = (st == 0 || st == 4 || st == 5 || st == 7 || st == 10 || st == 12 || st == 13);
                if (sel == 3) hit = (st == 2 || st == 3);
                if (sel == 4) hit = (st == 8 || st == 9);
                if (sel == 5) hit = (st == 6 || st == 11 || st == 14);
                if (sel == 6) hit = (st == 1);
                if (sel == 7) hit = (st == 0);
                if (sel == 8) hit = (st == 12);
                if (sel == 9) hit = (st == 13);
                if (bx == 0 && hit) { volatile LAS unsigned long long* a_ = (volatile LAS unsigned long long*)(lds + LDS_MISC + 64); __hip_atomic_fetch_add((LAS unsigned long long*)a_, __builtin_amdgcn_s_memrealtime() - a_[1], __ATOMIC_RELAXED, __HIP_MEMORY_SCOPE_WORKGROUP); }
            }
#endif
        }
#ifdef PROBE_SEL
        if (bx == 0) { volatile LAS unsigned long long* a_ = (volatile LAS unsigned long long*)(lds + LDS_MISC + 64); a_[2] = __builtin_amdgcn_s_memrealtime(); }
#endif
        if (ph + 1 < p.ph_hi) { if ((ph - 1) % PH_PER_LAYER == 8) { __threadfence(); __syncthreads(); } else xcd_barrier(xbar); }
#ifdef PROBE_SEL
        if (PROBE_SEL == 1 && bx == 0) { volatile LAS unsigned long long* a_ = (volatile LAS unsigned long long*)(lds + LDS_MISC + 64); __hip_atomic_fetch_add((LAS unsigned long long*)a_, __builtin_amdgcn_s_memrealtime() - a_[2], __ATOMIC_RELAXED, __HIP_MEMORY_SCOPE_WORKGROUP); }
#endif
    }
#ifdef PROBE_SEL
    __syncthreads();
    if (blockIdx.x == 0) {
        volatile LAS unsigned long long* a_ = (volatile LAS unsigned long long*)((LAS unsigned char*)lds_raw + LDS_MISC + 64);
        const unsigned long long d_ = a_[0] >> 9, s_ = __builtin_amdgcn_s_memrealtime();
        while (__builtin_amdgcn_s_memrealtime() - s_ < d_) __builtin_amdgcn_s_sleep(8);
    }
#endif
}

extern "C" void kernel_launch(void* const* d_in, const int* in_sizes, int n_in, void* d_out, int out_size, void* d_ws, size_t ws_size, hipStream_t stream) {
    static int grid = 0;
    if (grid == 0) {
        if (n_in != N_IN || (size_t)out_size != O_END || ws_size < WS_END) { fprintf(stderr, "kernel_launch: unexpected shapes: n_in %d out %d ws %zu (need %zu)\n", n_in, out_size, ws_size, (size_t)WS_END); grid = -1; return; }
        int dev = 0, cus = 0, per_cu = 0;
        (void)hipGetDevice(&dev); (void)hipDeviceGetAttribute(&cus, hipDeviceAttributeMultiprocessorCount, dev);
        (void)hipFuncSetAttribute((const void*)fwd_kernel, hipFuncAttributeMaxDynamicSharedMemorySize, LDS_BYTES);
        if (hipOccupancyMaxActiveBlocksPerMultiprocessor(&per_cu, (const void*)fwd_kernel, NTHR, LDS_BYTES) != hipSuccess || per_cu < 1) { fprintf(stderr, "kernel_launch: occupancy query gave %d\n", per_cu); per_cu = 1; }
        (void)hipGetLastError();
        grid = cus * per_cu;
    }
    if (grid < 0) return;
    (void)hipMemsetAsync((char*)d_ws + WS_CTL, 0, CTL_BYTES, stream);
    Params p{};
    for (int i = 0; i < N_IN; ++i) p.in[i] = (const float*)d_in[i];
    p.out = (float*)d_out; p.ws = (unsigned char*)d_ws;
#ifdef MULTI_LAUNCH
    for (int ph = 0; ph < N_PHASES; ++ph) { p.ph_lo = ph; p.ph_hi = ph + 1; hipLaunchKernelGGL(fwd_kernel, dim3(grid), dim3(NTHR), LDS_BYTES, stream, p); }
#else
    p.ph_lo = 0; p.ph_hi = N_PHASES;
    void* args[] = {&p};
    const hipError_t e = hipLaunchCooperativeKernel((const void*)fwd_kernel, dim3(grid), dim3(NTHR), args, LDS_BYTES, stream);
    if (e != hipSuccess) fprintf(stderr, "kernel_launch: cooperative launch failed: %s (grid %d)\n", hipGetErrorString(e), grid);
#endif
}
```

```cpp
#include <hip/hip_runtime.h>
#include <hip/hip_cooperative_groups.h>
#include <cstdio>
#include <cstdint>
namespace cg = cooperative_groups;

namespace pg8 {
#define PG8_LAS __attribute__((address_space(3)))
typedef unsigned short bf16_t;
typedef short bf16x8 __attribute__((ext_vector_type(8)));
typedef float f32x4 __attribute__((ext_vector_type(4)));
typedef unsigned u32x4 __attribute__((ext_vector_type(4)));
typedef unsigned u32x2 __attribute__((ext_vector_type(2)));
constexpr int BM = 256, BK = 64, HALF = 128, HTB = HALF * BK * 2  , STAGE_BYTES = 8 * HTB, NXCD = 8, WGM = 8;

__host__ __device__ __forceinline__ int lds_byte(int r, int c) { const int st = (r >> 4) * 2 + (c >> 5), rr = r & 15, cc = c & 31, ob = rr * 64 + cc * 2; return st * 1024 + (ob ^ (((ob >> 9) & 1) << 5)); }
__host__ __device__ __forceinline__ void stage_rc(int b, int& R, int& C) { const int st = b / 1024, sb = b % 1024, swz = sb ^ (((sb >> 9) & 1) << 5); R = (st >> 1) * 16 + swz / 64; C = (st & 1) * 32 + (swz % 64) / 2; }
__host__ __device__ __forceinline__ int perm32(int rho) { const int n = rho >> 4, i = rho & 15; return 8 * (i >> 2) + 4 * n + (i & 3); }

struct Unit { int pm, pn; const char* a; const char* b; };
struct Gemm { int K, lda, ldb; };

struct TileOrder {
    int nM, nN, G, c, lda, ldb; const char* A; const char* B;
    __device__ void init(const void* A_, int lda_, const void* B_, int ldb_, int, int nM_, int nN_, int G_, int c_) {
        A = (const char*)A_; B = (const char*)B_; lda = lda_; ldb = ldb_; nM = nM_; nN = nN_; G = G_; c = c_; }
    __device__ bool next(int i, Unit& u) const {
        const int nwg = nM * nN; const long L = (long)i * G + c; if (L >= nwg) return false;
        int wgid = (int)L; { const int q = nwg / NXCD, r = nwg % NXCD, xcd = wgid % NXCD, off = wgid / NXCD; wgid = (xcd < r ? xcd * (q + 1) : r * (q + 1) + (xcd - r) * q) + off; }
        const int nig = WGM * nN, gid = wgid / nig, fm = gid * WGM, gsz = (nM - fm) < WGM ? (nM - fm) : WGM;
        u.pm = fm + ((wgid % nig) % gsz); u.pn = (wgid % nig) / gsz; u.a = A + (size_t)u.pm * ((size_t)BM * 2 * lda); u.b = B + (size_t)u.pn * ((size_t)BM * 2 * ldb); return true;
    }
    __device__ __forceinline__ void a_ready(const Unit&) const {}
    __device__ __forceinline__ void done(const Unit&) const {}
};

__device__ __forceinline__ int tid_() { int t = threadIdx.x; asm volatile("" : "+v"(t)); return t; }
__device__ __forceinline__ unsigned cvt_pk_bf16(float lo, float hi) { unsigned r; asm volatile("v_cvt_pk_bf16_f32 %0, %1, %2" : "=v"(r) : "v"(lo), "v"(hi)); return r; }

template <class Epi, class Sched, bool ALIGN_EPI = false, bool SP2 = false>
__device__ __forceinline__ void gemm_phase(PG8_LAS unsigned char* lds, const Gemm g, const Sched& S, const Epi& E) {
    const int tid = pg8::tid_(), wid = __builtin_amdgcn_readfirstlane(tid >> 6), lane = tid & 63, wr = wid >> 2, wc = wid & 3, fr = lane & 15, fq = lane >> 4;
    const int K = g.K, nt = K / BK;
    unsigned voffA, voffB;
    { int R, C; stage_rc(tid * 16, R, C); const int Rb = Epi::PERM ? ((R & ~31) + perm32(R & 31)) : R;
        voffA = (unsigned)(R * g.lda + C) * 2u; voffB = (unsigned)(Rb * g.ldb + C) * 2u; }
    const size_t qstepA = (size_t)64 * g.lda * 2, qstepB = (size_t)64 * g.ldb * 2;
    const size_t kstep = (size_t)(BK * 2);
    const size_t hstepA = (size_t)HALF * g.lda * 2, hstepB = (size_t)HALF * g.ldb * 2;
    const unsigned ldsw = (unsigned)wid * 1024u;
    const int aoff = lds_byte(wr * 64 + fr, fq * 8), boff = lds_byte(wc * 32 + fr, fq * 8);
#define PG8_SA(b, h) (((b) * 2 + (h)) * HTB)
#define PG8_SB(b, h) ((4 + (b) * 2 + (h)) * HTB)
#define PG8_STAGE(bufoff, gbase, voff) do { _Pragma("unroll") for (int _i = 0; _i < 2; ++_i) { const char* sb_ = (const char*)(gbase) + (size_t)_i * q##voff; asm volatile("" : "+s"(sb_));   \
        __builtin_amdgcn_global_load_lds((const unsigned*)(sb_ + (voff)), (PG8_LAS unsigned*)(lds + (bufoff) + ldsw + _i * 8192), 16, 0, 0); } } while (0)
#define qvoffA qstepA
#define qvoffB qstepB
#define PG8_LDA(dst, b, h) do { _Pragma("unroll") for (int m = 0; m < 4; ++m) _Pragma("unroll") for (int k = 0; k < 2; ++k) dst[m][k] = *(const PG8_LAS bf16x8*)(lds + PG8_SA(b, h) + aoff + m * 2048 + k * 1024); } while (0)
#define PG8_LDB(dst, b, h) do { _Pragma("unroll") for (int n = 0; n < 2; ++n) _Pragma("unroll") for (int k = 0; k < 2; ++k) dst[n][k] = *(const PG8_LAS bf16x8*)(lds + PG8_SB(b, h) + boff + n * 2048 + k * 1024); } while (0)
#define PG8_MMA(ai, bj, At, Bt) do { __builtin_amdgcn_s_setprio(1); _Pragma("unroll") for (int m = 0; m < 4; ++m) _Pragma("unroll") for (int n = 0; n < 2; ++n) _Pragma("unroll") for (int k = 0; k < 2; ++k) \
        acc[ai][bj][m][n] = __builtin_amdgcn_mfma_f32_16x16x32_bf16(Bt[n][k], At[m][k], acc[ai][bj][m][n], 0, 0, 0); __builtin_amdgcn_s_setprio(0); } while (0)
#define PG8_WAIT_V(n) asm volatile("s_waitcnt vmcnt(" #n ")" ::: "memory")
#define PG8_WAIT_L(n) asm volatile("s_waitcnt lgkmcnt(" #n ")" ::: "memory")
#define PG8_BAR __builtin_amdgcn_s_barrier()
#define PG8_SCHED __builtin_amdgcn_sched_barrier(0)
    Unit cur, nxt; int ui = 0;
    if (!S.next(0, cur)) return;
    f32x4 acc[2][2][4][2];
#pragma unroll
    for (int a = 0; a < 2; ++a)
#pragma unroll
        for (int b = 0; b < 2; ++b)
#pragma unroll
            for (int m = 0; m < 4; ++m)
#pragma unroll
                for (int n = 0; n < 2; ++n) acc[a][b][m][n] = (f32x4){0.f, 0.f, 0.f, 0.f};
    bf16x8 At[4][2], B0[2][2], B1[2][2];
    const char* cA = cur.a; const char* cB = cur.b;
    S.a_ready(cur);
    if constexpr (SP2) {
        PG8_STAGE(PG8_SB(0, 0), cB, voffB); PG8_STAGE(PG8_SB(0, 1), cB + hstepB, voffB); PG8_STAGE(PG8_SA(0, 0), cA, voffA); PG8_STAGE(PG8_SA(0, 1), cA + hstepA, voffA);
        if (wr == 1) PG8_BAR;
        PG8_WAIT_V(2); PG8_BAR;
        PG8_STAGE(PG8_SB(1, 0), cB + kstep, voffB); PG8_STAGE(PG8_SA(1, 0), cA + kstep, voffA); PG8_STAGE(PG8_SB(1, 1), cB + hstepB + kstep, voffB);
        PG8_WAIT_V(6); PG8_BAR;
    } else {
        PG8_STAGE(PG8_SB(0, 0), cB, voffB); PG8_STAGE(PG8_SA(0, 0), cA, voffA); PG8_STAGE(PG8_SB(0, 1), cB + hstepB, voffB); PG8_STAGE(PG8_SA(0, 1), cA + hstepA, voffA);
        if (wr == 1) PG8_BAR;
        PG8_WAIT_V(4); PG8_BAR;
        PG8_STAGE(PG8_SB(1, 0), cB + kstep, voffB); PG8_STAGE(PG8_SA(1, 0), cA + kstep, voffA); PG8_STAGE(PG8_SB(1, 1), cB + hstepB + kstep, voffB);
        PG8_WAIT_V(6); PG8_BAR;
    }
    for (;;) {
        const bool has_next = S.next(ui + 1, nxt);
        const char* nA = has_next ? nxt.a : cA; const char* nB = has_next ? nxt.b : cB;
        for (int t = 0; t < nt; t += 2) {
            const bool last = (t == nt - 2);
            const char* a1 = cA + (size_t)(t + 1) * kstep;
            const char* a2 = last ? nA : cA + (size_t)(t + 2) * kstep; const char* b2 = last ? nB : cB + (size_t)(t + 2) * kstep;
            const char* a3 = a2 + kstep; const char* b3 = b2 + kstep;
            if (last && has_next) S.a_ready(nxt);
            if constexpr (SP2) {
            PG8_LDB(B0, 0, 0); PG8_LDB(B1, 0, 1); PG8_SCHED; PG8_LDA(At, 0, 0); PG8_STAGE(PG8_SA(1, 1), a1 + hstepA, voffA);
            PG8_WAIT_V(8); PG8_WAIT_L(0); PG8_BAR; PG8_MMA(0, 0, At, B0); PG8_MMA(0, 1, At, B1); PG8_BAR; PG8_SCHED;
            PG8_LDA(At, 0, 1); PG8_STAGE(PG8_SB(0, 0), b2, voffB); PG8_STAGE(PG8_SB(0, 1), b2 + hstepB, voffB); PG8_STAGE(PG8_SA(0, 0), a2, voffA);
            PG8_WAIT_V(8); PG8_WAIT_L(0); PG8_BAR; PG8_MMA(1, 0, At, B0); PG8_MMA(1, 1, At, B1); PG8_BAR; PG8_SCHED;
            PG8_LDB(B0, 1, 0); PG8_LDB(B1, 1, 1); PG8_SCHED; PG8_LDA(At, 1, 0); PG8_STAGE(PG8_SA(0, 1), a2 + hstepA, voffA);
            PG8_WAIT_V(8); PG8_WAIT_L(0); PG8_BAR; PG8_MMA(0, 0, At, B0); PG8_MMA(0, 1, At, B1); PG8_BAR; PG8_SCHED;
            PG8_LDA(At, 1, 1); PG8_STAGE(PG8_SB(1, 0), b3, voffB); PG8_STAGE(PG8_SB(1, 1), b3 + hstepB, voffB); PG8_STAGE(PG8_SA(1, 0), a3, voffA);
            PG8_WAIT_V(8); PG8_WAIT_L(0); PG8_BAR; PG8_MMA(1, 0, At, B0); PG8_MMA(1, 1, At, B1); PG8_BAR; PG8_SCHED;
            } else {
            PG8_LDB(B0, 0, 0); PG8_SCHED; PG8_LDA(At, 0, 0); PG8_STAGE(PG8_SA(1, 1), a1 + hstepA, voffA);
            PG8_WAIT_L(8); PG8_BAR; PG8_WAIT_L(0); PG8_MMA(0, 0, At, B0); PG8_BAR; PG8_SCHED;
            PG8_LDB(B1, 0, 1); PG8_STAGE(PG8_SB(0, 0), b2, voffB);
            PG8_BAR; PG8_WAIT_L(0); PG8_MMA(0, 1, At, B1); PG8_BAR;
            PG8_LDA(At, 0, 1); PG8_STAGE(PG8_SA(0, 0), a2, voffA);
            PG8_BAR; PG8_WAIT_L(0); PG8_MMA(1, 0, At, B0); PG8_BAR; PG8_SCHED;
            PG8_STAGE(PG8_SB(0, 1), b2 + hstepB, voffB);
            PG8_WAIT_V(6); PG8_BAR; PG8_MMA(1, 1, At, B1); PG8_BAR;
            PG8_LDB(B0, 1, 0); PG8_SCHED; PG8_LDA(At, 1, 0); PG8_STAGE(PG8_SA(0, 1), a2 + hstepA, voffA);
            PG8_WAIT_L(8); PG8_BAR; PG8_WAIT_L(0); PG8_MMA(0, 0, At, B0); PG8_BAR; PG8_SCHED;
            PG8_LDB(B1, 1, 1); PG8_STAGE(PG8_SB(1, 0), b3, voffB);
            PG8_BAR; PG8_WAIT_L(0); PG8_MMA(0, 1, At, B1); PG8_BAR;
            PG8_LDA(At, 1, 1); PG8_STAGE(PG8_SA(1, 0), a3, voffA);
            PG8_BAR; PG8_WAIT_L(0); PG8_MMA(1, 0, At, B0); PG8_BAR; PG8_SCHED;
            PG8_STAGE(PG8_SB(1, 1), b3 + hstepB, voffB);
            PG8_WAIT_V(6); PG8_BAR; PG8_MMA(1, 1, At, B1); PG8_BAR;
            }
        }
        if constexpr (ALIGN_EPI) { if (wr == 0) PG8_BAR; }
        if constexpr (!Epi::AFTER_DRAIN) { const int l2_ = tid_() & 63, fr2 = l2_ & 15, fq2 = l2_ >> 4;   E(acc, cur, wr, wc, fr2, fq2); S.done(cur); }
        if (!has_next) break;
#pragma unroll
        for (int a = 0; a < 2; ++a)
#pragma unroll
            for (int b = 0; b < 2; ++b)
#pragma unroll
                for (int m = 0; m < 4; ++m)
#pragma unroll
                    for (int n = 0; n < 2; ++n) acc[a][b][m][n] = (f32x4){0.f, 0.f, 0.f, 0.f};
        cur = nxt; cA = nA; cB = nB; ++ui;
        if constexpr (ALIGN_EPI) { if (wr == 1) PG8_BAR; }
    }
    PG8_WAIT_V(0);
    if constexpr (!ALIGN_EPI) { if (wr == 0) PG8_BAR; }
    PG8_BAR;
    if constexpr (Epi::AFTER_DRAIN) { E.fused(acc, cur, wr, wc, fr, fq, lds, wid, lane); S.done(cur); }
#undef PG8_SA
#undef PG8_SB
#undef PG8_STAGE
#undef qvoffA
#undef qvoffB
#undef PG8_LDA
#undef PG8_LDB
#undef PG8_MMA
#undef PG8_WAIT_V
#undef PG8_WAIT_L
#undef PG8_BAR
#undef PG8_SCHED
}
}

using pg8::bf16_t; using pg8::f32x4; using pg8::bf16x8; using pg8::u32x4; using pg8::u32x2;
#define DI __device__ __forceinline__
#define LAS __attribute__((address_space(3)))
typedef float f32x16 __attribute__((ext_vector_type(16)));
typedef short s16x4 __attribute__((ext_vector_type(4)));
typedef float f32x2_t __attribute__((ext_vector_type(2))); typedef __bf16 bf16x2_t __attribute__((ext_vector_type(2)));

constexpr int NTHR = 512, NWAVES = 8;
constexpr int D = 1024, NB = 8, SEQ = 2048, DEPTH = 4, DB = 16, DT = 16, PAST = 1024;
constexpr int MP = NB * SEQ, MS = DB * DT, MA = MP + MS;
constexpr int NIN = 6032, NINP = 6144;
constexpr int C_QA = 0, C_KA = 384, C_VA = 768, C_U = 1152, C_QC = 1408, C_KC = 1792, C_VC = 2176, C_GC = 2560, C_LR = 2944, C_GA = 2960, C_GB = 3984, C_GCG = 5008;
constexpr int FF = 2816, FF2 = 5632;
constexpr int GH = 4, GK = 96;
constexpr int NGU_P = NB * GH * 32, NGU_S = DB * GH, NGU = NGU_P + NGU_S;
constexpr float EPS = 1e-6f;

constexpr size_t O_YP = 0, O_YS = O_YP + (size_t)MP * D, O_KP = O_YS + (size_t)MS * D, O_VP = O_KP + (size_t)DEPTH * MP * 384, O_POOLP = O_VP + (size_t)DEPTH * MP * 384,
    O_GLAP = O_POOLP + (size_t)DEPTH * NB * 15 * 256, O_MKP = O_GLAP + (size_t)DEPTH * NB * GH * GK * GK, O_MVP = O_MKP + (size_t)DEPTH * NB * 256 * D,
    O_KS = O_MVP + (size_t)DEPTH * NB * 256 * D, O_VS = O_KS + (size_t)DEPTH * MS * 384, O_POOLS = O_VS + (size_t)DEPTH * MS * 384, O_GLAS = O_POOLS + (size_t)DEPTH * DB * 15 * 256,
    O_END = O_GLAS + (size_t)DEPTH * DB * GH * GK * GK;

enum { I_XP = 0, I_XS, I_MEM, I_CSK, I_CSV, I_SPOOL, I_SGLA, I_CMK, I_CMV, I_WIN, I_WA2, I_BA, I_GLAN, I_WPOOL, I_PSCALE, I_WBA, I_WBB, I_WBC, I_WMIX, I_MEMN, I_WXQ, I_WXK, I_WXV, I_WXO,
       I_WF1, I_WF2, I_NMIXPRE, I_NMIXPOST, I_NXPRE, I_NXPOST, I_NFPRE, I_NFPOST, N_IN };

constexpr size_t MiB = 1u << 20;
constexpr size_t SZ_WIN = (size_t)NINP * D * 2, SZ_WBA = (size_t)D * 384 * 2, SZ_WBB = (size_t)D * 256 * 2, SZ_WSQ = (size_t)D * D * 2, SZ_WKV = 2 * SZ_WSQ, SZ_WF1 = (size_t)FF2 * D * 2, SZ_WF2 = (size_t)D * FF * 2;
constexpr size_t WS_CTL = 0, CTL_BYTES = 1 * MiB, WS_TAB = CTL_BYTES - 4096;
constexpr size_t WS_WIN = WS_CTL + CTL_BYTES, WS_WBA = WS_WIN + 4 * SZ_WIN, WS_WBB = WS_WBA + 4 * SZ_WBA, WS_WBC = WS_WBB + 4 * SZ_WBB, WS_WMIX = WS_WBC + 4 * SZ_WBA,
    WS_WXQ = WS_WMIX + 4 * SZ_WSQ, WS_WXO = WS_WXQ + 4 * SZ_WSQ, WS_WKV = WS_WXO + 4 * SZ_WSQ, WS_WF1 = WS_WKV + 4 * SZ_WKV, WS_WF2 = WS_WF1 + 4 * SZ_WF1,
    WS_MN = WS_WF2 + 4 * SZ_WF2, WS_MKV = WS_MN + 4 * SZ_WKV, WS_MEMVT = WS_MKV + 8 * SZ_WKV, WS_PROJ = WS_MEMVT + 4 * SZ_WKV;
constexpr size_t SZ_ROWS = (size_t)MA * D * 2;
constexpr size_t SZ_PROJ = (size_t)MA * NINP * 2;
constexpr size_t WS_Q = WS_PROJ, WS_P = WS_Q + SZ_ROWS, WS_O = WS_P + SZ_ROWS, WS_ACT = WS_O + SZ_ROWS;
static_assert(WS_ACT + (size_t)MA * FF * 2 <= WS_PROJ + SZ_PROJ, "overlay fits");
constexpr size_t WS_H = WS_PROJ + SZ_PROJ, WS_MERGED = WS_H + SZ_ROWS, WS_Y = WS_MERGED + SZ_ROWS;
constexpr size_t WS_GKV = WS_H, WS_GSP = WS_GKV + 39 * MiB, WS_GDEC = WS_GSP + 37 * MiB;
static_assert((size_t)NGU * GK * GK * 4 <= 39 * MiB && (size_t)NGU_P * GK * GK * 4 <= 37 * MiB && WS_GDEC + (size_t)NGU * GK * 4 <= WS_Y + SZ_ROWS, "GLA overlay fits");
constexpr size_t WS_OA = WS_Y + SZ_ROWS, WS_POOLED = WS_OA + (size_t)MA * 384 * 2, WS_OC = WS_POOLED + (size_t)MA * 256 * 2, WS_BB = WS_OC + (size_t)MA * 384 * 2, WS_XB = WS_BB + (size_t)NGU * 64 * GK * 4, WS_RN = WS_XB + SZ_ROWS, WS_END = WS_RN + (size_t)MA * 4;
static_assert(WS_WIN % 256 == 0 && WS_PROJ % 256 == 0 && WS_H % 256 == 0 && WS_OA % 256 == 0 && WS_POOLED % 256 == 0 && WS_OC % 256 == 0 && WS_P % 256 == 0, "alignment");

constexpr int CW_BAR = 16384;
constexpr int LDS_GEMM = 131072, LDS_X = LDS_GEMM, LDS_X_BYTES = 12288, LDS_MISC = LDS_X + LDS_X_BYTES, LDS_BYTES = LDS_MISC + 256;

struct Params { const float* in[N_IN]; float* out; unsigned char* ws; int ph_lo, ph_hi; };
struct InTab { const float* const* t;
    __device__ __forceinline__ const float* operator[](int i) const { const unsigned long long v = (unsigned long long)t[i];
        const unsigned lo = __builtin_amdgcn_readfirstlane((unsigned)v), hi = __builtin_amdgcn_readfirstlane((unsigned)(v >> 32)); return (const float*)(((unsigned long long)hi << 32) | lo); } };
struct Ctx { InTab in; float* out; unsigned char* ws; };

DI float bflo(unsigned w) { return __uint_as_float(w << 16); }
DI float bfhi(unsigned w) { return __uint_as_float(w & 0xffff0000u); }
DI float bf2f(unsigned short v) { return __uint_as_float((unsigned)v << 16); }
DI unsigned pk2(float lo, float hi) { f32x2_t v = {lo, hi}; bf16x2_t b = __builtin_convertvector(v, bf16x2_t); return __builtin_bit_cast(unsigned, b); }
DI unsigned short f2bf(float f) { return (unsigned short)(pk2(f, 0.f) & 0xffffu); }
DI float wave_sum(float v) {
#pragma unroll
    for (int o = 1; o < 64; o <<= 1) v += __shfl_xor(v, o);
    return v;
}
DI float wave_max(float v) {
#pragma unroll
    for (int o = 1; o < 64; o <<= 1) v = fmaxf(v, __shfl_xor(v, o));
    return v;
}
DI float sigmoidf_(float x) { return __builtin_amdgcn_rcpf(1.f + __expf(-x)); }
DI float softplusf_(float z) { return fmaxf(z, 0.f) + __logf(1.f + __expf(-fabsf(z))); }
DI int next_work(unsigned* ctr, volatile LAS int* slot) {
    __syncthreads();
    if (pg8::tid_() == 0) *slot = (int)atomicAdd(ctr, 1u);
    __syncthreads();
    return *slot;
}

typedef const pg8::f32x4 (&AccRef)[2][2][4][2];
struct EpiBf16 {
    static constexpr bool PERM = true, AFTER_DRAIN = false;
    bf16_t* O; int ldc; int pnmask;
    DI void operator()(AccRef acc, const pg8::Unit& u, int wr, int wc, int fr, int fq) const {
#pragma unroll
        for (int ai = 0; ai < 2; ++ai)
#pragma unroll
            for (int m = 0; m < 4; ++m) {
                bf16_t* rowp = O + (size_t)(u.pm * 256 + ai * 128 + wr * 64 + m * 16 + fr) * ldc + (u.pn & pnmask) * 256 + wc * 32 + 8 * fq;
#pragma unroll
                for (int bj = 0; bj < 2; ++bj) {
                    const f32x4 v0 = acc[ai][bj][m][0], v1 = acc[ai][bj][m][1];
                    u32x4 w; w.x = pk2(v0[0], v0[1]); w.y = pk2(v0[2], v0[3]); w.z = pk2(v1[0], v1[1]); w.w = pk2(v1[2], v1[3]);
                    *(u32x4*)(rowp + bj * 128) = w;
                }
            }
    }
};
struct EpiGate {
    static constexpr bool PERM = true, AFTER_DRAIN = false;
    bf16_t* merged; const bf16_t* proj; int goff; int accum;
    DI void operator()(AccRef acc, const pg8::Unit& u, int wr, int wc, int fr, int fq) const {
#pragma unroll
        for (int ai = 0; ai < 2; ++ai)
#pragma unroll
            for (int m = 0; m < 4; ++m) {
                const int row = u.pm * 256 + ai * 128 + wr * 64 + m * 16 + fr;
                const bf16_t* gp = proj + (size_t)row * NINP + goff + u.pn * 256 + wc * 32 + 8 * fq;
                bf16_t* mp = merged + (size_t)row * D + u.pn * 256 + wc * 32 + 8 * fq;
                u32x4 g[2], pm4[2];
#pragma unroll
                for (int bj = 0; bj < 2; ++bj) { g[bj] = *(const u32x4*)(gp + bj * 128); pm4[bj] = (u32x4){0u, 0u, 0u, 0u}; if (accum) pm4[bj] = *(const u32x4*)(mp + bj * 128); }
#pragma unroll
                for (int bj = 0; bj < 2; ++bj) {
                    const f32x4 v0 = acc[ai][bj][m][0], v1 = acc[ai][bj][m][1];
                    u32x4 w;
                    w.x = pk2(sigmoidf_(bflo(g[bj].x)) * v0[0] + bflo(pm4[bj].x), sigmoidf_(bfhi(g[bj].x)) * v0[1] + bfhi(pm4[bj].x));
                    w.y = pk2(sigmoidf_(bflo(g[bj].y)) * v0[2] + bflo(pm4[bj].y), sigmoidf_(bfhi(g[bj].y)) * v0[3] + bfhi(pm4[bj].y));
                    w.z = pk2(sigmoidf_(bflo(g[bj].z)) * v1[0] + bflo(pm4[bj].z), sigmoidf_(bfhi(g[bj].z)) * v1[1] + bfhi(pm4[bj].z));
                    w.w = pk2(sigmoidf_(bflo(g[bj].w)) * v1[2] + bflo(pm4[bj].w), sigmoidf_(bfhi(g[bj].w)) * v1[3] + bfhi(pm4[bj].w));
                    *(u32x4*)(mp + bj * 128) = w;
                }
                if (m & 1) asm volatile("" ::: "memory");
            }
    }
};
struct EpiSwiglu {
    static constexpr bool PERM = true, AFTER_DRAIN = false;
    bf16_t* act;
    DI void operator()(AccRef acc, const pg8::Unit& u, int wr, int wc, int fr, int fq) const {
#pragma unroll
        for (int ai = 0; ai < 2; ++ai)
#pragma unroll
            for (int m = 0; m < 4; ++m) {
                const int row = u.pm * 256 + ai * 128 + wr * 64 + m * 16 + fr;
#pragma unroll
                for (int bj = 0; bj < 2; ++bj) {
                    const int col0 = u.pn * 256 + bj * 128 + wc * 32 + 8 * fq;
                    const f32x4 g = acc[ai][bj][m][0], up = acc[ai][bj][m][1];
                    float r[4];
#pragma unroll
                    for (int j = 0; j < 4; ++j) r[j] = g[j] * sigmoidf_(g[j]) * up[j];
                    u32x2 w; w.x = pk2(r[0], r[1]); w.y = pk2(r[2], r[3]);
                    *(u32x2*)(act + (size_t)row * FF + (col0 >> 1)) = w;
                }
            }
    }
};
struct MemKvOrder {
    int G, c; const char* A; const char* B;
    DI bool next(int i, pg8::Unit& u) const {
        const int L = i * G + c; if (L >= 256) return false;
        const int l = L >> 6, r = L & 63; u.pm = l * 8 + (r & 7); u.pn = l * 8 + (r >> 3);
        u.a = A + (size_t)u.pm * (256 * D * 2); u.b = B + (size_t)u.pn * (256 * D * 2); return true;
    }
    DI void a_ready(const pg8::Unit&) const {}
    DI void done(const pg8::Unit&) const {}
};
struct CrossOrder {
    int G, c; const char* A; const char* B; int mode;
    DI bool next(int i, pg8::Unit& u) const {
        const int L = i * G + c; if (L >= 256) return false;
        u.pm = L >> 2; u.pn = L & 3; const int b = u.pm >> 3, h = u.pn;
        u.a = A + ((size_t)u.pm * 256 * D + h * 256) * 2;
        u.b = mode == 0 ? B + ((size_t)b * 256 * 2048 + h * 256) * 2 : B + ((size_t)h * 256 * 2048 + b * 256) * 2;
        return true;
    }
    DI void a_ready(const pg8::Unit&) const {}
    DI void done(const pg8::Unit&) const {}
};
struct EpiSoftmax {
    static constexpr bool PERM = true, AFTER_DRAIN = false;
    bf16_t* P; LAS float* xs;
    DI void operator()(AccRef acc, const pg8::Unit& u, int wr, int wc, int fr, int fq) const {
        const float sc = 0.0625f * 1.4426950408889634f;
        LAS float* xm = xs; LAS float* xsum = xs + 1024;
#pragma unroll
        for (int ai = 0; ai < 2; ++ai)
#pragma unroll
            for (int m = 0; m < 4; ++m) {
                float a = -3.0e38f;
#pragma unroll
                for (int bj = 0; bj < 2; ++bj)
#pragma unroll
                    for (int n = 0; n < 2; ++n) { const f32x4 v = acc[ai][bj][m][n]; a = fmaxf(a, fmaxf(fmaxf(v[0], v[1]), fmaxf(v[2], v[3]))); }
                a = fmaxf(a, __shfl_xor(a, 16)); a = fmaxf(a, __shfl_xor(a, 32));
                if (fq == 0) xm[(ai * 128 + wr * 64 + m * 16 + fr) * 4 + wc] = a;
                asm volatile("" ::: "memory");
            }
        __syncthreads();
#pragma unroll
        for (int ai = 0; ai < 2; ++ai)
#pragma unroll
            for (int m = 0; m < 4; ++m) {
                const f32x4 t = *(LAS f32x4*)(xm + (ai * 128 + wr * 64 + m * 16 + fr) * 4); const float mx = fmaxf(fmaxf(t[0], t[1]), fmaxf(t[2], t[3])) * sc;
                float s = 0.f;
#pragma unroll
                for (int bj = 0; bj < 2; ++bj)
#pragma unroll
                    for (int n = 0; n < 2; ++n)
#pragma unroll
                        for (int j = 0; j < 4; ++j) s += __builtin_amdgcn_exp2f(acc[ai][bj][m][n][j] * sc - mx);
                s += __shfl_xor(s, 16); s += __shfl_xor(s, 32);
                if (fq == 0) xsum[(ai * 128 + wr * 64 + m * 16 + fr) * 4 + wc] = s;
                asm volatile("" ::: "memory");
            }
        __syncthreads();
#pragma unroll
        for (int ai = 0; ai < 2; ++ai)
#pragma unroll
            for (int m = 0; m < 4; ++m) {
                const f32x4 t = *(LAS f32x4*)(xm + (ai * 128 + wr * 64 + m * 16 + fr) * 4); const float mx = fmaxf(fmaxf(t[0], t[1]), fmaxf(t[2], t[3])) * sc;
                const f32x4 t2 = *(LAS f32x4*)(xsum + (ai * 128 + wr * 64 + m * 16 + fr) * 4); const float inv = __builtin_amdgcn_rcpf((t2[0] + t2[1]) + (t2[2] + t2[3]));
                bf16_t* rowp = P + (size_t)(u.pm * 256 + ai * 128 + wr * 64 + m * 16 + fr) * D + u.pn * 256 + wc * 32 + 8 * fq;
#pragma unroll
                for (int bj = 0; bj < 2; ++bj)
#pragma unroll
                    for (int n = 0; n < 2; ++n) {
                        const f32x4 v = acc[ai][bj][m][n];
                        u32x2 w; w.x = pk2(__builtin_amdgcn_exp2f(v[0] * sc - mx) * inv, __builtin_amdgcn_exp2f(v[1] * sc - mx) * inv); w.y = pk2(__builtin_amdgcn_exp2f(v[2] * sc - mx) * inv, __builtin_amdgcn_exp2f(v[3] * sc - mx) * inv);
                        *(u32x2*)(rowp + bj * 128 + 4 * n) = w;
                    }
                asm volatile("" ::: "memory");
            }
        __syncthreads();
    }
};

#define XB_TMO      128
#define XB_XCNT(j)  (256  + 64 * (j))
#define XB_XSUB(j)  (1280 + 64 * (j))
#define XB_XGEN(j)  (2304 + 64 * (j))
#define XB_TOP      3328
#define XB_TOPGEN   3392
#define XCD_BAR_WORDS 3456
#define XB_SPIN_CAP (1u << 18)

__device__ __forceinline__ unsigned xb_ld(unsigned* p)              { return __hip_atomic_load(p, __ATOMIC_RELAXED, __HIP_MEMORY_SCOPE_AGENT); }
__device__ __forceinline__ unsigned xb_add(unsigned* p, unsigned v) { return __hip_atomic_fetch_add(p, v, __ATOMIC_RELAXED, __HIP_MEMORY_SCOPE_AGENT); }
__device__ __forceinline__ unsigned xb_xcc_id() { return (unsigned)__builtin_amdgcn_s_getreg((3 << 11) | 20) & 0xFu; }
#define XB_SPIN(cond, bar) do { unsigned _sp = 0; while (cond) { __builtin_amdgcn_s_sleep(1); \
    if ((++_sp & 255u) == 0u) { if (xb_ld(&(bar)[XB_TMO])) break; if (_sp > XB_SPIN_CAP) { atomicAdd(&(bar)[XB_TMO], 1u); break; } } } } while (0)

struct XcdBarrier {
    unsigned* bar; unsigned x;
    volatile LAS unsigned* st;
};

__device__ __forceinline__ XcdBarrier xcd_barrier_post(unsigned* bar, volatile LAS unsigned* st) {
    XcdBarrier b; b.bar = bar; b.x = xb_xcc_id(); b.st = st;
    if (threadIdx.x == 0) (void)xb_add(&bar[XB_XCNT(b.x)], 1u);
    return b;
}
__device__ __forceinline__ void xcd_barrier_complete(unsigned* bar, unsigned x, unsigned& nloc, unsigned& nx) {
    const unsigned G = gridDim.x * gridDim.y * gridDim.z;
    unsigned sum, cnt, mine, sp = 0u;
    for (;;) {
        sum = 0u; cnt = 0u; mine = 0u;
#pragma unroll
        for (unsigned j = 0; j < 16; ++j) { const unsigned c = xb_ld(&bar[XB_XCNT(j)]); sum += c; cnt += (c > 0u) ? 1u : 0u; mine = (j == x) ? c : mine; }
        if (sum == G) break;
        __builtin_amdgcn_s_sleep(1);
        if ((++sp & 255u) == 0u) { if (xb_ld(&bar[XB_TMO])) break; if (sp > XB_SPIN_CAP) { atomicAdd(&bar[XB_TMO], 1u); break; } }
    }
    nloc = mine > 0u ? mine : 1u; nx = cnt > 0u ? cnt : 1u;
}

__device__ __forceinline__ void xcd_barrier(const XcdBarrier& b) {
    asm volatile("s_waitcnt vmcnt(0)" ::: "memory");
    __syncthreads();
    if (threadIdx.x == 0) {
        unsigned* bar = b.bar;
        __builtin_amdgcn_s_waitcnt(0);
        unsigned nloc = b.st[0], nx = b.st[1];
        if (nloc == 0u) { xcd_barrier_complete(bar, b.x, nloc, nx); b.st[0] = nloc; b.st[1] = nx; }
        const unsigned old = xb_add(&bar[XB_XSUB(b.x)], 1u);
        const unsigned gen = old / nloc;
        if (old + 1u == (gen + 1u) * nloc) {
            __builtin_amdgcn_fence(__ATOMIC_RELEASE, "agent");
            asm volatile("s_waitcnt vmcnt(0)" ::: "memory");
            const unsigned og = xb_add(&bar[XB_TOP], 1u);
            const unsigned tg = og / nx;
            if (og + 1u == (tg + 1u) * nx) xb_add(&bar[XB_TOPGEN], 1u);
            else XB_SPIN(xb_ld(&bar[XB_TOPGEN]) == tg, bar);
            __builtin_amdgcn_fence(__ATOMIC_ACQUIRE, "agent");
            xb_add(&bar[XB_XGEN(b.x)], 1u);
            asm volatile("s_waitcnt vmcnt(0)" ::: "memory");
        } else {
            XB_SPIN(xb_ld(&bar[XB_XGEN(b.x)]) == gen, bar);
            __builtin_amdgcn_fence(__ATOMIC_ACQUIRE, "agent");
            asm volatile("s_waitcnt vmcnt(0)" ::: "memory");
        }
    }
    __syncthreads();
}


#define LDS_WAIT() asm volatile("s_waitcnt lgkmcnt(0)" ::: "memory")
DI void transpose_item(const float* W, int K, int N, int Npad, bf16_t* WT, int mode, LAS float* scr, int item, int lane, const float* gk = nullptr) {
    const int nblk = Npad / 32, kb = item / nblk, nb = item % nblk, k0 = 64 * kb, n0 = 32 * nb;
    const int nn = n0 + (lane & 31); const bool ok = nn < N;
    float tv[32];
#pragma unroll
    for (int i = 0; i < 32; ++i) tv[i] = ok ? W[(size_t)(k0 + 2 * i + (lane >> 5)) * N + nn] : 0.f;
    if (gk) {
#pragma unroll
        for (int i = 0; i < 32; ++i) tv[i] *= gk[k0 + 2 * i + (lane >> 5)];
    }
#pragma unroll
    for (int i = 0; i < 32; ++i) scr[(2 * i + (lane >> 5)) * 33 + (lane & 31)] = tv[i];
    LDS_WAIT(); asm volatile("" ::: "memory");
    const int c = lane & 7;
#pragma unroll
    for (int j = 0; j < 4; ++j) {
        const int n = (lane >> 3) + 8 * j; const LAS float* s = scr + (8 * c) * 33 + n;
        u32x4 o; o.x = pk2(s[0 * 33], s[1 * 33]); o.y = pk2(s[2 * 33], s[3 * 33]); o.z = pk2(s[4 * 33], s[5 * 33]); o.w = pk2(s[6 * 33], s[7 * 33]);
        int drow = n0 + n;
        if (mode == 1) { const int jj = drow >= FF ? drow - FF : drow, isu = drow >= FF ? 1 : 0; drow = (jj >> 2) * 8 + isu * 4 + (jj & 3); }
        *(u32x4*)(WT + (size_t)drow * K + k0 + 8 * c) = o;
    }
    LDS_WAIT(); asm volatile("" ::: "memory");
}

template <int NR> DI void norm_rows(const float* xsrc32, bf16_t* xn, float* rn, float* xdst32, const bf16_t* y, const float* gpost, size_t rstride, int lane) {
    f32x4 v[NR][4];
    if (xsrc32) {
#pragma unroll
        for (int r = 0; r < NR; ++r)
#pragma unroll
            for (int j = 0; j < 4; ++j) v[r][j] = *(const f32x4*)(xsrc32 + r * rstride + 4 * lane + 256 * j);
    } else {
        float rr[NR]; u32x2 w[NR][4];
#pragma unroll
        for (int r = 0; r < NR; ++r) { rr[r] = rn[r * (rstride / D)];
#pragma unroll
            for (int j = 0; j < 4; ++j) w[r][j] = *(const u32x2*)(xn + r * rstride + 4 * lane + 256 * j); }
#pragma unroll
        for (int r = 0; r < NR; ++r)
#pragma unroll
            for (int j = 0; j < 4; ++j) v[r][j] = (f32x4){bflo(w[r][j].x), bfhi(w[r][j].x), bflo(w[r][j].y), bfhi(w[r][j].y)} * rr[r];
    }
    if (y) {
        u32x2 yw[NR][4]; f32x4 g[4];
#pragma unroll
        for (int r = 0; r < NR; ++r)
#pragma unroll
            for (int j = 0; j < 4; ++j) yw[r][j] = *(const u32x2*)(y + r * rstride + 4 * lane + 256 * j);
#pragma unroll
        for (int j = 0; j < 4; ++j) g[j] = *(const f32x4*)(gpost + 4 * lane + 256 * j);
#pragma unroll
        for (int r = 0; r < NR; ++r) {
            f32x4 yv[4]; float ss = 0.f;
#pragma unroll
            for (int j = 0; j < 4; ++j) { yv[j] = (f32x4){bflo(yw[r][j].x), bfhi(yw[r][j].x), bflo(yw[r][j].y), bfhi(yw[r][j].y)}; ss += (yv[j][0] * yv[j][0] + yv[j][1] * yv[j][1]) + (yv[j][2] * yv[j][2] + yv[j][3] * yv[j][3]); }
            const float rs = rsqrtf(wave_sum(ss) * (1.f / D) + EPS);
#pragma unroll
            for (int j = 0; j < 4; ++j) v[r][j] = v[r][j] + yv[j] * rs * g[j];
        }
    }
#pragma unroll
    for (int r = 0; r < NR; ++r) {
        if (xdst32) {
#pragma unroll
            for (int j = 0; j < 4; ++j) *(f32x4*)(xdst32 + r * rstride + 4 * lane + 256 * j) = v[r][j];
        } else {
            float ss = 0.f;
#pragma unroll
            for (int j = 0; j < 4; ++j) ss += (v[r][j][0] * v[r][j][0] + v[r][j][1] * v[r][j][1]) + (v[r][j][2] * v[r][j][2] + v[r][j][3] * v[r][j][3]);
            const float ms = wave_sum(ss) * (1.f / D) + EPS, rs = rsqrtf(ms);
#pragma unroll
            for (int j = 0; j < 4; ++j) { const f32x4 o = v[r][j] * rs; u32x2 w; w.x = pk2(o[0], o[1]); w.y = pk2(o[2], o[3]); *(u32x2*)(xn + r * rstride + 4 * lane + 256 * j) = w; }
            if (lane == 0) rn[r * (rstride / D)] = ms * rs;
        }
    }
}
DI void norm_row(const float* xsrc32, bf16_t* xn, float* rn, float* xdst32, const bf16_t* y, const float* gpost, int lane) { norm_rows<1>(xsrc32, xn, rn, xdst32, y, gpost, (size_t)D, lane); }

DI void norm_phase(const Ctx& p, const float* gpost, bool last, int G, int bx) {
    const int tid = pg8::tid_(), lane = tid & 63, wv = tid >> 6, gw = bx * NWAVES + wv, NGW = G * NWAVES;
    const bf16_t* Yb = (const bf16_t*)(p.ws + WS_Y); bf16_t* Xb = (bf16_t*)(p.ws + WS_XB); float* Rn = (float*)(p.ws + WS_RN);
    int row = gw; const size_t rst = (size_t)NGW * D;
    for (; row + 3 * NGW < MA; row += 4 * NGW) norm_rows<4>(nullptr, Xb + (size_t)row * D, Rn + row, last ? p.out + (size_t)row * D : nullptr, Yb + (size_t)row * D, gpost, rst, lane);
    for (; row < MA; row += NGW) norm_row(nullptr, Xb + (size_t)row * D, Rn + row, last ? p.out + (size_t)row * D : nullptr, Yb + (size_t)row * D, gpost, lane);
}

DI void prologue(const Params& p, LAS unsigned char* lds) {
    const int tid = pg8::tid_(), lane = tid & 63, wv = tid >> 6;
    const int gw = blockIdx.x * NWAVES + wv, NGW = gridDim.x * NWAVES;
    LAS float* scr = (LAS float*)(lds + wv * 16384);
    unsigned char* ws = p.ws;
    constexpr int I0 = 3072, I1 = 192, I2 = 512, I3 = 2816, I4 = 1408, IPL = I0 + 2 * I1 + 5 * I2 + I3 + I4;
    for (int it = gw; it < 4 * IPL; it += NGW) {
        const int l = it / IPL; int r = it % IPL;
        if (r < I0) { transpose_item(p.in[I_WIN] + (size_t)l * D * NIN, D, NIN, NINP, (bf16_t*)(ws + WS_WIN + l * SZ_WIN), 0, scr, r, lane, p.in[I_NMIXPRE] + l * D); continue; } r -= I0;
        if (r < I1) { transpose_item(p.in[I_WBA] + (size_t)l * 384 * D, 384, D, D, (bf16_t*)(ws + WS_WBA + l * SZ_WBA), 0, scr, r, lane); continue; } r -= I1;
        if (r < I1) { transpose_item(p.in[I_WBC] + (size_t)l * 384 * D, 384, D, D, (bf16_t*)(ws + WS_WBC + l * SZ_WBA), 0, scr, r, lane); continue; } r -= I1;
        if (r < I2) { transpose_item(p.in[I_WMIX] + (size_t)l * D * D, D, D, D, (bf16_t*)(ws + WS_WMIX + l * SZ_WSQ), 0, scr, r, lane); continue; } r -= I2;
        if (r < I2) { transpose_item(p.in[I_WXQ] + (size_t)l * D * D, D, D, D, (bf16_t*)(ws + WS_WXQ + l * SZ_WSQ), 0, scr, r, lane, p.in[I_NXPRE] + l * D); continue; } r -= I2;
        if (r < I2) { transpose_item(p.in[I_WXO] + (size_t)l * D * D, D, D, D, (bf16_t*)(ws + WS_WXO + l * SZ_WSQ), 0, scr, r, lane); continue; } r -= I2;
        if (r < I2) { transpose_item(p.in[I_WXK] + (size_t)l * D * D, D, D, D, (bf16_t*)(ws + WS_WKV + l * SZ_WKV), 0, scr, r, lane); continue; } r -= I2;
        if (r < I2) { transpose_item(p.in[I_WXV] + (size_t)l * D * D, D, D, D, (bf16_t*)(ws + WS_WKV + l * SZ_WKV + SZ_WSQ), 0, scr, r, lane); continue; } r -= I2;
        if (r < I3) { transpose_item(p.in[I_WF1] + (size_t)l * D * FF2, D, FF2, FF2, (bf16_t*)(ws + WS_WF1 + l * SZ_WF1), 1, scr, r, lane, p.in[I_NFPRE] + l * D); continue; } r -= I3;
        transpose_item(p.in[I_WF2] + (size_t)l * FF * D, FF, D, D, (bf16_t*)(ws + WS_WF2 + l * SZ_WF2), 0, scr, r, lane);
    }
    for (int u = blockIdx.x; u < 128; u += gridDim.x) {
        const int l = u >> 5, g = (u >> 3) & 3, nb = (u >> 2) & 1, cq = u & 3;
        LAS float* Ps = (LAS float*)(lds + 8 * 16384);
        __syncthreads();
        for (int i = tid; i < 1024; i += NTHR) Ps[i] = p.in[I_WPOOL][((size_t)(l * 4 + g) * 64 + 16 * cq) * 64 + i];
        __syncthreads();
        const int n = nb * 512 + tid;
        const float* sc = p.in[I_PSCALE] + l * 256 + g * 64; const float* wb = p.in[I_WBB] + ((size_t)l * 256 + g * 64) * D + n;
        float acc[16];
#pragma unroll
        for (int c = 0; c < 16; ++c) acc[c] = 0.f;
#pragma unroll 2
        for (int d0 = 0; d0 < 64; d0 += 8) {
            float bc[8];
#pragma unroll
            for (int j = 0; j < 8; ++j) bc[j] = sc[d0 + j] * wb[(size_t)(d0 + j) * D];
#pragma unroll
            for (int c = 0; c < 16; ++c) { const f32x4 p0 = *(const LAS f32x4*)(Ps + c * 64 + d0), p1 = *(const LAS f32x4*)(Ps + c * 64 + d0 + 4);
                acc[c] += ((p0[0] * bc[0] + p0[1] * bc[1]) + (p0[2] * bc[2] + p0[3] * bc[3])) + ((p1[0] * bc[4] + p1[1] * bc[5]) + (p1[2] * bc[6] + p1[3] * bc[7])); }
        }
        unsigned ov[16];
#pragma unroll
        for (int c = 0; c < 16; ++c) ov[c] = f2bf(acc[c]);
        bf16_t* dst = (bf16_t*)(ws + WS_WBB + l * SZ_WBB) + (size_t)n * 256 + g * 64 + 16 * cq;
        u32x4 w0, w1; w0.x = ov[0] | (ov[1] << 16); w0.y = ov[2] | (ov[3] << 16); w0.z = ov[4] | (ov[5] << 16); w0.w = ov[6] | (ov[7] << 16);
        w1.x = ov[8] | (ov[9] << 16); w1.y = ov[10] | (ov[11] << 16); w1.z = ov[12] | (ov[13] << 16); w1.w = ov[14] | (ov[15] << 16);
        *(u32x4*)dst = w0; *(u32x4*)(dst + 8) = w1;
    }
    __syncthreads();
    for (int row = gw; row < MA; row += NGW) {
        const float* src = row < MP ? p.in[I_XP] + (size_t)row * D : p.in[I_XS] + (size_t)(row - MP) * D;
        norm_row(src, (bf16_t*)(ws + WS_XB) + (size_t)row * D, (float*)(ws + WS_RN) + row, nullptr, nullptr, nullptr, lane);
    }
    for (int row = gw; row < NB * 256; row += NGW) {
        f32x4 v[4]; float ss = 0.f;
#pragma unroll
        for (int j = 0; j < 4; ++j) { v[j] = *(const f32x4*)(p.in[I_MEM] + (size_t)row * D + 4 * lane + 256 * j); ss += (v[j][0] * v[j][0] + v[j][1] * v[j][1]) + (v[j][2] * v[j][2] + v[j][3] * v[j][3]); }
        const float rs = rsqrtf(wave_sum(ss) * (1.f / D) + EPS);
        for (int l = 0; l < 4; ++l)
#pragma unroll
            for (int j = 0; j < 4; ++j) { const f32x4 g = *(const f32x4*)(p.in[I_MEMN] + l * D + 4 * lane + 256 * j); const f32x4 o = v[j] * rs * g; u32x2 w; w.x = pk2(o[0], o[1]); w.y = pk2(o[2], o[3]);
                *(u32x2*)((bf16_t*)(ws + WS_MN) + ((size_t)l * 2048 + row) * D + 4 * lane + 256 * j) = w; }
    }
}

#define MFMA32(a, b, c) __builtin_amdgcn_mfma_f32_32x32x16_bf16((a), (b), (c), 0, 0, 0)
#define MFMA16(a, b, c) __builtin_amdgcn_mfma_f32_16x16x32_bf16((a), (b), (c), 0, 0, 0)
template <bool MASKED> DI void sb_tile_weights(f32x16 (&z)[2], float& R, int jt, int tq, int hi) {
    f32x16 e[2]; float T[8];
    const int sbase = 64 * jt + 4 * hi;
#pragma unroll
    for (int kb = 0; kb < 2; ++kb)
#pragma unroll
        for (int g = 0; g < 4; ++g) {
            float fl[4];
#pragma unroll
            for (int j = 0; j < 4; ++j) {
                const int r = 4 * g + j; const bool valid = !MASKED || (sbase + 32 * kb + 8 * g + j) < tq;
                const float zz = fminf(fmaxf(z[kb][r], -240.f), 240.f);
                const float t = __builtin_amdgcn_exp2f(zz * (-0.125f * 1.4426950408889634f));
                const float be = __builtin_amdgcn_rcpf(1.f + t);
                fl[j] = valid ? t * be : 1.f; z[kb][r] = valid ? be : 0.f;
            }
            e[kb][4 * g + 3] = 1.f; e[kb][4 * g + 2] = fl[3]; e[kb][4 * g + 1] = fl[3] * fl[2]; e[kb][4 * g + 0] = e[kb][4 * g + 1] * fl[1];
            T[kb * 4 + g] = e[kb][4 * g + 0] * fl[0];
        }
    float Tp[8], X[8];
#pragma unroll
    for (int gi = 0; gi < 8; ++gi) Tp[gi] = __shfl_xor(T[gi], 32);
    X[7] = 1.f;
#pragma unroll
    for (int gi = 6; gi >= 0; --gi) X[gi] = X[gi + 1] * (T[gi + 1] * Tp[gi + 1]);
    const float total = X[0] * (T[0] * Tp[0]);
#pragma unroll
    for (int kb = 0; kb < 2; ++kb)
#pragma unroll
        for (int g = 0; g < 4; ++g) {
            const int gi = kb * 4 + g; const float off = R * X[gi] * (hi == 0 ? Tp[gi] : 1.f);
#pragma unroll
            for (int j = 0; j < 4; ++j) { const int r = 4 * g + j; z[kb][r] = z[kb][r] * (off * e[kb][r]); }
        }
    R *= total;
}

DI void sb_prompt_unit(const Ctx& p, int b, int h, int qb, LAS unsigned char* lds) {
    const bf16_t* proj = (const bf16_t*)(p.ws + WS_PROJ);
    LAS unsigned short* KS = (LAS unsigned short*)lds;
    LAS unsigned short* VT = KS + 64 * 72;
    const int tid = pg8::tid_(), lane = tid & 63, wv = tid >> 6, hi = lane >> 5, c = lane & 31;
    const int q0 = qb * 256 + wv * 32, tq = q0 + c;
    const size_t rowbase = (size_t)b * SEQ;
    bf16x8 qf[4];
    {
        const bf16_t* qp = proj + (rowbase + tq) * NINP + C_QA + h * 64 + 8 * hi;
#pragma unroll
        for (int kk = 0; kk < 4; ++kk) qf[kk] = *(const bf16x8*)(qp + 16 * kk);
    }
    f32x16 o0, o1;
#pragma unroll
    for (int i = 0; i < 16; ++i) { o0[i] = 0.f; o1[i] = 0.f; }
    float R = 1.f;
    const bf16_t* kbase = proj + rowbase * NINP + C_KA + h * 64 + 8 * wv;
    const bf16_t* vbase = proj + rowbase * NINP + C_VA + h * 64 + 8 * wv;
    int jt = 4 * qb + 3;
    u32x4 kr = *(const u32x4*)(kbase + (size_t)(64 * jt + lane) * NINP), vr = *(const u32x4*)(vbase + (size_t)(64 * jt + lane) * NINP);
    for (; jt >= 0; --jt) {
        __syncthreads();
        *(LAS u32x4*)(KS + lane * 72 + 8 * wv) = kr;
#pragma unroll
        for (int i = 0; i < 4; ++i) { const unsigned w = vr[i]; VT[(8 * wv + 2 * i) * 72 + lane] = (unsigned short)(w & 0xffffu); VT[(8 * wv + 2 * i + 1) * 72 + lane] = (unsigned short)(w >> 16); }
        __syncthreads();
        if (jt > 0) { kr = *(const u32x4*)(kbase + (size_t)(64 * (jt - 1) + lane) * NINP); vr = *(const u32x4*)(vbase + (size_t)(64 * (jt - 1) + lane) * NINP); }
        if (64 * jt < q0 + 31) {
            f32x16 z[2];
#pragma unroll
            for (int kb = 0; kb < 2; ++kb) {
                f32x16 acc;
#pragma unroll
                for (int i = 0; i < 16; ++i) acc[i] = 0.f;
#pragma unroll
                for (int kk = 0; kk < 4; ++kk) { const bf16x8 a = *(const LAS bf16x8*)(KS + (32 * kb + c) * 72 + 16 * kk + 8 * hi); acc = MFMA32(a, qf[kk], acc); }
                z[kb] = acc;
            }
            if (64 * jt + 63 < q0) sb_tile_weights<false>(z, R, jt, tq, hi); else sb_tile_weights<true>(z, R, jt, tq, hi);
#pragma unroll
            for (int kb = 0; kb < 2; ++kb)
#pragma unroll
                for (int s2 = 0; s2 < 2; ++s2) {
                    u32x4 pw; pw.x = pk2(z[kb][8 * s2 + 0], z[kb][8 * s2 + 1]); pw.y = pk2(z[kb][8 * s2 + 2], z[kb][8 * s2 + 3]); pw.z = pk2(z[kb][8 * s2 + 4], z[kb][8 * s2 + 5]); pw.w = pk2(z[kb][8 * s2 + 6], z[kb][8 * s2 + 7]);
                    const bf16x8 pb = __builtin_bit_cast(bf16x8, pw);
                    const int ko = 32 * kb + 16 * s2 + 4 * hi;
                    { const s16x4 lo = *(const LAS s16x4*)(VT + c * 72 + ko), hh = *(const LAS s16x4*)(VT + c * 72 + ko + 8);
                      const bf16x8 va = __builtin_shufflevector(lo, hh, 0, 1, 2, 3, 4, 5, 6, 7); o0 = MFMA32(va, pb, o0); }
                    { const s16x4 lo = *(const LAS s16x4*)(VT + (c + 32) * 72 + ko), hh = *(const LAS s16x4*)(VT + (c + 32) * 72 + ko + 8);
                      const bf16x8 va = __builtin_shufflevector(lo, hh, 0, 1, 2, 3, 4, 5, 6, 7); o1 = MFMA32(va, pb, o1); }
                }
        }
    }
    bf16_t* op = (bf16_t*)(p.ws + WS_OA) + (rowbase + tq) * 384 + h * 64 + 4 * hi;
#pragma unroll
    for (int g = 0; g < 4; ++g) {
        u32x2 w; w.x = pk2(o0[4 * g], o0[4 * g + 1]); w.y = pk2(o0[4 * g + 2], o0[4 * g + 3]); *(u32x2*)(op + 8 * g) = w;
        w.x = pk2(o1[4 * g], o1[4 * g + 1]); w.y = pk2(o1[4 * g + 2], o1[4 * g + 3]); *(u32x2*)(op + 32 + 8 * g) = w;
    }
}

DI void sb_sample_unit(const Ctx& p, int l, int b, int h, LAS unsigned char* lds) {
    const bf16_t* proj = (const bf16_t*)(p.ws + WS_PROJ);
    LAS float* qs = (LAS float*)lds;
    LAS float* Z = qs + 1024;
    LAS float* RED = Z + 16 * 1056;
    const int tid = pg8::tid_(), lane = tid & 63, wv = tid >> 6;
    const size_t srow = (size_t)MP + b * 16;
    for (int i = tid; i < 1024; i += NTHR) qs[i] = bf2f(proj[(srow + (i >> 6)) * NINP + C_QA + h * 64 + (i & 63)]) * 0.125f;
    __syncthreads();
    {
        float a0[16], a1[16];
#pragma unroll
        for (int i = 0; i < 16; ++i) { a0[i] = 0.f; a1[i] = 0.f; }
        const float* k0p = p.in[I_CSK] + ((((size_t)l * DB + b) * PAST + tid) * 6 + h) * 64; const float* k1p = k0p + (size_t)512 * 6 * 64;
#pragma unroll 8
        for (int d4 = 0; d4 < 16; ++d4) {
            const f32x4 ka = *(const f32x4*)(k0p + 4 * d4), kb = *(const f32x4*)(k1p + 4 * d4);
#pragma unroll
            for (int i = 0; i < 16; ++i) { const f32x4 q = *(const LAS f32x4*)(qs + i * 64 + 4 * d4);
                a0[i] += (q[0] * ka[0] + q[1] * ka[1]) + (q[2] * ka[2] + q[3] * ka[3]); a1[i] += (q[0] * kb[0] + q[1] * kb[1]) + (q[2] * kb[2] + q[3] * kb[3]); }
        }
#pragma unroll
        for (int i = 0; i < 16; ++i) { Z[i * 1056 + tid] = a0[i]; Z[i * 1056 + tid + 512] = a1[i]; }
        if (tid < 256) {
            const int i = tid >> 4, j = tid & 15; const bf16_t* kp = proj + (srow + j) * NINP + C_KA + h * 64; float s = 0.f;
            for (int d = 0; d < 64; ++d) s += qs[i * 64 + d] * bf2f(kp[d]);
            Z[i * 1056 + 1024 + j] = s;
        }
    }
    __syncthreads();
    for (int qq = 0; qq < 2; ++qq) {
        const int i = 2 * wv + qq, lim = PAST + i; LAS float* zr = Z + i * 1056;
        const int st = 17 * lane, en = (st + 17 < 1040) ? st + 17 : 1040;
        float tot = 0.f;
        for (int s = st; s < en; ++s) if (s < lim) tot -= softplusf_(zr[s]);
        float incl = tot;
#pragma unroll
        for (int o = 1; o < 64; o <<= 1) { const float t = __shfl_down(incl, o); if (lane + o < 64) incl += t; }
        float run = incl - tot;
        for (int s = en - 1; s >= st; --s) {
            const float zz = zr[s]; float w = 0.f;
            if (s < lim) { const float sp = softplusf_(zz); w = __expf(zz - sp + run); run -= sp; }
            zr[s] = w;
        }
    }
    __syncthreads();
    {
        const int d = tid & 63, g = tid >> 6;
        float o[16];
#pragma unroll
        for (int i = 0; i < 16; ++i) o[i] = 0.f;
        const float* vp = p.in[I_CSV] + (((size_t)l * DB + b) * PAST * 6 + h) * 64 + d;
        for (int s0 = 130 * g; s0 < 130 * g + 130; s0 += 26) {
            float v[26];
#pragma unroll
            for (int j = 0; j < 26; ++j) { const int s = s0 + j; v[j] = s < PAST ? vp[(size_t)s * 384] : bf2f(proj[(srow + (s - PAST)) * NINP + C_VA + h * 64 + d]); }
#pragma unroll
            for (int j = 0; j < 26; ++j)
#pragma unroll
                for (int i = 0; i < 16; ++i) o[i] += Z[i * 1056 + s0 + j] * v[j];
        }
#pragma unroll
        for (int i = 0; i < 16; ++i) RED[(g * 16 + i) * 64 + d] = o[i];
    }
    __syncthreads();
    for (int i = tid; i < 1024; i += NTHR) {
        const int qi = i >> 6, d = i & 63; float s = 0.f;
#pragma unroll
        for (int g = 0; g < 8; ++g) s += RED[(g * 16 + qi) * 64 + d];
        ((bf16_t*)(p.ws + WS_OA))[(srow + qi) * 384 + h * 64 + d] = f2bf(s);
    }
}

template <int W> DI void pool_rows(const float (&uu)[48], int t0, float* outp, bf16_t* pooled_col) {
    float s = 0.f;
#pragma unroll
    for (int i = 16 - W; i < 16; ++i) s += uu[i];
#pragma unroll
    for (int r = 0; r < 32; ++r) {
        s += uu[16 + r] - uu[16 + r - W];
        const int t = t0 + r; const float cnt = (float)((t + 1 < W) ? t + 1 : W);
        pooled_col[(size_t)r * 256] = f2bf(s / cnt - uu[16 + r]);
        if (t >= SEQ - 15) outp[(size_t)(t - (SEQ - 15)) * 256] = uu[16 + r];
    }
}
DI void pool_unit(const Ctx& p, int l, int unit) {
    const bf16_t* proj = (const bf16_t*)(p.ws + WS_PROJ); bf16_t* pooled = (bf16_t*)(p.ws + WS_POOLED);
    const int tid = pg8::tid_(), ch = tid & 255, w = 2 << (ch >> 6);
    if (unit < MP / 64) {
        const int r0 = unit * 64 + 32 * (tid >> 8), t0 = r0 & (SEQ - 1), b = r0 >> 11;
        float uu[48];
        const bf16_t* up = proj + (size_t)(r0 - 16) * NINP + C_U + ch;
#pragma unroll
        for (int i = 0; i < 48; ++i) uu[i] = (t0 - 16 + i >= 0) ? bf2f(up[(size_t)i * NINP]) : 0.f;
        float* outp = p.out + O_POOLP + ((size_t)(l * NB + b) * 15) * 256 + ch; bf16_t* pc = pooled + (size_t)r0 * 256 + ch;
        if (w == 2) pool_rows<2>(uu, t0, outp, pc); else if (w == 4) pool_rows<4>(uu, t0, outp, pc); else if (w == 8) pool_rows<8>(uu, t0, outp, pc); else pool_rows<16>(uu, t0, outp, pc);
        return;
    }
    for (int i = 0; i < 32; ++i) {
        const int row = unit * 64 + (tid >> 8) + 2 * i;
        const int rs = row - MP, b = rs >> 4, t = rs & 15; float s = 0.f;
        const bf16_t* up = proj + (size_t)row * NINP + C_U + ch; const float u0 = bf2f(up[0]);
        const float* hist = p.in[I_SPOOL] + ((size_t)(l * DB + b) * 15) * 256 + ch;
        for (int j = 0; j < w; ++j) { const int tt = t - j; s += tt >= 0 ? bf2f(*(up - (size_t)j * NINP)) : hist[(15 + tt) * 256]; }
        if (t >= 1) p.out[O_POOLS + ((size_t)(l * DB + b) * 15 + (t - 1)) * 256 + ch] = u0;
        pooled[(size_t)row * 256 + ch] = f2bf(s / (float)w - u0);
    }
}

DI void kvout_unit(const Ctx& p, int l, int unit) {
    const bf16_t* proj = (const bf16_t*)(p.ws + WS_PROJ);
#pragma unroll 4
    for (int i = pg8::tid_(); i < 64 * 96; i += NTHR) {
        const int r = i / 96, ch = i % 96, row = unit * 64 + r;
        const u32x4 w = *(const u32x4*)(proj + (size_t)row * NINP + C_KA + 8 * ch);
        const bool isv = ch >= 48; const int c = 8 * (isv ? ch - 48 : ch);
        float* dst = (row < MP) ? p.out + (isv ? O_VP : O_KP) + ((size_t)l * MP + row) * 384 + c : p.out + (isv ? O_VS : O_KS) + ((size_t)l * MS + (row - MP)) * 384 + c;
        *(f32x4*)dst = (f32x4){bflo(w.x), bfhi(w.x), bflo(w.y), bfhi(w.y)}; *(f32x4*)(dst + 4) = (f32x4){bflo(w.z), bfhi(w.z), bflo(w.w), bfhi(w.w)};
    }
}
DI void memout_unit(const Ctx& p, int unit) {
    const bf16_t* mkv = (const bf16_t*)(p.ws + WS_MKV);
    for (int i = pg8::tid_(); i < 16 * 256; i += NTHR) {
        const int r = i >> 8, ch = i & 255, row = unit * 16 + r, col = 8 * ch;
        const u32x4 w = *(const u32x4*)(mkv + (size_t)row * 2048 + col);
        float* dst = p.out + (col >= 1024 ? O_MVP : O_MKP) + (size_t)row * D + (col & 1023);
        *(f32x4*)dst = (f32x4){bflo(w.x), bfhi(w.x), bflo(w.y), bfhi(w.y)}; *(f32x4*)(dst + 4) = (f32x4){bflo(w.z), bfhi(w.z), bflo(w.w), bfhi(w.w)};
    }
}
DI void memvt_unit(const Ctx& p, int unit) {
    const int l = unit >> 7, nb = (unit >> 3) & 15, b = unit & 7, tid = pg8::tid_(), n = nb * 64 + (tid & 63), wv = tid >> 6;
    const bf16_t* src = (const bf16_t*)(p.ws + WS_MKV) + ((size_t)l * 2048 + b * 256) * 2048 + 1024 + n;
    bf16_t* dst = (bf16_t*)(p.ws + WS_MEMVT) + ((size_t)l * 1024 + n) * 2048 + b * 256;
    for (int c = wv; c < 32; c += 8) {
        unsigned v[8];
#pragma unroll
        for (int j = 0; j < 8; ++j) v[j] = src[(size_t)(8 * c + j) * 2048];
        u32x4 w; w.x = v[0] | (v[1] << 16); w.y = v[2] | (v[3] << 16); w.z = v[4] | (v[5] << 16); w.w = v[6] | (v[7] << 16);
        *(u32x4*)(dst + 8 * c) = w;
    }
}

DI void gla_decay(const Ctx& p, int l, int h, size_t row0, int ntok, LAS unsigned char* lds) {
    const bf16_t* proj = (const bf16_t*)(p.ws + WS_PROJ);
    LAS float* Bc = (LAS float*)lds; LAS float* LR = (LAS float*)(lds + 24576); LAS float* A2 = (LAS float*)(lds + 28672); LAS float* BIA = (LAS float*)(lds + 34816); LAS float* SEG = (LAS float*)(lds + 35200);
    const int tid = pg8::tid_();
    if (tid < 128) {
        const int t = tid >> 1, hf = tid & 1; u32x4 w = {0u, 0u, 0u, 0u};
        if (t < ntok) w = *(const u32x4*)(proj + (row0 + t) * NINP + C_LR + 8 * hf);
        LAS float* d = LR + t * 16 + 8 * hf;
        d[0] = bflo(w.x); d[1] = bfhi(w.x); d[2] = bflo(w.y); d[3] = bfhi(w.y); d[4] = bflo(w.z); d[5] = bfhi(w.z); d[6] = bflo(w.w); d[7] = bfhi(w.w);
    } else if (tid < 128 + 384) {
        const int i = tid - 128, r = i / 24, c4 = i % 24;
        *(LAS f32x4*)(A2 + r * 96 + 4 * c4) = *(const f32x4*)(p.in[I_WA2] + ((size_t)l * 16 + r) * 384 + h * 96 + 4 * c4);
    }
    if (tid < 96) BIA[tid] = p.in[I_BA][l * 384 + h * 96 + tid];
    __syncthreads();
    for (int i = tid; i < 64 * 96; i += NTHR) {
        const int t = i / 96, k = i % 96; float sacc = BIA[k];
#pragma unroll
        for (int r = 0; r < 16; ++r) sacc += LR[t * 16 + r] * A2[r * 96 + k];
        Bc[i] = t < ntok ? -softplusf_(-sacc) * (1.f / 16.f) : 0.f;
    }
    __syncthreads();
    const int k = tid % 96, seg = tid / 96;
    if (tid < 384) { float run = 0.f; for (int i = 0; i < 16; ++i) { const int idx = (16 * seg + i) * 96 + k; run += Bc[idx]; Bc[idx] = run; } SEG[seg * 96 + k] = run; }
    __syncthreads();
    if (tid < 384 && seg > 0) { float off = 0.f; for (int s2 = 0; s2 < seg; ++s2) off += SEG[s2 * 96 + k]; for (int i = 0; i < 16; ++i) Bc[(16 * seg + i) * 96 + k] += off; }
    __syncthreads();
}
DI void gla_unit_rows(int gu, size_t& row0, int& ntok, int& bh, int& h) {
    if (gu < NGU_P) { bh = gu >> 5; const int c = gu & 31, b = bh >> 2; h = bh & 3; row0 = (size_t)b * SEQ + c * 64; ntok = 64; }
    else { bh = gu - NGU_P; const int b = bh >> 2; h = bh & 3; row0 = (size_t)MP + b * 16; ntok = 16; }
}
DI void gla_stage1_unit(const Ctx& p, int l, int gu, LAS unsigned char* lds) {
    const bf16_t* proj = (const bf16_t*)(p.ws + WS_PROJ);
    size_t row0; int ntok, bh, h; gla_unit_rows(gu, row0, ntok, bh, h);
    gla_decay(p, l, h, row0, ntok, lds);
    LAS float* Bc = (LAS float*)lds;
    LAS unsigned short* KT = (LAS unsigned short*)(lds + 36864);
    LAS unsigned short* VT = KT + 96 * 72;
    const int tid = pg8::tid_(), lane = tid & 63, wv = tid >> 6, fr = lane & 15, fq = lane >> 4;
    {
        float* bb = (float*)(p.ws + WS_BB) + (size_t)gu * (64 * GK);
        for (int i = tid; i < 64 * GK / 4; i += NTHR) *(f32x4*)(bb + 4 * i) = *(const LAS f32x4*)(Bc + 4 * i);
    }
    for (int task = tid; task < 768; task += NTHR) {
        const int t = task & 63, ch = task >> 6; u32x4 kw = {0u, 0u, 0u, 0u}, vw = {0u, 0u, 0u, 0u};
        if (t < ntok) { const bf16_t* rp = proj + (row0 + t) * NINP + h * 96 + 8 * ch; kw = *(const u32x4*)(rp + C_KC); vw = *(const u32x4*)(rp + C_VC); }
        const unsigned kk[4] = {kw.x, kw.y, kw.z, kw.w}, vv[4] = {vw.x, vw.y, vw.z, vw.w};
#pragma unroll
        for (int j = 0; j < 4; ++j) {
            const int k0 = 8 * ch + 2 * j;
            const float e0 = __expf(Bc[(ntok - 1) * 96 + k0] - Bc[t * 96 + k0]), e1 = __expf(Bc[(ntok - 1) * 96 + k0 + 1] - Bc[t * 96 + k0 + 1]);
            KT[k0 * 72 + t] = f2bf(bflo(kk[j]) * e0); KT[(k0 + 1) * 72 + t] = f2bf(bfhi(kk[j]) * e1);
            VT[k0 * 72 + t] = (unsigned short)(vv[j] & 0xffffu); VT[(k0 + 1) * 72 + t] = (unsigned short)(vv[j] >> 16);
        }
    }
    if (tid < 96) ((float*)(p.ws + WS_GDEC))[(size_t)gu * 96 + tid] = __expf(Bc[(ntok - 1) * 96 + tid]);
    __syncthreads();
    float* KV = (float*)(p.ws + WS_GKV) + (size_t)gu * (GK * GK);
    for (int tile = wv; tile < 36; tile += 8) {
        const int ki = tile / 6, vi = tile % 6; f32x4 acc = {0.f, 0.f, 0.f, 0.f};
#pragma unroll
        for (int ks = 0; ks < 2; ++ks) { const bf16x8 a = *(const LAS bf16x8*)(KT + (16 * ki + fr) * 72 + 32 * ks + 8 * fq), bb = *(const LAS bf16x8*)(VT + (16 * vi + fr) * 72 + 32 * ks + 8 * fq); acc = MFMA16(a, bb, acc); }
#pragma unroll
        for (int j = 0; j < 4; ++j) KV[(16 * ki + 4 * fq + j) * 96 + 16 * vi + fr] = acc[j];
    }
}
DI void gla_scan(const Ctx& p, int l) {
    const int gt = blockIdx.x * NTHR + pg8::tid_(), NT = gridDim.x * NTHR;
    const float* KV = (const float*)(p.ws + WS_GKV); const float* DEC = (const float*)(p.ws + WS_GDEC); float* SP = (float*)(p.ws + WS_GSP);
    for (int e = gt; e < 32 * GK * GK; e += NT) {
        const int bh = e / (GK * GK), kv = e % (GK * GK), k = kv / GK; float S = 0.f;
        float kvv[32], dcv[32];
#pragma unroll
        for (int c = 0; c < 32; ++c) { const size_t gu = (size_t)bh * 32 + c; kvv[c] = KV[gu * (GK * GK) + kv]; dcv[c] = DEC[gu * 96 + k]; }
#pragma unroll
        for (int c = 0; c < 32; ++c) { const size_t gu = (size_t)bh * 32 + c; SP[gu * (GK * GK) + kv] = S; S = dcv[c] * S + kvv[c]; }
        p.out[O_GLAP + ((size_t)l * 32 + bh) * (GK * GK) + kv] = S;
    }
    for (int e = gt; e < 64 * GK * GK; e += NT) {
        const int bh = e / (GK * GK), kv = e % (GK * GK), k = kv / GK; const size_t gu = (size_t)NGU_P + bh;
        const float S0 = p.in[I_SGLA][((size_t)l * 64 + bh) * (GK * GK) + kv];
        p.out[O_GLAS + ((size_t)l * 64 + bh) * (GK * GK) + kv] = DEC[gu * 96 + k] * S0 + KV[gu * (GK * GK) + kv];
    }
}
DI void gla_stage3_unit(const Ctx& p, int l, int gu, LAS unsigned char* lds) {
    const bf16_t* proj = (const bf16_t*)(p.ws + WS_PROJ);
    size_t row0; int ntok, bh, h; gla_unit_rows(gu, row0, ntok, bh, h);
    LAS float* OT = (LAS float*)lds;
    LAS unsigned short* QP = (LAS unsigned short*)(lds + 36864);
    LAS unsigned short* KP = QP + 64 * 104;
    LAS unsigned short* VT = KP + 64 * 104;
    LAS unsigned short* ST = VT + 96 * 72;
    LAS unsigned short* ATT = ST + 96 * 104;
    const int tid = pg8::tid_(), lane = tid & 63, wv = tid >> 6, fr = lane & 15, fq = lane >> 4;
    const float* Sprev = gu < NGU_P ? (const float*)(p.ws + WS_GSP) + (size_t)gu * (GK * GK) : p.in[I_SGLA] + ((size_t)l * 64 + bh) * (GK * GK);
    const float* bb = (const float*)(p.ws + WS_BB) + (size_t)gu * (64 * GK);
    __syncthreads();
    for (int task = tid; task < 768; task += NTHR) {
        const int t = task & 63, ch = task >> 6; u32x4 qw = {0u, 0u, 0u, 0u}, kw = qw, vw = qw; f32x4 b0 = {0.f, 0.f, 0.f, 0.f}, b1 = b0;
        if (t < ntok) { const bf16_t* rp = proj + (row0 + t) * NINP + h * 96 + 8 * ch; qw = *(const u32x4*)(rp + C_QC); kw = *(const u32x4*)(rp + C_KC); vw = *(const u32x4*)(rp + C_VC);
            b0 = *(const f32x4*)(bb + t * 96 + 8 * ch); b1 = *(const f32x4*)(bb + t * 96 + 8 * ch + 4); }
        const unsigned qq[4] = {qw.x, qw.y, qw.z, qw.w}, kk[4] = {kw.x, kw.y, kw.z, kw.w}, vv[4] = {vw.x, vw.y, vw.z, vw.w};
        const float be[8] = {b0[0], b0[1], b0[2], b0[3], b1[0], b1[1], b1[2], b1[3]};
        u32x4 qo, ko; unsigned qa[4], ka[4];
#pragma unroll
        for (int j = 0; j < 4; ++j) {
            const float e0 = __expf(be[2 * j]), e1 = __expf(be[2 * j + 1]), r0 = __builtin_amdgcn_rcpf(e0), r1 = __builtin_amdgcn_rcpf(e1);
            const bool ok = t < ntok;
            qa[j] = ok ? pk2(bflo(qq[j]) * 0.10206207261596575f * e0, bfhi(qq[j]) * 0.10206207261596575f * e1) : 0u;
            ka[j] = ok ? pk2(bflo(kk[j]) * r0, bfhi(kk[j]) * r1) : 0u;
            VT[(8 * ch + 2 * j) * 72 + t] = (unsigned short)(vv[j] & 0xffffu); VT[(8 * ch + 2 * j + 1) * 72 + t] = (unsigned short)(vv[j] >> 16);
        }
        qo.x = qa[0]; qo.y = qa[1]; qo.z = qa[2]; qo.w = qa[3]; ko.x = ka[0]; ko.y = ka[1]; ko.z = ka[2]; ko.w = ka[3];
        *(LAS u32x4*)(QP + t * 104 + 8 * ch) = qo; *(LAS u32x4*)(KP + t * 104 + 8 * ch) = ko;
    }
    for (int task = tid; task < 2304; task += NTHR) {
        const int k = task % 96, vc = task / 96; const f32x4 sv = *(const f32x4*)(Sprev + k * 96 + 4 * vc);
#pragma unroll
        for (int j = 0; j < 4; ++j) ST[(4 * vc + j) * 104 + k] = f2bf(sv[j]);
    }
    __syncthreads();
    for (int tile = 2 * wv; tile < 2 * wv + 2; ++tile) {
        const int ti = tile >> 2, si = tile & 3; f32x4 acc = {0.f, 0.f, 0.f, 0.f};
        if (si <= ti) {
#pragma unroll
            for (int ks = 0; ks < 3; ++ks) { const bf16x8 a = *(const LAS bf16x8*)(QP + (16 * ti + fr) * 104 + 32 * ks + 8 * fq), b2 = *(const LAS bf16x8*)(KP + (16 * si + fr) * 104 + 32 * ks + 8 * fq); acc = MFMA16(a, b2, acc); }
        }
#pragma unroll
        for (int j = 0; j < 4; ++j) { const int t = 16 * ti + 4 * fq + j, s2 = 16 * si + fr; ATT[t * 72 + s2] = f2bf(s2 <= t ? acc[j] : 0.f); }
    }
    __syncthreads();
    for (int tile = wv; tile < 24; tile += 8) {
        const int ti = tile / 6, vi = tile % 6; f32x4 acc = {0.f, 0.f, 0.f, 0.f};
#pragma unroll
        for (int ks = 0; ks < 2; ++ks) { const bf16x8 a = *(const LAS bf16x8*)(ATT + (16 * ti + fr) * 72 + 32 * ks + 8 * fq), b2 = *(const LAS bf16x8*)(VT + (16 * vi + fr) * 72 + 32 * ks + 8 * fq); acc = MFMA16(a, b2, acc); }
#pragma unroll
        for (int ks = 0; ks < 3; ++ks) { const bf16x8 a = *(const LAS bf16x8*)(QP + (16 * ti + fr) * 104 + 32 * ks + 8 * fq), b2 = *(const LAS bf16x8*)(ST + (16 * vi + fr) * 104 + 32 * ks + 8 * fq); acc = MFMA16(a, b2, acc); }
#pragma unroll
        for (int j = 0; j < 4; ++j) OT[(16 * ti + 4 * fq + j) * 96 + 16 * vi + fr] = acc[j];
    }
    __syncthreads();
    bf16_t* oc = (bf16_t*)(p.ws + WS_OC);
    const float* gn = p.in[I_GLAN] + l * 384 + h * 96; const float gn0 = gn[lane], gn1 = lane < 32 ? gn[64 + lane] : 0.f;
    float g0[8], g1[8];
#pragma unroll
    for (int tt = 0; tt < 8; ++tt) { const int t = wv * 8 + tt; g0[tt] = 0.f; g1[tt] = 0.f;
        if (t < ntok) { const bf16_t* gp = proj + (row0 + t) * NINP + C_GC + h * 96; g0[tt] = bf2f(gp[lane]); if (lane < 32) g1[tt] = bf2f(gp[64 + lane]); } }
#pragma unroll
    for (int tt = 0; tt < 8; ++tt) {
        const int t = wv * 8 + tt;
        if (t < ntok) {
            const float a0 = OT[t * 96 + lane], a1 = lane < 32 ? OT[t * 96 + 64 + lane] : 0.f;
            const float rs = rsqrtf(wave_sum(a0 * a0 + a1 * a1) * (1.f / 96.f) + EPS);
            oc[(row0 + t) * 384 + h * 96 + lane] = f2bf(a0 * rs * gn0 * g0[tt] * sigmoidf_(g0[tt]));
            if (lane < 32) oc[(row0 + t) * 384 + h * 96 + 64 + lane] = f2bf(a1 * rs * gn1 * g1[tt] * sigmoidf_(g1[tt]));
        }
    }
}

DI void cross_sample_unit(const Ctx& p, int l, int b, int h, int qh, LAS unsigned char* lds) {
    LAS float* qs = (LAS float*)lds;
    LAS float* ST = qs + 8 * 256;
    LAS float* PART = ST + 256 * 8;
    const bf16_t* Q = (const bf16_t*)(p.ws + WS_Q);
    const int tid = pg8::tid_(), lane = tid & 63, wv = tid >> 6;
    const size_t srow = (size_t)MP + b * 16 + 8 * qh;
    for (int i = tid; i < 8 * 256; i += NTHR) qs[i] = bf2f(Q[(srow + (i >> 8)) * D + h * 256 + (i & 255)]) * 0.0625f;
    __syncthreads();
    const int m = tid & 255, half = tid >> 8;
    {
        float acc[8];
#pragma unroll
        for (int i = 0; i < 8; ++i) acc[i] = 0.f;
        const float* kp = p.in[I_CMK] + ((((size_t)l * DB + b) * 256 + m) * 4 + h) * 256 + 128 * half;
#pragma unroll 16
        for (int d4 = 0; d4 < 32; ++d4) {
            const f32x4 kv = *(const f32x4*)(kp + 4 * d4);
#pragma unroll
            for (int i = 0; i < 8; ++i) { const f32x4 q = *(const LAS f32x4*)(qs + i * 256 + 128 * half + 4 * d4); acc[i] += (q[0] * kv[0] + q[1] * kv[1]) + (q[2] * kv[2] + q[3] * kv[3]); }
        }
#pragma unroll
        for (int i = 0; i < 8; ++i) PART[(half * 8 + i) * 256 + m] = acc[i];
    }
    __syncthreads();
    {
        const int i = wv; float v[4], mx = -3.0e38f;
#pragma unroll
        for (int j = 0; j < 4; ++j) { v[j] = PART[i * 256 + lane + 64 * j] + PART[(8 + i) * 256 + lane + 64 * j]; mx = fmaxf(mx, v[j]); }
        mx = wave_max(mx); float sum = 0.f;
#pragma unroll
        for (int j = 0; j < 4; ++j) { v[j] = __expf(v[j] - mx); sum += v[j]; }
        sum = wave_sum(sum); const float inv = 1.f / sum;
#pragma unroll
        for (int j = 0; j < 4; ++j) ST[(lane + 64 * j) * 8 + i] = v[j] * inv;
    }
    __syncthreads();
    {
        float acc[8];
#pragma unroll
        for (int i = 0; i < 8; ++i) acc[i] = 0.f;
        const float* vp = p.in[I_CMV] + ((((size_t)l * DB + b) * 256 + 128 * half) * 4 + h) * 256 + m;
        for (int k0 = 0; k0 < 128; k0 += 32) {
            float v[32];
#pragma unroll
            for (int j = 0; j < 32; ++j) v[j] = vp[(size_t)(k0 + j) * 1024];
#pragma unroll
            for (int j = 0; j < 32; ++j) {
                const f32x4 s0 = *(const LAS f32x4*)(ST + (128 * half + k0 + j) * 8), s1 = *(const LAS f32x4*)(ST + (128 * half + k0 + j) * 8 + 4);
                acc[0] += s0[0] * v[j]; acc[1] += s0[1] * v[j]; acc[2] += s0[2] * v[j]; acc[3] += s0[3] * v[j];
                acc[4] += s1[0] * v[j]; acc[5] += s1[1] * v[j]; acc[6] += s1[2] * v[j]; acc[7] += s1[3] * v[j];
            }
        }
#pragma unroll
        for (int i = 0; i < 8; ++i) PART[(half * 8 + i) * 256 + m] = acc[i];
    }
    __syncthreads();
    bf16_t* O = (bf16_t*)(p.ws + WS_O);
    for (int i = tid; i < 8 * 256; i += NTHR) { const int qi = i >> 8, d = i & 255; O[(srow + qi) * D + h * 256 + d] = f2bf(PART[qi * 256 + d] + PART[(8 + qi) * 256 + d]); }
}

struct SkBf16 { bf16_t* O; int ldc; DI void operator()(int row, int col, f32x4 v) const { u32x2 w; w.x = pk2(v[0], v[1]); w.y = pk2(v[2], v[3]); *(u32x2*)(O + (size_t)(MP + row) * ldc + col) = w; } };
struct SkGate { bf16_t* merged; const bf16_t* proj; int goff; int accum;
    DI void operator()(int row, int col, f32x4 v) const {
        const u32x2 g = *(const u32x2*)(proj + (size_t)(MP + row) * NINP + goff + col); bf16_t* mp = merged + (size_t)(MP + row) * D + col;
        u32x2 pm2 = {0u, 0u}; if (accum) pm2 = *(const u32x2*)mp;
        u32x2 w; w.x = pk2(sigmoidf_(bflo(g.x)) * v[0] + bflo(pm2.x), sigmoidf_(bfhi(g.x)) * v[1] + bfhi(pm2.x)); w.y = pk2(sigmoidf_(bflo(g.y)) * v[2] + bflo(pm2.y), sigmoidf_(bfhi(g.y)) * v[3] + bfhi(pm2.y));
        *(u32x2*)mp = w; } };
template <class EF> DI void skinny_gemm(const bf16_t* A, int lda, const bf16_t* Bt, int ldb, int K, int N, int G, int bx, LAS unsigned char* lds, const EF& ef) {
    const int tid = pg8::tid_(), lane = tid & 63, wv = tid >> 6, fr = lane & 15, fq = lane >> 4, nks = K >> 5, nunits = 4 * (N >> 4);
    LAS f32x4* red = (LAS f32x4*)lds;
    for (int u = bx; u < nunits; u += G) {
        const int rb = u & 3, cb = u >> 2;
        f32x4 acc[4];
#pragma unroll
        for (int i = 0; i < 4; ++i) acc[i] = (f32x4){0.f, 0.f, 0.f, 0.f};
        const bf16_t* bp = Bt + (size_t)(16 * cb + fr) * ldb + 8 * fq; const bf16_t* ap = A + (size_t)(64 * rb + fr) * lda + 8 * fq;
        for (int ks = wv; ks < nks; ks += 8) {
            const bf16x8 bb = *(const bf16x8*)(bp + 32 * ks);
            bf16x8 aa[4];
#pragma unroll
            for (int i = 0; i < 4; ++i) aa[i] = *(const bf16x8*)(ap + (size_t)(16 * i) * lda + 32 * ks);
#pragma unroll
            for (int i = 0; i < 4; ++i) acc[i] = MFMA16(bb, aa[i], acc[i]);
        }
#pragma unroll
        for (int i = 0; i < 4; ++i) red[(wv * 4 + i) * 64 + lane] = acc[i];
        __syncthreads();
        if (tid < 256) {
            const int i = tid >> 6; f32x4 s = red[i * 64 + lane];
#pragma unroll
            for (int w = 1; w < 8; ++w) s = s + red[(w * 4 + i) * 64 + lane];
            ef(64 * rb + 16 * i + fr, 16 * cb + 4 * fq, s);
        }
        __syncthreads();
    }
}

constexpr int PH_PER_LAYER = 15, N_PHASES = 1 + DEPTH * PH_PER_LAYER;
#define RUN_GEMM(EpiT, E, Aptr, lda_, Bptr, ldb_, K_, pm0_, nM_, nN_) do { const pg8::Gemm g_{(K_), (lda_), (ldb_)}; pg8::TileOrder S_; S_.init((Aptr), (lda_), (Bptr), (ldb_), (pm0_), (nM_), (nN_), G, bx); \
        pg8::gemm_phase<EpiT, pg8::TileOrder, true, true>(lds, g_, S_, (E)); } while (0)

__global__ void __launch_bounds__(NTHR, 2) fwd_kernel(Params p) {
    extern __shared__ __attribute__((aligned(16))) unsigned char lds_raw[];
#define PROJ ((bf16_t*)(ws + WS_PROJ))
#define H ((bf16_t*)(ws + WS_XB))
#define MERGED ((bf16_t*)(ws + WS_MERGED))
#define Y ((bf16_t*)(ws + WS_Y))
#define QB ((bf16_t*)(ws + WS_Q))
#define PB ((bf16_t*)(ws + WS_P))
#define OB ((bf16_t*)(ws + WS_O))
#define ACT ((bf16_t*)(ws + WS_ACT))

    {
        volatile LAS unsigned* st0 = (volatile LAS unsigned*)((LAS unsigned char*)lds_raw + LDS_MISC + 32);
        if (pg8::tid_() == 0) { st0[0] = 0u; st0[1] = 0u; st0[8] = 0u; st0[9] = 0u; }
        __syncthreads();
    }
    XcdBarrier xbar = xcd_barrier_post((unsigned*)(p.ws + WS_CTL) + CW_BAR, (volatile LAS unsigned*)((LAS unsigned char*)lds_raw + LDS_MISC + 32));
    if (p.ph_lo == 0) {
        prologue(p, (LAS unsigned char*)lds_raw);
        if (blockIdx.x == 0 && pg8::tid_() == 0) {
            const float** tab = (const float**)(p.ws + WS_TAB);
#pragma unroll
            for (int i = 0; i < N_IN; ++i) tab[i] = p.in[i];
        }
        if (p.ph_hi > 1) xcd_barrier(xbar);
        if (p.ph_hi < 0) cg::this_grid().sync();
    }
    for (int ph = p.ph_lo > 1 ? p.ph_lo : 1; ph < p.ph_hi; ++ph) {
        unsigned ldsb = (unsigned)(size_t)(LAS unsigned char*)lds_raw; asm volatile("" : "+s"(ldsb));
        LAS unsigned char* lds = (LAS unsigned char*)(size_t)ldsb;
        volatile LAS int* slot = (volatile LAS int*)(lds + LDS_MISC);
        unsigned char* ws = p.ws; asm volatile("" : "+s"(ws));
        Ctx c; c.ws = ws; c.in.t = (const float* const*)(ws + WS_TAB); c.out = p.out;
        unsigned* ctl = (unsigned*)(ws + WS_CTL);
        int G = gridDim.x, bx = blockIdx.x; asm volatile("" : "+s"(G), "+s"(bx));
        {
            const int l = (ph - 1) / PH_PER_LAYER, st = (ph - 1) % PH_PER_LAYER;
#ifdef PROBE_SEL
            if (bx == 0) { volatile LAS unsigned long long* a_ = (volatile LAS unsigned long long*)(lds + LDS_MISC + 64); a_[1] = __builtin_amdgcn_s_memrealtime(); }
#endif
            switch (st) {
            case 0: {
                EpiBf16 E{PROJ, NINP, 0xffff};
                RUN_GEMM(EpiBf16, E, H, D, ws + WS_WIN + l * SZ_WIN, D, D, 0, MA / 256, NINP / 256);
                if (l == 0) {
                    const pg8::Gemm g{D, D, D}; MemKvOrder S{G, bx, (const char*)(ws + WS_MN), (const char*)(ws + WS_WKV)};
                    EpiBf16 E2{(bf16_t*)(ws + WS_MKV), 2048, 7};
                    pg8::gemm_phase<EpiBf16, MemKvOrder, true, true>(lds, g, S, E2);
                }
            } break;
            case 1: {
                unsigned* ctr = ctl + 64 * ph;
                constexpr int U_SBP = 384, U_SBS = U_SBP + DB * 6, U_GLA = U_SBS + NGU, U_POOL = U_GLA + MA / 64, U_KV = U_POOL + MA / 64, U_MO = U_KV + 512, U_VT = U_MO + 512;
                const int U_ALL = l == 0 ? U_VT : U_KV;
                for (;;) {
                    const int u = next_work(ctr, slot); if (u >= U_ALL) break;
#ifdef PROBE_SEL
                    const int ut_ = u < DB * 6 ? 10 : (u < U_SBS ? 11 : (u < U_GLA ? 12 : 13));
                    if (bx == 0 && ut_ == PROBE_SEL) { volatile LAS unsigned long long* a_ = (volatile LAS unsigned long long*)(lds + LDS_MISC + 64); a_[3] = __builtin_amdgcn_s_memrealtime(); }
#endif
                    if (u < DB * 6) sb_sample_unit(c, l, u / 6, u % 6, lds);
                    else if (u < U_SBS) { const int v = u - DB * 6, qb = 7 - v / 48, bh = v % 48; sb_prompt_unit(c, bh / 6, bh % 6, qb, lds); }
                    else if (u < U_GLA) gla_stage1_unit(c, l, u - U_SBS, lds);
                    else if (u < U_POOL) pool_unit(c, l, u - U_GLA);
                    else if (u < U_KV) kvout_unit(c, l, u - U_POOL);
                    else if (u < U_MO) memout_unit(c, u - U_KV);
                    else memvt_unit(c, u - U_MO);
#ifdef PROBE_SEL
                    if (bx == 0 && ut_ == PROBE_SEL) { volatile LAS unsigned long long* a_ = (volatile LAS unsigned long long*)(lds + LDS_MISC + 64); __hip_atomic_fetch_add((LAS unsigned long long*)a_, __builtin_amdgcn_s_memrealtime() - a_[3], __ATOMIC_RELAXED, __HIP_MEMORY_SCOPE_WORKGROUP); }
#endif
                }
            } break;
            case 2: gla_scan(c, l); break;
            case 3: {
                unsigned* ctr = ctl + 64 * ph;
                for (;;) { const int u = next_work(ctr, slot); if (u >= NGU) break; gla_stage3_unit(c, l, u, lds); }
            } break;
            case 4: {
                EpiGate E1{MERGED, PROJ, C_GA, 0}, E2{MERGED, PROJ, C_GB, 1}, E3{MERGED, PROJ, C_GCG, 1};
                RUN_GEMM(EpiGate, E1, ws + WS_OA, 384, ws + WS_WBA + l * SZ_WBA, 384, 384, 0, MP / 256, 4);
                RUN_GEMM(EpiGate, E2, ws + WS_POOLED, 256, ws + WS_WBB + l * SZ_WBB, 256, 256, 0, MP / 256, 4);
                RUN_GEMM(EpiGate, E3, ws + WS_OC, 384, ws + WS_WBC + l * SZ_WBA, 384, 384, 0, MP / 256, 4);
                { SkGate F1{MERGED, PROJ, C_GA, 0}, F2{MERGED, PROJ, C_GB, 1}, F3{MERGED, PROJ, C_GCG, 1};
                  skinny_gemm((const bf16_t*)(ws + WS_OA) + (size_t)MP * 384, 384, (const bf16_t*)(ws + WS_WBA + l * SZ_WBA), 384, 384, D, G, bx, lds, F1);
                  skinny_gemm((const bf16_t*)(ws + WS_POOLED) + (size_t)MP * 256, 256, (const bf16_t*)(ws + WS_WBB + l * SZ_WBB), 256, 256, D, G, bx, lds, F2);
                  skinny_gemm((const bf16_t*)(ws + WS_OC) + (size_t)MP * 384, 384, (const bf16_t*)(ws + WS_WBC + l * SZ_WBA), 384, 384, D, G, bx, lds, F3); }
            } break;
            case 5: { EpiBf16 E{Y, D, 0xffff}; RUN_GEMM(EpiBf16, E, MERGED, D, ws + WS_WMIX + l * SZ_WSQ, D, D, 0, MP / 256, 4);
                SkBf16 F{Y, D}; skinny_gemm((const bf16_t*)MERGED + (size_t)MP * D, D, (const bf16_t*)(ws + WS_WMIX + l * SZ_WSQ), D, D, D, G, bx, lds, F); } break;
            case 6: norm_phase(c, c.in[I_NMIXPOST] + l * D, false, G, bx); break;
            case 7: { EpiBf16 E{QB, D, 0xffff}; RUN_GEMM(EpiBf16, E, H, D, ws + WS_WXQ + l * SZ_WSQ, D, D, 0, MP / 256, 4);
                SkBf16 F{QB, D}; skinny_gemm((const bf16_t*)H + (size_t)MP * D, D, (const bf16_t*)(ws + WS_WXQ + l * SZ_WSQ), D, D, D, G, bx, lds, F); } break;
            case 8: {
                const pg8::Gemm g{256, D, 2048}; CrossOrder S{G, bx, (const char*)QB, (const char*)(ws + WS_MKV + (size_t)l * 2 * SZ_WKV), 0};
                EpiSoftmax E{PB, (LAS float*)(lds + LDS_X)};
                pg8::gemm_phase<EpiSoftmax, CrossOrder, true, true>(lds, g, S, E);
            } break;
            case 9: {
                const pg8::Gemm g{256, D, 2048}; CrossOrder S{G, bx, (const char*)PB, (const char*)(ws + WS_MEMVT + (size_t)l * SZ_WKV), 1};
                EpiBf16 E{OB, D, 0xffff};
                pg8::gemm_phase<EpiBf16, CrossOrder, true, true>(lds, g, S, E);
                for (int u = bx; u < DB * 4 * 2; u += G) { __syncthreads(); cross_sample_unit(c, l, u >> 3, (u >> 1) & 3, u & 1, lds); }
            } break;
            case 10: { EpiBf16 E{Y, D, 0xffff}; RUN_GEMM(EpiBf16, E, OB, D, ws + WS_WXO + l * SZ_WSQ, D, D, 0, MP / 256, 4);
                SkBf16 F{Y, D}; skinny_gemm((const bf16_t*)OB + (size_t)MP * D, D, (const bf16_t*)(ws + WS_WXO + l * SZ_WSQ), D, D, D, G, bx, lds, F); } break;
            case 11: norm_phase(c, c.in[I_NXPOST] + l * D, false, G, bx); break;
            case 12: { EpiSwiglu E{ACT}; RUN_GEMM(EpiSwiglu, E, H, D, ws + WS_WF1 + l * SZ_WF1, D, D, 0, MA / 256, FF2 / 256); } break;
            case 13: { EpiBf16 E{Y, D, 0xffff}; RUN_GEMM(EpiBf16, E, ACT, FF, ws + WS_WF2 + l * SZ_WF2, FF, FF, 0, MP / 256, 4);
                SkBf16 F{Y, D}; skinny_gemm((const bf16_t*)ACT + (size_t)MP * FF, FF, (const bf16_t*)(ws + WS_WF2 + l * SZ_WF2), FF, FF, D, G, bx, lds, F); } break;
            default: norm_phase(c, c.in[I_NFPOST] + l * D, l == DEPTH - 1, G, bx); break;
            }
#ifdef PROBE_SEL
            {
                const int sel = PROBE_SEL; bool hit = false;
                if (sel == 2) hit = (st == 0 || st == 4 || st == 5 || st == 7 || st == 10 || st == 12 || st == 13);
                if (sel == 3) hit = (st == 2 || st == 3);
                if (sel == 4) hit = (st == 8 || st == 9);
                if (sel == 5) hit = (st == 6 || st == 11 || st == 14);
                if (sel == 6) hit = (st == 1);
                if (sel == 7) hit = (st == 0);
                if (sel == 8) hit = (st == 12);
                if (sel == 9) hit = (st == 13);
                if (bx == 0 && hit) { volatile LAS unsigned long long* a_ = (volatile LAS unsigned long long*)(lds + LDS_MISC + 64); __hip_atomic_fetch_add((LAS unsigned long long*)a_, __builtin_amdgcn_s_memrealtime() - a_[1], __ATOMIC_RELAXED, __HIP_MEMORY_SCOPE_WORKGROUP); }
            }
#endif
        }
#ifdef PROBE_SEL
        if (bx == 0) { volatile LAS unsigned long long* a_ = (volatile LAS unsigned long long*)(lds + LDS_MISC + 64); a_[2] = __builtin_amdgcn_s_memrealtime(); }
#endif
        if (ph + 1 < p.ph_hi) { if ((ph - 1) % PH_PER_LAYER == 8) { __threadfence(); __syncthreads(); } else xcd_barrier(xbar); }
#ifdef PROBE_SEL
        if (PROBE_SEL == 1 && bx == 0) { volatile LAS unsigned long long* a_ = (volatile LAS unsigned long long*)(lds + LDS_MISC + 64); __hip_atomic_fetch_add((LAS unsigned long long*)a_, __builtin_amdgcn_s_memrealtime() - a_[2], __ATOMIC_RELAXED, __HIP_MEMORY_SCOPE_WORKGROUP); }
#endif
    }
#ifdef PROBE_SEL
    __syncthreads();
    if (blockIdx.x == 0) {
        volatile LAS unsigned long long* a_ = (volatile LAS unsigned long long*)((LAS unsigned char*)lds_raw + LDS_MISC + 64);
        const unsigned long long d_ = a_[0] >> 9, s_ = __builtin_amdgcn_s_memrealtime();
        while (__builtin_amdgcn_s_memrealtime() - s_ < d_) __builtin_amdgcn_s_sleep(8);
    }
#endif
}

extern "C" void kernel_launch(void* const* d_in, const int* in_sizes, int n_in, void* d_out, int out_size, void* d_ws, size_t ws_size, hipStream_t stream) {
    static int grid = 0;
    if (grid == 0) {
        if (n_in != N_IN || (size_t)out_size != O_END || ws_size < WS_END) { fprintf(stderr, "kernel_launch: unexpected shapes: n_in %d out %d ws %zu (need %zu)\n", n_in, out_size, ws_size, (size_t)WS_END); grid = -1; return; }
        int dev = 0, cus = 0, per_cu = 0;
        (void)hipGetDevice(&dev); (void)hipDeviceGetAttribute(&cus, hipDeviceAttributeMultiprocessorCount, dev);
        (void)hipFuncSetAttribute((const void*)fwd_kernel, hipFuncAttributeMaxDynamicSharedMemorySize, LDS_BYTES);
        if (hipOccupancyMaxActiveBlocksPerMultiprocessor(&per_cu, (const void*)fwd_kernel, NTHR, LDS_BYTES) != hipSuccess || per_cu < 1) { fprintf(stderr, "kernel_launch: occupancy query gave %d\n", per_cu); per_cu = 1; }
        (void)hipGetLastError();
        grid = cus * per_cu;
    }
    if (grid < 0) return;
    (void)hipMemsetAsync((char*)d_ws + WS_CTL, 0, CTL_BYTES, stream);
    Params p{};
    for (int i = 0; i < N_IN; ++i) p.in[i] = (const float*)d_in[i];
    p.out = (float*)d_out; p.ws = (unsigned char*)d_ws;
#ifdef MULTI_LAUNCH
    for (int ph = 0; ph < N_PHASES; ++ph) { p.ph_lo = ph; p.ph_hi = ph + 1; hipLaunchKernelGGL(fwd_kernel, dim3(grid), dim3(NTHR), LDS_BYTES, stream, p); }
#else
    p.ph_lo = 0; p.ph_hi = N_PHASES;
    void* args[] = {&p};
    const hipError_t e = hipLaunchCooperativeKernel((const void*)fwd_kernel, dim3(grid), dim3(NTHR), args, LDS_BYTES, stream);
    if (e != hipSuccess) fprintf(stderr, "kernel_launch: cooperative launch failed: %s (grid %d)\n", hipGetErrorString(e), grid);
#endif
}
```

```cpp
#include <hip/hip_runtime.h>
#include <hip/hip_cooperative_groups.h>
#include <cstdio>
#include <cstdint>
namespace cg = cooperative_groups;

namespace pg8 {
#define PG8_LAS __attribute__((address_space(3)))
typedef unsigned short bf16_t;
typedef short bf16x8 __attribute__((ext_vector_type(8)));
typedef float f32x4 __attribute__((ext_vector_type(4)));
typedef unsigned u32x4 __attribute__((ext_vector_type(4)));
typedef unsigned u32x2 __attribute__((ext_vector_type(2)));
constexpr int BM = 256, BK = 64, HALF = 128, HTB = HALF * BK * 2  , STAGE_BYTES = 8 * HTB, NXCD = 8, WGM = 8;

__host__ __device__ __forceinline__ int lds_byte(int r, int c) { const int st = (r >> 4) * 2 + (c >> 5), rr = r & 15, cc = c & 31, ob = rr * 64 + cc * 2; return st * 1024 + (ob ^ (((ob >> 9) & 1) << 5)); }
__host__ __device__ __forceinline__ void stage_rc(int b, int& R, int& C) { const int st = b / 1024, sb = b % 1024, swz = sb ^ (((sb >> 9) & 1) << 5); R = (st >> 1) * 16 + swz / 64; C = (st & 1) * 32 + (swz % 64) / 2; }
__host__ __device__ __forceinline__ int perm32(int rho) { const int n = rho >> 4, i = rho & 15; return 8 * (i >> 2) + 4 * n + (i & 3); }

struct Unit { int pm, pn; const char* a; const char* b; };
struct Gemm { int K, lda, ldb; };

struct TileOrder {
    int nM, nN, G, c, lda, ldb; const char* A; const char* B;
    __device__ void init(const void* A_, int lda_, const void* B_, int ldb_, int, int nM_, int nN_, int G_, int c_) {
        A = (const char*)A_; B = (const char*)B_; lda = lda_; ldb = ldb_; nM = nM_; nN = nN_; G = G_; c = c_; }
    __device__ bool next(int i, Unit& u) const {
        const int nwg = nM * nN; const long L = (long)i * G + c; if (L >= nwg) return false;
        int wgid = (int)L; { const int q = nwg / NXCD, r = nwg % NXCD, xcd = wgid % NXCD, off = wgid / NXCD; wgid = (xcd < r ? xcd * (q + 1) : r * (q + 1) + (xcd - r) * q) + off; }
        const int nig = WGM * nN, gid = wgid / nig, fm = gid * WGM, gsz = (nM - fm) < WGM ? (nM - fm) : WGM;
        u.pm = fm + ((wgid % nig) % gsz); u.pn = (wgid % nig) / gsz; u.a = A + (size_t)u.pm * ((size_t)BM * 2 * lda); u.b = B + (size_t)u.pn * ((size_t)BM * 2 * ldb); return true;
    }
    __device__ __forceinline__ void a_ready(const Unit&) const {}
    __device__ __forceinline__ void done(const Unit&) const {}
};

__device__ __forceinline__ int tid_() { int t = threadIdx.x; asm volatile("" : "+v"(t)); return t; }
__device__ __forceinline__ unsigned cvt_pk_bf16(float lo, float hi) { unsigned r; asm volatile("v_cvt_pk_bf16_f32 %0, %1, %2" : "=v"(r) : "v"(lo), "v"(hi)); return r; }

template <class Epi, class Sched, bool ALIGN_EPI = false, bool SP2 = false>
__device__ __forceinline__ void gemm_phase(PG8_LAS unsigned char* lds, const Gemm g, const Sched& S, const Epi& E) {
    const int tid = pg8::tid_(), wid = __builtin_amdgcn_readfirstlane(tid >> 6), lane = tid & 63, wr = wid >> 2, wc = wid & 3, fr = lane & 15, fq = lane >> 4;
    const int K = g.K, nt = K / BK;
    unsigned voffA, voffB;
    { int R, C; stage_rc(tid * 16, R, C); const int Rb = Epi::PERM ? ((R & ~31) + perm32(R & 31)) : R;
        voffA = (unsigned)(R * g.lda + C) * 2u; voffB = (unsigned)(Rb * g.ldb + C) * 2u; }
    const size_t qstepA = (size_t)64 * g.lda * 2, qstepB = (size_t)64 * g.ldb * 2;
    const size_t kstep = (size_t)(BK * 2);
    const size_t hstepA = (size_t)HALF * g.lda * 2, hstepB = (size_t)HALF * g.ldb * 2;
    const unsigned ldsw = (unsigned)wid * 1024u;
    const int aoff = lds_byte(wr * 64 + fr, fq * 8), boff = lds_byte(wc * 32 + fr, fq * 8);
#define PG8_SA(b, h) (((b) * 2 + (h)) * HTB)
#define PG8_SB(b, h) ((4 + (b) * 2 + (h)) * HTB)
#define PG8_STAGE(bufoff, gbase, voff) do { _Pragma("unroll") for (int _i = 0; _i < 2; ++_i) { const char* sb_ = (const char*)(gbase) + (size_t)_i * q##voff; asm volatile("" : "+s"(sb_));   \
        __builtin_amdgcn_global_load_lds((const unsigned*)(sb_ + (voff)), (PG8_LAS unsigned*)(lds + (bufoff) + ldsw + _i * 8192), 16, 0, 0); } } while (0)
#define qvoffA qstepA
#define qvoffB qstepB
#define PG8_LDA(dst, b, h) do { _Pragma("unroll") for (int m = 0; m < 4; ++m) _Pragma("unroll") for (int k = 0; k < 2; ++k) dst[m][k] = *(const PG8_LAS bf16x8*)(lds + PG8_SA(b, h) + aoff + m * 2048 + k * 1024); } while (0)
#define PG8_LDB(dst, b, h) do { _Pragma("unroll") for (int n = 0; n < 2; ++n) _Pragma("unroll") for (int k = 0; k < 2; ++k) dst[n][k] = *(const PG8_LAS bf16x8*)(lds + PG8_SB(b, h) + boff + n * 2048 + k * 1024); } while (0)
#define PG8_MMA(ai, bj, At, Bt) do { __builtin_amdgcn_s_setprio(1); _Pragma("unroll") for (int m = 0; m < 4; ++m) _Pragma("unroll") for (int n = 0; n < 2; ++n) _Pragma("unroll") for (int k = 0; k < 2; ++k) \
        acc[ai][bj][m][n] = __builtin_amdgcn_mfma_f32_16x16x32_bf16(Bt[n][k], At[m][k], acc[ai][bj][m][n], 0, 0, 0); __builtin_amdgcn_s_setprio(0); } while (0)
#define PG8_WAIT_V(n) asm volatile("s_waitcnt vmcnt(" #n ")" ::: "memory")
#define PG8_WAIT_L(n) asm volatile("s_waitcnt lgkmcnt(" #n ")" ::: "memory")
#define PG8_BAR __builtin_amdgcn_s_barrier()
#define PG8_SCHED __builtin_amdgcn_sched_barrier(0)
    Unit cur, nxt; int ui = 0;
    if (!S.next(0, cur)) return;
    f32x4 acc[2][2][4][2];
#pragma unroll
    for (int a = 0; a < 2; ++a)
#pragma unroll
        for (int b = 0; b < 2; ++b)
#pragma unroll
            for (int m = 0; m < 4; ++m)
#pragma unroll
                for (int n = 0; n < 2; ++n) acc[a][b][m][n] = (f32x4){0.f, 0.f, 0.f, 0.f};
    bf16x8 At[4][2], B0[2][2], B1[2][2];
    const char* cA = cur.a; const char* cB = cur.b;
    S.a_ready(cur);
    if constexpr (SP2) {
        PG8_STAGE(PG8_SB(0, 0), cB, voffB); PG8_STAGE(PG8_SB(0, 1), cB + hstepB, voffB); PG8_STAGE(PG8_SA(0, 0), cA, voffA); PG8_STAGE(PG8_SA(0, 1), cA + hstepA, voffA);
        if (wr == 1) PG8_BAR;
        PG8_WAIT_V(2); PG8_BAR;
        PG8_STAGE(PG8_SB(1, 0), cB + kstep, voffB); PG8_STAGE(PG8_SA(1, 0), cA + kstep, voffA); PG8_STAGE(PG8_SB(1, 1), cB + hstepB + kstep, voffB);
        PG8_WAIT_V(6); PG8_BAR;
    } else {
        PG8_STAGE(PG8_SB(0, 0), cB, voffB); PG8_STAGE(PG8_SA(0, 0), cA, voffA); PG8_STAGE(PG8_SB(0, 1), cB + hstepB, voffB); PG8_STAGE(PG8_SA(0, 1), cA + hstepA, voffA);
        if (wr == 1) PG8_BAR;
        PG8_WAIT_V(4); PG8_BAR;
        PG8_STAGE(PG8_SB(1, 0), cB + kstep, voffB); PG8_STAGE(PG8_SA(1, 0), cA + kstep, voffA); PG8_STAGE(PG8_SB(1, 1), cB + hstepB + kstep, voffB);
        PG8_WAIT_V(6); PG8_BAR;
    }
    for (;;) {
        const bool has_next = S.next(ui + 1, nxt);
        const char* nA = has_next ? nxt.a : cA; const char* nB = has_next ? nxt.b : cB;
        for (int t = 0; t < nt; t += 2) {
            const bool last = (t == nt - 2);
            const char* a1 = cA + (size_t)(t + 1) * kstep;
            const char* a2 = last ? nA : cA + (size_t)(t + 2) * kstep; const char* b2 = last ? nB : cB + (size_t)(t + 2) * kstep;
            const char* a3 = a2 + kstep; const char* b3 = b2 + kstep;
            if (last && has_next) S.a_ready(nxt);
            if constexpr (SP2) {
            PG8_LDB(B0, 0, 0); PG8_LDB(B1, 0, 1); PG8_SCHED; PG8_LDA(At, 0, 0); PG8_STAGE(PG8_SA(1, 1), a1 + hstepA, voffA);
            PG8_WAIT_V(8); PG8_WAIT_L(0); PG8_BAR; PG8_MMA(0, 0, At, B0); PG8_MMA(0, 1, At, B1); PG8_BAR; PG8_SCHED;
            PG8_LDA(At, 0, 1); PG8_STAGE(PG8_SB(0, 0), b2, voffB); PG8_STAGE(PG8_SB(0, 1), b2 + hstepB, voffB); PG8_STAGE(PG8_SA(0, 0), a2, voffA);
            PG8_WAIT_V(8); PG8_WAIT_L(0); PG8_BAR; PG8_MMA(1, 0, At, B0); PG8_MMA(1, 1, At, B1); PG8_BAR; PG8_SCHED;
            PG8_LDB(B0, 1, 0); PG8_LDB(B1, 1, 1); PG8_SCHED; PG8_LDA(At, 1, 0); PG8_STAGE(PG8_SA(0, 1), a2 + hstepA, voffA);
            PG8_WAIT_V(8); PG8_WAIT_L(0); PG8_BAR; PG8_MMA(0, 0, At, B0); PG8_MMA(0, 1, At, B1); PG8_BAR; PG8_SCHED;
            PG8_LDA(At, 1, 1); PG8_STAGE(PG8_SB(1, 0), b3, voffB); PG8_STAGE(PG8_SB(1, 1), b3 + hstepB, voffB); PG8_STAGE(PG8_SA(1, 0), a3, voffA);
            PG8_WAIT_V(8); PG8_WAIT_L(0); PG8_BAR; PG8_MMA(1, 0, At, B0); PG8_MMA(1, 1, At, B1); PG8_BAR; PG8_SCHED;
            } else {
            PG8_LDB(B0, 0, 0); PG8_SCHED; PG8_LDA(At, 0, 0); PG8_STAGE(PG8_SA(1, 1), a1 + hstepA, voffA);
            PG8_WAIT_L(8); PG8_BAR; PG8_WAIT_L(0); PG8_MMA(0, 0, At, B0); PG8_BAR; PG8_SCHED;
            PG8_LDB(B1, 0, 1); PG8_STAGE(PG8_SB(0, 0), b2, voffB);
            PG8_BAR; PG8_WAIT_L(0); PG8_MMA(0, 1, At, B1); PG8_BAR;
            PG8_LDA(At, 0, 1); PG8_STAGE(PG8_SA(0, 0), a2, voffA);
            PG8_BAR; PG8_WAIT_L(0); PG8_MMA(1, 0, At, B0); PG8_BAR; PG8_SCHED;
            PG8_STAGE(PG8_SB(0, 1), b2 + hstepB, voffB);
            PG8_WAIT_V(6); PG8_BAR; PG8_MMA(1, 1, At, B1); PG8_BAR;
            PG8_LDB(B0, 1, 0); PG8_SCHED; PG8_LDA(At, 1, 0); PG8_STAGE(PG8_SA(0, 1), a2 + hstepA, voffA);
            PG8_WAIT_L(8); PG8_BAR; PG8_WAIT_L(0); PG8_MMA(0, 0, At, B0); PG8_BAR; PG8_SCHED;
            PG8_LDB(B1, 1, 1); PG8_STAGE(PG8_SB(1, 0), b3, voffB);
            PG8_BAR; PG8_WAIT_L(0); PG8_MMA(0, 1, At, B1); PG8_BAR;
            PG8_LDA(At, 1, 1); PG8_STAGE(PG8_SA(1, 0), a3, voffA);
            PG8_BAR; PG8_WAIT_L(0); PG8_MMA(1, 0, At, B0); PG8_BAR; PG8_SCHED;
            PG8_STAGE(PG8_SB(1, 1), b3 + hstepB, voffB);
            PG8_WAIT_V(6); PG8_BAR; PG8_MMA(1, 1, At, B1); PG8_BAR;
            }
        }
        if constexpr (ALIGN_EPI) { if (wr == 0) PG8_BAR; }
        if constexpr (!Epi::AFTER_DRAIN) { const int l2_ = tid_() & 63, fr2 = l2_ & 15, fq2 = l2_ >> 4;   E(acc, cur, wr, wc, fr2, fq2); S.done(cur); }
        if (!has_next) break;
#pragma unroll
        for (int a = 0; a < 2; ++a)
#pragma unroll
            for (int b = 0; b < 2; ++b)
#pragma unroll
                for (int m = 0; m < 4; ++m)
#pragma unroll
                    for (int n = 0; n < 2; ++n) acc[a][b][m][n] = (f32x4){0.f, 0.f, 0.f, 0.f};
        cur = nxt; cA = nA; cB = nB; ++ui;
        if constexpr (ALIGN_EPI) { if (wr == 1) PG8_BAR; }
    }
    PG8_WAIT_V(0);
    if constexpr (!ALIGN_EPI) { if (wr == 0) PG8_BAR; }
    PG8_BAR;
    if constexpr (Epi::AFTER_DRAIN) { E.fused(acc, cur, wr, wc, fr, fq, lds, wid, lane); S.done(cur); }
#undef PG8_SA
#undef PG8_SB
#undef PG8_STAGE
#undef qvoffA
#undef qvoffB
#undef PG8_LDA
#undef PG8_LDB
#undef PG8_MMA
#undef PG8_WAIT_V
#undef PG8_WAIT_L
#undef PG8_BAR
#undef PG8_SCHED
}
}

using pg8::bf16_t; using pg8::f32x4; using pg8::bf16x8; using pg8::u32x4; using pg8::u32x2;
#define DI __device__ __forceinline__
#define LAS __attribute__((address_space(3)))
typedef float f32x16 __attribute__((ext_vector_type(16)));
typedef short s16x4 __attribute__((ext_vector_type(4)));
typedef float f32x2_t __attribute__((ext_vector_type(2))); typedef __bf16 bf16x2_t __attribute__((ext_vector_type(2)));

constexpr int NTHR = 512, NWAVES = 8;
constexpr int D = 1024, NB = 8, SEQ = 2048, DEPTH = 4, DB = 16, DT = 16, PAST = 1024;
constexpr int MP = NB * SEQ, MS = DB * DT, MA = MP + MS;
constexpr int NIN = 6032, NINP = 6144;
constexpr int C_QA = 0, C_KA = 384, C_VA = 768, C_U = 1152, C_QC = 1408, C_KC = 1792, C_VC = 2176, C_GC = 2560, C_LR = 2944, C_GA = 2960, C_GB = 3984, C_GCG = 5008;
constexpr int FF = 2816, FF2 = 5632;
constexpr int GH = 4, GK = 96;
constexpr int NGU_P = NB * GH * 32, NGU_S = DB * GH, NGU = NGU_P + NGU_S;
constexpr float EPS = 1e-6f;

constexpr size_t O_YP = 0, O_YS = O_YP + (size_t)MP * D, O_KP = O_YS + (size_t)MS * D, O_VP = O_KP + (size_t)DEPTH * MP * 384, O_POOLP = O_VP + (size_t)DEPTH * MP * 384,
    O_GLAP = O_POOLP + (size_t)DEPTH * NB * 15 * 256, O_MKP = O_GLAP + (size_t)DEPTH * NB * GH * GK * GK, O_MVP = O_MKP + (size_t)DEPTH * NB * 256 * D,
    O_KS = O_MVP + (size_t)DEPTH * NB * 256 * D, O_VS = O_KS + (size_t)DEPTH * MS * 384, O_POOLS = O_VS + (size_t)DEPTH * MS * 384, O_GLAS = O_POOLS + (size_t)DEPTH * DB * 15 * 256,
    O_END = O_GLAS + (size_t)DEPTH * DB * GH * GK * GK;

enum { I_XP = 0, I_XS, I_MEM, I_CSK, I_CSV, I_SPOOL, I_SGLA, I_CMK, I_CMV, I_WIN, I_WA2, I_BA, I_GLAN, I_WPOOL, I_PSCALE, I_WBA, I_WBB, I_WBC, I_WMIX, I_MEMN, I_WXQ, I_WXK, I_WXV, I_WXO,
       I_WF1, I_WF2, I_NMIXPRE, I_NMIXPOST, I_NXPRE, I_NXPOST, I_NFPRE, I_NFPOST, N_IN };

constexpr size_t MiB = 1u << 20;
constexpr size_t SZ_WIN = (size_t)NINP * D * 2, SZ_WBA = (size_t)D * 384 * 2, SZ_WBB = (size_t)D * 256 * 2, SZ_WSQ = (size_t)D * D * 2, SZ_WKV = 2 * SZ_WSQ, SZ_WF1 = (size_t)FF2 * D * 2, SZ_WF2 = (size_t)D * FF * 2;
constexpr size_t WS_CTL = 0, CTL_BYTES = 1 * MiB, WS_TAB = CTL_BYTES - 4096;
constexpr size_t WS_WIN = WS_CTL + CTL_BYTES, WS_WBA = WS_WIN + 4 * SZ_WIN, WS_WBB = WS_WBA + 4 * SZ_WBA, WS_WBC = WS_WBB + 4 * SZ_WBB, WS_WMIX = WS_WBC + 4 * SZ_WBA,
    WS_WXQ = WS_WMIX + 4 * SZ_WSQ, WS_WXO = WS_WXQ + 4 * SZ_WSQ, WS_WKV = WS_WXO + 4 * SZ_WSQ, WS_WF1 = WS_WKV + 4 * SZ_WKV, WS_WF2 = WS_WF1 + 4 * SZ_WF1,
    WS_MN = WS_WF2 + 4 * SZ_WF2, WS_MKV = WS_MN + 4 * SZ_WKV, WS_MEMVT = WS_MKV + 8 * SZ_WKV, WS_PROJ = WS_MEMVT + 4 * SZ_WKV;
constexpr size_t SZ_ROWS = (size_t)MA * D * 2;
constexpr size_t SZ_PROJ = (size_t)MA * NINP * 2;
constexpr size_t WS_Q = WS_PROJ, WS_P = WS_Q + SZ_ROWS, WS_O = WS_P + SZ_ROWS, WS_ACT = WS_O + SZ_ROWS;
static_assert(WS_ACT + (size_t)MA * FF * 2 <= WS_PROJ + SZ_PROJ, "overlay fits");
constexpr size_t WS_H = WS_PROJ + SZ_PROJ, WS_MERGED = WS_H + SZ_ROWS, WS_Y = WS_MERGED + SZ_ROWS;
constexpr size_t WS_GKV = WS_H, WS_GSP = WS_GKV + 39 * MiB, WS_GDEC = WS_GSP + 37 * MiB;
static_assert((size_t)NGU * GK * GK * 4 <= 39 * MiB && (size_t)NGU_P * GK * GK * 4 <= 37 * MiB && WS_GDEC + (size_t)NGU * GK * 4 <= WS_Y + SZ_ROWS, "GLA overlay fits");
constexpr size_t WS_OA = WS_Y + SZ_ROWS, WS_POOLED = WS_OA + (size_t)MA * 384 * 2, WS_OC = WS_POOLED + (size_t)MA * 256 * 2, WS_BB = WS_OC + (size_t)MA * 384 * 2, WS_XB = WS_BB + (size_t)NGU * 64 * GK * 4, WS_RN = WS_XB + SZ_ROWS, WS_END = WS_RN + (size_t)MA * 4;
static_assert(WS_WIN % 256 == 0 && WS_PROJ % 256 == 0 && WS_H % 256 == 0 && WS_OA % 256 == 0 && WS_POOLED % 256 == 0 && WS_OC % 256 == 0 && WS_P % 256 == 0, "alignment");

constexpr int CW_BAR = 16384;
constexpr int LDS_GEMM = 131072, LDS_X = LDS_GEMM, LDS_X_BYTES = 12288, LDS_MISC = LDS_X + LDS_X_BYTES, LDS_BYTES = LDS_MISC + 256;

struct Params { const float* in[N_IN]; float* out; unsigned char* ws; int ph_lo, ph_hi; };
struct InTab { const float* const* t;
    __device__ __forceinline__ const float* operator[](int i) const { const unsigned long long v = (unsigned long long)t[i];
        const unsigned lo = __builtin_amdgcn_readfirstlane((unsigned)v), hi = __builtin_amdgcn_readfirstlane((unsigned)(v >> 32)); return (const float*)(((unsigned long long)hi << 32) | lo); } };
struct Ctx { InTab in; float* out; unsigned char* ws; };

DI float bflo(unsigned w) { return __uint_as_float(w << 16); }
DI float bfhi(unsigned w) { return __uint_as_float(w & 0xffff0000u); }
DI float bf2f(unsigned short v) { return __uint_as_float((unsigned)v << 16); }
DI unsigned pk2(float lo, float hi) { f32x2_t v = {lo, hi}; bf16x2_t b = __builtin_convertvector(v, bf16x2_t); return __builtin_bit_cast(unsigned, b); }
DI unsigned short f2bf(float f) { return (unsigned short)(pk2(f, 0.f) & 0xffffu); }
DI float wave_sum(float v) {
#pragma unroll
    for (int o = 1; o < 64; o <<= 1) v += __shfl_xor(v, o);
    return v;
}
DI float wave_max(float v) {
#pragma unroll
    for (int o = 1; o < 64; o <<= 1) v = fmaxf(v, __shfl_xor(v, o));
    return v;
}
DI float sigmoidf_(float x) { return __builtin_amdgcn_rcpf(1.f + __expf(-x)); }
DI float softplusf_(float z) { return fmaxf(z, 0.f) + __logf(1.f + __expf(-fabsf(z))); }
DI int next_work(unsigned* ctr, volatile LAS int* slot) {
    __syncthreads();
    if (pg8::tid_() == 0) *slot = (int)atomicAdd(ctr, 1u);
    __syncthreads();
    return *slot;
}

typedef const pg8::f32x4 (&AccRef)[2][2][4][2];
struct EpiBf16 {
    static constexpr bool PERM = true, AFTER_DRAIN = false;
    bf16_t* O; int ldc; int pnmask;
    DI void operator()(AccRef acc, const pg8::Unit& u, int wr, int wc, int fr, int fq) const {
#pragma unroll
        for (int ai = 0; ai < 2; ++ai)
#pragma unroll
            for (int m = 0; m < 4; ++m) {
                bf16_t* rowp = O + (size_t)(u.pm * 256 + ai * 128 + wr * 64 + m * 16 + fr) * ldc + (u.pn & pnmask) * 256 + wc * 32 + 8 * fq;
#pragma unroll
                for (int bj = 0; bj < 2; ++bj) {
                    const f32x4 v0 = acc[ai][bj][m][0], v1 = acc[ai][bj][m][1];
                    u32x4 w; w.x = pk2(v0[0], v0[1]); w.y = pk2(v0[2], v0[3]); w.z = pk2(v1[0], v1[1]); w.w = pk2(v1[2], v1[3]);
                    *(u32x4*)(rowp + bj * 128) = w;
                }
            }
    }
};
struct EpiGate {
    static constexpr bool PERM = true, AFTER_DRAIN = false;
    bf16_t* merged; const bf16_t* proj; int goff; int accum;
    DI void operator()(AccRef acc, const pg8::Unit& u, int wr, int wc, int fr, int fq) const {
#pragma unroll
        for (int ai = 0; ai < 2; ++ai)
#pragma unroll
            for (int m = 0; m < 4; ++m) {
                const int row = u.pm * 256 + ai * 128 + wr * 64 + m * 16 + fr;
                const bf16_t* gp = proj + (size_t)row * NINP + goff + u.pn * 256 + wc * 32 + 8 * fq;
                bf16_t* mp = merged + (size_t)row * D + u.pn * 256 + wc * 32 + 8 * fq;
                u32x4 g[2], pm4[2];
#pragma unroll
                for (int bj = 0; bj < 2; ++bj) { g[bj] = *(const u32x4*)(gp + bj * 128); pm4[bj] = (u32x4){0u, 0u, 0u, 0u}; if (accum) pm4[bj] = *(const u32x4*)(mp + bj * 128); }
#pragma unroll
                for (int bj = 0; bj < 2; ++bj) {
                    const f32x4 v0 = acc[ai][bj][m][0], v1 = acc[ai][bj][m][1];
                    u32x4 w;
                    w.x = pk2(sigmoidf_(bflo(g[bj].x)) * v0[0] + bflo(pm4[bj].x), sigmoidf_(bfhi(g[bj].x)) * v0[1] + bfhi(pm4[bj].x));
                    w.y = pk2(sigmoidf_(bflo(g[bj].y)) * v0[2] + bflo(pm4[bj].y), sigmoidf_(bfhi(g[bj].y)) * v0[3] + bfhi(pm4[bj].y));
                    w.z = pk2(sigmoidf_(bflo(g[bj].z)) * v1[0] + bflo(pm4[bj].z), sigmoidf_(bfhi(g[bj].z)) * v1[1] + bfhi(pm4[bj].z));
                    w.w = pk2(sigmoidf_(bflo(g[bj].w)) * v1[2] + bflo(pm4[bj].w), sigmoidf_(bfhi(g[bj].w)) * v1[3] + bfhi(pm4[bj].w));
                    *(u32x4*)(mp + bj * 128) = w;
                }
                if (m & 1) asm volatile("" ::: "memory");
            }
    }
};
struct EpiSwiglu {
    static constexpr bool PERM = true, AFTER_DRAIN = false;
    bf16_t* act;
    DI void operator()(AccRef acc, const pg8::Unit& u, int wr, int wc, int fr, int fq) const {
#pragma unroll
        for (int ai = 0; ai < 2; ++ai)
#pragma unroll
            for (int m = 0; m < 4; ++m) {
                const int row = u.pm * 256 + ai * 128 + wr * 64 + m * 16 + fr;
#pragma unroll
                for (int bj = 0; bj < 2; ++bj) {
                    const int col0 = u.pn * 256 + bj * 128 + wc * 32 + 8 * fq;
                    const f32x4 g = acc[ai][bj][m][0], up = acc[ai][bj][m][1];
                    float r[4];
#pragma unroll
                    for (int j = 0; j < 4; ++j) r[j] = g[j] * sigmoidf_(g[j]) * up[j];
                    u32x2 w; w.x = pk2(r[0], r[1]); w.y = pk2(r[2], r[3]);
                    *(u32x2*)(act + (size_t)row * FF + (col0 >> 1)) = w;
                }
            }
    }
};
struct MemKvOrder {
    int G, c; const char* A; const char* B;
    DI bool next(int i, pg8::Unit& u) const {
        const int L = i * G + c; if (L >= 256) return false;
        const int l = L >> 6, r = L & 63; u.pm = l * 8 + (r & 7); u.pn = l * 8 + (r >> 3);
        u.a = A + (size_t)u.pm * (256 * D * 2); u.b = B + (size_t)u.pn * (256 * D * 2); return true;
    }
    DI void a_ready(const pg8::Unit&) const {}
    DI void done(const pg8::Unit&) const {}
};
struct CrossOrder {
    int G, c; const char* A; const char* B; int mode;
    DI bool next(int i, pg8::Unit& u) const {
        const int L = i * G + c; if (L >= 256) return false;
        u.pm = L >> 2; u.pn = L & 3; const int b = u.pm >> 3, h = u.pn;
        u.a = A + ((size_t)u.pm * 256 * D + h * 256) * 2;
        u.b = mode == 0 ? B + ((size_t)b * 256 * 2048 + h * 256) * 2 : B + ((size_t)h * 256 * 2048 + b * 256) * 2;
        return true;
    }
    DI void a_ready(const pg8::Unit&) const {}
    DI void done(const pg8::Unit&) const {}
};
struct EpiSoftmax {
    static constexpr bool PERM = true, AFTER_DRAIN = false;
    bf16_t* P; LAS float* xs;
    DI void operator()(AccRef acc, const pg8::Unit& u, int wr, int wc, int fr, int fq) const {
        const float sc = 0.0625f * 1.4426950408889634f;
        LAS float* xm = xs; LAS float* xsum = xs + 1024;
#pragma unroll
        for (int ai = 0; ai < 2; ++ai)
#pragma unroll
            for (int m = 0; m < 4; ++m) {
                float a = -3.0e38f;
#pragma unroll
                for (int bj = 0; bj < 2; ++bj)
#pragma unroll
                    for (int n = 0; n < 2; ++n) { const f32x4 v = acc[ai][bj][m][n]; a = fmaxf(a, fmaxf(fmaxf(v[0], v[1]), fmaxf(v[2], v[3]))); }
                a = fmaxf(a, __shfl_xor(a, 16)); a = fmaxf(a, __shfl_xor(a, 32));
                if (fq == 0) xm[(ai * 128 + wr * 64 + m * 16 + fr) * 4 + wc] = a;
                asm volatile("" ::: "memory");
            }
        __syncthreads();
#pragma unroll
        for (int ai = 0; ai < 2; ++ai)
#pragma unroll
            for (int m = 0; m < 4; ++m) {
                const f32x4 t = *(LAS f32x4*)(xm + (ai * 128 + wr * 64 + m * 16 + fr) * 4); const float mx = fmaxf(fmaxf(t[0], t[1]), fmaxf(t[2], t[3])) * sc;
                float s = 0.f;
#pragma unroll
                for (int bj = 0; bj < 2; ++bj)
#pragma unroll
                    for (int n = 0; n < 2; ++n)
#pragma unroll
                        for (int j = 0; j < 4; ++j) s += __builtin_amdgcn_exp2f(acc[ai][bj][m][n][j] * sc - mx);
                s += __shfl_xor(s, 16); s += __shfl_xor(s, 32);
                if (fq == 0) xsum[(ai * 128 + wr * 64 + m * 16 + fr) * 4 + wc] = s;
                asm volatile("" ::: "memory");
            }
        __syncthreads();
#pragma unroll
        for (int ai = 0; ai < 2; ++ai)
#pragma unroll
            for (int m = 0; m < 4; ++m) {
                const f32x4 t = *(LAS f32x4*)(xm + (ai * 128 + wr * 64 + m * 16 + fr) * 4); const float mx = fmaxf(fmaxf(t[0], t[1]), fmaxf(t[2], t[3])) * sc;
                const f32x4 t2 = *(LAS f32x4*)(xsum + (ai * 128 + wr * 64 + m * 16 + fr) * 4); const float inv = __builtin_amdgcn_rcpf((t2[0] + t2[1]) + (t2[2] + t2[3]));
                bf16_t* rowp = P + (size_t)(u.pm * 256 + ai * 128 + wr * 64 + m * 16 + fr) * D + u.pn * 256 + wc * 32 + 8 * fq;
#pragma unroll
                for (int bj = 0; bj < 2; ++bj)
#pragma unroll
                    for (int n = 0; n < 2; ++n) {
                        const f32x4 v = acc[ai][bj][m][n];
                        u32x2 w; w.x = pk2(__builtin_amdgcn_exp2f(v[0] * sc - mx) * inv, __builtin_amdgcn_exp2f(v[1] * sc - mx) * inv); w.y = pk2(__builtin_amdgcn_exp2f(v[2] * sc - mx) * inv, __builtin_amdgcn_exp2f(v[3] * sc - mx) * inv);
                        *(u32x2*)(rowp + bj * 128 + 4 * n) = w;
                    }
                asm volatile("" ::: "memory");
            }
        __syncthreads();
    }
};

#define XB_TMO      128
#define XB_XCNT(j)  (256  + 64 * (j))
#define XB_XSUB(j)  (1280 + 64 * (j))
#define XB_XGEN(j)  (2304 + 64 * (j))
#define XB_TOP      3328
#define XB_TOPGEN   3392
#define XCD_BAR_WORDS 3456
#define XB_SPIN_CAP (1u << 18)

__device__ __forceinline__ unsigned xb_ld(unsigned* p)              { return __hip_atomic_load(p, __ATOMIC_RELAXED, __HIP_MEMORY_SCOPE_AGENT); }
__device__ __forceinline__ unsigned xb_add(unsigned* p, unsigned v) { return __hip_atomic_fetch_add(p, v, __ATOMIC_RELAXED, __HIP_MEMORY_SCOPE_AGENT); }
__device__ __forceinline__ unsigned xb_xcc_id() { return (unsigned)__builtin_amdgcn_s_getreg((3 << 11) | 20) & 0xFu; }
#define XB_SPIN(cond, bar) do { unsigned _sp = 0; while (cond) { __builtin_amdgcn_s_sleep(1); \
    if ((++_sp & 255u) == 0u) { if (xb_ld(&(bar)[XB_TMO])) break; if (_sp > XB_SPIN_CAP) { atomicAdd(&(bar)[XB_TMO], 1u); break; } } } } while (0)

struct XcdBarrier {
    unsigned* bar; unsigned x;
    volatile LAS unsigned* st;
};

__device__ __forceinline__ XcdBarrier xcd_barrier_post(unsigned* bar, volatile LAS unsigned* st) {
    XcdBarrier b; b.bar = bar; b.x = xb_xcc_id(); b.st = st;
    if (threadIdx.x == 0) (void)xb_add(&bar[XB_XCNT(b.x)], 1u);
    return b;
}
__device__ __forceinline__ void xcd_barrier_complete(unsigned* bar, unsigned x, unsigned& nloc, unsigned& nx) {
    const unsigned G = gridDim.x * gridDim.y * gridDim.z;
    unsigned sum, cnt, mine, sp = 0u;
    for (;;) {
        sum = 0u; cnt = 0u; mine = 0u;
#pragma unroll
        for (unsigned j = 0; j < 16; ++j) { const unsigned c = xb_ld(&bar[XB_XCNT(j)]); sum += c; cnt += (c > 0u) ? 1u : 0u; mine = (j == x) ? c : mine; }
        if (sum == G) break;
        __builtin_amdgcn_s_sleep(1);
        if ((++sp & 255u) == 0u) { if (xb_ld(&bar[XB_TMO])) break; if (sp > XB_SPIN_CAP) { atomicAdd(&bar[XB_TMO], 1u); break; } }
    }
    nloc = mine > 0u ? mine : 1u; nx = cnt > 0u ? cnt : 1u;
}

__device__ __forceinline__ void xcd_barrier(const XcdBarrier& b) {
    asm volatile("s_waitcnt vmcnt(0)" ::: "memory");
    __syncthreads();
    if (threadIdx.x == 0) {
        unsigned* bar = b.bar;
        __builtin_amdgcn_s_waitcnt(0);
        unsigned nloc = b.st[0], nx = b.st[1];
        if (nloc == 0u) { xcd_barrier_complete(bar, b.x, nloc, nx); b.st[0] = nloc; b.st[1] = nx; }
        const unsigned old = xb_add(&bar[XB_XSUB(b.x)], 1u);
        const unsigned gen = old / nloc;
        if (old + 1u == (gen + 1u) * nloc) {
            __builtin_amdgcn_fence(__ATOMIC_RELEASE, "agent");
            asm volatile("s_waitcnt vmcnt(0)" ::: "memory");
            const unsigned og = xb_add(&bar[XB_TOP], 1u);
            const unsigned tg = og / nx;
            if (og + 1u == (tg + 1u) * nx) xb_add(&bar[XB_TOPGEN], 1u);
            else XB_SPIN(xb_ld(&bar[XB_TOPGEN]) == tg, bar);
            __builtin_amdgcn_fence(__ATOMIC_ACQUIRE, "agent");
            xb_add(&bar[XB_XGEN(b.x)], 1u);
            asm volatile("s_waitcnt vmcnt(0)" ::: "memory");
        } else {
            XB_SPIN(xb_ld(&bar[XB_XGEN(b.x)]) == gen, bar);
            __builtin_amdgcn_fence(__ATOMIC_ACQUIRE, "agent");
            asm volatile("s_waitcnt vmcnt(0)" ::: "memory");
        }
    }
    __syncthreads();
}


#define LDS_WAIT() asm volatile("s_waitcnt lgkmcnt(0)" ::: "memory")
DI void transpose_item(const float* W, int K, int N, int Npad, bf16_t* WT, int mode, LAS float* scr, int item, int lane, const float* gk = nullptr) {
    const int nblk = Npad / 32, kb = item / nblk, nb = item % nblk, k0 = 64 * kb, n0 = 32 * nb;
    const int nn = n0 + (lane & 31); const bool ok = nn < N;
    float tv[32];
#pragma unroll
    for (int i = 0; i < 32; ++i) tv[i] = ok ? W[(size_t)(k0 + 2 * i + (lane >> 5)) * N + nn] : 0.f;
    if (gk) {
#pragma unroll
        for (int i = 0; i < 32; ++i) tv[i] *= gk[k0 + 2 * i + (lane >> 5)];
    }
#pragma unroll
    for (int i = 0; i < 32; ++i) scr[(2 * i + (lane >> 5)) * 33 + (lane & 31)] = tv[i];
    LDS_WAIT(); asm volatile("" ::: "memory");
    const int c = lane & 7;
#pragma unroll
    for (int j = 0; j < 4; ++j) {
        const int n = (lane >> 3) + 8 * j; const LAS float* s = scr + (8 * c) * 33 + n;
        u32x4 o; o.x = pk2(s[0 * 33], s[1 * 33]); o.y = pk2(s[2 * 33], s[3 * 33]); o.z = pk2(s[4 * 33], s[5 * 33]); o.w = pk2(s[6 * 33], s[7 * 33]);
        int drow = n0 + n;
        if (mode == 1) { const int jj = drow >= FF ? drow - FF : drow, isu = drow >= FF ? 1 : 0; drow = (jj >> 2) * 8 + isu * 4 + (jj & 3); }
        *(u32x4*)(WT + (size_t)drow * K + k0 + 8 * c) = o;
    }
    LDS_WAIT(); asm volatile("" ::: "memory");
}

template <int NR> DI void norm_rows(const float* xsrc32, bf16_t* xn, float* rn, float* xdst32, const bf16_t* y, const float* gpost, size_t rstride, int lane) {
    f32x4 v[NR][4];
    if (xsrc32) {
#pragma unroll
        for (int r = 0; r < NR; ++r)
#pragma unroll
            for (int j = 0; j < 4; ++j) v[r][j] = *(const f32x4*)(xsrc32 + r * rstride + 4 * lane + 256 * j);
    } else {
        float rr[NR]; u32x2 w[NR][4];
#pragma unroll
        for (int r = 0; r < NR; ++r) { rr[r] = rn[r * (rstride / D)];
#pragma unroll
            for (int j = 0; j < 4; ++j) w[r][j] = *(const u32x2*)(xn + r * rstride + 4 * lane + 256 * j); }
#pragma unroll
        for (int r = 0; r < NR; ++r)
#pragma unroll
            for (int j = 0; j < 4; ++j) v[r][j] = (f32x4){bflo(w[r][j].x), bfhi(w[r][j].x), bflo(w[r][j].y), bfhi(w[r][j].y)} * rr[r];
    }
    if (y) {
        u32x2 yw[NR][4]; f32x4 g[4];
#pragma unroll
        for (int r = 0; r < NR; ++r)
#pragma unroll
            for (int j = 0; j < 4; ++j) yw[r][j] = *(const u32x2*)(y + r * rstride + 4 * lane + 256 * j);
#pragma unroll
        for (int j = 0; j < 4; ++j) g[j] = *(const f32x4*)(gpost + 4 * lane + 256 * j);
#pragma unroll
        for (int r = 0; r < NR; ++r) {
            f32x4 yv[4]; float ss = 0.f;
#pragma unroll
            for (int j = 0; j < 4; ++j) { yv[j] = (f32x4){bflo(yw[r][j].x), bfhi(yw[r][j].x), bflo(yw[r][j].y), bfhi(yw[r][j].y)}; ss += (yv[j][0] * yv[j][0] + yv[j][1] * yv[j][1]) + (yv[j][2] * yv[j][2] + yv[j][3] * yv[j][3]); }
            const float rs = rsqrtf(wave_sum(ss) * (1.f / D) + EPS);
#pragma unroll
            for (int j = 0; j < 4; ++j) v[r][j] = v[r][j] + yv[j] * rs * g[j];
        }
    }
#pragma unroll
    for (int r = 0; r < NR; ++r) {
        if (xdst32) {
#pragma unroll
            for (int j = 0; j < 4; ++j) *(f32x4*)(xdst32 + r * rstride + 4 * lane + 256 * j) = v[r][j];
        } else {
            float ss = 0.f;
#pragma unroll
            for (int j = 0; j < 4; ++j) ss += (v[r][j][0] * v[r][j][0] + v[r][j][1] * v[r][j][1]) + (v[r][j][2] * v[r][j][2] + v[r][j][3] * v[r][j][3]);
            const float ms = wave_sum(ss) * (1.f / D) + EPS, rs = rsqrtf(ms);
#pragma unroll
            for (int j = 0; j < 4; ++j) { const f32x4 o = v[r][j] * rs; u32x2 w; w.x = pk2(o[0], o[1]); w.y = pk2(o[2], o[3]); *(u32x2*)(xn + r * rstride + 4 * lane + 256 * j) = w; }
            if (lane == 0) rn[r * (rstride / D)] = ms * rs;
        }
    }
}
DI void norm_row(const float* xsrc32, bf16_t* xn, float* rn, float* xdst32, const bf16_t* y, const float* gpost, int lane) { norm_rows<1>(xsrc32, xn, rn, xdst32, y, gpost, (size_t)D, lane); }

DI void norm_phase(const Ctx& p, const float* gpost, bool last, int G, int bx) {
    const int tid = pg8::tid_(), lane = tid & 63, wv = tid >> 6, gw = bx * NWAVES + wv, NGW = G * NWAVES;
    const bf16_t* Yb = (const bf16_t*)(p.ws + WS_Y); bf16_t* Xb = (bf16_t*)(p.ws + WS_XB); float* Rn = (float*)(p.ws + WS_RN);
    int row = gw; const size_t rst = (size_t)NGW * D;
    for (; row + 3 * NGW < MA; row += 4 * NGW) norm_rows<4>(nullptr, Xb + (size_t)row * D, Rn + row, last ? p.out + (size_t)row * D : nullptr, Yb + (size_t)row * D, gpost, rst, lane);
    for (; row < MA; row += NGW) norm_row(nullptr, Xb + (size_t)row * D, Rn + row, last ? p.out + (size_t)row * D : nullptr, Yb + (size_t)row * D, gpost, lane);
}

DI void prologue(const Params& p, LAS unsigned char* lds) {
    const int tid = pg8::tid_(), lane = tid & 63, wv = tid >> 6;
    const int gw = blockIdx.x * NWAVES + wv, NGW = gridDim.x * NWAVES;
    LAS float* scr = (LAS float*)(lds + wv * 16384);
    unsigned char* ws = p.ws;
    constexpr int I0 = 3072, I1 = 192, I2 = 512, I3 = 2816, I4 = 1408, IPL = I0 + 2 * I1 + 5 * I2 + I3 + I4;
    for (int it = gw; it < 4 * IPL; it += NGW) {
        const int l = it / IPL; int r = it % IPL;
        if (r < I0) { transpose_item(p.in[I_WIN] + (size_t)l * D * NIN, D, NIN, NINP, (bf16_t*)(ws + WS_WIN + l * SZ_WIN), 0, scr, r, lane, p.in[I_NMIXPRE] + l * D); continue; } r -= I0;
        if (r < I1) { transpose_item(p.in[I_WBA] + (size_t)l * 384 * D, 384, D, D, (bf16_t*)(ws + WS_WBA + l * SZ_WBA), 0, scr, r, lane); continue; } r -= I1;
        if (r < I1) { transpose_item(p.in[I_WBC] + (size_t)l * 384 * D, 384, D, D, (bf16_t*)(ws + WS_WBC + l * SZ_WBA), 0, scr, r, lane); continue; } r -= I1;
        if (r < I2) { transpose_item(p.in[I_WMIX] + (size_t)l * D * D, D, D, D, (bf16_t*)(ws + WS_WMIX + l * SZ_WSQ), 0, scr, r, lane); continue; } r -= I2;
        if (r < I2) { transpose_item(p.in[I_WXQ] + (size_t)l * D * D, D, D, D, (bf16_t*)(ws + WS_WXQ + l * SZ_WSQ), 0, scr, r, lane, p.in[I_NXPRE] + l * D); continue; } r -= I2;
        if (r < I2) { transpose_item(p.in[I_WXO] + (size_t)l * D * D, D, D, D, (bf16_t*)(ws + WS_WXO + l * SZ_WSQ), 0, scr, r, lane); continue; } r -= I2;
        if (r < I2) { transpose_item(p.in[I_WXK] + (size_t)l * D * D, D, D, D, (bf16_t*)(ws + WS_WKV + l * SZ_WKV), 0, scr, r, lane); continue; } r -= I2;
        if (r < I2) { transpose_item(p.in[I_WXV] + (size_t)l * D * D, D, D, D, (bf16_t*)(ws + WS_WKV + l * SZ_WKV + SZ_WSQ), 0, scr, r, lane); continue; } r -= I2;
        if (r < I3) { transpose_item(p.in[I_WF1] + (size_t)l * D * FF2, D, FF2, FF2, (bf16_t*)(ws + WS_WF1 + l * SZ_WF1), 1, scr, r, lane, p.in[I_NFPRE] + l * D); continue; } r -= I3;
        transpose_item(p.in[I_WF2] + (size_t)l * FF * D, FF, D, D, (bf16_t*)(ws + WS_WF2 + l * SZ_WF2), 0, scr, r, lane);
    }
    for (int u = blockIdx.x; u < 128; u += gridDim.x) {
        const int l = u >> 5, g = (u >> 3) & 3, nb = (u >> 2) & 1, cq = u & 3;
        LAS float* Ps = (LAS float*)(lds + 8 * 16384);
        __syncthreads();
        for (int i = tid; i < 1024; i += NTHR) Ps[i] = p.in[I_WPOOL][((size_t)(l * 4 + g) * 64 + 16 * cq) * 64 + i];
        __syncthreads();
        const int n = nb * 512 + tid;
        const float* sc = p.in[I_PSCALE] + l * 256 + g * 64; const float* wb = p.in[I_WBB] + ((size_t)l * 256 + g * 64) * D + n;
        float acc[16];
#pragma unroll
        for (int c = 0; c < 16; ++c) acc[c] = 0.f;
#pragma unroll 2
        for (int d0 = 0; d0 < 64; d0 += 8) {
            float bc[8];
#pragma unroll
            for (int j = 0; j < 8; ++j) bc[j] = sc[d0 + j] * wb[(size_t)(d0 + j) * D];
#pragma unroll
            for (int c = 0; c < 16; ++c) { const f32x4 p0 = *(const LAS f32x4*)(Ps + c * 64 + d0), p1 = *(const LAS f32x4*)(Ps + c * 64 + d0 + 4);
                acc[c] += ((p0[0] * bc[0] + p0[1] * bc[1]) + (p0[2] * bc[2] + p0[3] * bc[3])) + ((p1[0] * bc[4] + p1[1] * bc[5]) + (p1[2] * bc[6] + p1[3] * bc[7])); }
        }
        unsigned ov[16];
#pragma unroll
        for (int c = 0; c < 16; ++c) ov[c] = f2bf(acc[c]);
        bf16_t* dst = (bf16_t*)(ws + WS_WBB + l * SZ_WBB) + (size_t)n * 256 + g * 64 + 16 * cq;
        u32x4 w0, w1; w0.x = ov[0] | (ov[1] << 16); w0.y = ov[2] | (ov[3] << 16); w0.z = ov[4] | (ov[5] << 16); w0.w = ov[6] | (ov[7] << 16);
        w1.x = ov[8] | (ov[9] << 16); w1.y = ov[10] | (ov[11] << 16); w1.z = ov[12] | (ov[13] << 16); w1.w = ov[14] | (ov[15] << 16);
        *(u32x4*)dst = w0; *(u32x4*)(dst + 8) = w1;
    }
    __syncthreads();
    for (int row = gw; row < MA; row += NGW) {
        const float* src = row < MP ? p.in[I_XP] + (size_t)row * D : p.in[I_XS] + (size_t)(row - MP) * D;
        norm_row(src, (bf16_t*)(ws + WS_XB) + (size_t)row * D, (float*)(ws + WS_RN) + row, nullptr, nullptr, nullptr, lane);
    }
    for (int row = gw; row < NB * 256; row += NGW) {
        f32x4 v[4]; float ss = 0.f;
#pragma unroll
        for (int j = 0; j < 4; ++j) { v[j] = *(const f32x4*)(p.in[I_MEM] + (size_t)row * D + 4 * lane + 256 * j); ss += (v[j][0] * v[j][0] + v[j][1] * v[j][1]) + (v[j][2] * v[j][2] + v[j][3] * v[j][3]); }
        const float rs = rsqrtf(wave_sum(ss) * (1.f / D) + EPS);
        for (int l = 0; l < 4; ++l)
#pragma unroll
            for (int j = 0; j < 4; ++j) { const f32x4 g = *(const f32x4*)(p.in[I_MEMN] + l * D + 4 * lane + 256 * j); const f32x4 o = v[j] * rs * g; u32x2 w; w.x = pk2(o[0], o[1]); w.y = pk2(o[2], o[3]);
                *(u32x2*)((bf16_t*)(ws + WS_MN) + ((size_t)l * 2048 + row) * D + 4 * lane + 256 * j) = w; }
    }
}

#define MFMA32(a, b, c) __builtin_amdgcn_mfma_f32_32x32x16_bf16((a), (b), (c), 0, 0, 0)
#define MFMA16(a, b, c) __builtin_amdgcn_mfma_f32_16x16x32_bf16((a), (b), (c), 0, 0, 0)
template <bool MASKED> DI void sb_tile_weights(f32x16 (&z)[2], float& R, int jt, int tq, int hi) {
    f32x16 e[2]; float T[8];
    const int sbase = 64 * jt + 4 * hi;
#pragma unroll
    for (int kb = 0; kb < 2; ++kb)
#pragma unroll
        for (int g = 0; g < 4; ++g) {
            float fl[4];
#pragma unroll
            for (int j = 0; j < 4; ++j) {
                const int r = 4 * g + j; const bool valid = !MASKED || (sbase + 32 * kb + 8 * g + j) < tq;
                const float zz = fminf(fmaxf(z[kb][r], -240.f), 240.f);
                const float t = __builtin_amdgcn_exp2f(zz * (-0.125f * 1.4426950408889634f));
                const float be = __builtin_amdgcn_rcpf(1.f + t);
                fl[j] = valid ? t * be : 1.f; z[kb][r] = valid ? be : 0.f;
            }
            e[kb][4 * g + 3] = 1.f; e[kb][4 * g + 2] = fl[3]; e[kb][4 * g + 1] = fl[3] * fl[2]; e[kb][4 * g + 0] = e[kb][4 * g + 1] * fl[1];
            T[kb * 4 + g] = e[kb][4 * g + 0] * fl[0];
        }
    float Tp[8], X[8];
#pragma unroll
    for (int gi = 0; gi < 8; ++gi) Tp[gi] = __shfl_xor(T[gi], 32);
    X[7] = 1.f;
#pragma unroll
    for (int gi = 6; gi >= 0; --gi) X[gi] = X[gi + 1] * (T[gi + 1] * Tp[gi + 1]);
    const float total = X[0] * (T[0] * Tp[0]);
#pragma unroll
    for (int kb = 0; kb < 2; ++kb)
#pragma unroll
        for (int g = 0; g < 4; ++g) {
            const int gi = kb * 4 + g; const float off = R * X[gi] * (hi == 0 ? Tp[gi] : 1.f);
#pragma unroll
            for (int j = 0; j < 4; ++j) { const int r = 4 * g + j; z[kb][r] = z[kb][r] * (off * e[kb][r]); }
        }
    R *= total;
}

DI void sb_prompt_unit(const Ctx& p, int b, int h, int qb, LAS unsigned char* lds) {
    const bf16_t* proj = (const bf16_t*)(p.ws + WS_PROJ);
    LAS unsigned short* KS = (LAS unsigned short*)lds;
    LAS unsigned short* VT = KS + 64 * 72;
    const int tid = pg8::tid_(), lane = tid & 63, wv = tid >> 6, hi = lane >> 5, c = lane & 31;
    const int q0 = qb * 256 + wv * 32, tq = q0 + c;
    const size_t rowbase = (size_t)b * SEQ;
    bf16x8 qf[4];
    {
        const bf16_t* qp = proj + (rowbase + tq) * NINP + C_QA + h * 64 + 8 * hi;
#pragma unroll
        for (int kk = 0; kk < 4; ++kk) qf[kk] = *(const bf16x8*)(qp + 16 * kk);
    }
    f32x16 o0, o1;
#pragma unroll
    for (int i = 0; i < 16; ++i) { o0[i] = 0.f; o1[i] = 0.f; }
    float R = 1.f;
    const bf16_t* kbase = proj + rowbase * NINP + C_KA + h * 64 + 8 * wv;
    const bf16_t* vbase = proj + rowbase * NINP + C_VA + h * 64 + 8 * wv;
    int jt = 4 * qb + 3;
    u32x4 kr = *(const u32x4*)(kbase + (size_t)(64 * jt + lane) * NINP), vr = *(const u32x4*)(vbase + (size_t)(64 * jt + lane) * NINP);
    for (; jt >= 0; --jt) {
        __syncthreads();
        *(LAS u32x4*)(KS + lane * 72 + 8 * wv) = kr;
#pragma unroll
        for (int i = 0; i < 4; ++i) { const unsigned w = vr[i]; VT[(8 * wv + 2 * i) * 72 + lane] = (unsigned short)(w & 0xffffu); VT[(8 * wv + 2 * i + 1) * 72 + lane] = (unsigned short)(w >> 16); }
        __syncthreads();
        if (jt > 0) { kr = *(const u32x4*)(kbase + (size_t)(64 * (jt - 1) + lane) * NINP); vr = *(const u32x4*)(vbase + (size_t)(64 * (jt - 1) + lane) * NINP); }
        if (64 * jt < q0 + 31) {
            f32x16 z[2];
#pragma unroll
            for (int kb = 0; kb < 2; ++kb) {
                f32x16 acc;
#pragma unroll
                for (int i = 0; i < 16; ++i) acc[i] = 0.f;
#pragma unroll
                for (int kk = 0; kk < 4; ++kk) { const bf16x8 a = *(const LAS bf16x8*)(KS + (32 * kb + c) * 72 + 16 * kk + 8 * hi); acc = MFMA32(a, qf[kk], acc); }
                z[kb] = acc;
            }
            if (64 * jt + 63 < q0) sb_tile_weights<false>(z, R, jt, tq, hi); else sb_tile_weights<true>(z, R, jt, tq, hi);
#pragma unroll
            for (int kb = 0; kb < 2; ++kb)
#pragma unroll
                for (int s2 = 0; s2 < 2; ++s2) {
                    u32x4 pw; pw.x = pk2(z[kb][8 * s2 + 0], z[kb][8 * s2 + 1]); pw.y = pk2(z[kb][8 * s2 + 2], z[kb][8 * s2 + 3]); pw.z = pk2(z[kb][8 * s2 + 4], z[kb][8 * s2 + 5]); pw.w = pk2(z[kb][8 * s2 + 6], z[kb][8 * s2 + 7]);
                    const bf16x8 pb = __builtin_bit_cast(bf16x8, pw);
                    const int ko = 32 * kb + 16 * s2 + 4 * hi;
                    { const s16x4 lo = *(const LAS s16x4*)(VT + c * 72 + ko), hh = *(const LAS s16x4*)(VT + c * 72 + ko + 8);
                      const bf16x8 va = __builtin_shufflevector(lo, hh, 0, 1, 2, 3, 4, 5, 6, 7); o0 = MFMA32(va, pb, o0); }
                    { const s16x4 lo = *(const LAS s16x4*)(VT + (c + 32) * 72 + ko), hh = *(const LAS s16x4*)(VT + (c + 32) * 72 + ko + 8);
                      const bf16x8 va = __builtin_shufflevector(lo, hh, 0, 1, 2, 3, 4, 5, 6, 7); o1 = MFMA32(va, pb, o1); }
                }
        }
    }
    bf16_t* op = (bf16_t*)(p.ws + WS_OA) + (rowbase + tq) * 384 + h * 64 + 4 * hi;
#pragma unroll
    for (int g = 0; g < 4; ++g) {
        u32x2 w; w.x = pk2(o0[4 * g], o0[4 * g + 1]); w.y = pk2(o0[4 * g + 2], o0[4 * g + 3]); *(u32x2*)(op + 8 * g) = w;
        w.x = pk2(o1[4 * g], o1[4 * g + 1]); w.y = pk2(o1[4 * g + 2], o1[4 * g + 3]); *(u32x2*)(op + 32 + 8 * g) = w;
    }
}

DI void sb_sample_unit(const Ctx& p, int l, int b, int h, LAS unsigned char* lds) {
    const bf16_t* proj = (const bf16_t*)(p.ws + WS_PROJ);
    LAS float* qs = (LAS float*)lds;
    LAS float* Z = qs + 1024;
    LAS float* RED = Z + 16 * 1056;
    const int tid = pg8::tid_(), lane = tid & 63, wv = tid >> 6;
    const size_t srow = (size_t)MP + b * 16;
    for (int i = tid; i < 1024; i += NTHR) qs[i] = bf2f(proj[(srow + (i >> 6)) * NINP + C_QA + h * 64 + (i & 63)]) * 0.125f;
    __syncthreads();
    {
        float a0[16], a1[16];
#pragma unroll
        for (int i = 0; i < 16; ++i) { a0[i] = 0.f; a1[i] = 0.f; }
        const float* k0p = p.in[I_CSK] + ((((size_t)l * DB + b) * PAST + tid) * 6 + h) * 64; const float* k1p = k0p + (size_t)512 * 6 * 64;
#pragma unroll 8
        for (int d4 = 0; d4 < 16; ++d4) {
            const f32x4 ka = *(const f32x4*)(k0p + 4 * d4), kb = *(const f32x4*)(k1p + 4 * d4);
#pragma unroll
            for (int i = 0; i < 16; ++i) { const f32x4 q = *(const LAS f32x4*)(qs + i * 64 + 4 * d4);
                a0[i] += (q[0] * ka[0] + q[1] * ka[1]) + (q[2] * ka[2] + q[3] * ka[3]); a1[i] += (q[0] * kb[0] + q[1] * kb[1]) + (q[2] * kb[2] + q[3] * kb[3]); }
        }
#pragma unroll
        for (int i = 0; i < 16; ++i) { Z[i * 1056 + tid] = a0[i]; Z[i * 1056 + tid + 512] = a1[i]; }
        if (tid < 256) {
            const int i = tid >> 4, j = tid & 15; const bf16_t* kp = proj + (srow + j) * NINP + C_KA + h * 64; float s = 0.f;
            for (int d = 0; d < 64; ++d) s += qs[i * 64 + d] * bf2f(kp[d]);
            Z[i * 1056 + 1024 + j] = s;
        }
    }
    __syncthreads();
    for (int qq = 0; qq < 2; ++qq) {
        const int i = 2 * wv + qq, lim = PAST + i; LAS float* zr = Z + i * 1056;
        const int st = 17 * lane, en = (st + 17 < 1040) ? st + 17 : 1040;
        float tot = 0.f;
        for (int s = st; s < en; ++s) if (s < lim) tot -= softplusf_(zr[s]);
        float incl = tot;
#pragma unroll
        for (int o = 1; o < 64; o <<= 1) { const float t = __shfl_down(incl, o); if (lane + o < 64) incl += t; }
        float run = incl - tot;
        for (int s = en - 1; s >= st; --s) {
            const float zz = zr[s]; float w = 0.f;
            if (s < lim) { const float sp = softplusf_(zz); w = __expf(zz - sp + run); run -= sp; }
            zr[s] = w;
        }
    }
    __syncthreads();
    {
        const int d = tid & 63, g = tid >> 6;
        float o[16];
#pragma unroll
        for (int i = 0; i < 16; ++i) o[i] = 0.f;
        const float* vp = p.in[I_CSV] + (((size_t)l * DB + b) * PAST * 6 + h) * 64 + d;
        for (int s0 = 130 * g; s0 < 130 * g + 130; s0 += 26) {
            float v[26];
#pragma unroll
            for (int j = 0; j < 26; ++j) { const int s = s0 + j; v[j] = s < PAST ? vp[(size_t)s * 384] : bf2f(proj[(srow + (s - PAST)) * NINP + C_VA + h * 64 + d]); }
#pragma unroll
            for (int j = 0; j < 26; ++j)
#pragma unroll
                for (int i = 0; i < 16; ++i) o[i] += Z[i * 1056 + s0 + j] * v[j];
        }
#pragma unroll
        for (int i = 0; i < 16; ++i) RED[(g * 16 + i) * 64 + d] = o[i];
    }
    __syncthreads();
    for (int i = tid; i < 1024; i += NTHR) {
        const int qi = i >> 6, d = i & 63; float s = 0.f;
#pragma unroll
        for (int g = 0; g < 8; ++g) s += RED[(g * 16 + qi) * 64 + d];
        ((bf16_t*)(p.ws + WS_OA))[(srow + qi) * 384 + h * 64 + d] = f2bf(s);
    }
}

template <int W> DI void pool_rows(const float (&uu)[48], int t0, float* outp, bf16_t* pooled_col) {
    float s = 0.f;
#pragma unroll
    for (int i = 16 - W; i < 16; ++i) s += uu[i];
#pragma unroll
    for (int r = 0; r < 32; ++r) {
        s += uu[16 + r] - uu[16 + r - W];
        const int t = t0 + r; const float cnt = (float)((t + 1 < W) ? t + 1 : W);
        pooled_col[(size_t)r * 256] = f2bf(s / cnt - uu[16 + r]);
        if (t >= SEQ - 15) outp[(size_t)(t - (SEQ - 15)) * 256] = uu[16 + r];
    }
}
DI void pool_unit(const Ctx& p, int l, int unit) {
    const bf16_t* proj = (const bf16_t*)(p.ws + WS_PROJ); bf16_t* pooled = (bf16_t*)(p.ws + WS_POOLED);
    const int tid = pg8::tid_(), ch = tid & 255, w = 2 << (ch >> 6);
    if (unit < MP / 64) {
        const int r0 = unit * 64 + 32 * (tid >> 8), t0 = r0 & (SEQ - 1), b = r0 >> 11;
        float uu[48];
        const bf16_t* up = proj + (size_t)(r0 - 16) * NINP + C_U + ch;
#pragma unroll
        for (int i = 0; i < 48; ++i) uu[i] = (t0 - 16 + i >= 0) ? bf2f(up[(size_t)i * NINP]) : 0.f;
        float* outp = p.out + O_POOLP + ((size_t)(l * NB + b) * 15) * 256 + ch; bf16_t* pc = pooled + (size_t)r0 * 256 + ch;
        if (w == 2) pool_rows<2>(uu, t0, outp, pc); else if (w == 4) pool_rows<4>(uu, t0, outp, pc); else if (w == 8) pool_rows<8>(uu, t0, outp, pc); else pool_rows<16>(uu, t0, outp, pc);
        return;
    }
    for (int i = 0; i < 32; ++i) {
        const int row = unit * 64 + (tid >> 8) + 2 * i;
        const int rs = row - MP, b = rs >> 4, t = rs & 15; float s = 0.f;
        const bf16_t* up = proj + (size_t)row * NINP + C_U + ch; const float u0 = bf2f(up[0]);
        const float* hist = p.in[I_SPOOL] + ((size_t)(l * DB + b) * 15) * 256 + ch;
        for (int j = 0; j < w; ++j) { const int tt = t - j; s += tt >= 0 ? bf2f(*(up - (size_t)j * NINP)) : hist[(15 + tt) * 256]; }
        if (t >= 1) p.out[O_POOLS + ((size_t)(l * DB + b) * 15 + (t - 1)) * 256 + ch] = u0;
        pooled[(size_t)row * 256 + ch] = f2bf(s / (float)w - u0);
    }
}

DI void kvout_unit(const Ctx& p, int l, int unit) {
    const bf16_t* proj = (const bf16_t*)(p.ws + WS_PROJ);
#pragma unroll 4
    for (int i = pg8::tid_(); i < 64 * 96; i += NTHR) {
        const int r = i / 96, ch = i % 96, row = unit * 64 + r;
        const u32x4 w = *(const u32x4*)(proj + (size_t)row * NINP + C_KA + 8 * ch);
        const bool isv = ch >= 48; const int c = 8 * (isv ? ch - 48 : ch);
        float* dst = (row < MP) ? p.out + (isv ? O_VP : O_KP) + ((size_t)l * MP + row) * 384 + c : p.out + (isv ? O_VS : O_KS) + ((size_t)l * MS + (row - MP)) * 384 + c;
        *(f32x4*)dst = (f32x4){bflo(w.x), bfhi(w.x), bflo(w.y), bfhi(w.y)}; *(f32x4*)(dst + 4) = (f32x4){bflo(w.z), bfhi(w.z), bflo(w.w), bfhi(w.w)};
    }
}
DI void memout_unit(const Ctx& p, int unit) {
    const bf16_t* mkv = (const bf16_t*)(p.ws + WS_MKV);
    for (int i = pg8::tid_(); i < 16 * 256; i += NTHR) {
        const int r = i >> 8, ch = i & 255, row = unit * 16 + r, col = 8 * ch;
        const u32x4 w = *(const u32x4*)(mkv + (size_t)row * 2048 + col);
        float* dst = p.out + (col >= 1024 ? O_MVP : O_MKP) + (size_t)row * D + (col & 1023);
        *(f32x4*)dst = (f32x4){bflo(w.x), bfhi(w.x), bflo(w.y), bfhi(w.y)}; *(f32x4*)(dst + 4) = (f32x4){bflo(w.z), bfhi(w.z), bflo(w.w), bfhi(w.w)};
    }
}
DI void memvt_unit(const Ctx& p, int unit) {
    const int l = unit >> 7, nb = (unit >> 3) & 15, b = unit & 7, tid = pg8::tid_(), n = nb * 64 + (tid & 63), wv = tid >> 6;
    const bf16_t* src = (const bf16_t*)(p.ws + WS_MKV) + ((size_t)l * 2048 + b * 256) * 2048 + 1024 + n;
    bf16_t* dst = (bf16_t*)(p.ws + WS_MEMVT) + ((size_t)l * 1024 + n) * 2048 + b * 256;
    for (int c = wv; c < 32; c += 8) {
        unsigned v[8];
#pragma unroll
        for (int j = 0; j < 8; ++j) v[j] = src[(size_t)(8 * c + j) * 2048];
        u32x4 w; w.x = v[0] | (v[1] << 16); w.y = v[2] | (v[3] << 16); w.z = v[4] | (v[5] << 16); w.w = v[6] | (v[7] << 16);
        *(u32x4*)(dst + 8 * c) = w;
    }
}

DI void gla_decay(const Ctx& p, int l, int h, size_t row0, int ntok, LAS unsigned char* lds) {
    const bf16_t* proj = (const bf16_t*)(p.ws + WS_PROJ);
    LAS float* Bc = (LAS float*)lds; LAS float* LR = (LAS float*)(lds + 24576); LAS float* A2 = (LAS float*)(lds + 28672); LAS float* BIA = (LAS float*)(lds + 34816); LAS float* SEG = (LAS float*)(lds + 35200);
    const int tid = pg8::tid_();
    if (tid < 128) {
        const int t = tid >> 1, hf = tid & 1; u32x4 w = {0u, 0u, 0u, 0u};
        if (t < ntok) w = *(const u32x4*)(proj + (row0 + t) * NINP + C_LR + 8 * hf);
        LAS float* d = LR + t * 16 + 8 * hf;
        d[0] = bflo(w.x); d[1] = bfhi(w.x); d[2] = bflo(w.y); d[3] = bfhi(w.y); d[4] = bflo(w.z); d[5] = bfhi(w.z); d[6] = bflo(w.w); d[7] = bfhi(w.w);
    } else if (tid < 128 + 384) {
        const int i = tid - 128, r = i / 24, c4 = i % 24;
        *(LAS f32x4*)(A2 + r * 96 + 4 * c4) = *(const f32x4*)(p.in[I_WA2] + ((size_t)l * 16 + r) * 384 + h * 96 + 4 * c4);
    }
    if (tid < 96) BIA[tid] = p.in[I_BA][l * 384 + h * 96 + tid];
    __syncthreads();
    for (int i = tid; i < 64 * 96; i += NTHR) {
        const int t = i / 96, k = i % 96; float sacc = BIA[k];
#pragma unroll
        for (int r = 0; r < 16; ++r) sacc += LR[t * 16 + r] * A2[r * 96 + k];
        Bc[i] = t < ntok ? -softplusf_(-sacc) * (1.f / 16.f) : 0.f;
    }
    __syncthreads();
    const int k = tid % 96, seg = tid / 96;
    if (tid < 384) { float run = 0.f; for (int i = 0; i < 16; ++i) { const int idx = (16 * seg + i) * 96 + k; run += Bc[idx]; Bc[idx] = run; } SEG[seg * 96 + k] = run; }
    __syncthreads();
    if (tid < 384 && seg > 0) { float off = 0.f; for (int s2 = 0; s2 < seg; ++s2) off += SEG[s2 * 96 + k]; for (int i = 0; i < 16; ++i) Bc[(16 * seg + i) * 96 + k] += off; }
    __syncthreads();
}
DI void gla_unit_rows(int gu, size_t& row0, int& ntok, int& bh, int& h) {
    if (gu < NGU_P) { bh = gu >> 5; const int c = gu & 31, b = bh >> 2; h = bh & 3; row0 = (size_t)b * SEQ + c * 64; ntok = 64; }
    else { bh = gu - NGU_P; const int b = bh >> 2; h = bh & 3; row0 = (size_t)MP + b * 16; ntok = 16; }
}
DI void gla_stage1_unit(const Ctx& p, int l, int gu, LAS unsigned char* lds) {
    const bf16_t* proj = (const bf16_t*)(p.ws + WS_PROJ);
    size_t row0; int ntok, bh, h; gla_unit_rows(gu, row0, ntok, bh, h);
    gla_decay(p, l, h, row0, ntok, lds);
    LAS float* Bc = (LAS float*)lds;
    LAS unsigned short* KT = (LAS unsigned short*)(lds + 36864);
    LAS unsigned short* VT = KT + 96 * 72;
    const int tid = pg8::tid_(), lane = tid & 63, wv = tid >> 6, fr = lane & 15, fq = lane >> 4;
    {
        float* bb = (float*)(p.ws + WS_BB) + (size_t)gu * (64 * GK);
        for (int i = tid; i < 64 * GK / 4; i += NTHR) *(f32x4*)(bb + 4 * i) = *(const LAS f32x4*)(Bc + 4 * i);
    }
    for (int task = tid; task < 768; task += NTHR) {
        const int t = task & 63, ch = task >> 6; u32x4 kw = {0u, 0u, 0u, 0u}, vw = {0u, 0u, 0u, 0u};
        if (t < ntok) { const bf16_t* rp = proj + (row0 + t) * NINP + h * 96 + 8 * ch; kw = *(const u32x4*)(rp + C_KC); vw = *(const u32x4*)(rp + C_VC); }
        const unsigned kk[4] = {kw.x, kw.y, kw.z, kw.w}, vv[4] = {vw.x, vw.y, vw.z, vw.w};
#pragma unroll
        for (int j = 0; j < 4; ++j) {
            const int k0 = 8 * ch + 2 * j;
            const float e0 = __expf(Bc[(ntok - 1) * 96 + k0] - Bc[t * 96 + k0]), e1 = __expf(Bc[(ntok - 1) * 96 + k0 + 1] - Bc[t * 96 + k0 + 1]);
            KT[k0 * 72 + t] = f2bf(bflo(kk[j]) * e0); KT[(k0 + 1) * 72 + t] = f2bf(bfhi(kk[j]) * e1);
            VT[k0 * 72 + t] = (unsigned short)(vv[j] & 0xffffu); VT[(k0 + 1) * 72 + t] = (unsigned short)(vv[j] >> 16);
        }
    }
    if (tid < 96) ((float*)(p.ws + WS_GDEC))[(size_t)gu * 96 + tid] = __expf(Bc[(ntok - 1) * 96 + tid]);
    __syncthreads();
    float* KV = (float*)(p.ws + WS_GKV) + (size_t)gu * (GK * GK);
    for (int tile = wv; tile < 36; tile += 8) {
        const int ki = tile / 6, vi = tile % 6; f32x4 acc = {0.f, 0.f, 0.f, 0.f};
#pragma unroll
        for (int ks = 0; ks < 2; ++ks) { const bf16x8 a = *(const LAS bf16x8*)(KT + (16 * ki + fr) * 72 + 32 * ks + 8 * fq), bb = *(const LAS bf16x8*)(VT + (16 * vi + fr) * 72 + 32 * ks + 8 * fq); acc = MFMA16(a, bb, acc); }
#pragma unroll
        for (int j = 0; j < 4; ++j) KV[(16 * ki + 4 * fq + j) * 96 + 16 * vi + fr] = acc[j];
    }
}
DI void gla_scan(const Ctx& p, int l) {
    const int gt = blockIdx.x * NTHR + pg8::tid_(), NT = gridDim.x * NTHR;
    const float* KV = (const float*)(p.ws + WS_GKV); const float* DEC = (const float*)(p.ws + WS_GDEC); float* SP = (float*)(p.ws + WS_GSP);
    for (int e = gt; e < 32 * GK * GK; e += NT) {
        const int bh = e / (GK * GK), kv = e % (GK * GK), k = kv / GK; float S = 0.f;
        float kvv[32], dcv[32];
#pragma unroll
        for (int c = 0; c < 32; ++c) { const size_t gu = (size_t)bh * 32 + c; kvv[c] = KV[gu * (GK * GK) + kv]; dcv[c] = DEC[gu * 96 + k]; }
#pragma unroll
        for (int c = 0; c < 32; ++c) { const size_t gu = (size_t)bh * 32 + c; SP[gu * (GK * GK) + kv] = S; S = dcv[c] * S + kvv[c]; }
        p.out[O_GLAP + ((size_t)l * 32 + bh) * (GK * GK) + kv] = S;
    }
    for (int e = gt; e < 64 * GK * GK; e += NT) {
        const int bh = e / (GK * GK), kv = e % (GK * GK), k = kv / GK; const size_t gu = (size_t)NGU_P + bh;
        const float S0 = p.in[I_SGLA][((size_t)l * 64 + bh) * (GK * GK) + kv];
        p.out[O_GLAS + ((size_t)l * 64 + bh) * (GK * GK) + kv] = DEC[gu * 96 + k] * S0 + KV[gu * (GK * GK) + kv];
    }
}
DI void gla_stage3_unit(const Ctx& p, int l, int gu, LAS unsigned char* lds) {
    const bf16_t* proj = (const bf16_t*)(p.ws + WS_PROJ);
    size_t row0; int ntok, bh, h; gla_unit_rows(gu, row0, ntok, bh, h);
    LAS float* OT = (LAS float*)lds;
    LAS unsigned short* QP = (LAS unsigned short*)(lds + 36864);
    LAS unsigned short* KP = QP + 64 * 104;
    LAS unsigned short* VT = KP + 64 * 104;
    LAS unsigned short* ST = VT + 96 * 72;
    LAS unsigned short* ATT = ST + 96 * 104;
    const int tid = pg8::tid_(), lane = tid & 63, wv = tid >> 6, fr = lane & 15, fq = lane >> 4;
    const float* Sprev = gu < NGU_P ? (const float*)(p.ws + WS_GSP) + (size_t)gu * (GK * GK) : p.in[I_SGLA] + ((size_t)l * 64 + bh) * (GK * GK);
    const float* bb = (const float*)(p.ws + WS_BB) + (size_t)gu * (64 * GK);
    __syncthreads();
    for (int task = tid; task < 768; task += NTHR) {
        const int t = task & 63, ch = task >> 6; u32x4 qw = {0u, 0u, 0u, 0u}, kw = qw, vw = qw; f32x4 b0 = {0.f, 0.f, 0.f, 0.f}, b1 = b0;
        if (t < ntok) { const bf16_t* rp = proj + (row0 + t) * NINP + h * 96 + 8 * ch; qw = *(const u32x4*)(rp + C_QC); kw = *(const u32x4*)(rp + C_KC); vw = *(const u32x4*)(rp + C_VC);
            b0 = *(const f32x4*)(bb + t * 96 + 8 * ch); b1 = *(const f32x4*)(bb + t * 96 + 8 * ch + 4); }
        const unsigned qq[4] = {qw.x, qw.y, qw.z, qw.w}, kk[4] = {kw.x, kw.y, kw.z, kw.w}, vv[4] = {vw.x, vw.y, vw.z, vw.w};
        const float be[8] = {b0[0], b0[1], b0[2], b0[3], b1[0], b1[1], b1[2], b1[3]};
        u32x4 qo, ko; unsigned qa[4], ka[4];
#pragma unroll
        for (int j = 0; j < 4; ++j) {
            const float e0 = __expf(be[2 * j]), e1 = __expf(be[2 * j + 1]), r0 = __builtin_amdgcn_rcpf(e0), r1 = __builtin_amdgcn_rcpf(e1);
            const bool ok = t < ntok;
            qa[j] = ok ? pk2(bflo(qq[j]) * 0.10206207261596575f * e0, bfhi(qq[j]) * 0.10206207261596575f * e1) : 0u;
            ka[j] = ok ? pk2(bflo(kk[j]) * r0, bfhi(kk[j]) * r1) : 0u;
            VT[(8 * ch + 2 * j) * 72 + t] = (unsigned short)(vv[j] & 0xffffu); VT[(8 * ch + 2 * j + 1) * 72 + t] = (unsigned short)(vv[j] >> 16);
        }
        qo.x = qa[0]; qo.y = qa[1]; qo.z = qa[2]; qo.w = qa[3]; ko.x = ka[0]; ko.y = ka[1]; ko.z = ka[2]; ko.w = ka[3];
        *(LAS u32x4*)(QP + t * 104 + 8 * ch) = qo; *(LAS u32x4*)(KP + t * 104 + 8 * ch) = ko;
    }
    for (int task = tid; task < 2304; task += NTHR) {
        const int k = task % 96, vc = task / 96; const f32x4 sv = *(const f32x4*)(Sprev + k * 96 + 4 * vc);
#pragma unroll
        for (int j = 0; j < 4; ++j) ST[(4 * vc + j) * 104 + k] = f2bf(sv[j]);
    }
    __syncthreads();
    for (int tile = 2 * wv; tile < 2 * wv + 2; ++tile) {
        const int ti = tile >> 2, si = tile & 3; f32x4 acc = {0.f, 0.f, 0.f, 0.f};
        if (si <= ti) {
#pragma unroll
            for (int ks = 0; ks < 3; ++ks) { const bf16x8 a = *(const LAS bf16x8*)(QP + (16 * ti + fr) * 104 + 32 * ks + 8 * fq), b2 = *(const LAS bf16x8*)(KP + (16 * si + fr) * 104 + 32 * ks + 8 * fq); acc = MFMA16(a, b2, acc); }
        }
#pragma unroll
        for (int j = 0; j < 4; ++j) { const int t = 16 * ti + 4 * fq + j, s2 = 16 * si + fr; ATT[t * 72 + s2] = f2bf(s2 <= t ? acc[j] : 0.f); }
    }
    __syncthreads();
    for (int tile = wv; tile < 24; tile += 8) {
        const int ti = tile / 6, vi = tile % 6; f32x4 acc = {0.f, 0.f, 0.f, 0.f};
#pragma unroll
        for (int ks = 0; ks < 2; ++ks) { const bf16x8 a = *(const LAS bf16x8*)(ATT + (16 * ti + fr) * 72 + 32 * ks + 8 * fq), b2 = *(const LAS bf16x8*)(VT + (16 * vi + fr) * 72 + 32 * ks + 8 * fq); acc = MFMA16(a, b2, acc); }
#pragma unroll
        for (int ks = 0; ks < 3; ++ks) { const bf16x8 a = *(const LAS bf16x8*)(QP + (16 * ti + fr) * 104 + 32 * ks + 8 * fq), b2 = *(const LAS bf16x8*)(ST + (16 * vi + fr) * 104 + 32 * ks + 8 * fq); acc = MFMA16(a, b2, acc); }
#pragma unroll
        for (int j = 0; j < 4; ++j) OT[(16 * ti + 4 * fq + j) * 96 + 16 * vi + fr] = acc[j];
    }
    __syncthreads();
    bf16_t* oc = (bf16_t*)(p.ws + WS_OC);
    const float* gn = p.in[I_GLAN] + l * 384 + h * 96; const float gn0 = gn[lane], gn1 = lane < 32 ? gn[64 + lane] : 0.f;
    float g0[8], g1[8];
#pragma unroll
    for (int tt = 0; tt < 8; ++tt) { const int t = wv * 8 + tt; g0[tt] = 0.f; g1[tt] = 0.f;
        if (t < ntok) { const bf16_t* gp = proj + (row0 + t) * NINP + C_GC + h * 96; g0[tt] = bf2f(gp[lane]); if (lane < 32) g1[tt] = bf2f(gp[64 + lane]); } }
#pragma unroll
    for (int tt = 0; tt < 8; ++tt) {
        const int t = wv * 8 + tt;
        if (t < ntok) {
            const float a0 = OT[t * 96 + lane], a1 = lane < 32 ? OT[t * 96 + 64 + lane] : 0.f;
            const float rs = rsqrtf(wave_sum(a0 * a0 + a1 * a1) * (1.f / 96.f) + EPS);
            oc[(row0 + t) * 384 + h * 96 + lane] = f2bf(a0 * rs * gn0 * g0[tt] * sigmoidf_(g0[tt]));
            if (lane < 32) oc[(row0 + t) * 384 + h * 96 + 64 + lane] = f2bf(a1 * rs * gn1 * g1[tt] * sigmoidf_(g1[tt]));
        }
    }
}

DI void cross_sample_unit(const Ctx& p, int l, int b, int h, int qh, LAS unsigned char* lds) {
    LAS float* qs = (LAS float*)lds;
    LAS float* ST = qs + 8 * 256;
    LAS float* PART = ST + 256 * 8;
    const bf16_t* Q = (const bf16_t*)(p.ws + WS_Q);
    const int tid = pg8::tid_(), lane = tid & 63, wv = tid >> 6;
    const size_t srow = (size_t)MP + b * 16 + 8 * qh;
    for (int i = tid; i < 8 * 256; i += NTHR) qs[i] = bf2f(Q[(srow + (i >> 8)) * D + h * 256 + (i & 255)]) * 0.0625f;
    __syncthreads();
    const int m = tid & 255, half = tid >> 8;
    {
        float acc[8];
#pragma unroll
        for (int i = 0; i < 8; ++i) acc[i] = 0.f;
        const float* kp = p.in[I_CMK] + ((((size_t)l * DB + b) * 256 + m) * 4 + h) * 256 + 128 * half;
#pragma unroll 16
        for (int d4 = 0; d4 < 32; ++d4) {
            const f32x4 kv = *(const f32x4*)(kp + 4 * d4);
#pragma unroll
            for (int i = 0; i < 8; ++i) { const f32x4 q = *(const LAS f32x4*)(qs + i * 256 + 128 * half + 4 * d4); acc[i] += (q[0] * kv[0] + q[1] * kv[1]) + (q[2] * kv[2] + q[3] * kv[3]); }
        }
#pragma unroll
        for (int i = 0; i < 8; ++i) PART[(half * 8 + i) * 256 + m] = acc[i];
    }
    __syncthreads();
    {
        const int i = wv; float v[4], mx = -3.0e38f;
#pragma unroll
        for (int j = 0; j < 4; ++j) { v[j] = PART[i * 256 + lane + 64 * j] + PART[(8 + i) * 256 + lane + 64 * j]; mx = fmaxf(mx, v[j]); }
        mx = wave_max(mx); float sum = 0.f;
#pragma unroll
        for (int j = 0; j < 4; ++j) { v[j] = __expf(v[j] - mx); sum += v[j]; }
        sum = wave_sum(sum); const float inv = 1.f / sum;
#pragma unroll
        for (int j = 0; j < 4; ++j) ST[(lane + 64 * j) * 8 + i] = v[j] * inv;
    }
    __syncthreads();
    {
        float acc[8];
#pragma unroll
        for (int i = 0; i < 8; ++i) acc[i] = 0.f;
        const float* vp = p.in[I_CMV] + ((((size_t)l * DB + b) * 256 + 128 * half) * 4 + h) * 256 + m;
        for (int k0 = 0; k0 < 128; k0 += 32) {
            float v[32];
#pragma unroll
            for (int j = 0; j < 32; ++j) v[j] = vp[(size_t)(k0 + j) * 1024];
#pragma unroll
            for (int j = 0; j < 32; ++j) {
                const f32x4 s0 = *(const LAS f32x4*)(ST + (128 * half + k0 + j) * 8), s1 = *(const LAS f32x4*)(ST + (128 * half + k0 + j) * 8 + 4);
                acc[0] += s0[0] * v[j]; acc[1] += s0[1] * v[j]; acc[2] += s0[2] * v[j]; acc[3] += s0[3] * v[j];
                acc[4] += s1[0] * v[j]; acc[5] += s1[1] * v[j]; acc[6] += s1[2] * v[j]; acc[7] += s1[3] * v[j];
            }
        }
#pragma unroll
        for (int i = 0; i < 8; ++i) PART[(half * 8 + i) * 256 + m] = acc[i];
    }
    __syncthreads();
    bf16_t* O = (bf16_t*)(p.ws + WS_O);
    for (int i = tid; i < 8 * 256; i += NTHR) { const int qi = i >> 8, d = i & 255; O[(srow + qi) * D + h * 256 + d] = f2bf(PART[qi * 256 + d] + PART[(8 + qi) * 256 + d]); }
}

struct SkBf16 { bf16_t* O; int ldc; DI void operator()(int row, int col, f32x4 v) const { u32x2 w; w.x = pk2(v[0], v[1]); w.y = pk2(v[2], v[3]); *(u32x2*)(O + (size_t)(MP + row) * ldc + col) = w; } };
struct SkGate { bf16_t* merged; const bf16_t* proj; int goff; int accum;
    DI void operator()(int row, int col, f32x4 v) const {
        const u32x2 g = *(const u32x2*)(proj + (size_t)(MP + row) * NINP + goff + col); bf16_t* mp = merged + (size_t)(MP + row) * D + col;
        u32x2 pm2 = {0u, 0u}; if (accum) pm2 = *(const u32x2*)mp;
        u32x2 w; w.x = pk2(sigmoidf_(bflo(g.x)) * v[0] + bflo(pm2.x), sigmoidf_(bfhi(g.x)) * v[1] + bfhi(pm2.x)); w.y = pk2(sigmoidf_(bflo(g.y)) * v[2] + bflo(pm2.y), sigmoidf_(bfhi(g.y)) * v[3] + bfhi(pm2.y));
        *(u32x2*)mp = w; } };
template <class EF> DI void skinny_gemm(const bf16_t* A, int lda, const bf16_t* Bt, int ldb, int K, int N, int G, int bx, LAS unsigned char* lds, const EF& ef) {
    const int tid = pg8::tid_(), lane = tid & 63, wv = tid >> 6, fr = lane & 15, fq = lane >> 4, nks = K >> 5, nunits = 4 * (N >> 4);
    LAS f32x4* red = (LAS f32x4*)lds;
    for (int u = bx; u < nunits; u += G) {
        const int rb = u & 3, cb = u >> 2;
        f32x4 acc[4];
#pragma unroll
        for (int i = 0; i < 4; ++i) acc[i] = (f32x4){0.f, 0.f, 0.f, 0.f};
        const bf16_t* bp = Bt + (size_t)(16 * cb + fr) * ldb + 8 * fq; const bf16_t* ap = A + (size_t)(64 * rb + fr) * lda + 8 * fq;
        for (int ks = wv; ks < nks; ks += 8) {
            const bf16x8 bb = *(const bf16x8*)(bp + 32 * ks);
            bf16x8 aa[4];
#pragma unroll
            for (int i = 0; i < 4; ++i) aa[i] = *(const bf16x8*)(ap + (size_t)(16 * i) * lda + 32 * ks);
#pragma unroll
            for (int i = 0; i < 4; ++i) acc[i] = MFMA16(bb, aa[i], acc[i]);
        }
#pragma unroll
        for (int i = 0; i < 4; ++i) red[(wv * 4 + i) * 64 + lane] = acc[i];
        __syncthreads();
        if (tid < 256) {
            const int i = tid >> 6; f32x4 s = red[i * 64 + lane];
#pragma unroll
            for (int w = 1; w < 8; ++w) s = s + red[(w * 4 + i) * 64 + lane];
            ef(64 * rb + 16 * i + fr, 16 * cb + 4 * fq, s);
        }
        __syncthreads();
    }
}

constexpr int PH_PER_LAYER = 15, N_PHASES = 1 + DEPTH * PH_PER_LAYER;
#define RUN_GEMM(EpiT, E, Aptr, lda_, Bptr, ldb_, K_, pm0_, nM_, nN_) do { const pg8::Gemm g_{(K_), (lda_), (ldb_)}; pg8::TileOrder S_; S_.init((Aptr), (lda_), (Bptr), (ldb_), (pm0_), (nM_), (nN_), G, bx); \
        pg8::gemm_phase<EpiT, pg8::TileOrder, true, true>(lds, g_, S_, (E)); } while (0)

__global__ void __launch_bounds__(NTHR, 2) fwd_kernel(Params p) {
    extern __shared__ __attribute__((aligned(16))) unsigned char lds_raw[];
#define PROJ ((bf16_t*)(ws + WS_PROJ))
#define H ((bf16_t*)(ws + WS_XB))
#define MERGED ((bf16_t*)(ws + WS_MERGED))
#define Y ((bf16_t*)(ws + WS_Y))
#define QB ((bf16_t*)(ws + WS_Q))
#define PB ((bf16_t*)(ws + WS_P))
#define OB ((bf16_t*)(ws + WS_O))
#define ACT ((bf16_t*)(ws + WS_ACT))

    {
        volatile LAS unsigned* st0 = (volatile LAS unsigned*)((LAS unsigned char*)lds_raw + LDS_MISC + 32);
        if (pg8::tid_() == 0) { st0[0] = 0u; st0[1] = 0u; st0[8] = 0u; st0[9] = 0u; }
        __syncthreads();
    }
    XcdBarrier xbar = xcd_barrier_post((unsigned*)(p.ws + WS_CTL) + CW_BAR, (volatile LAS unsigned*)((LAS unsigned char*)lds_raw + LDS_MISC + 32));
    if (p.ph_lo == 0) {
        prologue(p, (LAS unsigned char*)lds_raw);
        if (blockIdx.x == 0 && pg8::tid_() == 0) {
            const float** tab = (const float**)(p.ws + WS_TAB);
#pragma unroll
            for (int i = 0; i < N_IN; ++i) tab[i] = p.in[i];
        }
        if (p.ph_hi > 1) xcd_barrier(xbar);
        if (p.ph_hi < 0) cg::this_grid().sync();
    }
    for (int ph = p.ph_lo > 1 ? p.ph_lo : 1; ph < p.ph_hi; ++ph) {
        unsigned ldsb = (unsigned)(size_t)(LAS unsigned char*)lds_raw; asm volatile("" : "+s"(ldsb));
        LAS unsigned char* lds = (LAS unsigned char*)(size_t)ldsb;
        volatile LAS int* slot = (volatile LAS int*)(lds + LDS_MISC);
        unsigned char* ws = p.ws; asm volatile("" : "+s"(ws));
        Ctx c; c.ws = ws; c.in.t = (const float* const*)(ws + WS_TAB); c.out = p.out;
        unsigned* ctl = (unsigned*)(ws + WS_CTL);
        int G = gridDim.x, bx = blockIdx.x; asm volatile("" : "+s"(G), "+s"(bx));
        {
            const int l = (ph - 1) / PH_PER_LAYER, st = (ph - 1) % PH_PER_LAYER;
#ifdef PROBE_SEL
            if (bx == 0) { volatile LAS unsigned long long* a_ = (volatile LAS unsigned long long*)(lds + LDS_MISC + 64); a_[1] = __builtin_amdgcn_s_memrealtime(); }
#endif
            switch (st) {
            case 0: {
                EpiBf16 E{PROJ, NINP, 0xffff};
                RUN_GEMM(EpiBf16, E, H, D, ws + WS_WIN + l * SZ_WIN, D, D, 0, MA / 256, NINP / 256);
                if (l == 0) {
                    const pg8::Gemm g{D, D, D}; MemKvOrder S{G, bx, (const char*)(ws + WS_MN), (const char*)(ws + WS_WKV)};
                    EpiBf16 E2{(bf16_t*)(ws + WS_MKV), 2048, 7};
                    pg8::gemm_phase<EpiBf16, MemKvOrder, true, true>(lds, g, S, E2);
                }
            } break;
            case 1: {
                unsigned* ctr = ctl + 64 * ph;
                constexpr int U_SBP = 384, U_SBS = U_SBP + DB * 6, U_GLA = U_SBS + NGU, U_POOL = U_GLA + MA / 64, U_KV = U_POOL + MA / 64, U_MO = U_KV + 512, U_VT = U_MO + 512;
                const int U_ALL = l == 0 ? U_VT : U_KV;
                for (;;) {
                    const int u = next_work(ctr, slot); if (u >= U_ALL) break;
#ifdef PROBE_SEL
                    const int ut_ = u < DB * 6 ? 10 : (u < U_SBS ? 11 : (u < U_GLA ? 12 : 13));
                    if (bx == 0 && ut_ == PROBE_SEL) { volatile LAS unsigned long long* a_ = (volatile LAS unsigned long long*)(lds + LDS_MISC + 64); a_[3] = __builtin_amdgcn_s_memrealtime(); }
#endif
                    if (u < DB * 6) sb_sample_unit(c, l, u / 6, u % 6, lds);
                    else if (u < U_SBS) { const int v = u - DB * 6, qb = 7 - v / 48, bh = v % 48; sb_prompt_unit(c, bh / 6, bh % 6, qb, lds); }
                    else if (u < U_GLA) gla_stage1_unit(c, l, u - U_SBS, lds);
                    else if (u < U_POOL) pool_unit(c, l, u - U_GLA);
                    else if (u < U_KV) kvout_unit(c, l, u - U_POOL);
                    else if (u < U_MO) memout_unit(c, u - U_KV);
                    else memvt_unit(c, u - U_MO);
#ifdef PROBE_SEL
                    if (bx == 0 && ut_ == PROBE_SEL) { volatile LAS unsigned long long* a_ = (volatile LAS unsigned long long*)(lds + LDS_MISC + 64); __hip_atomic_fetch_add((LAS unsigned long long*)a_, __builtin_amdgcn_s_memrealtime() - a_[3], __ATOMIC_RELAXED, __HIP_MEMORY_SCOPE_WORKGROUP); }
#endif
                }
            } break;
            case 2: gla_scan(c, l); break;
            case 3: {
                unsigned* ctr = ctl + 64 * ph;
                for (;;) { const int u = next_work(ctr, slot); if (u >= NGU) break; gla_stage3_unit(c, l, u, lds); }
            } break;
            case 4: {
                EpiGate E1{MERGED, PROJ, C_GA, 0}, E2{MERGED, PROJ, C_GB, 1}, E3{MERGED, PROJ, C_GCG, 1};
                RUN_GEMM(EpiGate, E1, ws + WS_OA, 384, ws + WS_WBA + l * SZ_WBA, 384, 384, 0, MP / 256, 4);
                RUN_GEMM(EpiGate, E2, ws + WS_POOLED, 256, ws + WS_WBB + l * SZ_WBB, 256, 256, 0, MP / 256, 4);
                RUN_GEMM(EpiGate, E3, ws + WS_OC, 384, ws + WS_WBC + l * SZ_WBA, 384, 384, 0, MP / 256, 4);
                { SkGate F1{MERGED, PROJ, C_GA, 0}, F2{MERGED, PROJ, C_GB, 1}, F3{MERGED, PROJ, C_GCG, 1};
                  skinny_gemm((const bf16_t*)(ws + WS_OA) + (size_t)MP * 384, 384, (const bf16_t*)(ws + WS_WBA + l * SZ_WBA), 384, 384, D, G, bx, lds, F1);
                  skinny_gemm((const bf16_t*)(ws + WS_POOLED) + (size_t)MP * 256, 256, (const bf16_t*)(ws + WS_WBB + l * SZ_WBB), 256, 256, D, G, bx, lds, F2);
                  skinny_gemm((const bf16_t*)(ws + WS_OC) + (size_t)MP * 384, 384, (const bf16_t*)(ws + WS_WBC + l * SZ_WBA), 384, 384, D, G, bx, lds, F3); }
            } break;
            case 5: { EpiBf16 E{Y, D, 0xffff}; RUN_GEMM(EpiBf16, E, MERGED, D, ws + WS_WMIX + l * SZ_WSQ, D, D, 0, MP / 256, 4);
                SkBf16 F{Y, D}; skinny_gemm((const bf16_t*)MERGED + (size_t)MP * D, D, (const bf16_t*)(ws + WS_WMIX + l * SZ_WSQ), D, D, D, G, bx, lds, F); } break;
            case 6: norm_phase(c, c.in[I_NMIXPOST] + l * D, false, G, bx); break;
            case 7: { EpiBf16 E{QB, D, 0xffff}; RUN_GEMM(EpiBf16, E, H, D, ws + WS_WXQ + l * SZ_WSQ, D, D, 0, MP / 256, 4);
                SkBf16 F{QB, D}; skinny_gemm((const bf16_t*)H + (size_t)MP * D, D, (const bf16_t*)(ws + WS_WXQ + l * SZ_WSQ), D, D, D, G, bx, lds, F); } break;
            case 8: {
                const pg8::Gemm g{256, D, 2048}; CrossOrder S{G, bx, (const char*)QB, (const char*)(ws + WS_MKV + (size_t)l * 2 * SZ_WKV), 0};
                EpiSoftmax E{PB, (LAS float*)(lds + LDS_X)};
                pg8::gemm_phase<EpiSoftmax, CrossOrder, true, true>(lds, g, S, E);
            } break;
            case 9: {
                const pg8::Gemm g{256, D, 2048}; CrossOrder S{G, bx, (const char*)PB, (const char*)(ws + WS_MEMVT + (size_t)l * SZ_WKV), 1};
                EpiBf16 E{OB, D, 0xffff};
                pg8::gemm_phase<EpiBf16, CrossOrder, true, true>(lds, g, S, E);
                for (int u = bx; u < DB * 4 * 2; u += G) { __syncthreads(); cross_sample_unit(c, l, u >> 3, (u >> 1) & 3, u & 1, lds); }
            } break;
            case 10: { EpiBf16 E{Y, D, 0xffff}; RUN_GEMM(EpiBf16, E, OB, D, ws + WS_WXO + l * SZ_WSQ, D, D, 0, MP / 256, 4);
                SkBf16 F{Y, D}; skinny_gemm((const bf16_t*)OB + (size_t)MP * D, D, (const bf16_t*)(ws + WS_WXO + l * SZ_WSQ), D, D, D, G, bx, lds, F); } break;
            case 11: norm_phase(c, c.in[I_NXPOST] + l * D, false, G, bx); break;
            case 12: { EpiSwiglu E{ACT}; RUN_GEMM(EpiSwiglu, E, H, D, ws + WS_WF1 + l * SZ_WF1, D, D, 0, MA / 256, FF2 / 256); } break;
            case 13: { EpiBf16 E{Y, D, 0xffff}; RUN_GEMM(EpiBf16, E, ACT, FF, ws + WS_WF2 + l * SZ_WF2, FF, FF, 0, MP / 256, 4);
                SkBf16 F{Y, D}; skinny_gemm((const bf16_t*)ACT + (size_t)MP * FF, FF, (const bf16_t*)(ws + WS_WF2 + l * SZ_WF2), FF, FF, D, G, bx, lds, F); } break;
            default: norm_phase(c, c.in[I_NFPOST] + l * D, l == DEPTH - 1, G, bx); break;
            }
#ifdef PROBE_SEL
            {
                const int sel = PROBE_SEL; bool hit = false;
                if (sel == 2) hit = (st == 0 || st == 4 || st == 5 || st == 7 || st == 10 || st == 12 || st == 13);
                if (sel == 3) hit = (st == 2 || st == 3);
                if (sel == 4) hit = (st == 8 || st == 9);
                if (sel == 5) hit = (st == 6 || st == 11 || st == 14);
                if (sel == 6) hit = (st == 1);
                if (sel == 7) hit = (st == 0);
                if (sel == 8) hit = (st == 12);
                if (sel == 9) hit = (st == 13);
                if (bx == 0 && hit) { volatile LAS unsigned long long* a_ = (volatile LAS unsigned long long*)(lds + LDS_MISC + 64); __hip_atomic_fetch_add((LAS unsigned long long*)a_, __builtin_amdgcn_s_memrealtime() - a_[1], __ATOMIC_RELAXED, __HIP_MEMORY_SCOPE_WORKGROUP); }
            }
#endif
        }
#ifdef PROBE_SEL
        if (bx == 0) { volatile LAS unsigned long long* a_ = (volatile LAS unsigned long long*)(lds + LDS_MISC + 64); a_[2] = __builtin_amdgcn_s_memrealtime(); }
#endif
        if (ph + 1 < p.ph_hi) { if ((ph - 1) % PH_PER_LAYER == 8) { asm volatile("s_waitcnt vmcnt(0)" ::: "memory"); __syncthreads(); __builtin_amdgcn_fence(__ATOMIC_ACQUIRE, "agent"); }   else xcd_barrier(xbar); }
#ifdef PROBE_SEL
        if (PROBE_SEL == 1 && bx == 0) { volatile LAS unsigned long long* a_ = (volatile LAS unsigned long long*)(lds + LDS_MISC + 64); __hip_atomic_fetch_add((LAS unsigned long long*)a_, __builtin_amdgcn_s_memrealtime() - a_[2], __ATOMIC_RELAXED, __HIP_MEMORY_SCOPE_WORKGROUP); }
#endif
    }
#ifdef PROBE_SEL
    __syncthreads();
    if (blockIdx.x == 0) {
        volatile LAS unsigned long long* a_ = (volatile LAS unsigned long long*)((LAS unsigned char*)lds_raw + LDS_MISC + 64);
        const unsigned long long d_ = a_[0] >> 9, s_ = __builtin_amdgcn_s_memrealtime();
        while (__builtin_amdgcn_s_memrealtime() - s_ < d_) __builtin_amdgcn_s_sleep(8);
    }
#endif
}

extern "C" void kernel_launch(void* const* d_in, const int* in_sizes, int n_in, void* d_out, int out_size, void* d_ws, size_t ws_size, hipStream_t stream) {
    static int grid = 0;
    if (grid == 0) {
        if (n_in != N_IN || (size_t)out_size != O_END || ws_size < WS_END) { fprintf(stderr, "kernel_launch: unexpected shapes: n_in %d out %d ws %zu (need %zu)\n", n_in, out_size, ws_size, (size_t)WS_END); grid = -1; return; }
        int dev = 0, cus = 0, per_cu = 0;
        (void)hipGetDevice(&dev); (void)hipDeviceGetAttribute(&cus, hipDeviceAttributeMultiprocessorCount, dev);
        (void)hipFuncSetAttribute((const void*)fwd_kernel, hipFuncAttributeMaxDynamicSharedMemorySize, LDS_BYTES);
        if (hipOccupancyMaxActiveBlocksPerMultiprocessor(&per_cu, (const void*)fwd_kernel, NTHR, LDS_BYTES) != hipSuccess || per_cu < 1) { fprintf(stderr, "kernel_launch: occupancy query gave %d\n", per_cu); per_cu = 1; }
        (void)hipGetLastError();
        grid = cus * per_cu;
    }
    if (grid < 0) return;
    (void)hipMemsetAsync((char*)d_ws + WS_CTL, 0, CTL_BYTES, stream);
    Params p{};
    for (int i = 0; i < N_IN; ++i) p.in[i] = (const float*)d_in[i];
    p.out = (float*)d_out; p.ws = (unsigned char*)d_ws;
#ifdef MULTI_LAUNCH
    for (int ph = 0; ph < N_PHASES; ++ph) { p.ph_lo = ph; p.ph_hi = ph + 1; hipLaunchKernelGGL(fwd_kernel, dim3(grid), dim3(NTHR), LDS_BYTES, stream, p); }
#else
    p.ph_lo = 0; p.ph_hi = N_PHASES;
    void* args[] = {&p};
    const hipError_t e = hipLaunchCooperativeKernel((const void*)fwd_kernel, dim3(grid), dim3(NTHR), args, LDS_BYTES, stream);
    if (e != hipSuccess) fprintf(stderr, "kernel_launch: cooperative launch failed: %s (grid %d)\n", hipGetErrorString(e), grid);
#endif
}
```

```cpp
#include <hip/hip_runtime.h>
#include <hip/hip_cooperative_groups.h>
#include <cstdio>
#include <cstdint>
namespace cg = cooperative_groups;

namespace pg8 {
#define PG8_LAS __attribute__((address_space(3)))
typedef unsigned short bf16_t;
typedef short bf16x8 __attribute__((ext_vector_type(8)));
typedef float f32x4 __attribute__((ext_vector_type(4)));
typedef unsigned u32x4 __attribute__((ext_vector_type(4)));
typedef unsigned u32x2 __attribute__((ext_vector_type(2)));
constexpr int BM = 256, BK = 64, HALF = 128, HTB = HALF * BK * 2  , STAGE_BYTES = 8 * HTB, NXCD = 8, WGM = 4;

__host__ __device__ __forceinline__ int lds_byte(int r, int c) { const int st = (r >> 4) * 2 + (c >> 5), rr = r & 15, cc = c & 31, ob = rr * 64 + cc * 2; return st * 1024 + (ob ^ (((ob >> 9) & 1) << 5)); }
__host__ __device__ __forceinline__ void stage_rc(int b, int& R, int& C) { const int st = b / 1024, sb = b % 1024, swz = sb ^ (((sb >> 9) & 1) << 5); R = (st >> 1) * 16 + swz / 64; C = (st & 1) * 32 + (swz % 64) / 2; }
__host__ __device__ __forceinline__ int perm32(int rho) { const int n = rho >> 4, i = rho & 15; return 8 * (i >> 2) + 4 * n + (i & 3); }

struct Unit { int pm, pn; const char* a; const char* b; };
struct Gemm { int K, lda, ldb; };

struct TileOrder {
    int nM, nN, G, c, lda, ldb; const char* A; const char* B;
    __device__ void init(const void* A_, int lda_, const void* B_, int ldb_, int, int nM_, int nN_, int G_, int c_) {
        A = (const char*)A_; B = (const char*)B_; lda = lda_; ldb = ldb_; nM = nM_; nN = nN_; G = G_; c = c_; }
    __device__ bool next(int i, Unit& u) const {
        const int nwg = nM * nN; const long L = (long)i * G + c; if (L >= nwg) return false;
        int wgid = (int)L; { const int q = nwg / NXCD, r = nwg % NXCD, xcd = wgid % NXCD, off = wgid / NXCD; wgid = (xcd < r ? xcd * (q + 1) : r * (q + 1) + (xcd - r) * q) + off; }
        const int nig = WGM * nN, gid = wgid / nig, fm = gid * WGM, gsz = (nM - fm) < WGM ? (nM - fm) : WGM;
        u.pm = fm + ((wgid % nig) % gsz); u.pn = (wgid % nig) / gsz; u.a = A + (size_t)u.pm * ((size_t)BM * 2 * lda); u.b = B + (size_t)u.pn * ((size_t)BM * 2 * ldb); return true;
    }
    __device__ __forceinline__ void a_ready(const Unit&) const {}
    __device__ __forceinline__ void done(const Unit&) const {}
};

__device__ __forceinline__ int tid_() { int t = threadIdx.x; asm volatile("" : "+v"(t)); return t; }
__device__ __forceinline__ unsigned cvt_pk_bf16(float lo, float hi) { unsigned r; asm volatile("v_cvt_pk_bf16_f32 %0, %1, %2" : "=v"(r) : "v"(lo), "v"(hi)); return r; }

template <class Epi, class Sched, bool ALIGN_EPI = false, bool SP2 = false>
__device__ __forceinline__ void gemm_phase(PG8_LAS unsigned char* lds, const Gemm g, const Sched& S, const Epi& E) {
    const int tid = pg8::tid_(), wid = __builtin_amdgcn_readfirstlane(tid >> 6), lane = tid & 63, wr = wid >> 2, wc = wid & 3, fr = lane & 15, fq = lane >> 4;
    const int K = g.K, nt = K / BK;
    unsigned voffA, voffB;
    { int R, C; stage_rc(tid * 16, R, C); const int Rb = Epi::PERM ? ((R & ~31) + perm32(R & 31)) : R;
        voffA = (unsigned)(R * g.lda + C) * 2u; voffB = (unsigned)(Rb * g.ldb + C) * 2u; }
    const size_t qstepA = (size_t)64 * g.lda * 2, qstepB = (size_t)64 * g.ldb * 2;
    const size_t kstep = (size_t)(BK * 2);
    const size_t hstepA = (size_t)HALF * g.lda * 2, hstepB = (size_t)HALF * g.ldb * 2;
    const unsigned ldsw = (unsigned)wid * 1024u;
    const int aoff = lds_byte(wr * 64 + fr, fq * 8), boff = lds_byte(wc * 32 + fr, fq * 8);
#define PG8_SA(b, h) (((b) * 2 + (h)) * HTB)
#define PG8_SB(b, h) ((4 + (b) * 2 + (h)) * HTB)
#define PG8_STAGE(bufoff, gbase, voff) do { _Pragma("unroll") for (int _i = 0; _i < 2; ++_i) { const char* sb_ = (const char*)(gbase) + (size_t)_i * q##voff; asm volatile("" : "+s"(sb_));   \
        __builtin_amdgcn_global_load_lds((const unsigned*)(sb_ + (voff)), (PG8_LAS unsigned*)(lds + (bufoff) + ldsw + _i * 8192), 16, 0, 0); } } while (0)
#define qvoffA qstepA
#define qvoffB qstepB
#define PG8_LDA(dst, b, h) do { _Pragma("unroll") for (int m = 0; m < 4; ++m) _Pragma("unroll") for (int k = 0; k < 2; ++k) dst[m][k] = *(const PG8_LAS bf16x8*)(lds + PG8_SA(b, h) + aoff + m * 2048 + k * 1024); } while (0)
#define PG8_LDB(dst, b, h) do { _Pragma("unroll") for (int n = 0; n < 2; ++n) _Pragma("unroll") for (int k = 0; k < 2; ++k) dst[n][k] = *(const PG8_LAS bf16x8*)(lds + PG8_SB(b, h) + boff + n * 2048 + k * 1024); } while (0)
#define PG8_MMA(ai, bj, At, Bt) do { __builtin_amdgcn_s_setprio(1); _Pragma("unroll") for (int m = 0; m < 4; ++m) _Pragma("unroll") for (int n = 0; n < 2; ++n) _Pragma("unroll") for (int k = 0; k < 2; ++k) \
        acc[ai][bj][m][n] = __builtin_amdgcn_mfma_f32_16x16x32_bf16(Bt[n][k], At[m][k], acc[ai][bj][m][n], 0, 0, 0); __builtin_amdgcn_s_setprio(0); } while (0)
#define PG8_WAIT_V(n) asm volatile("s_waitcnt vmcnt(" #n ")" ::: "memory")
#define PG8_WAIT_L(n) asm volatile("s_waitcnt lgkmcnt(" #n ")" ::: "memory")
#define PG8_BAR __builtin_amdgcn_s_barrier()
#define PG8_SCHED __builtin_amdgcn_sched_barrier(0)
    Unit cur, nxt; int ui = 0;
    if (!S.next(0, cur)) return;
    f32x4 acc[2][2][4][2];
#pragma unroll
    for (int a = 0; a < 2; ++a)
#pragma unroll
        for (int b = 0; b < 2; ++b)
#pragma unroll
            for (int m = 0; m < 4; ++m)
#pragma unroll
                for (int n = 0; n < 2; ++n) acc[a][b][m][n] = (f32x4){0.f, 0.f, 0.f, 0.f};
    bf16x8 At[4][2], B0[2][2], B1[2][2];
    const char* cA = cur.a; const char* cB = cur.b;
    S.a_ready(cur);
    if constexpr (SP2) {
        PG8_STAGE(PG8_SB(0, 0), cB, voffB); PG8_STAGE(PG8_SB(0, 1), cB + hstepB, voffB); PG8_STAGE(PG8_SA(0, 0), cA, voffA); PG8_STAGE(PG8_SA(0, 1), cA + hstepA, voffA);
        if (wr == 1) PG8_BAR;
        PG8_WAIT_V(2); PG8_BAR;
        PG8_STAGE(PG8_SB(1, 0), cB + kstep, voffB); PG8_STAGE(PG8_SA(1, 0), cA + kstep, voffA); PG8_STAGE(PG8_SB(1, 1), cB + hstepB + kstep, voffB);
        PG8_WAIT_V(6); PG8_BAR;
    } else {
        PG8_STAGE(PG8_SB(0, 0), cB, voffB); PG8_STAGE(PG8_SA(0, 0), cA, voffA); PG8_STAGE(PG8_SB(0, 1), cB + hstepB, voffB); PG8_STAGE(PG8_SA(0, 1), cA + hstepA, voffA);
        if (wr == 1) PG8_BAR;
        PG8_WAIT_V(4); PG8_BAR;
        PG8_STAGE(PG8_SB(1, 0), cB + kstep, voffB); PG8_STAGE(PG8_SA(1, 0), cA + kstep, voffA); PG8_STAGE(PG8_SB(1, 1), cB + hstepB + kstep, voffB);
        PG8_WAIT_V(6); PG8_BAR;
    }
    for (;;) {
        const bool has_next = S.next(ui + 1, nxt);
        const char* nA = has_next ? nxt.a : cA; const char* nB = has_next ? nxt.b : cB;
        for (int t = 0; t < nt; t += 2) {
            const bool last = (t == nt - 2);
            const char* a1 = cA + (size_t)(t + 1) * kstep;
            const char* a2 = last ? nA : cA + (size_t)(t + 2) * kstep; const char* b2 = last ? nB : cB + (size_t)(t + 2) * kstep;
            const char* a3 = a2 + kstep; const char* b3 = b2 + kstep;
            if (last && has_next) S.a_ready(nxt);
            if constexpr (SP2) {
            PG8_LDB(B0, 0, 0); PG8_LDB(B1, 0, 1); PG8_SCHED; PG8_LDA(At, 0, 0); PG8_STAGE(PG8_SA(1, 1), a1 + hstepA, voffA);
            PG8_WAIT_V(8); PG8_WAIT_L(0); PG8_BAR; PG8_MMA(0, 0, At, B0); PG8_MMA(0, 1, At, B1); PG8_BAR; PG8_SCHED;
            PG8_LDA(At, 0, 1); PG8_STAGE(PG8_SB(0, 0), b2, voffB); PG8_STAGE(PG8_SB(0, 1), b2 + hstepB, voffB); PG8_STAGE(PG8_SA(0, 0), a2, voffA);
            PG8_WAIT_V(8); PG8_WAIT_L(0); PG8_BAR; PG8_MMA(1, 0, At, B0); PG8_MMA(1, 1, At, B1); PG8_BAR; PG8_SCHED;
            PG8_LDB(B0, 1, 0); PG8_LDB(B1, 1, 1); PG8_SCHED; PG8_LDA(At, 1, 0); PG8_STAGE(PG8_SA(0, 1), a2 + hstepA, voffA);
            PG8_WAIT_V(8); PG8_WAIT_L(0); PG8_BAR; PG8_MMA(0, 0, At, B0); PG8_MMA(0, 1, At, B1); PG8_BAR; PG8_SCHED;
            PG8_LDA(At, 1, 1); PG8_STAGE(PG8_SB(1, 0), b3, voffB); PG8_STAGE(PG8_SB(1, 1), b3 + hstepB, voffB); PG8_STAGE(PG8_SA(1, 0), a3, voffA);
            PG8_WAIT_V(8); PG8_WAIT_L(0); PG8_BAR; PG8_MMA(1, 0, At, B0); PG8_MMA(1, 1, At, B1); PG8_BAR; PG8_SCHED;
            } else {
            PG8_LDB(B0, 0, 0); PG8_SCHED; PG8_LDA(At, 0, 0); PG8_STAGE(PG8_SA(1, 1), a1 + hstepA, voffA);
            PG8_WAIT_L(8); PG8_BAR; PG8_WAIT_L(0); PG8_MMA(0, 0, At, B0); PG8_BAR; PG8_SCHED;
            PG8_LDB(B1, 0, 1); PG8_STAGE(PG8_SB(0, 0), b2, voffB);
            PG8_BAR; PG8_WAIT_L(0); PG8_MMA(0, 1, At, B1); PG8_BAR;
            PG8_LDA(At, 0, 1); PG8_STAGE(PG8_SA(0, 0), a2, voffA);
            PG8_BAR; PG8_WAIT_L(0); PG8_MMA(1, 0, At, B0); PG8_BAR; PG8_SCHED;
            PG8_STAGE(PG8_SB(0, 1), b2 + hstepB, voffB);
            PG8_WAIT_V(6); PG8_BAR; PG8_MMA(1, 1, At, B1); PG8_BAR;
            PG8_LDB(B0, 1, 0); PG8_SCHED; PG8_LDA(At, 1, 0); PG8_STAGE(PG8_SA(0, 1), a2 + hstepA, voffA);
            PG8_WAIT_L(8); PG8_BAR; PG8_WAIT_L(0); PG8_MMA(0, 0, At, B0); PG8_BAR; PG8_SCHED;
            PG8_LDB(B1, 1, 1); PG8_STAGE(PG8_SB(1, 0), b3, voffB);
            PG8_BAR; PG8_WAIT_L(0); PG8_MMA(0, 1, At, B1); PG8_BAR;
            PG8_LDA(At, 1, 1); PG8_STAGE(PG8_SA(1, 0), a3, voffA);
            PG8_BAR; PG8_WAIT_L(0); PG8_MMA(1, 0, At, B0); PG8_BAR; PG8_SCHED;
            PG8_STAGE(PG8_SB(1, 1), b3 + hstepB, voffB);
            PG8_WAIT_V(6); PG8_BAR; PG8_MMA(1, 1, At, B1); PG8_BAR;
            }
        }
        if constexpr (ALIGN_EPI) { if (wr == 0) PG8_BAR; }
        if constexpr (!Epi::AFTER_DRAIN) { const int l2_ = tid_() & 63, fr2 = l2_ & 15, fq2 = l2_ >> 4;   E(acc, cur, wr, wc, fr2, fq2); S.done(cur); }
        if (!has_next) break;
#pragma unroll
        for (int a = 0; a < 2; ++a)
#pragma unroll
            for (int b = 0; b < 2; ++b)
#pragma unroll
                for (int m = 0; m < 4; ++m)
#pragma unroll
                    for (int n = 0; n < 2; ++n) acc[a][b][m][n] = (f32x4){0.f, 0.f, 0.f, 0.f};
        cur = nxt; cA = nA; cB = nB; ++ui;
        if constexpr (ALIGN_EPI) { if (wr == 1) PG8_BAR; }
    }
    PG8_WAIT_V(0);
    if constexpr (!ALIGN_EPI) { if (wr == 0) PG8_BAR; }
    PG8_BAR;
    if constexpr (Epi::AFTER_DRAIN) { E.fused(acc, cur, wr, wc, fr, fq, lds, wid, lane); S.done(cur); }
#undef PG8_SA
#undef PG8_SB
#undef PG8_STAGE
#undef qvoffA
#undef qvoffB
#undef PG8_LDA
#undef PG8_LDB
#undef PG8_MMA
#undef PG8_WAIT_V
#undef PG8_WAIT_L
#undef PG8_BAR
#undef PG8_SCHED
}
}

using pg8::bf16_t; using pg8::f32x4; using pg8::bf16x8; using pg8::u32x4; using pg8::u32x2;
#define DI __device__ __forceinline__
#define LAS __attribute__((address_space(3)))
typedef float f32x16 __attribute__((ext_vector_type(16)));
typedef short s16x4 __attribute__((ext_vector_type(4)));
typedef float f32x2_t __attribute__((ext_vector_type(2))); typedef __bf16 bf16x2_t __attribute__((ext_vector_type(2)));

constexpr int NTHR = 512, NWAVES = 8;
constexpr int D = 1024, NB = 8, SEQ = 2048, DEPTH = 4, DB = 16, DT = 16, PAST = 1024;
constexpr int MP = NB * SEQ, MS = DB * DT, MA = MP + MS;
constexpr int NIN = 6032, NINP = 6144;
constexpr int C_QA = 0, C_KA = 384, C_VA = 768, C_U = 1152, C_QC = 1408, C_KC = 1792, C_VC = 2176, C_GC = 2560, C_LR = 2944, C_GA = 2960, C_GB = 3984, C_GCG = 5008;
constexpr int FF = 2816, FF2 = 5632;
constexpr int GH = 4, GK = 96;
constexpr int NGU_P = NB * GH * 32, NGU_S = DB * GH, NGU = NGU_P + NGU_S;
constexpr float EPS = 1e-6f;

constexpr size_t O_YP = 0, O_YS = O_YP + (size_t)MP * D, O_KP = O_YS + (size_t)MS * D, O_VP = O_KP + (size_t)DEPTH * MP * 384, O_POOLP = O_VP + (size_t)DEPTH * MP * 384,
    O_GLAP = O_POOLP + (size_t)DEPTH * NB * 15 * 256, O_MKP = O_GLAP + (size_t)DEPTH * NB * GH * GK * GK, O_MVP = O_MKP + (size_t)DEPTH * NB * 256 * D,
    O_KS = O_MVP + (size_t)DEPTH * NB * 256 * D, O_VS = O_KS + (size_t)DEPTH * MS * 384, O_POOLS = O_VS + (size_t)DEPTH * MS * 384, O_GLAS = O_POOLS + (size_t)DEPTH * DB * 15 * 256,
    O_END = O_GLAS + (size_t)DEPTH * DB * GH * GK * GK;

enum { I_XP = 0, I_XS, I_MEM, I_CSK, I_CSV, I_SPOOL, I_SGLA, I_CMK, I_CMV, I_WIN, I_WA2, I_BA, I_GLAN, I_WPOOL, I_PSCALE, I_WBA, I_WBB, I_WBC, I_WMIX, I_MEMN, I_WXQ, I_WXK, I_WXV, I_WXO,
       I_WF1, I_WF2, I_NMIXPRE, I_NMIXPOST, I_NXPRE, I_NXPOST, I_NFPRE, I_NFPOST, N_IN };

constexpr size_t MiB = 1u << 20;
constexpr size_t SZ_WIN = (size_t)NINP * D * 2, SZ_WBA = (size_t)D * 384 * 2, SZ_WBB = (size_t)D * 256 * 2, SZ_WSQ = (size_t)D * D * 2, SZ_WKV = 2 * SZ_WSQ, SZ_WF1 = (size_t)FF2 * D * 2, SZ_WF2 = (size_t)D * FF * 2;
constexpr size_t WS_CTL = 0, CTL_BYTES = 1 * MiB, WS_TAB = CTL_BYTES - 4096;
constexpr size_t WS_WIN = WS_CTL + CTL_BYTES, WS_WBA = WS_WIN + 4 * SZ_WIN, WS_WBB = WS_WBA + 4 * SZ_WBA, WS_WBC = WS_WBB + 4 * SZ_WBB, WS_WMIX = WS_WBC + 4 * SZ_WBA,
    WS_WXQ = WS_WMIX + 4 * SZ_WSQ, WS_WXO = WS_WXQ + 4 * SZ_WSQ, WS_WKV = WS_WXO + 4 * SZ_WSQ, WS_WF1 = WS_WKV + 4 * SZ_WKV, WS_WF2 = WS_WF1 + 4 * SZ_WF1,
    WS_MN = WS_WF2 + 4 * SZ_WF2, WS_MKV = WS_MN + 4 * SZ_WKV, WS_MEMVT = WS_MKV + 8 * SZ_WKV, WS_PROJ = WS_MEMVT + 4 * SZ_WKV;
constexpr size_t SZ_ROWS = (size_t)MA * D * 2;
constexpr size_t SZ_PROJ = (size_t)MA * NINP * 2;
constexpr size_t WS_Q = WS_PROJ, WS_P = WS_Q + SZ_ROWS, WS_O = WS_P + SZ_ROWS, WS_ACT = WS_O + SZ_ROWS;
static_assert(WS_ACT + (size_t)MA * FF * 2 <= WS_PROJ + SZ_PROJ, "overlay fits");
constexpr size_t WS_H = WS_PROJ + SZ_PROJ, WS_MERGED = WS_H + SZ_ROWS, WS_Y = WS_MERGED + SZ_ROWS;
constexpr size_t WS_GKV = WS_H, WS_GSP = WS_GKV + 39 * MiB, WS_GDEC = WS_GSP + 37 * MiB;
static_assert((size_t)NGU * GK * GK * 4 <= 39 * MiB && (size_t)NGU_P * GK * GK * 4 <= 37 * MiB && WS_GDEC + (size_t)NGU * GK * 4 <= WS_Y + SZ_ROWS, "GLA overlay fits");
constexpr size_t WS_OA = WS_Y + SZ_ROWS, WS_POOLED = WS_OA + (size_t)MA * 384 * 2, WS_OC = WS_POOLED + (size_t)MA * 256 * 2, WS_BB = WS_OC + (size_t)MA * 384 * 2, WS_XB = WS_BB + (size_t)NGU * 64 * GK * 4, WS_RN = WS_XB + SZ_ROWS, WS_END = WS_RN + (size_t)MA * 4;
static_assert(WS_WIN % 256 == 0 && WS_PROJ % 256 == 0 && WS_H % 256 == 0 && WS_OA % 256 == 0 && WS_POOLED % 256 == 0 && WS_OC % 256 == 0 && WS_P % 256 == 0, "alignment");

constexpr int CW_BAR = 16384;
constexpr int LDS_GEMM = 131072, LDS_X = LDS_GEMM, LDS_X_BYTES = 12288, LDS_MISC = LDS_X + LDS_X_BYTES, LDS_BYTES = LDS_MISC + 256;

struct Params { const float* in[N_IN]; float* out; unsigned char* ws; int ph_lo, ph_hi; };
struct InTab { const float* const* t;
    __device__ __forceinline__ const float* operator[](int i) const { const unsigned long long v = (unsigned long long)t[i];
        const unsigned lo = __builtin_amdgcn_readfirstlane((unsigned)v), hi = __builtin_amdgcn_readfirstlane((unsigned)(v >> 32)); return (const float*)(((unsigned long long)hi << 32) | lo); } };
struct Ctx { InTab in; float* out; unsigned char* ws; };

DI float bflo(unsigned w) { return __uint_as_float(w << 16); }
DI float bfhi(unsigned w) { return __uint_as_float(w & 0xffff0000u); }
DI float bf2f(unsigned short v) { return __uint_as_float((unsigned)v << 16); }
DI unsigned pk2(float lo, float hi) { f32x2_t v = {lo, hi}; bf16x2_t b = __builtin_convertvector(v, bf16x2_t); return __builtin_bit_cast(unsigned, b); }
DI unsigned short f2bf(float f) { return (unsigned short)(pk2(f, 0.f) & 0xffffu); }
DI float wave_sum(float v) {
#pragma unroll
    for (int o = 1; o < 64; o <<= 1) v += __shfl_xor(v, o);
    return v;
}
DI float wave_max(float v) {
#pragma unroll
    for (int o = 1; o < 64; o <<= 1) v = fmaxf(v, __shfl_xor(v, o));
    return v;
}
DI float sigmoidf_(float x) { return __builtin_amdgcn_rcpf(1.f + __expf(-x)); }
DI float softplusf_(float z) { return fmaxf(z, 0.f) + __logf(1.f + __expf(-fabsf(z))); }
DI int next_work(unsigned* ctr, volatile LAS int* slot) {
    __syncthreads();
    if (pg8::tid_() == 0) *slot = (int)atomicAdd(ctr, 1u);
    __syncthreads();
    return *slot;
}

typedef const pg8::f32x4 (&AccRef)[2][2][4][2];
struct EpiBf16 {
    static constexpr bool PERM = true, AFTER_DRAIN = false;
    bf16_t* O; int ldc; int pnmask;
    DI void operator()(AccRef acc, const pg8::Unit& u, int wr, int wc, int fr, int fq) const {
#pragma unroll
        for (int ai = 0; ai < 2; ++ai)
#pragma unroll
            for (int m = 0; m < 4; ++m) {
                bf16_t* rowp = O + (size_t)(u.pm * 256 + ai * 128 + wr * 64 + m * 16 + fr) * ldc + (u.pn & pnmask) * 256 + wc * 32 + 8 * fq;
#pragma unroll
                for (int bj = 0; bj < 2; ++bj) {
                    const f32x4 v0 = acc[ai][bj][m][0], v1 = acc[ai][bj][m][1];
                    u32x4 w; w.x = pk2(v0[0], v0[1]); w.y = pk2(v0[2], v0[3]); w.z = pk2(v1[0], v1[1]); w.w = pk2(v1[2], v1[3]);
                    *(u32x4*)(rowp + bj * 128) = w;
                }
            }
    }
};
struct EpiGate {
    static constexpr bool PERM = true, AFTER_DRAIN = false;
    bf16_t* merged; const bf16_t* proj; int goff; int accum;
    DI void operator()(AccRef acc, const pg8::Unit& u, int wr, int wc, int fr, int fq) const {
#pragma unroll
        for (int ai = 0; ai < 2; ++ai)
#pragma unroll
            for (int m = 0; m < 4; ++m) {
                const int row = u.pm * 256 + ai * 128 + wr * 64 + m * 16 + fr;
                const bf16_t* gp = proj + (size_t)row * NINP + goff + u.pn * 256 + wc * 32 + 8 * fq;
                bf16_t* mp = merged + (size_t)row * D + u.pn * 256 + wc * 32 + 8 * fq;
                u32x4 g[2], pm4[2];
#pragma unroll
                for (int bj = 0; bj < 2; ++bj) { g[bj] = *(const u32x4*)(gp + bj * 128); pm4[bj] = (u32x4){0u, 0u, 0u, 0u}; if (accum) pm4[bj] = *(const u32x4*)(mp + bj * 128); }
#pragma unroll
                for (int bj = 0; bj < 2; ++bj) {
                    const f32x4 v0 = acc[ai][bj][m][0], v1 = acc[ai][bj][m][1];
                    u32x4 w;
                    w.x = pk2(sigmoidf_(bflo(g[bj].x)) * v0[0] + bflo(pm4[bj].x), sigmoidf_(bfhi(g[bj].x)) * v0[1] + bfhi(pm4[bj].x));
                    w.y = pk2(sigmoidf_(bflo(g[bj].y)) * v0[2] + bflo(pm4[bj].y), sigmoidf_(bfhi(g[bj].y)) * v0[3] + bfhi(pm4[bj].y));
                    w.z = pk2(sigmoidf_(bflo(g[bj].z)) * v1[0] + bflo(pm4[bj].z), sigmoidf_(bfhi(g[bj].z)) * v1[1] + bfhi(pm4[bj].z));
                    w.w = pk2(sigmoidf_(bflo(g[bj].w)) * v1[2] + bflo(pm4[bj].w), sigmoidf_(bfhi(g[bj].w)) * v1[3] + bfhi(pm4[bj].w));
                    *(u32x4*)(mp + bj * 128) = w;
                }
                if (m & 1) asm volatile("" ::: "memory");
            }
    }
};
struct EpiSwiglu {
    static constexpr bool PERM = true, AFTER_DRAIN = false;
    bf16_t* act;
    DI void operator()(AccRef acc, const pg8::Unit& u, int wr, int wc, int fr, int fq) const {
#pragma unroll
        for (int ai = 0; ai < 2; ++ai)
#pragma unroll
            for (int m = 0; m < 4; ++m) {
                const int row = u.pm * 256 + ai * 128 + wr * 64 + m * 16 + fr;
#pragma unroll
                for (int bj = 0; bj < 2; ++bj) {
                    const int col0 = u.pn * 256 + bj * 128 + wc * 32 + 8 * fq;
                    const f32x4 g = acc[ai][bj][m][0], up = acc[ai][bj][m][1];
                    float r[4];
#pragma unroll
                    for (int j = 0; j < 4; ++j) r[j] = g[j] * sigmoidf_(g[j]) * up[j];
                    u32x2 w; w.x = pk2(r[0], r[1]); w.y = pk2(r[2], r[3]);
                    *(u32x2*)(act + (size_t)row * FF + (col0 >> 1)) = w;
                }
            }
    }
};
struct MemKvOrder {
    int G, c; const char* A; const char* B;
    DI bool next(int i, pg8::Unit& u) const {
        const int L = i * G + c; if (L >= 256) return false;
        const int l = L >> 6, r = L & 63; u.pm = l * 8 + (r & 7); u.pn = l * 8 + (r >> 3);
        u.a = A + (size_t)u.pm * (256 * D * 2); u.b = B + (size_t)u.pn * (256 * D * 2); return true;
    }
    DI void a_ready(const pg8::Unit&) const {}
    DI void done(const pg8::Unit&) const {}
};
struct CrossOrder {
    int G, c; const char* A; const char* B; int mode;
    DI bool next(int i, pg8::Unit& u) const {
        const int L = i * G + c; if (L >= 256) return false;
        u.pm = L >> 2; u.pn = L & 3; const int b = u.pm >> 3, h = u.pn;
        u.a = A + ((size_t)u.pm * 256 * D + h * 256) * 2;
        u.b = mode == 0 ? B + ((size_t)b * 256 * 2048 + h * 256) * 2 : B + ((size_t)h * 256 * 2048 + b * 256) * 2;
        return true;
    }
    DI void a_ready(const pg8::Unit&) const {}
    DI void done(const pg8::Unit&) const {}
};
struct EpiSoftmax {
    static constexpr bool PERM = true, AFTER_DRAIN = false;
    bf16_t* P; LAS float* xs;
    DI void operator()(AccRef acc, const pg8::Unit& u, int wr, int wc, int fr, int fq) const {
        const float sc = 0.0625f * 1.4426950408889634f;
        LAS float* xm = xs; LAS float* xsum = xs + 1024;
#pragma unroll
        for (int ai = 0; ai < 2; ++ai)
#pragma unroll
            for (int m = 0; m < 4; ++m) {
                float a = -3.0e38f;
#pragma unroll
                for (int bj = 0; bj < 2; ++bj)
#pragma unroll
                    for (int n = 0; n < 2; ++n) { const f32x4 v = acc[ai][bj][m][n]; a = fmaxf(a, fmaxf(fmaxf(v[0], v[1]), fmaxf(v[2], v[3]))); }
                a = fmaxf(a, __shfl_xor(a, 16)); a = fmaxf(a, __shfl_xor(a, 32));
                if (fq == 0) xm[(ai * 128 + wr * 64 + m * 16 + fr) * 4 + wc] = a;
                asm volatile("" ::: "memory");
            }
        __syncthreads();
#pragma unroll
        for (int ai = 0; ai < 2; ++ai)
#pragma unroll
            for (int m = 0; m < 4; ++m) {
                const f32x4 t = *(LAS f32x4*)(xm + (ai * 128 + wr * 64 + m * 16 + fr) * 4); const float mx = fmaxf(fmaxf(t[0], t[1]), fmaxf(t[2], t[3])) * sc;
                float s = 0.f;
#pragma unroll
                for (int bj = 0; bj < 2; ++bj)
#pragma unroll
                    for (int n = 0; n < 2; ++n)
#pragma unroll
                        for (int j = 0; j < 4; ++j) s += __builtin_amdgcn_exp2f(acc[ai][bj][m][n][j] * sc - mx);
                s += __shfl_xor(s, 16); s += __shfl_xor(s, 32);
                if (fq == 0) xsum[(ai * 128 + wr * 64 + m * 16 + fr) * 4 + wc] = s;
                asm volatile("" ::: "memory");
            }
        __syncthreads();
#pragma unroll
        for (int ai = 0; ai < 2; ++ai)
#pragma unroll
            for (int m = 0; m < 4; ++m) {
                const f32x4 t = *(LAS f32x4*)(xm + (ai * 128 + wr * 64 + m * 16 + fr) * 4); const float mx = fmaxf(fmaxf(t[0], t[1]), fmaxf(t[2], t[3])) * sc;
                const f32x4 t2 = *(LAS f32x4*)(xsum + (ai * 128 + wr * 64 + m * 16 + fr) * 4); const float inv = __builtin_amdgcn_rcpf((t2[0] + t2[1]) + (t2[2] + t2[3]));
                bf16_t* rowp = P + (size_t)(u.pm * 256 + ai * 128 + wr * 64 + m * 16 + fr) * D + u.pn * 256 + wc * 32 + 8 * fq;
#pragma unroll
                for (int bj = 0; bj < 2; ++bj)
#pragma unroll
                    for (int n = 0; n < 2; ++n) {
                        const f32x4 v = acc[ai][bj][m][n];
                        u32x2 w; w.x = pk2(__builtin_amdgcn_exp2f(v[0] * sc - mx) * inv, __builtin_amdgcn_exp2f(v[1] * sc - mx) * inv); w.y = pk2(__builtin_amdgcn_exp2f(v[2] * sc - mx) * inv, __builtin_amdgcn_exp2f(v[3] * sc - mx) * inv);
                        *(u32x2*)(rowp + bj * 128 + 4 * n) = w;
                    }
                asm volatile("" ::: "memory");
            }
        __syncthreads();
    }
};

#define XB_TMO      128
#define XB_XCNT(j)  (256  + 64 * (j))
#define XB_XSUB(j)  (1280 + 64 * (j))
#define XB_XGEN(j)  (2304 + 64 * (j))
#define XB_TOP      3328
#define XB_TOPGEN   3392
#define XCD_BAR_WORDS 3456
#define XB_SPIN_CAP (1u << 18)

__device__ __forceinline__ unsigned xb_ld(unsigned* p)              { return __hip_atomic_load(p, __ATOMIC_RELAXED, __HIP_MEMORY_SCOPE_AGENT); }
__device__ __forceinline__ unsigned xb_add(unsigned* p, unsigned v) { return __hip_atomic_fetch_add(p, v, __ATOMIC_RELAXED, __HIP_MEMORY_SCOPE_AGENT); }
__device__ __forceinline__ unsigned xb_xcc_id() { return (unsigned)__builtin_amdgcn_s_getreg((3 << 11) | 20) & 0xFu; }
#define XB_SPIN(cond, bar) do { unsigned _sp = 0; while (cond) { __builtin_amdgcn_s_sleep(1); \
    if ((++_sp & 255u) == 0u) { if (xb_ld(&(bar)[XB_TMO])) break; if (_sp > XB_SPIN_CAP) { atomicAdd(&(bar)[XB_TMO], 1u); break; } } } } while (0)

struct XcdBarrier {
    unsigned* bar; unsigned x;
    volatile LAS unsigned* st;
};

__device__ __forceinline__ XcdBarrier xcd_barrier_post(unsigned* bar, volatile LAS unsigned* st) {
    XcdBarrier b; b.bar = bar; b.x = xb_xcc_id(); b.st = st;
    if (threadIdx.x == 0) (void)xb_add(&bar[XB_XCNT(b.x)], 1u);
    return b;
}
__device__ __forceinline__ void xcd_barrier_complete(unsigned* bar, unsigned x, unsigned& nloc, unsigned& nx) {
    const unsigned G = gridDim.x * gridDim.y * gridDim.z;
    unsigned sum, cnt, mine, sp = 0u;
    for (;;) {
        sum = 0u; cnt = 0u; mine = 0u;
#pragma unroll
        for (unsigned j = 0; j < 16; ++j) { const unsigned c = xb_ld(&bar[XB_XCNT(j)]); sum += c; cnt += (c > 0u) ? 1u : 0u; mine = (j == x) ? c : mine; }
        if (sum == G) break;
        __builtin_amdgcn_s_sleep(1);
        if ((++sp & 255u) == 0u) { if (xb_ld(&bar[XB_TMO])) break; if (sp > XB_SPIN_CAP) { atomicAdd(&bar[XB_TMO], 1u); break; } }
    }
    nloc = mine > 0u ? mine : 1u; nx = cnt > 0u ? cnt : 1u;
}

__device__ __forceinline__ void xcd_barrier(const XcdBarrier& b) {
    asm volatile("s_waitcnt vmcnt(0)" ::: "memory");
    __syncthreads();
    if (threadIdx.x == 0) {
        unsigned* bar = b.bar;
        __builtin_amdgcn_s_waitcnt(0);
        unsigned nloc = b.st[0], nx = b.st[1];
        if (nloc == 0u) { xcd_barrier_complete(bar, b.x, nloc, nx); b.st[0] = nloc; b.st[1] = nx; }
        const unsigned old = xb_add(&bar[XB_XSUB(b.x)], 1u);
        const unsigned gen = old / nloc;
        if (old + 1u == (gen + 1u) * nloc) {
            __builtin_amdgcn_fence(__ATOMIC_RELEASE, "agent");
            asm volatile("s_waitcnt vmcnt(0)" ::: "memory");
            const unsigned og = xb_add(&bar[XB_TOP], 1u);
            const unsigned tg = og / nx;
            if (og + 1u == (tg + 1u) * nx) xb_add(&bar[XB_TOPGEN], 1u);
            else XB_SPIN(xb_ld(&bar[XB_TOPGEN]) == tg, bar);
            __builtin_amdgcn_fence(__ATOMIC_ACQUIRE, "agent");
            xb_add(&bar[XB_XGEN(b.x)], 1u);
            asm volatile("s_waitcnt vmcnt(0)" ::: "memory");
        } else {
            XB_SPIN(xb_ld(&bar[XB_XGEN(b.x)]) == gen, bar);
            __builtin_amdgcn_fence(__ATOMIC_ACQUIRE, "agent");
            asm volatile("s_waitcnt vmcnt(0)" ::: "memory");
        }
    }
    __syncthreads();
}


#define LDS_WAIT() asm volatile("s_waitcnt lgkmcnt(0)" ::: "memory")
DI void transpose_item(const float* W, int K, int N, int Npad, bf16_t* WT, int mode, LAS float* scr, int item, int lane, const float* gk = nullptr) {
    const int nblk = Npad / 32, kb = item / nblk, nb = item % nblk, k0 = 64 * kb, n0 = 32 * nb;
    const int nn = n0 + (lane & 31); const bool ok = nn < N;
    float tv[32];
#pragma unroll
    for (int i = 0; i < 32; ++i) tv[i] = ok ? W[(size_t)(k0 + 2 * i + (lane >> 5)) * N + nn] : 0.f;
    if (gk) {
#pragma unroll
        for (int i = 0; i < 32; ++i) tv[i] *= gk[k0 + 2 * i + (lane >> 5)];
    }
#pragma unroll
    for (int i = 0; i < 32; ++i) scr[(2 * i + (lane >> 5)) * 33 + (lane & 31)] = tv[i];
    LDS_WAIT(); asm volatile("" ::: "memory");
    const int c = lane & 7;
#pragma unroll
    for (int j = 0; j < 4; ++j) {
        const int n = (lane >> 3) + 8 * j; const LAS float* s = scr + (8 * c) * 33 + n;
        u32x4 o; o.x = pk2(s[0 * 33], s[1 * 33]); o.y = pk2(s[2 * 33], s[3 * 33]); o.z = pk2(s[4 * 33], s[5 * 33]); o.w = pk2(s[6 * 33], s[7 * 33]);
        int drow = n0 + n;
        if (mode == 1) { const int jj = drow >= FF ? drow - FF : drow, isu = drow >= FF ? 1 : 0; drow = (jj >> 2) * 8 + isu * 4 + (jj & 3); }
        *(u32x4*)(WT + (size_t)drow * K + k0 + 8 * c) = o;
    }
    LDS_WAIT(); asm volatile("" ::: "memory");
}

template <int NR> DI void norm_rows(const float* xsrc32, bf16_t* xn, float* rn, float* xdst32, const bf16_t* y, const float* gpost, size_t rstride, int lane) {
    f32x4 v[NR][4];
    if (xsrc32) {
#pragma unroll
        for (int r = 0; r < NR; ++r)
#pragma unroll
            for (int j = 0; j < 4; ++j) v[r][j] = *(const f32x4*)(xsrc32 + r * rstride + 4 * lane + 256 * j);
    } else {
        float rr[NR]; u32x2 w[NR][4];
#pragma unroll
        for (int r = 0; r < NR; ++r) { rr[r] = rn[r * (rstride / D)];
#pragma unroll
            for (int j = 0; j < 4; ++j) w[r][j] = *(const u32x2*)(xn + r * rstride + 4 * lane + 256 * j); }
#pragma unroll
        for (int r = 0; r < NR; ++r)
#pragma unroll
            for (int j = 0; j < 4; ++j) v[r][j] = (f32x4){bflo(w[r][j].x), bfhi(w[r][j].x), bflo(w[r][j].y), bfhi(w[r][j].y)} * rr[r];
    }
    if (y) {
        u32x2 yw[NR][4]; f32x4 g[4];
#pragma unroll
        for (int r = 0; r < NR; ++r)
#pragma unroll
            for (int j = 0; j < 4; ++j) yw[r][j] = *(const u32x2*)(y + r * rstride + 4 * lane + 256 * j);
#pragma unroll
        for (int j = 0; j < 4; ++j) g[j] = *(const f32x4*)(gpost + 4 * lane + 256 * j);
#pragma unroll
        for (int r = 0; r < NR; ++r) {
            f32x4 yv[4]; float ss = 0.f;
#pragma unroll
            for (int j = 0; j < 4; ++j) { yv[j] = (f32x4){bflo(yw[r][j].x), bfhi(yw[r][j].x), bflo(yw[r][j].y), bfhi(yw[r][j].y)}; ss += (yv[j][0] * yv[j][0] + yv[j][1] * yv[j][1]) + (yv[j][2] * yv[j][2] + yv[j][3] * yv[j][3]); }
            const float rs = rsqrtf(wave_sum(ss) * (1.f / D) + EPS);
#pragma unroll
            for (int j = 0; j < 4; ++j) v[r][j] = v[r][j] + yv[j] * rs * g[j];
        }
    }
#pragma unroll
    for (int r = 0; r < NR; ++r) {
        if (xdst32) {
#pragma unroll
            for (int j = 0; j < 4; ++j) *(f32x4*)(xdst32 + r * rstride + 4 * lane + 256 * j) = v[r][j];
        } else {
            float ss = 0.f;
#pragma unroll
            for (int j = 0; j < 4; ++j) ss += (v[r][j][0] * v[r][j][0] + v[r][j][1] * v[r][j][1]) + (v[r][j][2] * v[r][j][2] + v[r][j][3] * v[r][j][3]);
            const float ms = wave_sum(ss) * (1.f / D) + EPS, rs = rsqrtf(ms);
#pragma unroll
            for (int j = 0; j < 4; ++j) { const f32x4 o = v[r][j] * rs; u32x2 w; w.x = pk2(o[0], o[1]); w.y = pk2(o[2], o[3]); *(u32x2*)(xn + r * rstride + 4 * lane + 256 * j) = w; }
            if (lane == 0) rn[r * (rstride / D)] = ms * rs;
        }
    }
}
DI void norm_row(const float* xsrc32, bf16_t* xn, float* rn, float* xdst32, const bf16_t* y, const float* gpost, int lane) { norm_rows<1>(xsrc32, xn, rn, xdst32, y, gpost, (size_t)D, lane); }

DI void norm_phase(const Ctx& p, const float* gpost, bool last, int G, int bx) {
    const int tid = pg8::tid_(), lane = tid & 63, wv = tid >> 6, gw = bx * NWAVES + wv, NGW = G * NWAVES;
    const bf16_t* Yb = (const bf16_t*)(p.ws + WS_Y); bf16_t* Xb = (bf16_t*)(p.ws + WS_XB); float* Rn = (float*)(p.ws + WS_RN);
    int row = gw; const size_t rst = (size_t)NGW * D;
    for (; row + 3 * NGW < MA; row += 4 * NGW) norm_rows<4>(nullptr, Xb + (size_t)row * D, Rn + row, last ? p.out + (size_t)row * D : nullptr, Yb + (size_t)row * D, gpost, rst, lane);
    for (; row < MA; row += NGW) norm_row(nullptr, Xb + (size_t)row * D, Rn + row, last ? p.out + (size_t)row * D : nullptr, Yb + (size_t)row * D, gpost, lane);
}

DI void prologue(const Params& p, LAS unsigned char* lds) {
    const int tid = pg8::tid_(), lane = tid & 63, wv = tid >> 6;
    const int gw = blockIdx.x * NWAVES + wv, NGW = gridDim.x * NWAVES;
    LAS float* scr = (LAS float*)(lds + wv * 16384);
    unsigned char* ws = p.ws;
    constexpr int I0 = 3072, I1 = 192, I2 = 512, I3 = 2816, I4 = 1408, IPL = I0 + 2 * I1 + 5 * I2 + I3 + I4;
    for (int it = gw; it < 4 * IPL; it += NGW) {
        const int l = it / IPL; int r = it % IPL;
        if (r < I0) { transpose_item(p.in[I_WIN] + (size_t)l * D * NIN, D, NIN, NINP, (bf16_t*)(ws + WS_WIN + l * SZ_WIN), 0, scr, r, lane, p.in[I_NMIXPRE] + l * D); continue; } r -= I0;
        if (r < I1) { transpose_item(p.in[I_WBA] + (size_t)l * 384 * D, 384, D, D, (bf16_t*)(ws + WS_WBA + l * SZ_WBA), 0, scr, r, lane); continue; } r -= I1;
        if (r < I1) { transpose_item(p.in[I_WBC] + (size_t)l * 384 * D, 384, D, D, (bf16_t*)(ws + WS_WBC + l * SZ_WBA), 0, scr, r, lane); continue; } r -= I1;
        if (r < I2) { transpose_item(p.in[I_WMIX] + (size_t)l * D * D, D, D, D, (bf16_t*)(ws + WS_WMIX + l * SZ_WSQ), 0, scr, r, lane); continue; } r -= I2;
        if (r < I2) { transpose_item(p.in[I_WXQ] + (size_t)l * D * D, D, D, D, (bf16_t*)(ws + WS_WXQ + l * SZ_WSQ), 0, scr, r, lane, p.in[I_NXPRE] + l * D); continue; } r -= I2;
        if (r < I2) { transpose_item(p.in[I_WXO] + (size_t)l * D * D, D, D, D, (bf16_t*)(ws + WS_WXO + l * SZ_WSQ), 0, scr, r, lane); continue; } r -= I2;
        if (r < I2) { transpose_item(p.in[I_WXK] + (size_t)l * D * D, D, D, D, (bf16_t*)(ws + WS_WKV + l * SZ_WKV), 0, scr, r, lane); continue; } r -= I2;
        if (r < I2) { transpose_item(p.in[I_WXV] + (size_t)l * D * D, D, D, D, (bf16_t*)(ws + WS_WKV + l * SZ_WKV + SZ_WSQ), 0, scr, r, lane); continue; } r -= I2;
        if (r < I3) { transpose_item(p.in[I_WF1] + (size_t)l * D * FF2, D, FF2, FF2, (bf16_t*)(ws + WS_WF1 + l * SZ_WF1), 1, scr, r, lane, p.in[I_NFPRE] + l * D); continue; } r -= I3;
        transpose_item(p.in[I_WF2] + (size_t)l * FF * D, FF, D, D, (bf16_t*)(ws + WS_WF2 + l * SZ_WF2), 0, scr, r, lane);
    }
    for (int u = blockIdx.x; u < 128; u += gridDim.x) {
        const int l = u >> 5, g = (u >> 3) & 3, nb = (u >> 2) & 1, cq = u & 3;
        LAS float* Ps = (LAS float*)(lds + 8 * 16384);
        __syncthreads();
        for (int i = tid; i < 1024; i += NTHR) Ps[i] = p.in[I_WPOOL][((size_t)(l * 4 + g) * 64 + 16 * cq) * 64 + i];
        __syncthreads();
        const int n = nb * 512 + tid;
        const float* sc = p.in[I_PSCALE] + l * 256 + g * 64; const float* wb = p.in[I_WBB] + ((size_t)l * 256 + g * 64) * D + n;
        float acc[16];
#pragma unroll
        for (int c = 0; c < 16; ++c) acc[c] = 0.f;
#pragma unroll 2
        for (int d0 = 0; d0 < 64; d0 += 8) {
            float bc[8];
#pragma unroll
            for (int j = 0; j < 8; ++j) bc[j] = sc[d0 + j] * wb[(size_t)(d0 + j) * D];
#pragma unroll
            for (int c = 0; c < 16; ++c) { const f32x4 p0 = *(const LAS f32x4*)(Ps + c * 64 + d0), p1 = *(const LAS f32x4*)(Ps + c * 64 + d0 + 4);
                acc[c] += ((p0[0] * bc[0] + p0[1] * bc[1]) + (p0[2] * bc[2] + p0[3] * bc[3])) + ((p1[0] * bc[4] + p1[1] * bc[5]) + (p1[2] * bc[6] + p1[3] * bc[7])); }
        }
        unsigned ov[16];
#pragma unroll
        for (int c = 0; c < 16; ++c) ov[c] = f2bf(acc[c]);
        bf16_t* dst = (bf16_t*)(ws + WS_WBB + l * SZ_WBB) + (size_t)n * 256 + g * 64 + 16 * cq;
        u32x4 w0, w1; w0.x = ov[0] | (ov[1] << 16); w0.y = ov[2] | (ov[3] << 16); w0.z = ov[4] | (ov[5] << 16); w0.w = ov[6] | (ov[7] << 16);
        w1.x = ov[8] | (ov[9] << 16); w1.y = ov[10] | (ov[11] << 16); w1.z = ov[12] | (ov[13] << 16); w1.w = ov[14] | (ov[15] << 16);
        *(u32x4*)dst = w0; *(u32x4*)(dst + 8) = w1;
    }
    __syncthreads();
    for (int row = gw; row < MA; row += NGW) {
        const float* src = row < MP ? p.in[I_XP] + (size_t)row * D : p.in[I_XS] + (size_t)(row - MP) * D;
        norm_row(src, (bf16_t*)(ws + WS_XB) + (size_t)row * D, (float*)(ws + WS_RN) + row, nullptr, nullptr, nullptr, lane);
    }
    for (int row = gw; row < NB * 256; row += NGW) {
        f32x4 v[4]; float ss = 0.f;
#pragma unroll
        for (int j = 0; j < 4; ++j) { v[j] = *(const f32x4*)(p.in[I_MEM] + (size_t)row * D + 4 * lane + 256 * j); ss += (v[j][0] * v[j][0] + v[j][1] * v[j][1]) + (v[j][2] * v[j][2] + v[j][3] * v[j][3]); }
        const float rs = rsqrtf(wave_sum(ss) * (1.f / D) + EPS);
        for (int l = 0; l < 4; ++l)
#pragma unroll
            for (int j = 0; j < 4; ++j) { const f32x4 g = *(const f32x4*)(p.in[I_MEMN] + l * D + 4 * lane + 256 * j); const f32x4 o = v[j] * rs * g; u32x2 w; w.x = pk2(o[0], o[1]); w.y = pk2(o[2], o[3]);
                *(u32x2*)((bf16_t*)(ws + WS_MN) + ((size_t)l * 2048 + row) * D + 4 * lane + 256 * j) = w; }
    }
}

#define MFMA32(a, b, c) __builtin_amdgcn_mfma_f32_32x32x16_bf16((a), (b), (c), 0, 0, 0)
#define MFMA16(a, b, c) __builtin_amdgcn_mfma_f32_16x16x32_bf16((a), (b), (c), 0, 0, 0)
template <bool MASKED> DI void sb_tile_weights(f32x16 (&z)[2], float& R, int jt, int tq, int hi) {
    f32x16 e[2]; float T[8];
    const int sbase = 64 * jt + 4 * hi;
#pragma unroll
    for (int kb = 0; kb < 2; ++kb)
#pragma unroll
        for (int g = 0; g < 4; ++g) {
            float fl[4];
#pragma unroll
            for (int j = 0; j < 4; ++j) {
                const int r = 4 * g + j; const bool valid = !MASKED || (sbase + 32 * kb + 8 * g + j) < tq;
                const float zz = fminf(fmaxf(z[kb][r], -240.f), 240.f);
                const float t = __builtin_amdgcn_exp2f(zz * (-0.125f * 1.4426950408889634f));
                const float be = __builtin_amdgcn_rcpf(1.f + t);
                fl[j] = valid ? t * be : 1.f; z[kb][r] = valid ? be : 0.f;
            }
            e[kb][4 * g + 3] = 1.f; e[kb][4 * g + 2] = fl[3]; e[kb][4 * g + 1] = fl[3] * fl[2]; e[kb][4 * g + 0] = e[kb][4 * g + 1] * fl[1];
            T[kb * 4 + g] = e[kb][4 * g + 0] * fl[0];
        }
    float Tp[8], X[8];
#pragma unroll
    for (int gi = 0; gi < 8; ++gi) Tp[gi] = __shfl_xor(T[gi], 32);
    X[7] = 1.f;
#pragma unroll
    for (int gi = 6; gi >= 0; --gi) X[gi] = X[gi + 1] * (T[gi + 1] * Tp[gi + 1]);
    const float total = X[0] * (T[0] * Tp[0]);
#pragma unroll
    for (int kb = 0; kb < 2; ++kb)
#pragma unroll
        for (int g = 0; g < 4; ++g) {
            const int gi = kb * 4 + g; const float off = R * X[gi] * (hi == 0 ? Tp[gi] : 1.f);
#pragma unroll
            for (int j = 0; j < 4; ++j) { const int r = 4 * g + j; z[kb][r] = z[kb][r] * (off * e[kb][r]); }
        }
    R *= total;
}

DI void sb_prompt_unit(const Ctx& p, int b, int h, int qb, LAS unsigned char* lds) {
    const bf16_t* proj = (const bf16_t*)(p.ws + WS_PROJ);
    LAS unsigned short* KS = (LAS unsigned short*)lds;
    LAS unsigned short* VT = KS + 64 * 72;
    const int tid = pg8::tid_(), lane = tid & 63, wv = tid >> 6, hi = lane >> 5, c = lane & 31;
    const int q0 = qb * 256 + wv * 32, tq = q0 + c;
    const size_t rowbase = (size_t)b * SEQ;
    bf16x8 qf[4];
    {
        const bf16_t* qp = proj + (rowbase + tq) * NINP + C_QA + h * 64 + 8 * hi;
#pragma unroll
        for (int kk = 0; kk < 4; ++kk) qf[kk] = *(const bf16x8*)(qp + 16 * kk);
    }
    f32x16 o0, o1;
#pragma unroll
    for (int i = 0; i < 16; ++i) { o0[i] = 0.f; o1[i] = 0.f; }
    float R = 1.f;
    const bf16_t* kbase = proj + rowbase * NINP + C_KA + h * 64 + 8 * wv;
    const bf16_t* vbase = proj + rowbase * NINP + C_VA + h * 64 + 8 * wv;
    int jt = 4 * qb + 3;
    u32x4 kr = *(const u32x4*)(kbase + (size_t)(64 * jt + lane) * NINP), vr = *(const u32x4*)(vbase + (size_t)(64 * jt + lane) * NINP);
    for (; jt >= 0; --jt) {
        __syncthreads();
        *(LAS u32x4*)(KS + lane * 72 + 8 * wv) = kr;
#pragma unroll
        for (int i = 0; i < 4; ++i) { const unsigned w = vr[i]; VT[(8 * wv + 2 * i) * 72 + lane] = (unsigned short)(w & 0xffffu); VT[(8 * wv + 2 * i + 1) * 72 + lane] = (unsigned short)(w >> 16); }
        __syncthreads();
        if (jt > 0) { kr = *(const u32x4*)(kbase + (size_t)(64 * (jt - 1) + lane) * NINP); vr = *(const u32x4*)(vbase + (size_t)(64 * (jt - 1) + lane) * NINP); }
        if (64 * jt < q0 + 31) {
            f32x16 z[2];
#pragma unroll
            for (int kb = 0; kb < 2; ++kb) {
                f32x16 acc;
#pragma unroll
                for (int i = 0; i < 16; ++i) acc[i] = 0.f;
#pragma unroll
                for (int kk = 0; kk < 4; ++kk) { const bf16x8 a = *(const LAS bf16x8*)(KS + (32 * kb + c) * 72 + 16 * kk + 8 * hi); acc = MFMA32(a, qf[kk], acc); }
                z[kb] = acc;
            }
            if (64 * jt + 63 < q0) sb_tile_weights<false>(z, R, jt, tq, hi); else sb_tile_weights<true>(z, R, jt, tq, hi);
#pragma unroll
            for (int kb = 0; kb < 2; ++kb)
#pragma unroll
                for (int s2 = 0; s2 < 2; ++s2) {
                    u32x4 pw; pw.x = pk2(z[kb][8 * s2 + 0], z[kb][8 * s2 + 1]); pw.y = pk2(z[kb][8 * s2 + 2], z[kb][8 * s2 + 3]); pw.z = pk2(z[kb][8 * s2 + 4], z[kb][8 * s2 + 5]); pw.w = pk2(z[kb][8 * s2 + 6], z[kb][8 * s2 + 7]);
                    const bf16x8 pb = __builtin_bit_cast(bf16x8, pw);
                    const int ko = 32 * kb + 16 * s2 + 4 * hi;
                    { const s16x4 lo = *(const LAS s16x4*)(VT + c * 72 + ko), hh = *(const LAS s16x4*)(VT + c * 72 + ko + 8);
                      const bf16x8 va = __builtin_shufflevector(lo, hh, 0, 1, 2, 3, 4, 5, 6, 7); o0 = MFMA32(va, pb, o0); }
                    { const s16x4 lo = *(const LAS s16x4*)(VT + (c + 32) * 72 + ko), hh = *(const LAS s16x4*)(VT + (c + 32) * 72 + ko + 8);
                      const bf16x8 va = __builtin_shufflevector(lo, hh, 0, 1, 2, 3, 4, 5, 6, 7); o1 = MFMA32(va, pb, o1); }
                }
        }
    }
    bf16_t* op = (bf16_t*)(p.ws + WS_OA) + (rowbase + tq) * 384 + h * 64 + 4 * hi;
#pragma unroll
    for (int g = 0; g < 4; ++g) {
        u32x2 w; w.x = pk2(o0[4 * g], o0[4 * g + 1]); w.y = pk2(o0[4 * g + 2], o0[4 * g + 3]); *(u32x2*)(op + 8 * g) = w;
        w.x = pk2(o1[4 * g], o1[4 * g + 1]); w.y = pk2(o1[4 * g + 2], o1[4 * g + 3]); *(u32x2*)(op + 32 + 8 * g) = w;
    }
}

DI void sb_sample_unit(const Ctx& p, int l, int b, int h, LAS unsigned char* lds) {
    const bf16_t* proj = (const bf16_t*)(p.ws + WS_PROJ);
    LAS float* qs = (LAS float*)lds;
    LAS float* Z = qs + 1024;
    LAS float* RED = Z + 16 * 1056;
    const int tid = pg8::tid_(), lane = tid & 63, wv = tid >> 6;
    const size_t srow = (size_t)MP + b * 16;
    for (int i = tid; i < 1024; i += NTHR) qs[i] = bf2f(proj[(srow + (i >> 6)) * NINP + C_QA + h * 64 + (i & 63)]) * 0.125f;
    __syncthreads();
    {
        float a0[16], a1[16];
#pragma unroll
        for (int i = 0; i < 16; ++i) { a0[i] = 0.f; a1[i] = 0.f; }
        const float* k0p = p.in[I_CSK] + ((((size_t)l * DB + b) * PAST + tid) * 6 + h) * 64; const float* k1p = k0p + (size_t)512 * 6 * 64;
#pragma unroll 8
        for (int d4 = 0; d4 < 16; ++d4) {
            const f32x4 ka = *(const f32x4*)(k0p + 4 * d4), kb = *(const f32x4*)(k1p + 4 * d4);
#pragma unroll
            for (int i = 0; i < 16; ++i) { const f32x4 q = *(const LAS f32x4*)(qs + i * 64 + 4 * d4);
                a0[i] += (q[0] * ka[0] + q[1] * ka[1]) + (q[2] * ka[2] + q[3] * ka[3]); a1[i] += (q[0] * kb[0] + q[1] * kb[1]) + (q[2] * kb[2] + q[3] * kb[3]); }
        }
#pragma unroll
        for (int i = 0; i < 16; ++i) { Z[i * 1056 + tid] = a0[i]; Z[i * 1056 + tid + 512] = a1[i]; }
        if (tid < 256) {
            const int i = tid >> 4, j = tid & 15; const bf16_t* kp = proj + (srow + j) * NINP + C_KA + h * 64; float s = 0.f;
            for (int d = 0; d < 64; ++d) s += qs[i * 64 + d] * bf2f(kp[d]);
            Z[i * 1056 + 1024 + j] = s;
        }
    }
    __syncthreads();
    for (int qq = 0; qq < 2; ++qq) {
        const int i = 2 * wv + qq, lim = PAST + i; LAS float* zr = Z + i * 1056;
        const int st = 17 * lane, en = (st + 17 < 1040) ? st + 17 : 1040;
        float tot = 0.f;
        for (int s = st; s < en; ++s) if (s < lim) tot -= softplusf_(zr[s]);
        float incl = tot;
#pragma unroll
        for (int o = 1; o < 64; o <<= 1) { const float t = __shfl_down(incl, o); if (lane + o < 64) incl += t; }
        float run = incl - tot;
        for (int s = en - 1; s >= st; --s) {
            const float zz = zr[s]; float w = 0.f;
            if (s < lim) { const float sp = softplusf_(zz); w = __expf(zz - sp + run); run -= sp; }
            zr[s] = w;
        }
    }
    __syncthreads();
    {
        const int d = tid & 63, g = tid >> 6;
        float o[16];
#pragma unroll
        for (int i = 0; i < 16; ++i) o[i] = 0.f;
        const float* vp = p.in[I_CSV] + (((size_t)l * DB + b) * PAST * 6 + h) * 64 + d;
        for (int s0 = 130 * g; s0 < 130 * g + 130; s0 += 26) {
            float v[26];
#pragma unroll
            for (int j = 0; j < 26; ++j) { const int s = s0 + j; v[j] = s < PAST ? vp[(size_t)s * 384] : bf2f(proj[(srow + (s - PAST)) * NINP + C_VA + h * 64 + d]); }
#pragma unroll
            for (int j = 0; j < 26; ++j)
#pragma unroll
                for (int i = 0; i < 16; ++i) o[i] += Z[i * 1056 + s0 + j] * v[j];
        }
#pragma unroll
        for (int i = 0; i < 16; ++i) RED[(g * 16 + i) * 64 + d] = o[i];
    }
    __syncthreads();
    for (int i = tid; i < 1024; i += NTHR) {
        const int qi = i >> 6, d = i & 63; float s = 0.f;
#pragma unroll
        for (int g = 0; g < 8; ++g) s += RED[(g * 16 + qi) * 64 + d];
        ((bf16_t*)(p.ws + WS_OA))[(srow + qi) * 384 + h * 64 + d] = f2bf(s);
    }
}

template <int W> DI void pool_rows(const float (&uu)[48], int t0, float* outp, bf16_t* pooled_col) {
    float s = 0.f;
#pragma unroll
    for (int i = 16 - W; i < 16; ++i) s += uu[i];
#pragma unroll
    for (int r = 0; r < 32; ++r) {
        s += uu[16 + r] - uu[16 + r - W];
        const int t = t0 + r; const float cnt = (float)((t + 1 < W) ? t + 1 : W);
        pooled_col[(size_t)r * 256] = f2bf(s / cnt - uu[16 + r]);
        if (t >= SEQ - 15) outp[(size_t)(t - (SEQ - 15)) * 256] = uu[16 + r];
    }
}
DI void pool_unit(const Ctx& p, int l, int unit) {
    const bf16_t* proj = (const bf16_t*)(p.ws + WS_PROJ); bf16_t* pooled = (bf16_t*)(p.ws + WS_POOLED);
    const int tid = pg8::tid_(), ch = tid & 255, w = 2 << (ch >> 6);
    if (unit < MP / 64) {
        const int r0 = unit * 64 + 32 * (tid >> 8), t0 = r0 & (SEQ - 1), b = r0 >> 11;
        float uu[48];
        const bf16_t* up = proj + (size_t)(r0 - 16) * NINP + C_U + ch;
#pragma unroll
        for (int i = 0; i < 48; ++i) uu[i] = (t0 - 16 + i >= 0) ? bf2f(up[(size_t)i * NINP]) : 0.f;
        float* outp = p.out + O_POOLP + ((size_t)(l * NB + b) * 15) * 256 + ch; bf16_t* pc = pooled + (size_t)r0 * 256 + ch;
        if (w == 2) pool_rows<2>(uu, t0, outp, pc); else if (w == 4) pool_rows<4>(uu, t0, outp, pc); else if (w == 8) pool_rows<8>(uu, t0, outp, pc); else pool_rows<16>(uu, t0, outp, pc);
        return;
    }
    for (int i = 0; i < 32; ++i) {
        const int row = unit * 64 + (tid >> 8) + 2 * i;
        const int rs = row - MP, b = rs >> 4, t = rs & 15; float s = 0.f;
        const bf16_t* up = proj + (size_t)row * NINP + C_U + ch; const float u0 = bf2f(up[0]);
        const float* hist = p.in[I_SPOOL] + ((size_t)(l * DB + b) * 15) * 256 + ch;
        for (int j = 0; j < w; ++j) { const int tt = t - j; s += tt >= 0 ? bf2f(*(up - (size_t)j * NINP)) : hist[(15 + tt) * 256]; }
        if (t >= 1) p.out[O_POOLS + ((size_t)(l * DB + b) * 15 + (t - 1)) * 256 + ch] = u0;
        pooled[(size_t)row * 256 + ch] = f2bf(s / (float)w - u0);
    }
}

DI void kvout_unit(const Ctx& p, int l, int unit) {
    const bf16_t* proj = (const bf16_t*)(p.ws + WS_PROJ);
#pragma unroll 4
    for (int i = pg8::tid_(); i < 64 * 96; i += NTHR) {
        const int r = i / 96, ch = i % 96, row = unit * 64 + r;
        const u32x4 w = *(const u32x4*)(proj + (size_t)row * NINP + C_KA + 8 * ch);
        const bool isv = ch >= 48; const int c = 8 * (isv ? ch - 48 : ch);
        float* dst = (row < MP) ? p.out + (isv ? O_VP : O_KP) + ((size_t)l * MP + row) * 384 + c : p.out + (isv ? O_VS : O_KS) + ((size_t)l * MS + (row - MP)) * 384 + c;
        *(f32x4*)dst = (f32x4){bflo(w.x), bfhi(w.x), bflo(w.y), bfhi(w.y)}; *(f32x4*)(dst + 4) = (f32x4){bflo(w.z), bfhi(w.z), bflo(w.w), bfhi(w.w)};
    }
}
DI void memout_unit(const Ctx& p, int unit) {
    const bf16_t* mkv = (const bf16_t*)(p.ws + WS_MKV);
    for (int i = pg8::tid_(); i < 16 * 256; i += NTHR) {
        const int r = i >> 8, ch = i & 255, row = unit * 16 + r, col = 8 * ch;
        const u32x4 w = *(const u32x4*)(mkv + (size_t)row * 2048 + col);
        float* dst = p.out + (col >= 1024 ? O_MVP : O_MKP) + (size_t)row * D + (col & 1023);
        *(f32x4*)dst = (f32x4){bflo(w.x), bfhi(w.x), bflo(w.y), bfhi(w.y)}; *(f32x4*)(dst + 4) = (f32x4){bflo(w.z), bfhi(w.z), bflo(w.w), bfhi(w.w)};
    }
}
DI void memvt_unit(const Ctx& p, int unit) {
    const int l = unit >> 7, nb = (unit >> 3) & 15, b = unit & 7, tid = pg8::tid_(), n = nb * 64 + (tid & 63), wv = tid >> 6;
    const bf16_t* src = (const bf16_t*)(p.ws + WS_MKV) + ((size_t)l * 2048 + b * 256) * 2048 + 1024 + n;
    bf16_t* dst = (bf16_t*)(p.ws + WS_MEMVT) + ((size_t)l * 1024 + n) * 2048 + b * 256;
    for (int c = wv; c < 32; c += 8) {
        unsigned v[8];
#pragma unroll
        for (int j = 0; j < 8; ++j) v[j] = src[(size_t)(8 * c + j) * 2048];
        u32x4 w; w.x = v[0] | (v[1] << 16); w.y = v[2] | (v[3] << 16); w.z = v[4] | (v[5] << 16); w.w = v[6] | (v[7] << 16);
        *(u32x4*)(dst + 8 * c) = w;
    }
}

DI void gla_decay(const Ctx& p, int l, int h, size_t row0, int ntok, LAS unsigned char* lds) {
    const bf16_t* proj = (const bf16_t*)(p.ws + WS_PROJ);
    LAS float* Bc = (LAS float*)lds; LAS float* LR = (LAS float*)(lds + 24576); LAS float* A2 = (LAS float*)(lds + 28672); LAS float* BIA = (LAS float*)(lds + 34816); LAS float* SEG = (LAS float*)(lds + 35200);
    const int tid = pg8::tid_();
    if (tid < 128) {
        const int t = tid >> 1, hf = tid & 1; u32x4 w = {0u, 0u, 0u, 0u};
        if (t < ntok) w = *(const u32x4*)(proj + (row0 + t) * NINP + C_LR + 8 * hf);
        LAS float* d = LR + t * 16 + 8 * hf;
        d[0] = bflo(w.x); d[1] = bfhi(w.x); d[2] = bflo(w.y); d[3] = bfhi(w.y); d[4] = bflo(w.z); d[5] = bfhi(w.z); d[6] = bflo(w.w); d[7] = bfhi(w.w);
    } else if (tid < 128 + 384) {
        const int i = tid - 128, r = i / 24, c4 = i % 24;
        *(LAS f32x4*)(A2 + r * 96 + 4 * c4) = *(const f32x4*)(p.in[I_WA2] + ((size_t)l * 16 + r) * 384 + h * 96 + 4 * c4);
    }
    if (tid < 96) BIA[tid] = p.in[I_BA][l * 384 + h * 96 + tid];
    __syncthreads();
    for (int i = tid; i < 64 * 96; i += NTHR) {
        const int t = i / 96, k = i % 96; float sacc = BIA[k];
#pragma unroll
        for (int r = 0; r < 16; ++r) sacc += LR[t * 16 + r] * A2[r * 96 + k];
        Bc[i] = t < ntok ? -softplusf_(-sacc) * (1.f / 16.f) : 0.f;
    }
    __syncthreads();
    const int k = tid % 96, seg = tid / 96;
    if (tid < 384) { float run = 0.f; for (int i = 0; i < 16; ++i) { const int idx = (16 * seg + i) * 96 + k; run += Bc[idx]; Bc[idx] = run; } SEG[seg * 96 + k] = run; }
    __syncthreads();
    if (tid < 384 && seg > 0) { float off = 0.f; for (int s2 = 0; s2 < seg; ++s2) off += SEG[s2 * 96 + k]; for (int i = 0; i < 16; ++i) Bc[(16 * seg + i) * 96 + k] += off; }
    __syncthreads();
}
DI void gla_unit_rows(int gu, size_t& row0, int& ntok, int& bh, int& h) {
    if (gu < NGU_P) { bh = gu >> 5; const int c = gu & 31, b = bh >> 2; h = bh & 3; row0 = (size_t)b * SEQ + c * 64; ntok = 64; }
    else { bh = gu - NGU_P; const int b = bh >> 2; h = bh & 3; row0 = (size_t)MP + b * 16; ntok = 16; }
}
DI void gla_stage1_unit(const Ctx& p, int l, int gu, LAS unsigned char* lds) {
    const bf16_t* proj = (const bf16_t*)(p.ws + WS_PROJ);
    size_t row0; int ntok, bh, h; gla_unit_rows(gu, row0, ntok, bh, h);
    gla_decay(p, l, h, row0, ntok, lds);
    LAS float* Bc = (LAS float*)lds;
    LAS unsigned short* KT = (LAS unsigned short*)(lds + 36864);
    LAS unsigned short* VT = KT + 96 * 72;
    const int tid = pg8::tid_(), lane = tid & 63, wv = tid >> 6, fr = lane & 15, fq = lane >> 4;
    {
        float* bb = (float*)(p.ws + WS_BB) + (size_t)gu * (64 * GK);
        for (int i = tid; i < 64 * GK / 4; i += NTHR) *(f32x4*)(bb + 4 * i) = *(const LAS f32x4*)(Bc + 4 * i);
    }
    for (int task = tid; task < 768; task += NTHR) {
        const int t = task & 63, ch = task >> 6; u32x4 kw = {0u, 0u, 0u, 0u}, vw = {0u, 0u, 0u, 0u};
        if (t < ntok) { const bf16_t* rp = proj + (row0 + t) * NINP + h * 96 + 8 * ch; kw = *(const u32x4*)(rp + C_KC); vw = *(const u32x4*)(rp + C_VC); }
        const unsigned kk[4] = {kw.x, kw.y, kw.z, kw.w}, vv[4] = {vw.x, vw.y, vw.z, vw.w};
#pragma unroll
        for (int j = 0; j < 4; ++j) {
            const int k0 = 8 * ch + 2 * j;
            const float e0 = __expf(Bc[(ntok - 1) * 96 + k0] - Bc[t * 96 + k0]), e1 = __expf(Bc[(ntok - 1) * 96 + k0 + 1] - Bc[t * 96 + k0 + 1]);
            KT[k0 * 72 + t] = f2bf(bflo(kk[j]) * e0); KT[(k0 + 1) * 72 + t] = f2bf(bfhi(kk[j]) * e1);
            VT[k0 * 72 + t] = (unsigned short)(vv[j] & 0xffffu); VT[(k0 + 1) * 72 + t] = (unsigned short)(vv[j] >> 16);
        }
    }
    if (tid < 96) ((float*)(p.ws + WS_GDEC))[(size_t)gu * 96 + tid] = __expf(Bc[(ntok - 1) * 96 + tid]);
    __syncthreads();
    float* KV = (float*)(p.ws + WS_GKV) + (size_t)gu * (GK * GK);
    for (int tile = wv; tile < 36; tile += 8) {
        const int ki = tile / 6, vi = tile % 6; f32x4 acc = {0.f, 0.f, 0.f, 0.f};
#pragma unroll
        for (int ks = 0; ks < 2; ++ks) { const bf16x8 a = *(const LAS bf16x8*)(KT + (16 * ki + fr) * 72 + 32 * ks + 8 * fq), bb = *(const LAS bf16x8*)(VT + (16 * vi + fr) * 72 + 32 * ks + 8 * fq); acc = MFMA16(a, bb, acc); }
#pragma unroll
        for (int j = 0; j < 4; ++j) KV[(16 * ki + 4 * fq + j) * 96 + 16 * vi + fr] = acc[j];
    }
}
DI void gla_scan(const Ctx& p, int l) {
    const int gt = blockIdx.x * NTHR + pg8::tid_(), NT = gridDim.x * NTHR;
    const float* KV = (const float*)(p.ws + WS_GKV); const float* DEC = (const float*)(p.ws + WS_GDEC); float* SP = (float*)(p.ws + WS_GSP);
    for (int e = gt; e < 32 * GK * GK; e += NT) {
        const int bh = e / (GK * GK), kv = e % (GK * GK), k = kv / GK; float S = 0.f;
        float kvv[32], dcv[32];
#pragma unroll
        for (int c = 0; c < 32; ++c) { const size_t gu = (size_t)bh * 32 + c; kvv[c] = KV[gu * (GK * GK) + kv]; dcv[c] = DEC[gu * 96 + k]; }
#pragma unroll
        for (int c = 0; c < 32; ++c) { const size_t gu = (size_t)bh * 32 + c; SP[gu * (GK * GK) + kv] = S; S = dcv[c] * S + kvv[c]; }
        p.out[O_GLAP + ((size_t)l * 32 + bh) * (GK * GK) + kv] = S;
    }
    for (int e = gt; e < 64 * GK * GK; e += NT) {
        const int bh = e / (GK * GK), kv = e % (GK * GK), k = kv / GK; const size_t gu = (size_t)NGU_P + bh;
        const float S0 = p.in[I_SGLA][((size_t)l * 64 + bh) * (GK * GK) + kv];
        p.out[O_GLAS + ((size_t)l * 64 + bh) * (GK * GK) + kv] = DEC[gu * 96 + k] * S0 + KV[gu * (GK * GK) + kv];
    }
}
DI void gla_stage3_unit(const Ctx& p, int l, int gu, LAS unsigned char* lds) {
    const bf16_t* proj = (const bf16_t*)(p.ws + WS_PROJ);
    size_t row0; int ntok, bh, h; gla_unit_rows(gu, row0, ntok, bh, h);
    LAS float* OT = (LAS float*)lds;
    LAS unsigned short* QP = (LAS unsigned short*)(lds + 36864);
    LAS unsigned short* KP = QP + 64 * 104;
    LAS unsigned short* VT = KP + 64 * 104;
    LAS unsigned short* ST = VT + 96 * 72;
    LAS unsigned short* ATT = ST + 96 * 104;
    const int tid = pg8::tid_(), lane = tid & 63, wv = tid >> 6, fr = lane & 15, fq = lane >> 4;
    const float* Sprev = gu < NGU_P ? (const float*)(p.ws + WS_GSP) + (size_t)gu * (GK * GK) : p.in[I_SGLA] + ((size_t)l * 64 + bh) * (GK * GK);
    const float* bb = (const float*)(p.ws + WS_BB) + (size_t)gu * (64 * GK);
    __syncthreads();
    for (int task = tid; task < 768; task += NTHR) {
        const int t = task & 63, ch = task >> 6; u32x4 qw = {0u, 0u, 0u, 0u}, kw = qw, vw = qw; f32x4 b0 = {0.f, 0.f, 0.f, 0.f}, b1 = b0;
        if (t < ntok) { const bf16_t* rp = proj + (row0 + t) * NINP + h * 96 + 8 * ch; qw = *(const u32x4*)(rp + C_QC); kw = *(const u32x4*)(rp + C_KC); vw = *(const u32x4*)(rp + C_VC);
            b0 = *(const f32x4*)(bb + t * 96 + 8 * ch); b1 = *(const f32x4*)(bb + t * 96 + 8 * ch + 4); }
        const unsigned qq[4] = {qw.x, qw.y, qw.z, qw.w}, kk[4] = {kw.x, kw.y, kw.z, kw.w}, vv[4] = {vw.x, vw.y, vw.z, vw.w};
        const float be[8] = {b0[0], b0[1], b0[2], b0[3], b1[0], b1[1], b1[2], b1[3]};
        u32x4 qo, ko; unsigned qa[4], ka[4];
#pragma unroll
        for (int j = 0; j < 4; ++j) {
            const float e0 = __expf(be[2 * j]), e1 = __expf(be[2 * j + 1]), r0 = __builtin_amdgcn_rcpf(e0), r1 = __builtin_amdgcn_rcpf(e1);
            const bool ok = t < ntok;
            qa[j] = ok ? pk2(bflo(qq[j]) * 0.10206207261596575f * e0, bfhi(qq[j]) * 0.10206207261596575f * e1) : 0u;
            ka[j] = ok ? pk2(bflo(kk[j]) * r0, bfhi(kk[j]) * r1) : 0u;
            VT[(8 * ch + 2 * j) * 72 + t] = (unsigned short)(vv[j] & 0xffffu); VT[(8 * ch + 2 * j + 1) * 72 + t] = (unsigned short)(vv[j] >> 16);
        }
        qo.x = qa[0]; qo.y = qa[1]; qo.z = qa[2]; qo.w = qa[3]; ko.x = ka[0]; ko.y = ka[1]; ko.z = ka[2]; ko.w = ka[3];
        *(LAS u32x4*)(QP + t * 104 + 8 * ch) = qo; *(LAS u32x4*)(KP + t * 104 + 8 * ch) = ko;
    }
    for (int task = tid; task < 2304; task += NTHR) {
        const int k = task % 96, vc = task / 96; const f32x4 sv = *(const f32x4*)(Sprev + k * 96 + 4 * vc);
#pragma unroll
        for (int j = 0; j < 4; ++j) ST[(4 * vc + j) * 104 + k] = f2bf(sv[j]);
    }
    __syncthreads();
    for (int tile = 2 * wv; tile < 2 * wv + 2; ++tile) {
        const int ti = tile >> 2, si = tile & 3; f32x4 acc = {0.f, 0.f, 0.f, 0.f};
        if (si <= ti) {
#pragma unroll
            for (int ks = 0; ks < 3; ++ks) { const bf16x8 a = *(const LAS bf16x8*)(QP + (16 * ti + fr) * 104 + 32 * ks + 8 * fq), b2 = *(const LAS bf16x8*)(KP + (16 * si + fr) * 104 + 32 * ks + 8 * fq); acc = MFMA16(a, b2, acc); }
        }
#pragma unroll
        for (int j = 0; j < 4; ++j) { const int t = 16 * ti + 4 * fq + j, s2 = 16 * si + fr; ATT[t * 72 + s2] = f2bf(s2 <= t ? acc[j] : 0.f); }
    }
    __syncthreads();
    for (int tile = wv; tile < 24; tile += 8) {
        const int ti = tile / 6, vi = tile % 6; f32x4 acc = {0.f, 0.f, 0.f, 0.f};
#pragma unroll
        for (int ks = 0; ks < 2; ++ks) { const bf16x8 a = *(const LAS bf16x8*)(ATT + (16 * ti + fr) * 72 + 32 * ks + 8 * fq), b2 = *(const LAS bf16x8*)(VT + (16 * vi + fr) * 72 + 32 * ks + 8 * fq); acc = MFMA16(a, b2, acc); }
#pragma unroll
        for (int ks = 0; ks < 3; ++ks) { const bf16x8 a = *(const LAS bf16x8*)(QP + (16 * ti + fr) * 104 + 32 * ks + 8 * fq), b2 = *(const LAS bf16x8*)(ST + (16 * vi + fr) * 104 + 32 * ks + 8 * fq); acc = MFMA16(a, b2, acc); }
#pragma unroll
        for (int j = 0; j < 4; ++j) OT[(16 * ti + 4 * fq + j) * 96 + 16 * vi + fr] = acc[j];
    }
    __syncthreads();
    bf16_t* oc = (bf16_t*)(p.ws + WS_OC);
    const float* gn = p.in[I_GLAN] + l * 384 + h * 96; const float gn0 = gn[lane], gn1 = lane < 32 ? gn[64 + lane] : 0.f;
    float g0[8], g1[8];
#pragma unroll
    for (int tt = 0; tt < 8; ++tt) { const int t = wv * 8 + tt; g0[tt] = 0.f; g1[tt] = 0.f;
        if (t < ntok) { const bf16_t* gp = proj + (row0 + t) * NINP + C_GC + h * 96; g0[tt] = bf2f(gp[lane]); if (lane < 32) g1[tt] = bf2f(gp[64 + lane]); } }
#pragma unroll
    for (int tt = 0; tt < 8; ++tt) {
        const int t = wv * 8 + tt;
        if (t < ntok) {
            const float a0 = OT[t * 96 + lane], a1 = lane < 32 ? OT[t * 96 + 64 + lane] : 0.f;
            const float rs = rsqrtf(wave_sum(a0 * a0 + a1 * a1) * (1.f / 96.f) + EPS);
            oc[(row0 + t) * 384 + h * 96 + lane] = f2bf(a0 * rs * gn0 * g0[tt] * sigmoidf_(g0[tt]));
            if (lane < 32) oc[(row0 + t) * 384 + h * 96 + 64 + lane] = f2bf(a1 * rs * gn1 * g1[tt] * sigmoidf_(g1[tt]));
        }
    }
}

DI void cross_sample_unit(const Ctx& p, int l, int b, int h, int qh, LAS unsigned char* lds) {
    LAS float* qs = (LAS float*)lds;
    LAS float* ST = qs + 8 * 256;
    LAS float* PART = ST + 256 * 8;
    const bf16_t* Q = (const bf16_t*)(p.ws + WS_Q);
    const int tid = pg8::tid_(), lane = tid & 63, wv = tid >> 6;
    const size_t srow = (size_t)MP + b * 16 + 8 * qh;
    for (int i = tid; i < 8 * 256; i += NTHR) qs[i] = bf2f(Q[(srow + (i >> 8)) * D + h * 256 + (i & 255)]) * 0.0625f;
    __syncthreads();
    const int m = tid & 255, half = tid >> 8;
    {
        float acc[8];
#pragma unroll
        for (int i = 0; i < 8; ++i) acc[i] = 0.f;
        const float* kp = p.in[I_CMK] + ((((size_t)l * DB + b) * 256 + m) * 4 + h) * 256 + 128 * half;
#pragma unroll 16
        for (int d4 = 0; d4 < 32; ++d4) {
            const f32x4 kv = *(const f32x4*)(kp + 4 * d4);
#pragma unroll
            for (int i = 0; i < 8; ++i) { const f32x4 q = *(const LAS f32x4*)(qs + i * 256 + 128 * half + 4 * d4); acc[i] += (q[0] * kv[0] + q[1] * kv[1]) + (q[2] * kv[2] + q[3] * kv[3]); }
        }
#pragma unroll
        for (int i = 0; i < 8; ++i) PART[(half * 8 + i) * 256 + m] = acc[i];
    }
    __syncthreads();
    {
        const int i = wv; float v[4], mx = -3.0e38f;
#pragma unroll
        for (int j = 0; j < 4; ++j) { v[j] = PART[i * 256 + lane + 64 * j] + PART[(8 + i) * 256 + lane + 64 * j]; mx = fmaxf(mx, v[j]); }
        mx = wave_max(mx); float sum = 0.f;
#pragma unroll
        for (int j = 0; j < 4; ++j) { v[j] = __expf(v[j] - mx); sum += v[j]; }
        sum = wave_sum(sum); const float inv = 1.f / sum;
#pragma unroll
        for (int j = 0; j < 4; ++j) ST[(lane + 64 * j) * 8 + i] = v[j] * inv;
    }
    __syncthreads();
    {
        float acc[8];
#pragma unroll
        for (int i = 0; i < 8; ++i) acc[i] = 0.f;
        const float* vp = p.in[I_CMV] + ((((size_t)l * DB + b) * 256 + 128 * half) * 4 + h) * 256 + m;
        for (int k0 = 0; k0 < 128; k0 += 32) {
            float v[32];
#pragma unroll
            for (int j = 0; j < 32; ++j) v[j] = vp[(size_t)(k0 + j) * 1024];
#pragma unroll
            for (int j = 0; j < 32; ++j) {
                const f32x4 s0 = *(const LAS f32x4*)(ST + (128 * half + k0 + j) * 8), s1 = *(const LAS f32x4*)(ST + (128 * half + k0 + j) * 8 + 4);
                acc[0] += s0[0] * v[j]; acc[1] += s0[1] * v[j]; acc[2] += s0[2] * v[j]; acc[3] += s0[3] * v[j];
                acc[4] += s1[0] * v[j]; acc[5] += s1[1] * v[j]; acc[6] += s1[2] * v[j]; acc[7] += s1[3] * v[j];
            }
        }
#pragma unroll
        for (int i = 0; i < 8; ++i) PART[(half * 8 + i) * 256 + m] = acc[i];
    }
    __syncthreads();
    bf16_t* O = (bf16_t*)(p.ws + WS_O);
    for (int i = tid; i < 8 * 256; i += NTHR) { const int qi = i >> 8, d = i & 255; O[(srow + qi) * D + h * 256 + d] = f2bf(PART[qi * 256 + d] + PART[(8 + qi) * 256 + d]); }
}

struct SkBf16 { bf16_t* O; int ldc; DI void operator()(int row, int col, f32x4 v) const { u32x2 w; w.x = pk2(v[0], v[1]); w.y = pk2(v[2], v[3]); *(u32x2*)(O + (size_t)(MP + row) * ldc + col) = w; } };
struct SkGate { bf16_t* merged; const bf16_t* proj; int goff; int accum;
    DI void operator()(int row, int col, f32x4 v) const {
        const u32x2 g = *(const u32x2*)(proj + (size_t)(MP + row) * NINP + goff + col); bf16_t* mp = merged + (size_t)(MP + row) * D + col;
        u32x2 pm2 = {0u, 0u}; if (accum) pm2 = *(const u32x2*)mp;
        u32x2 w; w.x = pk2(sigmoidf_(bflo(g.x)) * v[0] + bflo(pm2.x), sigmoidf_(bfhi(g.x)) * v[1] + bfhi(pm2.x)); w.y = pk2(sigmoidf_(bflo(g.y)) * v[2] + bflo(pm2.y), sigmoidf_(bfhi(g.y)) * v[3] + bfhi(pm2.y));
        *(u32x2*)mp = w; } };
template <class EF> DI void skinny_gemm(const bf16_t* A, int lda, const bf16_t* Bt, int ldb, int K, int N, int G, int bx, LAS unsigned char* lds, const EF& ef) {
    const int tid = pg8::tid_(), lane = tid & 63, wv = tid >> 6, fr = lane & 15, fq = lane >> 4, nks = K >> 5, nunits = 4 * (N >> 4);
    LAS f32x4* red = (LAS f32x4*)lds;
    for (int u = bx; u < nunits; u += G) {
        const int rb = u & 3, cb = u >> 2;
        f32x4 acc[4];
#pragma unroll
        for (int i = 0; i < 4; ++i) acc[i] = (f32x4){0.f, 0.f, 0.f, 0.f};
        const bf16_t* bp = Bt + (size_t)(16 * cb + fr) * ldb + 8 * fq; const bf16_t* ap = A + (size_t)(64 * rb + fr) * lda + 8 * fq;
        for (int ks = wv; ks < nks; ks += 8) {
            const bf16x8 bb = *(const bf16x8*)(bp + 32 * ks);
            bf16x8 aa[4];
#pragma unroll
            for (int i = 0; i < 4; ++i) aa[i] = *(const bf16x8*)(ap + (size_t)(16 * i) * lda + 32 * ks);
#pragma unroll
            for (int i = 0; i < 4; ++i) acc[i] = MFMA16(bb, aa[i], acc[i]);
        }
#pragma unroll
        for (int i = 0; i < 4; ++i) red[(wv * 4 + i) * 64 + lane] = acc[i];
        __syncthreads();
        if (tid < 256) {
            const int i = tid >> 6; f32x4 s = red[i * 64 + lane];
#pragma unroll
            for (int w = 1; w < 8; ++w) s = s + red[(w * 4 + i) * 64 + lane];
            ef(64 * rb + 16 * i + fr, 16 * cb + 4 * fq, s);
        }
        __syncthreads();
    }
}

constexpr int PH_PER_LAYER = 15, N_PHASES = 1 + DEPTH * PH_PER_LAYER;
#define RUN_GEMM(EpiT, E, Aptr, lda_, Bptr, ldb_, K_, pm0_, nM_, nN_) do { const pg8::Gemm g_{(K_), (lda_), (ldb_)}; pg8::TileOrder S_; S_.init((Aptr), (lda_), (Bptr), (ldb_), (pm0_), (nM_), (nN_), G, bx); \
        pg8::gemm_phase<EpiT, pg8::TileOrder, true, true>(lds, g_, S_, (E)); } while (0)

__global__ void __launch_bounds__(NTHR, 2) fwd_kernel(Params p) {
    extern __shared__ __attribute__((aligned(16))) unsigned char lds_raw[];
#define PROJ ((bf16_t*)(ws + WS_PROJ))
#define H ((bf16_t*)(ws + WS_XB))
#define MERGED ((bf16_t*)(ws + WS_MERGED))
#define Y ((bf16_t*)(ws + WS_Y))
#define QB ((bf16_t*)(ws + WS_Q))
#define PB ((bf16_t*)(ws + WS_P))
#define OB ((bf16_t*)(ws + WS_O))
#define ACT ((bf16_t*)(ws + WS_ACT))

    {
        volatile LAS unsigned* st0 = (volatile LAS unsigned*)((LAS unsigned char*)lds_raw + LDS_MISC + 32);
        if (pg8::tid_() == 0) { st0[0] = 0u; st0[1] = 0u; st0[8] = 0u; st0[9] = 0u; }
        __syncthreads();
    }
    XcdBarrier xbar = xcd_barrier_post((unsigned*)(p.ws + WS_CTL) + CW_BAR, (volatile LAS unsigned*)((LAS unsigned char*)lds_raw + LDS_MISC + 32));
    if (p.ph_lo == 0) {
        prologue(p, (LAS unsigned char*)lds_raw);
        if (blockIdx.x == 0 && pg8::tid_() == 0) {
            const float** tab = (const float**)(p.ws + WS_TAB);
#pragma unroll
            for (int i = 0; i < N_IN; ++i) tab[i] = p.in[i];
        }
        if (p.ph_hi > 1) xcd_barrier(xbar);
        if (p.ph_hi < 0) cg::this_grid().sync();
    }
    for (int ph = p.ph_lo > 1 ? p.ph_lo : 1; ph < p.ph_hi; ++ph) {
        unsigned ldsb = (unsigned)(size_t)(LAS unsigned char*)lds_raw; asm volatile("" : "+s"(ldsb));
        LAS unsigned char* lds = (LAS unsigned char*)(size_t)ldsb;
        volatile LAS int* slot = (volatile LAS int*)(lds + LDS_MISC);
        unsigned char* ws = p.ws; asm volatile("" : "+s"(ws));
        Ctx c; c.ws = ws; c.in.t = (const float* const*)(ws + WS_TAB); c.out = p.out;
        unsigned* ctl = (unsigned*)(ws + WS_CTL);
        int G = gridDim.x, bx = blockIdx.x; asm volatile("" : "+s"(G), "+s"(bx));
        {
            const int l = (ph - 1) / PH_PER_LAYER, st = (ph - 1) % PH_PER_LAYER;
#ifdef PROBE_SEL
            if (bx == 0) { volatile LAS unsigned long long* a_ = (volatile LAS unsigned long long*)(lds + LDS_MISC + 64); a_[1] = __builtin_amdgcn_s_memrealtime(); }
#endif
            switch (st) {
            case 0: {
                EpiBf16 E{PROJ, NINP, 0xffff};
                RUN_GEMM(EpiBf16, E, H, D, ws + WS_WIN + l * SZ_WIN, D, D, 0, MA / 256, NINP / 256);
                if (l == 0) {
                    const pg8::Gemm g{D, D, D}; MemKvOrder S{G, bx, (const char*)(ws + WS_MN), (const char*)(ws + WS_WKV)};
                    EpiBf16 E2{(bf16_t*)(ws + WS_MKV), 2048, 7};
                    pg8::gemm_phase<EpiBf16, MemKvOrder, true, true>(lds, g, S, E2);
                }
            } break;
            case 1: {
                unsigned* ctr = ctl + 64 * ph;
                constexpr int U_SBP = 384, U_SBS = U_SBP + DB * 6, U_GLA = U_SBS + NGU, U_POOL = U_GLA + MA / 64, U_KV = U_POOL + MA / 64, U_MO = U_KV + 512, U_VT = U_MO + 512;
                const int U_ALL = l == 0 ? U_VT : U_KV;
                for (;;) {
                    const int u = next_work(ctr, slot); if (u >= U_ALL) break;
#ifdef PROBE_SEL
                    const int ut_ = u < DB * 6 ? 10 : (u < U_SBS ? 11 : (u < U_GLA ? 12 : 13));
                    if (bx == 0 && ut_ == PROBE_SEL) { volatile LAS unsigned long long* a_ = (volatile LAS unsigned long long*)(lds + LDS_MISC + 64); a_[3] = __builtin_amdgcn_s_memrealtime(); }
#endif
                    if (u < DB * 6) sb_sample_unit(c, l, u / 6, u % 6, lds);
                    else if (u < U_SBS) { const int v = u - DB * 6, qb = 7 - v / 48, bh = v % 48; sb_prompt_unit(c, bh / 6, bh % 6, qb, lds); }
                    else if (u < U_GLA) gla_stage1_unit(c, l, u - U_SBS, lds);
                    else if (u < U_POOL) pool_unit(c, l, u - U_GLA);
                    else if (u < U_KV) kvout_unit(c, l, u - U_POOL);
                    else if (u < U_MO) memout_unit(c, u - U_KV);
                    else memvt_unit(c, u - U_MO);
#ifdef PROBE_SEL
                    if (bx == 0 && ut_ == PROBE_SEL) { volatile LAS unsigned long long* a_ = (volatile LAS unsigned long long*)(lds + LDS_MISC + 64); __hip_atomic_fetch_add((LAS unsigned long long*)a_, __builtin_amdgcn_s_memrealtime() - a_[3], __ATOMIC_RELAXED, __HIP_MEMORY_SCOPE_WORKGROUP); }
#endif
                }
            } break;
            case 2: gla_scan(c, l); break;
            case 3: {
                unsigned* ctr = ctl + 64 * ph;
                for (;;) { const int u = next_work(ctr, slot); if (u >= NGU) break; gla_stage3_unit(c, l, u, lds); }
            } break;
            case 4: {
                EpiGate E1{MERGED, PROJ, C_GA, 0}, E2{MERGED, PROJ, C_GB, 1}, E3{MERGED, PROJ, C_GCG, 1};
                RUN_GEMM(EpiGate, E1, ws + WS_OA, 384, ws + WS_WBA + l * SZ_WBA, 384, 384, 0, MP / 256, 4);
                RUN_GEMM(EpiGate, E2, ws + WS_POOLED, 256, ws + WS_WBB + l * SZ_WBB, 256, 256, 0, MP / 256, 4);
                RUN_GEMM(EpiGate, E3, ws + WS_OC, 384, ws + WS_WBC + l * SZ_WBA, 384, 384, 0, MP / 256, 4);
                { SkGate F1{MERGED, PROJ, C_GA, 0}, F2{MERGED, PROJ, C_GB, 1}, F3{MERGED, PROJ, C_GCG, 1};
                  skinny_gemm((const bf16_t*)(ws + WS_OA) + (size_t)MP * 384, 384, (const bf16_t*)(ws + WS_WBA + l * SZ_WBA), 384, 384, D, G, bx, lds, F1);
                  skinny_gemm((const bf16_t*)(ws + WS_POOLED) + (size_t)MP * 256, 256, (const bf16_t*)(ws + WS_WBB + l * SZ_WBB), 256, 256, D, G, bx, lds, F2);
                  skinny_gemm((const bf16_t*)(ws + WS_OC) + (size_t)MP * 384, 384, (const bf16_t*)(ws + WS_WBC + l * SZ_WBA), 384, 384, D, G, bx, lds, F3); }
            } break;
            case 5: { EpiBf16 E{Y, D, 0xffff}; RUN_GEMM(EpiBf16, E, MERGED, D, ws + WS_WMIX + l * SZ_WSQ, D, D, 0, MP / 256, 4);
                SkBf16 F{Y, D}; skinny_gemm((const bf16_t*)MERGED + (size_t)MP * D, D, (const bf16_t*)(ws + WS_WMIX + l * SZ_WSQ), D, D, D, G, bx, lds, F); } break;
            case 6: norm_phase(c, c.in[I_NMIXPOST] + l * D, false, G, bx); break;
            case 7: { EpiBf16 E{QB, D, 0xffff}; RUN_GEMM(EpiBf16, E, H, D, ws + WS_WXQ + l * SZ_WSQ, D, D, 0, MP / 256, 4);
                SkBf16 F{QB, D}; skinny_gemm((const bf16_t*)H + (size_t)MP * D, D, (const bf16_t*)(ws + WS_WXQ + l * SZ_WSQ), D, D, D, G, bx, lds, F); } break;
            case 8: {
                const pg8::Gemm g{256, D, 2048}; CrossOrder S{G, bx, (const char*)QB, (const char*)(ws + WS_MKV + (size_t)l * 2 * SZ_WKV), 0};
                EpiSoftmax E{PB, (LAS float*)(lds + LDS_X)};
                pg8::gemm_phase<EpiSoftmax, CrossOrder, true, true>(lds, g, S, E);
            } break;
            case 9: {
                const pg8::Gemm g{256, D, 2048}; CrossOrder S{G, bx, (const char*)PB, (const char*)(ws + WS_MEMVT + (size_t)l * SZ_WKV), 1};
                EpiBf16 E{OB, D, 0xffff};
                pg8::gemm_phase<EpiBf16, CrossOrder, true, true>(lds, g, S, E);
                for (int u = bx; u < DB * 4 * 2; u += G) { __syncthreads(); cross_sample_unit(c, l, u >> 3, (u >> 1) & 3, u & 1, lds); }
            } break;
            case 10: { EpiBf16 E{Y, D, 0xffff}; RUN_GEMM(EpiBf16, E, OB, D, ws + WS_WXO + l * SZ_WSQ, D, D, 0, MP / 256, 4);
                SkBf16 F{Y, D}; skinny_gemm((const bf16_t*)OB + (size_t)MP * D, D, (const bf16_t*)(ws + WS_WXO + l * SZ_WSQ), D, D, D, G, bx, lds, F); } break;
            case 11: norm_phase(c, c.in[I_NXPOST] + l * D, false, G, bx); break;
            case 12: { EpiSwiglu E{ACT}; RUN_GEMM(EpiSwiglu, E, H, D, ws + WS_WF1 + l * SZ_WF1, D, D, 0, MA / 256, FF2 / 256); } break;
            case 13: { EpiBf16 E{Y, D, 0xffff}; RUN_GEMM(EpiBf16, E, ACT, FF, ws + WS_WF2 + l * SZ_WF2, FF, FF, 0, MP / 256, 4);
                SkBf16 F{Y, D}; skinny_gemm((const bf16_t*)ACT + (size_t)MP * FF, FF, (const bf16_t*)(ws + WS_WF2 + l * SZ_WF2), FF, FF, D, G, bx, lds, F); } break;
            default: norm_phase(c, c.in[I_NFPOST] + l * D, l == DEPTH - 1, G, bx); break;
            }
#ifdef PROBE_SEL
            {
                const int sel = PROBE_SEL; bool hit = false;
                if (sel == 2) hit = (st == 0 || st == 4 || st == 5 || st == 7 || st == 10 || st == 12 || st == 13);
                if (sel == 3) hit = (st == 2 || st == 3);
                if (sel == 4) hit = (st == 8 || st == 9);
                if (sel == 5) hit = (st == 6 || st == 11 || st == 14);
                if (sel == 6) hit = (st == 1);
                if (sel == 7) hit = (st == 0);
                if (sel == 8) hit = (st == 12);
                if (sel == 9) hit = (st == 13);
                if (bx == 0 && hit) { volatile LAS unsigned long long* a_ = (volatile LAS unsigned long long*)(lds + LDS_MISC + 64); __hip_atomic_fetch_add((LAS unsigned long long*)a_, __builtin_amdgcn_s_memrealtime() - a_[1], __ATOMIC_RELAXED, __HIP_MEMORY_SCOPE_WORKGROUP); }
            }
#endif
        }
#ifdef PROBE_SEL
        if (bx == 0) { volatile LAS unsigned long long* a_ = (volatile LAS unsigned long long*)(lds + LDS_MISC + 64); a_[2] = __builtin_amdgcn_s_memrealtime(); }
#endif
        if (ph + 1 < p.ph_hi) { if ((ph - 1) % PH_PER_LAYER == 8) { asm volatile("s_waitcnt vmcnt(0)" ::: "memory"); __syncthreads(); __builtin_amdgcn_fence(__ATOMIC_ACQUIRE, "agent"); }   else xcd_barrier(xbar); }
#ifdef PROBE_SEL
        if (PROBE_SEL == 1 && bx == 0) { volatile LAS unsigned long long* a_ = (volatile LAS unsigned long long*)(lds + LDS_MISC + 64); __hip_atomic_fetch_add((LAS unsigned long long*)a_, __builtin_amdgcn_s_memrealtime() - a_[2], __ATOMIC_RELAXED, __HIP_MEMORY_SCOPE_WORKGROUP); }
#endif
    }
#ifdef PROBE_SEL
    __syncthreads();
    if (blockIdx.x == 0) {
        volatile LAS unsigned long long* a_ = (volatile LAS unsigned long long*)((LAS unsigned char*)lds_raw + LDS_MISC + 64);
        const unsigned long long d_ = a_[0] >> 9, s_ = __builtin_amdgcn_s_memrealtime();
        while (__builtin_amdgcn_s_memrealtime() - s_ < d_) __builtin_amdgcn_s_sleep(8);
    }
#endif
}

extern "C" void kernel_launch(void* const* d_in, const int* in_sizes, int n_in, void* d_out, int out_size, void* d_ws, size_t ws_size, hipStream_t stream) {
    static int grid = 0;
    if (grid == 0) {
        if (n_in != N_IN || (size_t)out_size != O_END || ws_size < WS_END) { fprintf(stderr, "kernel_launch: unexpected shapes: n_in %d out %d ws %zu (need %zu)\n", n_in, out_size, ws_size, (size_t)WS_END); grid = -1; return; }
        int dev = 0, cus = 0, per_cu = 0;
        (void)hipGetDevice(&dev); (void)hipDeviceGetAttribute(&cus, hipDeviceAttributeMultiprocessorCount, dev);
        (void)hipFuncSetAttribute((const void*)fwd_kernel, hipFuncAttributeMaxDynamicSharedMemorySize, LDS_BYTES);
        if (hipOccupancyMaxActiveBlocksPerMultiprocessor(&per_cu, (const void*)fwd_kernel, NTHR, LDS_BYTES) != hipSuccess || per_cu < 1) { fprintf(stderr, "kernel_launch: occupancy query gave %d\n", per_cu); per_cu = 1; }
        (void)hipGetLastError();
        grid = cus * per_cu;
    }
    if (grid < 0) return;
    (void)hipMemsetAsync((char*)d_ws + WS_CTL, 0, CTL_BYTES, stream);
    Params p{};
    for (int i = 0; i < N_IN; ++i) p.in[i] = (const float*)d_in[i];
    p.out = (float*)d_out; p.ws = (unsigned char*)d_ws;
#ifdef MULTI_LAUNCH
    for (int ph = 0; ph < N_PHASES; ++ph) { p.ph_lo = ph; p.ph_hi = ph + 1; hipLaunchKernelGGL(fwd_kernel, dim3(grid), dim3(NTHR), LDS_BYTES, stream, p); }
#else
    p.ph_lo = 0; p.ph_hi = N_PHASES;
    void* args[] = {&p};
    const hipError_t e = hipLaunchCooperativeKernel((const void*)fwd_kernel, dim3(grid), dim3(NTHR), args, LDS_BYTES, stream);
    if (e != hipSuccess) fprintf(stderr, "kernel_launch: cooperative launch failed: %s (grid %d)\n", hipGetErrorString(e), grid);
#endif
}
```

```cpp
#include <hip/hip_runtime.h>
#include <hip/hip_cooperative_groups.h>
#include <cstdio>
#include <cstdint>
namespace cg = cooperative_groups;

namespace pg8 {
#define PG8_LAS __attribute__((address_space(3)))
typedef unsigned short bf16_t;
typedef short bf16x8 __attribute__((ext_vector_type(8)));
typedef float f32x4 __attribute__((ext_vector_type(4)));
typedef unsigned u32x4 __attribute__((ext_vector_type(4)));
typedef unsigned u32x2 __attribute__((ext_vector_type(2)));
constexpr int BM = 256, BK = 64, HALF = 128, HTB = HALF * BK * 2  , STAGE_BYTES = 8 * HTB, NXCD = 8, WGM = 4;

__host__ __device__ __forceinline__ int lds_byte(int r, int c) { const int st = (r >> 4) * 2 + (c >> 5), rr = r & 15, cc = c & 31, ob = rr * 64 + cc * 2; return st * 1024 + (ob ^ (((ob >> 9) & 1) << 5)); }
__host__ __device__ __forceinline__ void stage_rc(int b, int& R, int& C) { const int st = b / 1024, sb = b % 1024, swz = sb ^ (((sb >> 9) & 1) << 5); R = (st >> 1) * 16 + swz / 64; C = (st & 1) * 32 + (swz % 64) / 2; }
__host__ __device__ __forceinline__ int perm32(int rho) { const int n = rho >> 4, i = rho & 15; return 8 * (i >> 2) + 4 * n + (i & 3); }

struct Unit { int pm, pn; const char* a; const char* b; };
struct Gemm { int K, lda, ldb; };

struct TileOrder {
    int nM, nN, G, c, lda, ldb; const char* A; const char* B;
    __device__ void init(const void* A_, int lda_, const void* B_, int ldb_, int, int nM_, int nN_, int G_, int c_) {
        A = (const char*)A_; B = (const char*)B_; lda = lda_; ldb = ldb_; nM = nM_; nN = nN_; G = G_; c = c_; }
    __device__ bool next(int i, Unit& u) const {
        const int nwg = nM * nN; const long L = (long)i * G + c; if (L >= nwg) return false;
        int wgid = (int)L; { const int q = nwg / NXCD, r = nwg % NXCD, xcd = wgid % NXCD, off = wgid / NXCD; wgid = (xcd < r ? xcd * (q + 1) : r * (q + 1) + (xcd - r) * q) + off; }
        const int nig = WGM * nN, gid = wgid / nig, fm = gid * WGM, gsz = (nM - fm) < WGM ? (nM - fm) : WGM;
        u.pm = fm + ((wgid % nig) % gsz); u.pn = (wgid % nig) / gsz; u.a = A + (size_t)u.pm * ((size_t)BM * 2 * lda); u.b = B + (size_t)u.pn * ((size_t)BM * 2 * ldb); return true;
    }
    __device__ __forceinline__ void a_ready(const Unit&) const {}
    __device__ __forceinline__ void done(const Unit&) const {}
};

__device__ __forceinline__ int tid_() { int t = threadIdx.x; asm volatile("" : "+v"(t)); return t; }
__device__ __forceinline__ unsigned cvt_pk_bf16(float lo, float hi) { unsigned r; asm volatile("v_cvt_pk_bf16_f32 %0, %1, %2" : "=v"(r) : "v"(lo), "v"(hi)); return r; }

template <class Epi, class Sched, bool ALIGN_EPI = false, bool SP2 = false>
__device__ __forceinline__ void gemm_phase(PG8_LAS unsigned char* lds, const Gemm g, const Sched& S, const Epi& E) {
    const int tid = pg8::tid_(), wid = __builtin_amdgcn_readfirstlane(tid >> 6), lane = tid & 63, wr = wid >> 2, wc = wid & 3, fr = lane & 15, fq = lane >> 4;
    const int K = g.K, nt = K / BK;
    unsigned voffA, voffB;
    { int R, C; stage_rc(tid * 16, R, C); const int Rb = Epi::PERM ? ((R & ~31) + perm32(R & 31)) : R;
        voffA = (unsigned)(R * g.lda + C) * 2u; voffB = (unsigned)(Rb * g.ldb + C) * 2u; }
    const size_t qstepA = (size_t)64 * g.lda * 2, qstepB = (size_t)64 * g.ldb * 2;
    const size_t kstep = (size_t)(BK * 2);
    const size_t hstepA = (size_t)HALF * g.lda * 2, hstepB = (size_t)HALF * g.ldb * 2;
    const unsigned ldsw = (unsigned)wid * 1024u;
    const int aoff = lds_byte(wr * 64 + fr, fq * 8), boff = lds_byte(wc * 32 + fr, fq * 8);
#define PG8_SA(b, h) (((b) * 2 + (h)) * HTB)
#define PG8_SB(b, h) ((4 + (b) * 2 + (h)) * HTB)
#define PG8_STAGE(bufoff, gbase, voff) do { _Pragma("unroll") for (int _i = 0; _i < 2; ++_i) { const char* sb_ = (const char*)(gbase) + (size_t)_i * q##voff; asm volatile("" : "+s"(sb_));   \
        __builtin_amdgcn_global_load_lds((const unsigned*)(sb_ + (voff)), (PG8_LAS unsigned*)(lds + (bufoff) + ldsw + _i * 8192), 16, 0, 0); } } while (0)
#define qvoffA qstepA
#define qvoffB qstepB
#define PG8_LDA(dst, b, h) do { _Pragma("unroll") for (int m = 0; m < 4; ++m) _Pragma("unroll") for (int k = 0; k < 2; ++k) dst[m][k] = *(const PG8_LAS bf16x8*)(lds + PG8_SA(b, h) + aoff + m * 2048 + k * 1024); } while (0)
#define PG8_LDB(dst, b, h) do { _Pragma("unroll") for (int n = 0; n < 2; ++n) _Pragma("unroll") for (int k = 0; k < 2; ++k) dst[n][k] = *(const PG8_LAS bf16x8*)(lds + PG8_SB(b, h) + boff + n * 2048 + k * 1024); } while (0)
#define PG8_MMA(ai, bj, At, Bt) do { __builtin_amdgcn_s_setprio(1); _Pragma("unroll") for (int m = 0; m < 4; ++m) _Pragma("unroll") for (int n = 0; n < 2; ++n) _Pragma("unroll") for (int k = 0; k < 2; ++k) \
        acc[ai][bj][m][n] = __builtin_amdgcn_mfma_f32_16x16x32_bf16(Bt[n][k], At[m][k], acc[ai][bj][m][n], 0, 0, 0); __builtin_amdgcn_s_setprio(0); } while (0)
#define PG8_WAIT_V(n) asm volatile("s_waitcnt vmcnt(" #n ")" ::: "memory")
#define PG8_WAIT_L(n) asm volatile("s_waitcnt lgkmcnt(" #n ")" ::: "memory")
#define PG8_BAR __builtin_amdgcn_s_barrier()
#define PG8_SCHED __builtin_amdgcn_sched_barrier(0)
    Unit cur, nxt; int ui = 0;
    if (!S.next(0, cur)) return;
    f32x4 acc[2][2][4][2];
#pragma unroll
    for (int a = 0; a < 2; ++a)
#pragma unroll
        for (int b = 0; b < 2; ++b)
#pragma unroll
            for (int m = 0; m < 4; ++m)
#pragma unroll
                for (int n = 0; n < 2; ++n) acc[a][b][m][n] = (f32x4){0.f, 0.f, 0.f, 0.f};
    bf16x8 At[4][2], B0[2][2], B1[2][2];
    const char* cA = cur.a; const char* cB = cur.b;
    S.a_ready(cur);
    if constexpr (SP2) {
        PG8_STAGE(PG8_SB(0, 0), cB, voffB); PG8_STAGE(PG8_SB(0, 1), cB + hstepB, voffB); PG8_STAGE(PG8_SA(0, 0), cA, voffA); PG8_STAGE(PG8_SA(0, 1), cA + hstepA, voffA);
        if (wr == 1) PG8_BAR;
        PG8_WAIT_V(2); PG8_BAR;
        PG8_STAGE(PG8_SB(1, 0), cB + kstep, voffB); PG8_STAGE(PG8_SA(1, 0), cA + kstep, voffA); PG8_STAGE(PG8_SB(1, 1), cB + hstepB + kstep, voffB);
        PG8_WAIT_V(6); PG8_BAR;
    } else {
        PG8_STAGE(PG8_SB(0, 0), cB, voffB); PG8_STAGE(PG8_SA(0, 0), cA, voffA); PG8_STAGE(PG8_SB(0, 1), cB + hstepB, voffB); PG8_STAGE(PG8_SA(0, 1), cA + hstepA, voffA);
        if (wr == 1) PG8_BAR;
        PG8_WAIT_V(4); PG8_BAR;
        PG8_STAGE(PG8_SB(1, 0), cB + kstep, voffB); PG8_STAGE(PG8_SA(1, 0), cA + kstep, voffA); PG8_STAGE(PG8_SB(1, 1), cB + hstepB + kstep, voffB);
        PG8_WAIT_V(6); PG8_BAR;
    }
    for (;;) {
        const bool has_next = S.next(ui + 1, nxt);
        const char* nA = has_next ? nxt.a : cA; const char* nB = has_next ? nxt.b : cB;
        for (int t = 0; t < nt; t += 2) {
            const bool last = (t == nt - 2);
            const char* a1 = cA + (size_t)(t + 1) * kstep;
            const char* a2 = last ? nA : cA + (size_t)(t + 2) * kstep; const char* b2 = last ? nB : cB + (size_t)(t + 2) * kstep;
            const char* a3 = a2 + kstep; const char* b3 = b2 + kstep;
            if (last && has_next) S.a_ready(nxt);
            if constexpr (SP2) {
            PG8_LDB(B0, 0, 0); PG8_LDB(B1, 0, 1); PG8_SCHED; PG8_LDA(At, 0, 0); PG8_STAGE(PG8_SA(1, 1), a1 + hstepA, voffA);
            PG8_WAIT_V(8); PG8_WAIT_L(0); PG8_BAR; PG8_MMA(0, 0, At, B0); PG8_MMA(0, 1, At, B1); PG8_BAR; PG8_SCHED;
            PG8_LDA(At, 0, 1); PG8_STAGE(PG8_SB(0, 0), b2, voffB); PG8_STAGE(PG8_SB(0, 1), b2 + hstepB, voffB); PG8_STAGE(PG8_SA(0, 0), a2, voffA);
            PG8_WAIT_V(8); PG8_WAIT_L(0); PG8_BAR; PG8_MMA(1, 0, At, B0); PG8_MMA(1, 1, At, B1); PG8_BAR; PG8_SCHED;
            PG8_LDB(B0, 1, 0); PG8_LDB(B1, 1, 1); PG8_SCHED; PG8_LDA(At, 1, 0); PG8_STAGE(PG8_SA(0, 1), a2 + hstepA, voffA);
            PG8_WAIT_V(8); PG8_WAIT_L(0); PG8_BAR; PG8_MMA(0, 0, At, B0); PG8_MMA(0, 1, At, B1); PG8_BAR; PG8_SCHED;
            PG8_LDA(At, 1, 1); PG8_STAGE(PG8_SB(1, 0), b3, voffB); PG8_STAGE(PG8_SB(1, 1), b3 + hstepB, voffB); PG8_STAGE(PG8_SA(1, 0), a3, voffA);
            PG8_WAIT_V(8); PG8_WAIT_L(0); PG8_BAR; PG8_MMA(1, 0, At, B0); PG8_MMA(1, 1, At, B1); PG8_BAR; PG8_SCHED;
            } else {
            PG8_LDB(B0, 0, 0); PG8_SCHED; PG8_LDA(At, 0, 0); PG8_STAGE(PG8_SA(1, 1), a1 + hstepA, voffA);
            PG8_WAIT_L(8); PG8_BAR; PG8_WAIT_L(0); PG8_MMA(0, 0, At, B0); PG8_BAR; PG8_SCHED;
            PG8_LDB(B1, 0, 1); PG8_STAGE(PG8_SB(0, 0), b2, voffB);
            PG8_BAR; PG8_WAIT_L(0); PG8_MMA(0, 1, At, B1); PG8_BAR;
            PG8_LDA(At, 0, 1); PG8_STAGE(PG8_SA(0, 0), a2, voffA);
            PG8_BAR; PG8_WAIT_L(0); PG8_MMA(1, 0, At, B0); PG8_BAR; PG8_SCHED;
            PG8_STAGE(PG8_SB(0, 1), b2 + hstepB, voffB);
            PG8_WAIT_V(6); PG8_BAR; PG8_MMA(1, 1, At, B1); PG8_BAR;
            PG8_LDB(B0, 1, 0); PG8_SCHED; PG8_LDA(At, 1, 0); PG8_STAGE(PG8_SA(0, 1), a2 + hstepA, voffA);
            PG8_WAIT_L(8); PG8_BAR; PG8_WAIT_L(0); PG8_MMA(0, 0, At, B0); PG8_BAR; PG8_SCHED;
            PG8_LDB(B1, 1, 1); PG8_STAGE(PG8_SB(1, 0), b3, voffB);
            PG8_BAR; PG8_WAIT_L(0); PG8_MMA(0, 1, At, B1); PG8_BAR;
            PG8_LDA(At, 1, 1); PG8_STAGE(PG8_SA(1, 0), a3, voffA);
            PG8_BAR; PG8_WAIT_L(0); PG8_MMA(1, 0, At, B0); PG8_BAR; PG8_SCHED;
            PG8_STAGE(PG8_SB(1, 1), b3 + hstepB, voffB);
            PG8_WAIT_V(6); PG8_BAR; PG8_MMA(1, 1, At, B1); PG8_BAR;
            }
        }
        if constexpr (ALIGN_EPI) { if (wr == 0) PG8_BAR; }
        if constexpr (!Epi::AFTER_DRAIN) { const int l2_ = tid_() & 63, fr2 = l2_ & 15, fq2 = l2_ >> 4;   E(acc, cur, wr, wc, fr2, fq2); S.done(cur); }
        if (!has_next) break;
#pragma unroll
        for (int a = 0; a < 2; ++a)
#pragma unroll
            for (int b = 0; b < 2; ++b)
#pragma unroll
                for (int m = 0; m < 4; ++m)
#pragma unroll
                    for (int n = 0; n < 2; ++n) acc[a][b][m][n] = (f32x4){0.f, 0.f, 0.f, 0.f};
        cur = nxt; cA = nA; cB = nB; ++ui;
        if constexpr (ALIGN_EPI) { if (wr == 1) PG8_BAR; }
    }
    PG8_WAIT_V(0);
    if constexpr (!ALIGN_EPI) { if (wr == 0) PG8_BAR; }
    PG8_BAR;
    if constexpr (Epi::AFTER_DRAIN) { E.fused(acc, cur, wr, wc, fr, fq, lds, wid, lane); S.done(cur); }
#undef PG8_SA
#undef PG8_SB
#undef PG8_STAGE
#undef qvoffA
#undef qvoffB
#undef PG8_LDA
#undef PG8_LDB
#undef PG8_MMA
#undef PG8_WAIT_V
#undef PG8_WAIT_L
#undef PG8_BAR
#undef PG8_SCHED
}
}

using pg8::bf16_t; using pg8::f32x4; using pg8::bf16x8; using pg8::u32x4; using pg8::u32x2;
#define DI __device__ __forceinline__
#define LAS __attribute__((address_space(3)))
typedef float f32x16 __attribute__((ext_vector_type(16)));
typedef short s16x4 __attribute__((ext_vector_type(4)));
typedef float f32x2_t __attribute__((ext_vector_type(2))); typedef __bf16 bf16x2_t __attribute__((ext_vector_type(2)));

constexpr int NTHR = 512, NWAVES = 8;
constexpr int D = 1024, NB = 8, SEQ = 2048, DEPTH = 4, DB = 16, DT = 16, PAST = 1024;
constexpr int MP = NB * SEQ, MS = DB * DT, MA = MP + MS;
constexpr int NIN = 6032, NINP = 6144;
constexpr int C_QA = 0, C_KA = 384, C_VA = 768, C_U = 1152, C_QC = 1408, C_KC = 1792, C_VC = 2176, C_GC = 2560, C_LR = 2944, C_GA = 2960, C_GB = 3984, C_GCG = 5008;
constexpr int FF = 2816, FF2 = 5632;
constexpr int GH = 4, GK = 96;
constexpr int NGU_P = NB * GH * 32, NGU_S = DB * GH, NGU = NGU_P + NGU_S;
constexpr float EPS = 1e-6f;

constexpr size_t O_YP = 0, O_YS = O_YP + (size_t)MP * D, O_KP = O_YS + (size_t)MS * D, O_VP = O_KP + (size_t)DEPTH * MP * 384, O_POOLP = O_VP + (size_t)DEPTH * MP * 384,
    O_GLAP = O_POOLP + (size_t)DEPTH * NB * 15 * 256, O_MKP = O_GLAP + (size_t)DEPTH * NB * GH * GK * GK, O_MVP = O_MKP + (size_t)DEPTH * NB * 256 * D,
    O_KS = O_MVP + (size_t)DEPTH * NB * 256 * D, O_VS = O_KS + (size_t)DEPTH * MS * 384, O_POOLS = O_VS + (size_t)DEPTH * MS * 384, O_GLAS = O_POOLS + (size_t)DEPTH * DB * 15 * 256,
    O_END = O_GLAS + (size_t)DEPTH * DB * GH * GK * GK;

enum { I_XP = 0, I_XS, I_MEM, I_CSK, I_CSV, I_SPOOL, I_SGLA, I_CMK, I_CMV, I_WIN, I_WA2, I_BA, I_GLAN, I_WPOOL, I_PSCALE, I_WBA, I_WBB, I_WBC, I_WMIX, I_MEMN, I_WXQ, I_WXK, I_WXV, I_WXO,
       I_WF1, I_WF2, I_NMIXPRE, I_NMIXPOST, I_NXPRE, I_NXPOST, I_NFPRE, I_NFPOST, N_IN };

constexpr size_t MiB = 1u << 20;
constexpr size_t SZ_WIN = (size_t)NINP * D * 2, SZ_WBA = (size_t)D * 384 * 2, SZ_WBB = (size_t)D * 256 * 2, SZ_WSQ = (size_t)D * D * 2, SZ_WKV = 2 * SZ_WSQ, SZ_WF1 = (size_t)FF2 * D * 2, SZ_WF2 = (size_t)D * FF * 2;
constexpr size_t WS_CTL = 0, CTL_BYTES = 1 * MiB, WS_TAB = CTL_BYTES - 4096;
constexpr size_t WS_WIN = WS_CTL + CTL_BYTES, WS_WBA = WS_WIN + 4 * SZ_WIN, WS_WBB = WS_WBA + 4 * SZ_WBA, WS_WBC = WS_WBB + 4 * SZ_WBB, WS_WMIX = WS_WBC + 4 * SZ_WBA,
    WS_WXQ = WS_WMIX + 4 * SZ_WSQ, WS_WXO = WS_WXQ + 4 * SZ_WSQ, WS_WKV = WS_WXO + 4 * SZ_WSQ, WS_WF1 = WS_WKV + 4 * SZ_WKV, WS_WF2 = WS_WF1 + 4 * SZ_WF1,
    WS_MN = WS_WF2 + 4 * SZ_WF2, WS_MKV = WS_MN + 4 * SZ_WKV, WS_MEMVT = WS_MKV + 8 * SZ_WKV, WS_PROJ = WS_MEMVT + 4 * SZ_WKV;
constexpr size_t SZ_ROWS = (size_t)MA * D * 2;
constexpr size_t SZ_PROJ = (size_t)MA * NINP * 2;
constexpr size_t WS_Q = WS_PROJ, WS_P = WS_Q + SZ_ROWS, WS_O = WS_P + SZ_ROWS, WS_ACT = WS_O + SZ_ROWS;
static_assert(WS_ACT + (size_t)MA * FF * 2 <= WS_PROJ + SZ_PROJ, "overlay fits");
constexpr size_t WS_H = WS_PROJ + SZ_PROJ, WS_MERGED = WS_H + SZ_ROWS, WS_Y = WS_MERGED + SZ_ROWS;
constexpr size_t WS_GKV = WS_H, WS_GSP = WS_GKV + 39 * MiB, WS_GDEC = WS_GSP + 37 * MiB;
static_assert((size_t)NGU * GK * GK * 4 <= 39 * MiB && (size_t)NGU_P * GK * GK * 4 <= 37 * MiB && WS_GDEC + (size_t)NGU * GK * 4 <= WS_Y + SZ_ROWS, "GLA overlay fits");
constexpr size_t WS_OA = WS_Y + SZ_ROWS, WS_POOLED = WS_OA + (size_t)MA * 384 * 2, WS_OC = WS_POOLED + (size_t)MA * 256 * 2, WS_BB = WS_OC + (size_t)MA * 384 * 2, WS_XB = WS_BB + (size_t)NGU * 64 * GK * 4, WS_RN = WS_XB + SZ_ROWS, WS_END = WS_RN + (size_t)MA * 4;
static_assert(WS_WIN % 256 == 0 && WS_PROJ % 256 == 0 && WS_H % 256 == 0 && WS_OA % 256 == 0 && WS_POOLED % 256 == 0 && WS_OC % 256 == 0 && WS_P % 256 == 0, "alignment");

constexpr int CW_BAR = 16384;
constexpr int LDS_GEMM = 131072, LDS_X = LDS_GEMM, LDS_X_BYTES = 12288, LDS_MISC = LDS_X + LDS_X_BYTES, LDS_BYTES = LDS_MISC + 256;

struct Params { const float* in[N_IN]; float* out; unsigned char* ws; int ph_lo, ph_hi; };
struct InTab { const float* const* t;
    __device__ __forceinline__ const float* operator[](int i) const { const unsigned long long v = (unsigned long long)t[i];
        const unsigned lo = __builtin_amdgcn_readfirstlane((unsigned)v), hi = __builtin_amdgcn_readfirstlane((unsigned)(v >> 32)); return (const float*)(((unsigned long long)hi << 32) | lo); } };
struct Ctx { InTab in; float* out; unsigned char* ws; };

DI float bflo(unsigned w) { return __uint_as_float(w << 16); }
DI float bfhi(unsigned w) { return __uint_as_float(w & 0xffff0000u); }
DI float bf2f(unsigned short v) { return __uint_as_float((unsigned)v << 16); }
DI unsigned pk2(float lo, float hi) { f32x2_t v = {lo, hi}; bf16x2_t b = __builtin_convertvector(v, bf16x2_t); return __builtin_bit_cast(unsigned, b); }
DI unsigned short f2bf(float f) { return (unsigned short)(pk2(f, 0.f) & 0xffffu); }
DI float wave_sum(float v) {
#pragma unroll
    for (int o = 1; o < 64; o <<= 1) v += __shfl_xor(v, o);
    return v;
}
DI float wave_max(float v) {
#pragma unroll
    for (int o = 1; o < 64; o <<= 1) v = fmaxf(v, __shfl_xor(v, o));
    return v;
}
DI float sigmoidf_(float x) { return __builtin_amdgcn_rcpf(1.f + __expf(-x)); }
DI float softplusf_(float z) { return fmaxf(z, 0.f) + __logf(1.f + __expf(-fabsf(z))); }
DI int next_work(unsigned* ctr, volatile LAS int* slot) {
    __syncthreads();
    if (pg8::tid_() == 0) *slot = (int)atomicAdd(ctr, 1u);
    __syncthreads();
    return *slot;
}

typedef const pg8::f32x4 (&AccRef)[2][2][4][2];
struct EpiBf16 {
    static constexpr bool PERM = true, AFTER_DRAIN = false;
    bf16_t* O; int ldc; int pnmask;
    DI void operator()(AccRef acc, const pg8::Unit& u, int wr, int wc, int fr, int fq) const {
#pragma unroll
        for (int ai = 0; ai < 2; ++ai)
#pragma unroll
            for (int m = 0; m < 4; ++m) {
                bf16_t* rowp = O + (size_t)(u.pm * 256 + ai * 128 + wr * 64 + m * 16 + fr) * ldc + (u.pn & pnmask) * 256 + wc * 32 + 8 * fq;
#pragma unroll
                for (int bj = 0; bj < 2; ++bj) {
                    const f32x4 v0 = acc[ai][bj][m][0], v1 = acc[ai][bj][m][1];
                    u32x4 w; w.x = pk2(v0[0], v0[1]); w.y = pk2(v0[2], v0[3]); w.z = pk2(v1[0], v1[1]); w.w = pk2(v1[2], v1[3]);
                    *(u32x4*)(rowp + bj * 128) = w;
                }
            }
    }
};
struct EpiGate {
    static constexpr bool PERM = true, AFTER_DRAIN = false;
    bf16_t* merged; const bf16_t* proj; int goff; int accum;
    DI void operator()(AccRef acc, const pg8::Unit& u, int wr, int wc, int fr, int fq) const {
#pragma unroll
        for (int ai = 0; ai < 2; ++ai)
#pragma unroll
            for (int m = 0; m < 4; ++m) {
                const int row = u.pm * 256 + ai * 128 + wr * 64 + m * 16 + fr;
                const bf16_t* gp = proj + (size_t)row * NINP + goff + u.pn * 256 + wc * 32 + 8 * fq;
                bf16_t* mp = merged + (size_t)row * D + u.pn * 256 + wc * 32 + 8 * fq;
                u32x4 g[2], pm4[2];
#pragma unroll
                for (int bj = 0; bj < 2; ++bj) { g[bj] = *(const u32x4*)(gp + bj * 128); pm4[bj] = (u32x4){0u, 0u, 0u, 0u}; if (accum) pm4[bj] = *(const u32x4*)(mp + bj * 128); }
#pragma unroll
                for (int bj = 0; bj < 2; ++bj) {
                    const f32x4 v0 = acc[ai][bj][m][0], v1 = acc[ai][bj][m][1];
                    u32x4 w;
                    w.x = pk2(sigmoidf_(bflo(g[bj].x)) * v0[0] + bflo(pm4[bj].x), sigmoidf_(bfhi(g[bj].x)) * v0[1] + bfhi(pm4[bj].x));
                    w.y = pk2(sigmoidf_(bflo(g[bj].y)) * v0[2] + bflo(pm4[bj].y), sigmoidf_(bfhi(g[bj].y)) * v0[3] + bfhi(pm4[bj].y));
                    w.z = pk2(sigmoidf_(bflo(g[bj].z)) * v1[0] + bflo(pm4[bj].z), sigmoidf_(bfhi(g[bj].z)) * v1[1] + bfhi(pm4[bj].z));
                    w.w = pk2(sigmoidf_(bflo(g[bj].w)) * v1[2] + bflo(pm4[bj].w), sigmoidf_(bfhi(g[bj].w)) * v1[3] + bfhi(pm4[bj].w));
                    *(u32x4*)(mp + bj * 128) = w;
                }
                if (m & 1) asm volatile("" ::: "memory");
            }
    }
};
struct EpiSwiglu {
    static constexpr bool PERM = true, AFTER_DRAIN = false;
    bf16_t* act;
    DI void operator()(AccRef acc, const pg8::Unit& u, int wr, int wc, int fr, int fq) const {
#pragma unroll
        for (int ai = 0; ai < 2; ++ai)
#pragma unroll
            for (int m = 0; m < 4; ++m) {
                const int row = u.pm * 256 + ai * 128 + wr * 64 + m * 16 + fr;
#pragma unroll
                for (int bj = 0; bj < 2; ++bj) {
                    const int col0 = u.pn * 256 + bj * 128 + wc * 32 + 8 * fq;
                    const f32x4 g = acc[ai][bj][m][0], up = acc[ai][bj][m][1];
                    float r[4];
#pragma unroll
                    for (int j = 0; j < 4; ++j) r[j] = g[j] * sigmoidf_(g[j]) * up[j];
                    u32x2 w; w.x = pk2(r[0], r[1]); w.y = pk2(r[2], r[3]);
                    *(u32x2*)(act + (size_t)row * FF + (col0 >> 1)) = w;
                }
            }
    }
};
struct MemKvOrder {
    int G, c; const char* A; const char* B;
    DI bool next(int i, pg8::Unit& u) const {
        const int L = i * G + c; if (L >= 256) return false;
        const int l = L >> 6, r = L & 63; u.pm = l * 8 + (r & 7); u.pn = l * 8 + (r >> 3);
        u.a = A + (size_t)u.pm * (256 * D * 2); u.b = B + (size_t)u.pn * (256 * D * 2); return true;
    }
    DI void a_ready(const pg8::Unit&) const {}
    DI void done(const pg8::Unit&) const {}
};
struct CrossOrder {
    int G, c; const char* A; const char* B; int mode;
    DI bool next(int i, pg8::Unit& u) const {
        const int L = i * G + c; if (L >= 256) return false;
        u.pm = L >> 2; u.pn = L & 3; const int b = u.pm >> 3, h = u.pn;
        u.a = A + ((size_t)u.pm * 256 * D + h * 256) * 2;
        u.b = mode == 0 ? B + ((size_t)b * 256 * 2048 + h * 256) * 2 : B + ((size_t)h * 256 * 2048 + b * 256) * 2;
        return true;
    }
    DI void a_ready(const pg8::Unit&) const {}
    DI void done(const pg8::Unit&) const {}
};
struct EpiSoftmax {
    static constexpr bool PERM = true, AFTER_DRAIN = false;
    bf16_t* P; LAS float* xs;
    DI void operator()(AccRef acc, const pg8::Unit& u, int wr, int wc, int fr, int fq) const {
        const float sc = 0.0625f * 1.4426950408889634f;
        LAS float* xm = xs; LAS float* xsum = xs + 1024;
#pragma unroll
        for (int ai = 0; ai < 2; ++ai)
#pragma unroll
            for (int m = 0; m < 4; ++m) {
                float a = -3.0e38f;
#pragma unroll
                for (int bj = 0; bj < 2; ++bj)
#pragma unroll
                    for (int n = 0; n < 2; ++n) { const f32x4 v = acc[ai][bj][m][n]; a = fmaxf(a, fmaxf(fmaxf(v[0], v[1]), fmaxf(v[2], v[3]))); }
                a = fmaxf(a, __shfl_xor(a, 16)); a = fmaxf(a, __shfl_xor(a, 32));
                if (fq == 0) xm[(ai * 128 + wr * 64 + m * 16 + fr) * 4 + wc] = a;
                asm volatile("" ::: "memory");
            }
        __syncthreads();
#pragma unroll
        for (int ai = 0; ai < 2; ++ai)
#pragma unroll
            for (int m = 0; m < 4; ++m) {
                const f32x4 t = *(LAS f32x4*)(xm + (ai * 128 + wr * 64 + m * 16 + fr) * 4); const float mx = fmaxf(fmaxf(t[0], t[1]), fmaxf(t[2], t[3])) * sc;
                float s = 0.f;
#pragma unroll
                for (int bj = 0; bj < 2; ++bj)
#pragma unroll
                    for (int n = 0; n < 2; ++n)
#pragma unroll
                        for (int j = 0; j < 4; ++j) s += __builtin_amdgcn_exp2f(acc[ai][bj][m][n][j] * sc - mx);
                s += __shfl_xor(s, 16); s += __shfl_xor(s, 32);
                if (fq == 0) xsum[(ai * 128 + wr * 64 + m * 16 + fr) * 4 + wc] = s;
                asm volatile("" ::: "memory");
            }
        __syncthreads();
#pragma unroll
        for (int ai = 0; ai < 2; ++ai)
#pragma unroll
            for (int m = 0; m < 4; ++m) {
                const f32x4 t = *(LAS f32x4*)(xm + (ai * 128 + wr * 64 + m * 16 + fr) * 4); const float mx = fmaxf(fmaxf(t[0], t[1]), fmaxf(t[2], t[3])) * sc;
                const f32x4 t2 = *(LAS f32x4*)(xsum + (ai * 128 + wr * 64 + m * 16 + fr) * 4); const float inv = __builtin_amdgcn_rcpf((t2[0] + t2[1]) + (t2[2] + t2[3]));
                bf16_t* rowp = P + (size_t)(u.pm * 256 + ai * 128 + wr * 64 + m * 16 + fr) * D + u.pn * 256 + wc * 32 + 8 * fq;
#pragma unroll
                for (int bj = 0; bj < 2; ++bj)
#pragma unroll
                    for (int n = 0; n < 2; ++n) {
                        const f32x4 v = acc[ai][bj][m][n];
                        u32x2 w; w.x = pk2(__builtin_amdgcn_exp2f(v[0] * sc - mx) * inv, __builtin_amdgcn_exp2f(v[1] * sc - mx) * inv); w.y = pk2(__builtin_amdgcn_exp2f(v[2] * sc - mx) * inv, __builtin_amdgcn_exp2f(v[3] * sc - mx) * inv);
                        *(u32x2*)(rowp + bj * 128 + 4 * n) = w;
                    }
                asm volatile("" ::: "memory");
            }
        __syncthreads();
    }
};

#define XB_TMO      128
#define XB_XCNT(j)  (256  + 64 * (j))
#define XB_XSUB(j)  (1280 + 64 * (j))
#define XB_XGEN(j)  (2304 + 64 * (j))
#define XB_TOP      3328
#define XB_TOPGEN   3392
#define XCD_BAR_WORDS 3456
#define XB_SPIN_CAP (1u << 18)

__device__ __forceinline__ unsigned xb_ld(unsigned* p)              { return __hip_atomic_load(p, __ATOMIC_RELAXED, __HIP_MEMORY_SCOPE_AGENT); }
__device__ __forceinline__ unsigned xb_add(unsigned* p, unsigned v) { return __hip_atomic_fetch_add(p, v, __ATOMIC_RELAXED, __HIP_MEMORY_SCOPE_AGENT); }
__device__ __forceinline__ unsigned xb_xcc_id() { return (unsigned)__builtin_amdgcn_s_getreg((3 << 11) | 20) & 0xFu; }
#define XB_SPIN(cond, bar) do { unsigned _sp = 0; while (cond) { __builtin_amdgcn_s_sleep(1); \
    if ((++_sp & 255u) == 0u) { if (xb_ld(&(bar)[XB_TMO])) break; if (_sp > XB_SPIN_CAP) { atomicAdd(&(bar)[XB_TMO], 1u); break; } } } } while (0)

struct XcdBarrier {
    unsigned* bar; unsigned x;
    volatile LAS unsigned* st;
};

__device__ __forceinline__ XcdBarrier xcd_barrier_post(unsigned* bar, volatile LAS unsigned* st) {
    XcdBarrier b; b.bar = bar; b.x = xb_xcc_id(); b.st = st;
    if (threadIdx.x == 0) (void)xb_add(&bar[XB_XCNT(b.x)], 1u);
    return b;
}
__device__ __forceinline__ void xcd_barrier_complete(unsigned* bar, unsigned x, unsigned& nloc, unsigned& nx) {
    const unsigned G = gridDim.x * gridDim.y * gridDim.z;
    unsigned sum, cnt, mine, sp = 0u;
    for (;;) {
        sum = 0u; cnt = 0u; mine = 0u;
#pragma unroll
        for (unsigned j = 0; j < 16; ++j) { const unsigned c = xb_ld(&bar[XB_XCNT(j)]); sum += c; cnt += (c > 0u) ? 1u : 0u; mine = (j == x) ? c : mine; }
        if (sum == G) break;
        __builtin_amdgcn_s_sleep(1);
        if ((++sp & 255u) == 0u) { if (xb_ld(&bar[XB_TMO])) break; if (sp > XB_SPIN_CAP) { atomicAdd(&bar[XB_TMO], 1u); break; } }
    }
    nloc = mine > 0u ? mine : 1u; nx = cnt > 0u ? cnt : 1u;
}

__device__ __forceinline__ void xcd_barrier(const XcdBarrier& b) {
    asm volatile("s_waitcnt vmcnt(0)" ::: "memory");
    __syncthreads();
    if (threadIdx.x == 0) {
        unsigned* bar = b.bar;
        __builtin_amdgcn_s_waitcnt(0);
        unsigned nloc = b.st[0], nx = b.st[1];
        if (nloc == 0u) { xcd_barrier_complete(bar, b.x, nloc, nx); b.st[0] = nloc; b.st[1] = nx; }
        const unsigned old = xb_add(&bar[XB_XSUB(b.x)], 1u);
        const unsigned gen = old / nloc;
        if (old + 1u == (gen + 1u) * nloc) {
            __builtin_amdgcn_fence(__ATOMIC_RELEASE, "agent");
            asm volatile("s_waitcnt vmcnt(0)" ::: "memory");
            const unsigned og = xb_add(&bar[XB_TOP], 1u);
            const unsigned tg = og / nx;
            if (og + 1u == (tg + 1u) * nx) xb_add(&bar[XB_TOPGEN], 1u);
            else XB_SPIN(xb_ld(&bar[XB_TOPGEN]) == tg, bar);
            __builtin_amdgcn_fence(__ATOMIC_ACQUIRE, "agent");
            xb_add(&bar[XB_XGEN(b.x)], 1u);
            asm volatile("s_waitcnt vmcnt(0)" ::: "memory");
        } else {
            XB_SPIN(xb_ld(&bar[XB_XGEN(b.x)]) == gen, bar);
            __builtin_amdgcn_fence(__ATOMIC_ACQUIRE, "agent");
            asm volatile("s_waitcnt vmcnt(0)" ::: "memory");
        }
    }
    __syncthreads();
}


#define LDS_WAIT() asm volatile("s_waitcnt lgkmcnt(0)" ::: "memory")
DI void transpose_item(const float* W, int K, int N, int Npad, bf16_t* WT, int mode, LAS float* scr, int item, int lane, const float* gk = nullptr) {
    const int nblk = Npad / 32, kb = item / nblk, nb = item % nblk, k0 = 64 * kb, n0 = 32 * nb;
    const int nn = n0 + (lane & 31); const bool ok = nn < N;
    float tv[32];
#pragma unroll
    for (int i = 0; i < 32; ++i) tv[i] = ok ? W[(size_t)(k0 + 2 * i + (lane >> 5)) * N + nn] : 0.f;
    if (gk) {
#pragma unroll
        for (int i = 0; i < 32; ++i) tv[i] *= gk[k0 + 2 * i + (lane >> 5)];
    }
#pragma unroll
    for (int i = 0; i < 32; ++i) scr[(2 * i + (lane >> 5)) * 33 + (lane & 31)] = tv[i];
    LDS_WAIT(); asm volatile("" ::: "memory");
    const int c = lane & 7;
#pragma unroll
    for (int j = 0; j < 4; ++j) {
        const int n = (lane >> 3) + 8 * j; const LAS float* s = scr + (8 * c) * 33 + n;
        u32x4 o; o.x = pk2(s[0 * 33], s[1 * 33]); o.y = pk2(s[2 * 33], s[3 * 33]); o.z = pk2(s[4 * 33], s[5 * 33]); o.w = pk2(s[6 * 33], s[7 * 33]);
        int drow = n0 + n;
        if (mode == 1) { const int jj = drow >= FF ? drow - FF : drow, isu = drow >= FF ? 1 : 0; drow = (jj >> 2) * 8 + isu * 4 + (jj & 3); }
        *(u32x4*)(WT + (size_t)drow * K + k0 + 8 * c) = o;
    }
    LDS_WAIT(); asm volatile("" ::: "memory");
}

template <int NR> DI void norm_rows(const float* xsrc32, bf16_t* xn, float* rn, float* xdst32, const bf16_t* y, const float* gpost, size_t rstride, int lane) {
    f32x4 v[NR][4];
    if (xsrc32) {
#pragma unroll
        for (int r = 0; r < NR; ++r)
#pragma unroll
            for (int j = 0; j < 4; ++j) v[r][j] = *(const f32x4*)(xsrc32 + r * rstride + 4 * lane + 256 * j);
    } else {
        float rr[NR]; u32x2 w[NR][4];
#pragma unroll
        for (int r = 0; r < NR; ++r) { rr[r] = rn[r * (rstride / D)];
#pragma unroll
            for (int j = 0; j < 4; ++j) w[r][j] = *(const u32x2*)(xn + r * rstride + 4 * lane + 256 * j); }
#pragma unroll
        for (int r = 0; r < NR; ++r)
#pragma unroll
            for (int j = 0; j < 4; ++j) v[r][j] = (f32x4){bflo(w[r][j].x), bfhi(w[r][j].x), bflo(w[r][j].y), bfhi(w[r][j].y)} * rr[r];
    }
    if (y) {
        u32x2 yw[NR][4]; f32x4 g[4];
#pragma unroll
        for (int r = 0; r < NR; ++r)
#pragma unroll
            for (int j = 0; j < 4; ++j) yw[r][j] = *(const u32x2*)(y + r * rstride + 4 * lane + 256 * j);
#pragma unroll
        for (int j = 0; j < 4; ++j) g[j] = *(const f32x4*)(gpost + 4 * lane + 256 * j);
#pragma unroll
        for (int r = 0; r < NR; ++r) {
            f32x4 yv[4]; float ss = 0.f;
#pragma unroll
            for (int j = 0; j < 4; ++j) { yv[j] = (f32x4){bflo(yw[r][j].x), bfhi(yw[r][j].x), bflo(yw[r][j].y), bfhi(yw[r][j].y)}; ss += (yv[j][0] * yv[j][0] + yv[j][1] * yv[j][1]) + (yv[j][2] * yv[j][2] + yv[j][3] * yv[j][3]); }
            const float rs = rsqrtf(wave_sum(ss) * (1.f / D) + EPS);
#pragma unroll
            for (int j = 0; j < 4; ++j) v[r][j] = v[r][j] + yv[j] * rs * g[j];
        }
    }
#pragma unroll
    for (int r = 0; r < NR; ++r) {
        if (xdst32) {
#pragma unroll
            for (int j = 0; j < 4; ++j) *(f32x4*)(xdst32 + r * rstride + 4 * lane + 256 * j) = v[r][j];
        } else {
            float ss = 0.f;
#pragma unroll
            for (int j = 0; j < 4; ++j) ss += (v[r][j][0] * v[r][j][0] + v[r][j][1] * v[r][j][1]) + (v[r][j][2] * v[r][j][2] + v[r][j][3] * v[r][j][3]);
            const float ms = wave_sum(ss) * (1.f / D) + EPS, rs = rsqrtf(ms);
#pragma unroll
            for (int j = 0; j < 4; ++j) { const f32x4 o = v[r][j] * rs; u32x2 w; w.x = pk2(o[0], o[1]); w.y = pk2(o[2], o[3]); *(u32x2*)(xn + r * rstride + 4 * lane + 256 * j) = w; }
            if (lane == 0) rn[r * (rstride / D)] = ms * rs;
        }
    }
}
DI void norm_row(const float* xsrc32, bf16_t* xn, float* rn, float* xdst32, const bf16_t* y, const float* gpost, int lane) { norm_rows<1>(xsrc32, xn, rn, xdst32, y, gpost, (size_t)D, lane); }

DI void norm_phase(const Ctx& p, const float* gpost, bool last, int G, int bx) {
    const int tid = pg8::tid_(), lane = tid & 63, wv = tid >> 6, gw = bx * NWAVES + wv, NGW = G * NWAVES;
    const bf16_t* Yb = (const bf16_t*)(p.ws + WS_Y); bf16_t* Xb = (bf16_t*)(p.ws + WS_XB); float* Rn = (float*)(p.ws + WS_RN);
    int row = gw; const size_t rst = (size_t)NGW * D;
    for (; row + 3 * NGW < MA; row += 4 * NGW) norm_rows<4>(nullptr, Xb + (size_t)row * D, Rn + row, last ? p.out + (size_t)row * D : nullptr, Yb + (size_t)row * D, gpost, rst, lane);
    for (; row < MA; row += NGW) norm_row(nullptr, Xb + (size_t)row * D, Rn + row, last ? p.out + (size_t)row * D : nullptr, Yb + (size_t)row * D, gpost, lane);
}

DI void prologue(const Params& p, LAS unsigned char* lds) {
    const int tid = pg8::tid_(), lane = tid & 63, wv = tid >> 6;
    const int gw = blockIdx.x * NWAVES + wv, NGW = gridDim.x * NWAVES;
    LAS float* scr = (LAS float*)(lds + wv * 16384);
    unsigned char* ws = p.ws;
    constexpr int I0 = 3072, I1 = 192, I2 = 512, I3 = 2816, I4 = 1408, IPL = I0 + 2 * I1 + 5 * I2 + I3 + I4;
    for (int it = gw; it < 4 * IPL; it += NGW) {
        const int l = it / IPL; int r = it % IPL;
        if (r < I0) { transpose_item(p.in[I_WIN] + (size_t)l * D * NIN, D, NIN, NINP, (bf16_t*)(ws + WS_WIN + l * SZ_WIN), 0, scr, r, lane, p.in[I_NMIXPRE] + l * D); continue; } r -= I0;
        if (r < I1) { transpose_item(p.in[I_WBA] + (size_t)l * 384 * D, 384, D, D, (bf16_t*)(ws + WS_WBA + l * SZ_WBA), 0, scr, r, lane); continue; } r -= I1;
        if (r < I1) { transpose_item(p.in[I_WBC] + (size_t)l * 384 * D, 384, D, D, (bf16_t*)(ws + WS_WBC + l * SZ_WBA), 0, scr, r, lane); continue; } r -= I1;
        if (r < I2) { transpose_item(p.in[I_WMIX] + (size_t)l * D * D, D, D, D, (bf16_t*)(ws + WS_WMIX + l * SZ_WSQ), 0, scr, r, lane); continue; } r -= I2;
        if (r < I2) { transpose_item(p.in[I_WXQ] + (size_t)l * D * D, D, D, D, (bf16_t*)(ws + WS_WXQ + l * SZ_WSQ), 0, scr, r, lane, p.in[I_NXPRE] + l * D); continue; } r -= I2;
        if (r < I2) { transpose_item(p.in[I_WXO] + (size_t)l * D * D, D, D, D, (bf16_t*)(ws + WS_WXO + l * SZ_WSQ), 0, scr, r, lane); continue; } r -= I2;
        if (r < I2) { transpose_item(p.in[I_WXK] + (size_t)l * D * D, D, D, D, (bf16_t*)(ws + WS_WKV + l * SZ_WKV), 0, scr, r, lane); continue; } r -= I2;
        if (r < I2) { transpose_item(p.in[I_WXV] + (size_t)l * D * D, D, D, D, (bf16_t*)(ws + WS_WKV + l * SZ_WKV + SZ_WSQ), 0, scr, r, lane); continue; } r -= I2;
        if (r < I3) { transpose_item(p.in[I_WF1] + (size_t)l * D * FF2, D, FF2, FF2, (bf16_t*)(ws + WS_WF1 + l * SZ_WF1), 1, scr, r, lane, p.in[I_NFPRE] + l * D); continue; } r -= I3;
        transpose_item(p.in[I_WF2] + (size_t)l * FF * D, FF, D, D, (bf16_t*)(ws + WS_WF2 + l * SZ_WF2), 0, scr, r, lane);
    }
    for (int u = blockIdx.x; u < 128; u += gridDim.x) {
        const int l = u >> 5, g = (u >> 3) & 3, nb = (u >> 2) & 1, cq = u & 3;
        LAS float* Ps = (LAS float*)(lds + 8 * 16384);
        __syncthreads();
        for (int i = tid; i < 1024; i += NTHR) Ps[i] = p.in[I_WPOOL][((size_t)(l * 4 + g) * 64 + 16 * cq) * 64 + i];
        __syncthreads();
        const int n = nb * 512 + tid;
        const float* sc = p.in[I_PSCALE] + l * 256 + g * 64; const float* wb = p.in[I_WBB] + ((size_t)l * 256 + g * 64) * D + n;
        float acc[16];
#pragma unroll
        for (int c = 0; c < 16; ++c) acc[c] = 0.f;
#pragma unroll 2
        for (int d0 = 0; d0 < 64; d0 += 8) {
            float bc[8];
#pragma unroll
            for (int j = 0; j < 8; ++j) bc[j] = sc[d0 + j] * wb[(size_t)(d0 + j) * D];
#pragma unroll
            for (int c = 0; c < 16; ++c) { const f32x4 p0 = *(const LAS f32x4*)(Ps + c * 64 + d0), p1 = *(const LAS f32x4*)(Ps + c * 64 + d0 + 4);
                acc[c] += ((p0[0] * bc[0] + p0[1] * bc[1]) + (p0[2] * bc[2] + p0[3] * bc[3])) + ((p1[0] * bc[4] + p1[1] * bc[5]) + (p1[2] * bc[6] + p1[3] * bc[7])); }
        }
        unsigned ov[16];
#pragma unroll
        for (int c = 0; c < 16; ++c) ov[c] = f2bf(acc[c]);
        bf16_t* dst = (bf16_t*)(ws + WS_WBB + l * SZ_WBB) + (size_t)n * 256 + g * 64 + 16 * cq;
        u32x4 w0, w1; w0.x = ov[0] | (ov[1] << 16); w0.y = ov[2] | (ov[3] << 16); w0.z = ov[4] | (ov[5] << 16); w0.w = ov[6] | (ov[7] << 16);
        w1.x = ov[8] | (ov[9] << 16); w1.y = ov[10] | (ov[11] << 16); w1.z = ov[12] | (ov[13] << 16); w1.w = ov[14] | (ov[15] << 16);
        *(u32x4*)dst = w0; *(u32x4*)(dst + 8) = w1;
    }
    __syncthreads();
    for (int row = gw; row < MA; row += NGW) {
        const float* src = row < MP ? p.in[I_XP] + (size_t)row * D : p.in[I_XS] + (size_t)(row - MP) * D;
        norm_row(src, (bf16_t*)(ws + WS_XB) + (size_t)row * D, (float*)(ws + WS_RN) + row, nullptr, nullptr, nullptr, lane);
    }
    for (int row = gw; row < NB * 256; row += NGW) {
        f32x4 v[4]; float ss = 0.f;
#pragma unroll
        for (int j = 0; j < 4; ++j) { v[j] = *(const f32x4*)(p.in[I_MEM] + (size_t)row * D + 4 * lane + 256 * j); ss += (v[j][0] * v[j][0] + v[j][1] * v[j][1]) + (v[j][2] * v[j][2] + v[j][3] * v[j][3]); }
        const float rs = rsqrtf(wave_sum(ss) * (1.f / D) + EPS);
        for (int l = 0; l < 4; ++l)
#pragma unroll
            for (int j = 0; j < 4; ++j) { const f32x4 g = *(const f32x4*)(p.in[I_MEMN] + l * D + 4 * lane + 256 * j); const f32x4 o = v[j] * rs * g; u32x2 w; w.x = pk2(o[0], o[1]); w.y = pk2(o[2], o[3]);
                *(u32x2*)((bf16_t*)(ws + WS_MN) + ((size_t)l * 2048 + row) * D + 4 * lane + 256 * j) = w; }
    }
}

#define MFMA32(a, b, c) __builtin_amdgcn_mfma_f32_32x32x16_bf16((a), (b), (c), 0, 0, 0)
#define MFMA16(a, b, c) __builtin_amdgcn_mfma_f32_16x16x32_bf16((a), (b), (c), 0, 0, 0)
template <bool MASKED> DI void sb_tile_weights(f32x16 (&z)[2], float& R, int jt, int tq, int hi) {
    f32x16 e[2]; float T[8];
    const int sbase = 64 * jt + 4 * hi;
#pragma unroll
    for (int kb = 0; kb < 2; ++kb)
#pragma unroll
        for (int g = 0; g < 4; ++g) {
            float fl[4];
#pragma unroll
            for (int j = 0; j < 4; ++j) {
                const int r = 4 * g + j; const bool valid = !MASKED || (sbase + 32 * kb + 8 * g + j) < tq;
                const float zz = fminf(fmaxf(z[kb][r], -240.f), 240.f);
                const float t = __builtin_amdgcn_exp2f(zz * (-0.125f * 1.4426950408889634f));
                const float be = __builtin_amdgcn_rcpf(1.f + t);
                fl[j] = valid ? t * be : 1.f; z[kb][r] = valid ? be : 0.f;
            }
            e[kb][4 * g + 3] = 1.f; e[kb][4 * g + 2] = fl[3]; e[kb][4 * g + 1] = fl[3] * fl[2]; e[kb][4 * g + 0] = e[kb][4 * g + 1] * fl[1];
            T[kb * 4 + g] = e[kb][4 * g + 0] * fl[0];
        }
    float Tp[8], X[8];
#pragma unroll
    for (int gi = 0; gi < 8; ++gi) Tp[gi] = __shfl_xor(T[gi], 32);
    X[7] = 1.f;
#pragma unroll
    for (int gi = 6; gi >= 0; --gi) X[gi] = X[gi + 1] * (T[gi + 1] * Tp[gi + 1]);
    const float total = X[0] * (T[0] * Tp[0]);
#pragma unroll
    for (int kb = 0; kb < 2; ++kb)
#pragma unroll
        for (int g = 0; g < 4; ++g) {
            const int gi = kb * 4 + g; const float off = R * X[gi] * (hi == 0 ? Tp[gi] : 1.f);
#pragma unroll
            for (int j = 0; j < 4; ++j) { const int r = 4 * g + j; z[kb][r] = z[kb][r] * (off * e[kb][r]); }
        }
    R *= total;
}

DI void sb_prompt_unit(const Ctx& p, int b, int h, int qb, LAS unsigned char* lds) {
    const bf16_t* proj = (const bf16_t*)(p.ws + WS_PROJ);
    LAS unsigned short* KS = (LAS unsigned short*)lds;
    LAS unsigned short* VT = KS + 64 * 72;
    const int tid = pg8::tid_(), lane = tid & 63, wv = tid >> 6, hi = lane >> 5, c = lane & 31;
    const int q0 = qb * 256 + wv * 32, tq = q0 + c;
    const size_t rowbase = (size_t)b * SEQ;
    bf16x8 qf[4];
    {
        const bf16_t* qp = proj + (rowbase + tq) * NINP + C_QA + h * 64 + 8 * hi;
#pragma unroll
        for (int kk = 0; kk < 4; ++kk) qf[kk] = *(const bf16x8*)(qp + 16 * kk);
    }
    f32x16 o0, o1;
#pragma unroll
    for (int i = 0; i < 16; ++i) { o0[i] = 0.f; o1[i] = 0.f; }
    float R = 1.f;
    const bf16_t* kbase = proj + rowbase * NINP + C_KA + h * 64 + 8 * wv;
    const bf16_t* vbase = proj + rowbase * NINP + C_VA + h * 64 + 8 * wv;
    int jt = 4 * qb + 3;
    u32x4 kr = *(const u32x4*)(kbase + (size_t)(64 * jt + lane) * NINP), vr = *(const u32x4*)(vbase + (size_t)(64 * jt + lane) * NINP);
    for (; jt >= 0; --jt) {
        __syncthreads();
        *(LAS u32x4*)(KS + lane * 72 + 8 * wv) = kr;
#pragma unroll
        for (int i = 0; i < 4; ++i) { const unsigned w = vr[i]; VT[(8 * wv + 2 * i) * 72 + lane] = (unsigned short)(w & 0xffffu); VT[(8 * wv + 2 * i + 1) * 72 + lane] = (unsigned short)(w >> 16); }
        __syncthreads();
        if (jt > 0) { kr = *(const u32x4*)(kbase + (size_t)(64 * (jt - 1) + lane) * NINP); vr = *(const u32x4*)(vbase + (size_t)(64 * (jt - 1) + lane) * NINP); }
        if (64 * jt < q0 + 31) {
            f32x16 z[2];
#pragma unroll
            for (int kb = 0; kb < 2; ++kb) {
                f32x16 acc;
#pragma unroll
                for (int i = 0; i < 16; ++i) acc[i] = 0.f;
#pragma unroll
                for (int kk = 0; kk < 4; ++kk) { const bf16x8 a = *(const LAS bf16x8*)(KS + (32 * kb + c) * 72 + 16 * kk + 8 * hi); acc = MFMA32(a, qf[kk], acc); }
                z[kb] = acc;
            }
            if (64 * jt + 63 < q0) sb_tile_weights<false>(z, R, jt, tq, hi); else sb_tile_weights<true>(z, R, jt, tq, hi);
#pragma unroll
            for (int kb = 0; kb < 2; ++kb)
#pragma unroll
                for (int s2 = 0; s2 < 2; ++s2) {
                    u32x4 pw; pw.x = pk2(z[kb][8 * s2 + 0], z[kb][8 * s2 + 1]); pw.y = pk2(z[kb][8 * s2 + 2], z[kb][8 * s2 + 3]); pw.z = pk2(z[kb][8 * s2 + 4], z[kb][8 * s2 + 5]); pw.w = pk2(z[kb][8 * s2 + 6], z[kb][8 * s2 + 7]);
                    const bf16x8 pb = __builtin_bit_cast(bf16x8, pw);
                    const int ko = 32 * kb + 16 * s2 + 4 * hi;
                    { const s16x4 lo = *(const LAS s16x4*)(VT + c * 72 + ko), hh = *(const LAS s16x4*)(VT + c * 72 + ko + 8);
                      const bf16x8 va = __builtin_shufflevector(lo, hh, 0, 1, 2, 3, 4, 5, 6, 7); o0 = MFMA32(va, pb, o0); }
                    { const s16x4 lo = *(const LAS s16x4*)(VT + (c + 32) * 72 + ko), hh = *(const LAS s16x4*)(VT + (c + 32) * 72 + ko + 8);
                      const bf16x8 va = __builtin_shufflevector(lo, hh, 0, 1, 2, 3, 4, 5, 6, 7); o1 = MFMA32(va, pb, o1); }
                }
        }
    }
    bf16_t* op = (bf16_t*)(p.ws + WS_OA) + (rowbase + tq) * 384 + h * 64 + 4 * hi;
#pragma unroll
    for (int g = 0; g < 4; ++g) {
        u32x2 w; w.x = pk2(o0[4 * g], o0[4 * g + 1]); w.y = pk2(o0[4 * g + 2], o0[4 * g + 3]); *(u32x2*)(op + 8 * g) = w;
        w.x = pk2(o1[4 * g], o1[4 * g + 1]); w.y = pk2(o1[4 * g + 2], o1[4 * g + 3]); *(u32x2*)(op + 32 + 8 * g) = w;
    }
}

DI void sb_sample_unit(const Ctx& p, int l, int b, int h, LAS unsigned char* lds) {
    const bf16_t* proj = (const bf16_t*)(p.ws + WS_PROJ);
    LAS float* qs = (LAS float*)lds;
    LAS float* Z = qs + 1024;
    LAS float* RED = Z + 16 * 1056;
    const int tid = pg8::tid_(), lane = tid & 63, wv = tid >> 6;
    const size_t srow = (size_t)MP + b * 16;
    for (int i = tid; i < 1024; i += NTHR) qs[i] = bf2f(proj[(srow + (i >> 6)) * NINP + C_QA + h * 64 + (i & 63)]) * 0.125f;
    __syncthreads();
    {
        float a0[16], a1[16];
#pragma unroll
        for (int i = 0; i < 16; ++i) { a0[i] = 0.f; a1[i] = 0.f; }
        const float* k0p = p.in[I_CSK] + ((((size_t)l * DB + b) * PAST + tid) * 6 + h) * 64; const float* k1p = k0p + (size_t)512 * 6 * 64;
#pragma unroll 8
        for (int d4 = 0; d4 < 16; ++d4) {
            const f32x4 ka = *(const f32x4*)(k0p + 4 * d4), kb = *(const f32x4*)(k1p + 4 * d4);
#pragma unroll
            for (int i = 0; i < 16; ++i) { const f32x4 q = *(const LAS f32x4*)(qs + i * 64 + 4 * d4);
                a0[i] += (q[0] * ka[0] + q[1] * ka[1]) + (q[2] * ka[2] + q[3] * ka[3]); a1[i] += (q[0] * kb[0] + q[1] * kb[1]) + (q[2] * kb[2] + q[3] * kb[3]); }
        }
#pragma unroll
        for (int i = 0; i < 16; ++i) { Z[i * 1056 + tid] = a0[i]; Z[i * 1056 + tid + 512] = a1[i]; }
        if (tid < 256) {
            const int i = tid >> 4, j = tid & 15; const bf16_t* kp = proj + (srow + j) * NINP + C_KA + h * 64; float s = 0.f;
            for (int d = 0; d < 64; ++d) s += qs[i * 64 + d] * bf2f(kp[d]);
            Z[i * 1056 + 1024 + j] = s;
        }
    }
    __syncthreads();
    for (int qq = 0; qq < 2; ++qq) {
        const int i = 2 * wv + qq, lim = PAST + i; LAS float* zr = Z + i * 1056;
        const int st = 17 * lane, en = (st + 17 < 1040) ? st + 17 : 1040;
        float tot = 0.f;
        for (int s = st; s < en; ++s) if (s < lim) tot -= softplusf_(zr[s]);
        float incl = tot;
#pragma unroll
        for (int o = 1; o < 64; o <<= 1) { const float t = __shfl_down(incl, o); if (lane + o < 64) incl += t; }
        float run = incl - tot;
        for (int s = en - 1; s >= st; --s) {
            const float zz = zr[s]; float w = 0.f;
            if (s < lim) { const float sp = softplusf_(zz); w = __expf(zz - sp + run); run -= sp; }
            zr[s] = w;
        }
    }
    __syncthreads();
    {
        const int d = tid & 63, g = tid >> 6;
        float o[16];
#pragma unroll
        for (int i = 0; i < 16; ++i) o[i] = 0.f;
        const float* vp = p.in[I_CSV] + (((size_t)l * DB + b) * PAST * 6 + h) * 64 + d;
        for (int s0 = 130 * g; s0 < 130 * g + 130; s0 += 26) {
            float v[26];
#pragma unroll
            for (int j = 0; j < 26; ++j) { const int s = s0 + j; v[j] = s < PAST ? vp[(size_t)s * 384] : bf2f(proj[(srow + (s - PAST)) * NINP + C_VA + h * 64 + d]); }
#pragma unroll
            for (int j = 0; j < 26; ++j)
#pragma unroll
                for (int i = 0; i < 16; ++i) o[i] += Z[i * 1056 + s0 + j] * v[j];
        }
#pragma unroll
        for (int i = 0; i < 16; ++i) RED[(g * 16 + i) * 64 + d] = o[i];
    }
    __syncthreads();
    for (int i = tid; i < 1024; i += NTHR) {
        const int qi = i >> 6, d = i & 63; float s = 0.f;
#pragma unroll
        for (int g = 0; g < 8; ++g) s += RED[(g * 16 + qi) * 64 + d];
        ((bf16_t*)(p.ws + WS_OA))[(srow + qi) * 384 + h * 64 + d] = f2bf(s);
    }
}

template <int W> DI void pool_rows(const float (&uu)[48], int t0, float* outp, bf16_t* pooled_col) {
    float s = 0.f;
#pragma unroll
    for (int i = 16 - W; i < 16; ++i) s += uu[i];
#pragma unroll
    for (int r = 0; r < 32; ++r) {
        s += uu[16 + r] - uu[16 + r - W];
        const int t = t0 + r; const float cnt = (float)((t + 1 < W) ? t + 1 : W);
        pooled_col[(size_t)r * 256] = f2bf(s / cnt - uu[16 + r]);
        if (t >= SEQ - 15) outp[(size_t)(t - (SEQ - 15)) * 256] = uu[16 + r];
    }
}
DI void pool_unit(const Ctx& p, int l, int unit) {
    const bf16_t* proj = (const bf16_t*)(p.ws + WS_PROJ); bf16_t* pooled = (bf16_t*)(p.ws + WS_POOLED);
    const int tid = pg8::tid_(), ch = tid & 255, w = 2 << (ch >> 6);
    if (unit < MP / 64) {
        const int r0 = unit * 64 + 32 * (tid >> 8), t0 = r0 & (SEQ - 1), b = r0 >> 11;
        float uu[48];
        const bf16_t* up = proj + (size_t)(r0 - 16) * NINP + C_U + ch;
#pragma unroll
        for (int i = 0; i < 48; ++i) uu[i] = (t0 - 16 + i >= 0) ? bf2f(up[(size_t)i * NINP]) : 0.f;
        float* outp = p.out + O_POOLP + ((size_t)(l * NB + b) * 15) * 256 + ch; bf16_t* pc = pooled + (size_t)r0 * 256 + ch;
        if (w == 2) pool_rows<2>(uu, t0, outp, pc); else if (w == 4) pool_rows<4>(uu, t0, outp, pc); else if (w == 8) pool_rows<8>(uu, t0, outp, pc); else pool_rows<16>(uu, t0, outp, pc);
        return;
    }
    for (int i = 0; i < 32; ++i) {
        const int row = unit * 64 + (tid >> 8) + 2 * i;
        const int rs = row - MP, b = rs >> 4, t = rs & 15; float s = 0.f;
        const bf16_t* up = proj + (size_t)row * NINP + C_U + ch; const float u0 = bf2f(up[0]);
        const float* hist = p.in[I_SPOOL] + ((size_t)(l * DB + b) * 15) * 256 + ch;
        for (int j = 0; j < w; ++j) { const int tt = t - j; s += tt >= 0 ? bf2f(*(up - (size_t)j * NINP)) : hist[(15 + tt) * 256]; }
        if (t >= 1) p.out[O_POOLS + ((size_t)(l * DB + b) * 15 + (t - 1)) * 256 + ch] = u0;
        pooled[(size_t)row * 256 + ch] = f2bf(s / (float)w - u0);
    }
}

DI void kvout_unit(const Ctx& p, int l, int unit) {
    const bf16_t* proj = (const bf16_t*)(p.ws + WS_PROJ);
#pragma unroll 4
    for (int i = pg8::tid_(); i < 64 * 96; i += NTHR) {
        const int r = i / 96, ch = i % 96, row = unit * 64 + r;
        const u32x4 w = *(const u32x4*)(proj + (size_t)row * NINP + C_KA + 8 * ch);
        const bool isv = ch >= 48; const int c = 8 * (isv ? ch - 48 : ch);
        float* dst = (row < MP) ? p.out + (isv ? O_VP : O_KP) + ((size_t)l * MP + row) * 384 + c : p.out + (isv ? O_VS : O_KS) + ((size_t)l * MS + (row - MP)) * 384 + c;
        *(f32x4*)dst = (f32x4){bflo(w.x), bfhi(w.x), bflo(w.y), bfhi(w.y)}; *(f32x4*)(dst + 4) = (f32x4){bflo(w.z), bfhi(w.z), bflo(w.w), bfhi(w.w)};
    }
}
DI void memout_unit(const Ctx& p, int unit) {
    const bf16_t* mkv = (const bf16_t*)(p.ws + WS_MKV);
    for (int i = pg8::tid_(); i < 16 * 256; i += NTHR) {
        const int r = i >> 8, ch = i & 255, row = unit * 16 + r, col = 8 * ch;
        const u32x4 w = *(const u32x4*)(mkv + (size_t)row * 2048 + col);
        float* dst = p.out + (col >= 1024 ? O_MVP : O_MKP) + (size_t)row * D + (col & 1023);
        *(f32x4*)dst = (f32x4){bflo(w.x), bfhi(w.x), bflo(w.y), bfhi(w.y)}; *(f32x4*)(dst + 4) = (f32x4){bflo(w.z), bfhi(w.z), bflo(w.w), bfhi(w.w)};
    }
}
DI void memvt_unit(const Ctx& p, int unit) {
    const int l = unit >> 7, nb = (unit >> 3) & 15, b = unit & 7, tid = pg8::tid_(), n = nb * 64 + (tid & 63), wv = tid >> 6;
    const bf16_t* src = (const bf16_t*)(p.ws + WS_MKV) + ((size_t)l * 2048 + b * 256) * 2048 + 1024 + n;
    bf16_t* dst = (bf16_t*)(p.ws + WS_MEMVT) + ((size_t)l * 1024 + n) * 2048 + b * 256;
    for (int c = wv; c < 32; c += 8) {
        unsigned v[8];
#pragma unroll
        for (int j = 0; j < 8; ++j) v[j] = src[(size_t)(8 * c + j) * 2048];
        u32x4 w; w.x = v[0] | (v[1] << 16); w.y = v[2] | (v[3] << 16); w.z = v[4] | (v[5] << 16); w.w = v[6] | (v[7] << 16);
        *(u32x4*)(dst + 8 * c) = w;
    }
}

DI void gla_decay(const Ctx& p, int l, int h, size_t row0, int ntok, LAS unsigned char* lds) {
    const bf16_t* proj = (const bf16_t*)(p.ws + WS_PROJ);
    LAS float* Bc = (LAS float*)lds; LAS float* LR = (LAS float*)(lds + 24576); LAS float* A2 = (LAS float*)(lds + 28672); LAS float* BIA = (LAS float*)(lds + 34816); LAS float* SEG = (LAS float*)(lds + 35200);
    const int tid = pg8::tid_();
    if (tid < 128) {
        const int t = tid >> 1, hf = tid & 1; u32x4 w = {0u, 0u, 0u, 0u};
        if (t < ntok) w = *(const u32x4*)(proj + (row0 + t) * NINP + C_LR + 8 * hf);
        LAS float* d = LR + t * 16 + 8 * hf;
        d[0] = bflo(w.x); d[1] = bfhi(w.x); d[2] = bflo(w.y); d[3] = bfhi(w.y); d[4] = bflo(w.z); d[5] = bfhi(w.z); d[6] = bflo(w.w); d[7] = bfhi(w.w);
    } else if (tid < 128 + 384) {
        const int i = tid - 128, r = i / 24, c4 = i % 24;
        *(LAS f32x4*)(A2 + r * 96 + 4 * c4) = *(const f32x4*)(p.in[I_WA2] + ((size_t)l * 16 + r) * 384 + h * 96 + 4 * c4);
    }
    if (tid < 96) BIA[tid] = p.in[I_BA][l * 384 + h * 96 + tid];
    __syncthreads();
    for (int i = tid; i < 64 * 96; i += NTHR) {
        const int t = i / 96, k = i % 96; float sacc = BIA[k];
#pragma unroll
        for (int r = 0; r < 16; ++r) sacc += LR[t * 16 + r] * A2[r * 96 + k];
        Bc[i] = t < ntok ? -softplusf_(-sacc) * (1.f / 16.f) : 0.f;
    }
    __syncthreads();
    const int k = tid % 96, seg = tid / 96;
    if (tid < 384) { float run = 0.f; for (int i = 0; i < 16; ++i) { const int idx = (16 * seg + i) * 96 + k; run += Bc[idx]; Bc[idx] = run; } SEG[seg * 96 + k] = run; }
    __syncthreads();
    if (tid < 384 && seg > 0) { float off = 0.f; for (int s2 = 0; s2 < seg; ++s2) off += SEG[s2 * 96 + k]; for (int i = 0; i < 16; ++i) Bc[(16 * seg + i) * 96 + k] += off; }
    __syncthreads();
}
DI void gla_unit_rows(int gu, size_t& row0, int& ntok, int& bh, int& h) {
    if (gu < NGU_P) { bh = gu >> 5; const int c = gu & 31, b = bh >> 2; h = bh & 3; row0 = (size_t)b * SEQ + c * 64; ntok = 64; }
    else { bh = gu - NGU_P; const int b = bh >> 2; h = bh & 3; row0 = (size_t)MP + b * 16; ntok = 16; }
}
DI void gla_stage1_unit(const Ctx& p, int l, int gu, LAS unsigned char* lds) {
    const bf16_t* proj = (const bf16_t*)(p.ws + WS_PROJ);
    size_t row0; int ntok, bh, h; gla_unit_rows(gu, row0, ntok, bh, h);
    gla_decay(p, l, h, row0, ntok, lds);
    LAS float* Bc = (LAS float*)lds;
    LAS unsigned short* KT = (LAS unsigned short*)(lds + 36864);
    LAS unsigned short* VT = KT + 96 * 72;
    const int tid = pg8::tid_(), lane = tid & 63, wv = tid >> 6, fr = lane & 15, fq = lane >> 4;
    {
        float* bb = (float*)(p.ws + WS_BB) + (size_t)gu * (64 * GK);
        for (int i = tid; i < 64 * GK / 4; i += NTHR) *(f32x4*)(bb + 4 * i) = *(const LAS f32x4*)(Bc + 4 * i);
    }
    for (int task = tid; task < 768; task += NTHR) {
        const int t = task & 63, ch = task >> 6; u32x4 kw = {0u, 0u, 0u, 0u}, vw = {0u, 0u, 0u, 0u};
        if (t < ntok) { const bf16_t* rp = proj + (row0 + t) * NINP + h * 96 + 8 * ch; kw = *(const u32x4*)(rp + C_KC); vw = *(const u32x4*)(rp + C_VC); }
        const unsigned kk[4] = {kw.x, kw.y, kw.z, kw.w}, vv[4] = {vw.x, vw.y, vw.z, vw.w};
#pragma unroll
        for (int j = 0; j < 4; ++j) {
            const int k0 = 8 * ch + 2 * j;
            const float e0 = __expf(Bc[(ntok - 1) * 96 + k0] - Bc[t * 96 + k0]), e1 = __expf(Bc[(ntok - 1) * 96 + k0 + 1] - Bc[t * 96 + k0 + 1]);
            KT[k0 * 72 + t] = f2bf(bflo(kk[j]) * e0); KT[(k0 + 1) * 72 + t] = f2bf(bfhi(kk[j]) * e1);
            VT[k0 * 72 + t] = (unsigned short)(vv[j] & 0xffffu); VT[(k0 + 1) * 72 + t] = (unsigned short)(vv[j] >> 16);
        }
    }
    if (tid < 96) ((float*)(p.ws + WS_GDEC))[(size_t)gu * 96 + tid] = __expf(Bc[(ntok - 1) * 96 + tid]);
    __syncthreads();
    float* KV = (float*)(p.ws + WS_GKV) + (size_t)gu * (GK * GK);
    for (int tile = wv; tile < 36; tile += 8) {
        const int ki = tile / 6, vi = tile % 6; f32x4 acc = {0.f, 0.f, 0.f, 0.f};
#pragma unroll
        for (int ks = 0; ks < 2; ++ks) { const bf16x8 a = *(const LAS bf16x8*)(KT + (16 * ki + fr) * 72 + 32 * ks + 8 * fq), bb = *(const LAS bf16x8*)(VT + (16 * vi + fr) * 72 + 32 * ks + 8 * fq); acc = MFMA16(a, bb, acc); }
#pragma unroll
        for (int j = 0; j < 4; ++j) KV[(16 * ki + 4 * fq + j) * 96 + 16 * vi + fr] = acc[j];
    }
}
DI void gla_scan(const Ctx& p, int l) {
    const int gt = blockIdx.x * NTHR + pg8::tid_(), NT = gridDim.x * NTHR;
    const float* KV = (const float*)(p.ws + WS_GKV); const float* DEC = (const float*)(p.ws + WS_GDEC); float* SP = (float*)(p.ws + WS_GSP);
    for (int e = gt; e < 32 * GK * GK; e += NT) {
        const int bh = e / (GK * GK), kv = e % (GK * GK), k = kv / GK; float S = 0.f;
        float kvv[32], dcv[32];
#pragma unroll
        for (int c = 0; c < 32; ++c) { const size_t gu = (size_t)bh * 32 + c; kvv[c] = KV[gu * (GK * GK) + kv]; dcv[c] = DEC[gu * 96 + k]; }
#pragma unroll
        for (int c = 0; c < 32; ++c) { const size_t gu = (size_t)bh * 32 + c; SP[gu * (GK * GK) + kv] = S; S = dcv[c] * S + kvv[c]; }
        p.out[O_GLAP + ((size_t)l * 32 + bh) * (GK * GK) + kv] = S;
    }
    for (int e = gt; e < 64 * GK * GK; e += NT) {
        const int bh = e / (GK * GK), kv = e % (GK * GK), k = kv / GK; const size_t gu = (size_t)NGU_P + bh;
        const float S0 = p.in[I_SGLA][((size_t)l * 64 + bh) * (GK * GK) + kv];
        p.out[O_GLAS + ((size_t)l * 64 + bh) * (GK * GK) + kv] = DEC[gu * 96 + k] * S0 + KV[gu * (GK * GK) + kv];
    }
}
DI void gla_stage3_unit(const Ctx& p, int l, int gu, LAS unsigned char* lds) {
    const bf16_t* proj = (const bf16_t*)(p.ws + WS_PROJ);
    size_t row0; int ntok, bh, h; gla_unit_rows(gu, row0, ntok, bh, h);
    LAS float* OT = (LAS float*)lds;
    LAS unsigned short* QP = (LAS unsigned short*)(lds + 36864);
    LAS unsigned short* KP = QP + 64 * 104;
    LAS unsigned short* VT = KP + 64 * 104;
    LAS unsigned short* ST = VT + 96 * 72;
    LAS unsigned short* ATT = ST + 96 * 104;
    const int tid = pg8::tid_(), lane = tid & 63, wv = tid >> 6, fr = lane & 15, fq = lane >> 4;
    const float* Sprev = gu < NGU_P ? (const float*)(p.ws + WS_GSP) + (size_t)gu * (GK * GK) : p.in[I_SGLA] + ((size_t)l * 64 + bh) * (GK * GK);
    const float* bb = (const float*)(p.ws + WS_BB) + (size_t)gu * (64 * GK);
    __syncthreads();
    for (int task = tid; task < 768; task += NTHR) {
        const int t = task & 63, ch = task >> 6; u32x4 qw = {0u, 0u, 0u, 0u}, kw = qw, vw = qw; f32x4 b0 = {0.f, 0.f, 0.f, 0.f}, b1 = b0;
        if (t < ntok) { const bf16_t* rp = proj + (row0 + t) * NINP + h * 96 + 8 * ch; qw = *(const u32x4*)(rp + C_QC); kw = *(const u32x4*)(rp + C_KC); vw = *(const u32x4*)(rp + C_VC);
            b0 = *(const f32x4*)(bb + t * 96 + 8 * ch); b1 = *(const f32x4*)(bb + t * 96 + 8 * ch + 4); }
        const unsigned qq[4] = {qw.x, qw.y, qw.z, qw.w}, kk[4] = {kw.x, kw.y, kw.z, kw.w}, vv[4] = {vw.x, vw.y, vw.z, vw.w};
        const float be[8] = {b0[0], b0[1], b0[2], b0[3], b1[0], b1[1], b1[2], b1[3]};
        u32x4 qo, ko; unsigned qa[4], ka[4];
#pragma unroll
        for (int j = 0; j < 4; ++j) {
            const float e0 = __expf(be[2 * j]), e1 = __expf(be[2 * j + 1]), r0 = __builtin_amdgcn_rcpf(e0), r1 = __builtin_amdgcn_rcpf(e1);
            const bool ok = t < ntok;
            qa[j] = ok ? pk2(bflo(qq[j]) * 0.10206207261596575f * e0, bfhi(qq[j]) * 0.10206207261596575f * e1) : 0u;
            ka[j] = ok ? pk2(bflo(kk[j]) * r0, bfhi(kk[j]) * r1) : 0u;
            VT[(8 * ch + 2 * j) * 72 + t] = (unsigned short)(vv[j] & 0xffffu); VT[(8 * ch + 2 * j + 1) * 72 + t] = (unsigned short)(vv[j] >> 16);
        }
        qo.x = qa[0]; qo.y = qa[1]; qo.z = qa[2]; qo.w = qa[3]; ko.x = ka[0]; ko.y = ka[1]; ko.z = ka[2]; ko.w = ka[3];
        *(LAS u32x4*)(QP + t * 104 + 8 * ch) = qo; *(LAS u32x4*)(KP + t * 104 + 8 * ch) = ko;
    }
    for (int task = tid; task < 2304; task += NTHR) {
        const int k = task % 96, vc = task / 96; const f32x4 sv = *(const f32x4*)(Sprev + k * 96 + 4 * vc);
#pragma unroll
        for (int j = 0; j < 4; ++j) ST[(4 * vc + j) * 104 + k] = f2bf(sv[j]);
    }
    __syncthreads();
    for (int tile = 2 * wv; tile < 2 * wv + 2; ++tile) {
        const int ti = tile >> 2, si = tile & 3; f32x4 acc = {0.f, 0.f, 0.f, 0.f};
        if (si <= ti) {
#pragma unroll
            for (int ks = 0; ks < 3; ++ks) { const bf16x8 a = *(const LAS bf16x8*)(QP + (16 * ti + fr) * 104 + 32 * ks + 8 * fq), b2 = *(const LAS bf16x8*)(KP + (16 * si + fr) * 104 + 32 * ks + 8 * fq); acc = MFMA16(a, b2, acc); }
        }
#pragma unroll
        for (int j = 0; j < 4; ++j) { const int t = 16 * ti + 4 * fq + j, s2 = 16 * si + fr; ATT[t * 72 + s2] = f2bf(s2 <= t ? acc[j] : 0.f); }
    }
    __syncthreads();
    for (int tile = wv; tile < 24; tile += 8) {
        const int ti = tile / 6, vi = tile % 6; f32x4 acc = {0.f, 0.f, 0.f, 0.f};
#pragma unroll
        for (int ks = 0; ks < 2; ++ks) { const bf16x8 a = *(const LAS bf16x8*)(ATT + (16 * ti + fr) * 72 + 32 * ks + 8 * fq), b2 = *(const LAS bf16x8*)(VT + (16 * vi + fr) * 72 + 32 * ks + 8 * fq); acc = MFMA16(a, b2, acc); }
#pragma unroll
        for (int ks = 0; ks < 3; ++ks) { const bf16x8 a = *(const LAS bf16x8*)(QP + (16 * ti + fr) * 104 + 32 * ks + 8 * fq), b2 = *(const LAS bf16x8*)(ST + (16 * vi + fr) * 104 + 32 * ks + 8 * fq); acc = MFMA16(a, b2, acc); }
#pragma unroll
        for (int j = 0; j < 4; ++j) OT[(16 * ti + 4 * fq + j) * 96 + 16 * vi + fr] = acc[j];
    }
    __syncthreads();
    bf16_t* oc = (bf16_t*)(p.ws + WS_OC);
    const float* gn = p.in[I_GLAN] + l * 384 + h * 96; const float gn0 = gn[lane], gn1 = lane < 32 ? gn[64 + lane] : 0.f;
    float g0[8], g1[8];
#pragma unroll
    for (int tt = 0; tt < 8; ++tt) { const int t = wv * 8 + tt; g0[tt] = 0.f; g1[tt] = 0.f;
        if (t < ntok) { const bf16_t* gp = proj + (row0 + t) * NINP + C_GC + h * 96; g0[tt] = bf2f(gp[lane]); if (lane < 32) g1[tt] = bf2f(gp[64 + lane]); } }
#pragma unroll
    for (int tt = 0; tt < 8; ++tt) {
        const int t = wv * 8 + tt;
        if (t < ntok) {
            const float a0 = OT[t * 96 + lane], a1 = lane < 32 ? OT[t * 96 + 64 + lane] : 0.f;
            const float rs = rsqrtf(wave_sum(a0 * a0 + a1 * a1) * (1.f / 96.f) + EPS);
            oc[(row0 + t) * 384 + h * 96 + lane] = f2bf(a0 * rs * gn0 * g0[tt] * sigmoidf_(g0[tt]));
            if (lane < 32) oc[(row0 + t) * 384 + h * 96 + 64 + lane] = f2bf(a1 * rs * gn1 * g1[tt] * sigmoidf_(g1[tt]));
        }
    }
}

DI void cross_sample_unit(const Ctx& p, int l, int b, int h, int qh, LAS unsigned char* lds) {
    LAS float* qs = (LAS float*)lds;
    LAS float* ST = qs + 8 * 256;
    LAS float* PART = ST + 256 * 8;
    const bf16_t* Q = (const bf16_t*)(p.ws + WS_Q);
    const int tid = pg8::tid_(), lane = tid & 63, wv = tid >> 6;
    const size_t srow = (size_t)MP + b * 16 + 8 * qh;
    for (int i = tid; i < 8 * 256; i += NTHR) qs[i] = bf2f(Q[(srow + (i >> 8)) * D + h * 256 + (i & 255)]) * 0.0625f;
    __syncthreads();
    const int m = tid & 255, half = tid >> 8;
    {
        float acc[8];
#pragma unroll
        for (int i = 0; i < 8; ++i) acc[i] = 0.f;
        const float* kp = p.in[I_CMK] + ((((size_t)l * DB + b) * 256 + m) * 4 + h) * 256 + 128 * half;
#pragma unroll 16
        for (int d4 = 0; d4 < 32; ++d4) {
            const f32x4 kv = *(const f32x4*)(kp + 4 * d4);
#pragma unroll
            for (int i = 0; i < 8; ++i) { const f32x4 q = *(const LAS f32x4*)(qs + i * 256 + 128 * half + 4 * d4); acc[i] += (q[0] * kv[0] + q[1] * kv[1]) + (q[2] * kv[2] + q[3] * kv[3]); }
        }
#pragma unroll
        for (int i = 0; i < 8; ++i) PART[(half * 8 + i) * 256 + m] = acc[i];
    }
    __syncthreads();
    {
        const int i = wv; float v[4], mx = -3.0e38f;
#pragma unroll
        for (int j = 0; j < 4; ++j) { v[j] = PART[i * 256 + lane + 64 * j] + PART[(8 + i) * 256 + lane + 64 * j]; mx = fmaxf(mx, v[j]); }
        mx = wave_max(mx); float sum = 0.f;
#pragma unroll
        for (int j = 0; j < 4; ++j) { v[j] = __expf(v[j] - mx); sum += v[j]; }
        sum = wave_sum(sum); const float inv = 1.f / sum;
#pragma unroll
        for (int j = 0; j < 4; ++j) ST[(lane + 64 * j) * 8 + i] = v[j] * inv;
    }
    __syncthreads();
    {
        float acc[8];
#pragma unroll
        for (int i = 0; i < 8; ++i) acc[i] = 0.f;
        const float* vp = p.in[I_CMV] + ((((size_t)l * DB + b) * 256 + 128 * half) * 4 + h) * 256 + m;
        for (int k0 = 0; k0 < 128; k0 += 32) {
            float v[32];
#pragma unroll
            for (int j = 0; j < 32; ++j) v[j] = vp[(size_t)(k0 + j) * 1024];
#pragma unroll
            for (int j = 0; j < 32; ++j) {
                const f32x4 s0 = *(const LAS f32x4*)(ST + (128 * half + k0 + j) * 8), s1 = *(const LAS f32x4*)(ST + (128 * half + k0 + j) * 8 + 4);
                acc[0] += s0[0] * v[j]; acc[1] += s0[1] * v[j]; acc[2] += s0[2] * v[j]; acc[3] += s0[3] * v[j];
                acc[4] += s1[0] * v[j]; acc[5] += s1[1] * v[j]; acc[6] += s1[2] * v[j]; acc[7] += s1[3] * v[j];
            }
        }
#pragma unroll
        for (int i = 0; i < 8; ++i) PART[(half * 8 + i) * 256 + m] = acc[i];
    }
    __syncthreads();
    bf16_t* O = (bf16_t*)(p.ws + WS_O);
    for (int i = tid; i < 8 * 256; i += NTHR) { const int qi = i >> 8, d = i & 255; O[(srow + qi) * D + h * 256 + d] = f2bf(PART[qi * 256 + d] + PART[(8 + qi) * 256 + d]); }
}

struct SkBf16 { bf16_t* O; int ldc; DI void operator()(int row, int col, f32x4 v) const { u32x2 w; w.x = pk2(v[0], v[1]); w.y = pk2(v[2], v[3]); *(u32x2*)(O + (size_t)(MP + row) * ldc + col) = w; } };
struct SkGate { bf16_t* merged; const bf16_t* proj; int goff; int accum;
    DI void operator()(int row, int col, f32x4 v) const {
        const u32x2 g = *(const u32x2*)(proj + (size_t)(MP + row) * NINP + goff + col); bf16_t* mp = merged + (size_t)(MP + row) * D + col;
        u32x2 pm2 = {0u, 0u}; if (accum) pm2 = *(const u32x2*)mp;
        u32x2 w; w.x = pk2(sigmoidf_(bflo(g.x)) * v[0] + bflo(pm2.x), sigmoidf_(bfhi(g.x)) * v[1] + bfhi(pm2.x)); w.y = pk2(sigmoidf_(bflo(g.y)) * v[2] + bflo(pm2.y), sigmoidf_(bfhi(g.y)) * v[3] + bfhi(pm2.y));
        *(u32x2*)mp = w; } };
template <class EF> DI void skinny_gemm(const bf16_t* A, int lda, const bf16_t* Bt, int ldb, int K, int N, int G, int bx, LAS unsigned char* lds, const EF& ef) {
    const int tid = pg8::tid_(), lane = tid & 63, wv = tid >> 6, fr = lane & 15, fq = lane >> 4, nks = K >> 5, nunits = 4 * (N >> 4);
    LAS f32x4* red = (LAS f32x4*)lds;
    for (int u = bx; u < nunits; u += G) {
        const int rb = u & 3, cb = u >> 2;
        f32x4 acc[4];
#pragma unroll
        for (int i = 0; i < 4; ++i) acc[i] = (f32x4){0.f, 0.f, 0.f, 0.f};
        const bf16_t* bp = Bt + (size_t)(16 * cb + fr) * ldb + 8 * fq; const bf16_t* ap = A + (size_t)(64 * rb + fr) * lda + 8 * fq;
        for (int ks = wv; ks < nks; ks += 8) {
            const bf16x8 bb = *(const bf16x8*)(bp + 32 * ks);
            bf16x8 aa[4];
#pragma unroll
            for (int i = 0; i < 4; ++i) aa[i] = *(const bf16x8*)(ap + (size_t)(16 * i) * lda + 32 * ks);
#pragma unroll
            for (int i = 0; i < 4; ++i) acc[i] = MFMA16(bb, aa[i], acc[i]);
        }
#pragma unroll
        for (int i = 0; i < 4; ++i) red[(wv * 4 + i) * 64 + lane] = acc[i];
        __syncthreads();
        if (tid < 256) {
            const int i = tid >> 6; f32x4 s = red[i * 64 + lane];
#pragma unroll
            for (int w = 1; w < 8; ++w) s = s + red[(w * 4 + i) * 64 + lane];
            ef(64 * rb + 16 * i + fr, 16 * cb + 4 * fq, s);
        }
        __syncthreads();
    }
}

constexpr int PH_PER_LAYER = 15, N_PHASES = 1 + DEPTH * PH_PER_LAYER;
#define RUN_GEMM(EpiT, E, Aptr, lda_, Bptr, ldb_, K_, pm0_, nM_, nN_) do { const pg8::Gemm g_{(K_), (lda_), (ldb_)}; pg8::TileOrder S_; S_.init((Aptr), (lda_), (Bptr), (ldb_), (pm0_), (nM_), (nN_), G, bx); \
        pg8::gemm_phase<EpiT, pg8::TileOrder, true, true>(lds, g_, S_, (E)); } while (0)

__global__ void __launch_bounds__(NTHR, 2) fwd_kernel(Params p) {
    extern __shared__ __attribute__((aligned(16))) unsigned char lds_raw[];
#define PROJ ((bf16_t*)(ws + WS_PROJ))
#define H ((bf16_t*)(ws + WS_XB))
#define MERGED ((bf16_t*)(ws + WS_MERGED))
#define Y ((bf16_t*)(ws + WS_Y))
#define QB ((bf16_t*)(ws + WS_Q))
#define PB ((bf16_t*)(ws + WS_P))
#define OB ((bf16_t*)(ws + WS_O))
#define ACT ((bf16_t*)(ws + WS_ACT))

    {
        volatile LAS unsigned* st0 = (volatile LAS unsigned*)((LAS unsigned char*)lds_raw + LDS_MISC + 32);
        if (pg8::tid_() == 0) { st0[0] = 0u; st0[1] = 0u; st0[8] = 0u; st0[9] = 0u; }
        __syncthreads();
    }
    XcdBarrier xbar = xcd_barrier_post((unsigned*)(p.ws + WS_CTL) + CW_BAR, (volatile LAS unsigned*)((LAS unsigned char*)lds_raw + LDS_MISC + 32));
    if (p.ph_lo == 0) {
        prologue(p, (LAS unsigned char*)lds_raw);
        if (blockIdx.x == 0 && pg8::tid_() == 0) {
            const float** tab = (const float**)(p.ws + WS_TAB);
#pragma unroll
            for (int i = 0; i < N_IN; ++i) tab[i] = p.in[i];
        }
        if (p.ph_hi > 1) xcd_barrier(xbar);
        if (p.ph_hi < 0) cg::this_grid().sync();
    }
    for (int ph = p.ph_lo > 1 ? p.ph_lo : 1; ph < p.ph_hi; ++ph) {
        unsigned ldsb = (unsigned)(size_t)(LAS unsigned char*)lds_raw; asm volatile("" : "+s"(ldsb));
        LAS unsigned char* lds = (LAS unsigned char*)(size_t)ldsb;
        volatile LAS int* slot = (volatile LAS int*)(lds + LDS_MISC);
        unsigned char* ws = p.ws; asm volatile("" : "+s"(ws));
        Ctx c; c.ws = ws; c.in.t = (const float* const*)(ws + WS_TAB); c.out = p.out;
        unsigned* ctl = (unsigned*)(ws + WS_CTL);
        int G = gridDim.x, bx = blockIdx.x; asm volatile("" : "+s"(G), "+s"(bx));
        {
            const int l = (ph - 1) / PH_PER_LAYER, st = (ph - 1) % PH_PER_LAYER;
#ifdef PROBE_SEL
            if (bx == 0) { volatile LAS unsigned long long* a_ = (volatile LAS unsigned long long*)(lds + LDS_MISC + 64); a_[1] = __builtin_amdgcn_s_memrealtime(); }
#endif
            switch (st) {
            case 0: {
                EpiBf16 E{PROJ, NINP, 0xffff};
                RUN_GEMM(EpiBf16, E, H, D, ws + WS_WIN + l * SZ_WIN, D, D, 0, MA / 256, NINP / 256);
                if (l == 0) {
                    const pg8::Gemm g{D, D, D}; MemKvOrder S{G, bx, (const char*)(ws + WS_MN), (const char*)(ws + WS_WKV)};
                    EpiBf16 E2{(bf16_t*)(ws + WS_MKV), 2048, 7};
                    pg8::gemm_phase<EpiBf16, MemKvOrder, true, true>(lds, g, S, E2);
                }
            } break;
            case 1: {
                unsigned* ctr = ctl + 64 * ph;
                constexpr int U_SBP = 384, U_SBS = U_SBP + DB * 6, U_GLA = U_SBS + NGU, U_POOL = U_GLA + MA / 64, U_KV = U_POOL + MA / 64, U_MO = U_KV + 512, U_VT = U_MO + 512;
                const int U_ALL = l == 0 ? U_VT : U_KV;
                for (;;) {
                    const int q = next_work(ctr, slot); if (q >= U_ALL) break;
                    int u = q;
                    if (q >= DB * 6) { const int r = q - DB * 6, nbw = U_ALL - U_GLA;
                        if (l == 0) u = r < nbw ? U_GLA + r : DB * 6 + (r - nbw);
                        else u = r < 2 * nbw ? ((r & 1) ? DB * 6 + (r >> 1) : U_GLA + (r >> 1)) : DB * 6 + (r - nbw); }
#ifdef PROBE_SEL
                    const int ut_ = u < DB * 6 ? 10 : (u < U_SBS ? 11 : (u < U_GLA ? 12 : 13));
                    if (bx == 0 && ut_ == PROBE_SEL) { volatile LAS unsigned long long* a_ = (volatile LAS unsigned long long*)(lds + LDS_MISC + 64); a_[3] = __builtin_amdgcn_s_memrealtime(); }
#endif
                    if (u < DB * 6) sb_sample_unit(c, l, u / 6, u % 6, lds);
                    else if (u < U_SBS) { const int v = u - DB * 6, qb = 7 - v / 48, bh = v % 48; sb_prompt_unit(c, bh / 6, bh % 6, qb, lds); }
                    else if (u < U_GLA) gla_stage1_unit(c, l, u - U_SBS, lds);
                    else if (u < U_POOL) pool_unit(c, l, u - U_GLA);
                    else if (u < U_KV) kvout_unit(c, l, u - U_POOL);
                    else if (u < U_MO) memout_unit(c, u - U_KV);
                    else memvt_unit(c, u - U_MO);
#ifdef PROBE_SEL
                    if (bx == 0 && ut_ == PROBE_SEL) { volatile LAS unsigned long long* a_ = (volatile LAS unsigned long long*)(lds + LDS_MISC + 64); __hip_atomic_fetch_add((LAS unsigned long long*)a_, __builtin_amdgcn_s_memrealtime() - a_[3], __ATOMIC_RELAXED, __HIP_MEMORY_SCOPE_WORKGROUP); }
#endif
                }
            } break;
            case 2: gla_scan(c, l); break;
            case 3: {
                unsigned* ctr = ctl + 64 * ph;
                for (;;) { const int u = next_work(ctr, slot); if (u >= NGU) break; gla_stage3_unit(c, l, u, lds); }
            } break;
            case 4: {
                EpiGate E1{MERGED, PROJ, C_GA, 0}, E2{MERGED, PROJ, C_GB, 1}, E3{MERGED, PROJ, C_GCG, 1};
                RUN_GEMM(EpiGate, E1, ws + WS_OA, 384, ws + WS_WBA + l * SZ_WBA, 384, 384, 0, MP / 256, 4);
                RUN_GEMM(EpiGate, E2, ws + WS_POOLED, 256, ws + WS_WBB + l * SZ_WBB, 256, 256, 0, MP / 256, 4);
                RUN_GEMM(EpiGate, E3, ws + WS_OC, 384, ws + WS_WBC + l * SZ_WBA, 384, 384, 0, MP / 256, 4);
                { SkGate F1{MERGED, PROJ, C_GA, 0}, F2{MERGED, PROJ, C_GB, 1}, F3{MERGED, PROJ, C_GCG, 1};
                  skinny_gemm((const bf16_t*)(ws + WS_OA) + (size_t)MP * 384, 384, (const bf16_t*)(ws + WS_WBA + l * SZ_WBA), 384, 384, D, G, bx, lds, F1);
                  skinny_gemm((const bf16_t*)(ws + WS_POOLED) + (size_t)MP * 256, 256, (const bf16_t*)(ws + WS_WBB + l * SZ_WBB), 256, 256, D, G, bx, lds, F2);
                  skinny_gemm((const bf16_t*)(ws + WS_OC) + (size_t)MP * 384, 384, (const bf16_t*)(ws + WS_WBC + l * SZ_WBA), 384, 384, D, G, bx, lds, F3); }
            } break;
            case 5: { EpiBf16 E{Y, D, 0xffff}; RUN_GEMM(EpiBf16, E, MERGED, D, ws + WS_WMIX + l * SZ_WSQ, D, D, 0, MP / 256, 4);
                SkBf16 F{Y, D}; skinny_gemm((const bf16_t*)MERGED + (size_t)MP * D, D, (const bf16_t*)(ws + WS_WMIX + l * SZ_WSQ), D, D, D, G, bx, lds, F); } break;
            case 6: norm_phase(c, c.in[I_NMIXPOST] + l * D, false, G, bx); break;
            case 7: { EpiBf16 E{QB, D, 0xffff}; RUN_GEMM(EpiBf16, E, H, D, ws + WS_WXQ + l * SZ_WSQ, D, D, 0, MP / 256, 4);
                SkBf16 F{QB, D}; skinny_gemm((const bf16_t*)H + (size_t)MP * D, D, (const bf16_t*)(ws + WS_WXQ + l * SZ_WSQ), D, D, D, G, bx, lds, F); } break;
            case 8: {
                const pg8::Gemm g{256, D, 2048}; CrossOrder S{G, bx, (const char*)QB, (const char*)(ws + WS_MKV + (size_t)l * 2 * SZ_WKV), 0};
                EpiSoftmax E{PB, (LAS float*)(lds + LDS_X)};
                pg8::gemm_phase<EpiSoftmax, CrossOrder, true, true>(lds, g, S, E);
            } break;
            case 9: {
                const pg8::Gemm g{256, D, 2048}; CrossOrder S{G, bx, (const char*)PB, (const char*)(ws + WS_MEMVT + (size_t)l * SZ_WKV), 1};
                EpiBf16 E{OB, D, 0xffff};
                pg8::gemm_phase<EpiBf16, CrossOrder, true, true>(lds, g, S, E);
                for (int u = bx; u < DB * 4 * 2; u += G) { __syncthreads(); cross_sample_unit(c, l, u >> 3, (u >> 1) & 3, u & 1, lds); }
            } break;
            case 10: { EpiBf16 E{Y, D, 0xffff}; RUN_GEMM(EpiBf16, E, OB, D, ws + WS_WXO + l * SZ_WSQ, D, D, 0, MP / 256, 4);
                SkBf16 F{Y, D}; skinny_gemm((const bf16_t*)OB + (size_t)MP * D, D, (const bf16_t*)(ws + WS_WXO + l * SZ_WSQ), D, D, D, G, bx, lds, F); } break;
            case 11: norm_phase(c, c.in[I_NXPOST] + l * D, false, G, bx); break;
            case 12: { EpiSwiglu E{ACT}; RUN_GEMM(EpiSwiglu, E, H, D, ws + WS_WF1 + l * SZ_WF1, D, D, 0, MA / 256, FF2 / 256); } break;
            case 13: { EpiBf16 E{Y, D, 0xffff}; RUN_GEMM(EpiBf16, E, ACT, FF, ws + WS_WF2 + l * SZ_WF2, FF, FF, 0, MP / 256, 4);
                SkBf16 F{Y, D}; skinny_gemm((const bf16_t*)ACT + (size_t)MP * FF, FF, (const bf16_t*)(ws + WS_WF2 + l * SZ_WF2), FF, FF, D, G, bx, lds, F); } break;
            default: norm_phase(c, c.in[I_NFPOST] + l * D, l == DEPTH - 1, G, bx); break;
            }
#ifdef PROBE_SEL
            {
                const int sel = PROBE_SEL; bool hit = false;
                if (sel == 2) hit = (st == 0 || st == 4 || st == 5 || st == 7 || st == 10 || st == 12 || st == 13);
                if (sel == 3) hit = (st == 2 || st == 3);
                if (sel == 4) hit = (st == 8 || st == 9);
                if (sel == 5) hit = (st == 6 || st == 11 || st == 14);
                if (sel == 6) hit = (st == 1);
                if (sel == 7) hit = (st == 0);
                if (sel == 8) hit = (st == 12);
                if (sel == 9) hit = (st == 13);
                if (bx == 0 && hit) { volatile LAS unsigned long long* a_ = (volatile LAS unsigned long long*)(lds + LDS_MISC + 64); __hip_atomic_fetch_add((LAS unsigned long long*)a_, __builtin_amdgcn_s_memrealtime() - a_[1], __ATOMIC_RELAXED, __HIP_MEMORY_SCOPE_WORKGROUP); }
            }
#endif
        }
#ifdef PROBE_SEL
        if (bx == 0) { volatile LAS unsigned long long* a_ = (volatile LAS unsigned long long*)(lds + LDS_MISC + 64); a_[2] = __builtin_amdgcn_s_memrealtime(); }
#endif
        if (ph + 1 < p.ph_hi) { if ((ph - 1) % PH_PER_LAYER == 8) { asm volatile("s_waitcnt vmcnt(0)" ::: "memory"); __syncthreads(); __builtin_amdgcn_fence(__ATOMIC_ACQUIRE, "agent"); }   else xcd_barrier(xbar); }
#ifdef PROBE_SEL
        if (PROBE_SEL == 1 && bx == 0) { volatile LAS unsigned long long* a_ = (volatile LAS unsigned long long*)(lds + LDS_MISC + 64); __hip_atomic_fetch_add((LAS unsigned long long*)a_, __builtin_amdgcn_s_memrealtime() - a_[2], __ATOMIC_RELAXED, __HIP_MEMORY_SCOPE_WORKGROUP); }
#endif
    }
#ifdef PROBE_SEL
    __syncthreads();
    if (blockIdx.x == 0) {
        volatile LAS unsigned long long* a_ = (volatile LAS unsigned long long*)((LAS unsigned char*)lds_raw + LDS_MISC + 64);
        const unsigned long long d_ = a_[0] >> 9, s_ = __builtin_amdgcn_s_memrealtime();
        while (__builtin_amdgcn_s_memrealtime() - s_ < d_) __builtin_amdgcn_s_sleep(8);
    }
#endif
}

extern "C" void kernel_launch(void* const* d_in, const int* in_sizes, int n_in, void* d_out, int out_size, void* d_ws, size_t ws_size, hipStream_t stream) {
    static int grid = 0;
    if (grid == 0) {
        if (n_in != N_IN || (size_t)out_size != O_END || ws_size < WS_END) { fprintf(stderr, "kernel_launch: unexpected shapes: n_in %d out %d ws %zu (need %zu)\n", n_in, out_size, ws_size, (size_t)WS_END); grid = -1; return; }
        int dev = 0, cus = 0, per_cu = 0;
        (void)hipGetDevice(&dev); (void)hipDeviceGetAttribute(&cus, hipDeviceAttributeMultiprocessorCount, dev);
        (void)hipFuncSetAttribute((const void*)fwd_kernel, hipFuncAttributeMaxDynamicSharedMemorySize, LDS_BYTES);
        if (hipOccupancyMaxActiveBlocksPerMultiprocessor(&per_cu, (const void*)fwd_kernel, NTHR, LDS_BYTES) != hipSuccess || per_cu < 1) { fprintf(stderr, "kernel_launch: occupancy query gave %d\n", per_cu); per_cu = 1; }
        (void)hipGetLastError();
        grid = cus * per_cu;
    }
    if (grid < 0) return;
    (void)hipMemsetAsync((char*)d_ws + WS_CTL, 0, CTL_BYTES, stream);
    Params p{};
    for (int i = 0; i < N_IN; ++i) p.in[i] = (const float*)d_in[i];
    p.out = (float*)d_out; p.ws = (unsigned char*)d_ws;
#ifdef MULTI_LAUNCH
    for (int ph = 0; ph < N_PHASES; ++ph) { p.ph_lo = ph; p.ph_hi = ph + 1; hipLaunchKernelGGL(fwd_kernel, dim3(grid), dim3(NTHR), LDS_BYTES, stream, p); }
#else
    p.ph_lo = 0; p.ph_hi = N_PHASES;
    void* args[] = {&p};
    const hipError_t e = hipLaunchCooperativeKernel((const void*)fwd_kernel, dim3(grid), dim3(NTHR), args, LDS_BYTES, stream);
    if (e != hipSuccess) fprintf(stderr, "kernel_launch: cooperative launch failed: %s (grid %d)\n", hipGetErrorString(e), grid);
#endif
}
```

```cpp
#include <hip/hip_runtime.h>
#include <hip/hip_cooperative_groups.h>
#include <cstdio>
#include <cstdint>
namespace cg = cooperative_groups;

namespace pg8 {
#define PG8_LAS __attribute__((address_space(3)))
typedef unsigned short bf16_t;
typedef short bf16x8 __attribute__((ext_vector_type(8)));
typedef float f32x4 __attribute__((ext_vector_type(4)));
typedef unsigned u32x4 __attribute__((ext_vector_type(4)));
typedef unsigned u32x2 __attribute__((ext_vector_type(2)));
constexpr int BM = 256, BK = 64, HALF = 128, HTB = HALF * BK * 2  , STAGE_BYTES = 8 * HTB, NXCD = 8, WGM = 4;

__host__ __device__ __forceinline__ int lds_byte(int r, int c) { const int st = (r >> 4) * 2 + (c >> 5), rr = r & 15, cc = c & 31, ob = rr * 64 + cc * 2; return st * 1024 + (ob ^ (((ob >> 9) & 1) << 5)); }
__host__ __device__ __forceinline__ void stage_rc(int b, int& R, int& C) { const int st = b / 1024, sb = b % 1024, swz = sb ^ (((sb >> 9) & 1) << 5); R = (st >> 1) * 16 + swz / 64; C = (st & 1) * 32 + (swz % 64) / 2; }
__host__ __device__ __forceinline__ int perm32(int rho) { const int n = rho >> 4, i = rho & 15; return 8 * (i >> 2) + 4 * n + (i & 3); }

struct Unit { int pm, pn; const char* a; const char* b; };
struct Gemm { int K, lda, ldb; };

struct TileOrder {
    int nM, nN, G, c, lda, ldb; const char* A; const char* B;
    __device__ void init(const void* A_, int lda_, const void* B_, int ldb_, int, int nM_, int nN_, int G_, int c_) {
        A = (const char*)A_; B = (const char*)B_; lda = lda_; ldb = ldb_; nM = nM_; nN = nN_; G = G_; c = c_; }
    __device__ bool next(int i, Unit& u) const {
        const int nwg = nM * nN; const long L = (long)i * G + c; if (L >= nwg) return false;
        int wgid = (int)L; { const int q = nwg / NXCD, r = nwg % NXCD, xcd = wgid % NXCD, off = wgid / NXCD; wgid = (xcd < r ? xcd * (q + 1) : r * (q + 1) + (xcd - r) * q) + off; }
        const int nig = WGM * nN, gid = wgid / nig, fm = gid * WGM, gsz = (nM - fm) < WGM ? (nM - fm) : WGM;
        u.pm = fm + ((wgid % nig) % gsz); u.pn = (wgid % nig) / gsz; u.a = A + (size_t)u.pm * ((size_t)BM * 2 * lda); u.b = B + (size_t)u.pn * ((size_t)BM * 2 * ldb); return true;
    }
    __device__ __forceinline__ void a_ready(const Unit&) const {}
    __device__ __forceinline__ void done(const Unit&) const {}
};

__device__ __forceinline__ int tid_() { int t = threadIdx.x; asm volatile("" : "+v"(t)); return t; }
__device__ __forceinline__ unsigned cvt_pk_bf16(float lo, float hi) { unsigned r; asm volatile("v_cvt_pk_bf16_f32 %0, %1, %2" : "=v"(r) : "v"(lo), "v"(hi)); return r; }

template <class Epi, class Sched, bool ALIGN_EPI = false, bool SP2 = false>
__device__ __forceinline__ void gemm_phase(PG8_LAS unsigned char* lds, const Gemm g, const Sched& S, const Epi& E) {
    const int tid = pg8::tid_(), wid = __builtin_amdgcn_readfirstlane(tid >> 6), lane = tid & 63, wr = wid >> 2, wc = wid & 3, fr = lane & 15, fq = lane >> 4;
    const int K = g.K, nt = K / BK;
    unsigned voffA, voffB;
    { int R, C; stage_rc(tid * 16, R, C); const int Rb = Epi::PERM ? ((R & ~31) + perm32(R & 31)) : R;
        voffA = (unsigned)(R * g.lda + C) * 2u; voffB = (unsigned)(Rb * g.ldb + C) * 2u; }
    const size_t qstepA = (size_t)64 * g.lda * 2, qstepB = (size_t)64 * g.ldb * 2;
    const size_t kstep = (size_t)(BK * 2);
    const size_t hstepA = (size_t)HALF * g.lda * 2, hstepB = (size_t)HALF * g.ldb * 2;
    const unsigned ldsw = (unsigned)wid * 1024u;
    const int aoff = lds_byte(wr * 64 + fr, fq * 8), boff = lds_byte(wc * 32 + fr, fq * 8);
#define PG8_SA(b, h) (((b) * 2 + (h)) * HTB)
#define PG8_SB(b, h) ((4 + (b) * 2 + (h)) * HTB)
#define PG8_STAGE(bufoff, gbase, voff) do { _Pragma("unroll") for (int _i = 0; _i < 2; ++_i) { const char* sb_ = (const char*)(gbase) + (size_t)_i * q##voff; asm volatile("" : "+s"(sb_));   \
        __builtin_amdgcn_global_load_lds((const unsigned*)(sb_ + (voff)), (PG8_LAS unsigned*)(lds + (bufoff) + ldsw + _i * 8192), 16, 0, 0); } } while (0)
#define qvoffA qstepA
#define qvoffB qstepB
#define PG8_LDA(dst, b, h) do { _Pragma("unroll") for (int m = 0; m < 4; ++m) _Pragma("unroll") for (int k = 0; k < 2; ++k) dst[m][k] = *(const PG8_LAS bf16x8*)(lds + PG8_SA(b, h) + aoff + m * 2048 + k * 1024); } while (0)
#define PG8_LDB(dst, b, h) do { _Pragma("unroll") for (int n = 0; n < 2; ++n) _Pragma("unroll") for (int k = 0; k < 2; ++k) dst[n][k] = *(const PG8_LAS bf16x8*)(lds + PG8_SB(b, h) + boff + n * 2048 + k * 1024); } while (0)
#define PG8_MMA(ai, bj, At, Bt) do { __builtin_amdgcn_s_setprio(1); _Pragma("unroll") for (int m = 0; m < 4; ++m) _Pragma("unroll") for (int n = 0; n < 2; ++n) _Pragma("unroll") for (int k = 0; k < 2; ++k) \
        acc[ai][bj][m][n] = __builtin_amdgcn_mfma_f32_16x16x32_bf16(Bt[n][k], At[m][k], acc[ai][bj][m][n], 0, 0, 0); __builtin_amdgcn_s_setprio(0); } while (0)
#define PG8_WAIT_V(n) asm volatile("s_waitcnt vmcnt(" #n ")" ::: "memory")
#define PG8_WAIT_L(n) asm volatile("s_waitcnt lgkmcnt(" #n ")" ::: "memory")
#define PG8_BAR __builtin_amdgcn_s_barrier()
#define PG8_SCHED __builtin_amdgcn_sched_barrier(0)
    Unit cur, nxt; int ui = 0;
    if (!S.next(0, cur)) return;
    f32x4 acc[2][2][4][2];
#pragma unroll
    for (int a = 0; a < 2; ++a)
#pragma unroll
        for (int b = 0; b < 2; ++b)
#pragma unroll
            for (int m = 0; m < 4; ++m)
#pragma unroll
                for (int n = 0; n < 2; ++n) acc[a][b][m][n] = (f32x4){0.f, 0.f, 0.f, 0.f};
    bf16x8 At[4][2], B0[2][2], B1[2][2];
    const char* cA = cur.a; const char* cB = cur.b;
    S.a_ready(cur);
    if constexpr (SP2) {
        PG8_STAGE(PG8_SB(0, 0), cB, voffB); PG8_STAGE(PG8_SB(0, 1), cB + hstepB, voffB); PG8_STAGE(PG8_SA(0, 0), cA, voffA); PG8_STAGE(PG8_SA(0, 1), cA + hstepA, voffA);
        if (wr == 1) PG8_BAR;
        PG8_WAIT_V(2); PG8_BAR;
        PG8_STAGE(PG8_SB(1, 0), cB + kstep, voffB); PG8_STAGE(PG8_SA(1, 0), cA + kstep, voffA); PG8_STAGE(PG8_SB(1, 1), cB + hstepB + kstep, voffB);
        PG8_WAIT_V(6); PG8_BAR;
    } else {
        PG8_STAGE(PG8_SB(0, 0), cB, voffB); PG8_STAGE(PG8_SA(0, 0), cA, voffA); PG8_STAGE(PG8_SB(0, 1), cB + hstepB, voffB); PG8_STAGE(PG8_SA(0, 1), cA + hstepA, voffA);
        if (wr == 1) PG8_BAR;
        PG8_WAIT_V(4); PG8_BAR;
        PG8_STAGE(PG8_SB(1, 0), cB + kstep, voffB); PG8_STAGE(PG8_SA(1, 0), cA + kstep, voffA); PG8_STAGE(PG8_SB(1, 1), cB + hstepB + kstep, voffB);
        PG8_WAIT_V(6); PG8_BAR;
    }
    for (;;) {
        const bool has_next = S.next(ui + 1, nxt);
        const char* nA = has_next ? nxt.a : cA; const char* nB = has_next ? nxt.b : cB;
        for (int t = 0; t < nt; t += 2) {
            const bool last = (t == nt - 2);
            const char* a1 = cA + (size_t)(t + 1) * kstep;
            const char* a2 = last ? nA : cA + (size_t)(t + 2) * kstep; const char* b2 = last ? nB : cB + (size_t)(t + 2) * kstep;
            const char* a3 = a2 + kstep; const char* b3 = b2 + kstep;
            if (last && has_next) S.a_ready(nxt);
            if constexpr (SP2) {
            PG8_LDB(B0, 0, 0); PG8_LDB(B1, 0, 1); PG8_SCHED; PG8_LDA(At, 0, 0); PG8_STAGE(PG8_SA(1, 1), a1 + hstepA, voffA);
            PG8_WAIT_V(8); PG8_WAIT_L(0); PG8_BAR; PG8_MMA(0, 0, At, B0); PG8_MMA(0, 1, At, B1); PG8_BAR; PG8_SCHED;
            PG8_LDA(At, 0, 1); PG8_STAGE(PG8_SB(0, 0), b2, voffB); PG8_STAGE(PG8_SB(0, 1), b2 + hstepB, voffB); PG8_STAGE(PG8_SA(0, 0), a2, voffA);
            PG8_WAIT_V(8); PG8_WAIT_L(0); PG8_BAR; PG8_MMA(1, 0, At, B0); PG8_MMA(1, 1, At, B1); PG8_BAR; PG8_SCHED;
            PG8_LDB(B0, 1, 0); PG8_LDB(B1, 1, 1); PG8_SCHED; PG8_LDA(At, 1, 0); PG8_STAGE(PG8_SA(0, 1), a2 + hstepA, voffA);
            PG8_WAIT_V(8); PG8_WAIT_L(0); PG8_BAR; PG8_MMA(0, 0, At, B0); PG8_MMA(0, 1, At, B1); PG8_BAR; PG8_SCHED;
            PG8_LDA(At, 1, 1); PG8_STAGE(PG8_SB(1, 0), b3, voffB); PG8_STAGE(PG8_SB(1, 1), b3 + hstepB, voffB); PG8_STAGE(PG8_SA(1, 0), a3, voffA);
            PG8_WAIT_V(8); PG8_WAIT_L(0); PG8_BAR; PG8_MMA(1, 0, At, B0); PG8_MMA(1, 1, At, B1); PG8_BAR; PG8_SCHED;
            } else {
            PG8_LDB(B0, 0, 0); PG8_SCHED; PG8_LDA(At, 0, 0); PG8_STAGE(PG8_SA(1, 1), a1 + hstepA, voffA);
            PG8_WAIT_L(8); PG8_BAR; PG8_WAIT_L(0); PG8_MMA(0, 0, At, B0); PG8_BAR; PG8_SCHED;
            PG8_LDB(B1, 0, 1); PG8_STAGE(PG8_SB(0, 0), b2, voffB);
            PG8_BAR; PG8_WAIT_L(0); PG8_MMA(0, 1, At, B1); PG8_BAR;
            PG8_LDA(At, 0, 1); PG8_STAGE(PG8_SA(0, 0), a2, voffA);
            PG8_BAR; PG8_WAIT_L(0); PG8_MMA(1, 0, At, B0); PG8_BAR; PG8_SCHED;
            PG8_STAGE(PG8_SB(0, 1), b2 + hstepB, voffB);
            PG8_WAIT_V(6); PG8_BAR; PG8_MMA(1, 1, At, B1); PG8_BAR;
            PG8_LDB(B0, 1, 0); PG8_SCHED; PG8_LDA(At, 1, 0); PG8_STAGE(PG8_SA(0, 1), a2 + hstepA, voffA);
            PG8_WAIT_L(8); PG8_BAR; PG8_WAIT_L(0); PG8_MMA(0, 0, At, B0); PG8_BAR; PG8_SCHED;
            PG8_LDB(B1, 1, 1); PG8_STAGE(PG8_SB(1, 0), b3, voffB);
            PG8_BAR; PG8_WAIT_L(0); PG8_MMA(0, 1, At, B1); PG8_BAR;
            PG8_LDA(At, 1, 1); PG8_STAGE(PG8_SA(1, 0), a3, voffA);
            PG8_BAR; PG8_WAIT_L(0); PG8_MMA(1, 0, At, B0); PG8_BAR; PG8_SCHED;
            PG8_STAGE(PG8_SB(1, 1), b3 + hstepB, voffB);
            PG8_WAIT_V(6); PG8_BAR; PG8_MMA(1, 1, At, B1); PG8_BAR;
            }
        }
        if constexpr (ALIGN_EPI) { if (wr == 0) PG8_BAR; }
        if constexpr (!Epi::AFTER_DRAIN) { const int l2_ = tid_() & 63, fr2 = l2_ & 15, fq2 = l2_ >> 4;   E(acc, cur, wr, wc, fr2, fq2); S.done(cur); }
        if (!has_next) break;
#pragma unroll
        for (int a = 0; a < 2; ++a)
#pragma unroll
            for (int b = 0; b < 2; ++b)
#pragma unroll
                for (int m = 0; m < 4; ++m)
#pragma unroll
                    for (int n = 0; n < 2; ++n) acc[a][b][m][n] = (f32x4){0.f, 0.f, 0.f, 0.f};
        cur = nxt; cA = nA; cB = nB; ++ui;
        if constexpr (ALIGN_EPI) { if (wr == 1) PG8_BAR; }
    }
    PG8_WAIT_V(0);
    if constexpr (!ALIGN_EPI) { if (wr == 0) PG8_BAR; }
    PG8_BAR;
    if constexpr (Epi::AFTER_DRAIN) { E.fused(acc, cur, wr, wc, fr, fq, lds, wid, lane); S.done(cur); }
#undef PG8_SA
#undef PG8_SB
#undef PG8_STAGE
#undef qvoffA
#undef qvoffB
#undef PG8_LDA
#undef PG8_LDB
#undef PG8_MMA
#undef PG8_WAIT_V
#undef PG8_WAIT_L
#undef PG8_BAR
#undef PG8_SCHED
}
}

using pg8::bf16_t; using pg8::f32x4; using pg8::bf16x8; using pg8::u32x4; using pg8::u32x2;
#define DI __device__ __forceinline__
#define LAS __attribute__((address_space(3)))
typedef float f32x16 __attribute__((ext_vector_type(16)));
typedef short s16x4 __attribute__((ext_vector_type(4)));
typedef float f32x2_t __attribute__((ext_vector_type(2))); typedef __bf16 bf16x2_t __attribute__((ext_vector_type(2)));

constexpr int NTHR = 512, NWAVES = 8;
constexpr int D = 1024, NB = 8, SEQ = 2048, DEPTH = 4, DB = 16, DT = 16, PAST = 1024;
constexpr int MP = NB * SEQ, MS = DB * DT, MA = MP + MS;
constexpr int NIN = 6032, NINP = 6144;
constexpr int C_QA = 0, C_KA = 384, C_VA = 768, C_U = 1152, C_QC = 1408, C_KC = 1792, C_VC = 2176, C_GC = 2560, C_LR = 2944, C_GA = 2960, C_GB = 3984, C_GCG = 5008;
constexpr int FF = 2816, FF2 = 5632;
constexpr int GH = 4, GK = 96;
constexpr int NGU_P = NB * GH * 32, NGU_S = DB * GH, NGU = NGU_P + NGU_S;
constexpr float EPS = 1e-6f;

constexpr size_t O_YP = 0, O_YS = O_YP + (size_t)MP * D, O_KP = O_YS + (size_t)MS * D, O_VP = O_KP + (size_t)DEPTH * MP * 384, O_POOLP = O_VP + (size_t)DEPTH * MP * 384,
    O_GLAP = O_POOLP + (size_t)DEPTH * NB * 15 * 256, O_MKP = O_GLAP + (size_t)DEPTH * NB * GH * GK * GK, O_MVP = O_MKP + (size_t)DEPTH * NB * 256 * D,
    O_KS = O_MVP + (size_t)DEPTH * NB * 256 * D, O_VS = O_KS + (size_t)DEPTH * MS * 384, O_POOLS = O_VS + (size_t)DEPTH * MS * 384, O_GLAS = O_POOLS + (size_t)DEPTH * DB * 15 * 256,
    O_END = O_GLAS + (size_t)DEPTH * DB * GH * GK * GK;

enum { I_XP = 0, I_XS, I_MEM, I_CSK, I_CSV, I_SPOOL, I_SGLA, I_CMK, I_CMV, I_WIN, I_WA2, I_BA, I_GLAN, I_WPOOL, I_PSCALE, I_WBA, I_WBB, I_WBC, I_WMIX, I_MEMN, I_WXQ, I_WXK, I_WXV, I_WXO,
       I_WF1, I_WF2, I_NMIXPRE, I_NMIXPOST, I_NXPRE, I_NXPOST, I_NFPRE, I_NFPOST, N_IN };

constexpr size_t MiB = 1u << 20;
constexpr size_t SZ_WIN = (size_t)NINP * D * 2, SZ_WBA = (size_t)D * 384 * 2, SZ_WBB = (size_t)D * 256 * 2, SZ_WSQ = (size_t)D * D * 2, SZ_WKV = 2 * SZ_WSQ, SZ_WF1 = (size_t)FF2 * D * 2, SZ_WF2 = (size_t)D * FF * 2;
constexpr size_t WS_CTL = 0, CTL_BYTES = 1 * MiB, WS_TAB = CTL_BYTES - 4096;
constexpr size_t WS_WIN = WS_CTL + CTL_BYTES, WS_WBA = WS_WIN + 4 * SZ_WIN, WS_WBB = WS_WBA + 4 * SZ_WBA, WS_WBC = WS_WBB + 4 * SZ_WBB, WS_WMIX = WS_WBC + 4 * SZ_WBA,
    WS_WXQ = WS_WMIX + 4 * SZ_WSQ, WS_WXO = WS_WXQ + 4 * SZ_WSQ, WS_WKV = WS_WXO + 4 * SZ_WSQ, WS_WF1 = WS_WKV + 4 * SZ_WKV, WS_WF2 = WS_WF1 + 4 * SZ_WF1,
    WS_MN = WS_WF2 + 4 * SZ_WF2, WS_MKV = WS_MN + 4 * SZ_WKV, WS_MEMVT = WS_MKV + 8 * SZ_WKV, WS_PROJ = WS_MEMVT + 4 * SZ_WKV;
constexpr size_t SZ_ROWS = (size_t)MA * D * 2;
constexpr size_t SZ_PROJ = (size_t)MA * NINP * 2;
constexpr size_t WS_Q = WS_PROJ, WS_P = WS_Q + SZ_ROWS, WS_O = WS_P + SZ_ROWS, WS_ACT = WS_O + SZ_ROWS;
static_assert(WS_ACT + (size_t)MA * FF * 2 <= WS_PROJ + SZ_PROJ, "overlay fits");
constexpr size_t WS_H = WS_PROJ + SZ_PROJ, WS_MERGED = WS_H + SZ_ROWS, WS_Y = WS_MERGED + SZ_ROWS;
constexpr size_t WS_GKV = WS_H, WS_GSP = WS_GKV + 39 * MiB, WS_GDEC = WS_GSP + 37 * MiB;
static_assert((size_t)NGU * GK * GK * 4 <= 39 * MiB && (size_t)NGU_P * GK * GK * 4 <= 37 * MiB && WS_GDEC + (size_t)NGU * GK * 4 <= WS_Y + SZ_ROWS, "GLA overlay fits");
constexpr size_t WS_OA = WS_Y + SZ_ROWS, WS_POOLED = WS_OA + (size_t)MA * 384 * 2, WS_OC = WS_POOLED + (size_t)MA * 256 * 2, WS_BB = WS_OC + (size_t)MA * 384 * 2, WS_XB = WS_BB + (size_t)NGU * 64 * GK * 4, WS_RN = WS_XB + SZ_ROWS, WS_END = WS_RN + (size_t)MA * 4;
static_assert(WS_WIN % 256 == 0 && WS_PROJ % 256 == 0 && WS_H % 256 == 0 && WS_OA % 256 == 0 && WS_POOLED % 256 == 0 && WS_OC % 256 == 0 && WS_P % 256 == 0, "alignment");

constexpr int CW_BAR = 16384;
constexpr int LDS_GEMM = 131072, LDS_X = LDS_GEMM, LDS_X_BYTES = 12288, LDS_MISC = LDS_X + LDS_X_BYTES, LDS_BYTES = LDS_MISC + 256;

struct Params { const float* in[N_IN]; float* out; unsigned char* ws; int ph_lo, ph_hi; };
struct InTab { const float* const* t;
    __device__ __forceinline__ const float* operator[](int i) const { const unsigned long long v = (unsigned long long)t[i];
        const unsigned lo = __builtin_amdgcn_readfirstlane((unsigned)v), hi = __builtin_amdgcn_readfirstlane((unsigned)(v >> 32)); return (const float*)(((unsigned long long)hi << 32) | lo); } };
struct Ctx { InTab in; float* out; unsigned char* ws; };

DI float bflo(unsigned w) { return __uint_as_float(w << 16); }
DI float bfhi(unsigned w) { return __uint_as_float(w & 0xffff0000u); }
DI float bf2f(unsigned short v) { return __uint_as_float((unsigned)v << 16); }
DI unsigned pk2(float lo, float hi) { f32x2_t v = {lo, hi}; bf16x2_t b = __builtin_convertvector(v, bf16x2_t); return __builtin_bit_cast(unsigned, b); }
DI unsigned short f2bf(float f) { return (unsigned short)(pk2(f, 0.f) & 0xffffu); }
DI float wave_sum(float v) {
#pragma unroll
    for (int o = 1; o < 64; o <<= 1) v += __shfl_xor(v, o);
    return v;
}
DI float wave_max(float v) {
#pragma unroll
    for (int o = 1; o < 64; o <<= 1) v = fmaxf(v, __shfl_xor(v, o));
    return v;
}
DI float sigmoidf_(float x) { return __builtin_amdgcn_rcpf(1.f + __expf(-x)); }
DI float softplusf_(float z) { return fmaxf(z, 0.f) + __logf(1.f + __expf(-fabsf(z))); }
DI int next_work(unsigned* ctr, volatile LAS int* slot) {
    __syncthreads();
    if (pg8::tid_() == 0) *slot = (int)atomicAdd(ctr, 1u);
    __syncthreads();
    return *slot;
}

typedef const pg8::f32x4 (&AccRef)[2][2][4][2];
struct EpiBf16 {
    static constexpr bool PERM = true, AFTER_DRAIN = false;
    bf16_t* O; int ldc; int pnmask;
    DI void operator()(AccRef acc, const pg8::Unit& u, int wr, int wc, int fr, int fq) const {
#pragma unroll
        for (int ai = 0; ai < 2; ++ai)
#pragma unroll
            for (int m = 0; m < 4; ++m) {
                bf16_t* rowp = O + (size_t)(u.pm * 256 + ai * 128 + wr * 64 + m * 16 + fr) * ldc + (u.pn & pnmask) * 256 + wc * 32 + 8 * fq;
#pragma unroll
                for (int bj = 0; bj < 2; ++bj) {
                    const f32x4 v0 = acc[ai][bj][m][0], v1 = acc[ai][bj][m][1];
                    u32x4 w; w.x = pk2(v0[0], v0[1]); w.y = pk2(v0[2], v0[3]); w.z = pk2(v1[0], v1[1]); w.w = pk2(v1[2], v1[3]);
                    *(u32x4*)(rowp + bj * 128) = w;
                }
            }
    }
};
struct EpiGate {
    static constexpr bool PERM = true, AFTER_DRAIN = false;
    bf16_t* merged; const bf16_t* proj; int goff; int accum;
    DI void operator()(AccRef acc, const pg8::Unit& u, int wr, int wc, int fr, int fq) const {
#pragma unroll
        for (int ai = 0; ai < 2; ++ai)
#pragma unroll
            for (int m = 0; m < 4; ++m) {
                const int row = u.pm * 256 + ai * 128 + wr * 64 + m * 16 + fr;
                const bf16_t* gp = proj + (size_t)row * NINP + goff + u.pn * 256 + wc * 32 + 8 * fq;
                bf16_t* mp = merged + (size_t)row * D + u.pn * 256 + wc * 32 + 8 * fq;
                u32x4 g[2], pm4[2];
#pragma unroll
                for (int bj = 0; bj < 2; ++bj) { g[bj] = *(const u32x4*)(gp + bj * 128); pm4[bj] = (u32x4){0u, 0u, 0u, 0u}; if (accum) pm4[bj] = *(const u32x4*)(mp + bj * 128); }
#pragma unroll
                for (int bj = 0; bj < 2; ++bj) {
                    const f32x4 v0 = acc[ai][bj][m][0], v1 = acc[ai][bj][m][1];
                    u32x4 w;
                    w.x = pk2(sigmoidf_(bflo(g[bj].x)) * v0[0] + bflo(pm4[bj].x), sigmoidf_(bfhi(g[bj].x)) * v0[1] + bfhi(pm4[bj].x));
                    w.y = pk2(sigmoidf_(bflo(g[bj].y)) * v0[2] + bflo(pm4[bj].y), sigmoidf_(bfhi(g[bj].y)) * v0[3] + bfhi(pm4[bj].y));
                    w.z = pk2(sigmoidf_(bflo(g[bj].z)) * v1[0] + bflo(pm4[bj].z), sigmoidf_(bfhi(g[bj].z)) * v1[1] + bfhi(pm4[bj].z));
                    w.w = pk2(sigmoidf_(bflo(g[bj].w)) * v1[2] + bflo(pm4[bj].w), sigmoidf_(bfhi(g[bj].w)) * v1[3] + bfhi(pm4[bj].w));
                    *(u32x4*)(mp + bj * 128) = w;
                }
                if (m & 1) asm volatile("" ::: "memory");
            }
    }
};
struct EpiSwiglu {
    static constexpr bool PERM = true, AFTER_DRAIN = false;
    bf16_t* act;
    DI void operator()(AccRef acc, const pg8::Unit& u, int wr, int wc, int fr, int fq) const {
#pragma unroll
        for (int ai = 0; ai < 2; ++ai)
#pragma unroll
            for (int m = 0; m < 4; ++m) {
                const int row = u.pm * 256 + ai * 128 + wr * 64 + m * 16 + fr;
#pragma unroll
                for (int bj = 0; bj < 2; ++bj) {
                    const int col0 = u.pn * 256 + bj * 128 + wc * 32 + 8 * fq;
                    const f32x4 g = acc[ai][bj][m][0], up = acc[ai][bj][m][1];
                    float r[4];
#pragma unroll
                    for (int j = 0; j < 4; ++j) r[j] = g[j] * sigmoidf_(g[j]) * up[j];
                    u32x2 w; w.x = pk2(r[0], r[1]); w.y = pk2(r[2], r[3]);
                    *(u32x2*)(act + (size_t)row * FF + (col0 >> 1)) = w;
                }
            }
    }
};
struct MemKvOrder {
    int G, c; const char* A; const char* B;
    DI bool next(int i, pg8::Unit& u) const {
        const int L = i * G + c; if (L >= 256) return false;
        const int l = L >> 6, r = L & 63; u.pm = l * 8 + (r & 7); u.pn = l * 8 + (r >> 3);
        u.a = A + (size_t)u.pm * (256 * D * 2); u.b = B + (size_t)u.pn * (256 * D * 2); return true;
    }
    DI void a_ready(const pg8::Unit&) const {}
    DI void done(const pg8::Unit&) const {}
};
struct CrossOrder {
    int G, c; const char* A; const char* B; int mode;
    DI bool next(int i, pg8::Unit& u) const {
        const int L = i * G + c; if (L >= 256) return false;
        u.pm = L >> 2; u.pn = L & 3; const int b = u.pm >> 3, h = u.pn;
        u.a = A + ((size_t)u.pm * 256 * D + h * 256) * 2;
        u.b = mode == 0 ? B + ((size_t)b * 256 * 2048 + h * 256) * 2 : B + ((size_t)h * 256 * 2048 + b * 256) * 2;
        return true;
    }
    DI void a_ready(const pg8::Unit&) const {}
    DI void done(const pg8::Unit&) const {}
};
struct EpiSoftmax {
    static constexpr bool PERM = true, AFTER_DRAIN = false;
    bf16_t* P; LAS float* xs;
    DI void operator()(AccRef acc, const pg8::Unit& u, int wr, int wc, int fr, int fq) const {
        const float sc = 0.0625f * 1.4426950408889634f;
        LAS float* xm = xs; LAS float* xsum = xs + 1024;
#pragma unroll
        for (int ai = 0; ai < 2; ++ai)
#pragma unroll
            for (int m = 0; m < 4; ++m) {
                float a = -3.0e38f;
#pragma unroll
                for (int bj = 0; bj < 2; ++bj)
#pragma unroll
                    for (int n = 0; n < 2; ++n) { const f32x4 v = acc[ai][bj][m][n]; a = fmaxf(a, fmaxf(fmaxf(v[0], v[1]), fmaxf(v[2], v[3]))); }
                a = fmaxf(a, __shfl_xor(a, 16)); a = fmaxf(a, __shfl_xor(a, 32));
                if (fq == 0) xm[(ai * 128 + wr * 64 + m * 16 + fr) * 4 + wc] = a;
                asm volatile("" ::: "memory");
            }
        __syncthreads();
#pragma unroll
        for (int ai = 0; ai < 2; ++ai)
#pragma unroll
            for (int m = 0; m < 4; ++m) {
                const f32x4 t = *(LAS f32x4*)(xm + (ai * 128 + wr * 64 + m * 16 + fr) * 4); const float mx = fmaxf(fmaxf(t[0], t[1]), fmaxf(t[2], t[3])) * sc;
                float s = 0.f;
#pragma unroll
                for (int bj = 0; bj < 2; ++bj)
#pragma unroll
                    for (int n = 0; n < 2; ++n)
#pragma unroll
                        for (int j = 0; j < 4; ++j) s += __builtin_amdgcn_exp2f(acc[ai][bj][m][n][j] * sc - mx);
                s += __shfl_xor(s, 16); s += __shfl_xor(s, 32);
                if (fq == 0) xsum[(ai * 128 + wr * 64 + m * 16 + fr) * 4 + wc] = s;
                asm volatile("" ::: "memory");
            }
        __syncthreads();
#pragma unroll
        for (int ai = 0; ai < 2; ++ai)
#pragma unroll
            for (int m = 0; m < 4; ++m) {
                const f32x4 t = *(LAS f32x4*)(xm + (ai * 128 + wr * 64 + m * 16 + fr) * 4); const float mx = fmaxf(fmaxf(t[0], t[1]), fmaxf(t[2], t[3])) * sc;
                const f32x4 t2 = *(LAS f32x4*)(xsum + (ai * 128 + wr * 64 + m * 16 + fr) * 4); const float inv = __builtin_amdgcn_rcpf((t2[0] + t2[1]) + (t2[2] + t2[3]));
                bf16_t* rowp = P + (size_t)(u.pm * 256 + ai * 128 + wr * 64 + m * 16 + fr) * D + u.pn * 256 + wc * 32 + 8 * fq;
#pragma unroll
                for (int bj = 0; bj < 2; ++bj)
#pragma unroll
                    for (int n = 0; n < 2; ++n) {
                        const f32x4 v = acc[ai][bj][m][n];
                        u32x2 w; w.x = pk2(__builtin_amdgcn_exp2f(v[0] * sc - mx) * inv, __builtin_amdgcn_exp2f(v[1] * sc - mx) * inv); w.y = pk2(__builtin_amdgcn_exp2f(v[2] * sc - mx) * inv, __builtin_amdgcn_exp2f(v[3] * sc - mx) * inv);
                        *(u32x2*)(rowp + bj * 128 + 4 * n) = w;
                    }
                asm volatile("" ::: "memory");
            }
        __syncthreads();
    }
};

#define XB_TMO      128
#define XB_XCNT(j)  (256  + 64 * (j))
#define XB_XSUB(j)  (1280 + 64 * (j))
#define XB_XGEN(j)  (2304 + 64 * (j))
#define XB_TOP      3328
#define XB_TOPGEN   3392
#define XCD_BAR_WORDS 3456
#define XB_SPIN_CAP (1u << 18)

__device__ __forceinline__ unsigned xb_ld(unsigned* p)              { return __hip_atomic_load(p, __ATOMIC_RELAXED, __HIP_MEMORY_SCOPE_AGENT); }
__device__ __forceinline__ unsigned xb_add(unsigned* p, unsigned v) { return __hip_atomic_fetch_add(p, v, __ATOMIC_RELAXED, __HIP_MEMORY_SCOPE_AGENT); }
__device__ __forceinline__ unsigned xb_xcc_id() { return (unsigned)__builtin_amdgcn_s_getreg((3 << 11) | 20) & 0xFu; }
#define XB_SPIN(cond, bar) do { unsigned _sp = 0; while (cond) { __builtin_amdgcn_s_sleep(1); \
    if ((++_sp & 255u) == 0u) { if (xb_ld(&(bar)[XB_TMO])) break; if (_sp > XB_SPIN_CAP) { atomicAdd(&(bar)[XB_TMO], 1u); break; } } } } while (0)

struct XcdBarrier {
    unsigned* bar; unsigned x;
    volatile LAS unsigned* st;
};

__device__ __forceinline__ XcdBarrier xcd_barrier_post(unsigned* bar, volatile LAS unsigned* st) {
    XcdBarrier b; b.bar = bar; b.x = xb_xcc_id(); b.st = st;
    if (threadIdx.x == 0) (void)xb_add(&bar[XB_XCNT(b.x)], 1u);
    return b;
}
__device__ __forceinline__ void xcd_barrier_complete(unsigned* bar, unsigned x, unsigned& nloc, unsigned& nx) {
    const unsigned G = gridDim.x * gridDim.y * gridDim.z;
    unsigned sum, cnt, mine, sp = 0u;
    for (;;) {
        sum = 0u; cnt = 0u; mine = 0u;
#pragma unroll
        for (unsigned j = 0; j < 16; ++j) { const unsigned c = xb_ld(&bar[XB_XCNT(j)]); sum += c; cnt += (c > 0u) ? 1u : 0u; mine = (j == x) ? c : mine; }
        if (sum == G) break;
        __builtin_amdgcn_s_sleep(1);
        if ((++sp & 255u) == 0u) { if (xb_ld(&bar[XB_TMO])) break; if (sp > XB_SPIN_CAP) { atomicAdd(&bar[XB_TMO], 1u); break; } }
    }
    nloc = mine > 0u ? mine : 1u; nx = cnt > 0u ? cnt : 1u;
}

__device__ __forceinline__ void xcd_barrier(const XcdBarrier& b) {
    asm volatile("s_waitcnt vmcnt(0)" ::: "memory");
    __syncthreads();
    if (threadIdx.x == 0) {
        unsigned* bar = b.bar;
        __builtin_amdgcn_s_waitcnt(0);
        unsigned nloc = b.st[0], nx = b.st[1];
        if (nloc == 0u) { xcd_barrier_complete(bar, b.x, nloc, nx); b.st[0] = nloc; b.st[1] = nx; }
        const unsigned old = xb_add(&bar[XB_XSUB(b.x)], 1u);
        const unsigned gen = old / nloc;
        if (old + 1u == (gen + 1u) * nloc) {
            __builtin_amdgcn_fence(__ATOMIC_RELEASE, "agent");
            asm volatile("s_waitcnt vmcnt(0)" ::: "memory");
            const unsigned og = xb_add(&bar[XB_TOP], 1u);
            const unsigned tg = og / nx;
            if (og + 1u == (tg + 1u) * nx) xb_add(&bar[XB_TOPGEN], 1u);
            else XB_SPIN(xb_ld(&bar[XB_TOPGEN]) == tg, bar);
            __builtin_amdgcn_fence(__ATOMIC_ACQUIRE, "agent");
            xb_add(&bar[XB_XGEN(b.x)], 1u);
            asm volatile("s_waitcnt vmcnt(0)" ::: "memory");
        } else {
            XB_SPIN(xb_ld(&bar[XB_XGEN(b.x)]) == gen, bar);
            __builtin_amdgcn_fence(__ATOMIC_ACQUIRE, "agent");
            asm volatile("s_waitcnt vmcnt(0)" ::: "memory");
        }
    }
    __syncthreads();
}


#define LDS_WAIT() asm volatile("s_waitcnt lgkmcnt(0)" ::: "memory")
DI void transpose_item(const float* W, int K, int N, int Npad, bf16_t* WT, int mode, LAS float* scr, int item, int lane, const float* gk = nullptr) {
    const int nblk = Npad / 32, kb = item / nblk, nb = item % nblk, k0 = 64 * kb, n0 = 32 * nb;
    const int nn = n0 + (lane & 31); const bool ok = nn < N;
    float tv[32];
#pragma unroll
    for (int i = 0; i < 32; ++i) tv[i] = ok ? W[(size_t)(k0 + 2 * i + (lane >> 5)) * N + nn] : 0.f;
    if (gk) {
#pragma unroll
        for (int i = 0; i < 32; ++i) tv[i] *= gk[k0 + 2 * i + (lane >> 5)];
    }
#pragma unroll
    for (int i = 0; i < 32; ++i) scr[(2 * i + (lane >> 5)) * 33 + (lane & 31)] = tv[i];
    LDS_WAIT(); asm volatile("" ::: "memory");
    const int c = lane & 7;
#pragma unroll
    for (int j = 0; j < 4; ++j) {
        const int n = (lane >> 3) + 8 * j; const LAS float* s = scr + (8 * c) * 33 + n;
        u32x4 o; o.x = pk2(s[0 * 33], s[1 * 33]); o.y = pk2(s[2 * 33], s[3 * 33]); o.z = pk2(s[4 * 33], s[5 * 33]); o.w = pk2(s[6 * 33], s[7 * 33]);
        int drow = n0 + n;
        if (mode == 1) { const int jj = drow >= FF ? drow - FF : drow, isu = drow >= FF ? 1 : 0; drow = (jj >> 2) * 8 + isu * 4 + (jj & 3); }
        *(u32x4*)(WT + (size_t)drow * K + k0 + 8 * c) = o;
    }
    LDS_WAIT(); asm volatile("" ::: "memory");
}

template <int NR> DI void norm_rows(const float* xsrc32, bf16_t* xn, float* rn, float* xdst32, const bf16_t* y, const float* gpost, size_t rstride, int lane) {
    f32x4 v[NR][4];
    if (xsrc32) {
#pragma unroll
        for (int r = 0; r < NR; ++r)
#pragma unroll
            for (int j = 0; j < 4; ++j) v[r][j] = *(const f32x4*)(xsrc32 + r * rstride + 4 * lane + 256 * j);
    } else {
        float rr[NR]; u32x2 w[NR][4];
#pragma unroll
        for (int r = 0; r < NR; ++r) { rr[r] = rn[r * (rstride / D)];
#pragma unroll
            for (int j = 0; j < 4; ++j) w[r][j] = *(const u32x2*)(xn + r * rstride + 4 * lane + 256 * j); }
#pragma unroll
        for (int r = 0; r < NR; ++r)
#pragma unroll
            for (int j = 0; j < 4; ++j) v[r][j] = (f32x4){bflo(w[r][j].x), bfhi(w[r][j].x), bflo(w[r][j].y), bfhi(w[r][j].y)} * rr[r];
    }
    if (y) {
        u32x2 yw[NR][4]; f32x4 g[4];
#pragma unroll
        for (int r = 0; r < NR; ++r)
#pragma unroll
            for (int j = 0; j < 4; ++j) yw[r][j] = *(const u32x2*)(y + r * rstride + 4 * lane + 256 * j);
#pragma unroll
        for (int j = 0; j < 4; ++j) g[j] = *(const f32x4*)(gpost + 4 * lane + 256 * j);
#pragma unroll
        for (int r = 0; r < NR; ++r) {
            f32x4 yv[4]; float ss = 0.f;
#pragma unroll
            for (int j = 0; j < 4; ++j) { yv[j] = (f32x4){bflo(yw[r][j].x), bfhi(yw[r][j].x), bflo(yw[r][j].y), bfhi(yw[r][j].y)}; ss += (yv[j][0] * yv[j][0] + yv[j][1] * yv[j][1]) + (yv[j][2] * yv[j][2] + yv[j][3] * yv[j][3]); }
            const float rs = rsqrtf(wave_sum(ss) * (1.f / D) + EPS);
#pragma unroll
            for (int j = 0; j < 4; ++j) v[r][j] = v[r][j] + yv[j] * rs * g[j];
        }
    }
#pragma unroll
    for (int r = 0; r < NR; ++r) {
        if (xdst32) {
#pragma unroll
            for (int j = 0; j < 4; ++j) *(f32x4*)(xdst32 + r * rstride + 4 * lane + 256 * j) = v[r][j];
        } else {
            float ss = 0.f;
#pragma unroll
            for (int j = 0; j < 4; ++j) ss += (v[r][j][0] * v[r][j][0] + v[r][j][1] * v[r][j][1]) + (v[r][j][2] * v[r][j][2] + v[r][j][3] * v[r][j][3]);
            const float ms = wave_sum(ss) * (1.f / D) + EPS, rs = rsqrtf(ms);
#pragma unroll
            for (int j = 0; j < 4; ++j) { const f32x4 o = v[r][j] * rs; u32x2 w; w.x = pk2(o[0], o[1]); w.y = pk2(o[2], o[3]); *(u32x2*)(xn + r * rstride + 4 * lane + 256 * j) = w; }
            if (lane == 0) rn[r * (rstride / D)] = ms * rs;
        }
    }
}
DI void norm_row(const float* xsrc32, bf16_t* xn, float* rn, float* xdst32, const bf16_t* y, const float* gpost, int lane) { norm_rows<1>(xsrc32, xn, rn, xdst32, y, gpost, (size_t)D, lane); }

DI void norm_phase(const Ctx& p, const float* gpost, bool last, int G, int bx) {
    const int tid = pg8::tid_(), lane = tid & 63, wv = tid >> 6, gw = bx * NWAVES + wv, NGW = G * NWAVES;
    const bf16_t* Yb = (const bf16_t*)(p.ws + WS_Y); bf16_t* Xb = (bf16_t*)(p.ws + WS_XB); float* Rn = (float*)(p.ws + WS_RN);
    int row = gw; const size_t rst = (size_t)NGW * D;
    for (; row + 3 * NGW < MA; row += 4 * NGW) norm_rows<4>(nullptr, Xb + (size_t)row * D, Rn + row, last ? p.out + (size_t)row * D : nullptr, Yb + (size_t)row * D, gpost, rst, lane);
    for (; row < MA; row += NGW) norm_row(nullptr, Xb + (size_t)row * D, Rn + row, last ? p.out + (size_t)row * D : nullptr, Yb + (size_t)row * D, gpost, lane);
}

constexpr int CV_I0 = 3072, CV_I1 = 192, CV_I2 = 512, CV_I3 = 2816, CV_I4 = 1408, CV_IPL = CV_I0 + 2 * CV_I1 + 5 * CV_I2 + CV_I3 + CV_I4, CV_KV0 = CV_I0 + 2 * CV_I1 + 3 * CV_I2, CV_NKV = 2 * CV_I2;
constexpr int CV_UNITS = (CV_IPL - CV_NKV) / 64;
static_assert((CV_IPL - CV_NKV) % 64 == 0, "conversion units");
template <class IN> DI void convert_item(const IN& in, unsigned char* ws, int l, int r, LAS float* scr, int lane) {
    constexpr int I0 = CV_I0, I1 = CV_I1, I2 = CV_I2, I3 = CV_I3;
    if (r < I0) { transpose_item(in[I_WIN] + (size_t)l * D * NIN, D, NIN, NINP, (bf16_t*)(ws + WS_WIN + l * SZ_WIN), 0, scr, r, lane, in[I_NMIXPRE] + l * D); return; } r -= I0;
    if (r < I1) { transpose_item(in[I_WBA] + (size_t)l * 384 * D, 384, D, D, (bf16_t*)(ws + WS_WBA + l * SZ_WBA), 0, scr, r, lane); return; } r -= I1;
    if (r < I1) { transpose_item(in[I_WBC] + (size_t)l * 384 * D, 384, D, D, (bf16_t*)(ws + WS_WBC + l * SZ_WBA), 0, scr, r, lane); return; } r -= I1;
    if (r < I2) { transpose_item(in[I_WMIX] + (size_t)l * D * D, D, D, D, (bf16_t*)(ws + WS_WMIX + l * SZ_WSQ), 0, scr, r, lane); return; } r -= I2;
    if (r < I2) { transpose_item(in[I_WXQ] + (size_t)l * D * D, D, D, D, (bf16_t*)(ws + WS_WXQ + l * SZ_WSQ), 0, scr, r, lane, in[I_NXPRE] + l * D); return; } r -= I2;
    if (r < I2) { transpose_item(in[I_WXO] + (size_t)l * D * D, D, D, D, (bf16_t*)(ws + WS_WXO + l * SZ_WSQ), 0, scr, r, lane); return; } r -= I2;
    if (r < I2) { transpose_item(in[I_WXK] + (size_t)l * D * D, D, D, D, (bf16_t*)(ws + WS_WKV + l * SZ_WKV), 0, scr, r, lane); return; } r -= I2;
    if (r < I2) { transpose_item(in[I_WXV] + (size_t)l * D * D, D, D, D, (bf16_t*)(ws + WS_WKV + l * SZ_WKV + SZ_WSQ), 0, scr, r, lane); return; } r -= I2;
    if (r < I3) { transpose_item(in[I_WF1] + (size_t)l * D * FF2, D, FF2, FF2, (bf16_t*)(ws + WS_WF1 + l * SZ_WF1), 1, scr, r, lane, in[I_NFPRE] + l * D); return; } r -= I3;
    transpose_item(in[I_WF2] + (size_t)l * FF * D, FF, D, D, (bf16_t*)(ws + WS_WF2 + l * SZ_WF2), 0, scr, r, lane);
}
DI void conv_unit(const Ctx& p, int l, int j, LAS unsigned char* lds) {
    const int tid = pg8::tid_(), lane = tid & 63, wv = tid >> 6; LAS float* scr = (LAS float*)(lds + wv * 16384);
    for (int q = 0; q < 8; ++q) { const int r = j * 64 + wv * 8 + q; convert_item(p.in, p.ws, l, r < CV_KV0 ? r : r + CV_NKV, scr, lane); }
}
DI void prologue(const Params& p, LAS unsigned char* lds) {
    const int tid = pg8::tid_(), lane = tid & 63, wv = tid >> 6;
    const int gw = blockIdx.x * NWAVES + wv, NGW = gridDim.x * NWAVES;
    LAS float* scr = (LAS float*)(lds + wv * 16384);
    unsigned char* ws = p.ws;
    for (int it = gw; it < CV_IPL + 3 * CV_NKV; it += NGW) {
        if (it < CV_IPL) convert_item(p.in, ws, 0, it, scr, lane);
        else { const int j = it - CV_IPL; convert_item(p.in, ws, 1 + j / CV_NKV, CV_KV0 + j % CV_NKV, scr, lane); }
    }
    for (int u = blockIdx.x; u < 128; u += gridDim.x) {
        const int l = u >> 5, g = (u >> 3) & 3, nb = (u >> 2) & 1, cq = u & 3;
        LAS float* Ps = (LAS float*)(lds + 8 * 16384);
        __syncthreads();
        for (int i = tid; i < 1024; i += NTHR) Ps[i] = p.in[I_WPOOL][((size_t)(l * 4 + g) * 64 + 16 * cq) * 64 + i];
        __syncthreads();
        const int n = nb * 512 + tid;
        const float* sc = p.in[I_PSCALE] + l * 256 + g * 64; const float* wb = p.in[I_WBB] + ((size_t)l * 256 + g * 64) * D + n;
        float acc[16];
#pragma unroll
        for (int c = 0; c < 16; ++c) acc[c] = 0.f;
#pragma unroll 2
        for (int d0 = 0; d0 < 64; d0 += 8) {
            float bc[8];
#pragma unroll
            for (int j = 0; j < 8; ++j) bc[j] = sc[d0 + j] * wb[(size_t)(d0 + j) * D];
#pragma unroll
            for (int c = 0; c < 16; ++c) { const f32x4 p0 = *(const LAS f32x4*)(Ps + c * 64 + d0), p1 = *(const LAS f32x4*)(Ps + c * 64 + d0 + 4);
                acc[c] += ((p0[0] * bc[0] + p0[1] * bc[1]) + (p0[2] * bc[2] + p0[3] * bc[3])) + ((p1[0] * bc[4] + p1[1] * bc[5]) + (p1[2] * bc[6] + p1[3] * bc[7])); }
        }
        unsigned ov[16];
#pragma unroll
        for (int c = 0; c < 16; ++c) ov[c] = f2bf(acc[c]);
        bf16_t* dst = (bf16_t*)(ws + WS_WBB + l * SZ_WBB) + (size_t)n * 256 + g * 64 + 16 * cq;
        u32x4 w0, w1; w0.x = ov[0] | (ov[1] << 16); w0.y = ov[2] | (ov[3] << 16); w0.z = ov[4] | (ov[5] << 16); w0.w = ov[6] | (ov[7] << 16);
        w1.x = ov[8] | (ov[9] << 16); w1.y = ov[10] | (ov[11] << 16); w1.z = ov[12] | (ov[13] << 16); w1.w = ov[14] | (ov[15] << 16);
        *(u32x4*)dst = w0; *(u32x4*)(dst + 8) = w1;
    }
    __syncthreads();
    for (int row = gw; row < MA; row += NGW) {
        const float* src = row < MP ? p.in[I_XP] + (size_t)row * D : p.in[I_XS] + (size_t)(row - MP) * D;
        norm_row(src, (bf16_t*)(ws + WS_XB) + (size_t)row * D, (float*)(ws + WS_RN) + row, nullptr, nullptr, nullptr, lane);
    }
    for (int row = gw; row < NB * 256; row += NGW) {
        f32x4 v[4]; float ss = 0.f;
#pragma unroll
        for (int j = 0; j < 4; ++j) { v[j] = *(const f32x4*)(p.in[I_MEM] + (size_t)row * D + 4 * lane + 256 * j); ss += (v[j][0] * v[j][0] + v[j][1] * v[j][1]) + (v[j][2] * v[j][2] + v[j][3] * v[j][3]); }
        const float rs = rsqrtf(wave_sum(ss) * (1.f / D) + EPS);
        for (int l = 0; l < 4; ++l)
#pragma unroll
            for (int j = 0; j < 4; ++j) { const f32x4 g = *(const f32x4*)(p.in[I_MEMN] + l * D + 4 * lane + 256 * j); const f32x4 o = v[j] * rs * g; u32x2 w; w.x = pk2(o[0], o[1]); w.y = pk2(o[2], o[3]);
                *(u32x2*)((bf16_t*)(ws + WS_MN) + ((size_t)l * 2048 + row) * D + 4 * lane + 256 * j) = w; }
    }
}

#define MFMA32(a, b, c) __builtin_amdgcn_mfma_f32_32x32x16_bf16((a), (b), (c), 0, 0, 0)
#define MFMA16(a, b, c) __builtin_amdgcn_mfma_f32_16x16x32_bf16((a), (b), (c), 0, 0, 0)
template <bool MASKED> DI void sb_tile_weights(f32x16 (&z)[2], float& R, int jt, int tq, int hi) {
    f32x16 e[2]; float T[8];
    const int sbase = 64 * jt + 4 * hi;
#pragma unroll
    for (int kb = 0; kb < 2; ++kb)
#pragma unroll
        for (int g = 0; g < 4; ++g) {
            float fl[4];
#pragma unroll
            for (int j = 0; j < 4; ++j) {
                const int r = 4 * g + j; const bool valid = !MASKED || (sbase + 32 * kb + 8 * g + j) < tq;
                const float zz = fminf(fmaxf(z[kb][r], -240.f), 240.f);
                const float t = __builtin_amdgcn_exp2f(zz * (-0.125f * 1.4426950408889634f));
                const float be = __builtin_amdgcn_rcpf(1.f + t);
                fl[j] = valid ? t * be : 1.f; z[kb][r] = valid ? be : 0.f;
            }
            e[kb][4 * g + 3] = 1.f; e[kb][4 * g + 2] = fl[3]; e[kb][4 * g + 1] = fl[3] * fl[2]; e[kb][4 * g + 0] = e[kb][4 * g + 1] * fl[1];
            T[kb * 4 + g] = e[kb][4 * g + 0] * fl[0];
        }
    float Tp[8], X[8];
#pragma unroll
    for (int gi = 0; gi < 8; ++gi) Tp[gi] = __shfl_xor(T[gi], 32);
    X[7] = 1.f;
#pragma unroll
    for (int gi = 6; gi >= 0; --gi) X[gi] = X[gi + 1] * (T[gi + 1] * Tp[gi + 1]);
    const float total = X[0] * (T[0] * Tp[0]);
#pragma unroll
    for (int kb = 0; kb < 2; ++kb)
#pragma unroll
        for (int g = 0; g < 4; ++g) {
            const int gi = kb * 4 + g; const float off = R * X[gi] * (hi == 0 ? Tp[gi] : 1.f);
#pragma unroll
            for (int j = 0; j < 4; ++j) { const int r = 4 * g + j; z[kb][r] = z[kb][r] * (off * e[kb][r]); }
        }
    R *= total;
}

DI void sb_prompt_unit(const Ctx& p, int b, int h, int qb, LAS unsigned char* lds) {
    const bf16_t* proj = (const bf16_t*)(p.ws + WS_PROJ);
    LAS unsigned short* KS = (LAS unsigned short*)lds;
    LAS unsigned short* VT = KS + 64 * 72;
    const int tid = pg8::tid_(), lane = tid & 63, wv = tid >> 6, hi = lane >> 5, c = lane & 31;
    const int q0 = qb * 256 + wv * 32, tq = q0 + c;
    const size_t rowbase = (size_t)b * SEQ;
    bf16x8 qf[4];
    {
        const bf16_t* qp = proj + (rowbase + tq) * NINP + C_QA + h * 64 + 8 * hi;
#pragma unroll
        for (int kk = 0; kk < 4; ++kk) qf[kk] = *(const bf16x8*)(qp + 16 * kk);
    }
    f32x16 o0, o1;
#pragma unroll
    for (int i = 0; i < 16; ++i) { o0[i] = 0.f; o1[i] = 0.f; }
    float R = 1.f;
    const bf16_t* kbase = proj + rowbase * NINP + C_KA + h * 64 + 8 * wv;
    const bf16_t* vbase = proj + rowbase * NINP + C_VA + h * 64 + 8 * wv;
    int jt = 4 * qb + 3;
    u32x4 kr = *(const u32x4*)(kbase + (size_t)(64 * jt + lane) * NINP), vr = *(const u32x4*)(vbase + (size_t)(64 * jt + lane) * NINP);
    for (; jt >= 0; --jt) {
        __syncthreads();
        *(LAS u32x4*)(KS + lane * 72 + 8 * wv) = kr;
#pragma unroll
        for (int i = 0; i < 4; ++i) { const unsigned w = vr[i]; VT[(8 * wv + 2 * i) * 72 + lane] = (unsigned short)(w & 0xffffu); VT[(8 * wv + 2 * i + 1) * 72 + lane] = (unsigned short)(w >> 16); }
        __syncthreads();
        if (jt > 0) { kr = *(const u32x4*)(kbase + (size_t)(64 * (jt - 1) + lane) * NINP); vr = *(const u32x4*)(vbase + (size_t)(64 * (jt - 1) + lane) * NINP); }
        if (64 * jt < q0 + 31) {
            f32x16 z[2];
#pragma unroll
            for (int kb = 0; kb < 2; ++kb) {
                f32x16 acc;
#pragma unroll
                for (int i = 0; i < 16; ++i) acc[i] = 0.f;
#pragma unroll
                for (int kk = 0; kk < 4; ++kk) { const bf16x8 a = *(const LAS bf16x8*)(KS + (32 * kb + c) * 72 + 16 * kk + 8 * hi); acc = MFMA32(a, qf[kk], acc); }
                z[kb] = acc;
            }
            if (64 * jt + 63 < q0) sb_tile_weights<false>(z, R, jt, tq, hi); else sb_tile_weights<true>(z, R, jt, tq, hi);
#pragma unroll
            for (int kb = 0; kb < 2; ++kb)
#pragma unroll
                for (int s2 = 0; s2 < 2; ++s2) {
                    u32x4 pw; pw.x = pk2(z[kb][8 * s2 + 0], z[kb][8 * s2 + 1]); pw.y = pk2(z[kb][8 * s2 + 2], z[kb][8 * s2 + 3]); pw.z = pk2(z[kb][8 * s2 + 4], z[kb][8 * s2 + 5]); pw.w = pk2(z[kb][8 * s2 + 6], z[kb][8 * s2 + 7]);
                    const bf16x8 pb = __builtin_bit_cast(bf16x8, pw);
                    const int ko = 32 * kb + 16 * s2 + 4 * hi;
                    { const s16x4 lo = *(const LAS s16x4*)(VT + c * 72 + ko), hh = *(const LAS s16x4*)(VT + c * 72 + ko + 8);
                      const bf16x8 va = __builtin_shufflevector(lo, hh, 0, 1, 2, 3, 4, 5, 6, 7); o0 = MFMA32(va, pb, o0); }
                    { const s16x4 lo = *(const LAS s16x4*)(VT + (c + 32) * 72 + ko), hh = *(const LAS s16x4*)(VT + (c + 32) * 72 + ko + 8);
                      const bf16x8 va = __builtin_shufflevector(lo, hh, 0, 1, 2, 3, 4, 5, 6, 7); o1 = MFMA32(va, pb, o1); }
                }
        }
    }
    bf16_t* op = (bf16_t*)(p.ws + WS_OA) + (rowbase + tq) * 384 + h * 64 + 4 * hi;
#pragma unroll
    for (int g = 0; g < 4; ++g) {
        u32x2 w; w.x = pk2(o0[4 * g], o0[4 * g + 1]); w.y = pk2(o0[4 * g + 2], o0[4 * g + 3]); *(u32x2*)(op + 8 * g) = w;
        w.x = pk2(o1[4 * g], o1[4 * g + 1]); w.y = pk2(o1[4 * g + 2], o1[4 * g + 3]); *(u32x2*)(op + 32 + 8 * g) = w;
    }
}

DI void sb_sample_unit(const Ctx& p, int l, int b, int h, LAS unsigned char* lds) {
    const bf16_t* proj = (const bf16_t*)(p.ws + WS_PROJ);
    LAS float* qs = (LAS float*)lds;
    LAS float* Z = qs + 1024;
    LAS float* RED = Z + 16 * 1056;
    const int tid = pg8::tid_(), lane = tid & 63, wv = tid >> 6;
    const size_t srow = (size_t)MP + b * 16;
    for (int i = tid; i < 1024; i += NTHR) qs[i] = bf2f(proj[(srow + (i >> 6)) * NINP + C_QA + h * 64 + (i & 63)]) * 0.125f;
    __syncthreads();
    {
        float a0[16], a1[16];
#pragma unroll
        for (int i = 0; i < 16; ++i) { a0[i] = 0.f; a1[i] = 0.f; }
        const float* k0p = p.in[I_CSK] + ((((size_t)l * DB + b) * PAST + tid) * 6 + h) * 64; const float* k1p = k0p + (size_t)512 * 6 * 64;
#pragma unroll 8
        for (int d4 = 0; d4 < 16; ++d4) {
            const f32x4 ka = *(const f32x4*)(k0p + 4 * d4), kb = *(const f32x4*)(k1p + 4 * d4);
#pragma unroll
            for (int i = 0; i < 16; ++i) { const f32x4 q = *(const LAS f32x4*)(qs + i * 64 + 4 * d4);
                a0[i] += (q[0] * ka[0] + q[1] * ka[1]) + (q[2] * ka[2] + q[3] * ka[3]); a1[i] += (q[0] * kb[0] + q[1] * kb[1]) + (q[2] * kb[2] + q[3] * kb[3]); }
        }
#pragma unroll
        for (int i = 0; i < 16; ++i) { Z[i * 1056 + tid] = a0[i]; Z[i * 1056 + tid + 512] = a1[i]; }
        if (tid < 256) {
            const int i = tid >> 4, j = tid & 15; const bf16_t* kp = proj + (srow + j) * NINP + C_KA + h * 64; float s = 0.f;
            for (int d = 0; d < 64; ++d) s += qs[i * 64 + d] * bf2f(kp[d]);
            Z[i * 1056 + 1024 + j] = s;
        }
    }
    __syncthreads();
    for (int qq = 0; qq < 2; ++qq) {
        const int i = 2 * wv + qq, lim = PAST + i; LAS float* zr = Z + i * 1056;
        const int st = 17 * lane, en = (st + 17 < 1040) ? st + 17 : 1040;
        float tot = 0.f;
        for (int s = st; s < en; ++s) if (s < lim) tot -= softplusf_(zr[s]);
        float incl = tot;
#pragma unroll
        for (int o = 1; o < 64; o <<= 1) { const float t = __shfl_down(incl, o); if (lane + o < 64) incl += t; }
        float run = incl - tot;
        for (int s = en - 1; s >= st; --s) {
            const float zz = zr[s]; float w = 0.f;
            if (s < lim) { const float sp = softplusf_(zz); w = __expf(zz - sp + run); run -= sp; }
            zr[s] = w;
        }
    }
    __syncthreads();
    {
        const int d = tid & 63, g = tid >> 6;
        float o[16];
#pragma unroll
        for (int i = 0; i < 16; ++i) o[i] = 0.f;
        const float* vp = p.in[I_CSV] + (((size_t)l * DB + b) * PAST * 6 + h) * 64 + d;
        for (int s0 = 130 * g; s0 < 130 * g + 130; s0 += 26) {
            float v[26];
#pragma unroll
            for (int j = 0; j < 26; ++j) { const int s = s0 + j; v[j] = s < PAST ? vp[(size_t)s * 384] : bf2f(proj[(srow + (s - PAST)) * NINP + C_VA + h * 64 + d]); }
#pragma unroll
            for (int j = 0; j < 26; ++j)
#pragma unroll
                for (int i = 0; i < 16; ++i) o[i] += Z[i * 1056 + s0 + j] * v[j];
        }
#pragma unroll
        for (int i = 0; i < 16; ++i) RED[(g * 16 + i) * 64 + d] = o[i];
    }
    __syncthreads();
    for (int i = tid; i < 1024; i += NTHR) {
        const int qi = i >> 6, d = i & 63; float s = 0.f;
#pragma unroll
        for (int g = 0; g < 8; ++g) s += RED[(g * 16 + qi) * 64 + d];
        ((bf16_t*)(p.ws + WS_OA))[(srow + qi) * 384 + h * 64 + d] = f2bf(s);
    }
}

template <int W> DI void pool_rows(const float (&uu)[48], int t0, float* outp, bf16_t* pooled_col) {
    float s = 0.f;
#pragma unroll
    for (int i = 16 - W; i < 16; ++i) s += uu[i];
#pragma unroll
    for (int r = 0; r < 32; ++r) {
        s += uu[16 + r] - uu[16 + r - W];
        const int t = t0 + r; const float cnt = (float)((t + 1 < W) ? t + 1 : W);
        pooled_col[(size_t)r * 256] = f2bf(s / cnt - uu[16 + r]);
        if (t >= SEQ - 15) outp[(size_t)(t - (SEQ - 15)) * 256] = uu[16 + r];
    }
}
DI void pool_unit(const Ctx& p, int l, int unit) {
    const bf16_t* proj = (const bf16_t*)(p.ws + WS_PROJ); bf16_t* pooled = (bf16_t*)(p.ws + WS_POOLED);
    const int tid = pg8::tid_(), ch = tid & 255, w = 2 << (ch >> 6);
    if (unit < MP / 64) {
        const int r0 = unit * 64 + 32 * (tid >> 8), t0 = r0 & (SEQ - 1), b = r0 >> 11;
        float uu[48];
        const bf16_t* up = proj + (size_t)(r0 - 16) * NINP + C_U + ch;
#pragma unroll
        for (int i = 0; i < 48; ++i) uu[i] = (t0 - 16 + i >= 0) ? bf2f(up[(size_t)i * NINP]) : 0.f;
        float* outp = p.out + O_POOLP + ((size_t)(l * NB + b) * 15) * 256 + ch; bf16_t* pc = pooled + (size_t)r0 * 256 + ch;
        if (w == 2) pool_rows<2>(uu, t0, outp, pc); else if (w == 4) pool_rows<4>(uu, t0, outp, pc); else if (w == 8) pool_rows<8>(uu, t0, outp, pc); else pool_rows<16>(uu, t0, outp, pc);
        return;
    }
    for (int i = 0; i < 32; ++i) {
        const int row = unit * 64 + (tid >> 8) + 2 * i;
        const int rs = row - MP, b = rs >> 4, t = rs & 15; float s = 0.f;
        const bf16_t* up = proj + (size_t)row * NINP + C_U + ch; const float u0 = bf2f(up[0]);
        const float* hist = p.in[I_SPOOL] + ((size_t)(l * DB + b) * 15) * 256 + ch;
        for (int j = 0; j < w; ++j) { const int tt = t - j; s += tt >= 0 ? bf2f(*(up - (size_t)j * NINP)) : hist[(15 + tt) * 256]; }
        if (t >= 1) p.out[O_POOLS + ((size_t)(l * DB + b) * 15 + (t - 1)) * 256 + ch] = u0;
        pooled[(size_t)row * 256 + ch] = f2bf(s / (float)w - u0);
    }
}

DI void kvout_unit(const Ctx& p, int l, int unit) {
    const bf16_t* proj = (const bf16_t*)(p.ws + WS_PROJ);
#pragma unroll 4
    for (int i = pg8::tid_(); i < 64 * 96; i += NTHR) {
        const int r = i / 96, ch = i % 96, row = unit * 64 + r;
        const u32x4 w = *(const u32x4*)(proj + (size_t)row * NINP + C_KA + 8 * ch);
        const bool isv = ch >= 48; const int c = 8 * (isv ? ch - 48 : ch);
        float* dst = (row < MP) ? p.out + (isv ? O_VP : O_KP) + ((size_t)l * MP + row) * 384 + c : p.out + (isv ? O_VS : O_KS) + ((size_t)l * MS + (row - MP)) * 384 + c;
        *(f32x4*)dst = (f32x4){bflo(w.x), bfhi(w.x), bflo(w.y), bfhi(w.y)}; *(f32x4*)(dst + 4) = (f32x4){bflo(w.z), bfhi(w.z), bflo(w.w), bfhi(w.w)};
    }
}
DI void memout_unit(const Ctx& p, int unit) {
    const bf16_t* mkv = (const bf16_t*)(p.ws + WS_MKV);
    for (int i = pg8::tid_(); i < 16 * 256; i += NTHR) {
        const int r = i >> 8, ch = i & 255, row = unit * 16 + r, col = 8 * ch;
        const u32x4 w = *(const u32x4*)(mkv + (size_t)row * 2048 + col);
        float* dst = p.out + (col >= 1024 ? O_MVP : O_MKP) + (size_t)row * D + (col & 1023);
        *(f32x4*)dst = (f32x4){bflo(w.x), bfhi(w.x), bflo(w.y), bfhi(w.y)}; *(f32x4*)(dst + 4) = (f32x4){bflo(w.z), bfhi(w.z), bflo(w.w), bfhi(w.w)};
    }
}
DI void memvt_unit(const Ctx& p, int unit) {
    const int l = unit >> 7, nb = (unit >> 3) & 15, b = unit & 7, tid = pg8::tid_(), n = nb * 64 + (tid & 63), wv = tid >> 6;
    const bf16_t* src = (const bf16_t*)(p.ws + WS_MKV) + ((size_t)l * 2048 + b * 256) * 2048 + 1024 + n;
    bf16_t* dst = (bf16_t*)(p.ws + WS_MEMVT) + ((size_t)l * 1024 + n) * 2048 + b * 256;
    for (int c = wv; c < 32; c += 8) {
        unsigned v[8];
#pragma unroll
        for (int j = 0; j < 8; ++j) v[j] = src[(size_t)(8 * c + j) * 2048];
        u32x4 w; w.x = v[0] | (v[1] << 16); w.y = v[2] | (v[3] << 16); w.z = v[4] | (v[5] << 16); w.w = v[6] | (v[7] << 16);
        *(u32x4*)(dst + 8 * c) = w;
    }
}

DI void gla_decay(const Ctx& p, int l, int h, size_t row0, int ntok, LAS unsigned char* lds) {
    const bf16_t* proj = (const bf16_t*)(p.ws + WS_PROJ);
    LAS float* Bc = (LAS float*)lds; LAS float* LR = (LAS float*)(lds + 24576); LAS float* A2 = (LAS float*)(lds + 28672); LAS float* BIA = (LAS float*)(lds + 34816); LAS float* SEG = (LAS float*)(lds + 35200);
    const int tid = pg8::tid_();
    if (tid < 128) {
        const int t = tid >> 1, hf = tid & 1; u32x4 w = {0u, 0u, 0u, 0u};
        if (t < ntok) w = *(const u32x4*)(proj + (row0 + t) * NINP + C_LR + 8 * hf);
        LAS float* d = LR + t * 16 + 8 * hf;
        d[0] = bflo(w.x); d[1] = bfhi(w.x); d[2] = bflo(w.y); d[3] = bfhi(w.y); d[4] = bflo(w.z); d[5] = bfhi(w.z); d[6] = bflo(w.w); d[7] = bfhi(w.w);
    } else if (tid < 128 + 384) {
        const int i = tid - 128, r = i / 24, c4 = i % 24;
        *(LAS f32x4*)(A2 + r * 96 + 4 * c4) = *(const f32x4*)(p.in[I_WA2] + ((size_t)l * 16 + r) * 384 + h * 96 + 4 * c4);
    }
    if (tid < 96) BIA[tid] = p.in[I_BA][l * 384 + h * 96 + tid];
    __syncthreads();
    for (int i = tid; i < 64 * 96; i += NTHR) {
        const int t = i / 96, k = i % 96; float sacc = BIA[k];
#pragma unroll
        for (int r = 0; r < 16; ++r) sacc += LR[t * 16 + r] * A2[r * 96 + k];
        Bc[i] = t < ntok ? -softplusf_(-sacc) * (1.f / 16.f) : 0.f;
    }
    __syncthreads();
    const int k = tid % 96, seg = tid / 96;
    if (tid < 384) { float run = 0.f; for (int i = 0; i < 16; ++i) { const int idx = (16 * seg + i) * 96 + k; run += Bc[idx]; Bc[idx] = run; } SEG[seg * 96 + k] = run; }
    __syncthreads();
    if (tid < 384 && seg > 0) { float off = 0.f; for (int s2 = 0; s2 < seg; ++s2) off += SEG[s2 * 96 + k]; for (int i = 0; i < 16; ++i) Bc[(16 * seg + i) * 96 + k] += off; }
    __syncthreads();
}
DI void gla_unit_rows(int gu, size_t& row0, int& ntok, int& bh, int& h) {
    if (gu < NGU_P) { bh = gu >> 5; const int c = gu & 31, b = bh >> 2; h = bh & 3; row0 = (size_t)b * SEQ + c * 64; ntok = 64; }
    else { bh = gu - NGU_P; const int b = bh >> 2; h = bh & 3; row0 = (size_t)MP + b * 16; ntok = 16; }
}
DI void gla_stage1_unit(const Ctx& p, int l, int gu, LAS unsigned char* lds) {
    const bf16_t* proj = (const bf16_t*)(p.ws + WS_PROJ);
    size_t row0; int ntok, bh, h; gla_unit_rows(gu, row0, ntok, bh, h);
    gla_decay(p, l, h, row0, ntok, lds);
    LAS float* Bc = (LAS float*)lds;
    LAS unsigned short* KT = (LAS unsigned short*)(lds + 36864);
    LAS unsigned short* VT = KT + 96 * 72;
    const int tid = pg8::tid_(), lane = tid & 63, wv = tid >> 6, fr = lane & 15, fq = lane >> 4;
    {
        float* bb = (float*)(p.ws + WS_BB) + (size_t)gu * (64 * GK);
        for (int i = tid; i < 64 * GK / 4; i += NTHR) *(f32x4*)(bb + 4 * i) = *(const LAS f32x4*)(Bc + 4 * i);
    }
    for (int task = tid; task < 768; task += NTHR) {
        const int t = task & 63, ch = task >> 6; u32x4 kw = {0u, 0u, 0u, 0u}, vw = {0u, 0u, 0u, 0u};
        if (t < ntok) { const bf16_t* rp = proj + (row0 + t) * NINP + h * 96 + 8 * ch; kw = *(const u32x4*)(rp + C_KC); vw = *(const u32x4*)(rp + C_VC); }
        const unsigned kk[4] = {kw.x, kw.y, kw.z, kw.w}, vv[4] = {vw.x, vw.y, vw.z, vw.w};
#pragma unroll
        for (int j = 0; j < 4; ++j) {
            const int k0 = 8 * ch + 2 * j;
            const float e0 = __expf(Bc[(ntok - 1) * 96 + k0] - Bc[t * 96 + k0]), e1 = __expf(Bc[(ntok - 1) * 96 + k0 + 1] - Bc[t * 96 + k0 + 1]);
            KT[k0 * 72 + t] = f2bf(bflo(kk[j]) * e0); KT[(k0 + 1) * 72 + t] = f2bf(bfhi(kk[j]) * e1);
            VT[k0 * 72 + t] = (unsigned short)(vv[j] & 0xffffu); VT[(k0 + 1) * 72 + t] = (unsigned short)(vv[j] >> 16);
        }
    }
    if (tid < 96) ((float*)(p.ws + WS_GDEC))[(size_t)gu * 96 + tid] = __expf(Bc[(ntok - 1) * 96 + tid]);
    __syncthreads();
    float* KV = (float*)(p.ws + WS_GKV) + (size_t)gu * (GK * GK);
    for (int tile = wv; tile < 36; tile += 8) {
        const int ki = tile / 6, vi = tile % 6; f32x4 acc = {0.f, 0.f, 0.f, 0.f};
#pragma unroll
        for (int ks = 0; ks < 2; ++ks) { const bf16x8 a = *(const LAS bf16x8*)(KT + (16 * ki + fr) * 72 + 32 * ks + 8 * fq), bb = *(const LAS bf16x8*)(VT + (16 * vi + fr) * 72 + 32 * ks + 8 * fq); acc = MFMA16(a, bb, acc); }
#pragma unroll
        for (int j = 0; j < 4; ++j) KV[(16 * ki + 4 * fq + j) * 96 + 16 * vi + fr] = acc[j];
    }
}
DI void gla_scan(const Ctx& p, int l) {
    const int gt = blockIdx.x * NTHR + pg8::tid_(), NT = gridDim.x * NTHR;
    const float* KV = (const float*)(p.ws + WS_GKV); const float* DEC = (const float*)(p.ws + WS_GDEC); float* SP = (float*)(p.ws + WS_GSP);
    for (int e = gt; e < 32 * GK * GK; e += NT) {
        const int bh = e / (GK * GK), kv = e % (GK * GK), k = kv / GK; float S = 0.f;
        float kvv[32], dcv[32];
#pragma unroll
        for (int c = 0; c < 32; ++c) { const size_t gu = (size_t)bh * 32 + c; kvv[c] = KV[gu * (GK * GK) + kv]; dcv[c] = DEC[gu * 96 + k]; }
#pragma unroll
        for (int c = 0; c < 32; ++c) { const size_t gu = (size_t)bh * 32 + c; SP[gu * (GK * GK) + kv] = S; S = dcv[c] * S + kvv[c]; }
        p.out[O_GLAP + ((size_t)l * 32 + bh) * (GK * GK) + kv] = S;
    }
    for (int e = gt; e < 64 * GK * GK; e += NT) {
        const int bh = e / (GK * GK), kv = e % (GK * GK), k = kv / GK; const size_t gu = (size_t)NGU_P + bh;
        const float S0 = p.in[I_SGLA][((size_t)l * 64 + bh) * (GK * GK) + kv];
        p.out[O_GLAS + ((size_t)l * 64 + bh) * (GK * GK) + kv] = DEC[gu * 96 + k] * S0 + KV[gu * (GK * GK) + kv];
    }
}
DI void gla_stage3_unit(const Ctx& p, int l, int gu, LAS unsigned char* lds) {
    const bf16_t* proj = (const bf16_t*)(p.ws + WS_PROJ);
    size_t row0; int ntok, bh, h; gla_unit_rows(gu, row0, ntok, bh, h);
    LAS float* OT = (LAS float*)lds;
    LAS unsigned short* QP = (LAS unsigned short*)(lds + 36864);
    LAS unsigned short* KP = QP + 64 * 104;
    LAS unsigned short* VT = KP + 64 * 104;
    LAS unsigned short* ST = VT + 96 * 72;
    LAS unsigned short* ATT = ST + 96 * 104;
    const int tid = pg8::tid_(), lane = tid & 63, wv = tid >> 6, fr = lane & 15, fq = lane >> 4;
    const float* Sprev = gu < NGU_P ? (const float*)(p.ws + WS_GSP) + (size_t)gu * (GK * GK) : p.in[I_SGLA] + ((size_t)l * 64 + bh) * (GK * GK);
    const float* bb = (const float*)(p.ws + WS_BB) + (size_t)gu * (64 * GK);
    __syncthreads();
    for (int task = tid; task < 768; task += NTHR) {
        const int t = task & 63, ch = task >> 6; u32x4 qw = {0u, 0u, 0u, 0u}, kw = qw, vw = qw; f32x4 b0 = {0.f, 0.f, 0.f, 0.f}, b1 = b0;
        if (t < ntok) { const bf16_t* rp = proj + (row0 + t) * NINP + h * 96 + 8 * ch; qw = *(const u32x4*)(rp + C_QC); kw = *(const u32x4*)(rp + C_KC); vw = *(const u32x4*)(rp + C_VC);
            b0 = *(const f32x4*)(bb + t * 96 + 8 * ch); b1 = *(const f32x4*)(bb + t * 96 + 8 * ch + 4); }
        const unsigned qq[4] = {qw.x, qw.y, qw.z, qw.w}, kk[4] = {kw.x, kw.y, kw.z, kw.w}, vv[4] = {vw.x, vw.y, vw.z, vw.w};
        const float be[8] = {b0[0], b0[1], b0[2], b0[3], b1[0], b1[1], b1[2], b1[3]};
        u32x4 qo, ko; unsigned qa[4], ka[4];
#pragma unroll
        for (int j = 0; j < 4; ++j) {
            const float e0 = __expf(be[2 * j]), e1 = __expf(be[2 * j + 1]), r0 = __builtin_amdgcn_rcpf(e0), r1 = __builtin_amdgcn_rcpf(e1);
            const bool ok = t < ntok;
            qa[j] = ok ? pk2(bflo(qq[j]) * 0.10206207261596575f * e0, bfhi(qq[j]) * 0.10206207261596575f * e1) : 0u;
            ka[j] = ok ? pk2(bflo(kk[j]) * r0, bfhi(kk[j]) * r1) : 0u;
            VT[(8 * ch + 2 * j) * 72 + t] = (unsigned short)(vv[j] & 0xffffu); VT[(8 * ch + 2 * j + 1) * 72 + t] = (unsigned short)(vv[j] >> 16);
        }
        qo.x = qa[0]; qo.y = qa[1]; qo.z = qa[2]; qo.w = qa[3]; ko.x = ka[0]; ko.y = ka[1]; ko.z = ka[2]; ko.w = ka[3];
        *(LAS u32x4*)(QP + t * 104 + 8 * ch) = qo; *(LAS u32x4*)(KP + t * 104 + 8 * ch) = ko;
    }
    for (int task = tid; task < 2304; task += NTHR) {
        const int k = task % 96, vc = task / 96; const f32x4 sv = *(const f32x4*)(Sprev + k * 96 + 4 * vc);
#pragma unroll
        for (int j = 0; j < 4; ++j) ST[(4 * vc + j) * 104 + k] = f2bf(sv[j]);
    }
    __syncthreads();
    for (int tile = 2 * wv; tile < 2 * wv + 2; ++tile) {
        const int ti = tile >> 2, si = tile & 3; f32x4 acc = {0.f, 0.f, 0.f, 0.f};
        if (si <= ti) {
#pragma unroll
            for (int ks = 0; ks < 3; ++ks) { const bf16x8 a = *(const LAS bf16x8*)(QP + (16 * ti + fr) * 104 + 32 * ks + 8 * fq), b2 = *(const LAS bf16x8*)(KP + (16 * si + fr) * 104 + 32 * ks + 8 * fq); acc = MFMA16(a, b2, acc); }
        }
#pragma unroll
        for (int j = 0; j < 4; ++j) { const int t = 16 * ti + 4 * fq + j, s2 = 16 * si + fr; ATT[t * 72 + s2] = f2bf(s2 <= t ? acc[j] : 0.f); }
    }
    __syncthreads();
    for (int tile = wv; tile < 24; tile += 8) {
        const int ti = tile / 6, vi = tile % 6; f32x4 acc = {0.f, 0.f, 0.f, 0.f};
#pragma unroll
        for (int ks = 0; ks < 2; ++ks) { const bf16x8 a = *(const LAS bf16x8*)(ATT + (16 * ti + fr) * 72 + 32 * ks + 8 * fq), b2 = *(const LAS bf16x8*)(VT + (16 * vi + fr) * 72 + 32 * ks + 8 * fq); acc = MFMA16(a, b2, acc); }
#pragma unroll
        for (int ks = 0; ks < 3; ++ks) { const bf16x8 a = *(const LAS bf16x8*)(QP + (16 * ti + fr) * 104 + 32 * ks + 8 * fq), b2 = *(const LAS bf16x8*)(ST + (16 * vi + fr) * 104 + 32 * ks + 8 * fq); acc = MFMA16(a, b2, acc); }
#pragma unroll
        for (int j = 0; j < 4; ++j) OT[(16 * ti + 4 * fq + j) * 96 + 16 * vi + fr] = acc[j];
    }
    __syncthreads();
    bf16_t* oc = (bf16_t*)(p.ws + WS_OC);
    const float* gn = p.in[I_GLAN] + l * 384 + h * 96; const float gn0 = gn[lane], gn1 = lane < 32 ? gn[64 + lane] : 0.f;
    float g0[8], g1[8];
#pragma unroll
    for (int tt = 0; tt < 8; ++tt) { const int t = wv * 8 + tt; g0[tt] = 0.f; g1[tt] = 0.f;
        if (t < ntok) { const bf16_t* gp = proj + (row0 + t) * NINP + C_GC + h * 96; g0[tt] = bf2f(gp[lane]); if (lane < 32) g1[tt] = bf2f(gp[64 + lane]); } }
#pragma unroll
    for (int tt = 0; tt < 8; ++tt) {
        const int t = wv * 8 + tt;
        if (t < ntok) {
            const float a0 = OT[t * 96 + lane], a1 = lane < 32 ? OT[t * 96 + 64 + lane] : 0.f;
            const float rs = rsqrtf(wave_sum(a0 * a0 + a1 * a1) * (1.f / 96.f) + EPS);
            oc[(row0 + t) * 384 + h * 96 + lane] = f2bf(a0 * rs * gn0 * g0[tt] * sigmoidf_(g0[tt]));
            if (lane < 32) oc[(row0 + t) * 384 + h * 96 + 64 + lane] = f2bf(a1 * rs * gn1 * g1[tt] * sigmoidf_(g1[tt]));
        }
    }
}

DI void cross_sample_unit(const Ctx& p, int l, int b, int h, int qh, LAS unsigned char* lds) {
    LAS float* qs = (LAS float*)lds;
    LAS float* ST = qs + 8 * 256;
    LAS float* PART = ST + 256 * 8;
    const bf16_t* Q = (const bf16_t*)(p.ws + WS_Q);
    const int tid = pg8::tid_(), lane = tid & 63, wv = tid >> 6;
    const size_t srow = (size_t)MP + b * 16 + 8 * qh;
    for (int i = tid; i < 8 * 256; i += NTHR) qs[i] = bf2f(Q[(srow + (i >> 8)) * D + h * 256 + (i & 255)]) * 0.0625f;
    __syncthreads();
    const int m = tid & 255, half = tid >> 8;
    {
        float acc[8];
#pragma unroll
        for (int i = 0; i < 8; ++i) acc[i] = 0.f;
        const float* kp = p.in[I_CMK] + ((((size_t)l * DB + b) * 256 + m) * 4 + h) * 256 + 128 * half;
#pragma unroll 16
        for (int d4 = 0; d4 < 32; ++d4) {
            const f32x4 kv = *(const f32x4*)(kp + 4 * d4);
#pragma unroll
            for (int i = 0; i < 8; ++i) { const f32x4 q = *(const LAS f32x4*)(qs + i * 256 + 128 * half + 4 * d4); acc[i] += (q[0] * kv[0] + q[1] * kv[1]) + (q[2] * kv[2] + q[3] * kv[3]); }
        }
#pragma unroll
        for (int i = 0; i < 8; ++i) PART[(half * 8 + i) * 256 + m] = acc[i];
    }
    __syncthreads();
    {
        const int i = wv; float v[4], mx = -3.0e38f;
#pragma unroll
        for (int j = 0; j < 4; ++j) { v[j] = PART[i * 256 + lane + 64 * j] + PART[(8 + i) * 256 + lane + 64 * j]; mx = fmaxf(mx, v[j]); }
        mx = wave_max(mx); float sum = 0.f;
#pragma unroll
        for (int j = 0; j < 4; ++j) { v[j] = __expf(v[j] - mx); sum += v[j]; }
        sum = wave_sum(sum); const float inv = 1.f / sum;
#pragma unroll
        for (int j = 0; j < 4; ++j) ST[(lane + 64 * j) * 8 + i] = v[j] * inv;
    }
    __syncthreads();
    {
        float acc[8];
#pragma unroll
        for (int i = 0; i < 8; ++i) acc[i] = 0.f;
        const float* vp = p.in[I_CMV] + ((((size_t)l * DB + b) * 256 + 128 * half) * 4 + h) * 256 + m;
        for (int k0 = 0; k0 < 128; k0 += 32) {
            float v[32];
#pragma unroll
            for (int j = 0; j < 32; ++j) v[j] = vp[(size_t)(k0 + j) * 1024];
#pragma unroll
            for (int j = 0; j < 32; ++j) {
                const f32x4 s0 = *(const LAS f32x4*)(ST + (128 * half + k0 + j) * 8), s1 = *(const LAS f32x4*)(ST + (128 * half + k0 + j) * 8 + 4);
                acc[0] += s0[0] * v[j]; acc[1] += s0[1] * v[j]; acc[2] += s0[2] * v[j]; acc[3] += s0[3] * v[j];
                acc[4] += s1[0] * v[j]; acc[5] += s1[1] * v[j]; acc[6] += s1[2] * v[j]; acc[7] += s1[3] * v[j];
            }
        }
#pragma unroll
        for (int i = 0; i < 8; ++i) PART[(half * 8 + i) * 256 + m] = acc[i];
    }
    __syncthreads();
    bf16_t* O = (bf16_t*)(p.ws + WS_O);
    for (int i = tid; i < 8 * 256; i += NTHR) { const int qi = i >> 8, d = i & 255; O[(srow + qi) * D + h * 256 + d] = f2bf(PART[qi * 256 + d] + PART[(8 + qi) * 256 + d]); }
}

struct SkBf16 { bf16_t* O; int ldc; DI void operator()(int row, int col, f32x4 v) const { u32x2 w; w.x = pk2(v[0], v[1]); w.y = pk2(v[2], v[3]); *(u32x2*)(O + (size_t)(MP + row) * ldc + col) = w; } };
struct SkGate { bf16_t* merged; const bf16_t* proj; int goff; int accum;
    DI void operator()(int row, int col, f32x4 v) const {
        const u32x2 g = *(const u32x2*)(proj + (size_t)(MP + row) * NINP + goff + col); bf16_t* mp = merged + (size_t)(MP + row) * D + col;
        u32x2 pm2 = {0u, 0u}; if (accum) pm2 = *(const u32x2*)mp;
        u32x2 w; w.x = pk2(sigmoidf_(bflo(g.x)) * v[0] + bflo(pm2.x), sigmoidf_(bfhi(g.x)) * v[1] + bfhi(pm2.x)); w.y = pk2(sigmoidf_(bflo(g.y)) * v[2] + bflo(pm2.y), sigmoidf_(bfhi(g.y)) * v[3] + bfhi(pm2.y));
        *(u32x2*)mp = w; } };
template <class EF> DI void skinny_gemm(const bf16_t* A, int lda, const bf16_t* Bt, int ldb, int K, int N, int G, int bx, LAS unsigned char* lds, const EF& ef) {
    const int tid = pg8::tid_(), lane = tid & 63, wv = tid >> 6, fr = lane & 15, fq = lane >> 4, nks = K >> 5, nunits = 4 * (N >> 4);
    LAS f32x4* red = (LAS f32x4*)lds;
    for (int u = bx; u < nunits; u += G) {
        const int rb = u & 3, cb = u >> 2;
        f32x4 acc[4];
#pragma unroll
        for (int i = 0; i < 4; ++i) acc[i] = (f32x4){0.f, 0.f, 0.f, 0.f};
        const bf16_t* bp = Bt + (size_t)(16 * cb + fr) * ldb + 8 * fq; const bf16_t* ap = A + (size_t)(64 * rb + fr) * lda + 8 * fq;
        for (int ks = wv; ks < nks; ks += 8) {
            const bf16x8 bb = *(const bf16x8*)(bp + 32 * ks);
            bf16x8 aa[4];
#pragma unroll
            for (int i = 0; i < 4; ++i) aa[i] = *(const bf16x8*)(ap + (size_t)(16 * i) * lda + 32 * ks);
#pragma unroll
            for (int i = 0; i < 4; ++i) acc[i] = MFMA16(bb, aa[i], acc[i]);
        }
#pragma unroll
        for (int i = 0; i < 4; ++i) red[(wv * 4 + i) * 64 + lane] = acc[i];
        __syncthreads();
        if (tid < 256) {
            const int i = tid >> 6; f32x4 s = red[i * 64 + lane];
#pragma unroll
            for (int w = 1; w < 8; ++w) s = s + red[(w * 4 + i) * 64 + lane];
            ef(64 * rb + 16 * i + fr, 16 * cb + 4 * fq, s);
        }
        __syncthreads();
    }
}

constexpr int PH_PER_LAYER = 15, N_PHASES = 1 + DEPTH * PH_PER_LAYER;
#define RUN_GEMM(EpiT, E, Aptr, lda_, Bptr, ldb_, K_, pm0_, nM_, nN_) do { const pg8::Gemm g_{(K_), (lda_), (ldb_)}; pg8::TileOrder S_; S_.init((Aptr), (lda_), (Bptr), (ldb_), (pm0_), (nM_), (nN_), G, bx); \
        pg8::gemm_phase<EpiT, pg8::TileOrder, true, true>(lds, g_, S_, (E)); } while (0)

__global__ void __launch_bounds__(NTHR, 2) fwd_kernel(Params p) {
    extern __shared__ __attribute__((aligned(16))) unsigned char lds_raw[];
#define PROJ ((bf16_t*)(ws + WS_PROJ))
#define H ((bf16_t*)(ws + WS_XB))
#define MERGED ((bf16_t*)(ws + WS_MERGED))
#define Y ((bf16_t*)(ws + WS_Y))
#define QB ((bf16_t*)(ws + WS_Q))
#define PB ((bf16_t*)(ws + WS_P))
#define OB ((bf16_t*)(ws + WS_O))
#define ACT ((bf16_t*)(ws + WS_ACT))

    {
        volatile LAS unsigned* st0 = (volatile LAS unsigned*)((LAS unsigned char*)lds_raw + LDS_MISC + 32);
        if (pg8::tid_() == 0) { st0[0] = 0u; st0[1] = 0u; st0[8] = 0u; st0[9] = 0u; }
        __syncthreads();
    }
    XcdBarrier xbar = xcd_barrier_post((unsigned*)(p.ws + WS_CTL) + CW_BAR, (volatile LAS unsigned*)((LAS unsigned char*)lds_raw + LDS_MISC + 32));
    if (p.ph_lo == 0) {
        prologue(p, (LAS unsigned char*)lds_raw);
        if (blockIdx.x == 0 && pg8::tid_() == 0) {
            const float** tab = (const float**)(p.ws + WS_TAB);
#pragma unroll
            for (int i = 0; i < N_IN; ++i) tab[i] = p.in[i];
        }
        if (p.ph_hi > 1) xcd_barrier(xbar);
        if (p.ph_hi < 0) cg::this_grid().sync();
    }
    for (int ph = p.ph_lo > 1 ? p.ph_lo : 1; ph < p.ph_hi; ++ph) {
        unsigned ldsb = (unsigned)(size_t)(LAS unsigned char*)lds_raw; asm volatile("" : "+s"(ldsb));
        LAS unsigned char* lds = (LAS unsigned char*)(size_t)ldsb;
        volatile LAS int* slot = (volatile LAS int*)(lds + LDS_MISC);
        unsigned char* ws = p.ws; asm volatile("" : "+s"(ws));
        Ctx c; c.ws = ws; c.in.t = (const float* const*)(ws + WS_TAB); c.out = p.out;
        unsigned* ctl = (unsigned*)(ws + WS_CTL);
        int G = gridDim.x, bx = blockIdx.x; asm volatile("" : "+s"(G), "+s"(bx));
        {
            const int l = (ph - 1) / PH_PER_LAYER, st = (ph - 1) % PH_PER_LAYER;
#ifdef PROBE_SEL
            if (bx == 0) { volatile LAS unsigned long long* a_ = (volatile LAS unsigned long long*)(lds + LDS_MISC + 64); a_[1] = __builtin_amdgcn_s_memrealtime(); }
#endif
            switch (st) {
            case 0: {
                EpiBf16 E{PROJ, NINP, 0xffff};
                RUN_GEMM(EpiBf16, E, H, D, ws + WS_WIN + l * SZ_WIN, D, D, 0, MA / 256, NINP / 256);
                if (l == 0) {
                    const pg8::Gemm g{D, D, D}; MemKvOrder S{G, bx, (const char*)(ws + WS_MN), (const char*)(ws + WS_WKV)};
                    EpiBf16 E2{(bf16_t*)(ws + WS_MKV), 2048, 7};
                    pg8::gemm_phase<EpiBf16, MemKvOrder, true, true>(lds, g, S, E2);
                }
            } break;
            case 1: {
                unsigned* ctr = ctl + 64 * ph;
                constexpr int U_SBP = 384, U_SBS = U_SBP + DB * 6, U_GLA = U_SBS + NGU, U_POOL = U_GLA + MA / 64, U_KV = U_POOL + MA / 64;
                const int U_CV = U_KV + (l + 1 < DEPTH ? CV_UNITS : 0), U_MO = U_CV + (l == 0 ? 512 : 0), U_VT = U_MO + (l == 0 ? 512 : 0), U_ALL = U_VT;
                for (;;) {
                    const int q = next_work(ctr, slot); if (q >= U_ALL) break;
                    int u = q;
                    if (q >= DB * 6) { const int r = q - DB * 6, nbw = U_ALL - U_GLA, nva = U_GLA - DB * 6, ni = nbw < nva ? nbw : nva;
                        if (r < 2 * ni) u = (r & 1) ? DB * 6 + (r >> 1) : U_GLA + (r >> 1);
                        else { const int r2 = r - 2 * ni; u = r2 < nbw - ni ? U_GLA + ni + r2 : DB * 6 + ni + (r2 - (nbw - ni)); } }
#ifdef PROBE_SEL
                    const int ut_ = u < DB * 6 ? 10 : (u < U_SBS ? 11 : (u < U_GLA ? 12 : 13));
                    if (bx == 0 && ut_ == PROBE_SEL) { volatile LAS unsigned long long* a_ = (volatile LAS unsigned long long*)(lds + LDS_MISC + 64); a_[3] = __builtin_amdgcn_s_memrealtime(); }
#endif
                    if (u < DB * 6) sb_sample_unit(c, l, u / 6, u % 6, lds);
                    else if (u < U_SBS) { const int v = u - DB * 6, qb = 7 - v / 48, bh = v % 48; sb_prompt_unit(c, bh / 6, bh % 6, qb, lds); }
                    else if (u < U_GLA) gla_stage1_unit(c, l, u - U_SBS, lds);
                    else if (u < U_POOL) pool_unit(c, l, u - U_GLA);
                    else if (u < U_KV) kvout_unit(c, l, u - U_POOL);
                    else if (u < U_CV) conv_unit(c, l + 1, u - U_KV, lds);
                    else if (u < U_MO) memout_unit(c, u - U_CV);
                    else memvt_unit(c, u - U_MO);
#ifdef PROBE_SEL
                    if (bx == 0 && ut_ == PROBE_SEL) { volatile LAS unsigned long long* a_ = (volatile LAS unsigned long long*)(lds + LDS_MISC + 64); __hip_atomic_fetch_add((LAS unsigned long long*)a_, __builtin_amdgcn_s_memrealtime() - a_[3], __ATOMIC_RELAXED, __HIP_MEMORY_SCOPE_WORKGROUP); }
#endif
                }
            } break;
            case 2: gla_scan(c, l); break;
            case 3: {
                unsigned* ctr = ctl + 64 * ph;
                for (;;) { const int u = next_work(ctr, slot); if (u >= NGU) break; gla_stage3_unit(c, l, u, lds); }
            } break;
            case 4: {
                EpiGate E1{MERGED, PROJ, C_GA, 0}, E2{MERGED, PROJ, C_GB, 1}, E3{MERGED, PROJ, C_GCG, 1};
                RUN_GEMM(EpiGate, E1, ws + WS_OA, 384, ws + WS_WBA + l * SZ_WBA, 384, 384, 0, MP / 256, 4);
                RUN_GEMM(EpiGate, E2, ws + WS_POOLED, 256, ws + WS_WBB + l * SZ_WBB, 256, 256, 0, MP / 256, 4);
                RUN_GEMM(EpiGate, E3, ws + WS_OC, 384, ws + WS_WBC + l * SZ_WBA, 384, 384, 0, MP / 256, 4);
                { SkGate F1{MERGED, PROJ, C_GA, 0}, F2{MERGED, PROJ, C_GB, 1}, F3{MERGED, PROJ, C_GCG, 1};
                  skinny_gemm((const bf16_t*)(ws + WS_OA) + (size_t)MP * 384, 384, (const bf16_t*)(ws + WS_WBA + l * SZ_WBA), 384, 384, D, G, bx, lds, F1);
                  skinny_gemm((const bf16_t*)(ws + WS_POOLED) + (size_t)MP * 256, 256, (const bf16_t*)(ws + WS_WBB + l * SZ_WBB), 256, 256, D, G, bx, lds, F2);
                  skinny_gemm((const bf16_t*)(ws + WS_OC) + (size_t)MP * 384, 384, (const bf16_t*)(ws + WS_WBC + l * SZ_WBA), 384, 384, D, G, bx, lds, F3); }
            } break;
            case 5: { EpiBf16 E{Y, D, 0xffff}; RUN_GEMM(EpiBf16, E, MERGED, D, ws + WS_WMIX + l * SZ_WSQ, D, D, 0, MP / 256, 4);
                SkBf16 F{Y, D}; skinny_gemm((const bf16_t*)MERGED + (size_t)MP * D, D, (const bf16_t*)(ws + WS_WMIX + l * SZ_WSQ), D, D, D, G, bx, lds, F); } break;
            case 6: norm_phase(c, c.in[I_NMIXPOST] + l * D, false, G, bx); break;
            case 7: { EpiBf16 E{QB, D, 0xffff}; RUN_GEMM(EpiBf16, E, H, D, ws + WS_WXQ + l * SZ_WSQ, D, D, 0, MP / 256, 4);
                SkBf16 F{QB, D}; skinny_gemm((const bf16_t*)H + (size_t)MP * D, D, (const bf16_t*)(ws + WS_WXQ + l * SZ_WSQ), D, D, D, G, bx, lds, F); } break;
            case 8: {
                const pg8::Gemm g{256, D, 2048}; CrossOrder S{G, bx, (const char*)QB, (const char*)(ws + WS_MKV + (size_t)l * 2 * SZ_WKV), 0};
                EpiSoftmax E{PB, (LAS float*)(lds + LDS_X)};
                pg8::gemm_phase<EpiSoftmax, CrossOrder, true, true>(lds, g, S, E);
            } break;
            case 9: {
                const pg8::Gemm g{256, D, 2048}; CrossOrder S{G, bx, (const char*)PB, (const char*)(ws + WS_MEMVT + (size_t)l * SZ_WKV), 1};
                EpiBf16 E{OB, D, 0xffff};
                pg8::gemm_phase<EpiBf16, CrossOrder, true, true>(lds, g, S, E);
                for (int u = bx; u < DB * 4 * 2; u += G) { __syncthreads(); cross_sample_unit(c, l, u >> 3, (u >> 1) & 3, u & 1, lds); }
            } break;
            case 10: { EpiBf16 E{Y, D, 0xffff}; RUN_GEMM(EpiBf16, E, OB, D, ws + WS_WXO + l * SZ_WSQ, D, D, 0, MP / 256, 4);
                SkBf16 F{Y, D}; skinny_gemm((const bf16_t*)OB + (size_t)MP * D, D, (const bf16_t*)(ws + WS_WXO + l * SZ_WSQ), D, D, D, G, bx, lds, F); } break;
            case 11: norm_phase(c, c.in[I_NXPOST] + l * D, false, G, bx); break;
            case 12: { EpiSwiglu E{ACT}; RUN_GEMM(EpiSwiglu, E, H, D, ws + WS_WF1 + l * SZ_WF1, D, D, 0, MA / 256, FF2 / 256); } break;
            case 13: { EpiBf16 E{Y, D, 0xffff}; RUN_GEMM(EpiBf16, E, ACT, FF, ws + WS_WF2 + l * SZ_WF2, FF, FF, 0, MP / 256, 4);
                SkBf16 F{Y, D}; skinny_gemm((const bf16_t*)ACT + (size_t)MP * FF, FF, (const bf16_t*)(ws + WS_WF2 + l * SZ_WF2), FF, FF, D, G, bx, lds, F); } break;
            default: norm_phase(c, c.in[I_NFPOST] + l * D, l == DEPTH - 1, G, bx); break;
            }
#ifdef PROBE_SEL
            {
                const int sel = PROBE_SEL; bool hit = false;
                if (sel == 2) hit = (st == 0 || st == 4 || st == 5 || st == 7 || st == 10 || st == 12 || st == 13);
                if (sel == 3) hit = (st == 2 || st == 3);
                if (sel == 4) hit = (st == 8 || st == 9);
                if (sel == 5) hit = (st == 6 || st == 11 || st == 14);
                if (sel == 6) hit = (st == 1);
                if (sel == 7) hit = (st == 0);
                if (sel == 8) hit = (st == 12);
                if (sel == 9) hit = (st == 13);
                if (bx == 0 && hit) { volatile LAS unsigned long long* a_ = (volatile LAS unsigned long long*)(lds + LDS_MISC + 64); __hip_atomic_fetch_add((LAS unsigned long long*)a_, __builtin_amdgcn_s_memrealtime() - a_[1], __ATOMIC_RELAXED, __HIP_MEMORY_SCOPE_WORKGROUP); }
            }
#endif
        }
#ifdef PROBE_SEL
        if (bx == 0) { volatile LAS unsigned long long* a_ = (volatile LAS unsigned long long*)(lds + LDS_MISC + 64); a_[2] = __builtin_amdgcn_s_memrealtime(); }
#endif
        if (ph + 1 < p.ph_hi) { if ((ph - 1) % PH_PER_LAYER == 8) { asm volatile("s_waitcnt vmcnt(0)" ::: "memory"); __syncthreads(); __builtin_amdgcn_fence(__ATOMIC_ACQUIRE, "agent"); }   else xcd_barrier(xbar); }
#ifdef PROBE_SEL
        if (PROBE_SEL == 1 && bx == 0) { volatile LAS unsigned long long* a_ = (volatile LAS unsigned long long*)(lds + LDS_MISC + 64); __hip_atomic_fetch_add((LAS unsigned long long*)a_, __builtin_amdgcn_s_memrealtime() - a_[2], __ATOMIC_RELAXED, __HIP_MEMORY_SCOPE_WORKGROUP); }
#endif
    }
#ifdef PROBE_SEL
    __syncthreads();
    if (blockIdx.x == 0) {
        volatile LAS unsigned long long* a_ = (volatile LAS unsigned long long*)((LAS unsigned char*)lds_raw + LDS_MISC + 64);
        const unsigned long long d_ = a_[0] >> 9, s_ = __builtin_amdgcn_s_memrealtime();
        while (__builtin_amdgcn_s_memrealtime() - s_ < d_) __builtin_amdgcn_s_sleep(8);
    }
#endif
}

extern "C" void kernel_launch(void* const* d_in, const int* in_sizes, int n_in, void* d_out, int out_size, void* d_ws, size_t ws_size, hipStream_t stream) {
    static int grid = 0;
    if (grid == 0) {
        if (n_in != N_IN || (size_t)out_size != O_END || ws_size < WS_END) { fprintf(stderr, "kernel_launch: unexpected shapes: n_in %d out %d ws %zu (need %zu)\n", n_in, out_size, ws_size, (size_t)WS_END); grid = -1; return; }
        int dev = 0, cus = 0, per_cu = 0;
        (void)hipGetDevice(&dev); (void)hipDeviceGetAttribute(&cus, hipDeviceAttributeMultiprocessorCount, dev);
        (void)hipFuncSetAttribute((const void*)fwd_kernel, hipFuncAttributeMaxDynamicSharedMemorySize, LDS_BYTES);
        if (hipOccupancyMaxActiveBlocksPerMultiprocessor(&per_cu, (const void*)fwd_kernel, NTHR, LDS_BYTES) != hipSuccess || per_cu < 1) { fprintf(stderr, "kernel_launch: occupancy query gave %d\n", per_cu); per_cu = 1; }
        (void)hipGetLastError();
        grid = cus * per_cu;
    }
    if (grid < 0) return;
    (void)hipMemsetAsync((char*)d_ws + WS_CTL, 0, CTL_BYTES, stream);
    Params p{};
    for (int i = 0; i < N_IN; ++i) p.in[i] = (const float*)d_in[i];
    p.out = (float*)d_out; p.ws = (unsigned char*)d_ws;
#ifdef MULTI_LAUNCH
    for (int ph = 0; ph < N_PHASES; ++ph) { p.ph_lo = ph; p.ph_hi = ph + 1; hipLaunchKernelGGL(fwd_kernel, dim3(grid), dim3(NTHR), LDS_BYTES, stream, p); }
#else
    p.ph_lo = 0; p.ph_hi = N_PHASES;
    void* args[] = {&p};
    const hipError_t e = hipLaunchCooperativeKernel((const void*)fwd_kernel, dim3(grid), dim3(NTHR), args, LDS_BYTES, stream);
    if (e != hipSuccess) fprintf(stderr, "kernel_launch: cooperative launch failed: %s (grid %d)\n", hipGetErrorString(e), grid);
#endif
}
```

```cpp
#include <hip/hip_runtime.h>
#include <hip/hip_cooperative_groups.h>
#include <cstdio>
#include <cstdint>
namespace cg = cooperative_groups;

namespace pg8 {
#define PG8_LAS __attribute__((address_space(3)))
typedef unsigned short bf16_t;
typedef short bf16x8 __attribute__((ext_vector_type(8)));
typedef float f32x4 __attribute__((ext_vector_type(4)));
typedef unsigned u32x4 __attribute__((ext_vector_type(4)));
typedef unsigned u32x2 __attribute__((ext_vector_type(2)));
constexpr int BM = 256, BK = 64, HALF = 128, HTB = HALF * BK * 2  , STAGE_BYTES = 8 * HTB, NXCD = 8, WGM = 4;

__host__ __device__ __forceinline__ int lds_byte(int r, int c) { const int st = (r >> 4) * 2 + (c >> 5), rr = r & 15, cc = c & 31, ob = rr * 64 + cc * 2; return st * 1024 + (ob ^ (((ob >> 9) & 1) << 5)); }
__host__ __device__ __forceinline__ void stage_rc(int b, int& R, int& C) { const int st = b / 1024, sb = b % 1024, swz = sb ^ (((sb >> 9) & 1) << 5); R = (st >> 1) * 16 + swz / 64; C = (st & 1) * 32 + (swz % 64) / 2; }
__host__ __device__ __forceinline__ int perm32(int rho) { const int n = rho >> 4, i = rho & 15; return 8 * (i >> 2) + 4 * n + (i & 3); }

struct Unit { int pm, pn; const char* a; const char* b; };
struct Gemm { int K, lda, ldb; };

struct TileOrder {
    int nM, nN, G, c, lda, ldb; const char* A; const char* B;
    __device__ void init(const void* A_, int lda_, const void* B_, int ldb_, int, int nM_, int nN_, int G_, int c_) {
        A = (const char*)A_; B = (const char*)B_; lda = lda_; ldb = ldb_; nM = nM_; nN = nN_; G = G_; c = c_; }
    __device__ bool next(int i, Unit& u) const {
        const int nwg = nM * nN; const long L = (long)i * G + c; if (L >= nwg) return false;
        int wgid = (int)L; { const int q = nwg / NXCD, r = nwg % NXCD, xcd = wgid % NXCD, off = wgid / NXCD; wgid = (xcd < r ? xcd * (q + 1) : r * (q + 1) + (xcd - r) * q) + off; }
        const int nig = WGM * nN, gid = wgid / nig, fm = gid * WGM, gsz = (nM - fm) < WGM ? (nM - fm) : WGM;
        u.pm = fm + ((wgid % nig) % gsz); u.pn = (wgid % nig) / gsz; u.a = A + (size_t)u.pm * ((size_t)BM * 2 * lda); u.b = B + (size_t)u.pn * ((size_t)BM * 2 * ldb); return true;
    }
    __device__ __forceinline__ void a_ready(const Unit&) const {}
    __device__ __forceinline__ void done(const Unit&) const {}
};

__device__ __forceinline__ int tid_() { int t = threadIdx.x; asm volatile("" : "+v"(t)); return t; }
__device__ __forceinline__ unsigned cvt_pk_bf16(float lo, float hi) { unsigned r; asm volatile("v_cvt_pk_bf16_f32 %0, %1, %2" : "=v"(r) : "v"(lo), "v"(hi)); return r; }

template <class Epi, class Sched, bool ALIGN_EPI = false, bool SP2 = false>
__device__ __forceinline__ void gemm_phase(PG8_LAS unsigned char* lds, const Gemm g, const Sched& S, const Epi& E) {
    const int tid = pg8::tid_(), wid = __builtin_amdgcn_readfirstlane(tid >> 6), lane = tid & 63, wr = wid >> 2, wc = wid & 3, fr = lane & 15, fq = lane >> 4;
    const int K = g.K, nt = K / BK;
    unsigned voffA, voffB;
    { int R, C; stage_rc(tid * 16, R, C); const int Rb = Epi::PERM ? ((R & ~31) + perm32(R & 31)) : R;
        voffA = (unsigned)(R * g.lda + C) * 2u; voffB = (unsigned)(Rb * g.ldb + C) * 2u; }
    const size_t qstepA = (size_t)64 * g.lda * 2, qstepB = (size_t)64 * g.ldb * 2;
    const size_t kstep = (size_t)(BK * 2);
    const size_t hstepA = (size_t)HALF * g.lda * 2, hstepB = (size_t)HALF * g.ldb * 2;
    const unsigned ldsw = (unsigned)wid * 1024u;
    const int aoff = lds_byte(wr * 64 + fr, fq * 8), boff = lds_byte(wc * 32 + fr, fq * 8);
#define PG8_SA(b, h) (((b) * 2 + (h)) * HTB)
#define PG8_SB(b, h) ((4 + (b) * 2 + (h)) * HTB)
#define PG8_STAGE(bufoff, gbase, voff) do { _Pragma("unroll") for (int _i = 0; _i < 2; ++_i) { const char* sb_ = (const char*)(gbase) + (size_t)_i * q##voff; asm volatile("" : "+s"(sb_));   \
        __builtin_amdgcn_global_load_lds((const unsigned*)(sb_ + (voff)), (PG8_LAS unsigned*)(lds + (bufoff) + ldsw + _i * 8192), 16, 0, 0); } } while (0)
#define qvoffA qstepA
#define qvoffB qstepB
#define PG8_LDA(dst, b, h) do { _Pragma("unroll") for (int m = 0; m < 4; ++m) _Pragma("unroll") for (int k = 0; k < 2; ++k) dst[m][k] = *(const PG8_LAS bf16x8*)(lds + PG8_SA(b, h) + aoff + m * 2048 + k * 1024); } while (0)
#define PG8_LDB(dst, b, h) do { _Pragma("unroll") for (int n = 0; n < 2; ++n) _Pragma("unroll") for (int k = 0; k < 2; ++k) dst[n][k] = *(const PG8_LAS bf16x8*)(lds + PG8_SB(b, h) + boff + n * 2048 + k * 1024); } while (0)
#define PG8_MMA(ai, bj, At, Bt) do { __builtin_amdgcn_s_setprio(1); _Pragma("unroll") for (int m = 0; m < 4; ++m) _Pragma("unroll") for (int n = 0; n < 2; ++n) _Pragma("unroll") for (int k = 0; k < 2; ++k) \
        acc[ai][bj][m][n] = __builtin_amdgcn_mfma_f32_16x16x32_bf16(Bt[n][k], At[m][k], acc[ai][bj][m][n], 0, 0, 0); __builtin_amdgcn_s_setprio(0); } while (0)
#define PG8_WAIT_V(n) asm volatile("s_waitcnt vmcnt(" #n ")" ::: "memory")
#define PG8_WAIT_L(n) asm volatile("s_waitcnt lgkmcnt(" #n ")" ::: "memory")
#define PG8_BAR __builtin_amdgcn_s_barrier()
#define PG8_SCHED __builtin_amdgcn_sched_barrier(0)
    Unit cur, nxt; int ui = 0;
    if (!S.next(0, cur)) return;
    f32x4 acc[2][2][4][2];
#pragma unroll
    for (int a = 0; a < 2; ++a)
#pragma unroll
        for (int b = 0; b < 2; ++b)
#pragma unroll
            for (int m = 0; m < 4; ++m)
#pragma unroll
                for (int n = 0; n < 2; ++n) acc[a][b][m][n] = (f32x4){0.f, 0.f, 0.f, 0.f};
    bf16x8 At[4][2], B0[2][2], B1[2][2];
    const char* cA = cur.a; const char* cB = cur.b;
    S.a_ready(cur);
    if constexpr (SP2) {
        PG8_STAGE(PG8_SB(0, 0), cB, voffB); PG8_STAGE(PG8_SB(0, 1), cB + hstepB, voffB); PG8_STAGE(PG8_SA(0, 0), cA, voffA); PG8_STAGE(PG8_SA(0, 1), cA + hstepA, voffA);
        if (wr == 1) PG8_BAR;
        PG8_WAIT_V(2); PG8_BAR;
        PG8_STAGE(PG8_SB(1, 0), cB + kstep, voffB); PG8_STAGE(PG8_SA(1, 0), cA + kstep, voffA); PG8_STAGE(PG8_SB(1, 1), cB + hstepB + kstep, voffB);
        PG8_WAIT_V(6); PG8_BAR;
    } else {
        PG8_STAGE(PG8_SB(0, 0), cB, voffB); PG8_STAGE(PG8_SA(0, 0), cA, voffA); PG8_STAGE(PG8_SB(0, 1), cB + hstepB, voffB); PG8_STAGE(PG8_SA(0, 1), cA + hstepA, voffA);
        if (wr == 1) PG8_BAR;
        PG8_WAIT_V(4); PG8_BAR;
        PG8_STAGE(PG8_SB(1, 0), cB + kstep, voffB); PG8_STAGE(PG8_SA(1, 0), cA + kstep, voffA); PG8_STAGE(PG8_SB(1, 1), cB + hstepB + kstep, voffB);
        PG8_WAIT_V(6); PG8_BAR;
    }
    for (;;) {
        const bool has_next = S.next(ui + 1, nxt);
        const char* nA = has_next ? nxt.a : cA; const char* nB = has_next ? nxt.b : cB;
        for (int t = 0; t < nt; t += 2) {
            const bool last = (t == nt - 2);
            const char* a1 = cA + (size_t)(t + 1) * kstep;
            const char* a2 = last ? nA : cA + (size_t)(t + 2) * kstep; const char* b2 = last ? nB : cB + (size_t)(t + 2) * kstep;
            const char* a3 = a2 + kstep; const char* b3 = b2 + kstep;
            if (last && has_next) S.a_ready(nxt);
            if constexpr (SP2) {
            PG8_LDB(B0, 0, 0); PG8_LDB(B1, 0, 1); PG8_SCHED; PG8_LDA(At, 0, 0); PG8_STAGE(PG8_SA(1, 1), a1 + hstepA, voffA);
            PG8_WAIT_V(8); PG8_WAIT_L(0); PG8_BAR; PG8_MMA(0, 0, At, B0); PG8_MMA(0, 1, At, B1); PG8_BAR; PG8_SCHED;
            PG8_LDA(At, 0, 1); PG8_STAGE(PG8_SB(0, 0), b2, voffB); PG8_STAGE(PG8_SB(0, 1), b2 + hstepB, voffB); PG8_STAGE(PG8_SA(0, 0), a2, voffA);
            PG8_WAIT_V(8); PG8_WAIT_L(0); PG8_BAR; PG8_MMA(1, 0, At, B0); PG8_MMA(1, 1, At, B1); PG8_BAR; PG8_SCHED;
            PG8_LDB(B0, 1, 0); PG8_LDB(B1, 1, 1); PG8_SCHED; PG8_LDA(At, 1, 0); PG8_STAGE(PG8_SA(0, 1), a2 + hstepA, voffA);
            PG8_WAIT_V(8); PG8_WAIT_L(0); PG8_BAR; PG8_MMA(0, 0, At, B0); PG8_MMA(0, 1, At, B1); PG8_BAR; PG8_SCHED;
            PG8_LDA(At, 1, 1); PG8_STAGE(PG8_SB(1, 0), b3, voffB); PG8_STAGE(PG8_SB(1, 1), b3 + hstepB, voffB); PG8_STAGE(PG8_SA(1, 0), a3, voffA);
            PG8_WAIT_V(8); PG8_WAIT_L(0); PG8_BAR; PG8_MMA(1, 0, At, B0); PG8_MMA(1, 1, At, B1); PG8_BAR; PG8_SCHED;
            } else {
            PG8_LDB(B0, 0, 0); PG8_SCHED; PG8_LDA(At, 0, 0); PG8_STAGE(PG8_SA(1, 1), a1 + hstepA, voffA);
            PG8_WAIT_L(8); PG8_BAR; PG8_WAIT_L(0); PG8_MMA(0, 0, At, B0); PG8_BAR; PG8_SCHED;
            PG8_LDB(B1, 0, 1); PG8_STAGE(PG8_SB(0, 0), b2, voffB);
            PG8_BAR; PG8_WAIT_L(0); PG8_MMA(0, 1, At, B1); PG8_BAR;
            PG8_LDA(At, 0, 1); PG8_STAGE(PG8_SA(0, 0), a2, voffA);
            PG8_BAR; PG8_WAIT_L(0); PG8_MMA(1, 0, At, B0); PG8_BAR; PG8_SCHED;
            PG8_STAGE(PG8_SB(0, 1), b2 + hstepB, voffB);
            PG8_WAIT_V(6); PG8_BAR; PG8_MMA(1, 1, At, B1); PG8_BAR;
            PG8_LDB(B0, 1, 0); PG8_SCHED; PG8_LDA(At, 1, 0); PG8_STAGE(PG8_SA(0, 1), a2 + hstepA, voffA);
            PG8_WAIT_L(8); PG8_BAR; PG8_WAIT_L(0); PG8_MMA(0, 0, At, B0); PG8_BAR; PG8_SCHED;
            PG8_LDB(B1, 1, 1); PG8_STAGE(PG8_SB(1, 0), b3, voffB);
            PG8_BAR; PG8_WAIT_L(0); PG8_MMA(0, 1, At, B1); PG8_BAR;
            PG8_LDA(At, 1, 1); PG8_STAGE(PG8_SA(1, 0), a3, voffA);
            PG8_BAR; PG8_WAIT_L(0); PG8_MMA(1, 0, At, B0); PG8_BAR; PG8_SCHED;
            PG8_STAGE(PG8_SB(1, 1), b3 + hstepB, voffB);
            PG8_WAIT_V(6); PG8_BAR; PG8_MMA(1, 1, At, B1); PG8_BAR;
            }
        }
        if constexpr (ALIGN_EPI) { if (wr == 0) PG8_BAR; }
        if constexpr (!Epi::AFTER_DRAIN) { const int l2_ = tid_() & 63, fr2 = l2_ & 15, fq2 = l2_ >> 4;   E(acc, cur, wr, wc, fr2, fq2); S.done(cur); }
        if (!has_next) break;
#pragma unroll
        for (int a = 0; a < 2; ++a)
#pragma unroll
            for (int b = 0; b < 2; ++b)
#pragma unroll
                for (int m = 0; m < 4; ++m)
#pragma unroll
                    for (int n = 0; n < 2; ++n) acc[a][b][m][n] = (f32x4){0.f, 0.f, 0.f, 0.f};
        cur = nxt; cA = nA; cB = nB; ++ui;
        if constexpr (ALIGN_EPI) { if (wr == 1) PG8_BAR; }
    }
    PG8_WAIT_V(0);
    if constexpr (!ALIGN_EPI) { if (wr == 0) PG8_BAR; }
    PG8_BAR;
    if constexpr (Epi::AFTER_DRAIN) { E.fused(acc, cur, wr, wc, fr, fq, lds, wid, lane); S.done(cur); }
#undef PG8_SA
#undef PG8_SB
#undef PG8_STAGE
#undef qvoffA
#undef qvoffB
#undef PG8_LDA
#undef PG8_LDB
#undef PG8_MMA
#undef PG8_WAIT_V
#undef PG8_WAIT_L
#undef PG8_BAR
#undef PG8_SCHED
}
}

using pg8::bf16_t; using pg8::f32x4; using pg8::bf16x8; using pg8::u32x4; using pg8::u32x2;
#define DI __device__ __forceinline__
#define LAS __attribute__((address_space(3)))
typedef float f32x16 __attribute__((ext_vector_type(16)));
typedef short s16x4 __attribute__((ext_vector_type(4)));
typedef float f32x2_t __attribute__((ext_vector_type(2))); typedef __bf16 bf16x2_t __attribute__((ext_vector_type(2)));

constexpr int NTHR = 512, NWAVES = 8;
constexpr int D = 1024, NB = 8, SEQ = 2048, DEPTH = 4, DB = 16, DT = 16, PAST = 1024;
constexpr int MP = NB * SEQ, MS = DB * DT, MA = MP + MS;
constexpr int NIN = 6032, NINP = 6144;
constexpr int C_QA = 0, C_KA = 384, C_VA = 768, C_U = 1152, C_QC = 1408, C_KC = 1792, C_VC = 2176, C_GC = 2560, C_LR = 2944, C_GA = 2960, C_GB = 3984, C_GCG = 5008;
constexpr int FF = 2816, FF2 = 5632;
constexpr int GH = 4, GK = 96;
constexpr int NGU_P = NB * GH * 32, NGU_S = DB * GH, NGU = NGU_P + NGU_S;
constexpr float EPS = 1e-6f;

constexpr size_t O_YP = 0, O_YS = O_YP + (size_t)MP * D, O_KP = O_YS + (size_t)MS * D, O_VP = O_KP + (size_t)DEPTH * MP * 384, O_POOLP = O_VP + (size_t)DEPTH * MP * 384,
    O_GLAP = O_POOLP + (size_t)DEPTH * NB * 15 * 256, O_MKP = O_GLAP + (size_t)DEPTH * NB * GH * GK * GK, O_MVP = O_MKP + (size_t)DEPTH * NB * 256 * D,
    O_KS = O_MVP + (size_t)DEPTH * NB * 256 * D, O_VS = O_KS + (size_t)DEPTH * MS * 384, O_POOLS = O_VS + (size_t)DEPTH * MS * 384, O_GLAS = O_POOLS + (size_t)DEPTH * DB * 15 * 256,
    O_END = O_GLAS + (size_t)DEPTH * DB * GH * GK * GK;

enum { I_XP = 0, I_XS, I_MEM, I_CSK, I_CSV, I_SPOOL, I_SGLA, I_CMK, I_CMV, I_WIN, I_WA2, I_BA, I_GLAN, I_WPOOL, I_PSCALE, I_WBA, I_WBB, I_WBC, I_WMIX, I_MEMN, I_WXQ, I_WXK, I_WXV, I_WXO,
       I_WF1, I_WF2, I_NMIXPRE, I_NMIXPOST, I_NXPRE, I_NXPOST, I_NFPRE, I_NFPOST, N_IN };

constexpr size_t MiB = 1u << 20;
constexpr size_t SZ_WIN = (size_t)NINP * D * 2, SZ_WBA = (size_t)D * 384 * 2, SZ_WBB = (size_t)D * 256 * 2, SZ_WSQ = (size_t)D * D * 2, SZ_WKV = 2 * SZ_WSQ, SZ_WF1 = (size_t)FF2 * D * 2, SZ_WF2 = (size_t)D * FF * 2;
constexpr size_t WS_CTL = 0, CTL_BYTES = 1 * MiB, WS_TAB = CTL_BYTES - 4096;
constexpr size_t WS_WIN = WS_CTL + CTL_BYTES, WS_WBA = WS_WIN + 4 * SZ_WIN, WS_WBB = WS_WBA + 4 * SZ_WBA, WS_WBC = WS_WBB + 4 * SZ_WBB, WS_WMIX = WS_WBC + 4 * SZ_WBA,
    WS_WXQ = WS_WMIX + 4 * SZ_WSQ, WS_WXO = WS_WXQ + 4 * SZ_WSQ, WS_WKV = WS_WXO + 4 * SZ_WSQ, WS_WF1 = WS_WKV + 4 * SZ_WKV, WS_WF2 = WS_WF1 + 4 * SZ_WF1,
    WS_MN = WS_WF2 + 4 * SZ_WF2, WS_MKV = WS_MN + 4 * SZ_WKV, WS_MEMVT = WS_MKV + 8 * SZ_WKV, WS_PROJ = WS_MEMVT + 4 * SZ_WKV;
constexpr size_t SZ_ROWS = (size_t)MA * D * 2;
constexpr size_t SZ_PROJ = (size_t)MA * NINP * 2;
constexpr size_t WS_Q = WS_PROJ, WS_P = WS_Q + SZ_ROWS, WS_O = WS_P + SZ_ROWS, WS_ACT = WS_O + SZ_ROWS;
static_assert(WS_ACT + (size_t)MA * FF * 2 <= WS_PROJ + SZ_PROJ, "overlay fits");
constexpr size_t WS_H = WS_PROJ + SZ_PROJ, WS_MERGED = WS_H + SZ_ROWS, WS_Y = WS_MERGED + SZ_ROWS;
constexpr size_t WS_GKV = WS_H, WS_GSP = WS_GKV + 39 * MiB, WS_GDEC = WS_GSP + 37 * MiB;
static_assert((size_t)NGU * GK * GK * 4 <= 39 * MiB && (size_t)NGU_P * GK * GK * 4 <= 37 * MiB && WS_GDEC + (size_t)NGU * GK * 4 <= WS_Y + SZ_ROWS, "GLA overlay fits");
constexpr size_t WS_OA = WS_Y + SZ_ROWS, WS_POOLED = WS_OA + (size_t)MA * 384 * 2, WS_OC = WS_POOLED + (size_t)MA * 256 * 2, WS_BB = WS_OC + (size_t)MA * 384 * 2, WS_XB = WS_BB + (size_t)NGU * 64 * GK * 4, WS_RN = WS_XB + SZ_ROWS, WS_END = WS_RN + (size_t)MA * 4;
static_assert(WS_WIN % 256 == 0 && WS_PROJ % 256 == 0 && WS_H % 256 == 0 && WS_OA % 256 == 0 && WS_POOLED % 256 == 0 && WS_OC % 256 == 0 && WS_P % 256 == 0, "alignment");

constexpr int CW_BAR = 16384;
constexpr int LDS_GEMM = 131072, LDS_X = LDS_GEMM, LDS_X_BYTES = 12288, LDS_MISC = LDS_X + LDS_X_BYTES, LDS_BYTES = LDS_MISC + 256;

struct Params { const float* in[N_IN]; float* out; unsigned char* ws; int ph_lo, ph_hi; };
struct InTab { const float* const* t;
    __device__ __forceinline__ const float* operator[](int i) const { const unsigned long long v = (unsigned long long)t[i];
        const unsigned lo = __builtin_amdgcn_readfirstlane((unsigned)v), hi = __builtin_amdgcn_readfirstlane((unsigned)(v >> 32)); return (const float*)(((unsigned long long)hi << 32) | lo); } };
struct Ctx { InTab in; float* out; unsigned char* ws; };

DI float bflo(unsigned w) { return __uint_as_float(w << 16); }
DI float bfhi(unsigned w) { return __uint_as_float(w & 0xffff0000u); }
DI float bf2f(unsigned short v) { return __uint_as_float((unsigned)v << 16); }
DI unsigned pk2(float lo, float hi) { f32x2_t v = {lo, hi}; bf16x2_t b = __builtin_convertvector(v, bf16x2_t); return __builtin_bit_cast(unsigned, b); }
DI unsigned short f2bf(float f) { return (unsigned short)(pk2(f, 0.f) & 0xffffu); }
DI float wave_sum(float v) {
#pragma unroll
    for (int o = 1; o < 64; o <<= 1) v += __shfl_xor(v, o);
    return v;
}
DI float wave_max(float v) {
#pragma unroll
    for (int o = 1; o < 64; o <<= 1) v = fmaxf(v, __shfl_xor(v, o));
    return v;
}
DI float sigmoidf_(float x) { return __builtin_amdgcn_rcpf(1.f + __expf(-x)); }
DI float softplusf_(float z) { return fmaxf(z, 0.f) + __logf(1.f + __expf(-fabsf(z))); }
DI int next_work(unsigned* ctr, volatile LAS int* slot) {
    __syncthreads();
    if (pg8::tid_() == 0) *slot = (int)atomicAdd(ctr, 1u);
    __syncthreads();
    return *slot;
}

typedef const pg8::f32x4 (&AccRef)[2][2][4][2];
struct EpiBf16 {
    static constexpr bool PERM = true, AFTER_DRAIN = false;
    bf16_t* O; int ldc; int pnmask;
    DI void operator()(AccRef acc, const pg8::Unit& u, int wr, int wc, int fr, int fq) const {
#pragma unroll
        for (int ai = 0; ai < 2; ++ai)
#pragma unroll
            for (int m = 0; m < 4; ++m) {
                bf16_t* rowp = O + (size_t)(u.pm * 256 + ai * 128 + wr * 64 + m * 16 + fr) * ldc + (u.pn & pnmask) * 256 + wc * 32 + 8 * fq;
#pragma unroll
                for (int bj = 0; bj < 2; ++bj) {
                    const f32x4 v0 = acc[ai][bj][m][0], v1 = acc[ai][bj][m][1];
                    u32x4 w; w.x = pk2(v0[0], v0[1]); w.y = pk2(v0[2], v0[3]); w.z = pk2(v1[0], v1[1]); w.w = pk2(v1[2], v1[3]);
                    *(u32x4*)(rowp + bj * 128) = w;
                }
            }
    }
};
struct EpiGate {
    static constexpr bool PERM = true, AFTER_DRAIN = false;
    bf16_t* merged; const bf16_t* proj; int goff; int accum;
    DI void operator()(AccRef acc, const pg8::Unit& u, int wr, int wc, int fr, int fq) const {
#pragma unroll
        for (int ai = 0; ai < 2; ++ai)
#pragma unroll
            for (int m = 0; m < 4; ++m) {
                const int row = u.pm * 256 + ai * 128 + wr * 64 + m * 16 + fr;
                const bf16_t* gp = proj + (size_t)row * NINP + goff + u.pn * 256 + wc * 32 + 8 * fq;
                bf16_t* mp = merged + (size_t)row * D + u.pn * 256 + wc * 32 + 8 * fq;
                u32x4 g[2], pm4[2];
#pragma unroll
                for (int bj = 0; bj < 2; ++bj) { g[bj] = *(const u32x4*)(gp + bj * 128); pm4[bj] = (u32x4){0u, 0u, 0u, 0u}; if (accum) pm4[bj] = *(const u32x4*)(mp + bj * 128); }
#pragma unroll
                for (int bj = 0; bj < 2; ++bj) {
                    const f32x4 v0 = acc[ai][bj][m][0], v1 = acc[ai][bj][m][1];
                    u32x4 w;
                    w.x = pk2(sigmoidf_(bflo(g[bj].x)) * v0[0] + bflo(pm4[bj].x), sigmoidf_(bfhi(g[bj].x)) * v0[1] + bfhi(pm4[bj].x));
                    w.y = pk2(sigmoidf_(bflo(g[bj].y)) * v0[2] + bflo(pm4[bj].y), sigmoidf_(bfhi(g[bj].y)) * v0[3] + bfhi(pm4[bj].y));
                    w.z = pk2(sigmoidf_(bflo(g[bj].z)) * v1[0] + bflo(pm4[bj].z), sigmoidf_(bfhi(g[bj].z)) * v1[1] + bfhi(pm4[bj].z));
                    w.w = pk2(sigmoidf_(bflo(g[bj].w)) * v1[2] + bflo(pm4[bj].w), sigmoidf_(bfhi(g[bj].w)) * v1[3] + bfhi(pm4[bj].w));
                    *(u32x4*)(mp + bj * 128) = w;
                }
                if (m & 1) asm volatile("" ::: "memory");
            }
    }
};
struct EpiSwiglu {
    static constexpr bool PERM = true, AFTER_DRAIN = false;
    bf16_t* act;
    DI void operator()(AccRef acc, const pg8::Unit& u, int wr, int wc, int fr, int fq) const {
#pragma unroll
        for (int ai = 0; ai < 2; ++ai)
#pragma unroll
            for (int m = 0; m < 4; ++m) {
                const int row = u.pm * 256 + ai * 128 + wr * 64 + m * 16 + fr;
#pragma unroll
                for (int bj = 0; bj < 2; ++bj) {
                    const int col0 = u.pn * 256 + bj * 128 + wc * 32 + 8 * fq;
                    const f32x4 g = acc[ai][bj][m][0], up = acc[ai][bj][m][1];
                    float r[4];
#pragma unroll
                    for (int j = 0; j < 4; ++j) r[j] = g[j] * sigmoidf_(g[j]) * up[j];
                    u32x2 w; w.x = pk2(r[0], r[1]); w.y = pk2(r[2], r[3]);
                    *(u32x2*)(act + (size_t)row * FF + (col0 >> 1)) = w;
                }
            }
    }
};
struct MemKvOrder {
    int G, c; const char* A; const char* B;
    DI bool next(int i, pg8::Unit& u) const {
        const int L = i * G + c; if (L >= 256) return false;
        const int l = L >> 6, r = L & 63; u.pm = l * 8 + (r & 7); u.pn = l * 8 + (r >> 3);
        u.a = A + (size_t)u.pm * (256 * D * 2); u.b = B + (size_t)u.pn * (256 * D * 2); return true;
    }
    DI void a_ready(const pg8::Unit&) const {}
    DI void done(const pg8::Unit&) const {}
};
struct CrossOrder {
    int G, c; const char* A; const char* B; int mode;
    DI bool next(int i, pg8::Unit& u) const {
        const int L = i * G + c; if (L >= 256) return false;
        u.pm = L >> 2; u.pn = L & 3; const int b = u.pm >> 3, h = u.pn;
        u.a = A + ((size_t)u.pm * 256 * D + h * 256) * 2;
        u.b = mode == 0 ? B + ((size_t)b * 256 * 2048 + h * 256) * 2 : B + ((size_t)h * 256 * 2048 + b * 256) * 2;
        return true;
    }
    DI void a_ready(const pg8::Unit&) const {}
    DI void done(const pg8::Unit&) const {}
};
struct EpiSoftmax {
    static constexpr bool PERM = true, AFTER_DRAIN = false;
    bf16_t* P; LAS float* xs;
    DI void operator()(AccRef acc, const pg8::Unit& u, int wr, int wc, int fr, int fq) const {
        const float sc = 0.0625f * 1.4426950408889634f;
        LAS float* xm = xs; LAS float* xsum = xs + 1024;
#pragma unroll
        for (int ai = 0; ai < 2; ++ai)
#pragma unroll
            for (int m = 0; m < 4; ++m) {
                float a = -3.0e38f;
#pragma unroll
                for (int bj = 0; bj < 2; ++bj)
#pragma unroll
                    for (int n = 0; n < 2; ++n) { const f32x4 v = acc[ai][bj][m][n]; a = fmaxf(a, fmaxf(fmaxf(v[0], v[1]), fmaxf(v[2], v[3]))); }
                a = fmaxf(a, __shfl_xor(a, 16)); a = fmaxf(a, __shfl_xor(a, 32));
                if (fq == 0) xm[(ai * 128 + wr * 64 + m * 16 + fr) * 4 + wc] = a;
                asm volatile("" ::: "memory");
            }
        __syncthreads();
#pragma unroll
        for (int ai = 0; ai < 2; ++ai)
#pragma unroll
            for (int m = 0; m < 4; ++m) {
                const f32x4 t = *(LAS f32x4*)(xm + (ai * 128 + wr * 64 + m * 16 + fr) * 4); const float mx = fmaxf(fmaxf(t[0], t[1]), fmaxf(t[2], t[3])) * sc;
                float s = 0.f;
#pragma unroll
                for (int bj = 0; bj < 2; ++bj)
#pragma unroll
                    for (int n = 0; n < 2; ++n)
#pragma unroll
                        for (int j = 0; j < 4; ++j) s += __builtin_amdgcn_exp2f(acc[ai][bj][m][n][j] * sc - mx);
                s += __shfl_xor(s, 16); s += __shfl_xor(s, 32);
                if (fq == 0) xsum[(ai * 128 + wr * 64 + m * 16 + fr) * 4 + wc] = s;
                asm volatile("" ::: "memory");
            }
        __syncthreads();
#pragma unroll
        for (int ai = 0; ai < 2; ++ai)
#pragma unroll
            for (int m = 0; m < 4; ++m) {
                const f32x4 t = *(LAS f32x4*)(xm + (ai * 128 + wr * 64 + m * 16 + fr) * 4); const float mx = fmaxf(fmaxf(t[0], t[1]), fmaxf(t[2], t[3])) * sc;
                const f32x4 t2 = *(LAS f32x4*)(xsum + (ai * 128 + wr * 64 + m * 16 + fr) * 4); const float inv = __builtin_amdgcn_rcpf((t2[0] + t2[1]) + (t2[2] + t2[3]));
                bf16_t* rowp = P + (size_t)(u.pm * 256 + ai * 128 + wr * 64 + m * 16 + fr) * D + u.pn * 256 + wc * 32 + 8 * fq;
#pragma unroll
                for (int bj = 0; bj < 2; ++bj)
#pragma unroll
                    for (int n = 0; n < 2; ++n) {
                        const f32x4 v = acc[ai][bj][m][n];
                        u32x2 w; w.x = pk2(__builtin_amdgcn_exp2f(v[0] * sc - mx) * inv, __builtin_amdgcn_exp2f(v[1] * sc - mx) * inv); w.y = pk2(__builtin_amdgcn_exp2f(v[2] * sc - mx) * inv, __builtin_amdgcn_exp2f(v[3] * sc - mx) * inv);
                        *(u32x2*)(rowp + bj * 128 + 4 * n) = w;
                    }
                asm volatile("" ::: "memory");
            }
        __syncthreads();
    }
};

#define XB_TMO      128
#define XB_XCNT(j)  (256  + 64 * (j))
#define XB_XSUB(j)  (1280 + 64 * (j))
#define XB_XGEN(j)  (2304 + 64 * (j))
#define XB_TOP      3328
#define XB_TOPGEN   3392
#define XCD_BAR_WORDS 3456
#define XB_SPIN_CAP (1u << 18)

__device__ __forceinline__ unsigned xb_ld(unsigned* p)              { return __hip_atomic_load(p, __ATOMIC_RELAXED, __HIP_MEMORY_SCOPE_AGENT); }
__device__ __forceinline__ unsigned xb_add(unsigned* p, unsigned v) { return __hip_atomic_fetch_add(p, v, __ATOMIC_RELAXED, __HIP_MEMORY_SCOPE_AGENT); }
__device__ __forceinline__ unsigned xb_xcc_id() { return (unsigned)__builtin_amdgcn_s_getreg((3 << 11) | 20) & 0xFu; }
#define XB_SPIN(cond, bar) do { unsigned _sp = 0; while (cond) { __builtin_amdgcn_s_sleep(1); \
    if ((++_sp & 255u) == 0u) { if (xb_ld(&(bar)[XB_TMO])) break; if (_sp > XB_SPIN_CAP) { atomicAdd(&(bar)[XB_TMO], 1u); break; } } } } while (0)

struct XcdBarrier {
    unsigned* bar; unsigned x;
    volatile LAS unsigned* st;
};

__device__ __forceinline__ XcdBarrier xcd_barrier_post(unsigned* bar, volatile LAS unsigned* st) {
    XcdBarrier b; b.bar = bar; b.x = xb_xcc_id(); b.st = st;
    if (threadIdx.x == 0) (void)xb_add(&bar[XB_XCNT(b.x)], 1u);
    return b;
}
__device__ __forceinline__ void xcd_barrier_complete(unsigned* bar, unsigned x, unsigned& nloc, unsigned& nx) {
    const unsigned G = gridDim.x * gridDim.y * gridDim.z;
    unsigned sum, cnt, mine, sp = 0u;
    for (;;) {
        sum = 0u; cnt = 0u; mine = 0u;
#pragma unroll
        for (unsigned j = 0; j < 16; ++j) { const unsigned c = xb_ld(&bar[XB_XCNT(j)]); sum += c; cnt += (c > 0u) ? 1u : 0u; mine = (j == x) ? c : mine; }
        if (sum == G) break;
        __builtin_amdgcn_s_sleep(1);
        if ((++sp & 255u) == 0u) { if (xb_ld(&bar[XB_TMO])) break; if (sp > XB_SPIN_CAP) { atomicAdd(&bar[XB_TMO], 1u); break; } }
    }
    nloc = mine > 0u ? mine : 1u; nx = cnt > 0u ? cnt : 1u;
}

__device__ __forceinline__ void xcd_barrier(const XcdBarrier& b) {
    asm volatile("s_waitcnt vmcnt(0)" ::: "memory");
    __syncthreads();
    if (threadIdx.x == 0) {
        unsigned* bar = b.bar;
        __builtin_amdgcn_s_waitcnt(0);
        unsigned nloc = b.st[0], nx = b.st[1];
        if (nloc == 0u) { xcd_barrier_complete(bar, b.x, nloc, nx); b.st[0] = nloc; b.st[1] = nx; }
        const unsigned old = xb_add(&bar[XB_XSUB(b.x)], 1u);
        const unsigned gen = old / nloc;
        if (old + 1u == (gen + 1u) * nloc) {
            __builtin_amdgcn_fence(__ATOMIC_RELEASE, "agent");
            asm volatile("s_waitcnt vmcnt(0)" ::: "memory");
            const unsigned og = xb_add(&bar[XB_TOP], 1u);
            const unsigned tg = og / nx;
            if (og + 1u == (tg + 1u) * nx) xb_add(&bar[XB_TOPGEN], 1u);
            else XB_SPIN(xb_ld(&bar[XB_TOPGEN]) == tg, bar);
            __builtin_amdgcn_fence(__ATOMIC_ACQUIRE, "agent");
            xb_add(&bar[XB_XGEN(b.x)], 1u);
            asm volatile("s_waitcnt vmcnt(0)" ::: "memory");
        } else {
            XB_SPIN(xb_ld(&bar[XB_XGEN(b.x)]) == gen, bar);
            __builtin_amdgcn_fence(__ATOMIC_ACQUIRE, "agent");
            asm volatile("s_waitcnt vmcnt(0)" ::: "memory");
        }
    }
    __syncthreads();
}


#define LDS_WAIT() asm volatile("s_waitcnt lgkmcnt(0)" ::: "memory")
DI void transpose_item(const float* W, int K, int N, int Npad, bf16_t* WT, int mode, LAS float* scr, int item, int lane, const float* gk = nullptr) {
    const int nblk = Npad / 32, kb = item / nblk, nb = item % nblk, k0 = 64 * kb, n0 = 32 * nb;
    const int nn = n0 + (lane & 31); const bool ok = nn < N;
    float tv[32];
#pragma unroll
    for (int i = 0; i < 32; ++i) tv[i] = ok ? W[(size_t)(k0 + 2 * i + (lane >> 5)) * N + nn] : 0.f;
    if (gk) {
#pragma unroll
        for (int i = 0; i < 32; ++i) tv[i] *= gk[k0 + 2 * i + (lane >> 5)];
    }
#pragma unroll
    for (int i = 0; i < 32; ++i) scr[(2 * i + (lane >> 5)) * 33 + (lane & 31)] = tv[i];
    LDS_WAIT(); asm volatile("" ::: "memory");
    const int c = lane & 7;
#pragma unroll
    for (int j = 0; j < 4; ++j) {
        const int n = (lane >> 3) + 8 * j; const LAS float* s = scr + (8 * c) * 33 + n;
        u32x4 o; o.x = pk2(s[0 * 33], s[1 * 33]); o.y = pk2(s[2 * 33], s[3 * 33]); o.z = pk2(s[4 * 33], s[5 * 33]); o.w = pk2(s[6 * 33], s[7 * 33]);
        int drow = n0 + n;
        if (mode == 1) { const int jj = drow >= FF ? drow - FF : drow, isu = drow >= FF ? 1 : 0; drow = (jj >> 2) * 8 + isu * 4 + (jj & 3); }
        *(u32x4*)(WT + (size_t)drow * K + k0 + 8 * c) = o;
    }
    LDS_WAIT(); asm volatile("" ::: "memory");
}

template <int NR> DI void norm_rows(const float* xsrc32, bf16_t* xn, float* rn, float* xdst32, const bf16_t* y, const float* gpost, size_t rstride, int lane) {
    f32x4 v[NR][4];
    if (xsrc32) {
#pragma unroll
        for (int r = 0; r < NR; ++r)
#pragma unroll
            for (int j = 0; j < 4; ++j) v[r][j] = *(const f32x4*)(xsrc32 + r * rstride + 4 * lane + 256 * j);
    } else {
        float rr[NR]; u32x2 w[NR][4];
#pragma unroll
        for (int r = 0; r < NR; ++r) { rr[r] = rn[r * (rstride / D)];
#pragma unroll
            for (int j = 0; j < 4; ++j) w[r][j] = *(const u32x2*)(xn + r * rstride + 4 * lane + 256 * j); }
#pragma unroll
        for (int r = 0; r < NR; ++r)
#pragma unroll
            for (int j = 0; j < 4; ++j) v[r][j] = (f32x4){bflo(w[r][j].x), bfhi(w[r][j].x), bflo(w[r][j].y), bfhi(w[r][j].y)} * rr[r];
    }
    if (y) {
        u32x2 yw[NR][4]; f32x4 g[4];
#pragma unroll
        for (int r = 0; r < NR; ++r)
#pragma unroll
            for (int j = 0; j < 4; ++j) yw[r][j] = *(const u32x2*)(y + r * rstride + 4 * lane + 256 * j);
#pragma unroll
        for (int j = 0; j < 4; ++j) g[j] = *(const f32x4*)(gpost + 4 * lane + 256 * j);
#pragma unroll
        for (int r = 0; r < NR; ++r) {
            f32x4 yv[4]; float ss = 0.f;
#pragma unroll
            for (int j = 0; j < 4; ++j) { yv[j] = (f32x4){bflo(yw[r][j].x), bfhi(yw[r][j].x), bflo(yw[r][j].y), bfhi(yw[r][j].y)}; ss += (yv[j][0] * yv[j][0] + yv[j][1] * yv[j][1]) + (yv[j][2] * yv[j][2] + yv[j][3] * yv[j][3]); }
            const float rs = rsqrtf(wave_sum(ss) * (1.f / D) + EPS);
#pragma unroll
            for (int j = 0; j < 4; ++j) v[r][j] = v[r][j] + yv[j] * rs * g[j];
        }
    }
#pragma unroll
    for (int r = 0; r < NR; ++r) {
        if (xdst32) {
#pragma unroll
            for (int j = 0; j < 4; ++j) *(f32x4*)(xdst32 + r * rstride + 4 * lane + 256 * j) = v[r][j];
        } else {
            float ss = 0.f;
#pragma unroll
            for (int j = 0; j < 4; ++j) ss += (v[r][j][0] * v[r][j][0] + v[r][j][1] * v[r][j][1]) + (v[r][j][2] * v[r][j][2] + v[r][j][3] * v[r][j][3]);
            const float ms = wave_sum(ss) * (1.f / D) + EPS, rs = rsqrtf(ms);
#pragma unroll
            for (int j = 0; j < 4; ++j) { const f32x4 o = v[r][j] * rs; u32x2 w; w.x = pk2(o[0], o[1]); w.y = pk2(o[2], o[3]); *(u32x2*)(xn + r * rstride + 4 * lane + 256 * j) = w; }
            if (lane == 0) rn[r * (rstride / D)] = ms * rs;
        }
    }
}
DI void norm_row(const float* xsrc32, bf16_t* xn, float* rn, float* xdst32, const bf16_t* y, const float* gpost, int lane) { norm_rows<1>(xsrc32, xn, rn, xdst32, y, gpost, (size_t)D, lane); }

DI void norm_phase(const Ctx& p, const float* gpost, bool last, int G, int bx) {
    const int tid = pg8::tid_(), lane = tid & 63, wv = tid >> 6, gw = bx * NWAVES + wv, NGW = G * NWAVES;
    const bf16_t* Yb = (const bf16_t*)(p.ws + WS_Y); bf16_t* Xb = (bf16_t*)(p.ws + WS_XB); float* Rn = (float*)(p.ws + WS_RN);
    int row = gw; const size_t rst = (size_t)NGW * D;
    for (; row + 3 * NGW < MA; row += 4 * NGW) norm_rows<4>(nullptr, Xb + (size_t)row * D, Rn + row, last ? p.out + (size_t)row * D : nullptr, Yb + (size_t)row * D, gpost, rst, lane);
    for (; row < MA; row += NGW) norm_row(nullptr, Xb + (size_t)row * D, Rn + row, last ? p.out + (size_t)row * D : nullptr, Yb + (size_t)row * D, gpost, lane);
}

constexpr int CV_I0 = 3072, CV_I1 = 192, CV_I2 = 512, CV_I3 = 2816, CV_I4 = 1408, CV_IPL = CV_I0 + 2 * CV_I1 + 5 * CV_I2 + CV_I3 + CV_I4, CV_KV0 = CV_I0 + 2 * CV_I1 + 3 * CV_I2, CV_NKV = 2 * CV_I2;
constexpr int CV_UNITS = (CV_IPL - CV_NKV) / 64;
static_assert((CV_IPL - CV_NKV) % 64 == 0, "conversion units");
template <class IN> DI void convert_item(const IN& in, unsigned char* ws, int l, int r, LAS float* scr, int lane) {
    constexpr int I0 = CV_I0, I1 = CV_I1, I2 = CV_I2, I3 = CV_I3;
    if (r < I0) { transpose_item(in[I_WIN] + (size_t)l * D * NIN, D, NIN, NINP, (bf16_t*)(ws + WS_WIN + l * SZ_WIN), 0, scr, r, lane, in[I_NMIXPRE] + l * D); return; } r -= I0;
    if (r < I1) { transpose_item(in[I_WBA] + (size_t)l * 384 * D, 384, D, D, (bf16_t*)(ws + WS_WBA + l * SZ_WBA), 0, scr, r, lane); return; } r -= I1;
    if (r < I1) { transpose_item(in[I_WBC] + (size_t)l * 384 * D, 384, D, D, (bf16_t*)(ws + WS_WBC + l * SZ_WBA), 0, scr, r, lane); return; } r -= I1;
    if (r < I2) { transpose_item(in[I_WMIX] + (size_t)l * D * D, D, D, D, (bf16_t*)(ws + WS_WMIX + l * SZ_WSQ), 0, scr, r, lane); return; } r -= I2;
    if (r < I2) { transpose_item(in[I_WXQ] + (size_t)l * D * D, D, D, D, (bf16_t*)(ws + WS_WXQ + l * SZ_WSQ), 0, scr, r, lane, in[I_NXPRE] + l * D); return; } r -= I2;
    if (r < I2) { transpose_item(in[I_WXO] + (size_t)l * D * D, D, D, D, (bf16_t*)(ws + WS_WXO + l * SZ_WSQ), 0, scr, r, lane); return; } r -= I2;
    if (r < I2) { transpose_item(in[I_WXK] + (size_t)l * D * D, D, D, D, (bf16_t*)(ws + WS_WKV + l * SZ_WKV), 0, scr, r, lane); return; } r -= I2;
    if (r < I2) { transpose_item(in[I_WXV] + (size_t)l * D * D, D, D, D, (bf16_t*)(ws + WS_WKV + l * SZ_WKV + SZ_WSQ), 0, scr, r, lane); return; } r -= I2;
    if (r < I3) { transpose_item(in[I_WF1] + (size_t)l * D * FF2, D, FF2, FF2, (bf16_t*)(ws + WS_WF1 + l * SZ_WF1), 1, scr, r, lane, in[I_NFPRE] + l * D); return; } r -= I3;
    transpose_item(in[I_WF2] + (size_t)l * FF * D, FF, D, D, (bf16_t*)(ws + WS_WF2 + l * SZ_WF2), 0, scr, r, lane);
}
DI void conv_unit(const Ctx& p, int l, int j, LAS unsigned char* lds) {
    const int tid = pg8::tid_(), lane = tid & 63, wv = tid >> 6; LAS float* scr = (LAS float*)(lds + wv * 16384);
    for (int q = 0; q < 8; ++q) { const int r = j * 64 + wv * 8 + q; convert_item(p.in, p.ws, l, r < CV_KV0 ? r : r + CV_NKV, scr, lane); }
}
DI void prologue(const Params& p, LAS unsigned char* lds) {
    const int tid = pg8::tid_(), lane = tid & 63, wv = tid >> 6;
    const int gw = blockIdx.x * NWAVES + wv, NGW = gridDim.x * NWAVES;
    LAS float* scr = (LAS float*)(lds + wv * 16384);
    unsigned char* ws = p.ws;
    for (int it = gw; it < CV_IPL + 3 * CV_NKV; it += NGW) {
        if (it < CV_IPL) convert_item(p.in, ws, 0, it, scr, lane);
        else { const int j = it - CV_IPL; convert_item(p.in, ws, 1 + j / CV_NKV, CV_KV0 + j % CV_NKV, scr, lane); }
    }
    for (int u = blockIdx.x; u < 128; u += gridDim.x) {
        const int l = u >> 5, g = (u >> 3) & 3, nb = (u >> 2) & 1, cq = u & 3;
        LAS float* Ps = (LAS float*)(lds + 8 * 16384);
        __syncthreads();
        for (int i = tid; i < 1024; i += NTHR) Ps[i] = p.in[I_WPOOL][((size_t)(l * 4 + g) * 64 + 16 * cq) * 64 + i];
        __syncthreads();
        const int n = nb * 512 + tid;
        const float* sc = p.in[I_PSCALE] + l * 256 + g * 64; const float* wb = p.in[I_WBB] + ((size_t)l * 256 + g * 64) * D + n;
        float acc[16];
#pragma unroll
        for (int c = 0; c < 16; ++c) acc[c] = 0.f;
#pragma unroll 2
        for (int d0 = 0; d0 < 64; d0 += 8) {
            float bc[8];
#pragma unroll
            for (int j = 0; j < 8; ++j) bc[j] = sc[d0 + j] * wb[(size_t)(d0 + j) * D];
#pragma unroll
            for (int c = 0; c < 16; ++c) { const f32x4 p0 = *(const LAS f32x4*)(Ps + c * 64 + d0), p1 = *(const LAS f32x4*)(Ps + c * 64 + d0 + 4);
                acc[c] += ((p0[0] * bc[0] + p0[1] * bc[1]) + (p0[2] * bc[2] + p0[3] * bc[3])) + ((p1[0] * bc[4] + p1[1] * bc[5]) + (p1[2] * bc[6] + p1[3] * bc[7])); }
        }
        unsigned ov[16];
#pragma unroll
        for (int c = 0; c < 16; ++c) ov[c] = f2bf(acc[c]);
        bf16_t* dst = (bf16_t*)(ws + WS_WBB + l * SZ_WBB) + (size_t)n * 256 + g * 64 + 16 * cq;
        u32x4 w0, w1; w0.x = ov[0] | (ov[1] << 16); w0.y = ov[2] | (ov[3] << 16); w0.z = ov[4] | (ov[5] << 16); w0.w = ov[6] | (ov[7] << 16);
        w1.x = ov[8] | (ov[9] << 16); w1.y = ov[10] | (ov[11] << 16); w1.z = ov[12] | (ov[13] << 16); w1.w = ov[14] | (ov[15] << 16);
        *(u32x4*)dst = w0; *(u32x4*)(dst + 8) = w1;
    }
    __syncthreads();
    for (int row = gw; row < MA; row += NGW) {
        const float* src = row < MP ? p.in[I_XP] + (size_t)row * D : p.in[I_XS] + (size_t)(row - MP) * D;
        norm_row(src, (bf16_t*)(ws + WS_XB) + (size_t)row * D, (float*)(ws + WS_RN) + row, nullptr, nullptr, nullptr, lane);
    }
    for (int row = gw; row < NB * 256; row += NGW) {
        f32x4 v[4]; float ss = 0.f;
#pragma unroll
        for (int j = 0; j < 4; ++j) { v[j] = *(const f32x4*)(p.in[I_MEM] + (size_t)row * D + 4 * lane + 256 * j); ss += (v[j][0] * v[j][0] + v[j][1] * v[j][1]) + (v[j][2] * v[j][2] + v[j][3] * v[j][3]); }
        const float rs = rsqrtf(wave_sum(ss) * (1.f / D) + EPS);
        for (int l = 0; l < 4; ++l)
#pragma unroll
            for (int j = 0; j < 4; ++j) { const f32x4 g = *(const f32x4*)(p.in[I_MEMN] + l * D + 4 * lane + 256 * j); const f32x4 o = v[j] * rs * g; u32x2 w; w.x = pk2(o[0], o[1]); w.y = pk2(o[2], o[3]);
                *(u32x2*)((bf16_t*)(ws + WS_MN) + ((size_t)l * 2048 + row) * D + 4 * lane + 256 * j) = w; }
    }
}

#define MFMA32(a, b, c) __builtin_amdgcn_mfma_f32_32x32x16_bf16((a), (b), (c), 0, 0, 0)
#define MFMA16(a, b, c) __builtin_amdgcn_mfma_f32_16x16x32_bf16((a), (b), (c), 0, 0, 0)
template <bool MASKED> DI void sb_tile_weights(f32x16 (&z)[2], float& R, int jt, int tq, int hi) {
    f32x16 e[2]; float T[8];
    const int sbase = 64 * jt + 4 * hi;
#pragma unroll
    for (int kb = 0; kb < 2; ++kb)
#pragma unroll
        for (int g = 0; g < 4; ++g) {
            float fl[4];
#pragma unroll
            for (int j = 0; j < 4; ++j) {
                const int r = 4 * g + j; const bool valid = !MASKED || (sbase + 32 * kb + 8 * g + j) < tq;
                const float zz = fminf(fmaxf(z[kb][r], -240.f), 240.f);
                const float t = __builtin_amdgcn_exp2f(zz * (-0.125f * 1.4426950408889634f));
                const float be = __builtin_amdgcn_rcpf(1.f + t);
                fl[j] = valid ? t * be : 1.f; z[kb][r] = valid ? be : 0.f;
            }
            e[kb][4 * g + 3] = 1.f; e[kb][4 * g + 2] = fl[3]; e[kb][4 * g + 1] = fl[3] * fl[2]; e[kb][4 * g + 0] = e[kb][4 * g + 1] * fl[1];
            T[kb * 4 + g] = e[kb][4 * g + 0] * fl[0];
        }
    float Tp[8], X[8];
#pragma unroll
    for (int gi = 0; gi < 8; ++gi) Tp[gi] = __shfl_xor(T[gi], 32);
    X[7] = 1.f;
#pragma unroll
    for (int gi = 6; gi >= 0; --gi) X[gi] = X[gi + 1] * (T[gi + 1] * Tp[gi + 1]);
    const float total = X[0] * (T[0] * Tp[0]);
#pragma unroll
    for (int kb = 0; kb < 2; ++kb)
#pragma unroll
        for (int g = 0; g < 4; ++g) {
            const int gi = kb * 4 + g; const float off = R * X[gi] * (hi == 0 ? Tp[gi] : 1.f);
#pragma unroll
            for (int j = 0; j < 4; ++j) { const int r = 4 * g + j; z[kb][r] = z[kb][r] * (off * e[kb][r]); }
        }
    R *= total;
}

DI void sb_prompt_unit(const Ctx& p, int b, int h, int qb, LAS unsigned char* lds) {
    const bf16_t* proj = (const bf16_t*)(p.ws + WS_PROJ);
    LAS unsigned short* KS = (LAS unsigned short*)lds;
    LAS unsigned short* VT = KS + 64 * 72;
    const int tid = pg8::tid_(), lane = tid & 63, wv = tid >> 6, hi = lane >> 5, c = lane & 31;
    const int q0 = qb * 256 + wv * 32, tq = q0 + c;
    const size_t rowbase = (size_t)b * SEQ;
    bf16x8 qf[4];
    {
        const bf16_t* qp = proj + (rowbase + tq) * NINP + C_QA + h * 64 + 8 * hi;
#pragma unroll
        for (int kk = 0; kk < 4; ++kk) qf[kk] = *(const bf16x8*)(qp + 16 * kk);
    }
    f32x16 o0, o1;
#pragma unroll
    for (int i = 0; i < 16; ++i) { o0[i] = 0.f; o1[i] = 0.f; }
    float R = 1.f;
    const bf16_t* kbase = proj + rowbase * NINP + C_KA + h * 64 + 8 * wv;
    const bf16_t* vbase = proj + rowbase * NINP + C_VA + h * 64 + 8 * wv;
    int jt = 4 * qb + 3;
    u32x4 kr = *(const u32x4*)(kbase + (size_t)(64 * jt + lane) * NINP), vr = *(const u32x4*)(vbase + (size_t)(64 * jt + lane) * NINP);
    for (; jt >= 0; --jt) {
        __syncthreads();
        *(LAS u32x4*)(KS + lane * 72 + 8 * wv) = kr;
#pragma unroll
        for (int i = 0; i < 4; ++i) { const unsigned w = vr[i]; VT[(8 * wv + 2 * i) * 72 + lane] = (unsigned short)(w & 0xffffu); VT[(8 * wv + 2 * i + 1) * 72 + lane] = (unsigned short)(w >> 16); }
        __syncthreads();
        if (jt > 0) { kr = *(const u32x4*)(kbase + (size_t)(64 * (jt - 1) + lane) * NINP); vr = *(const u32x4*)(vbase + (size_t)(64 * (jt - 1) + lane) * NINP); }
        if (64 * jt < q0 + 31) {
            f32x16 z[2];
#pragma unroll
            for (int kb = 0; kb < 2; ++kb) {
                f32x16 acc;
#pragma unroll
                for (int i = 0; i < 16; ++i) acc[i] = 0.f;
#pragma unroll
                for (int kk = 0; kk < 4; ++kk) { const bf16x8 a = *(const LAS bf16x8*)(KS + (32 * kb + c) * 72 + 16 * kk + 8 * hi); acc = MFMA32(a, qf[kk], acc); }
                z[kb] = acc;
            }
            if (64 * jt + 63 < q0) sb_tile_weights<false>(z, R, jt, tq, hi); else sb_tile_weights<true>(z, R, jt, tq, hi);
#pragma unroll
            for (int kb = 0; kb < 2; ++kb)
#pragma unroll
                for (int s2 = 0; s2 < 2; ++s2) {
                    u32x4 pw; pw.x = pk2(z[kb][8 * s2 + 0], z[kb][8 * s2 + 1]); pw.y = pk2(z[kb][8 * s2 + 2], z[kb][8 * s2 + 3]); pw.z = pk2(z[kb][8 * s2 + 4], z[kb][8 * s2 + 5]); pw.w = pk2(z[kb][8 * s2 + 6], z[kb][8 * s2 + 7]);
                    const bf16x8 pb = __builtin_bit_cast(bf16x8, pw);
                    const int ko = 32 * kb + 16 * s2 + 4 * hi;
                    { const s16x4 lo = *(const LAS s16x4*)(VT + c * 72 + ko), hh = *(const LAS s16x4*)(VT + c * 72 + ko + 8);
                      const bf16x8 va = __builtin_shufflevector(lo, hh, 0, 1, 2, 3, 4, 5, 6, 7); o0 = MFMA32(va, pb, o0); }
                    { const s16x4 lo = *(const LAS s16x4*)(VT + (c + 32) * 72 + ko), hh = *(const LAS s16x4*)(VT + (c + 32) * 72 + ko + 8);
                      const bf16x8 va = __builtin_shufflevector(lo, hh, 0, 1, 2, 3, 4, 5, 6, 7); o1 = MFMA32(va, pb, o1); }
                }
        }
    }
    bf16_t* op = (bf16_t*)(p.ws + WS_OA) + (rowbase + tq) * 384 + h * 64 + 4 * hi;
#pragma unroll
    for (int g = 0; g < 4; ++g) {
        u32x2 w; w.x = pk2(o0[4 * g], o0[4 * g + 1]); w.y = pk2(o0[4 * g + 2], o0[4 * g + 3]); *(u32x2*)(op + 8 * g) = w;
        w.x = pk2(o1[4 * g], o1[4 * g + 1]); w.y = pk2(o1[4 * g + 2], o1[4 * g + 3]); *(u32x2*)(op + 32 + 8 * g) = w;
    }
}

DI void sb_sample_unit(const Ctx& p, int l, int b, int h, LAS unsigned char* lds) {
    const bf16_t* proj = (const bf16_t*)(p.ws + WS_PROJ);
    LAS float* qs = (LAS float*)lds;
    LAS float* Z = qs + 1024;
    LAS float* RED = Z + 16 * 1056;
    const int tid = pg8::tid_(), lane = tid & 63, wv = tid >> 6;
    const size_t srow = (size_t)MP + b * 16;
    for (int i = tid; i < 1024; i += NTHR) qs[i] = bf2f(proj[(srow + (i >> 6)) * NINP + C_QA + h * 64 + (i & 63)]) * 0.125f;
    __syncthreads();
    {
        float a0[16], a1[16];
#pragma unroll
        for (int i = 0; i < 16; ++i) { a0[i] = 0.f; a1[i] = 0.f; }
        const float* k0p = p.in[I_CSK] + ((((size_t)l * DB + b) * PAST + tid) * 6 + h) * 64; const float* k1p = k0p + (size_t)512 * 6 * 64;
#pragma unroll 8
        for (int d4 = 0; d4 < 16; ++d4) {
            const f32x4 ka = *(const f32x4*)(k0p + 4 * d4), kb = *(const f32x4*)(k1p + 4 * d4);
#pragma unroll
            for (int i = 0; i < 16; ++i) { const f32x4 q = *(const LAS f32x4*)(qs + i * 64 + 4 * d4);
                a0[i] += (q[0] * ka[0] + q[1] * ka[1]) + (q[2] * ka[2] + q[3] * ka[3]); a1[i] += (q[0] * kb[0] + q[1] * kb[1]) + (q[2] * kb[2] + q[3] * kb[3]); }
        }
#pragma unroll
        for (int i = 0; i < 16; ++i) { Z[i * 1056 + tid] = a0[i]; Z[i * 1056 + tid + 512] = a1[i]; }
        if (tid < 256) {
            const int i = tid >> 4, j = tid & 15; const bf16_t* kp = proj + (srow + j) * NINP + C_KA + h * 64; float s = 0.f;
            for (int d = 0; d < 64; ++d) s += qs[i * 64 + d] * bf2f(kp[d]);
            Z[i * 1056 + 1024 + j] = s;
        }
    }
    __syncthreads();
    for (int qq = 0; qq < 2; ++qq) {
        const int i = 2 * wv + qq, lim = PAST + i; LAS float* zr = Z + i * 1056;
        const int st = 17 * lane, en = (st + 17 < 1040) ? st + 17 : 1040;
        float tot = 0.f;
        for (int s = st; s < en; ++s) if (s < lim) tot -= softplusf_(zr[s]);
        float incl = tot;
#pragma unroll
        for (int o = 1; o < 64; o <<= 1) { const float t = __shfl_down(incl, o); if (lane + o < 64) incl += t; }
        float run = incl - tot;
        for (int s = en - 1; s >= st; --s) {
            const float zz = zr[s]; float w = 0.f;
            if (s < lim) { const float sp = softplusf_(zz); w = __expf(zz - sp + run); run -= sp; }
            zr[s] = w;
        }
    }
    __syncthreads();
    {
        const int d = tid & 63, g = tid >> 6;
        float o[16];
#pragma unroll
        for (int i = 0; i < 16; ++i) o[i] = 0.f;
        const float* vp = p.in[I_CSV] + (((size_t)l * DB + b) * PAST * 6 + h) * 64 + d;
        for (int s0 = 130 * g; s0 < 130 * g + 130; s0 += 26) {
            float v[26];
#pragma unroll
            for (int j = 0; j < 26; ++j) { const int s = s0 + j; v[j] = s < PAST ? vp[(size_t)s * 384] : bf2f(proj[(srow + (s - PAST)) * NINP + C_VA + h * 64 + d]); }
#pragma unroll
            for (int j = 0; j < 26; ++j)
#pragma unroll
                for (int i = 0; i < 16; ++i) o[i] += Z[i * 1056 + s0 + j] * v[j];
        }
#pragma unroll
        for (int i = 0; i < 16; ++i) RED[(g * 16 + i) * 64 + d] = o[i];
    }
    __syncthreads();
    for (int i = tid; i < 1024; i += NTHR) {
        const int qi = i >> 6, d = i & 63; float s = 0.f;
#pragma unroll
        for (int g = 0; g < 8; ++g) s += RED[(g * 16 + qi) * 64 + d];
        ((bf16_t*)(p.ws + WS_OA))[(srow + qi) * 384 + h * 64 + d] = f2bf(s);
    }
}

template <int W> DI void pool_rows(const float (&uu)[48], int t0, float* outp, bf16_t* pooled_col) {
    float s = 0.f;
#pragma unroll
    for (int i = 16 - W; i < 16; ++i) s += uu[i];
#pragma unroll
    for (int r = 0; r < 32; ++r) {
        s += uu[16 + r] - uu[16 + r - W];
        const int t = t0 + r; const float cnt = (float)((t + 1 < W) ? t + 1 : W);
        pooled_col[(size_t)r * 256] = f2bf(s / cnt - uu[16 + r]);
        if (t >= SEQ - 15) outp[(size_t)(t - (SEQ - 15)) * 256] = uu[16 + r];
    }
}
DI void pool_unit(const Ctx& p, int l, int unit) {
    const bf16_t* proj = (const bf16_t*)(p.ws + WS_PROJ); bf16_t* pooled = (bf16_t*)(p.ws + WS_POOLED);
    const int tid = pg8::tid_(), ch = tid & 255, w = 2 << (ch >> 6);
    if (unit < MP / 64) {
        const int r0 = unit * 64 + 32 * (tid >> 8), t0 = r0 & (SEQ - 1), b = r0 >> 11;
        float uu[48];
        const bf16_t* up = proj + (size_t)(r0 - 16) * NINP + C_U + ch;
#pragma unroll
        for (int i = 0; i < 48; ++i) uu[i] = (t0 - 16 + i >= 0) ? bf2f(up[(size_t)i * NINP]) : 0.f;
        float* outp = p.out + O_POOLP + ((size_t)(l * NB + b) * 15) * 256 + ch; bf16_t* pc = pooled + (size_t)r0 * 256 + ch;
        if (w == 2) pool_rows<2>(uu, t0, outp, pc); else if (w == 4) pool_rows<4>(uu, t0, outp, pc); else if (w == 8) pool_rows<8>(uu, t0, outp, pc); else pool_rows<16>(uu, t0, outp, pc);
        return;
    }
    for (int i = 0; i < 32; ++i) {
        const int row = unit * 64 + (tid >> 8) + 2 * i;
        const int rs = row - MP, b = rs >> 4, t = rs & 15; float s = 0.f;
        const bf16_t* up = proj + (size_t)row * NINP + C_U + ch; const float u0 = bf2f(up[0]);
        const float* hist = p.in[I_SPOOL] + ((size_t)(l * DB + b) * 15) * 256 + ch;
        for (int j = 0; j < w; ++j) { const int tt = t - j; s += tt >= 0 ? bf2f(*(up - (size_t)j * NINP)) : hist[(15 + tt) * 256]; }
        if (t >= 1) p.out[O_POOLS + ((size_t)(l * DB + b) * 15 + (t - 1)) * 256 + ch] = u0;
        pooled[(size_t)row * 256 + ch] = f2bf(s / (float)w - u0);
    }
}

DI void kvout_unit(const Ctx& p, int l, int unit) {
    const bf16_t* proj = (const bf16_t*)(p.ws + WS_PROJ);
#pragma unroll 4
    for (int i = pg8::tid_(); i < 64 * 96; i += NTHR) {
        const int r = i / 96, ch = i % 96, row = unit * 64 + r;
        const u32x4 w = *(const u32x4*)(proj + (size_t)row * NINP + C_KA + 8 * ch);
        const bool isv = ch >= 48; const int c = 8 * (isv ? ch - 48 : ch);
        float* dst = (row < MP) ? p.out + (isv ? O_VP : O_KP) + ((size_t)l * MP + row) * 384 + c : p.out + (isv ? O_VS : O_KS) + ((size_t)l * MS + (row - MP)) * 384 + c;
        *(f32x4*)dst = (f32x4){bflo(w.x), bfhi(w.x), bflo(w.y), bfhi(w.y)}; *(f32x4*)(dst + 4) = (f32x4){bflo(w.z), bfhi(w.z), bflo(w.w), bfhi(w.w)};
    }
}
DI void memout_unit(const Ctx& p, int unit) {
    const bf16_t* mkv = (const bf16_t*)(p.ws + WS_MKV);
    for (int i = pg8::tid_(); i < 16 * 256; i += NTHR) {
        const int r = i >> 8, ch = i & 255, row = unit * 16 + r, col = 8 * ch;
        const u32x4 w = *(const u32x4*)(mkv + (size_t)row * 2048 + col);
        float* dst = p.out + (col >= 1024 ? O_MVP : O_MKP) + (size_t)row * D + (col & 1023);
        *(f32x4*)dst = (f32x4){bflo(w.x), bfhi(w.x), bflo(w.y), bfhi(w.y)}; *(f32x4*)(dst + 4) = (f32x4){bflo(w.z), bfhi(w.z), bflo(w.w), bfhi(w.w)};
    }
}
DI void memvt_unit(const Ctx& p, int unit) {
    const int l = unit >> 7, nb = (unit >> 3) & 15, b = unit & 7, tid = pg8::tid_(), n = nb * 64 + (tid & 63), wv = tid >> 6;
    const bf16_t* src = (const bf16_t*)(p.ws + WS_MKV) + ((size_t)l * 2048 + b * 256) * 2048 + 1024 + n;
    bf16_t* dst = (bf16_t*)(p.ws + WS_MEMVT) + ((size_t)l * 1024 + n) * 2048 + b * 256;
    for (int c = wv; c < 32; c += 8) {
        unsigned v[8];
#pragma unroll
        for (int j = 0; j < 8; ++j) v[j] = src[(size_t)(8 * c + j) * 2048];
        u32x4 w; w.x = v[0] | (v[1] << 16); w.y = v[2] | (v[3] << 16); w.z = v[4] | (v[5] << 16); w.w = v[6] | (v[7] << 16);
        *(u32x4*)(dst + 8 * c) = w;
    }
}

DI void gla_decay(const Ctx& p, int l, int h, size_t row0, int ntok, LAS unsigned char* lds) {
    const bf16_t* proj = (const bf16_t*)(p.ws + WS_PROJ);
    LAS float* Bc = (LAS float*)lds; LAS float* LR = (LAS float*)(lds + 24576); LAS float* A2 = (LAS float*)(lds + 28672); LAS float* BIA = (LAS float*)(lds + 34816); LAS float* SEG = (LAS float*)(lds + 35200);
    const int tid = pg8::tid_();
    if (tid < 128) {
        const int t = tid >> 1, hf = tid & 1; u32x4 w = {0u, 0u, 0u, 0u};
        if (t < ntok) w = *(const u32x4*)(proj + (row0 + t) * NINP + C_LR + 8 * hf);
        LAS float* d = LR + t * 16 + 8 * hf;
        d[0] = bflo(w.x); d[1] = bfhi(w.x); d[2] = bflo(w.y); d[3] = bfhi(w.y); d[4] = bflo(w.z); d[5] = bfhi(w.z); d[6] = bflo(w.w); d[7] = bfhi(w.w);
    } else if (tid < 128 + 384) {
        const int i = tid - 128, r = i / 24, c4 = i % 24;
        *(LAS f32x4*)(A2 + r * 96 + 4 * c4) = *(const f32x4*)(p.in[I_WA2] + ((size_t)l * 16 + r) * 384 + h * 96 + 4 * c4);
    }
    if (tid < 96) BIA[tid] = p.in[I_BA][l * 384 + h * 96 + tid];
    __syncthreads();
    for (int i = tid; i < 64 * 96; i += NTHR) {
        const int t = i / 96, k = i % 96; float sacc = BIA[k];
#pragma unroll
        for (int r = 0; r < 16; ++r) sacc += LR[t * 16 + r] * A2[r * 96 + k];
        Bc[i] = t < ntok ? -softplusf_(-sacc) * (1.f / 16.f) : 0.f;
    }
    __syncthreads();
    const int k = tid % 96, seg = tid / 96;
    if (tid < 384) { float run = 0.f; for (int i = 0; i < 16; ++i) { const int idx = (16 * seg + i) * 96 + k; run += Bc[idx]; Bc[idx] = run; } SEG[seg * 96 + k] = run; }
    __syncthreads();
    if (tid < 384 && seg > 0) { float off = 0.f; for (int s2 = 0; s2 < seg; ++s2) off += SEG[s2 * 96 + k]; for (int i = 0; i < 16; ++i) Bc[(16 * seg + i) * 96 + k] += off; }
    __syncthreads();
}
DI void gla_unit_rows(int gu, size_t& row0, int& ntok, int& bh, int& h) {
    if (gu < NGU_P) { bh = gu >> 5; const int c = gu & 31, b = bh >> 2; h = bh & 3; row0 = (size_t)b * SEQ + c * 64; ntok = 64; }
    else { bh = gu - NGU_P; const int b = bh >> 2; h = bh & 3; row0 = (size_t)MP + b * 16; ntok = 16; }
}
DI void gla_stage1_unit(const Ctx& p, int l, int gu, LAS unsigned char* lds) {
    const bf16_t* proj = (const bf16_t*)(p.ws + WS_PROJ);
    size_t row0; int ntok, bh, h; gla_unit_rows(gu, row0, ntok, bh, h);
    gla_decay(p, l, h, row0, ntok, lds);
    LAS float* Bc = (LAS float*)lds;
    LAS unsigned short* KT = (LAS unsigned short*)(lds + 36864);
    LAS unsigned short* VT = KT + 96 * 72;
    const int tid = pg8::tid_(), lane = tid & 63, wv = tid >> 6, fr = lane & 15, fq = lane >> 4;
    {
        float* bb = (float*)(p.ws + WS_BB) + (size_t)gu * (64 * GK);
        for (int i = tid; i < 64 * GK / 4; i += NTHR) *(f32x4*)(bb + 4 * i) = *(const LAS f32x4*)(Bc + 4 * i);
    }
    for (int task = tid; task < 768; task += NTHR) {
        const int t = task & 63, ch = task >> 6; u32x4 kw = {0u, 0u, 0u, 0u}, vw = {0u, 0u, 0u, 0u};
        if (t < ntok) { const bf16_t* rp = proj + (row0 + t) * NINP + h * 96 + 8 * ch; kw = *(const u32x4*)(rp + C_KC); vw = *(const u32x4*)(rp + C_VC); }
        const unsigned kk[4] = {kw.x, kw.y, kw.z, kw.w}, vv[4] = {vw.x, vw.y, vw.z, vw.w};
#pragma unroll
        for (int j = 0; j < 4; ++j) {
            const int k0 = 8 * ch + 2 * j;
            const float e0 = __expf(Bc[(ntok - 1) * 96 + k0] - Bc[t * 96 + k0]), e1 = __expf(Bc[(ntok - 1) * 96 + k0 + 1] - Bc[t * 96 + k0 + 1]);
            KT[k0 * 72 + t] = f2bf(bflo(kk[j]) * e0); KT[(k0 + 1) * 72 + t] = f2bf(bfhi(kk[j]) * e1);
            VT[k0 * 72 + t] = (unsigned short)(vv[j] & 0xffffu); VT[(k0 + 1) * 72 + t] = (unsigned short)(vv[j] >> 16);
        }
    }
    if (tid < 96) ((float*)(p.ws + WS_GDEC))[(size_t)gu * 96 + tid] = __expf(Bc[(ntok - 1) * 96 + tid]);
    __syncthreads();
    float* KV = (float*)(p.ws + WS_GKV) + (size_t)gu * (GK * GK);
    for (int tile = wv; tile < 36; tile += 8) {
        const int ki = tile / 6, vi = tile % 6; f32x4 acc = {0.f, 0.f, 0.f, 0.f};
#pragma unroll
        for (int ks = 0; ks < 2; ++ks) { const bf16x8 a = *(const LAS bf16x8*)(KT + (16 * ki + fr) * 72 + 32 * ks + 8 * fq), bb = *(const LAS bf16x8*)(VT + (16 * vi + fr) * 72 + 32 * ks + 8 * fq); acc = MFMA16(a, bb, acc); }
#pragma unroll
        for (int j = 0; j < 4; ++j) KV[(16 * ki + 4 * fq + j) * 96 + 16 * vi + fr] = acc[j];
    }
}
DI void gla_scan(const Ctx& p, int l) {
    const int gt = blockIdx.x * NTHR + pg8::tid_(), NT = gridDim.x * NTHR;
    const float* KV = (const float*)(p.ws + WS_GKV); const float* DEC = (const float*)(p.ws + WS_GDEC); float* SP = (float*)(p.ws + WS_GSP);
    for (int e = gt; e < 32 * GK * GK; e += NT) {
        const int bh = e / (GK * GK), kv = e % (GK * GK), k = kv / GK; float S = 0.f;
        float kvv[32], dcv[32];
#pragma unroll
        for (int c = 0; c < 32; ++c) { const size_t gu = (size_t)bh * 32 + c; kvv[c] = KV[gu * (GK * GK) + kv]; dcv[c] = DEC[gu * 96 + k]; }
#pragma unroll
        for (int c = 0; c < 32; ++c) { const size_t gu = (size_t)bh * 32 + c; SP[gu * (GK * GK) + kv] = S; S = dcv[c] * S + kvv[c]; }
        p.out[O_GLAP + ((size_t)l * 32 + bh) * (GK * GK) + kv] = S;
    }
    for (int e = gt; e < 64 * GK * GK; e += NT) {
        const int bh = e / (GK * GK), kv = e % (GK * GK), k = kv / GK; const size_t gu = (size_t)NGU_P + bh;
        const float S0 = p.in[I_SGLA][((size_t)l * 64 + bh) * (GK * GK) + kv];
        p.out[O_GLAS + ((size_t)l * 64 + bh) * (GK * GK) + kv] = DEC[gu * 96 + k] * S0 + KV[gu * (GK * GK) + kv];
    }
}
DI void gla_stage3_unit(const Ctx& p, int l, int gu, LAS unsigned char* lds) {
    const bf16_t* proj = (const bf16_t*)(p.ws + WS_PROJ);
    size_t row0; int ntok, bh, h; gla_unit_rows(gu, row0, ntok, bh, h);
    LAS float* OT = (LAS float*)lds;
    LAS unsigned short* QP = (LAS unsigned short*)(lds + 36864);
    LAS unsigned short* KP = QP + 64 * 104;
    LAS unsigned short* VT = KP + 64 * 104;
    LAS unsigned short* ST = VT + 96 * 72;
    LAS unsigned short* ATT = ST + 96 * 104;
    const int tid = pg8::tid_(), lane = tid & 63, wv = tid >> 6, fr = lane & 15, fq = lane >> 4;
    const float* Sprev = gu < NGU_P ? (const float*)(p.ws + WS_GSP) + (size_t)gu * (GK * GK) : p.in[I_SGLA] + ((size_t)l * 64 + bh) * (GK * GK);
    const float* bb = (const float*)(p.ws + WS_BB) + (size_t)gu * (64 * GK);
    __syncthreads();
    for (int task = tid; task < 768; task += NTHR) {
        const int t = task & 63, ch = task >> 6; u32x4 qw = {0u, 0u, 0u, 0u}, kw = qw, vw = qw; f32x4 b0 = {0.f, 0.f, 0.f, 0.f}, b1 = b0;
        if (t < ntok) { const bf16_t* rp = proj + (row0 + t) * NINP + h * 96 + 8 * ch; qw = *(const u32x4*)(rp + C_QC); kw = *(const u32x4*)(rp + C_KC); vw = *(const u32x4*)(rp + C_VC);
            b0 = *(const f32x4*)(bb + t * 96 + 8 * ch); b1 = *(const f32x4*)(bb + t * 96 + 8 * ch + 4); }
        const unsigned qq[4] = {qw.x, qw.y, qw.z, qw.w}, kk[4] = {kw.x, kw.y, kw.z, kw.w}, vv[4] = {vw.x, vw.y, vw.z, vw.w};
        const float be[8] = {b0[0], b0[1], b0[2], b0[3], b1[0], b1[1], b1[2], b1[3]};
        u32x4 qo, ko; unsigned qa[4], ka[4];
#pragma unroll
        for (int j = 0; j < 4; ++j) {
            const float e0 = __expf(be[2 * j]), e1 = __expf(be[2 * j + 1]), r0 = __builtin_amdgcn_rcpf(e0), r1 = __builtin_amdgcn_rcpf(e1);
            const bool ok = t < ntok;
            qa[j] = ok ? pk2(bflo(qq[j]) * 0.10206207261596575f * e0, bfhi(qq[j]) * 0.10206207261596575f * e1) : 0u;
            ka[j] = ok ? pk2(bflo(kk[j]) * r0, bfhi(kk[j]) * r1) : 0u;
            VT[(8 * ch + 2 * j) * 72 + t] = (unsigned short)(vv[j] & 0xffffu); VT[(8 * ch + 2 * j + 1) * 72 + t] = (unsigned short)(vv[j] >> 16);
        }
        qo.x = qa[0]; qo.y = qa[1]; qo.z = qa[2]; qo.w = qa[3]; ko.x = ka[0]; ko.y = ka[1]; ko.z = ka[2]; ko.w = ka[3];
        *(LAS u32x4*)(QP + t * 104 + 8 * ch) = qo; *(LAS u32x4*)(KP + t * 104 + 8 * ch) = ko;
    }
    for (int task = tid; task < 2304; task += NTHR) {
        const int k = task % 96, vc = task / 96; const f32x4 sv = *(const f32x4*)(Sprev + k * 96 + 4 * vc);
#pragma unroll
        for (int j = 0; j < 4; ++j) ST[(4 * vc + j) * 104 + k] = f2bf(sv[j]);
    }
    __syncthreads();
    for (int tile = 2 * wv; tile < 2 * wv + 2; ++tile) {
        const int ti = tile >> 2, si = tile & 3; f32x4 acc = {0.f, 0.f, 0.f, 0.f};
        if (si <= ti) {
#pragma unroll
            for (int ks = 0; ks < 3; ++ks) { const bf16x8 a = *(const LAS bf16x8*)(QP + (16 * ti + fr) * 104 + 32 * ks + 8 * fq), b2 = *(const LAS bf16x8*)(KP + (16 * si + fr) * 104 + 32 * ks + 8 * fq); acc = MFMA16(a, b2, acc); }
        }
#pragma unroll
        for (int j = 0; j < 4; ++j) { const int t = 16 * ti + 4 * fq + j, s2 = 16 * si + fr; ATT[t * 72 + s2] = f2bf(s2 <= t ? acc[j] : 0.f); }
    }
    __syncthreads();
    for (int tile = wv; tile < 24; tile += 8) {
        const int ti = tile / 6, vi = tile % 6; f32x4 acc = {0.f, 0.f, 0.f, 0.f};
#pragma unroll
        for (int ks = 0; ks < 2; ++ks) { const bf16x8 a = *(const LAS bf16x8*)(ATT + (16 * ti + fr) * 72 + 32 * ks + 8 * fq), b2 = *(const LAS bf16x8*)(VT + (16 * vi + fr) * 72 + 32 * ks + 8 * fq); acc = MFMA16(a, b2, acc); }
#pragma unroll
        for (int ks = 0; ks < 3; ++ks) { const bf16x8 a = *(const LAS bf16x8*)(QP + (16 * ti + fr) * 104 + 32 * ks + 8 * fq), b2 = *(const LAS bf16x8*)(ST + (16 * vi + fr) * 104 + 32 * ks + 8 * fq); acc = MFMA16(a, b2, acc); }
#pragma unroll
        for (int j = 0; j < 4; ++j) OT[(16 * ti + 4 * fq + j) * 96 + 16 * vi + fr] = acc[j];
    }
    __syncthreads();
    bf16_t* oc = (bf16_t*)(p.ws + WS_OC);
    const float* gn = p.in[I_GLAN] + l * 384 + h * 96; const float gn0 = gn[lane], gn1 = lane < 32 ? gn[64 + lane] : 0.f;
    float g0[8], g1[8];
#pragma unroll
    for (int tt = 0; tt < 8; ++tt) { const int t = wv * 8 + tt; g0[tt] = 0.f; g1[tt] = 0.f;
        if (t < ntok) { const bf16_t* gp = proj + (row0 + t) * NINP + C_GC + h * 96; g0[tt] = bf2f(gp[lane]); if (lane < 32) g1[tt] = bf2f(gp[64 + lane]); } }
#pragma unroll
    for (int tt = 0; tt < 8; ++tt) {
        const int t = wv * 8 + tt;
        if (t < ntok) {
            const float a0 = OT[t * 96 + lane], a1 = lane < 32 ? OT[t * 96 + 64 + lane] : 0.f;
            const float rs = rsqrtf(wave_sum(a0 * a0 + a1 * a1) * (1.f / 96.f) + EPS);
            oc[(row0 + t) * 384 + h * 96 + lane] = f2bf(a0 * rs * gn0 * g0[tt] * sigmoidf_(g0[tt]));
            if (lane < 32) oc[(row0 + t) * 384 + h * 96 + 64 + lane] = f2bf(a1 * rs * gn1 * g1[tt] * sigmoidf_(g1[tt]));
        }
    }
}

DI void cross_sample_unit(const Ctx& p, int l, int b, int h, int qh, LAS unsigned char* lds) {
    LAS float* qs = (LAS float*)lds;
    LAS float* ST = qs + 8 * 256;
    LAS float* PART = ST + 256 * 8;
    const bf16_t* Q = (const bf16_t*)(p.ws + WS_Q);
    const int tid = pg8::tid_(), lane = tid & 63, wv = tid >> 6;
    const size_t srow = (size_t)MP + b * 16 + 8 * qh;
    for (int i = tid; i < 8 * 256; i += NTHR) qs[i] = bf2f(Q[(srow + (i >> 8)) * D + h * 256 + (i & 255)]) * 0.0625f;
    __syncthreads();
    const int m = tid & 255, half = tid >> 8;
    {
        float acc[8];
#pragma unroll
        for (int i = 0; i < 8; ++i) acc[i] = 0.f;
        const float* kp = p.in[I_CMK] + ((((size_t)l * DB + b) * 256 + m) * 4 + h) * 256 + 128 * half;
#pragma unroll 16
        for (int d4 = 0; d4 < 32; ++d4) {
            const f32x4 kv = *(const f32x4*)(kp + 4 * d4);
#pragma unroll
            for (int i = 0; i < 8; ++i) { const f32x4 q = *(const LAS f32x4*)(qs + i * 256 + 128 * half + 4 * d4); acc[i] += (q[0] * kv[0] + q[1] * kv[1]) + (q[2] * kv[2] + q[3] * kv[3]); }
        }
#pragma unroll
        for (int i = 0; i < 8; ++i) PART[(half * 8 + i) * 256 + m] = acc[i];
    }
    __syncthreads();
    {
        const int i = wv; float v[4], mx = -3.0e38f;
#pragma unroll
        for (int j = 0; j < 4; ++j) { v[j] = PART[i * 256 + lane + 64 * j] + PART[(8 + i) * 256 + lane + 64 * j]; mx = fmaxf(mx, v[j]); }
        mx = wave_max(mx); float sum = 0.f;
#pragma unroll
        for (int j = 0; j < 4; ++j) { v[j] = __expf(v[j] - mx); sum += v[j]; }
        sum = wave_sum(sum); const float inv = 1.f / sum;
#pragma unroll
        for (int j = 0; j < 4; ++j) ST[(lane + 64 * j) * 8 + i] = v[j] * inv;
    }
    __syncthreads();
    {
        float acc[8];
#pragma unroll
        for (int i = 0; i < 8; ++i) acc[i] = 0.f;
        const float* vp = p.in[I_CMV] + ((((size_t)l * DB + b) * 256 + 128 * half) * 4 + h) * 256 + m;
        for (int k0 = 0; k0 < 128; k0 += 32) {
            float v[32];
#pragma unroll
            for (int j = 0; j < 32; ++j) v[j] = vp[(size_t)(k0 + j) * 1024];
#pragma unroll
            for (int j = 0; j < 32; ++j) {
                const f32x4 s0 = *(const LAS f32x4*)(ST + (128 * half + k0 + j) * 8), s1 = *(const LAS f32x4*)(ST + (128 * half + k0 + j) * 8 + 4);
                acc[0] += s0[0] * v[j]; acc[1] += s0[1] * v[j]; acc[2] += s0[2] * v[j]; acc[3] += s0[3] * v[j];
                acc[4] += s1[0] * v[j]; acc[5] += s1[1] * v[j]; acc[6] += s1[2] * v[j]; acc[7] += s1[3] * v[j];
            }
        }
#pragma unroll
        for (int i = 0; i < 8; ++i) PART[(half * 8 + i) * 256 + m] = acc[i];
    }
    __syncthreads();
    bf16_t* O = (bf16_t*)(p.ws + WS_O);
    for (int i = tid; i < 8 * 256; i += NTHR) { const int qi = i >> 8, d = i & 255; O[(srow + qi) * D + h * 256 + d] = f2bf(PART[qi * 256 + d] + PART[(8 + qi) * 256 + d]); }
}

struct SkBf16 { bf16_t* O; int ldc; DI void operator()(int row, int col, f32x4 v) const { u32x2 w; w.x = pk2(v[0], v[1]); w.y = pk2(v[2], v[3]); *(u32x2*)(O + (size_t)(MP + row) * ldc + col) = w; } };
struct SkGate { bf16_t* merged; const bf16_t* proj; int goff; int accum;
    DI void operator()(int row, int col, f32x4 v) const {
        const u32x2 g = *(const u32x2*)(proj + (size_t)(MP + row) * NINP + goff + col); bf16_t* mp = merged + (size_t)(MP + row) * D + col;
        u32x2 pm2 = {0u, 0u}; if (accum) pm2 = *(const u32x2*)mp;
        u32x2 w; w.x = pk2(sigmoidf_(bflo(g.x)) * v[0] + bflo(pm2.x), sigmoidf_(bfhi(g.x)) * v[1] + bfhi(pm2.x)); w.y = pk2(sigmoidf_(bflo(g.y)) * v[2] + bflo(pm2.y), sigmoidf_(bfhi(g.y)) * v[3] + bfhi(pm2.y));
        *(u32x2*)mp = w; } };
template <class EF> DI void skinny_gemm(const bf16_t* A, int lda, const bf16_t* Bt, int ldb, int K, int N, int G, int bx, LAS unsigned char* lds, const EF& ef) {
    const int tid = pg8::tid_(), lane = tid & 63, wv = tid >> 6, fr = lane & 15, fq = lane >> 4, nks = K >> 5, nunits = 4 * (N >> 4);
    LAS f32x4* red = (LAS f32x4*)lds;
    for (int u = bx; u < nunits; u += G) {
        const int rb = u & 3, cb = u >> 2;
        f32x4 acc[4];
#pragma unroll
        for (int i = 0; i < 4; ++i) acc[i] = (f32x4){0.f, 0.f, 0.f, 0.f};
        const bf16_t* bp = Bt + (size_t)(16 * cb + fr) * ldb + 8 * fq; const bf16_t* ap = A + (size_t)(64 * rb + fr) * lda + 8 * fq;
        for (int ks = wv; ks < nks; ks += 8) {
            const bf16x8 bb = *(const bf16x8*)(bp + 32 * ks);
            bf16x8 aa[4];
#pragma unroll
            for (int i = 0; i < 4; ++i) aa[i] = *(const bf16x8*)(ap + (size_t)(16 * i) * lda + 32 * ks);
#pragma unroll
            for (int i = 0; i < 4; ++i) acc[i] = MFMA16(bb, aa[i], acc[i]);
        }
#pragma unroll
        for (int i = 0; i < 4; ++i) red[(wv * 4 + i) * 64 + lane] = acc[i];
        __syncthreads();
        if (tid < 256) {
            const int i = tid >> 6; f32x4 s = red[i * 64 + lane];
#pragma unroll
            for (int w = 1; w < 8; ++w) s = s + red[(w * 4 + i) * 64 + lane];
            ef(64 * rb + 16 * i + fr, 16 * cb + 4 * fq, s);
        }
        __syncthreads();
    }
}

constexpr int PH_PER_LAYER = 15, N_PHASES = 1 + DEPTH * PH_PER_LAYER;
#define RUN_GEMM(EpiT, E, Aptr, lda_, Bptr, ldb_, K_, pm0_, nM_, nN_) do { const pg8::Gemm g_{(K_), (lda_), (ldb_)}; pg8::TileOrder S_; S_.init((Aptr), (lda_), (Bptr), (ldb_), (pm0_), (nM_), (nN_), G, bx); \
        pg8::gemm_phase<EpiT, pg8::TileOrder, true, true>(lds, g_, S_, (E)); } while (0)

__global__ void __launch_bounds__(NTHR, 2) fwd_kernel(Params p) {
    extern __shared__ __attribute__((aligned(16))) unsigned char lds_raw[];
#define PROJ ((bf16_t*)(ws + WS_PROJ))
#define H ((bf16_t*)(ws + WS_XB))
#define MERGED ((bf16_t*)(ws + WS_MERGED))
#define Y ((bf16_t*)(ws + WS_Y))
#define QB ((bf16_t*)(ws + WS_Q))
#define PB ((bf16_t*)(ws + WS_P))
#define OB ((bf16_t*)(ws + WS_O))
#define ACT ((bf16_t*)(ws + WS_ACT))

    {
        volatile LAS unsigned* st0 = (volatile LAS unsigned*)((LAS unsigned char*)lds_raw + LDS_MISC + 32);
        if (pg8::tid_() == 0) { st0[0] = 0u; st0[1] = 0u; st0[8] = 0u; st0[9] = 0u; }
        __syncthreads();
    }
    XcdBarrier xbar = xcd_barrier_post((unsigned*)(p.ws + WS_CTL) + CW_BAR, (volatile LAS unsigned*)((LAS unsigned char*)lds_raw + LDS_MISC + 32));
    if (p.ph_lo == 0) {
        prologue(p, (LAS unsigned char*)lds_raw);
        if (blockIdx.x == 0 && pg8::tid_() == 0) {
            const float** tab = (const float**)(p.ws + WS_TAB);
#pragma unroll
            for (int i = 0; i < N_IN; ++i) tab[i] = p.in[i];
        }
        if (p.ph_hi > 1) xcd_barrier(xbar);
        if (p.ph_hi < 0) cg::this_grid().sync();
    }
    for (int ph = p.ph_lo > 1 ? p.ph_lo : 1; ph < p.ph_hi; ++ph) {
        unsigned ldsb = (unsigned)(size_t)(LAS unsigned char*)lds_raw; asm volatile("" : "+s"(ldsb));
        LAS unsigned char* lds = (LAS unsigned char*)(size_t)ldsb;
        volatile LAS int* slot = (volatile LAS int*)(lds + LDS_MISC);
        unsigned char* ws = p.ws; asm volatile("" : "+s"(ws));
        Ctx c; c.ws = ws; c.in.t = (const float* const*)(ws + WS_TAB); c.out = p.out;
        unsigned* ctl = (unsigned*)(ws + WS_CTL);
        int G = gridDim.x, bx = blockIdx.x; asm volatile("" : "+s"(G), "+s"(bx));
        {
            const int l = (ph - 1) / PH_PER_LAYER, st = (ph - 1) % PH_PER_LAYER;
#ifdef PROBE_SEL
            if (bx == 0) { volatile LAS unsigned long long* a_ = (volatile LAS unsigned long long*)(lds + LDS_MISC + 64); a_[1] = __builtin_amdgcn_s_memrealtime(); }
#endif
            switch (st) {
            case 0: {
                EpiBf16 E{PROJ, NINP, 0xffff};
                RUN_GEMM(EpiBf16, E, H, D, ws + WS_WIN + l * SZ_WIN, D, D, 0, MA / 256, NINP / 256);
                if (l == 0) {
                    const pg8::Gemm g{D, D, D}; MemKvOrder S{G, bx, (const char*)(ws + WS_MN), (const char*)(ws + WS_WKV)};
                    EpiBf16 E2{(bf16_t*)(ws + WS_MKV), 2048, 7};
                    pg8::gemm_phase<EpiBf16, MemKvOrder, true, true>(lds, g, S, E2);
                }
            } break;
            case 1: {
                unsigned* ctr = ctl + 64 * ph;
                constexpr int U_SBP = 384, U_SBS = U_SBP + DB * 6, U_GLA = U_SBS + NGU, U_POOL = U_GLA + MA / 64, U_KV = U_POOL + MA / 64;
                const int U_CV = U_KV + (l + 1 < DEPTH ? CV_UNITS : 0), U_MO = U_CV + (l == 0 ? 512 : 0), U_VT = U_MO + (l == 0 ? 512 : 0), U_ALL = U_VT;
                for (;;) {
                    const int q = next_work(ctr, slot); if (q >= U_ALL) break;
                    int u = q;
                    if (q >= DB * 6) { const int r = q - DB * 6, nbw = U_ALL - U_GLA, nva = U_GLA - DB * 6; int nb2 = nbw >> 1; if (nb2 > nva) nb2 = nva;
                        if (r < 3 * nb2) { const int g3 = r / 3, pos = r - 3 * g3; u = pos < 2 ? U_GLA + 2 * g3 + pos : DB * 6 + g3; }
                        else { const int r2 = r - 3 * nb2, lb = nbw - 2 * nb2; u = r2 < lb ? U_GLA + 2 * nb2 + r2 : DB * 6 + nb2 + (r2 - lb); } }
#ifdef PROBE_SEL
                    const int ut_ = u < DB * 6 ? 10 : (u < U_SBS ? 11 : (u < U_GLA ? 12 : 13));
                    if (bx == 0 && ut_ == PROBE_SEL) { volatile LAS unsigned long long* a_ = (volatile LAS unsigned long long*)(lds + LDS_MISC + 64); a_[3] = __builtin_amdgcn_s_memrealtime(); }
#endif
                    if (u < DB * 6) sb_sample_unit(c, l, u / 6, u % 6, lds);
                    else if (u < U_SBS) { const int v = u - DB * 6, qb = 7 - v / 48, bh = v % 48; sb_prompt_unit(c, bh / 6, bh % 6, qb, lds); }
                    else if (u < U_GLA) gla_stage1_unit(c, l, u - U_SBS, lds);
                    else if (u < U_POOL) pool_unit(c, l, u - U_GLA);
                    else if (u < U_KV) kvout_unit(c, l, u - U_POOL);
                    else if (u < U_CV) conv_unit(c, l + 1, u - U_KV, lds);
                    else if (u < U_MO) memout_unit(c, u - U_CV);
                    else memvt_unit(c, u - U_MO);
#ifdef PROBE_SEL
                    if (bx == 0 && ut_ == PROBE_SEL) { volatile LAS unsigned long long* a_ = (volatile LAS unsigned long long*)(lds + LDS_MISC + 64); __hip_atomic_fetch_add((LAS unsigned long long*)a_, __builtin_amdgcn_s_memrealtime() - a_[3], __ATOMIC_RELAXED, __HIP_MEMORY_SCOPE_WORKGROUP); }
#endif
                }
            } break;
            case 2: gla_scan(c, l); break;
            case 3: {
                unsigned* ctr = ctl + 64 * ph;
                for (;;) { const int u = next_work(ctr, slot); if (u >= NGU) break; gla_stage3_unit(c, l, u, lds); }
            } break;
            case 4: {
                EpiGate E1{MERGED, PROJ, C_GA, 0}, E2{MERGED, PROJ, C_GB, 1}, E3{MERGED, PROJ, C_GCG, 1};
                RUN_GEMM(EpiGate, E1, ws + WS_OA, 384, ws + WS_WBA + l * SZ_WBA, 384, 384, 0, MP / 256, 4);
                RUN_GEMM(EpiGate, E2, ws + WS_POOLED, 256, ws + WS_WBB + l * SZ_WBB, 256, 256, 0, MP / 256, 4);
                RUN_GEMM(EpiGate, E3, ws + WS_OC, 384, ws + WS_WBC + l * SZ_WBA, 384, 384, 0, MP / 256, 4);
                { SkGate F1{MERGED, PROJ, C_GA, 0}, F2{MERGED, PROJ, C_GB, 1}, F3{MERGED, PROJ, C_GCG, 1};
                  skinny_gemm((const bf16_t*)(ws + WS_OA) + (size_t)MP * 384, 384, (const bf16_t*)(ws + WS_WBA + l * SZ_WBA), 384, 384, D, G, bx, lds, F1);
                  skinny_gemm((const bf16_t*)(ws + WS_POOLED) + (size_t)MP * 256, 256, (const bf16_t*)(ws + WS_WBB + l * SZ_WBB), 256, 256, D, G, bx, lds, F2);
                  skinny_gemm((const bf16_t*)(ws + WS_OC) + (size_t)MP * 384, 384, (const bf16_t*)(ws + WS_WBC + l * SZ_WBA), 384, 384, D, G, bx, lds, F3); }
            } break;
            case 5: { EpiBf16 E{Y, D, 0xffff}; RUN_GEMM(EpiBf16, E, MERGED, D, ws + WS_WMIX + l * SZ_WSQ, D, D, 0, MP / 256, 4);
                SkBf16 F{Y, D}; skinny_gemm((const bf16_t*)MERGED + (size_t)MP * D, D, (const bf16_t*)(ws + WS_WMIX + l * SZ_WSQ), D, D, D, G, bx, lds, F); } break;
            case 6: norm_phase(c, c.in[I_NMIXPOST] + l * D, false, G, bx); break;
            case 7: { EpiBf16 E{QB, D, 0xffff}; RUN_GEMM(EpiBf16, E, H, D, ws + WS_WXQ + l * SZ_WSQ, D, D, 0, MP / 256, 4);
                SkBf16 F{QB, D}; skinny_gemm((const bf16_t*)H + (size_t)MP * D, D, (const bf16_t*)(ws + WS_WXQ + l * SZ_WSQ), D, D, D, G, bx, lds, F); } break;
            case 8: {
                const pg8::Gemm g{256, D, 2048}; CrossOrder S{G, bx, (const char*)QB, (const char*)(ws + WS_MKV + (size_t)l * 2 * SZ_WKV), 0};
                EpiSoftmax E{PB, (LAS float*)(lds + LDS_X)};
                pg8::gemm_phase<EpiSoftmax, CrossOrder, true, true>(lds, g, S, E);
            } break;
            case 9: {
                const pg8::Gemm g{256, D, 2048}; CrossOrder S{G, bx, (const char*)PB, (const char*)(ws + WS_MEMVT + (size_t)l * SZ_WKV), 1};
                EpiBf16 E{OB, D, 0xffff};
                pg8::gemm_phase<EpiBf16, CrossOrder, true, true>(lds, g, S, E);
                for (int u = bx; u < DB * 4 * 2; u += G) { __syncthreads(); cross_sample_unit(c, l, u >> 3, (u >> 1) & 3, u & 1, lds); }
            } break;
            case 10: { EpiBf16 E{Y, D, 0xffff}; RUN_GEMM(EpiBf16, E, OB, D, ws + WS_WXO + l * SZ_WSQ, D, D, 0, MP / 256, 4);
                SkBf16 F{Y, D}; skinny_gemm((const bf16_t*)OB + (size_t)MP * D, D, (const bf16_t*)(ws + WS_WXO + l * SZ_WSQ), D, D, D, G, bx, lds, F); } break;
            case 11: norm_phase(c, c.in[I_NXPOST] + l * D, false, G, bx); break;
            case 12: { EpiSwiglu E{ACT}; RUN_GEMM(EpiSwiglu, E, H, D, ws + WS_WF1 + l * SZ_WF1, D, D, 0, MA / 256, FF2 / 256); } break;
            case 13: { EpiBf16 E{Y, D, 0xffff}; RUN_GEMM(EpiBf16, E, ACT, FF, ws + WS_WF2 + l * SZ_WF2, FF, FF, 0, MP / 256, 4);
                SkBf16 F{Y, D}; skinny_gemm((const bf16_t*)ACT + (size_t)MP * FF, FF, (const bf16_t*)(ws + WS_WF2 + l * SZ_WF2), FF, FF, D, G, bx, lds, F); } break;
            default: norm_phase(c, c.in[I_NFPOST] + l * D, l == DEPTH - 1, G, bx); break;
            }
#ifdef PROBE_SEL
            {
                const int sel = PROBE_SEL; bool hit = false;
                if (sel == 2) hit = (st == 0 || st == 4 || st == 5 || st == 7 || st == 10 || st == 12 || st == 13);
                if (sel == 3) hit = (st == 2 || st == 3);
                if (sel == 4) hit = (st == 8 || st == 9);
                if (sel == 5) hit = (st == 6 || st == 11 || st == 14);
                if (sel == 6) hit = (st == 1);
                if (sel == 7) hit = (st == 0);
                if (sel == 8) hit = (st == 12);
                if (sel == 9) hit = (st == 13);
                if (bx == 0 && hit) { volatile LAS unsigned long long* a_ = (volatile LAS unsigned long long*)(lds + LDS_MISC + 64); __hip_atomic_fetch_add((LAS unsigned long long*)a_, __builtin_amdgcn_s_memrealtime() - a_[1], __ATOMIC_RELAXED, __HIP_MEMORY_SCOPE_WORKGROUP); }
            }
#endif
        }
#ifdef PROBE_SEL
        if (bx == 0) { volatile LAS unsigned long long* a_ = (volatile LAS unsigned long long*)(lds + LDS_MISC + 64); a_[2] = __builtin_amdgcn_s_memrealtime(); }
#endif
        if (ph + 1 < p.ph_hi) { if ((ph - 1) % PH_PER_LAYER == 8) { asm volatile("s_waitcnt vmcnt(0)" ::: "memory"); __syncthreads(); __builtin_amdgcn_fence(__ATOMIC_ACQUIRE, "agent"); }   else xcd_barrier(xbar); }
#ifdef PROBE_SEL
        if (PROBE_SEL == 1 && bx == 0) { volatile LAS unsigned long long* a_ = (volatile LAS unsigned long long*)(lds + LDS_MISC + 64); __hip_atomic_fetch_add((LAS unsigned long long*)a_, __builtin_amdgcn_s_memrealtime() - a_[2], __ATOMIC_RELAXED, __HIP_MEMORY_SCOPE_WORKGROUP); }
#endif
    }
#ifdef PROBE_SEL
    __syncthreads();
    if (blockIdx.x == 0) {
        volatile LAS unsigned long long* a_ = (volatile LAS unsigned long long*)((LAS unsigned char*)lds_raw + LDS_MISC + 64);
        const unsigned long long d_ = a_[0] >> 9, s_ = __builtin_amdgcn_s_memrealtime();
        while (__builtin_amdgcn_s_memrealtime() - s_ < d_) __builtin_amdgcn_s_sleep(8);
    }
#endif
}

extern "C" void kernel_launch(void* const* d_in, const int* in_sizes, int n_in, void* d_out, int out_size, void* d_ws, size_t ws_size, hipStream_t stream) {
    static int grid = 0;
    if (grid == 0) {
        if (n_in != N_IN || (size_t)out_size != O_END || ws_size < WS_END) { fprintf(stderr, "kernel_launch: unexpected shapes: n_in %d out %d ws %zu (need %zu)\n", n_in, out_size, ws_size, (size_t)WS_END); grid = -1; return; }
        int dev = 0, cus = 0, per_cu = 0;
        (void)hipGetDevice(&dev); (void)hipDeviceGetAttribute(&cus, hipDeviceAttributeMultiprocessorCount, dev);
        (void)hipFuncSetAttribute((const void*)fwd_kernel, hipFuncAttributeMaxDynamicSharedMemorySize, LDS_BYTES);
        if (hipOccupancyMaxActiveBlocksPerMultiprocessor(&per_cu, (const void*)fwd_kernel, NTHR, LDS_BYTES) != hipSuccess || per_cu < 1) { fprintf(stderr, "kernel_launch: occupancy query gave %d\n", per_cu); per_cu = 1; }
        (void)hipGetLastError();
        grid = cus * per_cu;
    }
    if (grid < 0) return;
    (void)hipMemsetAsync((char*)d_ws + WS_CTL, 0, CTL_BYTES, stream);
    Params p{};
    for (int i = 0; i < N_IN; ++i) p.in[i] = (const float*)d_in[i];
    p.out = (float*)d_out; p.ws = (unsigned char*)d_ws;
#ifdef MULTI_LAUNCH
    for (int ph = 0; ph < N_PHASES; ++ph) { p.ph_lo = ph; p.ph_hi = ph + 1; hipLaunchKernelGGL(fwd_kernel, dim3(grid), dim3(NTHR), LDS_BYTES, stream, p); }
#else
    p.ph_lo = 0; p.ph_hi = N_PHASES;
    void* args[] = {&p};
    const hipError_t e = hipLaunchCooperativeKernel((const void*)fwd_kernel, dim3(grid), dim3(NTHR), args, LDS_BYTES, stream);
    if (e != hipSuccess) fprintf(stderr, "kernel_launch: cooperative launch failed: %s (grid %d)\n", hipGetErrorString(e), grid);
#endif
}
```
